# Optimizing an MI355X kernel written in HIP

```python
import jax
import jax.numpy as jnp
from jax import lax
import numpy as np

D_MODEL = 1024
BATCH = 8
SEQ = 2048
DEPTH = 2

GRID_W = 64
HEAD_DIM = 64
NORM_EPS = 1e-6
RW_HEADS = 8
RW_DIM = RW_HEADS * HEAD_DIM
DECAY_RANK = 64
ICLR_RANK = 64
GATE_RANK = 128
RWKV_GN_EPS = 64e-5
RW_IN = 3 * RW_DIM + DECAY_RANK + ICLR_RANK + GATE_RANK
ATT_HEADS = 8
ATT_KV_HEADS = 2
ATT_DIM = ATT_HEADS * HEAD_DIM
ATT_KV_DIM = ATT_KV_HEADS * HEAD_DIM
ATT_IN = ATT_DIM + 2 * ATT_KV_DIM
Q_BLOCK = 128
ROPE_THETA = 10000.0
E_IN = RW_IN + ATT_IN
GLA_HEADS = 4
GLA_DK = D_MODEL // 2
GLA_DV = D_MODEL
GLA_DKH = GLA_DK // GLA_HEADS
GLA_DVH = GLA_DV // GLA_HEADS
GLA_GATE_RANK = 16
GLA_GATE_NORM = 16.0
GLA_CHUNK = 64
O_IN = 2 * GLA_DK + GLA_DV + GLA_GATE_RANK + GLA_DV
D_FF = 2816
N_EXPERTS = 8
TOP_K = 2
D_FF_EXPERT = 3584
MOE_BLOCK = 128
N_EVEN = (DEPTH + 1) // 2
N_ODD = DEPTH // 2

kernel_name = 'hybrid_rwkv7_gqa_gla_moe_encoder'


def rms_norm(x, g, eps=NORM_EPS):
    xf = x.astype(jnp.float32)
    y = xf * lax.rsqrt(jnp.mean(xf * xf, axis=-1, keepdims=True) + eps)
    return (y * g.astype(jnp.float32)).astype(x.dtype)


def swiglu(h, w_gate, w_up, w_down):
    return (jax.nn.silu(h @ w_gate) * (h @ w_up)) @ w_down


def centred_shift(x):
    prev = jnp.pad(x, ((0, 0), (1, 0), (0, 0)))[:, :-1]
    nxt = jnp.pad(x, ((0, 0), (0, 1), (0, 0)))[:, 1:]
    return 0.5 * (prev + nxt)


def rwkv7_scan(r, w, k, v, a, b, reverse):
    Bn, S, H, N = r.shape

    def step(state, inp):
        r_t, w_t, k_t, v_t, a_t, b_t = inp
        sa = jnp.einsum('bhvk,bhk->bhv', state, a_t)
        new = state * w_t[:, :, None, :] + sa[..., None] * b_t[:, :, None, :] + v_t[..., None] * k_t[:, :, None, :]
        read = state if reverse else new
        return new, jnp.einsum('bhvk,bhk->bhv', read, r_t)

    xs = tuple(jnp.moveaxis(t, 1, 0) for t in (r, w, k, v, a, b))
    init = jnp.zeros((Bn, H, N, N), jnp.float32)
    _, out = lax.scan(step, init, xs, reverse=reverse)
    return jnp.moveaxis(out, 0, 1)


def rwkv7_mixer(p, shift_mu, w0_f, w_up_f, w0_b, w_up_b, a0_f, a_up_f, a0_b, a_up_b, g_up, k_k, k_a, r_k, gn_w, gn_b):
    Bn, S, _ = p.shape
    p = p + (centred_shift(p) - p) * shift_mu
    o1 = 3 * RW_DIM
    o2 = o1 + DECAY_RANK
    o3 = o2 + ICLR_RANK
    r = p[..., :RW_DIM]
    k = p[..., RW_DIM:2 * RW_DIM]
    v = p[..., 2 * RW_DIM:o1]
    wd = jnp.tanh(p[..., o1:o2])
    ad = p[..., o2:o3]
    g = jax.nn.sigmoid(p[..., o3:]) @ g_up

    def heads(t):
        return t.reshape(Bn, S, RW_HEADS, HEAD_DIM).astype(jnp.float32)

    def per_head(c):
        return c.reshape(RW_HEADS, HEAD_DIM).astype(jnp.float32)

    rh, kh, vh = heads(r), heads(k), heads(v)
    kk = kh * per_head(k_k)
    kk = kk / jnp.maximum(jnp.sqrt(jnp.sum(kk * kk, axis=-1, keepdims=True)), 1e-12)

    def direction(w0, w_up, a0, a_up, reverse):
        z = (w0 + wd @ w_up).astype(jnp.float32)
        w = heads(jnp.exp(-jnp.exp(-jax.nn.softplus(-z) - 0.5)))
        a = heads(jax.nn.sigmoid((a0 + ad @ a_up).astype(jnp.float32)))
        kd = kh * (1.0 + (a - 1.0) * per_head(k_a))
        return rwkv7_scan(rh, w, kd, vh, -kk, kk * a, reverse), kd

    y_f, k_fwd = direction(w0_f, w_up_f, a0_f, a_up_f, False)
    y_b, _ = direction(w0_b, w_up_b, a0_b, a_up_b, True)
    y = y_f + y_b
    mean = jnp.mean(y, axis=-1, keepdims=True)
    var = jnp.mean(jnp.square(y - mean), axis=-1, keepdims=True)
    y = ((y - mean) * lax.rsqrt(var + RWKV_GN_EPS)).reshape(Bn, S, RW_DIM)
    y = y * gn_w.astype(jnp.float32) + gn_b.astype(jnp.float32)
    bonus = jnp.sum(rh * k_fwd * per_head(r_k), axis=-1, keepdims=True) * vh
    y = (y + bonus.reshape(Bn, S, RW_DIM)) * g.astype(jnp.float32)
    return y.astype(p.dtype)


def axial_rope_tables(S):
    rows = S // GRID_W
    row = jnp.repeat(jnp.arange(rows), GRID_W).astype(jnp.float32)
    col = jnp.tile(jnp.arange(GRID_W), rows).astype(jnp.float32)
    half = HEAD_DIM // 2
    freq = ROPE_THETA ** (-jnp.arange(0, half, 2, dtype=jnp.float32) / half)
    ang = jnp.concatenate([row[:, None] * freq, col[:, None] * freq], axis=-1)
    return jnp.cos(ang), jnp.sin(ang)


def apply_rope(x, cos, sin):
    xp = x.reshape(x.shape[:-1] + (HEAD_DIM // 2, 2))
    x0, x1 = xp[..., 0], xp[..., 1]
    c = cos[None, :, None, :]
    s = sin[None, :, None, :]
    return jnp.stack([x0 * c - x1 * s, x0 * s + x1 * c], axis=-1).reshape(x.shape)


def gqa_axial_attention(p, q_norm, k_norm):
    Bn, S, _ = p.shape
    G = ATT_HEADS // ATT_KV_HEADS
    q = p[..., :ATT_DIM].reshape(Bn, S, ATT_HEADS, HEAD_DIM)
    k = p[..., ATT_DIM:ATT_DIM + ATT_KV_DIM].reshape(Bn, S, ATT_KV_HEADS, HEAD_DIM)
    v = p[..., ATT_DIM + ATT_KV_DIM:].reshape(Bn, S, ATT_KV_HEADS, HEAD_DIM)
    cos, sin = axial_rope_tables(S)
    q = apply_rope(rms_norm(q, q_norm).astype(jnp.float32), cos, sin) * (HEAD_DIM ** -0.5)
    k = apply_rope(rms_norm(k, k_norm).astype(jnp.float32), cos, sin)
    nb = S // Q_BLOCK
    qb = q.reshape(Bn, nb, Q_BLOCK, ATT_KV_HEADS, G, HEAD_DIM).transpose(1, 0, 3, 4, 2, 5)

    def block(q_blk):
        s = jnp.einsum('bkgqd,bskd->bkgqs', q_blk, k)
        pr = jax.nn.softmax(s, axis=-1).astype(v.dtype)
        return jnp.einsum('bkgqs,bskd->bqkgd', pr, v)

    o = lax.map(block, qb)
    return o.transpose(1, 0, 2, 3, 4, 5).reshape(Bn, S, ATT_DIM).astype(p.dtype)


def gla_chunked(q, k, v, g, strict):
    Bn, H, S, dk = q.shape
    dv = v.shape[-1]
    C = GLA_CHUNK
    n = S // C
    q = q.reshape(Bn, H, n, C, dk)
    k = k.reshape(Bn, H, n, C, dk)
    g = g.reshape(Bn, H, n, C, dk)
    v = v.reshape(Bn, H, n, C, dv)
    b = jnp.cumsum(g, axis=3)
    b_mid = b[:, :, :, C // 2:C // 2 + 1]
    b_last = b[:, :, :, C - 1:C]
    att = jnp.einsum('bhnid,bhnjd->bhnij', q * jnp.exp(b - b_mid), k * jnp.exp(b_mid - b))
    mask = jnp.tril(jnp.ones((C, C), dtype=bool), k=-1 if strict else 0)
    att = jnp.where(mask, att, 0.0)
    o = jnp.einsum('bhnij,bhnjv->bhniv', att, v)
    kv = jnp.einsum('bhncd,bhncv->bhndv', k * jnp.exp(b_last - b), v)
    dec = jnp.exp(b_last[:, :, :, 0, :])

    def step(state, inp):
        d, kv_n = inp
        return state * d[..., None] + kv_n, state

    init = jnp.zeros((Bn, H, dk, dv), jnp.float32)
    _, states = lax.scan(step, init, (jnp.moveaxis(dec, 2, 0), jnp.moveaxis(kv, 2, 0)))
    states = jnp.moveaxis(states, 0, 2)
    o = o + jnp.einsum('bhncd,bhndv->bhncv', q * jnp.exp(b), states)
    return o.reshape(Bn, H, S, dv)


def gla_mixer(p, gate_up_f, gate_bias_f, gate_up_b, gate_bias_b, out_norm):
    Bn, S, _ = p.shape
    o1 = GLA_DK
    o2 = 2 * GLA_DK
    o3 = o2 + GLA_DV
    o4 = o3 + GLA_GATE_RANK
    gd = p[..., o3:o4]
    og = p[..., o4:]

    def heads(t, d):
        return t.reshape(Bn, S, GLA_HEADS, d).transpose(0, 2, 1, 3).astype(jnp.float32)

    qh = heads(p[..., :o1], GLA_DKH) * (GLA_DKH ** -0.5)
    kh = heads(p[..., o1:o2], GLA_DKH)
    vh = heads(p[..., o2:o3], GLA_DVH)

    def log_gate(up, bias):
        return heads(jax.nn.log_sigmoid((gd @ up + bias).astype(jnp.float32)) / GLA_GATE_NORM, GLA_DKH)

    def flip(t):
        return jnp.flip(t, axis=2)

    o_f = gla_chunked(qh, kh, vh, log_gate(gate_up_f, gate_bias_f), strict=False)
    o_b = flip(gla_chunked(flip(qh), flip(kh), flip(vh), flip(log_gate(gate_up_b, gate_bias_b)), strict=True))
    o = rms_norm(o_f + o_b, out_norm)
    o = o.transpose(0, 2, 1, 3).reshape(Bn, S, GLA_DV).astype(p.dtype)
    return o * jax.nn.silu(og)


def moe_swiglu(h, router, w_gate, w_up, w_down):
    Bn, S, D = h.shape
    T = Bn * S
    A = T * TOP_K
    hf = h.reshape(T, D)
    logits = (hf @ router).astype(jnp.float32)
    top_val, top_idx = lax.top_k(logits, TOP_K)
    gates = jax.nn.softmax(top_val, axis=-1)
    e_flat = top_idx.reshape(A)
    tok_flat = jnp.repeat(jnp.arange(T, dtype=jnp.int32), TOP_K)
    g_flat = gates.reshape(A)
    order = jnp.argsort(e_flat)
    e_sorted = e_flat[order]
    counts = jnp.zeros((N_EXPERTS,), jnp.int32).at[e_flat].add(1)
    padded = (counts + MOE_BLOCK - 1) // MOE_BLOCK * MOE_BLOCK
    start = jnp.cumsum(counts) - counts
    ends = jnp.cumsum(padded)
    pstart = ends - padded
    dest = pstart[e_sorted] + jnp.arange(A, dtype=jnp.int32) - start[e_sorted]
    P = (A + MOE_BLOCK - 1) // MOE_BLOCK * MOE_BLOCK + N_EXPERTS * MOE_BLOCK
    nb = P // MOE_BLOCK
    row_tok = jnp.zeros((P,), jnp.int32).at[dest].set(tok_flat[order])
    row_gate = jnp.zeros((P,), jnp.float32).at[dest].set(g_flat[order])
    blk_start = jnp.arange(nb, dtype=jnp.int32) * MOE_BLOCK
    blk_exp = jnp.minimum(jnp.searchsorted(ends, blk_start, side='right'), N_EXPERTS - 1)
    xb = hf[row_tok].reshape(nb, MOE_BLOCK, D)

    def expert_block(inp):
        x_blk, e = inp
        return (jax.nn.silu(x_blk @ w_gate[e]) * (x_blk @ w_up[e])) @ w_down[e]

    yb = lax.map(expert_block, (xb, blk_exp)).reshape(P, D)
    y = jnp.zeros((T, D), h.dtype).at[row_tok].add((yb * row_gate[:, None]).astype(h.dtype))
    return y.reshape(Bn, S, D)


def even_layer(x, norm1, w_in, shift_mu, w0_f, w_up_f, w0_b, w_up_b, a0_f, a_up_f, a0_b, a_up_b, g_up,
               k_k, k_a, r_k, gn_w, gn_b, q_norm, k_norm, w_out, norm2, ffn_gate, ffn_up, ffn_down):
    p = rms_norm(x, norm1) @ w_in
    y_a = rwkv7_mixer(p[..., :RW_IN], shift_mu, w0_f, w_up_f, w0_b, w_up_b, a0_f, a_up_f, a0_b, a_up_b,
                      g_up, k_k, k_a, r_k, gn_w, gn_b)
    y_b = gqa_axial_attention(p[..., RW_IN:], q_norm, k_norm)
    x = x + jnp.concatenate([y_a, y_b], axis=-1) @ w_out
    return x + swiglu(rms_norm(x, norm2), ffn_gate, ffn_up, ffn_down)


def odd_layer(x, norm1, w_in, gate_up_f, gate_bias_f, gate_up_b, gate_bias_b, out_norm, w_out,
              norm2, router, exp_gate, exp_up, exp_down):
    p = rms_norm(x, norm1) @ w_in
    x = x + gla_mixer(p, gate_up_f, gate_bias_f, gate_up_b, gate_bias_b, out_norm) @ w_out
    return x + moe_swiglu(rms_norm(x, norm2), router, exp_gate, exp_up, exp_down)


def setup_inputs(seed: int = 0) -> dict:
    key = jax.random.key(seed)
    ks = iter(jax.random.split(key, 48))
    D = D_MODEL
    NE, NO = N_EVEN, N_ODD

    def nrm(shape, scale):
        return scale * jax.random.normal(next(ks), shape, jnp.float32)

    def gain(shape):
        return 1.0 + nrm(shape, 0.02)

    def unif(shape, lo, hi):
        return jax.random.uniform(next(ks), shape, jnp.float32, lo, hi)

    return {
        'x': nrm((BATCH, SEQ, D), 1.0),
        'e_norm1': gain((NE, D)),
        'e_w_in': nrm((NE, D, E_IN), D ** -0.5),
        'e_shift_mu': unif((NE, RW_IN), 0.0, 1.0),
        'e_w0_f': unif((NE, RW_DIM), -6.0, -1.0),
        'e_w_up_f': nrm((NE, DECAY_RANK, RW_DIM), 0.1),
        'e_w0_b': unif((NE, RW_DIM), -6.0, -1.0),
        'e_w_up_b': nrm((NE, DECAY_RANK, RW_DIM), 0.1),
        'e_a0_f': nrm((NE, RW_DIM), 0.1),
        'e_a_up_f': nrm((NE, ICLR_RANK, RW_DIM), 0.1),
        'e_a0_b': nrm((NE, RW_DIM), 0.1),
        'e_a_up_b': nrm((NE, ICLR_RANK, RW_DIM), 0.1),
        'e_g_up': nrm((NE, GATE_RANK, RW_DIM), GATE_RANK ** -0.5),
        'e_k_k': 0.85 + nrm((NE, RW_DIM), 0.02),
        'e_k_a': gain((NE, RW_DIM)),
        'e_r_k': nrm((NE, RW_DIM), 0.1),
        'e_gn_w': gain((NE, RW_DIM)),
        'e_gn_b': nrm((NE, RW_DIM), 0.02),
        'e_q_norm': gain((NE, HEAD_DIM)),
        'e_k_norm': gain((NE, HEAD_DIM)),
        'e_w_out': nrm((NE, RW_DIM + ATT_DIM, D), (RW_DIM + ATT_DIM) ** -0.5),
        'e_norm2': gain((NE, D)),
        'e_ffn_gate': nrm((NE, D, D_FF), D ** -0.5),
        'e_ffn_up': nrm((NE, D, D_FF), D ** -0.5),
        'e_ffn_down': nrm((NE, D_FF, D), D_FF ** -0.5),
        'o_norm1': gain((NO, D)),
        'o_w_in': nrm((NO, D, O_IN), D ** -0.5),
        'o_gate_up_f': nrm((NO, GLA_GATE_RANK, GLA_DK), GLA_GATE_RANK ** -0.5),
        'o_gate_bias_f': nrm((NO, GLA_DK), 0.1),
        'o_gate_up_b': nrm((NO, GLA_GATE_RANK, GLA_DK), GLA_GATE_RANK ** -0.5),
        'o_gate_bias_b': nrm((NO, GLA_DK), 0.1),
        'o_out_norm': gain((NO, GLA_DVH)),
        'o_w_out': nrm((NO, GLA_DV, D), GLA_DV ** -0.5),
        'o_norm2': gain((NO, D)),
        'o_router': nrm((NO, D, N_EXPERTS), D ** -0.5),
        'o_exp_gate': nrm((NO, N_EXPERTS, D, D_FF_EXPERT), D ** -0.5),
        'o_exp_up': nrm((NO, N_EXPERTS, D, D_FF_EXPERT), D ** -0.5),
        'o_exp_down': nrm((NO, N_EXPERTS, D_FF_EXPERT, D), D_FF_EXPERT ** -0.5),
    }


def reference(x, e_norm1, e_w_in, e_shift_mu, e_w0_f, e_w_up_f, e_w0_b, e_w_up_b, e_a0_f, e_a_up_f,
              e_a0_b, e_a_up_b, e_g_up, e_k_k, e_k_a, e_r_k, e_gn_w, e_gn_b, e_q_norm, e_k_norm, e_w_out,
              e_norm2, e_ffn_gate, e_ffn_up, e_ffn_down, o_norm1, o_w_in, o_gate_up_f, o_gate_bias_f,
              o_gate_up_b, o_gate_bias_b, o_out_norm, o_w_out, o_norm2, o_router, o_exp_gate, o_exp_up,
              o_exp_down):
    for i in range(DEPTH):
        j = i // 2
        if i % 2 == 0:
            x = even_layer(x, e_norm1[j], e_w_in[j], e_shift_mu[j], e_w0_f[j], e_w_up_f[j], e_w0_b[j],
                           e_w_up_b[j], e_a0_f[j], e_a_up_f[j], e_a0_b[j], e_a_up_b[j], e_g_up[j], e_k_k[j],
                           e_k_a[j], e_r_k[j], e_gn_w[j], e_gn_b[j], e_q_norm[j], e_k_norm[j], e_w_out[j],
                           e_norm2[j], e_ffn_gate[j], e_ffn_up[j], e_ffn_down[j])
        else:
            x = odd_layer(x, o_norm1[j], o_w_in[j], o_gate_up_f[j], o_gate_bias_f[j], o_gate_up_b[j],
                          o_gate_bias_b[j], o_out_norm[j], o_w_out[j], o_norm2[j], o_router[j],
                          o_exp_gate[j], o_exp_up[j], o_exp_down[j])
    return x
```

```cpp
#include <hip/hip_runtime.h>
#include <cstdio>
#include <cstdint>

#ifndef MK_N_LAUNCHES
#define MK_N_LAUNCHES 1
#define MK_REP_MASK 0u
#define MK_REP_SUB 0u
#endif

#define GAS __attribute__((address_space(1)))
#define LAS __attribute__((address_space(3)))
typedef unsigned short bf16_t;
typedef short bf16x8 __attribute__((ext_vector_type(8)));
typedef short bf16x4 __attribute__((ext_vector_type(4)));
typedef float f32x4 __attribute__((ext_vector_type(4)));
typedef float f32x2 __attribute__((ext_vector_type(2)));
typedef float f32x16 __attribute__((ext_vector_type(16)));
typedef unsigned u32x4 __attribute__((ext_vector_type(4)));
typedef unsigned u32x2 __attribute__((ext_vector_type(2)));
typedef __bf16 bf16x2_t __attribute__((ext_vector_type(2)));

constexpr int D_MODEL = 1024, BATCH = 8, SEQ = 2048, M_TOK = BATCH * SEQ;
constexpr int HD = 64;
constexpr int RW_HEADS = 8, RW_DIM = 512, RW_IN = 1792;
constexpr int ATT_HEADS = 8, ATT_KV = 2;
constexpr int E_IN = 2560;
constexpr int GLA_H = 4, GLA_DK = 512, GLA_DV = 1024, GLA_DKH = 128, GLA_DVH = 256, GLA_R = 16;
constexpr int O_IN = 3088, O_INP = 3328;
constexpr int D_FF = 2816, NEXP = 8, D_FFE = 3584;
constexpr float NORM_EPS = 1e-6f;

constexpr size_t MiB = 1u << 20;
constexpr size_t WS_CTL = 0, CTL_ZERO_BYTES = 1 * MiB;
constexpr size_t WS_SSQ0 = 1 * MiB, WS_SSQ1 = 2 * MiB, WS_SSQ2 = 3 * MiB;
constexpr size_t WS_RSTD3 = 4 * MiB;
constexpr size_t WS_TOKE = WS_RSTD3 + 65536;
constexpr size_t WS_TOKG = WS_TOKE + 131072;
constexpr size_t WS_CNT = WS_TOKG + 131072;
constexpr size_t WS_TOT = WS_CNT + 16384;
constexpr size_t WS_ROWTOK = WS_TOT + 256;
constexpr int ROWS_PER_SLOT = M_TOK + 256;
constexpr size_t WS_ROWGATE = WS_ROWTOK + (size_t)2 * ROWS_PER_SLOT * 4;
constexpr size_t WS_DECS = 6 * MiB;
constexpr size_t WS_ROPE = 7 * MiB;
constexpr size_t WS_XB = 8 * MiB;
constexpr size_t WS_WIN0 = 40 * MiB, WS_WLR = 45 * MiB, WS_WOUT0 = 47 * MiB, WS_WGU0 = 49 * MiB, WS_WD0 = 60 * MiB, WS_WIN1 = 66 * MiB, WS_WOUT1 = 73 * MiB;
constexpr size_t AR = 75 * MiB;
constexpr size_t A_P0 = AR + 0, A_RS = AR + 80 * MiB, A_KS = AR + 96 * MiB, A_VS = AR + 112 * MiB, A_NKK = AR + 128 * MiB, A_AP = AR + 144 * MiB;
constexpr size_t A_QH = AR + 152 * MiB, A_KH = AR + 168 * MiB, A_VT0 = AR + 172 * MiB;
constexpr size_t A_LWF = AR + 176 * MiB, A_LWB = AR + 192 * MiB, A_KDF = AR + 208 * MiB, A_KDB = AR + 224 * MiB, A_BBF = AR + 240 * MiB, A_BBB = AR + 256 * MiB;
constexpr size_t A_GG = AR + 272 * MiB, A_YF = AR + 288 * MiB, A_YB = AR + 320 * MiB, A_YCAT = AR + 352 * MiB;
constexpr size_t A_HID0 = AR + 0;
constexpr size_t A_P1 = AR + 0;
constexpr size_t A_QT = AR + 104 * MiB, A_KT = AR + 120 * MiB, A_QHAT = AR + 136 * MiB, A_K2T = AR + 152 * MiB;
constexpr size_t GLA_DIR_STRIDE = 64 * MiB;
constexpr size_t A_VT1 = AR + 232 * MiB, A_OF = AR + 264 * MiB, A_OB = AR + 296 * MiB, A_GOUT = AR + 328 * MiB;
constexpr size_t A_WEGU = AR + 0, A_WED = AR + 112 * MiB, A_HID1 = AR + 168 * MiB;
constexpr size_t WS_END = 460 * MiB;
static_assert(A_HID1 + (size_t)ROWS_PER_SLOT * D_FFE * 2 <= WS_END, "ws map");
static_assert(A_GOUT + 32 * MiB <= WS_END && A_YCAT + 32 * MiB <= WS_END, "ws map");

constexpr int CW_BAR = 4096;

constexpr int RING_BYTES = 131072;
constexpr int MISC_OFF = RING_BYTES;
constexpr int MOE_OFF = RING_BYTES + 256;
constexpr int LDS_BYTES = 147456;

__device__ __forceinline__ unsigned pk2(float lo, float hi) { f32x2 v = {lo, hi}; bf16x2_t b = __builtin_convertvector(v, bf16x2_t); return __builtin_bit_cast(unsigned, b); }
__device__ __forceinline__ bf16_t f2bf(float f) { return (bf16_t)(pk2(f, 0.f) & 0xffffu); }
__device__ __forceinline__ float bf2f(bf16_t h) { return __uint_as_float(((unsigned)h) << 16); }
__device__ __forceinline__ float bflo(unsigned w) { return __uint_as_float(w << 16); }
__device__ __forceinline__ float bfhi(unsigned w) { return __uint_as_float(w & 0xffff0000u); }
__device__ __forceinline__ float wave_sum(float v) {
#pragma unroll
    for (int o = 1; o < 64; o <<= 1) v += __shfl_xor(v, o);
    return v;
}
__device__ __forceinline__ float sigmoidf_(float x) { return 1.f / (1.f + __expf(-x)); }
__device__ __forceinline__ float siluf_(float x) { return x / (1.f + __expf(-x)); }
#define LDS_WAIT() asm volatile("s_waitcnt lgkmcnt(0)" ::: "memory")
#define VM_WAIT() asm volatile("s_waitcnt vmcnt(0)" ::: "memory")

#define XB_TMO      128
#define XB_XCNT(j)  (256  + 64 * (j))
#define XB_XSUB(j)  (1280 + 64 * (j))
#define XB_XGEN(j)  (2304 + 64 * (j))
#define XB_TOP      3328
#define XB_TOPGEN   3392
#define XCD_BAR_WORDS 3456
#define XB_SPIN_CAP (1u << 20)
__device__ __forceinline__ unsigned xb_ld(unsigned* p)              { return __hip_atomic_load(p, __ATOMIC_RELAXED, __HIP_MEMORY_SCOPE_AGENT); }
__device__ __forceinline__ unsigned xb_add(unsigned* p, unsigned v) { return __hip_atomic_fetch_add(p, v, __ATOMIC_RELAXED, __HIP_MEMORY_SCOPE_AGENT); }
__device__ __forceinline__ unsigned xb_xcc_id() { return (unsigned)__builtin_amdgcn_s_getreg((3 << 11) | 20) & 0xFu; }
#define XB_SPIN(cond, bar) do { unsigned _sp = 0; while (cond) { __builtin_amdgcn_s_sleep(1); \
    if ((++_sp & 255u) == 0u) { if (xb_ld(&(bar)[XB_TMO])) break; if (_sp > XB_SPIN_CAP) { atomicAdd(&(bar)[XB_TMO], 1u); break; } } } } while (0)
struct XcdBarrier { unsigned* bar; unsigned x; volatile LAS unsigned* st; };
__device__ __forceinline__ XcdBarrier xcd_barrier_post(unsigned* bar, volatile LAS unsigned* st) {
    XcdBarrier b; b.bar = bar; b.x = xb_xcc_id(); b.st = st;
    if (threadIdx.x == 0) (void)xb_add(&bar[XB_XCNT(b.x)], 1u);
    return b;
}
__device__ __forceinline__ void xcd_barrier_complete(unsigned* bar, unsigned x, unsigned& nloc, unsigned& nx) {
    const unsigned G = gridDim.x * gridDim.y * gridDim.z;
    unsigned sum, cnt, mine, sp = 0u;
    for (;;) {
        sum = 0u; cnt = 0u; mine = 0u;
#pragma unroll
        for (unsigned j = 0; j < 16; ++j) { const unsigned c = xb_ld(&bar[XB_XCNT(j)]); sum += c; cnt += (c > 0u) ? 1u : 0u; mine = (j == x) ? c : mine; }
        if (sum == G) break;
        __builtin_amdgcn_s_sleep(1);
        if ((++sp & 255u) == 0u) { if (xb_ld(&bar[XB_TMO])) break; if (sp > XB_SPIN_CAP) { atomicAdd(&bar[XB_TMO], 1u); break; } }
    }
    nloc = mine > 0u ? mine : 1u; nx = cnt > 0u ? cnt : 1u;
}
__device__ __forceinline__ void xcd_barrier(const XcdBarrier& b) {
    asm volatile("s_waitcnt vmcnt(0)" ::: "memory");
    __syncthreads();
    if (threadIdx.x == 0) {
        unsigned* bar = b.bar;
        __builtin_amdgcn_s_waitcnt(0);
        unsigned nloc = b.st[0], nx = b.st[1];
        if (nloc == 0u) { xcd_barrier_complete(bar, b.x, nloc, nx); b.st[0] = nloc; b.st[1] = nx; }
        const unsigned old = xb_add(&bar[XB_XSUB(b.x)], 1u);
        const unsigned gen = old / nloc;
        if (old + 1u == (gen + 1u) * nloc) {
            __builtin_amdgcn_fence(__ATOMIC_RELEASE, "agent");
            asm volatile("s_waitcnt vmcnt(0)" ::: "memory");
            const unsigned og = xb_add(&bar[XB_TOP], 1u);
            const unsigned tg = og / nx;
            if (og + 1u == (tg + 1u) * nx) xb_add(&bar[XB_TOPGEN], 1u);
            else XB_SPIN(xb_ld(&bar[XB_TOPGEN]) == tg, bar);
            __builtin_amdgcn_fence(__ATOMIC_ACQUIRE, "agent");
            xb_add(&bar[XB_XGEN(b.x)], 1u);
            asm volatile("s_waitcnt vmcnt(0)" ::: "memory");
        } else {
            XB_SPIN(xb_ld(&bar[XB_XGEN(b.x)]) == gen, bar);
            __builtin_amdgcn_fence(__ATOMIC_ACQUIRE, "agent");
            asm volatile("s_waitcnt vmcnt(0)" ::: "memory");
        }
    }
    __syncthreads();
}

namespace pg8 {
constexpr int BM = 256, BK = 64, HALF = 128, HTB = HALF * BK * 2, STAGE_BYTES = 8 * HTB, NXCD = 8, WGM = 4;
__host__ __device__ __forceinline__ int lds_byte(int r, int c) { const int st = (r >> 4) * 2 + (c >> 5), rr = r & 15, cc = c & 31, ob = rr * 64 + cc * 2; return st * 1024 + (ob ^ (((ob >> 9) & 1) << 5)); }
__host__ __device__ __forceinline__ void stage_rc(int b, int& R, int& C) { const int st = b / 1024, sb = b % 1024, swz = sb ^ (((sb >> 9) & 1) << 5); R = (st >> 1) * 16 + swz / 64; C = (st & 1) * 32 + (swz % 64) / 2; }
__host__ __device__ __forceinline__ int perm32(int rho) { const int n = rho >> 4, i = rho & 15; return 8 * (i >> 2) + 4 * n + (i & 3); }

struct Unit { const char* a; const char* b; int pm, pn; int row0, nrows, e; int nt, flags; };

struct GridOrder {
    int nM, nN, nwg, G, c;
    __device__ void init(int nM_, int nN_, int G_, int c_) { nM = nM_; nN = nN_; nwg = nM * nN; G = G_; c = c_; }
    __device__ bool tile(int i, int& pm, int& pn) const {
        const long L = (long)i * G + c; if (L >= nwg) return false;
        int wgid = (int)L; { const int q = nwg / NXCD, r = nwg % NXCD, xcd = wgid % NXCD, off = wgid / NXCD; wgid = (xcd < r ? xcd * (q + 1) : r * (q + 1) + (xcd - r) * q) + off; }
        const int nig = WGM * nN, gid = wgid / nig, fm = gid * WGM, gsz = (nM - fm) < WGM ? (nM - fm) : WGM;
        pm = fm + ((wgid % nig) % gsz); pn = (wgid % nig) / gsz; return true;
    }
};
struct DenseSched {
    GridOrder go; const char* A; const char* Bt; size_t tstep; int nt_;
    __device__ void init(const bf16_t* A_, const bf16_t* Bt_, int M, int N, int K, int G, int c) { go.init(M / BM, N / BM, G, c); A = (const char*)A_; Bt = (const char*)Bt_; tstep = (size_t)BM * K * 2; nt_ = K / BK; }
    __device__ bool next(int i, Unit& u) const { int pm, pn; if (!go.tile(i, pm, pn)) return false; u.pm = pm; u.pn = pn; u.a = A + (size_t)pm * tstep; u.b = Bt + (size_t)pn * tstep; u.row0 = pm * BM; u.nrows = BM; u.e = 0; u.nt = nt_; u.flags = 0; return true; }
};

template <class Epi, class Sched, bool GATHER>
__device__ __forceinline__ void gemm_phase(const int tid, LAS unsigned char* lds, const int K_, const Sched& S, const Epi& E, const int* gather_rows) {
    int K = K_; asm volatile("" : "+s"(K));
    const int wid = __builtin_amdgcn_readfirstlane(tid >> 6), lane = tid & 63, wr = wid >> 2, wc = wid & 3, fr = lane & 15, fq = lane >> 4;
    int sR[2], sC[2];
    unsigned voffB[2];
#pragma unroll
    for (int i = 0; i < 2; ++i) { int R, C; stage_rc(tid * 16 + i * 8192, R, C); sR[i] = R; sC[i] = C; const int Rb = Epi::PERM ? ((R & ~31) + perm32(R & 31)) : R; voffB[i] = (unsigned)(Rb * K + C) * 2u; }
    const size_t kstep = (size_t)(BK * 2);
    const size_t hstep = (size_t)HALF * K * 2;
    const unsigned ldsw = (unsigned)wid * 1024u;
    const int aoff = lds_byte(wr * 64 + fr, fq * 8), boff = lds_byte(wc * 32 + fr, fq * 8);
    unsigned cva[2][2], nva[2][2];
#define PG8_SETVA(va, u) do { _Pragma("unroll") for (int h_ = 0; h_ < 2; ++h_) _Pragma("unroll") for (int i_ = 0; i_ < 2; ++i_) { \
        if (GATHER) { int rr_ = (u).row0 + h_ * HALF + sR[i_]; const int rmax_ = (u).row0 + (u).nrows - 1; rr_ = rr_ > rmax_ ? rmax_ : rr_; int tk_ = gather_rows[rr_]; tk_ = tk_ < 0 ? 0 : (tk_ > 16383 ? 16383 : tk_); va[h_][i_] = (unsigned)(tk_ * K + sC[i_]) * 2u; } \
        else va[h_][i_] = (unsigned)((h_ * HALF + sR[i_]) * K + sC[i_]) * 2u; } } while (0)
#define PG8_SA(b, h) (((b) * 2 + (h)) * HTB)
#define PG8_SB(b, h) ((4 + (b) * 2 + (h)) * HTB)
#define PG8_STAGE2(bufoff, gbase, v0, v1) do { \
        __builtin_amdgcn_global_load_lds((const unsigned*)((const char*)(gbase) + (v0)), (LAS unsigned*)(lds + (bufoff) + ldsw), 16, 0, 0); \
        __builtin_amdgcn_global_load_lds((const unsigned*)((const char*)(gbase) + (v1)), (LAS unsigned*)(lds + (bufoff) + ldsw + 8192), 16, 0, 0); } while (0)
#define PG8_STAGEB(bufoff, gbase) PG8_STAGE2(bufoff, gbase, voffB[0], voffB[1])
#define PG8_STAGEA(bufoff, gbase, va, h) PG8_STAGE2(bufoff, gbase, va[h][0], va[h][1])
#define PG8_LDA(dst, b, h) do { _Pragma("unroll") for (int m = 0; m < 4; ++m) _Pragma("unroll") for (int k = 0; k < 2; ++k) dst[m][k] = *(const LAS bf16x8*)(lds + PG8_SA(b, h) + aoff + m * 2048 + k * 1024); } while (0)
#define PG8_LDB(dst, b, h) do { _Pragma("unroll") for (int n = 0; n < 2; ++n) _Pragma("unroll") for (int k = 0; k < 2; ++k) dst[n][k] = *(const LAS bf16x8*)(lds + PG8_SB(b, h) + boff + n * 2048 + k * 1024); } while (0)
#define PG8_MMA(ai, bj, At, Bt) do { __builtin_amdgcn_s_setprio(1); _Pragma("unroll") for (int m = 0; m < 4; ++m) _Pragma("unroll") for (int n = 0; n < 2; ++n) _Pragma("unroll") for (int k = 0; k < 2; ++k) \
        acc[ai][bj][m][n] = __builtin_amdgcn_mfma_f32_16x16x32_bf16(Bt[n][k], At[m][k], acc[ai][bj][m][n], 0, 0, 0); __builtin_amdgcn_s_setprio(0); } while (0)
#define PG8_WAIT_V(n) asm volatile("s_waitcnt vmcnt(" #n ")" ::: "memory")
#define PG8_WAIT_L(n) asm volatile("s_waitcnt lgkmcnt(" #n ")" ::: "memory")
#define PG8_BAR __builtin_amdgcn_s_barrier()
#define PG8_SCHED __builtin_amdgcn_sched_barrier(0)
    Unit cur, nxt; int ui = 0;
    if (!S.next(0, cur)) return;
    PG8_SETVA(cva, cur);
    f32x4 acc[2][2][4][2];
#pragma unroll
    for (int a = 0; a < 2; ++a)
#pragma unroll
        for (int b = 0; b < 2; ++b)
#pragma unroll
            for (int m = 0; m < 4; ++m)
#pragma unroll
                for (int n = 0; n < 2; ++n) acc[a][b][m][n] = (f32x4){0.f, 0.f, 0.f, 0.f};
    bf16x8 At[4][2], B0[2][2], B1[2][2];
    const char* cA = cur.a; const char* cB = cur.b;
    PG8_STAGEB(PG8_SB(0, 0), cB); PG8_STAGEB(PG8_SB(0, 1), cB + hstep); PG8_STAGEA(PG8_SA(0, 0), cA, cva, 0); PG8_STAGEA(PG8_SA(0, 1), cA, cva, 1);
    if (wr == 1) PG8_BAR;
    PG8_WAIT_V(2); PG8_BAR;
    PG8_STAGEB(PG8_SB(1, 0), cB + kstep); PG8_STAGEA(PG8_SA(1, 0), cA + kstep, cva, 0); PG8_STAGEB(PG8_SB(1, 1), cB + hstep + kstep);
    PG8_WAIT_V(6); PG8_BAR;
    for (;;) {
        const bool has_next = S.next(ui + 1, nxt);
        if (has_next) PG8_SETVA(nva, nxt);
        else {
#pragma unroll
            for (int h = 0; h < 2; ++h)
#pragma unroll
                for (int i = 0; i < 2; ++i) nva[h][i] = cva[h][i];
        }
        const char* nA = has_next ? nxt.a : cA; const char* nB = has_next ? nxt.b : cB;
        const int nt = cur.nt;
        for (int t = 0; t < nt; t += 2) {
            const bool last = (t == nt - 2);
            const char* a1 = cA + (size_t)(t + 1) * kstep;
            const char* a2 = last ? nA : cA + (size_t)(t + 2) * kstep; const char* b2 = last ? nB : cB + (size_t)(t + 2) * kstep;
            const char* a3 = a2 + kstep; const char* b3 = b2 + kstep;
            unsigned va2[2][2];
#pragma unroll
            for (int h = 0; h < 2; ++h)
#pragma unroll
                for (int i = 0; i < 2; ++i) va2[h][i] = (GATHER && last) ? nva[h][i] : cva[h][i];
            PG8_LDB(B0, 0, 0); PG8_LDB(B1, 0, 1); PG8_SCHED; PG8_LDA(At, 0, 0); PG8_STAGEA(PG8_SA(1, 1), a1, cva, 1);
            PG8_WAIT_V(8); PG8_WAIT_L(0); PG8_BAR; PG8_MMA(0, 0, At, B0); PG8_MMA(0, 1, At, B1); PG8_BAR; PG8_SCHED;
            PG8_LDA(At, 0, 1); PG8_STAGEB(PG8_SB(0, 0), b2); PG8_STAGEB(PG8_SB(0, 1), b2 + hstep); PG8_STAGEA(PG8_SA(0, 0), a2, va2, 0);
            PG8_WAIT_V(8); PG8_WAIT_L(0); PG8_BAR; PG8_MMA(1, 0, At, B0); PG8_MMA(1, 1, At, B1); PG8_BAR; PG8_SCHED;
            PG8_LDB(B0, 1, 0); PG8_LDB(B1, 1, 1); PG8_SCHED; PG8_LDA(At, 1, 0); PG8_STAGEA(PG8_SA(0, 1), a2, va2, 1);
            PG8_WAIT_V(8); PG8_WAIT_L(0); PG8_BAR; PG8_MMA(0, 0, At, B0); PG8_MMA(0, 1, At, B1); PG8_BAR; PG8_SCHED;
            PG8_LDA(At, 1, 1); PG8_STAGEB(PG8_SB(1, 0), b3); PG8_STAGEB(PG8_SB(1, 1), b3 + hstep); PG8_STAGEA(PG8_SA(1, 0), a3, va2, 0);
            PG8_WAIT_V(8); PG8_WAIT_L(0); PG8_BAR; PG8_MMA(1, 0, At, B0); PG8_MMA(1, 1, At, B1); PG8_BAR; PG8_SCHED;
        }
        if (wr == 0) PG8_BAR;
        E(acc, cur, wr, wc, fr, fq);
        if (!has_next) break;
#pragma unroll
        for (int a = 0; a < 2; ++a)
#pragma unroll
            for (int b = 0; b < 2; ++b)
#pragma unroll
                for (int m = 0; m < 4; ++m)
#pragma unroll
                    for (int n = 0; n < 2; ++n) acc[a][b][m][n] = (f32x4){0.f, 0.f, 0.f, 0.f};
        cur = nxt; cA = nA; cB = nB; ++ui;
#pragma unroll
        for (int h = 0; h < 2; ++h)
#pragma unroll
            for (int i = 0; i < 2; ++i) cva[h][i] = nva[h][i];
        if (wr == 1) PG8_BAR;
    }
    PG8_WAIT_V(0);
    PG8_BAR;
#undef PG8_SETVA
#undef PG8_SA
#undef PG8_SB
#undef PG8_STAGE2
#undef PG8_STAGEA
#undef PG8_STAGEB
#undef PG8_LDA
#undef PG8_LDB
#undef PG8_MMA
#undef PG8_WAIT_V
#undef PG8_WAIT_L
#undef PG8_BAR
#undef PG8_SCHED
}
}

__device__ __forceinline__ float rstd_from_ssq(const float* ssq, int row) {
    const f32x4* p = (const f32x4*)(ssq + (size_t)row * 16);
    const f32x4 a = p[0], b = p[1], c = p[2], d = p[3];
    const float s = (((a.x + a.y) + (a.z + a.w)) + ((b.x + b.y) + (b.z + b.w))) + (((c.x + c.y) + (c.z + c.w)) + ((d.x + d.y) + (d.z + d.w)));
    return 1.0f / sqrtf(s * (1.f / 1024.f) + NORM_EPS);
}
__device__ __forceinline__ u32x4 pack8(const f32x4 v0, const f32x4 v1) { u32x4 w; w.x = pk2(v0[0], v0[1]); w.y = pk2(v0[2], v0[3]); w.z = pk2(v1[0], v1[1]); w.w = pk2(v1[2], v1[3]); return w; }

struct EpiScaleBf16 {
    static constexpr bool PERM = true;
    bf16_t* O; int ldc; const float* ssq;
    __device__ __forceinline__ void operator()(const f32x4 (&acc)[2][2][4][2], const pg8::Unit& u, int wr, int wc, int fr, int fq) const {
        const int row0 = u.pm * 256 + wr * 64 + fr, col0 = u.pn * 256 + wc * 32 + 8 * fq;
#pragma unroll
        for (int ai = 0; ai < 2; ++ai)
#pragma unroll
            for (int m = 0; m < 4; ++m) { const int row = row0 + ai * 128 + m * 16; const float rs = rstd_from_ssq(ssq, row); bf16_t* rowp = O + (size_t)row * ldc + col0;
#pragma unroll
                for (int bj = 0; bj < 2; ++bj) *(u32x4*)(rowp + bj * 128) = pack8(acc[ai][bj][m][0] * rs, acc[ai][bj][m][1] * rs); }
    }
};
struct EpiResid {
    static constexpr bool PERM = true;
    const float* base; float* out; bf16_t* xb; float* ssq;
    __device__ __forceinline__ void operator()(const f32x4 (&acc)[2][2][4][2], const pg8::Unit& u, int wr, int wc, int fr, int fq) const {
        const int row0 = u.pm * 256 + wr * 64 + fr, col0 = u.pn * 256 + wc * 32 + 8 * fq;
#pragma unroll
        for (int ai = 0; ai < 2; ++ai)
#pragma unroll
            for (int m = 0; m < 4; ++m) { const int row = row0 + ai * 128 + m * 16; const size_t off = (size_t)row * 1024 + col0; float ss = 0.f;
#pragma unroll
                for (int bj = 0; bj < 2; ++bj) { const f32x4 b0 = *(const f32x4*)(base + off + bj * 128), b1 = *(const f32x4*)(base + off + bj * 128 + 4);
                    const f32x4 o0 = b0 + acc[ai][bj][m][0], o1 = b1 + acc[ai][bj][m][1];
                    *(f32x4*)(out + off + bj * 128) = o0; *(f32x4*)(out + off + bj * 128 + 4) = o1;
                    ss += (o0[0] * o0[0] + o0[1] * o0[1]) + (o0[2] * o0[2] + o0[3] * o0[3]) + (o1[0] * o1[0] + o1[1] * o1[1]) + (o1[2] * o1[2] + o1[3] * o1[3]);
                    *(u32x4*)(xb + off + bj * 128) = pack8(o0, o1); }
                ss += __shfl_xor(ss, 16); ss += __shfl_xor(ss, 32);
                if (ssq && fq == 0) ssq[(size_t)row * 16 + u.pn * 4 + wc] = ss; }
    }
};
struct EpiSwiGLU {
    static constexpr bool PERM = true;
    bf16_t* H; int ldh; const float* ssq;
    __device__ __forceinline__ void operator()(const f32x4 (&acc)[2][2][4][2], const pg8::Unit& u, int wr, int wc, int fr, int fq) const {
        const int row0 = u.pm * 256 + wr * 64 + fr, hcol0 = u.pn * 128 + wc * 32 + 8 * fq;
#pragma unroll
        for (int ai = 0; ai < 2; ++ai)
#pragma unroll
            for (int m = 0; m < 4; ++m) { const int row = row0 + ai * 128 + m * 16; const float rs = rstd_from_ssq(ssq, row);
                f32x4 h[2];
#pragma unroll
                for (int n = 0; n < 2; ++n) { const f32x4 g = acc[ai][0][m][n] * rs, up = acc[ai][1][m][n] * rs;
#pragma unroll
                    for (int i = 0; i < 4; ++i) h[n][i] = siluf_(g[i]) * up[i]; }
                *(u32x4*)(H + (size_t)row * ldh + hcol0) = pack8(h[0], h[1]); }
    }
};
struct EpiSwiGLUMoE {
    static constexpr bool PERM = true;
    bf16_t* H; const float* rstd3; const int* row_tok;
    __device__ __forceinline__ void operator()(const f32x4 (&acc)[2][2][4][2], const pg8::Unit& u, int wr, int wc, int fr, int fq) const {
        const int hcol0 = u.pn * 128 + wc * 32 + 8 * fq;
#pragma unroll
        for (int ai = 0; ai < 2; ++ai)
#pragma unroll
            for (int m = 0; m < 4; ++m) { const int rl = ai * 128 + wr * 64 + m * 16 + fr;
                if (rl < u.nrows) { const int grow = u.row0 + rl; const float rs = rstd3[row_tok[grow] & 16383];
                    f32x4 h[2];
#pragma unroll
                    for (int n = 0; n < 2; ++n) { const f32x4 g = acc[ai][0][m][n] * rs, up = acc[ai][1][m][n] * rs;
#pragma unroll
                        for (int i = 0; i < 4; ++i) h[n][i] = siluf_(g[i]) * up[i]; }
                    *(u32x4*)(H + (size_t)grow * D_FFE + hcol0) = pack8(h[0], h[1]); } }
    }
};
struct EpiMoEDown {
    static constexpr bool PERM = true;
    float* out; const int* row_tok; const float* row_gate;
    __device__ __forceinline__ void operator()(const f32x4 (&acc)[2][2][4][2], const pg8::Unit& u, int wr, int wc, int fr, int fq) const {
        const int col0 = u.pn * 256 + wc * 32 + 8 * fq;
#pragma unroll
        for (int ai = 0; ai < 2; ++ai)
#pragma unroll
            for (int m = 0; m < 4; ++m) { const int rl = ai * 128 + wr * 64 + m * 16 + fr;
                if (rl < u.nrows) { const int grow = u.row0 + rl; const int tok = row_tok[grow] & 16383; const float gt = row_gate[grow]; float* op = out + (size_t)tok * 1024 + col0;
#pragma unroll
                    for (int bj = 0; bj < 2; ++bj) { f32x4 b0 = *(const f32x4*)(op + bj * 128), b1 = *(const f32x4*)(op + bj * 128 + 4);
                        b0 += acc[ai][bj][m][0] * gt; b1 += acc[ai][bj][m][1] * gt; *(f32x4*)(op + bj * 128) = b0; *(f32x4*)(op + bj * 128 + 4) = b1; } } }
    }
};
struct EpiPart {
    static constexpr bool PERM = true;
    float* part;
    __device__ __forceinline__ void operator()(const f32x4 (&acc)[2][2][4][2], const pg8::Unit& u, int wr, int wc, int fr, int fq) const {
        float* pb = part + (size_t)(u.flags - 1) * 65536; const unsigned o0 = (unsigned)((wr * 64 + fr) * 256 + wc * 32 + 8 * fq);
#pragma unroll
        for (int ai = 0; ai < 2; ++ai)
#pragma unroll
            for (int m = 0; m < 4; ++m)
#pragma unroll
                for (int bj = 0; bj < 2; ++bj) { float* pp = pb + o0 + (ai * 128 + m * 16) * 256 + bj * 128; *(f32x4*)pp = acc[ai][bj][m][0]; *(f32x4*)(pp + 4) = acc[ai][bj][m][1]; }
    }
};
struct EpiLowRank {
    static constexpr bool PERM = true;
    unsigned char* ws; const float* const* in;
    __device__ __forceinline__ void operator()(const f32x4 (&acc)[2][2][4][2], const pg8::Unit& u, int wr, int wc, int fr, int fq) const {
        const int kind = u.pn >> 1; const int row0 = u.pm * 256 + wr * 64 + fr; const int c0 = (u.pn & 1) * 256 + wc * 32 + 8 * fq;
        const float* zp = in[kind == 0 ? 4 : kind == 1 ? 6 : kind == 2 ? 8 : 10]; const float* k_a = in[14];
        bf16_t* o1 = (bf16_t*)(ws + (kind == 0 ? A_LWF : kind == 1 ? A_LWB : kind == 2 ? A_KDF : kind == 3 ? A_KDB : A_GG));
        bf16_t* o2 = (bf16_t*)(ws + (kind == 3 ? A_BBB : A_BBF));
        const bf16_t* KS = (const bf16_t*)(ws + A_KS); const bf16_t* NKK = (const bf16_t*)(ws + A_NKK);
#pragma unroll
        for (int bj = 0; bj < 2; ++bj)
#pragma unroll
            for (int n = 0; n < 2; ++n) { const int c = c0 + bj * 128 + 4 * n;
                if (kind < 2) { const f32x4 z = *(const f32x4*)(zp + c);
#pragma unroll
                    for (int ai = 0; ai < 2; ++ai)
#pragma unroll
                        for (int m = 0; m < 4; ++m) { const int row = row0 + ai * 128 + m * 16; f32x4 v = acc[ai][bj][m][n] + z;
#pragma unroll
                            for (int i = 0; i < 4; ++i) v[i] = -0.87506126f * sigmoidf_(v[i]);
                            u32x2 w; w.x = pk2(v[0], v[1]); w.y = pk2(v[2], v[3]); *(u32x2*)(o1 + (size_t)row * 512 + c) = w; }
                } else if (kind < 4) { const f32x4 z = *(const f32x4*)(zp + c), ka = *(const f32x4*)(k_a + c);
#pragma unroll
                    for (int ai = 0; ai < 2; ++ai)
#pragma unroll
                        for (int m = 0; m < 4; ++m) { const int row = row0 + ai * 128 + m * 16; const size_t off = (size_t)row * 512 + c;
                            const u32x2 kw = *(const u32x2*)(KS + off), nw = *(const u32x2*)(NKK + off);
                            const f32x4 av = acc[ai][bj][m][n] + z;
                            const f32x4 kv = {bflo(kw.x), bfhi(kw.x), bflo(kw.y), bfhi(kw.y)}, nv = {bflo(nw.x), bfhi(nw.x), bflo(nw.y), bfhi(nw.y)};
                            f32x4 kd, bb;
#pragma unroll
                            for (int i = 0; i < 4; ++i) { const float sg = sigmoidf_(av[i]); kd[i] = kv[i] * (1.f + (sg - 1.f) * ka[i]); bb[i] = -nv[i] * sg; }
                            u32x2 w1, w2; w1.x = pk2(kd[0], kd[1]); w1.y = pk2(kd[2], kd[3]); w2.x = pk2(bb[0], bb[1]); w2.y = pk2(bb[2], bb[3]);
                            *(u32x2*)(o1 + off) = w1; *(u32x2*)(o2 + off) = w2; }
                } else {
#pragma unroll
                    for (int ai = 0; ai < 2; ++ai)
#pragma unroll
                        for (int m = 0; m < 4; ++m) { const int row = row0 + ai * 128 + m * 16; const f32x4 v = acc[ai][bj][m][n];
                            u32x2 w; w.x = pk2(v[0], v[1]); w.y = pk2(v[2], v[3]); *(u32x2*)(o1 + (size_t)row * 512 + c) = w; }
                } }
    }
};

constexpr int NWAVES = 8;
struct Args { const float* in[38]; float* out; unsigned char* ws; int ph_lo, ph_hi; };
struct Frame {
    LAS unsigned char* lds; unsigned char* ws; const float* const* in; float* out;
    int tid, lane, wave, vcu, G;
};
template <class T> __device__ __forceinline__ T* wsp(unsigned char* ws, size_t off) { return (T*)(ws + off); }

__device__ __forceinline__ void conv_item(const float* W, int ldw, int k0, int n0, int ncols, const float* gain, bf16_t* WT, int ldk, int dst_row0, LAS float* scr, int lane) {
#pragma unroll
    for (int i = 0; i < 8; ++i) { const int kk = (lane >> 3) + 8 * i, c4 = 4 * (lane & 7);
        f32x4 v = *(const f32x4*)(W + (size_t)(k0 + kk) * ldw + n0 + c4);
        if (gain) v = v * gain[k0 + kk];
        scr[kk * 33 + c4 + 0] = v[0]; scr[kk * 33 + c4 + 1] = v[1]; scr[kk * 33 + c4 + 2] = v[2]; scr[kk * 33 + c4 + 3] = v[3]; }
    LDS_WAIT(); asm volatile("" ::: "memory");
    const int c = lane & 7;
#pragma unroll
    for (int j = 0; j < 4; ++j) { const int n = (lane >> 3) + 8 * j; const LAS float* s = scr + (8 * c) * 33 + n;
        u32x4 o; o.x = pk2(s[0 * 33], s[1 * 33]); o.y = pk2(s[2 * 33], s[3 * 33]); o.z = pk2(s[4 * 33], s[5 * 33]); o.w = pk2(s[6 * 33], s[7 * 33]);
        if (n < ncols) *(u32x4*)(WT + (size_t)(dst_row0 + n) * ldk + k0 + 8 * c) = o; }
    LDS_WAIT(); asm volatile("" ::: "memory");
}
__device__ __forceinline__ void conv_job_item(int r, const float* W, int ldw, int col0, int nblk, int ncols_last, const float* gain, bf16_t* WT, int ldk, int mode, int dst_off, LAS float* scr, int lane) {
    const int kb = r / nblk, nb = r % nblk; const int nrel = 32 * nb;
    int drow = dst_off + nrel; if (mode) drow = 256 * (nrel >> 7) + (nrel & 127) + (mode == 2 ? 128 : 0);
    conv_item(W, ldw, 64 * kb, col0 + nrel, (nb == nblk - 1) ? ncols_last : 32, gain, WT, ldk, drow, scr, lane);
}
__device__ __forceinline__ void conv_group(const Frame& F, int group, int w, int nw) {
    LAS float* scr = (LAS float*)(F.lds + F.wave * 16384);
    const int lane = F.lane; unsigned char* ws = F.ws;
    constexpr int I0 = 16 * 80, I1 = 16 * 32, I2 = 16 * 88, I3 = I2, I4 = 44 * 32, I5 = 16 * 64, I6 = 16 * 32, I7 = 16, I8 = 16 * 32;
    if (group == 0) {
        for (int r = w; r < I0; r += nw) conv_job_item(r, F.in[2], 2560, 0, 80, 32, F.in[1], wsp<bf16_t>(ws, WS_WIN0), 1024, 0, 0, scr, lane);
    } else if (group == 1) {
        for (int it = w; it < I1 + I2 + I3 + I4; it += nw) { int r = it;
            if (r < I1) { conv_job_item(r, F.in[20], 1024, 0, 32, 32, nullptr, wsp<bf16_t>(ws, WS_WOUT0), 1024, 0, 0, scr, lane); continue; } r -= I1;
            if (r < I2) { conv_job_item(r, F.in[22], 2816, 0, 88, 32, F.in[21], wsp<bf16_t>(ws, WS_WGU0), 1024, 1, 0, scr, lane); continue; } r -= I2;
            if (r < I3) { conv_job_item(r, F.in[23], 2816, 0, 88, 32, F.in[21], wsp<bf16_t>(ws, WS_WGU0), 1024, 2, 0, scr, lane); continue; } r -= I3;
            conv_job_item(r, F.in[24], 1024, 0, 32, 32, nullptr, wsp<bf16_t>(ws, WS_WD0), 2816, 0, 0, scr, lane); }
    } else {
        for (int it = w; it < I5 + I6 + I7 + I8; it += nw) { int r = it;
            if (r < I5) { conv_job_item(r, F.in[26], 3088, 0, 64, 32, F.in[25], wsp<bf16_t>(ws, WS_WIN1), 1024, 0, 0, scr, lane); continue; } r -= I5;
            if (r < I6) { conv_job_item(r, F.in[26], 3088, 2064, 32, 32, F.in[25], wsp<bf16_t>(ws, WS_WIN1), 1024, 0, 2048, scr, lane); continue; } r -= I6;
            if (r < I7) { conv_job_item(r, F.in[26], 3088, 2048, 1, 16, F.in[25], wsp<bf16_t>(ws, WS_WIN1), 1024, 0, 3072, scr, lane); continue; } r -= I7;
            conv_job_item(r, F.in[32], 1024, 0, 32, 32, nullptr, wsp<bf16_t>(ws, WS_WOUT1), 1024, 0, 0, scr, lane); }
        u32x4* z = (u32x4*)(wsp<bf16_t>(ws, WS_WIN1) + (size_t)O_IN * 1024); const int n16 = (O_INP - O_IN) * 1024 / 8;
        for (int i = w * 64 + lane; i < n16; i += nw * 64) z[i] = (u32x4){0u, 0u, 0u, 0u};
    }
}
__device__ __forceinline__ void phase_prologue(const Frame& F) {
    const int gw = F.vcu * NWAVES + F.wave, NGW = F.G * NWAVES, lane = F.lane;
    unsigned char* ws = F.ws;
    conv_group(F, 0, gw, NGW);
    if (F.G < 256) { conv_group(F, 1, gw, NGW); conv_group(F, 2, gw, NGW); }
    const int gt = F.vcu * 512 + F.tid, NGT = F.G * 512;
    { bf16_t* wlr = wsp<bf16_t>(ws, WS_WLR);
      for (int i = gt; i < 2560 * 256; i += NGT) { const int n = i >> 8, k = i & 255; float v = 0.f;
          if (n < 512)       { if (k < 64) v = F.in[5][k * 512 + n]; }
          else if (n < 1024) { if (k < 64) v = F.in[7][k * 512 + (n - 512)]; }
          else if (n < 1536) { if (k >= 64 && k < 128) v = F.in[9][(k - 64) * 512 + (n - 1024)]; }
          else if (n < 2048) { if (k >= 64 && k < 128) v = F.in[11][(k - 64) * 512 + (n - 1536)]; }
          else               { if (k >= 128) v = F.in[12][(k - 128) * 512 + (n - 2048)]; }
          wlr[i] = f2bf(v); } }
    { f32x2* rt = wsp<f32x2>(ws, WS_ROPE);
      for (int i = gt; i < SEQ * 32; i += NGT) { const int ts = i >> 5, pi = i & 31; const float freq = expf(-(float)(pi & 15) * (9.210340371976184f / 16.f));
          const float ang = ((pi >= 16) ? (float)(ts & 63) : (float)(ts >> 6)) * freq; float sn, cs; sincosf(ang, &sn, &cs); rt[i] = (f32x2){cs, sn}; } }
    { const float* x = F.in[0]; bf16_t* xb = wsp<bf16_t>(ws, WS_XB); float* ssq = wsp<float>(ws, WS_SSQ0);
      for (int m = gw; m < M_TOK; m += NGW) { const f32x4* xr = (const f32x4*)(x + (size_t)m * 1024) + lane; f32x4 v[4]; float s = 0.f;
#pragma unroll
          for (int j = 0; j < 4; ++j) { v[j] = xr[64 * j]; s += (v[j].x * v[j].x + v[j].y * v[j].y) + (v[j].z * v[j].z + v[j].w * v[j].w); }
          s = wave_sum(s);
          u32x2* o8 = (u32x2*)(xb + (size_t)m * 1024) + lane;
#pragma unroll
          for (int j = 0; j < 4; ++j) { u32x2 w; w.x = pk2(v[j].x, v[j].y); w.y = pk2(v[j].z, v[j].w); o8[64 * j] = w; }
          if (lane < 16) ssq[(size_t)m * 16 + lane] = (lane == 0) ? s : 0.f; } }
}
__device__ __forceinline__ void phase_conv_experts(const Frame& F) {
    LAS float* scr = (LAS float*)(F.lds + F.wave * 16384);
    const int gw = F.vcu * NWAVES + F.wave, NGW = F.G * NWAVES, lane = F.lane;
    constexpr int IG = 16 * 112, ID = 56 * 32, IE = 2 * IG + ID;
    bf16_t* wegu = wsp<bf16_t>(F.ws, A_WEGU); bf16_t* wed = wsp<bf16_t>(F.ws, A_WED);
    for (int it = gw; it < NEXP * IE; it += NGW) { const int e = it / IE; int r = it % IE;
        if (r < IG) { conv_job_item(r, F.in[35] + (size_t)e * 1024 * D_FFE, D_FFE, 0, 112, 32, F.in[33], wegu + (size_t)e * 2 * D_FFE * 1024, 1024, 1, 0, scr, lane); continue; } r -= IG;
        if (r < IG) { conv_job_item(r, F.in[36] + (size_t)e * 1024 * D_FFE, D_FFE, 0, 112, 32, F.in[33], wegu + (size_t)e * 2 * D_FFE * 1024, 1024, 2, 0, scr, lane); continue; } r -= IG;
        conv_job_item(r, F.in[37] + (size_t)e * D_FFE * 1024, 1024, 0, 32, 32, nullptr, wed + (size_t)e * 1024 * D_FFE, D_FFE, 0, 0, scr, lane); }
}

__device__ __forceinline__ float dpp8_sum(float v) {
    v += __builtin_bit_cast(float, __builtin_amdgcn_update_dpp(0, __builtin_bit_cast(int, v), 0xB1, 0xF, 0xF, false));
    v += __builtin_bit_cast(float, __builtin_amdgcn_update_dpp(0, __builtin_bit_cast(int, v), 0x4E, 0xF, 0xF, false));
    v += __builtin_bit_cast(float, __builtin_amdgcn_update_dpp(0, __builtin_bit_cast(int, v), 0x141, 0xF, 0xF, false));
    return v;
}
__device__ __forceinline__ void unpack8(const u32x4 w, float (&f)[8]) { f[0] = bflo(w.x); f[1] = bfhi(w.x); f[2] = bflo(w.y); f[3] = bfhi(w.y); f[4] = bflo(w.z); f[5] = bfhi(w.z); f[6] = bflo(w.w); f[7] = bfhi(w.w); }
__device__ __forceinline__ u32x4 pack8f(const float (&f)[8]) { u32x4 w; w.x = pk2(f[0], f[1]); w.y = pk2(f[2], f[3]); w.z = pk2(f[4], f[5]); w.w = pk2(f[6], f[7]); return w; }
__device__ __forceinline__ void phase_prep0(const Frame& F) {
    const int gw = F.vcu * NWAVES + F.wave, lane = F.lane;
    const bf16_t* P = wsp<bf16_t>(F.ws, A_P0);
    bf16_t *RS = wsp<bf16_t>(F.ws, A_RS), *KS = wsp<bf16_t>(F.ws, A_KS), *VS = wsp<bf16_t>(F.ws, A_VS), *NKK = wsp<bf16_t>(F.ws, A_NKK), *AP = wsp<bf16_t>(F.ws, A_AP);
    bf16_t *QH = wsp<bf16_t>(F.ws, A_QH), *KH = wsp<bf16_t>(F.ws, A_KH), *VT = wsp<bf16_t>(F.ws, A_VT0);
    const f32x2* ROPE = wsp<f32x2>(F.ws, WS_ROPE);
    float mu[4][8], kkw[8], qn8[8], kn8[8];
#pragma unroll
    for (int j = 0; j < 4; ++j)
#pragma unroll
        for (int e = 0; e < 8; ++e) { const int col = 8 * (lane + 64 * j) + e; mu[j][e] = col < RW_IN ? F.in[3][col] : 0.f; }
#pragma unroll
    for (int e = 0; e < 8; ++e) { kkw[e] = F.in[13][8 * lane + e]; qn8[e] = F.in[18][8 * (lane & 7) + e]; kn8[e] = F.in[19][8 * (lane & 7) + e]; }
    for (int g8 = gw; g8 < M_TOK / 8; g8 += F.G * NWAVES) {
        u32x4 prev[4], cur[5], nxt[4];
        { const int tok = g8 * 8; const int ts = tok & (SEQ - 1);
#pragma unroll
          for (int j = 0; j < 5; ++j) cur[j] = *(const u32x4*)(P + (size_t)tok * E_IN + 8 * (lane + 64 * j));
#pragma unroll
          for (int j = 0; j < 4; ++j) prev[j] = (ts > 0) ? *(const u32x4*)(P + (size_t)(tok - 1) * E_IN + 8 * (lane + 64 * j)) : (u32x4){0u, 0u, 0u, 0u}; }
        for (int tt = 0; tt < 8; ++tt) { const int tok = g8 * 8 + tt; const int ts = tok & (SEQ - 1); const int bb = tok >> 11;
            u32x4 ncur4 = (u32x4){0u, 0u, 0u, 0u};
#pragma unroll
            for (int j = 0; j < 4; ++j) nxt[j] = (ts < SEQ - 1) ? *(const u32x4*)(P + (size_t)(tok + 1) * E_IN + 8 * (lane + 64 * j)) : (u32x4){0u, 0u, 0u, 0u};
            if (tt < 7) ncur4 = *(const u32x4*)(P + (size_t)(tok + 1) * E_IN + 8 * (lane + 256));
            const f32x4 rp0 = *(const f32x4*)(ROPE + (size_t)ts * 32 + 4 * (lane & 7)), rp1 = *(const f32x4*)(ROPE + (size_t)ts * 32 + 4 * (lane & 7) + 2);
            const float cs4[4] = {rp0[0], rp0[2], rp1[0], rp1[2]}, sn4[4] = {rp0[1], rp0[3], rp1[1], rp1[3]};
            float s[4][8];
#pragma unroll
            for (int j = 0; j < 4; ++j) { float c[8], p[8], n[8]; unpack8(cur[j], c); unpack8(prev[j], p); unpack8(nxt[j], n);
#pragma unroll
                for (int e = 0; e < 8; ++e) s[j][e] = c[e] + (0.5f * (p[e] + n[e]) - c[e]) * mu[j][e]; }
            const size_t o512 = (size_t)tok * 512 + 8 * lane;
            *(u32x4*)(RS + o512) = pack8f(s[0]); *(u32x4*)(KS + o512) = pack8f(s[1]); *(u32x4*)(VS + o512) = pack8f(s[2]);
            { float kr[8]; float ss = 0.f;
#pragma unroll
              for (int e = 0; e < 8; ++e) { kr[e] = s[1][e] * kkw[e]; ss += kr[e] * kr[e]; }
              ss = dpp8_sum(ss); const float inv = -1.f / fmaxf(sqrtf(ss), 1e-12f);
#pragma unroll
              for (int e = 0; e < 8; ++e) kr[e] *= inv;
              *(u32x4*)(NKK + o512) = pack8f(kr); }
            float x3[8], x4[8]; unpack8(cur[3], x3); unpack8(cur[4], x4);
            { float ap[8];
#pragma unroll
              for (int e = 0; e < 8; ++e) ap[e] = lane < 8 ? tanhf(s[3][e]) : (lane < 16 ? s[3][e] : sigmoidf_(s[3][e]));
              if (lane < 32) *(u32x4*)(AP + (size_t)tok * 256 + 8 * lane) = pack8f(ap); }
#pragma unroll
            for (int which = 0; which < 2; ++which) { float (&x)[8] = which ? x4 : x3; float ss = 0.f;
#pragma unroll
                for (int e = 0; e < 8; ++e) ss += x[e] * x[e];
                ss = dpp8_sum(ss); const float rs = 1.0f / sqrtf(ss * (1.f / 64.f) + NORM_EPS);
                const bool isk = which && lane >= 32; float o[8];
#pragma unroll
                for (int p = 0; p < 4; ++p) { const float x0 = x[2 * p] * rs * (isk ? kn8[2 * p] : qn8[2 * p]), x1 = x[2 * p + 1] * rs * (isk ? kn8[2 * p + 1] : qn8[2 * p + 1]);
                    o[2 * p] = x0 * cs4[p] - x1 * sn4[p]; o[2 * p + 1] = x0 * sn4[p] + x1 * cs4[p]; }
                if (!isk) {
#pragma unroll
                    for (int e = 0; e < 8; ++e) o[e] *= 0.18033688011112042f; }
                if (which == 0) { if (lane >= 32) *(u32x4*)(QH + (size_t)tok * 512 + 8 * (lane - 32)) = pack8f(o); }
                else { if (lane < 32) *(u32x4*)(QH + (size_t)tok * 512 + 256 + 8 * lane) = pack8f(o);
                       else if (lane < 48) *(u32x4*)(KH + (size_t)tok * 128 + 8 * (lane - 32)) = pack8f(o); } }
            if (lane >= 48) { const int g = (lane - 48) >> 3, d0 = 8 * ((lane - 48) & 7); const unsigned w[4] = {cur[4].x, cur[4].y, cur[4].z, cur[4].w};
#pragma unroll
                for (int e = 0; e < 8; ++e) VT[((size_t)(bb * 2 + g) * 64 + d0 + e) * SEQ + ts] = (bf16_t)((e & 1) ? (w[e >> 1] >> 16) : (w[e >> 1] & 0xffffu)); }
#pragma unroll
            for (int j = 0; j < 4; ++j) { prev[j] = cur[j]; cur[j] = nxt[j]; }
            cur[4] = ncur4;
        }
    }
}

__device__ __forceinline__ float dpp_row_sum(float v) {
    v += __builtin_bit_cast(float, __builtin_amdgcn_update_dpp(0, __builtin_bit_cast(int, v), 0xB1, 0xF, 0xF, false));
    v += __builtin_bit_cast(float, __builtin_amdgcn_update_dpp(0, __builtin_bit_cast(int, v), 0x4E, 0xF, 0xF, false));
    v += __builtin_bit_cast(float, __builtin_amdgcn_update_dpp(0, __builtin_bit_cast(int, v), 0x141, 0xF, 0xF, false));
    v += __builtin_bit_cast(float, __builtin_amdgcn_update_dpp(0, __builtin_bit_cast(int, v), 0x140, 0xF, 0xF, false));
    return v;
}
constexpr int SC_STEPS = 32, SC_STRIDE = 352, SC_BUF = SC_STEPS * SC_STRIDE;
__device__ __forceinline__ float dpp_row8_sum(float v) {
    v += __builtin_bit_cast(float, __builtin_amdgcn_update_dpp(0, __builtin_bit_cast(int, v), 0xB1, 0xF, 0xF, false));
    v += __builtin_bit_cast(float, __builtin_amdgcn_update_dpp(0, __builtin_bit_cast(int, v), 0x4E, 0xF, 0xF, false));
    v += __builtin_bit_cast(float, __builtin_amdgcn_update_dpp(0, __builtin_bit_cast(int, v), 0x141, 0xF, 0xF, false));
    return v;
}
struct ScOps { f32x2 w[4], kd[4], a[4], b[4], r[4]; float v; };
__device__ __forceinline__ void sc_ld(ScOps& o, const LAS float* bs, const LAS float* vp) {
#pragma unroll
    for (int i = 0; i < 2; ++i) {
        const f32x4 w4 = *(const LAS f32x4*)(bs + 4 * i), k4 = *(const LAS f32x4*)(bs + 64 + 4 * i), a4 = *(const LAS f32x4*)(bs + 128 + 4 * i), b4 = *(const LAS f32x4*)(bs + 192 + 4 * i), r4 = *(const LAS f32x4*)(bs + 256 + 4 * i);
        o.w[2 * i] = (f32x2){w4[0], w4[1]}; o.w[2 * i + 1] = (f32x2){w4[2], w4[3]}; o.kd[2 * i] = (f32x2){k4[0], k4[1]}; o.kd[2 * i + 1] = (f32x2){k4[2], k4[3]};
        o.a[2 * i] = (f32x2){a4[0], a4[1]}; o.a[2 * i + 1] = (f32x2){a4[2], a4[3]}; o.b[2 * i] = (f32x2){b4[0], b4[1]}; o.b[2 * i + 1] = (f32x2){b4[2], b4[3]};
        o.r[2 * i] = (f32x2){r4[0], r4[1]}; o.r[2 * i + 1] = (f32x2){r4[2], r4[3]}; }
    o.v = *vp;
}
template <int DIR> __device__ __forceinline__ float sc_step(f32x2 (&s)[4], const ScOps& o) {
    f32x2 u[4];
#pragma unroll
    for (int i = 0; i < 4; ++i) u[i] = o.kd[i] * o.v;
    f32x2 p = s[0] * o.a[0], q = s[1] * o.a[1];
    p = __builtin_elementwise_fma(s[2], o.a[2], p); q = __builtin_elementwise_fma(s[3], o.a[3], q); p = p + q;
    float sa = dpp_row8_sum(p[0] + p[1]);
    f32x2 yp, yq;
    if (DIR) { yp = s[0] * o.r[0]; yq = s[1] * o.r[1]; yp = __builtin_elementwise_fma(s[2], o.r[2], yp); yq = __builtin_elementwise_fma(s[3], o.r[3], yq); }
    const f32x2 sa2 = {sa, sa};
#pragma unroll
    for (int i = 0; i < 4; ++i) { const f32x2 t = __builtin_elementwise_fma(o.b[i], sa2, u[i]); s[i] = __builtin_elementwise_fma(s[i], o.w[i], t); }
    if (!DIR) { yp = s[0] * o.r[0]; yq = s[1] * o.r[1]; yp = __builtin_elementwise_fma(s[2], o.r[2], yp); yq = __builtin_elementwise_fma(s[3], o.r[3], yq); }
    yp = yp + yq;
    return dpp_row8_sum(yp[0] + yp[1]);
}
__device__ __forceinline__ void attn_tile_step(const LAS unsigned char* kb, const LAS unsigned char* vb, const bf16x8 (&q)[4], f32x16& o0, f32x16& o1, float& mrun, float& lrun, int r32, int hi) {
    f32x16 c0 = {}, c1 = {};
#pragma unroll
    for (int s4 = 0; s4 < 4; ++s4) { const int chk = 2 * s4 + hi;
        const bf16x8 k0 = *(const LAS bf16x8*)(kb + r32 * 128 + ((chk ^ (r32 & 7)) * 16));
        const bf16x8 k1 = *(const LAS bf16x8*)(kb + (32 + r32) * 128 + ((chk ^ (r32 & 7)) * 16));
        c0 = __builtin_amdgcn_mfma_f32_32x32x16_bf16(k0, q[s4], c0, 0, 0, 0);
        c1 = __builtin_amdgcn_mfma_f32_32x32x16_bf16(k1, q[s4], c1, 0, 0, 0); }
    float mx = c0[0];
#pragma unroll
    for (int r = 0; r < 16; ++r) { mx = fmaxf(mx, c0[r]); mx = fmaxf(mx, c1[r]); }
    mx = fmaxf(mx, __shfl_xor(mx, 32));
    const float mnew = fmaxf(mrun, mx); const float alpha = __builtin_amdgcn_exp2f(mrun - mnew); mrun = mnew;
    float ls = 0.f;
#pragma unroll
    for (int r = 0; r < 16; ++r) { c0[r] = __builtin_amdgcn_exp2f(c0[r] - mnew); c1[r] = __builtin_amdgcn_exp2f(c1[r] - mnew); ls += c0[r] + c1[r]; }
    lrun = lrun * alpha + ls;
#pragma unroll
    for (int r = 0; r < 16; ++r) { o0[r] *= alpha; o1[r] *= alpha; }
    u32x4 w00, w01, w10, w11;
    w00.x = pk2(c0[0], c0[1]); w00.y = pk2(c0[2], c0[3]); w00.z = pk2(c0[4], c0[5]); w00.w = pk2(c0[6], c0[7]);
    w01.x = pk2(c0[8], c0[9]); w01.y = pk2(c0[10], c0[11]); w01.z = pk2(c0[12], c0[13]); w01.w = pk2(c0[14], c0[15]);
    w10.x = pk2(c1[0], c1[1]); w10.y = pk2(c1[2], c1[3]); w10.z = pk2(c1[4], c1[5]); w10.w = pk2(c1[6], c1[7]);
    w11.x = pk2(c1[8], c1[9]); w11.y = pk2(c1[10], c1[11]); w11.z = pk2(c1[12], c1[13]); w11.w = pk2(c1[14], c1[15]);
    const bf16x8 p00 = __builtin_bit_cast(bf16x8, w00), p01 = __builtin_bit_cast(bf16x8, w01), p10 = __builtin_bit_cast(bf16x8, w10), p11 = __builtin_bit_cast(bf16x8, w11);
#define AT_VF(dd_, chk_) ({ const int sw_ = ((dd_) >> 1) & 7; const u32x2 lo_ = *(const LAS u32x2*)(vb + (dd_) * 128 + (((chk_) ^ sw_) * 16) + hi * 8); \
        const u32x2 hh_ = *(const LAS u32x2*)(vb + (dd_) * 128 + ((((chk_) + 1) ^ sw_) * 16) + hi * 8); const u32x4 vv_ = {lo_.x, lo_.y, hh_.x, hh_.y}; __builtin_bit_cast(bf16x8, vv_); })
    o0 = __builtin_amdgcn_mfma_f32_32x32x16_bf16(AT_VF(r32, 0), p00, o0, 0, 0, 0);
    o0 = __builtin_amdgcn_mfma_f32_32x32x16_bf16(AT_VF(r32, 2), p01, o0, 0, 0, 0);
    o0 = __builtin_amdgcn_mfma_f32_32x32x16_bf16(AT_VF(r32, 4), p10, o0, 0, 0, 0);
    o0 = __builtin_amdgcn_mfma_f32_32x32x16_bf16(AT_VF(r32, 6), p11, o0, 0, 0, 0);
    o1 = __builtin_amdgcn_mfma_f32_32x32x16_bf16(AT_VF(32 + r32, 0), p00, o1, 0, 0, 0);
    o1 = __builtin_amdgcn_mfma_f32_32x32x16_bf16(AT_VF(32 + r32, 2), p01, o1, 0, 0, 0);
    o1 = __builtin_amdgcn_mfma_f32_32x32x16_bf16(AT_VF(32 + r32, 4), p10, o1, 0, 0, 0);
    o1 = __builtin_amdgcn_mfma_f32_32x32x16_bf16(AT_VF(32 + r32, 6), p11, o1, 0, 0, 0);
#undef AT_VF
}
__device__ __forceinline__ void attn_store(bf16_t* op, const f32x16& o0, const f32x16& o1, float lrun) {
    const float ltot = lrun + __shfl_xor(lrun, 32); const float inv = 1.f / ltot;
#pragma unroll
    for (int q4 = 0; q4 < 4; ++q4) { u32x2 w0, w1;
        w0.x = pk2(o0[4 * q4 + 0] * inv, o0[4 * q4 + 1] * inv); w0.y = pk2(o0[4 * q4 + 2] * inv, o0[4 * q4 + 3] * inv);
        w1.x = pk2(o1[4 * q4 + 0] * inv, o1[4 * q4 + 1] * inv); w1.y = pk2(o1[4 * q4 + 2] * inv, o1[4 * q4 + 3] * inv);
        *(u32x2*)(op + 8 * q4) = w0; *(u32x2*)(op + 32 + 8 * q4) = w1; }
}
template <int DIR> __device__ __forceinline__ void scan_job(const Frame& F, int b, int h, int half, int job) {
    LAS float* buf = (LAS float*)F.lds; LAS float* ybuf = buf + 2 * SC_BUF;
    const int tid = F.tid, lane = F.lane, wave = F.wave;
    const bf16_t* s0 = wsp<bf16_t>(F.ws, DIR ? A_LWB : A_LWF); const bf16_t* s1 = wsp<bf16_t>(F.ws, DIR ? A_KDB : A_KDF); const bf16_t* s2 = wsp<bf16_t>(F.ws, A_NKK);
    const bf16_t* s3 = wsp<bf16_t>(F.ws, DIR ? A_BBB : A_BBF); const bf16_t* s4 = wsp<bf16_t>(F.ws, A_RS); const bf16_t* s5 = wsp<bf16_t>(F.ws, A_VS);
    float* Y = wsp<float>(F.ws, DIR ? A_YB : A_YF);
    constexpr int NCH = SEQ / SC_STEPS;
    const int htid = tid - 256;
#define SC_STAGE_LD(ch) do { const int step_ = ht_ >> 3, sub_ = ht_ & 7; \
        const int sq_ = (ch) * SC_STEPS + step_; const size_t to_ = (size_t)(b * SEQ + (DIR ? (SEQ - 1 - sq_) : sq_)) * 512 + h * 64 + 8 * sub_; \
        sst[0] = *(const u32x4*)(s0 + to_); sst[1] = *(const u32x4*)(s1 + to_); sst[2] = *(const u32x4*)(s2 + to_); sst[3] = *(const u32x4*)(s3 + to_); sst[4] = *(const u32x4*)(s4 + to_); \
        if (sub_ < 4) sst[5] = *(const u32x4*)(s5 + to_ + half * 32); } while (0)
#define SC_STAGE_ST(bufp) do { const int step_ = ht_ >> 3, sub_ = ht_ & 7; LAS float* d_ = (bufp) + step_ * SC_STRIDE + 8 * sub_; \
        _Pragma("unroll") for (int i_ = 0; i_ < 6; ++i_) { if (i_ < 5 || sub_ < 4) { \
            f32x4 lo_ = {bflo(sst[i_].x), bfhi(sst[i_].x), bflo(sst[i_].y), bfhi(sst[i_].y)}, hi_ = {bflo(sst[i_].z), bfhi(sst[i_].z), bflo(sst[i_].w), bfhi(sst[i_].w)}; \
            if (i_ == 0) { _Pragma("unroll") for (int e_ = 0; e_ < 4; ++e_) { lo_[e_] = __builtin_amdgcn_exp2f(lo_[e_]); hi_[e_] = __builtin_amdgcn_exp2f(hi_[e_]); } } \
            *(LAS f32x4*)(d_ + i_ * 64) = lo_; *(LAS f32x4*)(d_ + i_ * 64 + 4) = hi_; } } } while (0)
#define SC_STAGE(ch, bufp) do { SC_STAGE_LD(ch); SC_STAGE_ST(bufp); } while (0)
#define SC_FLUSH(ch) do { const LAS float* yb_ = ybuf + ((ch) & 1) * 1024; const int step_ = ht_ >> 3, c_ = ht_ & 7; const int sq_ = (ch) * SC_STEPS + step_; const int tok_ = b * SEQ + (DIR ? (SEQ - 1 - sq_) : sq_); \
        *(f32x4*)(Y + (size_t)tok_ * 512 + h * 64 + half * 32 + 4 * c_) = *(const LAS f32x4*)(yb_ + step_ * 32 + 4 * c_); } while (0)
    LAS unsigned char* alds = F.lds + 98304;
    const int hw = wave - 4;
    const bf16_t *QH = wsp<bf16_t>(F.ws, A_QH), *KH = wsp<bf16_t>(F.ws, A_KH), *VT0 = wsp<bf16_t>(F.ws, A_VT0); bf16_t* YC = wsp<bf16_t>(F.ws, A_YCAT);
    u32x4 sst[6];
    bf16x8 qfA[4], qfB[4]; f32x16 oA0 = {}, oA1 = {}, oB0 = {}, oB1 = {}; float mA = -1e30f, mB = -1e30f, lA = 0.f, lB = 0.f;
#define AT_UNIT(ch_) (2 * job + ((ch_) >> 5))
#define AT_LOAD(ch_) do { const int u_ = AT_UNIT(ch_), t_ = (ch_) & 31; const int ab_ = u_ >> 6, ag_ = (u_ >> 5) & 1; \
        _Pragma("unroll") for (int i_ = 0; i_ < 2; ++i_) { const int p_ = ht_ + 256 * i_, key_ = p_ >> 3, c_ = p_ & 7; \
            akst[i_] = *(const u32x4*)(KH + (size_t)(ab_ * SEQ + 64 * t_ + key_) * 128 + ag_ * 64 + 8 * c_); \
            avst[i_] = *(const u32x4*)(VT0 + ((size_t)(ab_ * 2 + ag_) * 64 + key_) * SEQ + 64 * t_ + 8 * c_); } } while (0)
#define AT_STORE(ch_) do { const int bo_ = ((ch_) & 1) * 8192; \
        _Pragma("unroll") for (int i_ = 0; i_ < 2; ++i_) { const int p_ = ht_ + 256 * i_, key_ = p_ >> 3, c_ = p_ & 7; \
            *(LAS u32x4*)(alds + bo_ + key_ * 128 + ((c_ ^ (key_ & 7)) * 16)) = akst[i_]; \
            *(LAS u32x4*)(alds + 16384 + bo_ + key_ * 128 + ((c_ ^ ((key_ >> 1) & 7)) * 16)) = avst[i_]; } } while (0)
#define AT_DMA(ch_) do { const int u_ = AT_UNIT(ch_), t_ = (ch_) & 31; const int ab_ = u_ >> 6, ag_ = (u_ >> 5) & 1; const int bo_ = ((ch_) & 1) * 8192; \
        _Pragma("unroll") for (int i_ = 0; i_ < 2; ++i_) { const int p_ = (hw * 2 + i_) * 64 + ln_, row_ = p_ >> 3, cp_ = p_ & 7; \
            __builtin_amdgcn_global_load_lds((const unsigned*)(KH + (size_t)(ab_ * SEQ + 64 * t_ + row_) * 128 + ag_ * 64 + 8 * (cp_ ^ (row_ & 7))), (LAS unsigned*)(alds + bo_ + (hw * 2 + i_) * 1024), 16, 0, 0); \
            __builtin_amdgcn_global_load_lds((const unsigned*)(VT0 + ((size_t)(ab_ * 2 + ag_) * 64 + row_) * SEQ + 64 * t_ + 8 * (cp_ ^ ((row_ >> 1) & 7))), (LAS unsigned*)(alds + 16384 + bo_ + (hw * 2 + i_) * 1024), 16, 0, 0); } } while (0)
    __syncthreads();
    if (wave >= 4) { int ht_ = htid; asm volatile("" : "+v"(ht_)); const int ln_ = ht_ & 63; SC_STAGE(0, buf); AT_DMA(0); asm volatile("s_waitcnt vmcnt(0)" ::: "memory"); }
    __syncthreads();
    if (wave < 4) {
        __builtin_amdgcn_s_setprio(3);
        const int row = lane >> 3, kg = lane & 7, rowl = wave * 8 + row;
        f32x2 s[4] = {(f32x2){0.f, 0.f}, (f32x2){0.f, 0.f}, (f32x2){0.f, 0.f}, (f32x2){0.f, 0.f}};
        for (int ch = 0; ch < NCH; ++ch) {
            const LAS float* bc = buf + (ch & 1) * SC_BUF + 8 * kg; const LAS float* vc = buf + (ch & 1) * SC_BUF + 320 + rowl; LAS float* yb = ybuf + (ch & 1) * 1024 + rowl;
            ScOps oa, ob; sc_ld(oa, bc, vc);
#pragma unroll 2
            for (int step = 0; step < SC_STEPS; step += 2) {
                sc_ld(ob, bc + (step + 1) * SC_STRIDE, vc + (step + 1) * SC_STRIDE);
                const float y0 = sc_step<DIR>(s, oa); yb[step * 32] = y0;
                if (step + 2 < SC_STEPS) sc_ld(oa, bc + (step + 2) * SC_STRIDE, vc + (step + 2) * SC_STRIDE);
                const float y1 = sc_step<DIR>(s, ob); yb[(step + 1) * 32] = y1; }
            __syncthreads();
        }
        __builtin_amdgcn_s_setprio(0);
    } else {
        for (int ch = 0; ch < NCH; ++ch) {
            int ht_ = htid; asm volatile("" : "+v"(ht_));
            int ln_ = lane; asm volatile("" : "+v"(ln_)); const int r32 = ln_ & 31, hi = ln_ >> 5;
            if (ch > 0) SC_FLUSH(ch - 1);
            if (ch + 1 < NCH) { AT_DMA(ch + 1); SC_STAGE_LD(ch + 1); }
            __builtin_amdgcn_sched_barrier(0);
            const int u = AT_UNIT(ch), t = ch & 31; const int ab = u >> 6, ag = (u >> 5) & 1, aqt = u & 31; const int head = 4 * ag + hw;
            const int qrowA = ab * SEQ + aqt * 64 + r32, qrowB = qrowA + 32;
            if (t == 0) {
#pragma unroll
                for (int s4 = 0; s4 < 4; ++s4) { qfA[s4] = *(const bf16x8*)(QH + (size_t)qrowA * 512 + head * 64 + 16 * s4 + 8 * hi); qfB[s4] = *(const bf16x8*)(QH + (size_t)qrowB * 512 + head * 64 + 16 * s4 + 8 * hi); }
                oA0 = f32x16{}; oA1 = f32x16{}; oB0 = f32x16{}; oB1 = f32x16{}; mA = -1e30f; mB = -1e30f; lA = 0.f; lB = 0.f; }
            { const LAS unsigned char* kb = alds + (ch & 1) * 8192; const LAS unsigned char* vb = alds + 16384 + (ch & 1) * 8192;
              __builtin_amdgcn_sched_barrier(0);
              attn_tile_step(kb, vb, qfA, oA0, oA1, mA, lA, r32, hi);
              __builtin_amdgcn_sched_barrier(0);
              if (ch + 1 < NCH) { SC_STAGE_ST(buf + ((ch + 1) & 1) * SC_BUF); }
              __builtin_amdgcn_sched_barrier(0);
              attn_tile_step(kb, vb, qfB, oB0, oB1, mB, lB, r32, hi);
              __builtin_amdgcn_sched_barrier(0); }
            if (t == 31) { attn_store(YC + (size_t)qrowA * 1024 + 512 + head * 64 + 4 * hi, oA0, oA1, lA); attn_store(YC + (size_t)qrowB * 1024 + 512 + head * 64 + 4 * hi, oB0, oB1, lB); }
            asm volatile("s_waitcnt vmcnt(0)" ::: "memory");
            __syncthreads();
        }
        { int ht_ = htid; asm volatile("" : "+v"(ht_)); SC_FLUSH(NCH - 1); }
    }
#undef AT_UNIT
#undef AT_LOAD
#undef AT_STORE
#undef SC_STAGE
#undef SC_STAGE_LD
#undef SC_STAGE_ST
#undef SC_FLUSH
}
__device__ __forceinline__ void phase_scan(const Frame& F) {
    for (int job = F.vcu; job < 256; job += F.G) {
        const int chain = job >> 1, half = job & 1, dir = chain & 1, bh = chain >> 1, b = bh >> 3, h = bh & 7;
        if (dir) scan_job<1>(F, b, h, half, job); else scan_job<0>(F, b, h, half, job);
    }
}

__device__ __forceinline__ void phase_attn(const Frame& F) {
    const int tid = F.tid, lane = F.lane, wave = F.wave, r32 = lane & 31, hi = lane >> 5;
    LAS unsigned char* lds = F.lds;
    const bf16_t *QH = wsp<bf16_t>(F.ws, A_QH), *KH = wsp<bf16_t>(F.ws, A_KH), *VT = wsp<bf16_t>(F.ws, A_VT0); bf16_t* YC = wsp<bf16_t>(F.ws, A_YCAT);
    const int skey = tid >> 3, sc = tid & 7;
    for (int u = F.vcu; u < 512; u += F.G) {
        const int b = u >> 6, g = (u >> 5) & 1, qt = u & 31;
        const int head = 4 * g + (wave >> 1); const int qrow = b * SEQ + qt * 64 + 32 * (wave & 1) + r32;
        bf16x8 qf[4];
#pragma unroll
        for (int s = 0; s < 4; ++s) qf[s] = *(const bf16x8*)(QH + (size_t)qrow * 512 + head * 64 + 16 * s + 8 * hi);
        const bf16_t* ksrc = KH + (size_t)(b * SEQ + skey) * 128 + g * 64 + 8 * sc;
        const bf16_t* vsrc = VT + ((size_t)(b * 2 + g) * 64 + skey) * SEQ + 8 * sc;
        const int kdst = skey * 128 + ((sc ^ (skey & 7)) * 16), vdst = 16384 + skey * 128 + ((sc ^ ((skey >> 1) & 7)) * 16);
        u32x4 kst = *(const u32x4*)ksrc, vst = *(const u32x4*)vsrc;
        __syncthreads();
        *(LAS u32x4*)(lds + kdst) = kst; *(LAS u32x4*)(lds + vdst) = vst;
        __syncthreads();
        f32x16 o0 = {}, o1 = {}; float mrun = -1e30f, lrun = 0.f;
        for (int t = 0; t < SEQ / 64; ++t) {
            if (t + 1 < SEQ / 64) { kst = *(const u32x4*)(ksrc + (size_t)(t + 1) * 64 * 128); vst = *(const u32x4*)(vsrc + (t + 1) * 64); }
            const int bo = (t & 1) * 8192;
            f32x16 c0 = {}, c1 = {};
#pragma unroll
            for (int s = 0; s < 4; ++s) { const int ch = 2 * s + hi;
                const bf16x8 k0 = *(const LAS bf16x8*)(lds + bo + r32 * 128 + ((ch ^ (r32 & 7)) * 16));
                const bf16x8 k1 = *(const LAS bf16x8*)(lds + bo + (32 + r32) * 128 + ((ch ^ (r32 & 7)) * 16));
                c0 = __builtin_amdgcn_mfma_f32_32x32x16_bf16(k0, qf[s], c0, 0, 0, 0);
                c1 = __builtin_amdgcn_mfma_f32_32x32x16_bf16(k1, qf[s], c1, 0, 0, 0); }
            float mx = c0[0];
#pragma unroll
            for (int r = 0; r < 16; ++r) { mx = fmaxf(mx, c0[r]); mx = fmaxf(mx, c1[r]); }
            mx = fmaxf(mx, __shfl_xor(mx, 32));
            const float mnew = fmaxf(mrun, mx); const float alpha = __builtin_amdgcn_exp2f(mrun - mnew); mrun = mnew;
            float ls = 0.f;
#pragma unroll
            for (int r = 0; r < 16; ++r) { c0[r] = __builtin_amdgcn_exp2f(c0[r] - mnew); c1[r] = __builtin_amdgcn_exp2f(c1[r] - mnew); ls += c0[r] + c1[r]; }
            lrun = lrun * alpha + ls;
#pragma unroll
            for (int r = 0; r < 16; ++r) { o0[r] *= alpha; o1[r] *= alpha; }
            bf16x8 pf[2][2];
#pragma unroll
            for (int s2 = 0; s2 < 2; ++s2) { u32x4 w0, w1;
                w0.x = pk2(c0[8 * s2 + 0], c0[8 * s2 + 1]); w0.y = pk2(c0[8 * s2 + 2], c0[8 * s2 + 3]); w0.z = pk2(c0[8 * s2 + 4], c0[8 * s2 + 5]); w0.w = pk2(c0[8 * s2 + 6], c0[8 * s2 + 7]);
                w1.x = pk2(c1[8 * s2 + 0], c1[8 * s2 + 1]); w1.y = pk2(c1[8 * s2 + 2], c1[8 * s2 + 3]); w1.z = pk2(c1[8 * s2 + 4], c1[8 * s2 + 5]); w1.w = pk2(c1[8 * s2 + 6], c1[8 * s2 + 7]);
                pf[0][s2] = __builtin_bit_cast(bf16x8, w0); pf[1][s2] = __builtin_bit_cast(bf16x8, w1); }
            const int vb = 16384 + bo;
#pragma unroll
            for (int dblk = 0; dblk < 2; ++dblk) { const int d = 32 * dblk + r32; const int sw = (d >> 1) & 7;
#pragma unroll
                for (int blk = 0; blk < 2; ++blk)
#pragma unroll
                    for (int s2 = 0; s2 < 2; ++s2) { const int ch = 4 * blk + 2 * s2;
                        const u32x2 lo = *(const LAS u32x2*)(lds + vb + d * 128 + ((ch ^ sw) * 16) + hi * 8);
                        const u32x2 hh = *(const LAS u32x2*)(lds + vb + d * 128 + (((ch + 1) ^ sw) * 16) + hi * 8);
                        const u32x4 vv = {lo.x, lo.y, hh.x, hh.y};
                        if (dblk == 0) o0 = __builtin_amdgcn_mfma_f32_32x32x16_bf16(__builtin_bit_cast(bf16x8, vv), pf[blk][s2], o0, 0, 0, 0);
                        else           o1 = __builtin_amdgcn_mfma_f32_32x32x16_bf16(__builtin_bit_cast(bf16x8, vv), pf[blk][s2], o1, 0, 0, 0); } }
            if (t + 1 < SEQ / 64) { const int nb = ((t + 1) & 1) * 8192; *(LAS u32x4*)(lds + nb + kdst) = kst; *(LAS u32x4*)(lds + nb + vdst) = vst; }
            __syncthreads();
        }
        const float ltot = lrun + __shfl_xor(lrun, 32); const float inv = 1.f / ltot;
        bf16_t* op = YC + (size_t)qrow * 1024 + 512 + head * 64 + 4 * hi;
#pragma unroll
        for (int q4 = 0; q4 < 4; ++q4) { u32x2 w0, w1;
            w0.x = pk2(o0[4 * q4 + 0] * inv, o0[4 * q4 + 1] * inv); w0.y = pk2(o0[4 * q4 + 2] * inv, o0[4 * q4 + 3] * inv);
            w1.x = pk2(o1[4 * q4 + 0] * inv, o1[4 * q4 + 1] * inv); w1.y = pk2(o1[4 * q4 + 2] * inv, o1[4 * q4 + 3] * inv);
            *(u32x2*)(op + 8 * q4) = w0; *(u32x2*)(op + 32 + 8 * q4) = w1; }
    }
}

__device__ __forceinline__ void phase_rwkv_post(const Frame& F) {
    const int gw = F.vcu * NWAVES + F.wave, lane = F.lane;
    const float *YF = wsp<float>(F.ws, A_YF), *YB = wsp<float>(F.ws, A_YB);
    const bf16_t *RS = wsp<bf16_t>(F.ws, A_RS), *VS = wsp<bf16_t>(F.ws, A_VS), *KDF = wsp<bf16_t>(F.ws, A_KDF), *GG = wsp<bf16_t>(F.ws, A_GG);
    bf16_t* YC = wsp<bf16_t>(F.ws, A_YCAT);
    const int c0 = 8 * lane;
    float gw_[8], gb_[8], rk_[8];
#pragma unroll
    for (int i = 0; i < 8; ++i) { gw_[i] = F.in[16][c0 + i]; gb_[i] = F.in[17][c0 + i]; rk_[i] = F.in[15][c0 + i]; }
    for (int tok = gw; tok < M_TOK; tok += F.G * NWAVES) { const size_t o = (size_t)tok * 512 + c0;
        const f32x4 a0 = *(const f32x4*)(YF + o), a1 = *(const f32x4*)(YF + o + 4), b0 = *(const f32x4*)(YB + o), b1 = *(const f32x4*)(YB + o + 4);
        float y[8]; float sm = 0.f;
#pragma unroll
        for (int i = 0; i < 4; ++i) { y[i] = a0[i] + b0[i]; y[4 + i] = a1[i] + b1[i]; }
#pragma unroll
        for (int i = 0; i < 8; ++i) sm += y[i];
        sm += __shfl_xor(sm, 1); sm += __shfl_xor(sm, 2); sm += __shfl_xor(sm, 4);
        const float mean = sm * (1.f / 64.f); float sv = 0.f;
#pragma unroll
        for (int i = 0; i < 8; ++i) { y[i] -= mean; sv += y[i] * y[i]; }
        sv += __shfl_xor(sv, 1); sv += __shfl_xor(sv, 2); sv += __shfl_xor(sv, 4);
        const float rstd = 1.0f / sqrtf(sv * (1.f / 64.f) + 64e-5f);
        const u32x4 rw = *(const u32x4*)(RS + o), vw = *(const u32x4*)(VS + o), kw = *(const u32x4*)(KDF + o), gw4 = *(const u32x4*)(GG + o);
        const float r8[8] = {bflo(rw.x), bfhi(rw.x), bflo(rw.y), bfhi(rw.y), bflo(rw.z), bfhi(rw.z), bflo(rw.w), bfhi(rw.w)};
        const float v8[8] = {bflo(vw.x), bfhi(vw.x), bflo(vw.y), bfhi(vw.y), bflo(vw.z), bfhi(vw.z), bflo(vw.w), bfhi(vw.w)};
        const float k8[8] = {bflo(kw.x), bfhi(kw.x), bflo(kw.y), bfhi(kw.y), bflo(kw.z), bfhi(kw.z), bflo(kw.w), bfhi(kw.w)};
        const float g8[8] = {bflo(gw4.x), bfhi(gw4.x), bflo(gw4.y), bfhi(gw4.y), bflo(gw4.z), bfhi(gw4.z), bflo(gw4.w), bfhi(gw4.w)};
        float bs = 0.f;
#pragma unroll
        for (int i = 0; i < 8; ++i) bs += r8[i] * k8[i] * rk_[i];
        bs += __shfl_xor(bs, 1); bs += __shfl_xor(bs, 2); bs += __shfl_xor(bs, 4);
        float ov[8];
#pragma unroll
        for (int i = 0; i < 8; ++i) ov[i] = ((y[i] * rstd) * gw_[i] + gb_[i] + bs * v8[i]) * g8[i];
        u32x4 w; w.x = pk2(ov[0], ov[1]); w.y = pk2(ov[2], ov[3]); w.z = pk2(ov[4], ov[5]); w.w = pk2(ov[6], ov[7]);
        *(u32x4*)(YC + (size_t)tok * 1024 + c0) = w; }
}

constexpr float GLA_QSCALE = 0.08838834764831845f;
__device__ __forceinline__ size_t gla_dir(size_t base, int dir) { return base + (size_t)dir * GLA_DIR_STRIDE; }
__device__ __forceinline__ float logsig16(float z) { return (fminf(z, 0.f) - __logf(1.f + __expf(-fabsf(z)))) * (1.f / 16.f); }
__device__ __forceinline__ void phase_gla_prep(const Frame& F) {
    const int tid = F.tid, lane = F.lane, wave = F.wave, fr = lane & 15, fq = lane >> 4;
    LAS float* GD = (LAS float*)F.lds;
    LAS float* PT = (LAS float*)(F.lds + 4096);
    LAS unsigned char* QTt = F.lds + 10240;
    LAS unsigned char* KTt = F.lds + 10240 + 17408;
    LAS unsigned char* RV = F.lds + 10240;
    LAS unsigned char* RQ = F.lds + 45056; LAS unsigned char* RK = F.lds + 45056 + 16384;
    LAS unsigned char* ATT = F.lds + 45056;
    LAS unsigned char* QHl = F.lds + 45056 + 9216;
    LAS unsigned char* VTt = F.lds + 77824;
    const bf16_t* P1 = wsp<bf16_t>(F.ws, A_P1);
    bf16_t* VT = wsp<bf16_t>(F.ws, A_VT1); float* DECS = wsp<float>(F.ws, WS_DECS); bf16_t* OF = wsp<bf16_t>(F.ws, A_OF);
    const int d = tid & 127, qr = tid >> 7;
    for (int unit = F.vcu; unit < BATCH * GLA_H * 32; unit += F.G) {
        const int n = unit & 31, h = (unit >> 5) & 3, b = unit >> 7; const int T0 = b * SEQ + 64 * n; const size_t tile = (size_t)(b * 4 + h) * 32 + n;
        __syncthreads();
        for (int i = tid; i < 1024; i += 512) GD[i] = bf2f(P1[(size_t)(T0 + (i >> 4)) * O_INP + 3072 + (i & 15)]);
#pragma unroll
        for (int i = 0; i < 2; ++i) { const int p = tid + 512 * i, row = p >> 4, c = p & 15; const bf16_t* src = P1 + (size_t)(T0 + row) * O_INP + h * 128 + 8 * c;
            *(LAS u32x4*)(RQ + row * 256 + c * 16) = *(const u32x4*)src; *(LAS u32x4*)(RK + row * 256 + c * 16) = *(const u32x4*)(src + 512); }
#pragma unroll
        for (int i = 0; i < 4; ++i) { const int p = tid + 512 * i, row = p >> 5, c = p & 31;
            *(LAS u32x4*)(RV + row * 512 + c * 16) = *(const u32x4*)(P1 + (size_t)(T0 + row) * O_INP + 1024 + h * 256 + 8 * c); }
        float upf[16], upb[16];
#pragma unroll
        for (int r = 0; r < 16; ++r) { upf[r] = F.in[27][r * 512 + h * 128 + d]; upb[r] = F.in[29][r * 512 + h * 128 + d]; }
        const float bif = F.in[28][h * 128 + d], bib = F.in[30][h * 128 + d];
        __syncthreads();
        bf16_t qraw[16], kraw[16];
#pragma unroll
        for (int j = 0; j < 16; ++j) { qraw[j] = *(const LAS bf16_t*)(RQ + (16 * qr + j) * 256 + d * 2); kraw[j] = *(const LAS bf16_t*)(RK + (16 * qr + j) * 256 + d * 2); }
        { const int dv = tid & 255, th = tid >> 8; unsigned pk[16];
#pragma unroll
          for (int j = 0; j < 16; ++j) pk[j] = (unsigned)*(const LAS bf16_t*)(RV + (32 * th + 2 * j) * 512 + dv * 2) | ((unsigned)*(const LAS bf16_t*)(RV + (32 * th + 2 * j + 1) * 512 + dv * 2) << 16);
          bf16_t* gdst = VT + tile * 16384 + dv * 64 + 32 * th;
#pragma unroll
          for (int q = 0; q < 4; ++q) { const u32x4 w = {pk[4 * q], pk[4 * q + 1], pk[4 * q + 2], pk[4 * q + 3]}; *(u32x4*)(gdst + 8 * q) = w; *(LAS u32x4*)(VTt + dv * 144 + (32 * th + 8 * q) * 2) = w; } }
        float Bf[16], Bb[16];
#pragma unroll
        for (int j = 0; j < 16; ++j) { const LAS f32x4* gp = (const LAS f32x4*)(GD + (16 * qr + j) * 16); float zf = bif, zb = bib;
#pragma unroll
            for (int q = 0; q < 4; ++q) { const f32x4 g4 = gp[q];
#pragma unroll
                for (int e = 0; e < 4; ++e) { zf += g4[e] * upf[4 * q + e]; zb += g4[e] * upb[4 * q + e]; } }
            Bf[j] = logsig16(zf); Bb[j] = logsig16(zb); }
#pragma unroll
        for (int j = 1; j < 16; ++j) Bf[j] += Bf[j - 1];
#pragma unroll
        for (int j = 14; j >= 0; --j) Bb[j] += Bb[j + 1];
        PT[(0 * 4 + qr) * 128 + d] = Bf[15]; PT[(1 * 4 + qr) * 128 + d] = Bb[0];
        if (qr == 2) PT[1024 + d] = Bf[0];
        if (qr == 1) PT[1024 + 128 + d] = Bb[15];
        __syncthreads();
        float offf = 0.f, offb = 0.f, totf = 0.f, totb = 0.f, pre2f = 0.f, suf2b = 0.f;
#pragma unroll
        for (int q = 0; q < 4; ++q) { const float pf = PT[q * 128 + d], pb = PT[(4 + q) * 128 + d]; totf += pf; totb += pb; if (q < qr) offf += pf; if (q > qr) offb += pb; if (q < 2) pre2f += pf; if (q >= 2) suf2b += pb; }
        const float bmf = pre2f + PT[1024 + d], bmb = suf2b + PT[1024 + 128 + d];
#pragma unroll
        for (int j = 0; j < 16; ++j) { Bf[j] += offf; Bb[j] += offb; }
        f32x4 oacc[2][4];
#pragma unroll
        for (int x = 0; x < 2; ++x)
#pragma unroll
            for (int y = 0; y < 4; ++y) oacc[x][y] = (f32x4){0.f, 0.f, 0.f, 0.f};
#pragma unroll
        for (int dir = 0; dir < 2; ++dir) {
            const float bm = dir ? bmb : bmf, bl = dir ? totb : totf; const float ebm = __expf(bm), ebl = __expf(bl - bm);
            bf16_t* QHT = wsp<bf16_t>(F.ws, gla_dir(A_QHAT, dir)) + tile * 8192; bf16_t* K2T = wsp<bf16_t>(F.ws, gla_dir(A_K2T, dir)) + tile * 8192;
            unsigned k2pk[8];
#pragma unroll
            for (int j = 0; j < 16; ++j) { const float bv = dir ? Bb[j] : Bf[j]; const float e1 = __expf(bv - bm), r1 = __builtin_amdgcn_rcpf(e1);
                const float qs = bf2f(qraw[j]) * GLA_QSCALE, kk = bf2f(kraw[j]); const int tk = 16 * qr + j;
                const float qt = qs * e1, kt = kk * r1, qh = qt * ebm, k2 = kt * ebl;
                *(LAS bf16_t*)(QTt + tk * 272 + d * 2) = f2bf(qt); *(LAS bf16_t*)(KTt + tk * 272 + d * 2) = f2bf(kt); *(LAS bf16_t*)(QHl + tk * 272 + d * 2) = f2bf(qh);
                if (j & 1) k2pk[j >> 1] |= ((unsigned)f2bf(k2)) << 16; else k2pk[j >> 1] = (unsigned)f2bf(k2); }
            { bf16_t* kd = K2T + d * 64 + 16 * qr;
              *(u32x4*)kd = (u32x4){k2pk[0], k2pk[1], k2pk[2], k2pk[3]}; *(u32x4*)(kd + 8) = (u32x4){k2pk[4], k2pk[5], k2pk[6], k2pk[7]}; }
            if (qr == 0) DECS[((size_t)((b * 4 + h) * 2 + dir) * 32 + n) * 128 + d] = __expf(bl);
            __syncthreads();
#pragma unroll
            for (int i = 0; i < 2; ++i) { const int p = tid + 512 * i, row = p >> 4, c = p & 15; *(u32x4*)(QHT + row * 128 + c * 8) = *(const LAS u32x4*)(QHl + row * 272 + c * 16); }
            { const int ib = wave >> 1, jb0 = 2 * (wave & 1); f32x4 at[2] = {(f32x4){0.f, 0.f, 0.f, 0.f}, (f32x4){0.f, 0.f, 0.f, 0.f}};
#pragma unroll
              for (int s2 = 0; s2 < 4; ++s2) { const bf16x8 a = *(const LAS bf16x8*)(QTt + (16 * ib + fr) * 272 + (32 * s2 + 8 * fq) * 2);
#pragma unroll
                  for (int jj = 0; jj < 2; ++jj) { const bf16x8 bb = *(const LAS bf16x8*)(KTt + (16 * (jb0 + jj) + fr) * 272 + (32 * s2 + 8 * fq) * 2);
                      at[jj] = __builtin_amdgcn_mfma_f32_16x16x32_bf16(a, bb, at[jj], 0, 0, 0); } }
#pragma unroll
              for (int jj = 0; jj < 2; ++jj)
#pragma unroll
                  for (int r = 0; r < 4; ++r) { const int i = 16 * ib + 4 * fq + r, j = 16 * (jb0 + jj) + fr; const bool keep = dir ? (j > i) : (j <= i);
                      *(LAS bf16_t*)(ATT + i * 144 + j * 2) = f2bf(keep ? at[jj][r] : 0.f); } }
            __syncthreads();
#pragma unroll
            for (int s2 = 0; s2 < 2; ++s2) { bf16x8 bfr[4];
#pragma unroll
                for (int ib = 0; ib < 4; ++ib) bfr[ib] = *(const LAS bf16x8*)(ATT + (16 * ib + fr) * 144 + (32 * s2 + 8 * fq) * 2);
#pragma unroll
                for (int x = 0; x < 2; ++x) { const bf16x8 a = *(const LAS bf16x8*)(VTt + (16 * (2 * wave + x) + fr) * 144 + (32 * s2 + 8 * fq) * 2);
#pragma unroll
                    for (int ib = 0; ib < 4; ++ib) oacc[x][ib] = __builtin_amdgcn_mfma_f32_16x16x32_bf16(a, bfr[ib], oacc[x][ib], 0, 0, 0); } }
        }
#pragma unroll
        for (int x = 0; x < 2; ++x)
#pragma unroll
            for (int ib = 0; ib < 4; ++ib) { u32x2 w; w.x = pk2(oacc[x][ib][0], oacc[x][ib][1]); w.y = pk2(oacc[x][ib][2], oacc[x][ib][3]);
                *(u32x2*)(OF + (size_t)(T0 + 16 * ib + fr) * 1024 + h * 256 + 16 * (2 * wave + x) + 4 * fq) = w; }
    }
}

template <int DIR> __device__ __forceinline__ void gla_seq_job(const Frame& F, int b, int h, int vs) {
    const int tid = F.tid, lane = F.lane, wave = F.wave, fr = lane & 15, fq = lane >> 4;
    LAS unsigned char* ST0 = F.lds; LAS unsigned char* ST1 = F.lds + 17408;
    LAS unsigned char* BUF = F.lds + 34816;
    constexpr int BQ = 0, BK2 = 17408, BVT = 17408 + 18432, BSZ = 45056;
    const bf16_t* QHT = wsp<bf16_t>(F.ws, gla_dir(A_QHAT, DIR)); const bf16_t* K2T = wsp<bf16_t>(F.ws, gla_dir(A_K2T, DIR));
    const bf16_t* VT = wsp<bf16_t>(F.ws, A_VT1); const float* DECS = wsp<float>(F.ws, WS_DECS); bf16_t* OF = wsp<bf16_t>(F.ws, A_OF); bf16_t* O = DIR ? wsp<bf16_t>(F.ws, A_OB) : OF;
    const int dvb = wave >> 1, ib0 = 2 * (wave & 1);
    const size_t tile0 = (size_t)(b * 4 + h) * 32;
    const int q0 = tid, q1 = tid + 512;
    const int dq0 = BQ + (q0 >> 4) * 272 + (q0 & 15) * 16, dq1 = BQ + (q1 >> 4) * 272 + (q1 & 15) * 16;
    const int dk0 = BK2 + (q0 >> 3) * 144 + (q0 & 7) * 16, dk1 = BK2 + (q1 >> 3) * 144 + (q1 & 7) * 16;
    const int dv0 = BVT + (q0 >> 3) * 144 + (q0 & 7) * 16;
    u32x4 sg[5]; f32x4 dec, decn; u32x2 oold[2], ooldn[2];
#define GL_LD(n_) do { const size_t t_ = tile0 + (n_); \
        sg[0] = *(const u32x4*)(QHT + t_ * 8192 + q0 * 8); sg[1] = *(const u32x4*)(QHT + t_ * 8192 + q1 * 8); \
        sg[2] = *(const u32x4*)(K2T + t_ * 8192 + q0 * 8); sg[3] = *(const u32x4*)(K2T + t_ * 8192 + q1 * 8); \
        sg[4] = *(const u32x4*)(VT + t_ * 16384 + vs * 4096 + q0 * 8); \
        decn = *(const f32x4*)(DECS + ((size_t)((b * 4 + h) * 2 + DIR) * 32 + (n_)) * 128 + 16 * wave + 4 * fq); \
        if (!DIR) { _Pragma("unroll") for (int ii = 0; ii < 2; ++ii) ooldn[ii] = *(const u32x2*)(OF + (size_t)(b * SEQ + 64 * (n_) + 16 * (ib0 + ii) + fr) * 1024 + h * 256 + 64 * vs + 16 * dvb + 4 * fq); } } while (0)
#define GL_ST(bp) do { *(LAS u32x4*)((bp) + dq0) = sg[0]; *(LAS u32x4*)((bp) + dq1) = sg[1]; *(LAS u32x4*)((bp) + dk0) = sg[2]; *(LAS u32x4*)((bp) + dk1) = sg[3]; *(LAS u32x4*)((bp) + dv0) = sg[4]; } while (0)
    __syncthreads();
    for (int i = tid; i < 17408 / 4; i += 512) ((LAS unsigned*)ST0)[i] = 0u;
    f32x4 st[4];
#pragma unroll
    for (int k = 0; k < 4; ++k) st[k] = (f32x4){0.f, 0.f, 0.f, 0.f};
    GL_LD(DIR ? 31 : 0); GL_ST(BUF); dec = decn; oold[0] = ooldn[0]; oold[1] = ooldn[1];
    __syncthreads();
    for (int cc = 0; cc < 32; ++cc) { const int n = DIR ? 31 - cc : cc, nn = DIR ? 30 - cc : cc + 1; const int T0 = b * SEQ + 64 * n;
        LAS unsigned char* STr = (cc & 1) ? ST1 : ST0; LAS unsigned char* STw = (cc & 1) ? ST0 : ST1;
        LAS unsigned char* bc = BUF + (cc & 1) * BSZ; LAS unsigned char* bn = BUF + ((cc + 1) & 1) * BSZ;
        if (cc + 1 < 32) GL_LD(nn);
#pragma unroll
        for (int x = 0; x < 4; ++x) st[x] = st[x] * dec;
        f32x4 oo[2] = {(f32x4){0.f, 0.f, 0.f, 0.f}, (f32x4){0.f, 0.f, 0.f, 0.f}};
#pragma unroll
        for (int s2 = 0; s2 < 4; ++s2) { const bf16x8 a = *(const LAS bf16x8*)(STr + (16 * dvb + fr) * 272 + (32 * s2 + 8 * fq) * 2);
#pragma unroll
            for (int ii = 0; ii < 2; ++ii) { const bf16x8 qf = *(const LAS bf16x8*)(bc + BQ + (16 * (ib0 + ii) + fr) * 272 + (32 * s2 + 8 * fq) * 2);
                oo[ii] = __builtin_amdgcn_mfma_f32_16x16x32_bf16(a, qf, oo[ii], 0, 0, 0); } }
#pragma unroll
        for (int s2 = 0; s2 < 2; ++s2) { const bf16x8 kf = *(const LAS bf16x8*)(bc + BK2 + (16 * wave + fr) * 144 + (32 * s2 + 8 * fq) * 2);
#pragma unroll
            for (int x = 0; x < 4; ++x) { const bf16x8 vf = *(const LAS bf16x8*)(bc + BVT + (16 * x + fr) * 144 + (32 * s2 + 8 * fq) * 2);
                st[x] = __builtin_amdgcn_mfma_f32_16x16x32_bf16(kf, vf, st[x], 0, 0, 0); } }
#pragma unroll
        for (int x = 0; x < 4; ++x) { u32x2 w; w.x = pk2(st[x][0], st[x][1]); w.y = pk2(st[x][2], st[x][3]); *(LAS u32x2*)(STw + (16 * x + fr) * 272 + (16 * wave + 4 * fq) * 2) = w; }
#pragma unroll
        for (int ii = 0; ii < 2; ++ii) { f32x4 v = oo[ii];
            if (!DIR) { v[0] += bflo(oold[ii].x); v[1] += bfhi(oold[ii].x); v[2] += bflo(oold[ii].y); v[3] += bfhi(oold[ii].y); }
            u32x2 w; w.x = pk2(v[0], v[1]); w.y = pk2(v[2], v[3]);
            *(u32x2*)(O + (size_t)(T0 + 16 * (ib0 + ii) + fr) * 1024 + h * 256 + 64 * vs + 16 * dvb + 4 * fq) = w; }
        if (cc + 1 < 32) { GL_ST(bn); dec = decn; oold[0] = ooldn[0]; oold[1] = ooldn[1]; }
        __syncthreads(); }
#undef GL_LD
#undef GL_ST
}
__device__ __forceinline__ void phase_gla_main(const Frame& F) {
    for (int job = F.vcu; job < 256; job += F.G) { const int vs = job & 3, dir = (job >> 2) & 1, h = (job >> 3) & 3, b = job >> 5;
        if (dir) gla_seq_job<1>(F, b, h, vs); else gla_seq_job<0>(F, b, h, vs); }
}

__device__ __forceinline__ void phase_gla_post(const Frame& F) {
    const int gw = F.vcu * NWAVES + F.wave, lane = F.lane; const int c0 = 16 * lane;
    const bf16_t *OF = wsp<bf16_t>(F.ws, A_OF), *OB = wsp<bf16_t>(F.ws, A_OB), *P1 = wsp<bf16_t>(F.ws, A_P1); bf16_t* GO = wsp<bf16_t>(F.ws, A_GOUT);
    float gn[16];
#pragma unroll
    for (int i = 0; i < 16; ++i) gn[i] = F.in[31][(c0 + i) & 255];
    for (int tok = gw; tok < M_TOK; tok += F.G * NWAVES) { const size_t o = (size_t)tok * 1024 + c0;
        float v[16]; float ss = 0.f;
#pragma unroll
        for (int hh = 0; hh < 2; ++hh) { const u32x4 a = *(const u32x4*)(OF + o + 8 * hh), bq = *(const u32x4*)(OB + o + 8 * hh);
            v[8 * hh + 0] = bflo(a.x) + bflo(bq.x); v[8 * hh + 1] = bfhi(a.x) + bfhi(bq.x); v[8 * hh + 2] = bflo(a.y) + bflo(bq.y); v[8 * hh + 3] = bfhi(a.y) + bfhi(bq.y);
            v[8 * hh + 4] = bflo(a.z) + bflo(bq.z); v[8 * hh + 5] = bfhi(a.z) + bfhi(bq.z); v[8 * hh + 6] = bflo(a.w) + bflo(bq.w); v[8 * hh + 7] = bfhi(a.w) + bfhi(bq.w); }
#pragma unroll
        for (int i = 0; i < 16; ++i) ss += v[i] * v[i];
        ss = dpp_row_sum(ss);
        const float rs = 1.0f / sqrtf(ss * (1.f / 256.f) + NORM_EPS);
        float og[16];
#pragma unroll
        for (int hh = 0; hh < 2; ++hh) { const u32x4 g = *(const u32x4*)(P1 + (size_t)tok * O_INP + 2048 + c0 + 8 * hh);
            og[8 * hh + 0] = bflo(g.x); og[8 * hh + 1] = bfhi(g.x); og[8 * hh + 2] = bflo(g.y); og[8 * hh + 3] = bfhi(g.y); og[8 * hh + 4] = bflo(g.z); og[8 * hh + 5] = bfhi(g.z); og[8 * hh + 6] = bflo(g.w); og[8 * hh + 7] = bfhi(g.w); }
        float r[16];
#pragma unroll
        for (int i = 0; i < 16; ++i) r[i] = v[i] * rs * gn[i] * siluf_(og[i]);
#pragma unroll
        for (int hh = 0; hh < 2; ++hh) { u32x4 w; w.x = pk2(r[8 * hh + 0], r[8 * hh + 1]); w.y = pk2(r[8 * hh + 2], r[8 * hh + 3]); w.z = pk2(r[8 * hh + 4], r[8 * hh + 5]); w.w = pk2(r[8 * hh + 6], r[8 * hh + 7]);
            *(u32x4*)(GO + o + 8 * hh) = w; } }
}

__device__ __forceinline__ void phase_route(const Frame& F) {
    const int tid = F.tid, lane = F.lane, wave = F.wave;
    LAS int* lcnt = (LAS int*)(F.lds + MOE_OFF);
    LAS float* RL = (LAS float*)F.lds;
    __syncthreads();
    if (tid < 16) lcnt[tid] = 0;
    const float* X = F.out; const float* g2 = F.in[33]; const float* RT = F.in[34];
    for (int i = tid; i < 2048; i += 512) { const int k = i >> 1; const f32x4 r = *(const f32x4*)(RT + (size_t)i * 4); *(LAS f32x4*)(RL + i * 4) = r * g2[k]; }
    __syncthreads();
    int* TE = wsp<int>(F.ws, WS_TOKE); float* TG = wsp<float>(F.ws, WS_TOKG); float* R3 = wsp<float>(F.ws, WS_RSTD3);
    const int tpb = M_TOK / F.G, tpw = tpb / NWAVES;
    for (int i0 = 0; i0 < tpw; i0 += 4) { const int tok0 = F.vcu * tpb + wave * tpw + i0;
        float acc[4][8], ss[4];
#pragma unroll
        for (int t = 0; t < 4; ++t) { ss[t] = 0.f;
#pragma unroll
            for (int e = 0; e < 8; ++e) acc[t][e] = 0.f; }
#pragma unroll
        for (int j = 0; j < 4; ++j) { const int k0 = 4 * lane + 256 * j; f32x4 xv[4];
#pragma unroll
            for (int t = 0; t < 4; ++t) xv[t] = *(const f32x4*)(X + (size_t)(tok0 + t) * 1024 + k0);
#pragma unroll
            for (int q = 0; q < 4; ++q) { const f32x4 r0 = *(const LAS f32x4*)(RL + (k0 + q) * 8), r1 = *(const LAS f32x4*)(RL + (k0 + q) * 8 + 4);
#pragma unroll
                for (int t = 0; t < 4; ++t) { const float xx = xv[t][q]; ss[t] += xx * xx;
                    acc[t][0] += xx * r0[0]; acc[t][1] += xx * r0[1]; acc[t][2] += xx * r0[2]; acc[t][3] += xx * r0[3]; acc[t][4] += xx * r1[0]; acc[t][5] += xx * r1[1]; acc[t][6] += xx * r1[2]; acc[t][7] += xx * r1[3]; } } }
#pragma unroll
        for (int t = 0; t < 4; ++t) { ss[t] = wave_sum(ss[t]);
#pragma unroll
            for (int e = 0; e < 8; ++e) acc[t][e] = wave_sum(acc[t][e]); }
        float lg[8]; float mss = 0.f;
#pragma unroll
        for (int t = 0; t < 4; ++t) { if (lane == t) { mss = ss[t];
#pragma unroll
                for (int e = 0; e < 8; ++e) lg[e] = acc[t][e]; } }
        if (lane < 4) { const int tok = tok0 + lane;
            const float rstd = 1.0f / sqrtf(mss * (1.f / 1024.f) + NORM_EPS);
            int i1 = 0; float l1 = lg[0] * rstd;
#pragma unroll
            for (int e = 1; e < 8; ++e) { const float l = lg[e] * rstd; if (l > l1) { l1 = l; i1 = e; } }
            int i2 = -1; float l2 = -3.0e38f;
#pragma unroll
            for (int e = 0; e < 8; ++e) { const float l = lg[e] * rstd; if (e != i1 && l > l2) { l2 = l; i2 = e; } }
            const float e2 = __expf(l2 - l1); const float ga = 1.f / (1.f + e2), gb = e2 / (1.f + e2);
            TE[tok * 2] = i1; TE[tok * 2 + 1] = i2; TG[tok * 2] = ga; TG[tok * 2 + 1] = gb; R3[tok] = rstd;
            atomicAdd((int*)&lcnt[i1], 1); atomicAdd((int*)&lcnt[8 + i2], 1); } }
    __syncthreads();
    if (tid < 16) wsp<int>(F.ws, WS_CNT)[F.vcu * 16 + tid] = lcnt[tid];
}
__device__ __forceinline__ void phase_place(const Frame& F) {
    const int tid = F.tid;
    LAS int* tab = (LAS int*)(F.lds + MOE_OFF);
    LAS int* C = (LAS int*)F.lds;
    LAS int* TEl = (LAS int*)(F.lds + 32768); LAS float* TGl = (LAS float*)(F.lds + 32768 + 1024);
    const int* CNT = wsp<int>(F.ws, WS_CNT); const int tpb = M_TOK / F.G;
    __syncthreads();
    for (int i = tid; i < F.G * 16; i += 512) C[i] = CNT[i];
    if (tid < 2 * tpb) { TEl[tid] = wsp<int>(F.ws, WS_TOKE)[F.vcu * tpb * 2 + tid]; TGl[tid] = wsp<float>(F.ws, WS_TOKG)[F.vcu * tpb * 2 + tid]; }
    __syncthreads();
    if (tid < 16) { int off = 0, tot = 0; for (int bb = 0; bb < F.G; ++bb) { const int c = C[bb * 16 + tid]; if (bb < F.vcu) off += c; tot += c; } tab[tid] = off; tab[16 + tid] = tot;
        if (F.vcu == 0) wsp<int>(F.ws, WS_TOT)[tid] = tot; }
    __syncthreads();
    if (tid < 16) { const int s = tid >> 3, e = tid & 7; int run = tab[tid]; for (int q = 0; q < e; ++q) run += tab[16 + s * 8 + q];
        int* RTK = wsp<int>(F.ws, WS_ROWTOK) + s * ROWS_PER_SLOT; float* RGT = wsp<float>(F.ws, WS_ROWGATE) + s * ROWS_PER_SLOT;
        for (int i = 0; i < tpb; ++i) { if (TEl[i * 2 + s] == e) { RTK[run] = F.vcu * tpb + i; RGT[run] = TGl[i * 2 + s]; ++run; } } }
}
struct MoESched {
    pg8::GridOrder go; const LAS int* tab;
    const char* A; const char* Bt; size_t a_rowbytes, b_expert_bytes, b_tile_bytes; bool gather; int nt_;
    __device__ bool next(int i, pg8::Unit& u) const {
        int pm, pn; if (!go.tile(i, pm, pn)) return false;
        int e = 0;
#pragma unroll
        for (int q = 1; q < 8; ++q) if (pm >= tab[16 + q]) e = q;
        e = __builtin_amdgcn_readfirstlane(e);
        const int mt = pm - __builtin_amdgcn_readfirstlane(tab[16 + e]); const int row0 = __builtin_amdgcn_readfirstlane(tab[e]) + 256 * mt; int nr = __builtin_amdgcn_readfirstlane(tab[8 + e]) - 256 * mt; nr = nr > 256 ? 256 : nr;
        u.pm = pm; u.pn = pn; u.e = e; u.row0 = row0; u.nrows = nr; u.nt = nt_; u.flags = 0;
        u.a = gather ? A : A + (size_t)row0 * a_rowbytes; u.b = Bt + (size_t)e * b_expert_bytes + (size_t)pn * b_tile_bytes; return true;
    }
};
struct MoEDownSched {
    const LAS int* tab; const char* A; const char* Bt; int nmt, c, round;
    __device__ void fill(pg8::Unit& u, int pm, int pn, int kp, int nt, int flags) const {
        int e = 0;
#pragma unroll
        for (int q = 1; q < 8; ++q) if (pm >= tab[16 + q]) e = q;
        e = __builtin_amdgcn_readfirstlane(e);
        const int mt = pm - __builtin_amdgcn_readfirstlane(tab[16 + e]); const int row0 = __builtin_amdgcn_readfirstlane(tab[e]) + 256 * mt; int nr = __builtin_amdgcn_readfirstlane(tab[8 + e]) - 256 * mt; nr = nr > 256 ? 256 : nr;
        u.pm = pm; u.pn = pn; u.e = e; u.row0 = row0; u.nrows = nr; u.nt = nt; u.flags = flags;
        u.a = A + (size_t)row0 * (D_FFE * 2) + (size_t)kp * 896 * 2; u.b = Bt + (size_t)e * ((size_t)1024 * D_FFE * 2) + (size_t)pn * ((size_t)256 * D_FFE * 2) + (size_t)kp * 896 * 2;
    }
    __device__ bool next(int i, pg8::Unit& u) const {
        if (i != 0) return false;
        if (round == 0) { const int pm = 8 * (c & 7) + ((c >> 3) & 7), pn = c >> 6; if (pm >= nmt) return false; fill(u, pm, pn, 0, D_FFE / 64, 0); return true; }
        { const int t = c >> 2, kp = c & 3; const int pm = 64 + (t >> 2), pn = t & 3; if (pm >= nmt) return false; fill(u, pm, pn, kp, 14, 1 + c); return true; }
        return false;
    }
};
__device__ __forceinline__ int moe_table(const Frame& F, int s) {
    LAS int* tab = (LAS int*)(F.lds + MOE_OFF);
    __syncthreads();
    if (F.tid == 0) { const int* TOT = wsp<int>(F.ws, WS_TOT); int rs = 0, ts = 0;
        for (int e = 0; e < 8; ++e) { const int c = TOT[s * 8 + e]; tab[e] = rs; tab[8 + e] = c; tab[16 + e] = ts; rs += c; ts += (c + 255) >> 8; }
        tab[24] = ts; }
    __syncthreads();
    return __builtin_amdgcn_readfirstlane(tab[24]);
}

constexpr size_t A_PART = AR + 290 * MiB;
__device__ __forceinline__ void moe_tail_reduce(const Frame& F, int s) {
    const int nmt = moe_table(F, s); const LAS int* tab = (const LAS int*)(F.lds + MOE_OFF);
    const int R = (nmt - 64) * 4; const int gw = F.vcu * NWAVES + F.wave, lane = F.lane;
    const float* part = wsp<float>(F.ws, A_PART); const int* RTK = wsp<int>(F.ws, WS_ROWTOK) + s * ROWS_PER_SLOT; const float* RGT = wsp<float>(F.ws, WS_ROWGATE) + s * ROWS_PER_SLOT;
    for (int idx = gw; idx < R * 256; idx += F.G * NWAVES) { const int t = idx >> 8, r = idx & 255; const int pm = 64 + (t >> 2), pn = t & 3;
        int e = 0;
#pragma unroll
        for (int q = 1; q < 8; ++q) if (pm >= tab[16 + q]) e = q;
        const int mt = pm - tab[16 + e]; const int row0 = tab[e] + 256 * mt; const int nr = tab[8 + e] - 256 * mt;
        if (r < nr) { const int tok = RTK[row0 + r] & 16383; const float gt = RGT[row0 + r];
            f32x4 a = {0.f, 0.f, 0.f, 0.f};
#pragma unroll
            for (int kp = 0; kp < 4; ++kp) a += *(const f32x4*)(part + ((size_t)(t * 4 + kp) * 256 + r) * 256 + 4 * lane);
            float* op = F.out + (size_t)tok * 1024 + 256 * pn + 4 * lane; f32x4 o = *(const f32x4*)op; o += a * gt; *(f32x4*)op = o; } }
}

constexpr int N_PHASES = 21;
__global__ void __launch_bounds__(NWAVES * 64, 2) mk_fwd(Args args) {
    extern __shared__ __attribute__((aligned(16))) unsigned char lds_raw[];
    Frame F; F.lds = (LAS unsigned char*)lds_raw; F.ws = args.ws; F.in = args.in; F.out = args.out;
    F.tid = threadIdx.x; F.lane = F.tid & 63; F.wave = __builtin_amdgcn_readfirstlane(F.tid >> 6);
    F.G = gridDim.x; { const int bx = blockIdx.x; F.vcu = (F.G % 8 == 0) ? (bx % 8) * (F.G / 8) + bx / 8 : bx; }
    volatile LAS unsigned* MISC = (volatile LAS unsigned*)(F.lds + MISC_OFF);
    if (F.tid < 64) MISC[F.tid] = 0u;
    __syncthreads();
    XcdBarrier bar; bar.bar = (unsigned*)(args.ws + WS_CTL) + CW_BAR; bar.x = 0; bar.st = nullptr;
    const int lo = args.ph_lo, hi = args.ph_hi;
    const bool multi = (hi - lo) > 1;
    if (multi) bar = xcd_barrier_post((unsigned*)(args.ws + WS_CTL) + CW_BAR, MISC + 8);
#ifdef PH_ONLY
#define IN(k) ((k) == PH_ONLY && lo <= (k) && (k) < hi)
#else
#define IN(k) (lo <= (k) && (k) < hi)
#endif
#define SEAM(k) do { if (IN(k) && IN((k) + 1)) xcd_barrier(bar); } while (0)
    unsigned char* ws = args.ws; const int cid = (int)blockIdx.x;
#define REFRESH() do { int t_ = threadIdx.x; asm volatile("" : "+v"(t_)); F.tid = t_; F.lane = t_ & 63; F.wave = __builtin_amdgcn_readfirstlane(t_ >> 6); unsigned long long w_ = (unsigned long long)args.ws; asm volatile("" : "+s"(w_)); F.ws = (unsigned char*)w_; ws = F.ws; } while (0)
    LAS unsigned char* ring = F.lds;

#ifndef MK_REP_MASK
#define MK_REP_MASK 0u
#endif
#define REPS(k) ((int)(((unsigned)(MK_REP_MASK) >> (k)) & 1u))
#define PHASE(k, ...) do { if (IN(k)) { for (int rep_ = 0; rep_ <= REPS(k); ++rep_) { if (rep_) xcd_barrier(bar); REFRESH(); __VA_ARGS__ } } SEAM(k); } while (0)
    PHASE(0, phase_prologue(F););
    PHASE(1, {
        pg8::DenseSched S; S.init(wsp<bf16_t>(ws, WS_XB), wsp<bf16_t>(ws, WS_WIN0), M_TOK, E_IN, 1024, F.G, cid);
        EpiScaleBf16 E{wsp<bf16_t>(ws, A_P0), E_IN, wsp<float>(ws, WS_SSQ0)};
        pg8::gemm_phase<EpiScaleBf16, pg8::DenseSched, false>(F.tid, ring, 1024, S, E, nullptr);
        if (F.G == 256 && cid >= 128 && rep_ == 0) { REFRESH(); conv_group(F, 1, (cid - 128) * NWAVES + F.wave, 128 * NWAVES); } });
    PHASE(2, phase_prep0(F););
    PHASE(3, {
        pg8::DenseSched S; S.init(wsp<bf16_t>(ws, A_AP), wsp<bf16_t>(ws, WS_WLR), M_TOK, 2560, 256, F.G, cid);
        EpiLowRank E{ws, F.in};
        pg8::gemm_phase<EpiLowRank, pg8::DenseSched, false>(F.tid, ring, 256, S, E, nullptr); });
#ifndef MK_REP_SUB
#define MK_REP_SUB 0u
#endif
    PHASE(4, phase_scan(F););
    PHASE(5, phase_rwkv_post(F););
    PHASE(6, {
        pg8::DenseSched S; S.init(wsp<bf16_t>(ws, A_YCAT), wsp<bf16_t>(ws, WS_WOUT0), M_TOK, 1024, 1024, F.G, cid);
        EpiResid E{F.in[0], F.out, wsp<bf16_t>(ws, WS_XB), wsp<float>(ws, WS_SSQ1)};
        pg8::gemm_phase<EpiResid, pg8::DenseSched, false>(F.tid, ring, 1024, S, E, nullptr); });
    PHASE(7, {
        pg8::DenseSched S; S.init(wsp<bf16_t>(ws, WS_XB), wsp<bf16_t>(ws, WS_WGU0), M_TOK, 2 * D_FF, 1024, F.G, cid);
        EpiSwiGLU E{wsp<bf16_t>(ws, A_HID0), D_FF, wsp<float>(ws, WS_SSQ1)};
        pg8::gemm_phase<EpiSwiGLU, pg8::DenseSched, false>(F.tid, ring, 1024, S, E, nullptr);
        if (F.G == 256 && cid >= 128 && rep_ == 0) { REFRESH(); conv_group(F, 2, (cid - 128) * NWAVES + F.wave, 128 * NWAVES); } });
    PHASE(8, {
        pg8::DenseSched S; S.init(wsp<bf16_t>(ws, A_HID0), wsp<bf16_t>(ws, WS_WD0), M_TOK, 1024, D_FF, F.G, cid);
        EpiResid E{F.out, rep_ ? wsp<float>(ws, A_YF) : F.out, rep_ ? wsp<bf16_t>(ws, A_YCAT) : wsp<bf16_t>(ws, WS_XB), rep_ ? wsp<float>(ws, WS_SSQ0) : wsp<float>(ws, WS_SSQ2)};
        pg8::gemm_phase<EpiResid, pg8::DenseSched, false>(F.tid, ring, D_FF, S, E, nullptr); });
    PHASE(9, {
        pg8::DenseSched S; S.init(wsp<bf16_t>(ws, WS_XB), wsp<bf16_t>(ws, WS_WIN1), M_TOK, O_INP, 1024, F.G, cid);
        EpiScaleBf16 E{wsp<bf16_t>(ws, A_P1), O_INP, wsp<float>(ws, WS_SSQ2)};
        pg8::gemm_phase<EpiScaleBf16, pg8::DenseSched, false>(F.tid, ring, 1024, S, E, nullptr); });
    PHASE(10, phase_gla_prep(F););
    PHASE(11, phase_gla_main(F););
    PHASE(12, phase_gla_post(F););
    PHASE(13, {
        pg8::DenseSched S; S.init(wsp<bf16_t>(ws, A_GOUT), wsp<bf16_t>(ws, WS_WOUT1), M_TOK, 1024, 1024, F.G, cid);
        EpiResid E{F.out, rep_ ? wsp<float>(ws, A_OF) : F.out, rep_ ? wsp<bf16_t>(ws, A_QT) : wsp<bf16_t>(ws, WS_XB), nullptr};
        pg8::gemm_phase<EpiResid, pg8::DenseSched, false>(F.tid, ring, 1024, S, E, nullptr); });
    PHASE(14, for (int q_ = 0; q_ <= (int)(((MK_REP_SUB) >> 2) & 1u); ++q_) { phase_route(F); __syncthreads(); REFRESH(); }
              for (int q_ = 0; q_ <= (int)(((MK_REP_SUB) >> 3) & 1u); ++q_) { phase_conv_experts(F); __syncthreads(); REFRESH(); });
    PHASE(15, phase_place(F););
#pragma unroll 1
    for (int s = 0; s < 2; ++s) {
        PHASE(16 + 2 * s, {
            if (s == 1 && rep_ == 0) moe_tail_reduce(F, 0);
            const int nmt = moe_table(F, s);
            MoESched S; S.go.init(nmt, 2 * D_FFE / 256, F.G, cid); S.tab = (const LAS int*)(F.lds + MOE_OFF);
            S.A = (const char*)wsp<bf16_t>(ws, WS_XB); S.Bt = (const char*)wsp<bf16_t>(ws, A_WEGU); S.a_rowbytes = 0; S.b_expert_bytes = (size_t)2 * D_FFE * 1024 * 2; S.b_tile_bytes = (size_t)256 * 1024 * 2; S.gather = true; S.nt_ = 16;
            const int* rtk = wsp<int>(ws, WS_ROWTOK) + s * ROWS_PER_SLOT;
            EpiSwiGLUMoE E{wsp<bf16_t>(ws, A_HID1), wsp<float>(ws, WS_RSTD3), rtk};
            pg8::gemm_phase<EpiSwiGLUMoE, MoESched, true>(F.tid, ring, 1024, S, E, rtk); });
        PHASE(17 + 2 * s, {
            const int nmt = moe_table(F, s);
            MoEDownSched S; S.tab = (const LAS int*)(F.lds + MOE_OFF); S.A = (const char*)wsp<bf16_t>(ws, A_HID1); S.Bt = (const char*)wsp<bf16_t>(ws, A_WED); S.nmt = nmt; S.c = cid; S.round = 0;
            EpiMoEDown E{rep_ ? wsp<float>(ws, AR + 330 * MiB) : F.out, wsp<int>(ws, WS_ROWTOK) + s * ROWS_PER_SLOT, wsp<float>(ws, WS_ROWGATE) + s * ROWS_PER_SLOT};
            pg8::gemm_phase<EpiMoEDown, MoEDownSched, false>(F.tid, ring, D_FFE, S, E, nullptr);
            REFRESH(); S.round = 1; EpiPart EP{wsp<float>(ws, A_PART)};
            pg8::gemm_phase<EpiPart, MoEDownSched, false>(F.tid, ring, D_FFE, S, EP, nullptr); });
    }
    PHASE(20, moe_tail_reduce(F, 1););
#undef PHASE
#undef REPS
#undef IN
#undef SEAM
}

extern "C" void kernel_launch(void* const* d_in, const int* in_sizes, int n_in, void* d_out, int out_size, void* d_ws, size_t ws_size, hipStream_t stream) {
    static int grid = 0;
    if (grid == 0) {
        if (n_in != 38 || out_size != M_TOK * D_MODEL || ws_size < WS_END) { fprintf(stderr, "kernel_launch: unexpected shapes: n_in %d out %d ws %zu (need %zu)\n", n_in, out_size, ws_size, (size_t)WS_END); grid = -1; return; }
        int dev = 0, cus = 0;
        if (hipGetDevice(&dev) != hipSuccess || hipDeviceGetAttribute(&cus, hipDeviceAttributeMultiprocessorCount, dev) != hipSuccess) { grid = -1; return; }
        if (hipFuncSetAttribute((const void*)mk_fwd, hipFuncAttributeMaxDynamicSharedMemorySize, LDS_BYTES) != hipSuccess) { fprintf(stderr, "kernel_launch: hipFuncSetAttribute failed\n"); grid = -1; return; }
        (void)hipGetLastError();
        grid = cus;
        if (grid != 256) fprintf(stderr, "kernel_launch: note: %d CUs (built for 256)\n", grid);
    }
    if (grid < 0) return;
    (void)hipMemsetAsync((char*)d_ws + WS_CTL, 0, CTL_ZERO_BYTES, stream);
    Args a{};
    for (int i = 0; i < 38; ++i) a.in[i] = (const float*)d_in[i];
    a.out = (float*)d_out; a.ws = (unsigned char*)d_ws;
#if MK_N_LAUNCHES == 1
    a.ph_lo = 0; a.ph_hi = N_PHASES - 1 + 0;
    a.ph_hi = 21;
    hipLaunchKernelGGL(mk_fwd, dim3(grid), dim3(NWAVES * 64), LDS_BYTES, stream, a);
#else
#ifndef MK_LAST_PHASE
#define MK_LAST_PHASE 20
#endif
    for (int p = 0; p < MK_LAST_PHASE; ++p) { a.ph_lo = p; a.ph_hi = p + 1; hipLaunchKernelGGL(mk_fwd, dim3(grid), dim3(NWAVES * 64), LDS_BYTES, stream, a); }
#endif
}
```

```cpp
#include <hip/hip_runtime.h>
#include <cstdio>
#include <cstdint>

#ifndef MK_N_LAUNCHES
#define MK_N_LAUNCHES 1
#define MK_REP_MASK 0u
#define MK_REP_SUB 0u
#endif

#define GAS __attribute__((address_space(1)))
#define LAS __attribute__((address_space(3)))
typedef unsigned short bf16_t;
typedef short bf16x8 __attribute__((ext_vector_type(8)));
typedef short bf16x4 __attribute__((ext_vector_type(4)));
typedef float f32x4 __attribute__((ext_vector_type(4)));
typedef float f32x2 __attribute__((ext_vector_type(2)));
typedef float f32x16 __attribute__((ext_vector_type(16)));
typedef unsigned u32x4 __attribute__((ext_vector_type(4)));
typedef unsigned u32x2 __attribute__((ext_vector_type(2)));
typedef __bf16 bf16x2_t __attribute__((ext_vector_type(2)));

constexpr int D_MODEL = 1024, BATCH = 8, SEQ = 2048, M_TOK = BATCH * SEQ;
constexpr int HD = 64;
constexpr int RW_HEADS = 8, RW_DIM = 512, RW_IN = 1792;
constexpr int ATT_HEADS = 8, ATT_KV = 2;
constexpr int E_IN = 2560;
constexpr int GLA_H = 4, GLA_DK = 512, GLA_DV = 1024, GLA_DKH = 128, GLA_DVH = 256, GLA_R = 16;
constexpr int O_IN = 3088, O_INP = 3328;
constexpr int D_FF = 2816, NEXP = 8, D_FFE = 3584;
constexpr float NORM_EPS = 1e-6f;

constexpr size_t MiB = 1u << 20;
constexpr size_t WS_CTL = 0, CTL_ZERO_BYTES = 1 * MiB;
constexpr size_t WS_SSQ0 = 1 * MiB, WS_SSQ1 = 2 * MiB, WS_SSQ2 = 3 * MiB;
constexpr size_t WS_RSTD3 = 4 * MiB;
constexpr size_t WS_TOKE = WS_RSTD3 + 65536;
constexpr size_t WS_TOKG = WS_TOKE + 131072;
constexpr size_t WS_CNT = WS_TOKG + 131072;
constexpr size_t WS_TOT = WS_CNT + 16384;
constexpr size_t WS_ROWTOK = WS_TOT + 256;
constexpr int ROWS_PER_SLOT = M_TOK + 256;
constexpr size_t WS_ROWGATE = WS_ROWTOK + (size_t)2 * ROWS_PER_SLOT * 4;
constexpr size_t WS_DECS = 6 * MiB;
constexpr size_t WS_ROPE = 7 * MiB;
constexpr size_t WS_XB = 8 * MiB;
constexpr size_t WS_WIN0 = 40 * MiB, WS_WLR = 45 * MiB, WS_WOUT0 = 47 * MiB, WS_WGU0 = 49 * MiB, WS_WD0 = 60 * MiB, WS_WIN1 = 66 * MiB, WS_WOUT1 = 73 * MiB;
constexpr size_t AR = 75 * MiB;
constexpr size_t A_P0 = AR + 0, A_RS = AR + 80 * MiB, A_KS = AR + 96 * MiB, A_VS = AR + 112 * MiB, A_NKK = AR + 128 * MiB, A_AP = AR + 144 * MiB;
constexpr size_t A_QH = AR + 152 * MiB, A_KH = AR + 168 * MiB, A_VT0 = AR + 172 * MiB;
constexpr size_t A_LWF = AR + 176 * MiB, A_LWB = AR + 192 * MiB, A_KDF = AR + 208 * MiB, A_KDB = AR + 224 * MiB, A_BBF = AR + 240 * MiB, A_BBB = AR + 256 * MiB;
constexpr size_t A_GG = AR + 272 * MiB, A_YF = AR + 288 * MiB, A_YB = AR + 320 * MiB, A_YCAT = AR + 352 * MiB;
constexpr size_t A_HID0 = AR + 0;
constexpr size_t A_P1 = AR + 0;
constexpr size_t A_QT = AR + 104 * MiB, A_KT = AR + 120 * MiB, A_QHAT = AR + 136 * MiB, A_K2T = AR + 152 * MiB;
constexpr size_t GLA_DIR_STRIDE = 64 * MiB;
constexpr size_t A_VT1 = AR + 232 * MiB, A_OF = AR + 264 * MiB, A_OB = AR + 296 * MiB, A_GOUT = AR + 328 * MiB;
constexpr size_t A_WEGU = 40 * MiB, A_WED = 152 * MiB, A_HID1 = 208 * MiB;
constexpr int ROWS_ALL = 2 * M_TOK + 256;
constexpr size_t WS_END = 460 * MiB;
static_assert(A_HID1 + (size_t)ROWS_ALL * D_FFE * 2 <= WS_END && 2 * ROWS_PER_SLOT >= ROWS_ALL, "ws map");
static_assert(A_GOUT + 32 * MiB <= WS_END && A_YCAT + 32 * MiB <= WS_END, "ws map");

constexpr int CW_BAR = 4096;

constexpr int RING_BYTES = 131072;
constexpr int MISC_OFF = RING_BYTES;
constexpr int MOE_OFF = RING_BYTES + 256;
constexpr int LDS_BYTES = 147456;

__device__ __forceinline__ unsigned pk2(float lo, float hi) { f32x2 v = {lo, hi}; bf16x2_t b = __builtin_convertvector(v, bf16x2_t); return __builtin_bit_cast(unsigned, b); }
__device__ __forceinline__ bf16_t f2bf(float f) { return (bf16_t)(pk2(f, 0.f) & 0xffffu); }
__device__ __forceinline__ float bf2f(bf16_t h) { return __uint_as_float(((unsigned)h) << 16); }
__device__ __forceinline__ float bflo(unsigned w) { return __uint_as_float(w << 16); }
__device__ __forceinline__ float bfhi(unsigned w) { return __uint_as_float(w & 0xffff0000u); }
__device__ __forceinline__ float wave_sum(float v) {
#pragma unroll
    for (int o = 1; o < 64; o <<= 1) v += __shfl_xor(v, o);
    return v;
}
__device__ __forceinline__ float sigmoidf_(float x) { return 1.f / (1.f + __expf(-x)); }
__device__ __forceinline__ float siluf_(float x) { return x / (1.f + __expf(-x)); }
#define LDS_WAIT() asm volatile("s_waitcnt lgkmcnt(0)" ::: "memory")
#define VM_WAIT() asm volatile("s_waitcnt vmcnt(0)" ::: "memory")

#define XB_TMO      128
#define XB_XCNT(j)  (256  + 64 * (j))
#define XB_XSUB(j)  (1280 + 64 * (j))
#define XB_XGEN(j)  (2304 + 64 * (j))
#define XB_TOP      3328
#define XB_TOPGEN   3392
#define XCD_BAR_WORDS 3456
#define XB_SPIN_CAP (1u << 20)
__device__ __forceinline__ unsigned xb_ld(unsigned* p)              { return __hip_atomic_load(p, __ATOMIC_RELAXED, __HIP_MEMORY_SCOPE_AGENT); }
__device__ __forceinline__ unsigned xb_add(unsigned* p, unsigned v) { return __hip_atomic_fetch_add(p, v, __ATOMIC_RELAXED, __HIP_MEMORY_SCOPE_AGENT); }
__device__ __forceinline__ unsigned xb_xcc_id() { return (unsigned)__builtin_amdgcn_s_getreg((3 << 11) | 20) & 0xFu; }
#define XB_SPIN(cond, bar) do { unsigned _sp = 0; while (cond) { __builtin_amdgcn_s_sleep(1); \
    if ((++_sp & 255u) == 0u) { if (xb_ld(&(bar)[XB_TMO])) break; if (_sp > XB_SPIN_CAP) { atomicAdd(&(bar)[XB_TMO], 1u); break; } } } } while (0)
struct XcdBarrier { unsigned* bar; unsigned x; volatile LAS unsigned* st; };
__device__ __forceinline__ XcdBarrier xcd_barrier_post(unsigned* bar, volatile LAS unsigned* st) {
    XcdBarrier b; b.bar = bar; b.x = xb_xcc_id(); b.st = st;
    if (threadIdx.x == 0) (void)xb_add(&bar[XB_XCNT(b.x)], 1u);
    return b;
}
__device__ __forceinline__ void xcd_barrier_complete(unsigned* bar, unsigned x, unsigned& nloc, unsigned& nx) {
    const unsigned G = gridDim.x * gridDim.y * gridDim.z;
    unsigned sum, cnt, mine, sp = 0u;
    for (;;) {
        sum = 0u; cnt = 0u; mine = 0u;
#pragma unroll
        for (unsigned j = 0; j < 16; ++j) { const unsigned c = xb_ld(&bar[XB_XCNT(j)]); sum += c; cnt += (c > 0u) ? 1u : 0u; mine = (j == x) ? c : mine; }
        if (sum == G) break;
        __builtin_amdgcn_s_sleep(1);
        if ((++sp & 255u) == 0u) { if (xb_ld(&bar[XB_TMO])) break; if (sp > XB_SPIN_CAP) { atomicAdd(&bar[XB_TMO], 1u); break; } }
    }
    nloc = mine > 0u ? mine : 1u; nx = cnt > 0u ? cnt : 1u;
}
__device__ __forceinline__ void xcd_barrier(const XcdBarrier& b) {
    asm volatile("s_waitcnt vmcnt(0)" ::: "memory");
    __syncthreads();
    if (threadIdx.x == 0) {
        unsigned* bar = b.bar;
        __builtin_amdgcn_s_waitcnt(0);
        unsigned nloc = b.st[0], nx = b.st[1];
        if (nloc == 0u) { xcd_barrier_complete(bar, b.x, nloc, nx); b.st[0] = nloc; b.st[1] = nx; }
        const unsigned old = xb_add(&bar[XB_XSUB(b.x)], 1u);
        const unsigned gen = old / nloc;
        if (old + 1u == (gen + 1u) * nloc) {
            __builtin_amdgcn_fence(__ATOMIC_RELEASE, "agent");
            asm volatile("s_waitcnt vmcnt(0)" ::: "memory");
            const unsigned og = xb_add(&bar[XB_TOP], 1u);
            const unsigned tg = og / nx;
            if (og + 1u == (tg + 1u) * nx) xb_add(&bar[XB_TOPGEN], 1u);
            else XB_SPIN(xb_ld(&bar[XB_TOPGEN]) == tg, bar);
            __builtin_amdgcn_fence(__ATOMIC_ACQUIRE, "agent");
            xb_add(&bar[XB_XGEN(b.x)], 1u);
            asm volatile("s_waitcnt vmcnt(0)" ::: "memory");
        } else {
            XB_SPIN(xb_ld(&bar[XB_XGEN(b.x)]) == gen, bar);
            __builtin_amdgcn_fence(__ATOMIC_ACQUIRE, "agent");
            asm volatile("s_waitcnt vmcnt(0)" ::: "memory");
        }
    }
    __syncthreads();
}

namespace pg8 {
constexpr int BM = 256, BK = 64, HALF = 128, HTB = HALF * BK * 2, STAGE_BYTES = 8 * HTB, NXCD = 8, WGM = 4;
__host__ __device__ __forceinline__ int lds_byte(int r, int c) { const int st = (r >> 4) * 2 + (c >> 5), rr = r & 15, cc = c & 31, ob = rr * 64 + cc * 2; return st * 1024 + (ob ^ (((ob >> 9) & 1) << 5)); }
__host__ __device__ __forceinline__ void stage_rc(int b, int& R, int& C) { const int st = b / 1024, sb = b % 1024, swz = sb ^ (((sb >> 9) & 1) << 5); R = (st >> 1) * 16 + swz / 64; C = (st & 1) * 32 + (swz % 64) / 2; }
__host__ __device__ __forceinline__ int perm32(int rho) { const int n = rho >> 4, i = rho & 15; return 8 * (i >> 2) + 4 * n + (i & 3); }

struct Unit { const char* a; const char* b; int pm, pn; int row0, nrows, e; int nt, flags; };

struct GridOrder {
    int nM, nN, nwg, G, c;
    __device__ void init(int nM_, int nN_, int G_, int c_) { nM = nM_; nN = nN_; nwg = nM * nN; G = G_; c = c_; }
    __device__ bool tile(int i, int& pm, int& pn) const {
        const long L = (long)i * G + c; if (L >= nwg) return false;
        int wgid = (int)L; { const int q = nwg / NXCD, r = nwg % NXCD, xcd = wgid % NXCD, off = wgid / NXCD; wgid = (xcd < r ? xcd * (q + 1) : r * (q + 1) + (xcd - r) * q) + off; }
        const int nig = WGM * nN, gid = wgid / nig, fm = gid * WGM, gsz = (nM - fm) < WGM ? (nM - fm) : WGM;
        pm = fm + ((wgid % nig) % gsz); pn = (wgid % nig) / gsz; return true;
    }
};
struct DenseSched {
    GridOrder go; const char* A; const char* Bt; size_t tstep; int nt_;
    __device__ void init(const bf16_t* A_, const bf16_t* Bt_, int M, int N, int K, int G, int c) { go.init(M / BM, N / BM, G, c); A = (const char*)A_; Bt = (const char*)Bt_; tstep = (size_t)BM * K * 2; nt_ = K / BK; }
    __device__ bool next(int i, Unit& u) const { int pm, pn; if (!go.tile(i, pm, pn)) return false; u.pm = pm; u.pn = pn; u.a = A + (size_t)pm * tstep; u.b = Bt + (size_t)pn * tstep; u.row0 = pm * BM; u.nrows = BM; u.e = 0; u.nt = nt_; u.flags = 0; return true; }
};

template <class Epi, class Sched, bool GATHER>
__device__ __forceinline__ void gemm_phase(const int tid, LAS unsigned char* lds, const int K_, const Sched& S, const Epi& E, const int* gather_rows) {
    int K = K_; asm volatile("" : "+s"(K));
    const int wid = __builtin_amdgcn_readfirstlane(tid >> 6), lane = tid & 63, wr = wid >> 2, wc = wid & 3, fr = lane & 15, fq = lane >> 4;
    int sR[2], sC[2];
    unsigned voffB[2];
#pragma unroll
    for (int i = 0; i < 2; ++i) { int R, C; stage_rc(tid * 16 + i * 8192, R, C); sR[i] = R; sC[i] = C; const int Rb = Epi::PERM ? ((R & ~31) + perm32(R & 31)) : R; voffB[i] = (unsigned)(Rb * K + C) * 2u; }
    const size_t kstep = (size_t)(BK * 2);
    const size_t hstep = (size_t)HALF * K * 2;
    const unsigned ldsw = (unsigned)wid * 1024u;
    const int aoff = lds_byte(wr * 64 + fr, fq * 8), boff = lds_byte(wc * 32 + fr, fq * 8);
    unsigned cva[2][2], nva[2][2];
#define PG8_SETVA(va, u) do { _Pragma("unroll") for (int h_ = 0; h_ < 2; ++h_) _Pragma("unroll") for (int i_ = 0; i_ < 2; ++i_) { \
        if (GATHER) { int rr_ = (u).row0 + h_ * HALF + sR[i_]; const int rmax_ = (u).row0 + (u).nrows - 1; rr_ = rr_ > rmax_ ? rmax_ : rr_; int tk_ = gather_rows[rr_]; tk_ = tk_ < 0 ? 0 : (tk_ > 16383 ? 16383 : tk_); va[h_][i_] = (unsigned)(tk_ * K + sC[i_]) * 2u; } \
        else va[h_][i_] = (unsigned)((h_ * HALF + sR[i_]) * K + sC[i_]) * 2u; } } while (0)
#define PG8_SA(b, h) (((b) * 2 + (h)) * HTB)
#define PG8_SB(b, h) ((4 + (b) * 2 + (h)) * HTB)
#define PG8_STAGE2(bufoff, gbase, v0, v1) do { \
        __builtin_amdgcn_global_load_lds((const unsigned*)((const char*)(gbase) + (v0)), (LAS unsigned*)(lds + (bufoff) + ldsw), 16, 0, 0); \
        __builtin_amdgcn_global_load_lds((const unsigned*)((const char*)(gbase) + (v1)), (LAS unsigned*)(lds + (bufoff) + ldsw + 8192), 16, 0, 0); } while (0)
#define PG8_STAGEB(bufoff, gbase) PG8_STAGE2(bufoff, gbase, voffB[0], voffB[1])
#define PG8_STAGEA(bufoff, gbase, va, h) PG8_STAGE2(bufoff, gbase, va[h][0], va[h][1])
#define PG8_LDA(dst, b, h) do { _Pragma("unroll") for (int m = 0; m < 4; ++m) _Pragma("unroll") for (int k = 0; k < 2; ++k) dst[m][k] = *(const LAS bf16x8*)(lds + PG8_SA(b, h) + aoff + m * 2048 + k * 1024); } while (0)
#define PG8_LDB(dst, b, h) do { _Pragma("unroll") for (int n = 0; n < 2; ++n) _Pragma("unroll") for (int k = 0; k < 2; ++k) dst[n][k] = *(const LAS bf16x8*)(lds + PG8_SB(b, h) + boff + n * 2048 + k * 1024); } while (0)
#define PG8_MMA(ai, bj, At, Bt) do { __builtin_amdgcn_s_setprio(1); _Pragma("unroll") for (int m = 0; m < 4; ++m) _Pragma("unroll") for (int n = 0; n < 2; ++n) _Pragma("unroll") for (int k = 0; k < 2; ++k) \
        acc[ai][bj][m][n] = __builtin_amdgcn_mfma_f32_16x16x32_bf16(Bt[n][k], At[m][k], acc[ai][bj][m][n], 0, 0, 0); __builtin_amdgcn_s_setprio(0); } while (0)
#define PG8_WAIT_V(n) asm volatile("s_waitcnt vmcnt(" #n ")" ::: "memory")
#define PG8_WAIT_L(n) asm volatile("s_waitcnt lgkmcnt(" #n ")" ::: "memory")
#define PG8_BAR __builtin_amdgcn_s_barrier()
#define PG8_SCHED __builtin_amdgcn_sched_barrier(0)
    Unit cur, nxt; int ui = 0;
    if (!S.next(0, cur)) return;
    PG8_SETVA(cva, cur);
    f32x4 acc[2][2][4][2];
#pragma unroll
    for (int a = 0; a < 2; ++a)
#pragma unroll
        for (int b = 0; b < 2; ++b)
#pragma unroll
            for (int m = 0; m < 4; ++m)
#pragma unroll
                for (int n = 0; n < 2; ++n) acc[a][b][m][n] = (f32x4){0.f, 0.f, 0.f, 0.f};
    bf16x8 At[4][2], B0[2][2], B1[2][2];
    const char* cA = cur.a; const char* cB = cur.b;
    PG8_STAGEB(PG8_SB(0, 0), cB); PG8_STAGEB(PG8_SB(0, 1), cB + hstep); PG8_STAGEA(PG8_SA(0, 0), cA, cva, 0); PG8_STAGEA(PG8_SA(0, 1), cA, cva, 1);
    if (wr == 1) PG8_BAR;
    PG8_WAIT_V(2); PG8_BAR;
    PG8_STAGEB(PG8_SB(1, 0), cB + kstep); PG8_STAGEA(PG8_SA(1, 0), cA + kstep, cva, 0); PG8_STAGEB(PG8_SB(1, 1), cB + hstep + kstep);
    PG8_WAIT_V(6); PG8_BAR;
    for (;;) {
        const bool has_next = S.next(ui + 1, nxt);
        if (has_next) PG8_SETVA(nva, nxt);
        else {
#pragma unroll
            for (int h = 0; h < 2; ++h)
#pragma unroll
                for (int i = 0; i < 2; ++i) nva[h][i] = cva[h][i];
        }
        const char* nA = has_next ? nxt.a : cA; const char* nB = has_next ? nxt.b : cB;
        const int nt = cur.nt;
        for (int t = 0; t < nt; t += 2) {
            const bool last = (t == nt - 2);
            const char* a1 = cA + (size_t)(t + 1) * kstep;
            const char* a2 = last ? nA : cA + (size_t)(t + 2) * kstep; const char* b2 = last ? nB : cB + (size_t)(t + 2) * kstep;
            const char* a3 = a2 + kstep; const char* b3 = b2 + kstep;
            unsigned va2[2][2];
#pragma unroll
            for (int h = 0; h < 2; ++h)
#pragma unroll
                for (int i = 0; i < 2; ++i) va2[h][i] = (GATHER && last) ? nva[h][i] : cva[h][i];
            PG8_LDB(B0, 0, 0); PG8_LDB(B1, 0, 1); PG8_SCHED; PG8_LDA(At, 0, 0); PG8_STAGEA(PG8_SA(1, 1), a1, cva, 1);
            PG8_WAIT_V(8); PG8_WAIT_L(0); PG8_BAR; PG8_MMA(0, 0, At, B0); PG8_MMA(0, 1, At, B1); PG8_BAR; PG8_SCHED;
            PG8_LDA(At, 0, 1); PG8_STAGEB(PG8_SB(0, 0), b2); PG8_STAGEB(PG8_SB(0, 1), b2 + hstep); PG8_STAGEA(PG8_SA(0, 0), a2, va2, 0);
            PG8_WAIT_V(8); PG8_WAIT_L(0); PG8_BAR; PG8_MMA(1, 0, At, B0); PG8_MMA(1, 1, At, B1); PG8_BAR; PG8_SCHED;
            PG8_LDB(B0, 1, 0); PG8_LDB(B1, 1, 1); PG8_SCHED; PG8_LDA(At, 1, 0); PG8_STAGEA(PG8_SA(0, 1), a2, va2, 1);
            PG8_WAIT_V(8); PG8_WAIT_L(0); PG8_BAR; PG8_MMA(0, 0, At, B0); PG8_MMA(0, 1, At, B1); PG8_BAR; PG8_SCHED;
            PG8_LDA(At, 1, 1); PG8_STAGEB(PG8_SB(1, 0), b3); PG8_STAGEB(PG8_SB(1, 1), b3 + hstep); PG8_STAGEA(PG8_SA(1, 0), a3, va2, 0);
            PG8_WAIT_V(8); PG8_WAIT_L(0); PG8_BAR; PG8_MMA(1, 0, At, B0); PG8_MMA(1, 1, At, B1); PG8_BAR; PG8_SCHED;
        }
        if (wr == 0) PG8_BAR;
        E(acc, cur, wr, wc, fr, fq);
        if (!has_next) break;
#pragma unroll
        for (int a = 0; a < 2; ++a)
#pragma unroll
            for (int b = 0; b < 2; ++b)
#pragma unroll
                for (int m = 0; m < 4; ++m)
#pragma unroll
                    for (int n = 0; n < 2; ++n) acc[a][b][m][n] = (f32x4){0.f, 0.f, 0.f, 0.f};
        cur = nxt; cA = nA; cB = nB; ++ui;
#pragma unroll
        for (int h = 0; h < 2; ++h)
#pragma unroll
            for (int i = 0; i < 2; ++i) cva[h][i] = nva[h][i];
        if (wr == 1) PG8_BAR;
    }
    PG8_WAIT_V(0);
    PG8_BAR;
#undef PG8_SETVA
#undef PG8_SA
#undef PG8_SB
#undef PG8_STAGE2
#undef PG8_STAGEA
#undef PG8_STAGEB
#undef PG8_LDA
#undef PG8_LDB
#undef PG8_MMA
#undef PG8_WAIT_V
#undef PG8_WAIT_L
#undef PG8_BAR
#undef PG8_SCHED
}
}

__device__ __forceinline__ float rstd_from_ssq(const float* ssq, int row) {
    const f32x4* p = (const f32x4*)(ssq + (size_t)row * 16);
    const f32x4 a = p[0], b = p[1], c = p[2], d = p[3];
    const float s = (((a.x + a.y) + (a.z + a.w)) + ((b.x + b.y) + (b.z + b.w))) + (((c.x + c.y) + (c.z + c.w)) + ((d.x + d.y) + (d.z + d.w)));
    return 1.0f / sqrtf(s * (1.f / 1024.f) + NORM_EPS);
}
__device__ __forceinline__ u32x4 pack8(const f32x4 v0, const f32x4 v1) { u32x4 w; w.x = pk2(v0[0], v0[1]); w.y = pk2(v0[2], v0[3]); w.z = pk2(v1[0], v1[1]); w.w = pk2(v1[2], v1[3]); return w; }

struct EpiScaleBf16 {
    static constexpr bool PERM = true;
    bf16_t* O; int ldc; const float* ssq;
    __device__ __forceinline__ void operator()(const f32x4 (&acc)[2][2][4][2], const pg8::Unit& u, int wr, int wc, int fr, int fq) const {
        const int row0 = u.pm * 256 + wr * 64 + fr, col0 = u.pn * 256 + wc * 32 + 8 * fq;
#pragma unroll
        for (int ai = 0; ai < 2; ++ai)
#pragma unroll
            for (int m = 0; m < 4; ++m) { const int row = row0 + ai * 128 + m * 16; const float rs = rstd_from_ssq(ssq, row); bf16_t* rowp = O + (size_t)row * ldc + col0;
#pragma unroll
                for (int bj = 0; bj < 2; ++bj) *(u32x4*)(rowp + bj * 128) = pack8(acc[ai][bj][m][0] * rs, acc[ai][bj][m][1] * rs); }
    }
};
struct EpiResid {
    static constexpr bool PERM = true;
    const float* base; float* out; bf16_t* xb; float* ssq;
    __device__ __forceinline__ void operator()(const f32x4 (&acc)[2][2][4][2], const pg8::Unit& u, int wr, int wc, int fr, int fq) const {
        const int row0 = u.pm * 256 + wr * 64 + fr, col0 = u.pn * 256 + wc * 32 + 8 * fq;
#pragma unroll
        for (int ai = 0; ai < 2; ++ai)
#pragma unroll
            for (int m = 0; m < 4; ++m) { const int row = row0 + ai * 128 + m * 16; const size_t off = (size_t)row * 1024 + col0; float ss = 0.f;
#pragma unroll
                for (int bj = 0; bj < 2; ++bj) { const f32x4 b0 = *(const f32x4*)(base + off + bj * 128), b1 = *(const f32x4*)(base + off + bj * 128 + 4);
                    const f32x4 o0 = b0 + acc[ai][bj][m][0], o1 = b1 + acc[ai][bj][m][1];
                    *(f32x4*)(out + off + bj * 128) = o0; *(f32x4*)(out + off + bj * 128 + 4) = o1;
                    ss += (o0[0] * o0[0] + o0[1] * o0[1]) + (o0[2] * o0[2] + o0[3] * o0[3]) + (o1[0] * o1[0] + o1[1] * o1[1]) + (o1[2] * o1[2] + o1[3] * o1[3]);
                    *(u32x4*)(xb + off + bj * 128) = pack8(o0, o1); }
                ss += __shfl_xor(ss, 16); ss += __shfl_xor(ss, 32);
                if (ssq && fq == 0) ssq[(size_t)row * 16 + u.pn * 4 + wc] = ss; }
    }
};
struct EpiResidBf {
    static constexpr bool PERM = true;
    bf16_t* xb; float* out; float* ssq;
    __device__ __forceinline__ void operator()(const f32x4 (&acc)[2][2][4][2], const pg8::Unit& u, int wr, int wc, int fr, int fq) const {
        const int row0 = u.pm * 256 + wr * 64 + fr, col0 = u.pn * 256 + wc * 32 + 8 * fq;
#pragma unroll
        for (int ai = 0; ai < 2; ++ai)
#pragma unroll
            for (int m = 0; m < 4; ++m) { const int row = row0 + ai * 128 + m * 16; const size_t off = (size_t)row * 1024 + col0; float ss = 0.f;
#pragma unroll
                for (int bj = 0; bj < 2; ++bj) { const u32x4 bw = *(const u32x4*)(xb + off + bj * 128);
                    const f32x4 b0 = {bflo(bw.x), bfhi(bw.x), bflo(bw.y), bfhi(bw.y)}, b1 = {bflo(bw.z), bfhi(bw.z), bflo(bw.w), bfhi(bw.w)};
                    const f32x4 o0 = b0 + acc[ai][bj][m][0], o1 = b1 + acc[ai][bj][m][1];
                    if (out) { *(f32x4*)(out + off + bj * 128) = o0; *(f32x4*)(out + off + bj * 128 + 4) = o1; }
                    ss += (o0[0] * o0[0] + o0[1] * o0[1]) + (o0[2] * o0[2] + o0[3] * o0[3]) + (o1[0] * o1[0] + o1[1] * o1[1]) + (o1[2] * o1[2] + o1[3] * o1[3]);
                    *(u32x4*)(xb + off + bj * 128) = pack8(o0, o1); }
                ss += __shfl_xor(ss, 16); ss += __shfl_xor(ss, 32);
                if (ssq && fq == 0) ssq[(size_t)row * 16 + u.pn * 4 + wc] = ss; }
    }
};
struct EpiSwiGLU {
    static constexpr bool PERM = true;
    bf16_t* H; int ldh; const float* ssq;
    __device__ __forceinline__ void operator()(const f32x4 (&acc)[2][2][4][2], const pg8::Unit& u, int wr, int wc, int fr, int fq) const {
        const int row0 = u.pm * 256 + wr * 64 + fr, hcol0 = u.pn * 128 + wc * 32 + 8 * fq;
#pragma unroll
        for (int ai = 0; ai < 2; ++ai)
#pragma unroll
            for (int m = 0; m < 4; ++m) { const int row = row0 + ai * 128 + m * 16; const float rs = rstd_from_ssq(ssq, row);
                f32x4 h[2];
#pragma unroll
                for (int n = 0; n < 2; ++n) { const f32x4 g = acc[ai][0][m][n] * rs, up = acc[ai][1][m][n] * rs;
#pragma unroll
                    for (int i = 0; i < 4; ++i) h[n][i] = siluf_(g[i]) * up[i]; }
                *(u32x4*)(H + (size_t)row * ldh + hcol0) = pack8(h[0], h[1]); }
    }
};
struct EpiSwiGLUMoE {
    static constexpr bool PERM = true;
    bf16_t* H; const float* rstd3; const int* row_tok;
    __device__ __forceinline__ void operator()(const f32x4 (&acc)[2][2][4][2], const pg8::Unit& u, int wr, int wc, int fr, int fq) const {
        const int hcol0 = u.pn * 128 + wc * 32 + 8 * fq;
#pragma unroll
        for (int ai = 0; ai < 2; ++ai)
#pragma unroll
            for (int m = 0; m < 4; ++m) { const int rl = ai * 128 + wr * 64 + m * 16 + fr;
                if (rl < u.nrows) { const int grow = u.row0 + rl; const float rs = rstd3[row_tok[grow] & 16383];
                    f32x4 h[2];
#pragma unroll
                    for (int n = 0; n < 2; ++n) { const f32x4 g = acc[ai][0][m][n] * rs, up = acc[ai][1][m][n] * rs;
#pragma unroll
                        for (int i = 0; i < 4; ++i) h[n][i] = siluf_(g[i]) * up[i]; }
                    *(u32x4*)(H + (size_t)grow * D_FFE + hcol0) = pack8(h[0], h[1]); } }
    }
};
struct EpiMoEDown {
    static constexpr bool PERM = true;
    float* out; const int* row_tok; const float* row_gate;
    __device__ __forceinline__ void operator()(const f32x4 (&acc)[2][2][4][2], const pg8::Unit& u, int wr, int wc, int fr, int fq) const {
        const int col0 = u.pn * 256 + wc * 32 + 8 * fq;
#pragma unroll
        for (int ai = 0; ai < 2; ++ai)
#pragma unroll
            for (int m = 0; m < 4; ++m) { const int rl = ai * 128 + wr * 64 + m * 16 + fr;
                if (rl < u.nrows) { const int grow = u.row0 + rl; const int tok = row_tok[grow] & 16383; const float gt = row_gate[grow]; float* op = out + (size_t)tok * 1024 + col0;
#pragma unroll
                    for (int bj = 0; bj < 2; ++bj) { f32x4 b0 = *(const f32x4*)(op + bj * 128), b1 = *(const f32x4*)(op + bj * 128 + 4);
                        b0 += acc[ai][bj][m][0] * gt; b1 += acc[ai][bj][m][1] * gt; *(f32x4*)(op + bj * 128) = b0; *(f32x4*)(op + bj * 128 + 4) = b1; } } }
    }
};
struct EpiPart {
    static constexpr bool PERM = true;
    float* part;
    __device__ __forceinline__ void operator()(const f32x4 (&acc)[2][2][4][2], const pg8::Unit& u, int wr, int wc, int fr, int fq) const {
        float* pb = part + (size_t)(u.flags - 1) * 65536; const unsigned o0 = (unsigned)((wr * 64 + fr) * 256 + wc * 32 + 8 * fq);
#pragma unroll
        for (int ai = 0; ai < 2; ++ai)
#pragma unroll
            for (int m = 0; m < 4; ++m)
#pragma unroll
                for (int bj = 0; bj < 2; ++bj) { float* pp = pb + o0 + (ai * 128 + m * 16) * 256 + bj * 128; *(f32x4*)pp = acc[ai][bj][m][0]; *(f32x4*)(pp + 4) = acc[ai][bj][m][1]; }
    }
};
struct EpiLowRank {
    static constexpr bool PERM = true;
    unsigned char* ws; const float* const* in;
    __device__ __forceinline__ void operator()(const f32x4 (&acc)[2][2][4][2], const pg8::Unit& u, int wr, int wc, int fr, int fq) const {
        const int kind = u.pn >> 1; const int row0 = u.pm * 256 + wr * 64 + fr; const int c0 = (u.pn & 1) * 256 + wc * 32 + 8 * fq;
        const float* zp = in[kind == 0 ? 4 : kind == 1 ? 6 : kind == 2 ? 8 : 10]; const float* k_a = in[14];
        bf16_t* o1 = (bf16_t*)(ws + (kind == 0 ? A_LWF : kind == 1 ? A_LWB : kind == 2 ? A_KDF : kind == 3 ? A_KDB : A_GG));
        bf16_t* o2 = (bf16_t*)(ws + (kind == 3 ? A_BBB : A_BBF));
        const bf16_t* KS = (const bf16_t*)(ws + A_KS); const bf16_t* NKK = (const bf16_t*)(ws + A_NKK);
#pragma unroll
        for (int bj = 0; bj < 2; ++bj)
#pragma unroll
            for (int n = 0; n < 2; ++n) { const int c = c0 + bj * 128 + 4 * n;
                if (kind < 2) { const f32x4 z = *(const f32x4*)(zp + c);
#pragma unroll
                    for (int ai = 0; ai < 2; ++ai)
#pragma unroll
                        for (int m = 0; m < 4; ++m) { const int row = row0 + ai * 128 + m * 16; f32x4 v = acc[ai][bj][m][n] + z;
#pragma unroll
                            for (int i = 0; i < 4; ++i) v[i] = -0.87506126f * sigmoidf_(v[i]);
                            u32x2 w; w.x = pk2(v[0], v[1]); w.y = pk2(v[2], v[3]); *(u32x2*)(o1 + (size_t)row * 512 + c) = w; }
                } else if (kind < 4) { const f32x4 z = *(const f32x4*)(zp + c), ka = *(const f32x4*)(k_a + c);
#pragma unroll
                    for (int ai = 0; ai < 2; ++ai)
#pragma unroll
                        for (int m = 0; m < 4; ++m) { const int row = row0 + ai * 128 + m * 16; const size_t off = (size_t)row * 512 + c;
                            const u32x2 kw = *(const u32x2*)(KS + off), nw = *(const u32x2*)(NKK + off);
                            const f32x4 av = acc[ai][bj][m][n] + z;
                            const f32x4 kv = {bflo(kw.x), bfhi(kw.x), bflo(kw.y), bfhi(kw.y)}, nv = {bflo(nw.x), bfhi(nw.x), bflo(nw.y), bfhi(nw.y)};
                            f32x4 kd, bb;
#pragma unroll
                            for (int i = 0; i < 4; ++i) { const float sg = sigmoidf_(av[i]); kd[i] = kv[i] * (1.f + (sg - 1.f) * ka[i]); bb[i] = -nv[i] * sg; }
                            u32x2 w1, w2; w1.x = pk2(kd[0], kd[1]); w1.y = pk2(kd[2], kd[3]); w2.x = pk2(bb[0], bb[1]); w2.y = pk2(bb[2], bb[3]);
                            *(u32x2*)(o1 + off) = w1; *(u32x2*)(o2 + off) = w2; }
                } else {
#pragma unroll
                    for (int ai = 0; ai < 2; ++ai)
#pragma unroll
                        for (int m = 0; m < 4; ++m) { const int row = row0 + ai * 128 + m * 16; const f32x4 v = acc[ai][bj][m][n];
                            u32x2 w; w.x = pk2(v[0], v[1]); w.y = pk2(v[2], v[3]); *(u32x2*)(o1 + (size_t)row * 512 + c) = w; }
                } }
    }
};

constexpr int NWAVES = 8;
struct Args { const float* in[38]; float* out; unsigned char* ws; int ph_lo, ph_hi; };
struct Frame {
    LAS unsigned char* lds; unsigned char* ws; const float* const* in; float* out;
    int tid, lane, wave, vcu, G;
};
template <class T> __device__ __forceinline__ T* wsp(unsigned char* ws, size_t off) { return (T*)(ws + off); }

__device__ __forceinline__ void conv_item(const float* W, int ldw, int k0, int n0, int ncols, const float* gain, bf16_t* WT, int ldk, int dst_row0, LAS float* scr, int lane) {
#pragma unroll
    for (int i = 0; i < 8; ++i) { const int kk = (lane >> 3) + 8 * i, c4 = 4 * (lane & 7);
        f32x4 v = *(const f32x4*)(W + (size_t)(k0 + kk) * ldw + n0 + c4);
        if (gain) v = v * gain[k0 + kk];
        scr[kk * 33 + c4 + 0] = v[0]; scr[kk * 33 + c4 + 1] = v[1]; scr[kk * 33 + c4 + 2] = v[2]; scr[kk * 33 + c4 + 3] = v[3]; }
    LDS_WAIT(); asm volatile("" ::: "memory");
    const int c = lane & 7;
#pragma unroll
    for (int j = 0; j < 4; ++j) { const int n = (lane >> 3) + 8 * j; const LAS float* s = scr + (8 * c) * 33 + n;
        u32x4 o; o.x = pk2(s[0 * 33], s[1 * 33]); o.y = pk2(s[2 * 33], s[3 * 33]); o.z = pk2(s[4 * 33], s[5 * 33]); o.w = pk2(s[6 * 33], s[7 * 33]);
        if (n < ncols) *(u32x4*)(WT + (size_t)(dst_row0 + n) * ldk + k0 + 8 * c) = o; }
    LDS_WAIT(); asm volatile("" ::: "memory");
}
__device__ __forceinline__ void conv_job_item(int r, const float* W, int ldw, int col0, int nblk, int ncols_last, const float* gain, bf16_t* WT, int ldk, int mode, int dst_off, LAS float* scr, int lane) {
    const int kb = r / nblk, nb = r % nblk; const int nrel = 32 * nb;
    int drow = dst_off + nrel; if (mode) drow = 256 * (nrel >> 7) + (nrel & 127) + (mode == 2 ? 128 : 0);
    conv_item(W, ldw, 64 * kb, col0 + nrel, (nb == nblk - 1) ? ncols_last : 32, gain, WT, ldk, drow, scr, lane);
}
__device__ __forceinline__ void conv_group(const Frame& F, int group, int w, int nw) {
    LAS float* scr = (LAS float*)(F.lds + F.wave * 16384);
    const int lane = F.lane; unsigned char* ws = F.ws;
    constexpr int I0 = 16 * 80, I1 = 16 * 32, I2 = 16 * 88, I3 = I2, I4 = 44 * 32, I5 = 16 * 64, I6 = 16 * 32, I7 = 16, I8 = 16 * 32;
    if (group == 0) {
        for (int r = w; r < I0; r += nw) conv_job_item(r, F.in[2], 2560, 0, 80, 32, F.in[1], wsp<bf16_t>(ws, WS_WIN0), 1024, 0, 0, scr, lane);
    } else if (group == 1) {
        for (int it = w; it < I1 + I2 + I3 + I4; it += nw) { int r = it;
            if (r < I1) { conv_job_item(r, F.in[20], 1024, 0, 32, 32, nullptr, wsp<bf16_t>(ws, WS_WOUT0), 1024, 0, 0, scr, lane); continue; } r -= I1;
            if (r < I2) { conv_job_item(r, F.in[22], 2816, 0, 88, 32, F.in[21], wsp<bf16_t>(ws, WS_WGU0), 1024, 1, 0, scr, lane); continue; } r -= I2;
            if (r < I3) { conv_job_item(r, F.in[23], 2816, 0, 88, 32, F.in[21], wsp<bf16_t>(ws, WS_WGU0), 1024, 2, 0, scr, lane); continue; } r -= I3;
            conv_job_item(r, F.in[24], 1024, 0, 32, 32, nullptr, wsp<bf16_t>(ws, WS_WD0), 2816, 0, 0, scr, lane); }
    } else {
        for (int it = w; it < I5 + I6 + I7 + I8; it += nw) { int r = it;
            if (r < I5) { conv_job_item(r, F.in[26], 3088, 0, 64, 32, F.in[25], wsp<bf16_t>(ws, WS_WIN1), 1024, 0, 0, scr, lane); continue; } r -= I5;
            if (r < I6) { conv_job_item(r, F.in[26], 3088, 2064, 32, 32, F.in[25], wsp<bf16_t>(ws, WS_WIN1), 1024, 0, 2048, scr, lane); continue; } r -= I6;
            if (r < I7) { conv_job_item(r, F.in[26], 3088, 2048, 1, 16, F.in[25], wsp<bf16_t>(ws, WS_WIN1), 1024, 0, 3072, scr, lane); continue; } r -= I7;
            conv_job_item(r, F.in[32], 1024, 0, 32, 32, nullptr, wsp<bf16_t>(ws, WS_WOUT1), 1024, 0, 0, scr, lane); }
        u32x4* z = (u32x4*)(wsp<bf16_t>(ws, WS_WIN1) + (size_t)O_IN * 1024); const int n16 = (O_INP - O_IN) * 1024 / 8;
        for (int i = w * 64 + lane; i < n16; i += nw * 64) z[i] = (u32x4){0u, 0u, 0u, 0u};
    }
}
__device__ __forceinline__ void phase_prologue(const Frame& F) {
    const int gw = F.vcu * NWAVES + F.wave, NGW = F.G * NWAVES, lane = F.lane;
    unsigned char* ws = F.ws;
    conv_group(F, 0, gw, NGW);
    if (F.G < 256) { conv_group(F, 1, gw, NGW); conv_group(F, 2, gw, NGW); }
    const int gt = F.vcu * 512 + F.tid, NGT = F.G * 512;
    { bf16_t* wlr = wsp<bf16_t>(ws, WS_WLR);
      for (int i = gt; i < 2560 * 256; i += NGT) { const int n = i >> 8, k = i & 255; float v = 0.f;
          if (n < 512)       { if (k < 64) v = F.in[5][k * 512 + n]; }
          else if (n < 1024) { if (k < 64) v = F.in[7][k * 512 + (n - 512)]; }
          else if (n < 1536) { if (k >= 64 && k < 128) v = F.in[9][(k - 64) * 512 + (n - 1024)]; }
          else if (n < 2048) { if (k >= 64 && k < 128) v = F.in[11][(k - 64) * 512 + (n - 1536)]; }
          else               { if (k >= 128) v = F.in[12][(k - 128) * 512 + (n - 2048)]; }
          wlr[i] = f2bf(v); } }
    { f32x2* rt = wsp<f32x2>(ws, WS_ROPE);
      for (int i = gt; i < SEQ * 32; i += NGT) { const int ts = i >> 5, pi = i & 31; const float freq = expf(-(float)(pi & 15) * (9.210340371976184f / 16.f));
          const float ang = ((pi >= 16) ? (float)(ts & 63) : (float)(ts >> 6)) * freq; float sn, cs; sincosf(ang, &sn, &cs); rt[i] = (f32x2){cs, sn}; } }
    { const float* x = F.in[0]; bf16_t* xb = wsp<bf16_t>(ws, WS_XB); float* ssq = wsp<float>(ws, WS_SSQ0);
      for (int m = gw; m < M_TOK; m += NGW) { const f32x4* xr = (const f32x4*)(x + (size_t)m * 1024) + lane; f32x4 v[4]; float s = 0.f;
#pragma unroll
          for (int j = 0; j < 4; ++j) { v[j] = xr[64 * j]; s += (v[j].x * v[j].x + v[j].y * v[j].y) + (v[j].z * v[j].z + v[j].w * v[j].w); }
          s = wave_sum(s);
          u32x2* o8 = (u32x2*)(xb + (size_t)m * 1024) + lane;
#pragma unroll
          for (int j = 0; j < 4; ++j) { u32x2 w; w.x = pk2(v[j].x, v[j].y); w.y = pk2(v[j].z, v[j].w); o8[64 * j] = w; }
          if (lane < 16) ssq[(size_t)m * 16 + lane] = (lane == 0) ? s : 0.f; } }
}
__device__ __forceinline__ void phase_conv_experts(const Frame& F) {
    LAS float* scr = (LAS float*)(F.lds + F.wave * 16384);
    const int gw = F.vcu * NWAVES + F.wave, NGW = F.G * NWAVES, lane = F.lane;
    constexpr int IG = 16 * 112, ID = 56 * 32, IE = 2 * IG + ID;
    bf16_t* wegu = wsp<bf16_t>(F.ws, A_WEGU); bf16_t* wed = wsp<bf16_t>(F.ws, A_WED);
    for (int it = gw; it < NEXP * IE; it += NGW) { const int e = it / IE; int r = it % IE;
        if (r < IG) { conv_job_item(r, F.in[35] + (size_t)e * 1024 * D_FFE, D_FFE, 0, 112, 32, F.in[33], wegu + (size_t)e * 2 * D_FFE * 1024, 1024, 1, 0, scr, lane); continue; } r -= IG;
        if (r < IG) { conv_job_item(r, F.in[36] + (size_t)e * 1024 * D_FFE, D_FFE, 0, 112, 32, F.in[33], wegu + (size_t)e * 2 * D_FFE * 1024, 1024, 2, 0, scr, lane); continue; } r -= IG;
        conv_job_item(r, F.in[37] + (size_t)e * D_FFE * 1024, 1024, 0, 32, 32, nullptr, wed + (size_t)e * 1024 * D_FFE, D_FFE, 0, 0, scr, lane); }
}

__device__ __forceinline__ float dpp8_sum(float v) {
    v += __builtin_bit_cast(float, __builtin_amdgcn_update_dpp(0, __builtin_bit_cast(int, v), 0xB1, 0xF, 0xF, false));
    v += __builtin_bit_cast(float, __builtin_amdgcn_update_dpp(0, __builtin_bit_cast(int, v), 0x4E, 0xF, 0xF, false));
    v += __builtin_bit_cast(float, __builtin_amdgcn_update_dpp(0, __builtin_bit_cast(int, v), 0x141, 0xF, 0xF, false));
    return v;
}
__device__ __forceinline__ void unpack8(const u32x4 w, float (&f)[8]) { f[0] = bflo(w.x); f[1] = bfhi(w.x); f[2] = bflo(w.y); f[3] = bfhi(w.y); f[4] = bflo(w.z); f[5] = bfhi(w.z); f[6] = bflo(w.w); f[7] = bfhi(w.w); }
__device__ __forceinline__ u32x4 pack8f(const float (&f)[8]) { u32x4 w; w.x = pk2(f[0], f[1]); w.y = pk2(f[2], f[3]); w.z = pk2(f[4], f[5]); w.w = pk2(f[6], f[7]); return w; }
__device__ __forceinline__ void phase_prep0(const Frame& F) {
    const int gw = F.vcu * NWAVES + F.wave, lane = F.lane;
    const bf16_t* P = wsp<bf16_t>(F.ws, A_P0);
    bf16_t *RS = wsp<bf16_t>(F.ws, A_RS), *KS = wsp<bf16_t>(F.ws, A_KS), *VS = wsp<bf16_t>(F.ws, A_VS), *NKK = wsp<bf16_t>(F.ws, A_NKK), *AP = wsp<bf16_t>(F.ws, A_AP);
    bf16_t *QH = wsp<bf16_t>(F.ws, A_QH), *KH = wsp<bf16_t>(F.ws, A_KH), *VT = wsp<bf16_t>(F.ws, A_VT0);
    const f32x2* ROPE = wsp<f32x2>(F.ws, WS_ROPE);
    float mu[4][8], kkw[8], qn8[8], kn8[8];
#pragma unroll
    for (int j = 0; j < 4; ++j)
#pragma unroll
        for (int e = 0; e < 8; ++e) { const int col = 8 * (lane + 64 * j) + e; mu[j][e] = col < RW_IN ? F.in[3][col] : 0.f; }
#pragma unroll
    for (int e = 0; e < 8; ++e) { kkw[e] = F.in[13][8 * lane + e]; qn8[e] = F.in[18][8 * (lane & 7) + e]; kn8[e] = F.in[19][8 * (lane & 7) + e]; }
    for (int g8 = gw; g8 < M_TOK / 8; g8 += F.G * NWAVES) {
        u32x4 prev[4], cur[5], nxt[4];
        { const int tok = g8 * 8; const int ts = tok & (SEQ - 1);
#pragma unroll
          for (int j = 0; j < 5; ++j) cur[j] = *(const u32x4*)(P + (size_t)tok * E_IN + 8 * (lane + 64 * j));
#pragma unroll
          for (int j = 0; j < 4; ++j) prev[j] = (ts > 0) ? *(const u32x4*)(P + (size_t)(tok - 1) * E_IN + 8 * (lane + 64 * j)) : (u32x4){0u, 0u, 0u, 0u}; }
        for (int tt = 0; tt < 8; ++tt) { const int tok = g8 * 8 + tt; const int ts = tok & (SEQ - 1); const int bb = tok >> 11;
            u32x4 ncur4 = (u32x4){0u, 0u, 0u, 0u};
#pragma unroll
            for (int j = 0; j < 4; ++j) nxt[j] = (ts < SEQ - 1) ? *(const u32x4*)(P + (size_t)(tok + 1) * E_IN + 8 * (lane + 64 * j)) : (u32x4){0u, 0u, 0u, 0u};
            if (tt < 7) ncur4 = *(const u32x4*)(P + (size_t)(tok + 1) * E_IN + 8 * (lane + 256));
            const f32x4 rp0 = *(const f32x4*)(ROPE + (size_t)ts * 32 + 4 * (lane & 7)), rp1 = *(const f32x4*)(ROPE + (size_t)ts * 32 + 4 * (lane & 7) + 2);
            const float cs4[4] = {rp0[0], rp0[2], rp1[0], rp1[2]}, sn4[4] = {rp0[1], rp0[3], rp1[1], rp1[3]};
            float s[4][8];
#pragma unroll
            for (int j = 0; j < 4; ++j) { float c[8], p[8], n[8]; unpack8(cur[j], c); unpack8(prev[j], p); unpack8(nxt[j], n);
#pragma unroll
                for (int e = 0; e < 8; ++e) s[j][e] = c[e] + (0.5f * (p[e] + n[e]) - c[e]) * mu[j][e]; }
            const size_t o512 = (size_t)tok * 512 + 8 * lane;
            *(u32x4*)(RS + o512) = pack8f(s[0]); *(u32x4*)(KS + o512) = pack8f(s[1]); *(u32x4*)(VS + o512) = pack8f(s[2]);
            { float kr[8]; float ss = 0.f;
#pragma unroll
              for (int e = 0; e < 8; ++e) { kr[e] = s[1][e] * kkw[e]; ss += kr[e] * kr[e]; }
              ss = dpp8_sum(ss); const float inv = -1.f / fmaxf(sqrtf(ss), 1e-12f);
#pragma unroll
              for (int e = 0; e < 8; ++e) kr[e] *= inv;
              *(u32x4*)(NKK + o512) = pack8f(kr); }
            float x3[8], x4[8]; unpack8(cur[3], x3); unpack8(cur[4], x4);
            { float ap[8];
#pragma unroll
              for (int e = 0; e < 8; ++e) ap[e] = lane < 8 ? tanhf(s[3][e]) : (lane < 16 ? s[3][e] : sigmoidf_(s[3][e]));
              if (lane < 32) *(u32x4*)(AP + (size_t)tok * 256 + 8 * lane) = pack8f(ap); }
#pragma unroll
            for (int which = 0; which < 2; ++which) { float (&x)[8] = which ? x4 : x3; float ss = 0.f;
#pragma unroll
                for (int e = 0; e < 8; ++e) ss += x[e] * x[e];
                ss = dpp8_sum(ss); const float rs = 1.0f / sqrtf(ss * (1.f / 64.f) + NORM_EPS);
                const bool isk = which && lane >= 32; float o[8];
#pragma unroll
                for (int p = 0; p < 4; ++p) { const float x0 = x[2 * p] * rs * (isk ? kn8[2 * p] : qn8[2 * p]), x1 = x[2 * p + 1] * rs * (isk ? kn8[2 * p + 1] : qn8[2 * p + 1]);
                    o[2 * p] = x0 * cs4[p] - x1 * sn4[p]; o[2 * p + 1] = x0 * sn4[p] + x1 * cs4[p]; }
                if (!isk) {
#pragma unroll
                    for (int e = 0; e < 8; ++e) o[e] *= 0.18033688011112042f; }
                if (which == 0) { if (lane >= 32) *(u32x4*)(QH + (size_t)tok * 512 + 8 * (lane - 32)) = pack8f(o); }
                else { if (lane < 32) *(u32x4*)(QH + (size_t)tok * 512 + 256 + 8 * lane) = pack8f(o);
                       else if (lane < 48) *(u32x4*)(KH + (size_t)tok * 128 + 8 * (lane - 32)) = pack8f(o); } }
            if (lane >= 48) { const int g = (lane - 48) >> 3, d0 = 8 * ((lane - 48) & 7); const unsigned w[4] = {cur[4].x, cur[4].y, cur[4].z, cur[4].w};
#pragma unroll
                for (int e = 0; e < 8; ++e) VT[((size_t)(bb * 2 + g) * 64 + d0 + e) * SEQ + ts] = (bf16_t)((e & 1) ? (w[e >> 1] >> 16) : (w[e >> 1] & 0xffffu)); }
#pragma unroll
            for (int j = 0; j < 4; ++j) { prev[j] = cur[j]; cur[j] = nxt[j]; }
            cur[4] = ncur4;
        }
    }
}

__device__ __forceinline__ float dpp_row_sum(float v) {
    v += __builtin_bit_cast(float, __builtin_amdgcn_update_dpp(0, __builtin_bit_cast(int, v), 0xB1, 0xF, 0xF, false));
    v += __builtin_bit_cast(float, __builtin_amdgcn_update_dpp(0, __builtin_bit_cast(int, v), 0x4E, 0xF, 0xF, false));
    v += __builtin_bit_cast(float, __builtin_amdgcn_update_dpp(0, __builtin_bit_cast(int, v), 0x141, 0xF, 0xF, false));
    v += __builtin_bit_cast(float, __builtin_amdgcn_update_dpp(0, __builtin_bit_cast(int, v), 0x140, 0xF, 0xF, false));
    return v;
}
constexpr int SC_STEPS = 32, SC_STRIDE = 352, SC_BUF = SC_STEPS * SC_STRIDE;
__device__ __forceinline__ float dpp_row8_sum(float v) {
    v += __builtin_bit_cast(float, __builtin_amdgcn_update_dpp(0, __builtin_bit_cast(int, v), 0xB1, 0xF, 0xF, false));
    v += __builtin_bit_cast(float, __builtin_amdgcn_update_dpp(0, __builtin_bit_cast(int, v), 0x4E, 0xF, 0xF, false));
    v += __builtin_bit_cast(float, __builtin_amdgcn_update_dpp(0, __builtin_bit_cast(int, v), 0x141, 0xF, 0xF, false));
    return v;
}
struct ScOps { f32x2 w[4], kd[4], a[4], b[4], r[4]; float v; };
__device__ __forceinline__ void sc_ld(ScOps& o, const LAS float* bs, const LAS float* vp) {
#pragma unroll
    for (int i = 0; i < 2; ++i) {
        const f32x4 w4 = *(const LAS f32x4*)(bs + 4 * i), k4 = *(const LAS f32x4*)(bs + 64 + 4 * i), a4 = *(const LAS f32x4*)(bs + 128 + 4 * i), b4 = *(const LAS f32x4*)(bs + 192 + 4 * i), r4 = *(const LAS f32x4*)(bs + 256 + 4 * i);
        o.w[2 * i] = (f32x2){w4[0], w4[1]}; o.w[2 * i + 1] = (f32x2){w4[2], w4[3]}; o.kd[2 * i] = (f32x2){k4[0], k4[1]}; o.kd[2 * i + 1] = (f32x2){k4[2], k4[3]};
        o.a[2 * i] = (f32x2){a4[0], a4[1]}; o.a[2 * i + 1] = (f32x2){a4[2], a4[3]}; o.b[2 * i] = (f32x2){b4[0], b4[1]}; o.b[2 * i + 1] = (f32x2){b4[2], b4[3]};
        o.r[2 * i] = (f32x2){r4[0], r4[1]}; o.r[2 * i + 1] = (f32x2){r4[2], r4[3]}; }
    o.v = *vp;
}
template <int DIR> __device__ __forceinline__ float sc_step(f32x2 (&s)[4], const ScOps& o) {
    f32x2 u[4];
#pragma unroll
    for (int i = 0; i < 4; ++i) u[i] = o.kd[i] * o.v;
    f32x2 p = s[0] * o.a[0], q = s[1] * o.a[1];
    p = __builtin_elementwise_fma(s[2], o.a[2], p); q = __builtin_elementwise_fma(s[3], o.a[3], q); p = p + q;
    float sa = dpp_row8_sum(p[0] + p[1]);
    f32x2 yp, yq;
    if (DIR) { yp = s[0] * o.r[0]; yq = s[1] * o.r[1]; yp = __builtin_elementwise_fma(s[2], o.r[2], yp); yq = __builtin_elementwise_fma(s[3], o.r[3], yq); }
    const f32x2 sa2 = {sa, sa};
#pragma unroll
    for (int i = 0; i < 4; ++i) { const f32x2 t = __builtin_elementwise_fma(o.b[i], sa2, u[i]); s[i] = __builtin_elementwise_fma(s[i], o.w[i], t); }
    if (!DIR) { yp = s[0] * o.r[0]; yq = s[1] * o.r[1]; yp = __builtin_elementwise_fma(s[2], o.r[2], yp); yq = __builtin_elementwise_fma(s[3], o.r[3], yq); }
    yp = yp + yq;
    return dpp_row8_sum(yp[0] + yp[1]);
}
__device__ __forceinline__ void attn_tile_step(const LAS unsigned char* kb, const LAS unsigned char* vb, const bf16x8 (&q)[4], f32x16& o0, f32x16& o1, float& mrun, float& lrun, int r32, int hi) {
    f32x16 c0 = {}, c1 = {};
#pragma unroll
    for (int s4 = 0; s4 < 4; ++s4) { const int chk = 2 * s4 + hi;
        const bf16x8 k0 = *(const LAS bf16x8*)(kb + r32 * 128 + ((chk ^ (r32 & 7)) * 16));
        const bf16x8 k1 = *(const LAS bf16x8*)(kb + (32 + r32) * 128 + ((chk ^ (r32 & 7)) * 16));
        c0 = __builtin_amdgcn_mfma_f32_32x32x16_bf16(k0, q[s4], c0, 0, 0, 0);
        c1 = __builtin_amdgcn_mfma_f32_32x32x16_bf16(k1, q[s4], c1, 0, 0, 0); }
    float mx = c0[0];
#pragma unroll
    for (int r = 0; r < 16; ++r) { mx = fmaxf(mx, c0[r]); mx = fmaxf(mx, c1[r]); }
    mx = fmaxf(mx, __shfl_xor(mx, 32));
    const float mnew = fmaxf(mrun, mx); const float alpha = __builtin_amdgcn_exp2f(mrun - mnew); mrun = mnew;
    float ls = 0.f;
#pragma unroll
    for (int r = 0; r < 16; ++r) { c0[r] = __builtin_amdgcn_exp2f(c0[r] - mnew); c1[r] = __builtin_amdgcn_exp2f(c1[r] - mnew); ls += c0[r] + c1[r]; }
    lrun = lrun * alpha + ls;
#pragma unroll
    for (int r = 0; r < 16; ++r) { o0[r] *= alpha; o1[r] *= alpha; }
    u32x4 w00, w01, w10, w11;
    w00.x = pk2(c0[0], c0[1]); w00.y = pk2(c0[2], c0[3]); w00.z = pk2(c0[4], c0[5]); w00.w = pk2(c0[6], c0[7]);
    w01.x = pk2(c0[8], c0[9]); w01.y = pk2(c0[10], c0[11]); w01.z = pk2(c0[12], c0[13]); w01.w = pk2(c0[14], c0[15]);
    w10.x = pk2(c1[0], c1[1]); w10.y = pk2(c1[2], c1[3]); w10.z = pk2(c1[4], c1[5]); w10.w = pk2(c1[6], c1[7]);
    w11.x = pk2(c1[8], c1[9]); w11.y = pk2(c1[10], c1[11]); w11.z = pk2(c1[12], c1[13]); w11.w = pk2(c1[14], c1[15]);
    const bf16x8 p00 = __builtin_bit_cast(bf16x8, w00), p01 = __builtin_bit_cast(bf16x8, w01), p10 = __builtin_bit_cast(bf16x8, w10), p11 = __builtin_bit_cast(bf16x8, w11);
#define AT_VF(dd_, chk_) ({ const int sw_ = ((dd_) >> 1) & 7; const u32x2 lo_ = *(const LAS u32x2*)(vb + (dd_) * 128 + (((chk_) ^ sw_) * 16) + hi * 8); \
        const u32x2 hh_ = *(const LAS u32x2*)(vb + (dd_) * 128 + ((((chk_) + 1) ^ sw_) * 16) + hi * 8); const u32x4 vv_ = {lo_.x, lo_.y, hh_.x, hh_.y}; __builtin_bit_cast(bf16x8, vv_); })
    o0 = __builtin_amdgcn_mfma_f32_32x32x16_bf16(AT_VF(r32, 0), p00, o0, 0, 0, 0);
    o0 = __builtin_amdgcn_mfma_f32_32x32x16_bf16(AT_VF(r32, 2), p01, o0, 0, 0, 0);
    o0 = __builtin_amdgcn_mfma_f32_32x32x16_bf16(AT_VF(r32, 4), p10, o0, 0, 0, 0);
    o0 = __builtin_amdgcn_mfma_f32_32x32x16_bf16(AT_VF(r32, 6), p11, o0, 0, 0, 0);
    o1 = __builtin_amdgcn_mfma_f32_32x32x16_bf16(AT_VF(32 + r32, 0), p00, o1, 0, 0, 0);
    o1 = __builtin_amdgcn_mfma_f32_32x32x16_bf16(AT_VF(32 + r32, 2), p01, o1, 0, 0, 0);
    o1 = __builtin_amdgcn_mfma_f32_32x32x16_bf16(AT_VF(32 + r32, 4), p10, o1, 0, 0, 0);
    o1 = __builtin_amdgcn_mfma_f32_32x32x16_bf16(AT_VF(32 + r32, 6), p11, o1, 0, 0, 0);
#undef AT_VF
}
__device__ __forceinline__ void attn_store(bf16_t* op, const f32x16& o0, const f32x16& o1, float lrun) {
    const float ltot = lrun + __shfl_xor(lrun, 32); const float inv = 1.f / ltot;
#pragma unroll
    for (int q4 = 0; q4 < 4; ++q4) { u32x2 w0, w1;
        w0.x = pk2(o0[4 * q4 + 0] * inv, o0[4 * q4 + 1] * inv); w0.y = pk2(o0[4 * q4 + 2] * inv, o0[4 * q4 + 3] * inv);
        w1.x = pk2(o1[4 * q4 + 0] * inv, o1[4 * q4 + 1] * inv); w1.y = pk2(o1[4 * q4 + 2] * inv, o1[4 * q4 + 3] * inv);
        *(u32x2*)(op + 8 * q4) = w0; *(u32x2*)(op + 32 + 8 * q4) = w1; }
}
template <int DIR> __device__ __forceinline__ void scan_job(const Frame& F, int b, int h, int half, int job) {
    LAS float* buf = (LAS float*)F.lds; LAS float* ybuf = buf + 2 * SC_BUF;
    const int tid = F.tid, lane = F.lane, wave = F.wave;
    const bf16_t* s0 = wsp<bf16_t>(F.ws, DIR ? A_LWB : A_LWF); const bf16_t* s1 = wsp<bf16_t>(F.ws, DIR ? A_KDB : A_KDF); const bf16_t* s2 = wsp<bf16_t>(F.ws, A_NKK);
    const bf16_t* s3 = wsp<bf16_t>(F.ws, DIR ? A_BBB : A_BBF); const bf16_t* s4 = wsp<bf16_t>(F.ws, A_RS); const bf16_t* s5 = wsp<bf16_t>(F.ws, A_VS);
    float* Y = wsp<float>(F.ws, DIR ? A_YB : A_YF);
    constexpr int NCH = SEQ / SC_STEPS;
    const int htid = tid - 256;
#define SC_STAGE_LD(ch) do { const int step_ = ht_ >> 3, sub_ = ht_ & 7; \
        const int sq_ = (ch) * SC_STEPS + step_; const size_t to_ = (size_t)(b * SEQ + (DIR ? (SEQ - 1 - sq_) : sq_)) * 512 + h * 64 + 8 * sub_; \
        sst[0] = *(const u32x4*)(s0 + to_); sst[1] = *(const u32x4*)(s1 + to_); sst[2] = *(const u32x4*)(s2 + to_); sst[3] = *(const u32x4*)(s3 + to_); sst[4] = *(const u32x4*)(s4 + to_); \
        if (sub_ < 4) sst[5] = *(const u32x4*)(s5 + to_ + half * 32); } while (0)
#define SC_STAGE_ST(bufp) do { const int step_ = ht_ >> 3, sub_ = ht_ & 7; LAS float* d_ = (bufp) + step_ * SC_STRIDE + 8 * sub_; \
        _Pragma("unroll") for (int i_ = 0; i_ < 6; ++i_) { if (i_ < 5 || sub_ < 4) { \
            f32x4 lo_ = {bflo(sst[i_].x), bfhi(sst[i_].x), bflo(sst[i_].y), bfhi(sst[i_].y)}, hi_ = {bflo(sst[i_].z), bfhi(sst[i_].z), bflo(sst[i_].w), bfhi(sst[i_].w)}; \
            if (i_ == 0) { _Pragma("unroll") for (int e_ = 0; e_ < 4; ++e_) { lo_[e_] = __builtin_amdgcn_exp2f(lo_[e_]); hi_[e_] = __builtin_amdgcn_exp2f(hi_[e_]); } } \
            *(LAS f32x4*)(d_ + i_ * 64) = lo_; *(LAS f32x4*)(d_ + i_ * 64 + 4) = hi_; } } } while (0)
#define SC_STAGE(ch, bufp) do { SC_STAGE_LD(ch); SC_STAGE_ST(bufp); } while (0)
#define SC_FLUSH(ch) do { const LAS float* yb_ = ybuf + ((ch) & 1) * 1024; const int step_ = ht_ >> 3, c_ = ht_ & 7; const int sq_ = (ch) * SC_STEPS + step_; const int tok_ = b * SEQ + (DIR ? (SEQ - 1 - sq_) : sq_); \
        *(f32x4*)(Y + (size_t)tok_ * 512 + h * 64 + half * 32 + 4 * c_) = *(const LAS f32x4*)(yb_ + step_ * 32 + 4 * c_); } while (0)
    LAS unsigned char* alds = F.lds + 98304;
    const int hw = wave - 4;
    const bf16_t *QH = wsp<bf16_t>(F.ws, A_QH), *KH = wsp<bf16_t>(F.ws, A_KH), *VT0 = wsp<bf16_t>(F.ws, A_VT0); bf16_t* YC = wsp<bf16_t>(F.ws, A_YCAT);
    u32x4 sst[6];
    bf16x8 qfA[4], qfB[4]; f32x16 oA0 = {}, oA1 = {}, oB0 = {}, oB1 = {}; float mA = -1e30f, mB = -1e30f, lA = 0.f, lB = 0.f;
#define AT_UNIT(ch_) (2 * job + ((ch_) >> 5))
#define AT_LOAD(ch_) do { const int u_ = AT_UNIT(ch_), t_ = (ch_) & 31; const int ab_ = u_ >> 6, ag_ = (u_ >> 5) & 1; \
        _Pragma("unroll") for (int i_ = 0; i_ < 2; ++i_) { const int p_ = ht_ + 256 * i_, key_ = p_ >> 3, c_ = p_ & 7; \
            akst[i_] = *(const u32x4*)(KH + (size_t)(ab_ * SEQ + 64 * t_ + key_) * 128 + ag_ * 64 + 8 * c_); \
            avst[i_] = *(const u32x4*)(VT0 + ((size_t)(ab_ * 2 + ag_) * 64 + key_) * SEQ + 64 * t_ + 8 * c_); } } while (0)
#define AT_STORE(ch_) do { const int bo_ = ((ch_) & 1) * 8192; \
        _Pragma("unroll") for (int i_ = 0; i_ < 2; ++i_) { const int p_ = ht_ + 256 * i_, key_ = p_ >> 3, c_ = p_ & 7; \
            *(LAS u32x4*)(alds + bo_ + key_ * 128 + ((c_ ^ (key_ & 7)) * 16)) = akst[i_]; \
            *(LAS u32x4*)(alds + 16384 + bo_ + key_ * 128 + ((c_ ^ ((key_ >> 1) & 7)) * 16)) = avst[i_]; } } while (0)
#define AT_DMA(ch_) do { const int u_ = AT_UNIT(ch_), t_ = (ch_) & 31; const int ab_ = u_ >> 6, ag_ = (u_ >> 5) & 1; const int bo_ = ((ch_) & 1) * 8192; \
        _Pragma("unroll") for (int i_ = 0; i_ < 2; ++i_) { const int p_ = (hw * 2 + i_) * 64 + ln_, row_ = p_ >> 3, cp_ = p_ & 7; \
            __builtin_amdgcn_global_load_lds((const unsigned*)(KH + (size_t)(ab_ * SEQ + 64 * t_ + row_) * 128 + ag_ * 64 + 8 * (cp_ ^ (row_ & 7))), (LAS unsigned*)(alds + bo_ + (hw * 2 + i_) * 1024), 16, 0, 0); \
            __builtin_amdgcn_global_load_lds((const unsigned*)(VT0 + ((size_t)(ab_ * 2 + ag_) * 64 + row_) * SEQ + 64 * t_ + 8 * (cp_ ^ ((row_ >> 1) & 7))), (LAS unsigned*)(alds + 16384 + bo_ + (hw * 2 + i_) * 1024), 16, 0, 0); } } while (0)
    __syncthreads();
    if (wave >= 4) { int ht_ = htid; asm volatile("" : "+v"(ht_)); const int ln_ = ht_ & 63; SC_STAGE(0, buf); AT_DMA(0); asm volatile("s_waitcnt vmcnt(0)" ::: "memory"); }
    __syncthreads();
    if (wave < 4) {
        __builtin_amdgcn_s_setprio(3);
        const int row = lane >> 3, kg = lane & 7, rowl = wave * 8 + row;
        f32x2 s[4] = {(f32x2){0.f, 0.f}, (f32x2){0.f, 0.f}, (f32x2){0.f, 0.f}, (f32x2){0.f, 0.f}};
        for (int ch = 0; ch < NCH; ++ch) {
            const LAS float* bc = buf + (ch & 1) * SC_BUF + 8 * kg; const LAS float* vc = buf + (ch & 1) * SC_BUF + 320 + rowl; LAS float* yb = ybuf + (ch & 1) * 1024 + rowl;
            ScOps oa, ob; sc_ld(oa, bc, vc);
#pragma unroll 2
            for (int step = 0; step < SC_STEPS; step += 2) {
                sc_ld(ob, bc + (step + 1) * SC_STRIDE, vc + (step + 1) * SC_STRIDE);
                const float y0 = sc_step<DIR>(s, oa); yb[step * 32] = y0;
                if (step + 2 < SC_STEPS) sc_ld(oa, bc + (step + 2) * SC_STRIDE, vc + (step + 2) * SC_STRIDE);
                const float y1 = sc_step<DIR>(s, ob); yb[(step + 1) * 32] = y1; }
            __syncthreads();
        }
        __builtin_amdgcn_s_setprio(0);
    } else {
        for (int ch = 0; ch < NCH; ++ch) {
            int ht_ = htid; asm volatile("" : "+v"(ht_));
            int ln_ = lane; asm volatile("" : "+v"(ln_)); const int r32 = ln_ & 31, hi = ln_ >> 5;
            if (ch > 0) SC_FLUSH(ch - 1);
            if (ch + 1 < NCH) { AT_DMA(ch + 1); SC_STAGE_LD(ch + 1); }
            __builtin_amdgcn_sched_barrier(0);
            const int u = AT_UNIT(ch), t = ch & 31; const int ab = u >> 6, ag = (u >> 5) & 1, aqt = u & 31; const int head = 4 * ag + hw;
            const int qrowA = ab * SEQ + aqt * 64 + r32, qrowB = qrowA + 32;
            if (t == 0) {
#pragma unroll
                for (int s4 = 0; s4 < 4; ++s4) { qfA[s4] = *(const bf16x8*)(QH + (size_t)qrowA * 512 + head * 64 + 16 * s4 + 8 * hi); qfB[s4] = *(const bf16x8*)(QH + (size_t)qrowB * 512 + head * 64 + 16 * s4 + 8 * hi); }
                oA0 = f32x16{}; oA1 = f32x16{}; oB0 = f32x16{}; oB1 = f32x16{}; mA = -1e30f; mB = -1e30f; lA = 0.f; lB = 0.f; }
            { const LAS unsigned char* kb = alds + (ch & 1) * 8192; const LAS unsigned char* vb = alds + 16384 + (ch & 1) * 8192;
              __builtin_amdgcn_sched_barrier(0);
              attn_tile_step(kb, vb, qfA, oA0, oA1, mA, lA, r32, hi);
              __builtin_amdgcn_sched_barrier(0);
              if (ch + 1 < NCH) { SC_STAGE_ST(buf + ((ch + 1) & 1) * SC_BUF); }
              __builtin_amdgcn_sched_barrier(0);
              attn_tile_step(kb, vb, qfB, oB0, oB1, mB, lB, r32, hi);
              __builtin_amdgcn_sched_barrier(0); }
            if (t == 31) { attn_store(YC + (size_t)qrowA * 1024 + 512 + head * 64 + 4 * hi, oA0, oA1, lA); attn_store(YC + (size_t)qrowB * 1024 + 512 + head * 64 + 4 * hi, oB0, oB1, lB); }
            asm volatile("s_waitcnt vmcnt(0)" ::: "memory");
            __syncthreads();
        }
        { int ht_ = htid; asm volatile("" : "+v"(ht_)); SC_FLUSH(NCH - 1); }
    }
#undef AT_UNIT
#undef AT_LOAD
#undef AT_STORE
#undef SC_STAGE
#undef SC_STAGE_LD
#undef SC_STAGE_ST
#undef SC_FLUSH
}
__device__ __forceinline__ void phase_scan(const Frame& F) {
    for (int job = F.vcu; job < 256; job += F.G) {
        const int chain = job >> 1, half = job & 1, dir = chain & 1, bh = chain >> 1, b = bh >> 3, h = bh & 7;
        if (dir) scan_job<1>(F, b, h, half, job); else scan_job<0>(F, b, h, half, job);
    }
}

__device__ __forceinline__ void phase_attn(const Frame& F) {
    const int tid = F.tid, lane = F.lane, wave = F.wave, r32 = lane & 31, hi = lane >> 5;
    LAS unsigned char* lds = F.lds;
    const bf16_t *QH = wsp<bf16_t>(F.ws, A_QH), *KH = wsp<bf16_t>(F.ws, A_KH), *VT = wsp<bf16_t>(F.ws, A_VT0); bf16_t* YC = wsp<bf16_t>(F.ws, A_YCAT);
    const int skey = tid >> 3, sc = tid & 7;
    for (int u = F.vcu; u < 512; u += F.G) {
        const int b = u >> 6, g = (u >> 5) & 1, qt = u & 31;
        const int head = 4 * g + (wave >> 1); const int qrow = b * SEQ + qt * 64 + 32 * (wave & 1) + r32;
        bf16x8 qf[4];
#pragma unroll
        for (int s = 0; s < 4; ++s) qf[s] = *(const bf16x8*)(QH + (size_t)qrow * 512 + head * 64 + 16 * s + 8 * hi);
        const bf16_t* ksrc = KH + (size_t)(b * SEQ + skey) * 128 + g * 64 + 8 * sc;
        const bf16_t* vsrc = VT + ((size_t)(b * 2 + g) * 64 + skey) * SEQ + 8 * sc;
        const int kdst = skey * 128 + ((sc ^ (skey & 7)) * 16), vdst = 16384 + skey * 128 + ((sc ^ ((skey >> 1) & 7)) * 16);
        u32x4 kst = *(const u32x4*)ksrc, vst = *(const u32x4*)vsrc;
        __syncthreads();
        *(LAS u32x4*)(lds + kdst) = kst; *(LAS u32x4*)(lds + vdst) = vst;
        __syncthreads();
        f32x16 o0 = {}, o1 = {}; float mrun = -1e30f, lrun = 0.f;
        for (int t = 0; t < SEQ / 64; ++t) {
            if (t + 1 < SEQ / 64) { kst = *(const u32x4*)(ksrc + (size_t)(t + 1) * 64 * 128); vst = *(const u32x4*)(vsrc + (t + 1) * 64); }
            const int bo = (t & 1) * 8192;
            f32x16 c0 = {}, c1 = {};
#pragma unroll
            for (int s = 0; s < 4; ++s) { const int ch = 2 * s + hi;
                const bf16x8 k0 = *(const LAS bf16x8*)(lds + bo + r32 * 128 + ((ch ^ (r32 & 7)) * 16));
                const bf16x8 k1 = *(const LAS bf16x8*)(lds + bo + (32 + r32) * 128 + ((ch ^ (r32 & 7)) * 16));
                c0 = __builtin_amdgcn_mfma_f32_32x32x16_bf16(k0, qf[s], c0, 0, 0, 0);
                c1 = __builtin_amdgcn_mfma_f32_32x32x16_bf16(k1, qf[s], c1, 0, 0, 0); }
            float mx = c0[0];
#pragma unroll
            for (int r = 0; r < 16; ++r) { mx = fmaxf(mx, c0[r]); mx = fmaxf(mx, c1[r]); }
            mx = fmaxf(mx, __shfl_xor(mx, 32));
            const float mnew = fmaxf(mrun, mx); const float alpha = __builtin_amdgcn_exp2f(mrun - mnew); mrun = mnew;
            float ls = 0.f;
#pragma unroll
            for (int r = 0; r < 16; ++r) { c0[r] = __builtin_amdgcn_exp2f(c0[r] - mnew); c1[r] = __builtin_amdgcn_exp2f(c1[r] - mnew); ls += c0[r] + c1[r]; }
            lrun = lrun * alpha + ls;
#pragma unroll
            for (int r = 0; r < 16; ++r) { o0[r] *= alpha; o1[r] *= alpha; }
            bf16x8 pf[2][2];
#pragma unroll
            for (int s2 = 0; s2 < 2; ++s2) { u32x4 w0, w1;
                w0.x = pk2(c0[8 * s2 + 0], c0[8 * s2 + 1]); w0.y = pk2(c0[8 * s2 + 2], c0[8 * s2 + 3]); w0.z = pk2(c0[8 * s2 + 4], c0[8 * s2 + 5]); w0.w = pk2(c0[8 * s2 + 6], c0[8 * s2 + 7]);
                w1.x = pk2(c1[8 * s2 + 0], c1[8 * s2 + 1]); w1.y = pk2(c1[8 * s2 + 2], c1[8 * s2 + 3]); w1.z = pk2(c1[8 * s2 + 4], c1[8 * s2 + 5]); w1.w = pk2(c1[8 * s2 + 6], c1[8 * s2 + 7]);
                pf[0][s2] = __builtin_bit_cast(bf16x8, w0); pf[1][s2] = __builtin_bit_cast(bf16x8, w1); }
            const int vb = 16384 + bo;
#pragma unroll
            for (int dblk = 0; dblk < 2; ++dblk) { const int d = 32 * dblk + r32; const int sw = (d >> 1) & 7;
#pragma unroll
                for (int blk = 0; blk < 2; ++blk)
#pragma unroll
                    for (int s2 = 0; s2 < 2; ++s2) { const int ch = 4 * blk + 2 * s2;
                        const u32x2 lo = *(const LAS u32x2*)(lds + vb + d * 128 + ((ch ^ sw) * 16) + hi * 8);
                        const u32x2 hh = *(const LAS u32x2*)(lds + vb + d * 128 + (((ch + 1) ^ sw) * 16) + hi * 8);
                        const u32x4 vv = {lo.x, lo.y, hh.x, hh.y};
                        if (dblk == 0) o0 = __builtin_amdgcn_mfma_f32_32x32x16_bf16(__builtin_bit_cast(bf16x8, vv), pf[blk][s2], o0, 0, 0, 0);
                        else           o1 = __builtin_amdgcn_mfma_f32_32x32x16_bf16(__builtin_bit_cast(bf16x8, vv), pf[blk][s2], o1, 0, 0, 0); } }
            if (t + 1 < SEQ / 64) { const int nb = ((t + 1) & 1) * 8192; *(LAS u32x4*)(lds + nb + kdst) = kst; *(LAS u32x4*)(lds + nb + vdst) = vst; }
            __syncthreads();
        }
        const float ltot = lrun + __shfl_xor(lrun, 32); const float inv = 1.f / ltot;
        bf16_t* op = YC + (size_t)qrow * 1024 + 512 + head * 64 + 4 * hi;
#pragma unroll
        for (int q4 = 0; q4 < 4; ++q4) { u32x2 w0, w1;
            w0.x = pk2(o0[4 * q4 + 0] * inv, o0[4 * q4 + 1] * inv); w0.y = pk2(o0[4 * q4 + 2] * inv, o0[4 * q4 + 3] * inv);
            w1.x = pk2(o1[4 * q4 + 0] * inv, o1[4 * q4 + 1] * inv); w1.y = pk2(o1[4 * q4 + 2] * inv, o1[4 * q4 + 3] * inv);
            *(u32x2*)(op + 8 * q4) = w0; *(u32x2*)(op + 32 + 8 * q4) = w1; }
    }
}

__device__ __forceinline__ void phase_rwkv_post(const Frame& F) {
    const int gw = F.vcu * NWAVES + F.wave, lane = F.lane;
    const float *YF = wsp<float>(F.ws, A_YF), *YB = wsp<float>(F.ws, A_YB);
    const bf16_t *RS = wsp<bf16_t>(F.ws, A_RS), *VS = wsp<bf16_t>(F.ws, A_VS), *KDF = wsp<bf16_t>(F.ws, A_KDF), *GG = wsp<bf16_t>(F.ws, A_GG);
    bf16_t* YC = wsp<bf16_t>(F.ws, A_YCAT);
    const int c0 = 8 * lane;
    float gw_[8], gb_[8], rk_[8];
#pragma unroll
    for (int i = 0; i < 8; ++i) { gw_[i] = F.in[16][c0 + i]; gb_[i] = F.in[17][c0 + i]; rk_[i] = F.in[15][c0 + i]; }
    for (int tok = gw; tok < M_TOK; tok += F.G * NWAVES) { const size_t o = (size_t)tok * 512 + c0;
        const f32x4 a0 = *(const f32x4*)(YF + o), a1 = *(const f32x4*)(YF + o + 4), b0 = *(const f32x4*)(YB + o), b1 = *(const f32x4*)(YB + o + 4);
        float y[8]; float sm = 0.f;
#pragma unroll
        for (int i = 0; i < 4; ++i) { y[i] = a0[i] + b0[i]; y[4 + i] = a1[i] + b1[i]; }
#pragma unroll
        for (int i = 0; i < 8; ++i) sm += y[i];
        sm += __shfl_xor(sm, 1); sm += __shfl_xor(sm, 2); sm += __shfl_xor(sm, 4);
        const float mean = sm * (1.f / 64.f); float sv = 0.f;
#pragma unroll
        for (int i = 0; i < 8; ++i) { y[i] -= mean; sv += y[i] * y[i]; }
        sv += __shfl_xor(sv, 1); sv += __shfl_xor(sv, 2); sv += __shfl_xor(sv, 4);
        const float rstd = 1.0f / sqrtf(sv * (1.f / 64.f) + 64e-5f);
        const u32x4 rw = *(const u32x4*)(RS + o), vw = *(const u32x4*)(VS + o), kw = *(const u32x4*)(KDF + o), gw4 = *(const u32x4*)(GG + o);
        const float r8[8] = {bflo(rw.x), bfhi(rw.x), bflo(rw.y), bfhi(rw.y), bflo(rw.z), bfhi(rw.z), bflo(rw.w), bfhi(rw.w)};
        const float v8[8] = {bflo(vw.x), bfhi(vw.x), bflo(vw.y), bfhi(vw.y), bflo(vw.z), bfhi(vw.z), bflo(vw.w), bfhi(vw.w)};
        const float k8[8] = {bflo(kw.x), bfhi(kw.x), bflo(kw.y), bfhi(kw.y), bflo(kw.z), bfhi(kw.z), bflo(kw.w), bfhi(kw.w)};
        const float g8[8] = {bflo(gw4.x), bfhi(gw4.x), bflo(gw4.y), bfhi(gw4.y), bflo(gw4.z), bfhi(gw4.z), bflo(gw4.w), bfhi(gw4.w)};
        float bs = 0.f;
#pragma unroll
        for (int i = 0; i < 8; ++i) bs += r8[i] * k8[i] * rk_[i];
        bs += __shfl_xor(bs, 1); bs += __shfl_xor(bs, 2); bs += __shfl_xor(bs, 4);
        float ov[8];
#pragma unroll
        for (int i = 0; i < 8; ++i) ov[i] = ((y[i] * rstd) * gw_[i] + gb_[i] + bs * v8[i]) * g8[i];
        u32x4 w; w.x = pk2(ov[0], ov[1]); w.y = pk2(ov[2], ov[3]); w.z = pk2(ov[4], ov[5]); w.w = pk2(ov[6], ov[7]);
        *(u32x4*)(YC + (size_t)tok * 1024 + c0) = w; }
}

constexpr float GLA_QSCALE = 0.08838834764831845f;
__device__ __forceinline__ size_t gla_dir(size_t base, int dir) { return base + (size_t)dir * GLA_DIR_STRIDE; }
__device__ __forceinline__ float logsig16(float z) { return (fminf(z, 0.f) - __logf(1.f + __expf(-fabsf(z)))) * (1.f / 16.f); }
__device__ __forceinline__ void phase_gla_prep(const Frame& F) {
    const int tid = F.tid, lane = F.lane, wave = F.wave, fr = lane & 15, fq = lane >> 4;
    LAS float* GD = (LAS float*)F.lds;
    LAS float* PT = (LAS float*)(F.lds + 4096);
    LAS unsigned char* QTt = F.lds + 10240;
    LAS unsigned char* KTt = F.lds + 10240 + 17408;
    LAS unsigned char* RV = F.lds + 10240;
    LAS unsigned char* RQ = F.lds + 45056; LAS unsigned char* RK = F.lds + 45056 + 16384;
    LAS unsigned char* ATT = F.lds + 45056;
    LAS unsigned char* QHl = F.lds + 45056 + 9216;
    LAS unsigned char* VTt = F.lds + 77824;
    const bf16_t* P1 = wsp<bf16_t>(F.ws, A_P1);
    bf16_t* VT = wsp<bf16_t>(F.ws, A_VT1); float* DECS = wsp<float>(F.ws, WS_DECS); bf16_t* OF = wsp<bf16_t>(F.ws, A_OF);
    const int d = tid & 127, qr = tid >> 7;
    for (int unit = F.vcu; unit < BATCH * GLA_H * 32; unit += F.G) {
        const int n = unit & 31, h = (unit >> 5) & 3, b = unit >> 7; const int T0 = b * SEQ + 64 * n; const size_t tile = (size_t)(b * 4 + h) * 32 + n;
        __syncthreads();
        for (int i = tid; i < 1024; i += 512) GD[i] = bf2f(P1[(size_t)(T0 + (i >> 4)) * O_INP + 3072 + (i & 15)]);
#pragma unroll
        for (int i = 0; i < 2; ++i) { const int p = tid + 512 * i, row = p >> 4, c = p & 15; const bf16_t* src = P1 + (size_t)(T0 + row) * O_INP + h * 128 + 8 * c;
            *(LAS u32x4*)(RQ + row * 256 + c * 16) = *(const u32x4*)src; *(LAS u32x4*)(RK + row * 256 + c * 16) = *(const u32x4*)(src + 512); }
#pragma unroll
        for (int i = 0; i < 4; ++i) { const int p = tid + 512 * i, row = p >> 5, c = p & 31;
            *(LAS u32x4*)(RV + row * 512 + c * 16) = *(const u32x4*)(P1 + (size_t)(T0 + row) * O_INP + 1024 + h * 256 + 8 * c); }
        float upf[16], upb[16];
#pragma unroll
        for (int r = 0; r < 16; ++r) { upf[r] = F.in[27][r * 512 + h * 128 + d]; upb[r] = F.in[29][r * 512 + h * 128 + d]; }
        const float bif = F.in[28][h * 128 + d], bib = F.in[30][h * 128 + d];
        __syncthreads();
        bf16_t qraw[16], kraw[16];
#pragma unroll
        for (int j = 0; j < 16; ++j) { qraw[j] = *(const LAS bf16_t*)(RQ + (16 * qr + j) * 256 + d * 2); kraw[j] = *(const LAS bf16_t*)(RK + (16 * qr + j) * 256 + d * 2); }
        { const int dv = tid & 255, th = tid >> 8; unsigned pk[16];
#pragma unroll
          for (int j = 0; j < 16; ++j) pk[j] = (unsigned)*(const LAS bf16_t*)(RV + (32 * th + 2 * j) * 512 + dv * 2) | ((unsigned)*(const LAS bf16_t*)(RV + (32 * th + 2 * j + 1) * 512 + dv * 2) << 16);
          bf16_t* gdst = VT + tile * 16384 + dv * 64 + 32 * th;
#pragma unroll
          for (int q = 0; q < 4; ++q) { const u32x4 w = {pk[4 * q], pk[4 * q + 1], pk[4 * q + 2], pk[4 * q + 3]}; *(u32x4*)(gdst + 8 * q) = w; *(LAS u32x4*)(VTt + dv * 144 + (32 * th + 8 * q) * 2) = w; } }
        float Bf[16], Bb[16];
#pragma unroll
        for (int j = 0; j < 16; ++j) { const LAS f32x4* gp = (const LAS f32x4*)(GD + (16 * qr + j) * 16); float zf = bif, zb = bib;
#pragma unroll
            for (int q = 0; q < 4; ++q) { const f32x4 g4 = gp[q];
#pragma unroll
                for (int e = 0; e < 4; ++e) { zf += g4[e] * upf[4 * q + e]; zb += g4[e] * upb[4 * q + e]; } }
            Bf[j] = logsig16(zf); Bb[j] = logsig16(zb); }
#pragma unroll
        for (int j = 1; j < 16; ++j) Bf[j] += Bf[j - 1];
#pragma unroll
        for (int j = 14; j >= 0; --j) Bb[j] += Bb[j + 1];
        PT[(0 * 4 + qr) * 128 + d] = Bf[15]; PT[(1 * 4 + qr) * 128 + d] = Bb[0];
        if (qr == 2) PT[1024 + d] = Bf[0];
        if (qr == 1) PT[1024 + 128 + d] = Bb[15];
        __syncthreads();
        float offf = 0.f, offb = 0.f, totf = 0.f, totb = 0.f, pre2f = 0.f, suf2b = 0.f;
#pragma unroll
        for (int q = 0; q < 4; ++q) { const float pf = PT[q * 128 + d], pb = PT[(4 + q) * 128 + d]; totf += pf; totb += pb; if (q < qr) offf += pf; if (q > qr) offb += pb; if (q < 2) pre2f += pf; if (q >= 2) suf2b += pb; }
        const float bmf = pre2f + PT[1024 + d], bmb = suf2b + PT[1024 + 128 + d];
#pragma unroll
        for (int j = 0; j < 16; ++j) { Bf[j] += offf; Bb[j] += offb; }
        f32x4 oacc[2][4];
#pragma unroll
        for (int x = 0; x < 2; ++x)
#pragma unroll
            for (int y = 0; y < 4; ++y) oacc[x][y] = (f32x4){0.f, 0.f, 0.f, 0.f};
#pragma unroll
        for (int dir = 0; dir < 2; ++dir) {
            const float bm = dir ? bmb : bmf, bl = dir ? totb : totf; const float ebm = __expf(bm), ebl = __expf(bl - bm);
            bf16_t* QHT = wsp<bf16_t>(F.ws, gla_dir(A_QHAT, dir)) + tile * 8192; bf16_t* K2T = wsp<bf16_t>(F.ws, gla_dir(A_K2T, dir)) + tile * 8192;
            unsigned k2pk[8];
#pragma unroll
            for (int j = 0; j < 16; ++j) { const float bv = dir ? Bb[j] : Bf[j]; const float e1 = __expf(bv - bm), r1 = __builtin_amdgcn_rcpf(e1);
                const float qs = bf2f(qraw[j]) * GLA_QSCALE, kk = bf2f(kraw[j]); const int tk = 16 * qr + j;
                const float qt = qs * e1, kt = kk * r1, qh = qt * ebm, k2 = kt * ebl;
                *(LAS bf16_t*)(QTt + tk * 272 + d * 2) = f2bf(qt); *(LAS bf16_t*)(KTt + tk * 272 + d * 2) = f2bf(kt); *(LAS bf16_t*)(QHl + tk * 272 + d * 2) = f2bf(qh);
                if (j & 1) k2pk[j >> 1] |= ((unsigned)f2bf(k2)) << 16; else k2pk[j >> 1] = (unsigned)f2bf(k2); }
            { bf16_t* kd = K2T + d * 64 + 16 * qr;
              *(u32x4*)kd = (u32x4){k2pk[0], k2pk[1], k2pk[2], k2pk[3]}; *(u32x4*)(kd + 8) = (u32x4){k2pk[4], k2pk[5], k2pk[6], k2pk[7]}; }
            if (qr == 0) DECS[((size_t)((b * 4 + h) * 2 + dir) * 32 + n) * 128 + d] = __expf(bl);
            __syncthreads();
#pragma unroll
            for (int i = 0; i < 2; ++i) { const int p = tid + 512 * i, row = p >> 4, c = p & 15; *(u32x4*)(QHT + row * 128 + c * 8) = *(const LAS u32x4*)(QHl + row * 272 + c * 16); }
            { const int ib = wave >> 1, jb0 = 2 * (wave & 1); f32x4 at[2] = {(f32x4){0.f, 0.f, 0.f, 0.f}, (f32x4){0.f, 0.f, 0.f, 0.f}};
#pragma unroll
              for (int s2 = 0; s2 < 4; ++s2) { const bf16x8 a = *(const LAS bf16x8*)(QTt + (16 * ib + fr) * 272 + (32 * s2 + 8 * fq) * 2);
#pragma unroll
                  for (int jj = 0; jj < 2; ++jj) { const bf16x8 bb = *(const LAS bf16x8*)(KTt + (16 * (jb0 + jj) + fr) * 272 + (32 * s2 + 8 * fq) * 2);
                      at[jj] = __builtin_amdgcn_mfma_f32_16x16x32_bf16(a, bb, at[jj], 0, 0, 0); } }
#pragma unroll
              for (int jj = 0; jj < 2; ++jj)
#pragma unroll
                  for (int r = 0; r < 4; ++r) { const int i = 16 * ib + 4 * fq + r, j = 16 * (jb0 + jj) + fr; const bool keep = dir ? (j > i) : (j <= i);
                      *(LAS bf16_t*)(ATT + i * 144 + j * 2) = f2bf(keep ? at[jj][r] : 0.f); } }
            __syncthreads();
#pragma unroll
            for (int s2 = 0; s2 < 2; ++s2) { bf16x8 bfr[4];
#pragma unroll
                for (int ib = 0; ib < 4; ++ib) bfr[ib] = *(const LAS bf16x8*)(ATT + (16 * ib + fr) * 144 + (32 * s2 + 8 * fq) * 2);
#pragma unroll
                for (int x = 0; x < 2; ++x) { const bf16x8 a = *(const LAS bf16x8*)(VTt + (16 * (2 * wave + x) + fr) * 144 + (32 * s2 + 8 * fq) * 2);
#pragma unroll
                    for (int ib = 0; ib < 4; ++ib) oacc[x][ib] = __builtin_amdgcn_mfma_f32_16x16x32_bf16(a, bfr[ib], oacc[x][ib], 0, 0, 0); } }
        }
#pragma unroll
        for (int x = 0; x < 2; ++x)
#pragma unroll
            for (int ib = 0; ib < 4; ++ib) { u32x2 w; w.x = pk2(oacc[x][ib][0], oacc[x][ib][1]); w.y = pk2(oacc[x][ib][2], oacc[x][ib][3]);
                *(u32x2*)(OF + (size_t)(T0 + 16 * ib + fr) * 1024 + h * 256 + 16 * (2 * wave + x) + 4 * fq) = w; }
    }
}

template <int DIR> __device__ __forceinline__ void gla_seq_job(const Frame& F, int b, int h, int vs) {
    const int tid = F.tid, lane = F.lane, wave = F.wave, fr = lane & 15, fq = lane >> 4;
    LAS unsigned char* ST0 = F.lds; LAS unsigned char* ST1 = F.lds + 17408;
    LAS unsigned char* BUF = F.lds + 34816;
    constexpr int BQ = 0, BK2 = 17408, BVT = 17408 + 18432, BSZ = 45056;
    const bf16_t* QHT = wsp<bf16_t>(F.ws, gla_dir(A_QHAT, DIR)); const bf16_t* K2T = wsp<bf16_t>(F.ws, gla_dir(A_K2T, DIR));
    const bf16_t* VT = wsp<bf16_t>(F.ws, A_VT1); const float* DECS = wsp<float>(F.ws, WS_DECS); bf16_t* OF = wsp<bf16_t>(F.ws, A_OF); bf16_t* O = DIR ? wsp<bf16_t>(F.ws, A_OB) : OF;
    const int dvb = wave >> 1, ib0 = 2 * (wave & 1);
    const size_t tile0 = (size_t)(b * 4 + h) * 32;
    const int q0 = tid, q1 = tid + 512;
    const int dq0 = BQ + (q0 >> 4) * 272 + (q0 & 15) * 16, dq1 = BQ + (q1 >> 4) * 272 + (q1 & 15) * 16;
    const int dk0 = BK2 + (q0 >> 3) * 144 + (q0 & 7) * 16, dk1 = BK2 + (q1 >> 3) * 144 + (q1 & 7) * 16;
    const int dv0 = BVT + (q0 >> 3) * 144 + (q0 & 7) * 16;
    u32x4 sg[5]; f32x4 dec, decn; u32x2 oold[2], ooldn[2];
#define GL_LD(n_) do { const size_t t_ = tile0 + (n_); \
        sg[0] = *(const u32x4*)(QHT + t_ * 8192 + q0 * 8); sg[1] = *(const u32x4*)(QHT + t_ * 8192 + q1 * 8); \
        sg[2] = *(const u32x4*)(K2T + t_ * 8192 + q0 * 8); sg[3] = *(const u32x4*)(K2T + t_ * 8192 + q1 * 8); \
        sg[4] = *(const u32x4*)(VT + t_ * 16384 + vs * 4096 + q0 * 8); \
        decn = *(const f32x4*)(DECS + ((size_t)((b * 4 + h) * 2 + DIR) * 32 + (n_)) * 128 + 16 * wave + 4 * fq); \
        if (!DIR) { _Pragma("unroll") for (int ii = 0; ii < 2; ++ii) ooldn[ii] = *(const u32x2*)(OF + (size_t)(b * SEQ + 64 * (n_) + 16 * (ib0 + ii) + fr) * 1024 + h * 256 + 64 * vs + 16 * dvb + 4 * fq); } } while (0)
#define GL_ST(bp) do { *(LAS u32x4*)((bp) + dq0) = sg[0]; *(LAS u32x4*)((bp) + dq1) = sg[1]; *(LAS u32x4*)((bp) + dk0) = sg[2]; *(LAS u32x4*)((bp) + dk1) = sg[3]; *(LAS u32x4*)((bp) + dv0) = sg[4]; } while (0)
    __syncthreads();
    for (int i = tid; i < 17408 / 4; i += 512) ((LAS unsigned*)ST0)[i] = 0u;
    f32x4 st[4];
#pragma unroll
    for (int k = 0; k < 4; ++k) st[k] = (f32x4){0.f, 0.f, 0.f, 0.f};
    GL_LD(DIR ? 31 : 0); GL_ST(BUF); dec = decn; oold[0] = ooldn[0]; oold[1] = ooldn[1];
    __syncthreads();
    for (int cc = 0; cc < 32; ++cc) { const int n = DIR ? 31 - cc : cc, nn = DIR ? 30 - cc : cc + 1; const int T0 = b * SEQ + 64 * n;
        LAS unsigned char* STr = (cc & 1) ? ST1 : ST0; LAS unsigned char* STw = (cc & 1) ? ST0 : ST1;
        LAS unsigned char* bc = BUF + (cc & 1) * BSZ; LAS unsigned char* bn = BUF + ((cc + 1) & 1) * BSZ;
        if (cc + 1 < 32) GL_LD(nn);
#pragma unroll
        for (int x = 0; x < 4; ++x) st[x] = st[x] * dec;
        f32x4 oo[2] = {(f32x4){0.f, 0.f, 0.f, 0.f}, (f32x4){0.f, 0.f, 0.f, 0.f}};
#pragma unroll
        for (int s2 = 0; s2 < 4; ++s2) { const bf16x8 a = *(const LAS bf16x8*)(STr + (16 * dvb + fr) * 272 + (32 * s2 + 8 * fq) * 2);
#pragma unroll
            for (int ii = 0; ii < 2; ++ii) { const bf16x8 qf = *(const LAS bf16x8*)(bc + BQ + (16 * (ib0 + ii) + fr) * 272 + (32 * s2 + 8 * fq) * 2);
                oo[ii] = __builtin_amdgcn_mfma_f32_16x16x32_bf16(a, qf, oo[ii], 0, 0, 0); } }
#pragma unroll
        for (int s2 = 0; s2 < 2; ++s2) { const bf16x8 kf = *(const LAS bf16x8*)(bc + BK2 + (16 * wave + fr) * 144 + (32 * s2 + 8 * fq) * 2);
#pragma unroll
            for (int x = 0; x < 4; ++x) { const bf16x8 vf = *(const LAS bf16x8*)(bc + BVT + (16 * x + fr) * 144 + (32 * s2 + 8 * fq) * 2);
                st[x] = __builtin_amdgcn_mfma_f32_16x16x32_bf16(kf, vf, st[x], 0, 0, 0); } }
#pragma unroll
        for (int x = 0; x < 4; ++x) { u32x2 w; w.x = pk2(st[x][0], st[x][1]); w.y = pk2(st[x][2], st[x][3]); *(LAS u32x2*)(STw + (16 * x + fr) * 272 + (16 * wave + 4 * fq) * 2) = w; }
#pragma unroll
        for (int ii = 0; ii < 2; ++ii) { f32x4 v = oo[ii];
            if (!DIR) { v[0] += bflo(oold[ii].x); v[1] += bfhi(oold[ii].x); v[2] += bflo(oold[ii].y); v[3] += bfhi(oold[ii].y); }
            u32x2 w; w.x = pk2(v[0], v[1]); w.y = pk2(v[2], v[3]);
            *(u32x2*)(O + (size_t)(T0 + 16 * (ib0 + ii) + fr) * 1024 + h * 256 + 64 * vs + 16 * dvb + 4 * fq) = w; }
        if (cc + 1 < 32) { GL_ST(bn); dec = decn; oold[0] = ooldn[0]; oold[1] = ooldn[1]; }
        __syncthreads(); }
#undef GL_LD
#undef GL_ST
}
__device__ __forceinline__ void phase_gla_main(const Frame& F) {
    for (int job = F.vcu; job < 256; job += F.G) { const int vs = job & 3, dir = (job >> 2) & 1, h = (job >> 3) & 3, b = job >> 5;
        if (dir) gla_seq_job<1>(F, b, h, vs); else gla_seq_job<0>(F, b, h, vs); }
}

__device__ __forceinline__ void phase_gla_post(const Frame& F) {
    const int gw = F.vcu * NWAVES + F.wave, lane = F.lane; const int c0 = 16 * lane;
    const bf16_t *OF = wsp<bf16_t>(F.ws, A_OF), *OB = wsp<bf16_t>(F.ws, A_OB), *P1 = wsp<bf16_t>(F.ws, A_P1); bf16_t* GO = wsp<bf16_t>(F.ws, A_GOUT);
    float gn[16];
#pragma unroll
    for (int i = 0; i < 16; ++i) gn[i] = F.in[31][(c0 + i) & 255];
    for (int tok = gw; tok < M_TOK; tok += F.G * NWAVES) { const size_t o = (size_t)tok * 1024 + c0;
        float v[16]; float ss = 0.f;
#pragma unroll
        for (int hh = 0; hh < 2; ++hh) { const u32x4 a = *(const u32x4*)(OF + o + 8 * hh), bq = *(const u32x4*)(OB + o + 8 * hh);
            v[8 * hh + 0] = bflo(a.x) + bflo(bq.x); v[8 * hh + 1] = bfhi(a.x) + bfhi(bq.x); v[8 * hh + 2] = bflo(a.y) + bflo(bq.y); v[8 * hh + 3] = bfhi(a.y) + bfhi(bq.y);
            v[8 * hh + 4] = bflo(a.z) + bflo(bq.z); v[8 * hh + 5] = bfhi(a.z) + bfhi(bq.z); v[8 * hh + 6] = bflo(a.w) + bflo(bq.w); v[8 * hh + 7] = bfhi(a.w) + bfhi(bq.w); }
#pragma unroll
        for (int i = 0; i < 16; ++i) ss += v[i] * v[i];
        ss = dpp_row_sum(ss);
        const float rs = 1.0f / sqrtf(ss * (1.f / 256.f) + NORM_EPS);
        float og[16];
#pragma unroll
        for (int hh = 0; hh < 2; ++hh) { const u32x4 g = *(const u32x4*)(P1 + (size_t)tok * O_INP + 2048 + c0 + 8 * hh);
            og[8 * hh + 0] = bflo(g.x); og[8 * hh + 1] = bfhi(g.x); og[8 * hh + 2] = bflo(g.y); og[8 * hh + 3] = bfhi(g.y); og[8 * hh + 4] = bflo(g.z); og[8 * hh + 5] = bfhi(g.z); og[8 * hh + 6] = bflo(g.w); og[8 * hh + 7] = bfhi(g.w); }
        float r[16];
#pragma unroll
        for (int i = 0; i < 16; ++i) r[i] = v[i] * rs * gn[i] * siluf_(og[i]);
#pragma unroll
        for (int hh = 0; hh < 2; ++hh) { u32x4 w; w.x = pk2(r[8 * hh + 0], r[8 * hh + 1]); w.y = pk2(r[8 * hh + 2], r[8 * hh + 3]); w.z = pk2(r[8 * hh + 4], r[8 * hh + 5]); w.w = pk2(r[8 * hh + 6], r[8 * hh + 7]);
            *(u32x4*)(GO + o + 8 * hh) = w; } }
}

__device__ __forceinline__ void phase_route(const Frame& F) {
    const int tid = F.tid, lane = F.lane, wave = F.wave;
    LAS int* lcnt = (LAS int*)(F.lds + MOE_OFF);
    LAS float* RL = (LAS float*)F.lds;
    __syncthreads();
    if (tid < 16) lcnt[tid] = 0;
    const float* X = F.out; const float* g2 = F.in[33]; const float* RT = F.in[34];
    for (int i = tid; i < 2048; i += 512) { const int k = i >> 1; const f32x4 r = *(const f32x4*)(RT + (size_t)i * 4); *(LAS f32x4*)(RL + i * 4) = r * g2[k]; }
    __syncthreads();
    int* TE = wsp<int>(F.ws, WS_TOKE); float* TG = wsp<float>(F.ws, WS_TOKG); float* R3 = wsp<float>(F.ws, WS_RSTD3);
    const int tpb = M_TOK / F.G, tpw = tpb / NWAVES;
    for (int i0 = 0; i0 < tpw; i0 += 4) { const int tok0 = F.vcu * tpb + wave * tpw + i0;
        float acc[4][8], ss[4];
#pragma unroll
        for (int t = 0; t < 4; ++t) { ss[t] = 0.f;
#pragma unroll
            for (int e = 0; e < 8; ++e) acc[t][e] = 0.f; }
#pragma unroll
        for (int j = 0; j < 4; ++j) { const int k0 = 4 * lane + 256 * j; f32x4 xv[4];
#pragma unroll
            for (int t = 0; t < 4; ++t) xv[t] = *(const f32x4*)(X + (size_t)(tok0 + t) * 1024 + k0);
#pragma unroll
            for (int q = 0; q < 4; ++q) { const f32x4 r0 = *(const LAS f32x4*)(RL + (k0 + q) * 8), r1 = *(const LAS f32x4*)(RL + (k0 + q) * 8 + 4);
#pragma unroll
                for (int t = 0; t < 4; ++t) { const float xx = xv[t][q]; ss[t] += xx * xx;
                    acc[t][0] += xx * r0[0]; acc[t][1] += xx * r0[1]; acc[t][2] += xx * r0[2]; acc[t][3] += xx * r0[3]; acc[t][4] += xx * r1[0]; acc[t][5] += xx * r1[1]; acc[t][6] += xx * r1[2]; acc[t][7] += xx * r1[3]; } } }
#pragma unroll
        for (int t = 0; t < 4; ++t) { ss[t] = wave_sum(ss[t]);
#pragma unroll
            for (int e = 0; e < 8; ++e) acc[t][e] = wave_sum(acc[t][e]); }
        float lg[8]; float mss = 0.f;
#pragma unroll
        for (int t = 0; t < 4; ++t) { if (lane == t) { mss = ss[t];
#pragma unroll
                for (int e = 0; e < 8; ++e) lg[e] = acc[t][e]; } }
        if (lane < 4) { const int tok = tok0 + lane;
            const float rstd = 1.0f / sqrtf(mss * (1.f / 1024.f) + NORM_EPS);
            int i1 = 0; float l1 = lg[0] * rstd;
#pragma unroll
            for (int e = 1; e < 8; ++e) { const float l = lg[e] * rstd; if (l > l1) { l1 = l; i1 = e; } }
            int i2 = -1; float l2 = -3.0e38f;
#pragma unroll
            for (int e = 0; e < 8; ++e) { const float l = lg[e] * rstd; if (e != i1 && l > l2) { l2 = l; i2 = e; } }
            const float e2 = __expf(l2 - l1); const float ga = 1.f / (1.f + e2), gb = e2 / (1.f + e2);
            TE[tok * 2] = i1; TE[tok * 2 + 1] = i2; TG[tok * 2] = ga; TG[tok * 2 + 1] = gb; R3[tok] = rstd;
            atomicAdd((int*)&lcnt[i1], 1); atomicAdd((int*)&lcnt[8 + i2], 1); } }
    __syncthreads();
    if (tid < 16) wsp<int>(F.ws, WS_CNT)[F.vcu * 16 + tid] = lcnt[tid];
}
__device__ __forceinline__ void phase_place(const Frame& F) {
    const int tid = F.tid;
    LAS int* tab = (LAS int*)(F.lds + MOE_OFF);
    LAS int* C = (LAS int*)F.lds;
    LAS int* TEl = (LAS int*)(F.lds + 32768); LAS float* TGl = (LAS float*)(F.lds + 32768 + 1024);
    const int* CNT = wsp<int>(F.ws, WS_CNT); const int tpb = M_TOK / F.G;
    __syncthreads();
    for (int i = tid; i < F.G * 16; i += 512) C[i] = CNT[i];
    if (tid < 2 * tpb) { TEl[tid] = wsp<int>(F.ws, WS_TOKE)[F.vcu * tpb * 2 + tid]; TGl[tid] = wsp<float>(F.ws, WS_TOKG)[F.vcu * tpb * 2 + tid]; }
    __syncthreads();
    if (tid < 16) { int off = 0, tot = 0; for (int bb = 0; bb < F.G; ++bb) { const int c = C[bb * 16 + tid]; if (bb < F.vcu) off += c; tot += c; } tab[tid] = off; tab[16 + tid] = tot;
        if (F.vcu == 0) wsp<int>(F.ws, WS_TOT)[tid] = tot; }
    __syncthreads();
    if (tid < 16) { const int s = tid >> 3, e = tid & 7; int run = tab[tid]; for (int q = 0; q < e; ++q) run += tab[16 + q] + tab[24 + q];
        if (s) run += tab[16 + e];
        int* RTK = wsp<int>(F.ws, WS_ROWTOK); float* RGT = wsp<float>(F.ws, WS_ROWGATE);
        for (int i = 0; i < tpb; ++i) { if (TEl[i * 2 + s] == e) { RTK[run] = F.vcu * tpb + i; RGT[run] = TGl[i * 2 + s]; ++run; } } }
}
struct MoESched {
    pg8::GridOrder go; const LAS int* tab;
    const char* A; const char* Bt; size_t a_rowbytes, b_expert_bytes, b_tile_bytes; bool gather; int nt_;
    __device__ bool next(int i, pg8::Unit& u) const {
        int pm, pn; if (!go.tile(i, pm, pn)) return false;
        int e = 0;
#pragma unroll
        for (int q = 1; q < 8; ++q) if (pm >= tab[16 + q]) e = q;
        e = __builtin_amdgcn_readfirstlane(e);
        const int mt = pm - __builtin_amdgcn_readfirstlane(tab[16 + e]); const int row0 = __builtin_amdgcn_readfirstlane(tab[e]) + 256 * mt; int nr = __builtin_amdgcn_readfirstlane(tab[8 + e]) - 256 * mt; nr = nr > 256 ? 256 : nr;
        u.pm = pm; u.pn = pn; u.e = e; u.row0 = row0; u.nrows = nr; u.nt = nt_; u.flags = 0;
        u.a = gather ? A : A + (size_t)row0 * a_rowbytes; u.b = Bt + (size_t)e * b_expert_bytes + (size_t)pn * b_tile_bytes; return true;
    }
};
struct MoEDownSched {
    const LAS int* tab; const char* A; const char* Bt; int nmt, c, round;
    __device__ void fill(pg8::Unit& u, int pm, int pn, int kp, int nt, int flags) const {
        int e = 0;
#pragma unroll
        for (int q = 1; q < 8; ++q) if (pm >= tab[16 + q]) e = q;
        e = __builtin_amdgcn_readfirstlane(e);
        const int mt = pm - __builtin_amdgcn_readfirstlane(tab[16 + e]); const int row0 = __builtin_amdgcn_readfirstlane(tab[e]) + 256 * mt; int nr = __builtin_amdgcn_readfirstlane(tab[8 + e]) - 256 * mt; nr = nr > 256 ? 256 : nr;
        u.pm = pm; u.pn = pn; u.e = e; u.row0 = row0; u.nrows = nr; u.nt = nt; u.flags = flags;
        u.a = A + (size_t)row0 * (D_FFE * 2) + (size_t)kp * 896 * 2; u.b = Bt + (size_t)e * ((size_t)1024 * D_FFE * 2) + (size_t)pn * ((size_t)256 * D_FFE * 2) + (size_t)kp * 896 * 2;
    }
    __device__ bool next(int i, pg8::Unit& u) const {
        if (i != 0) return false;
        if (round == 0) { const int pm = 8 * (c & 7) + ((c >> 3) & 7), pn = c >> 6; if (pm >= nmt) return false; fill(u, pm, pn, 0, D_FFE / 64, 0); return true; }
        { const int t = c >> 2, kp = c & 3; const int pm = 64 + (t >> 2), pn = t & 3; if (pm >= nmt) return false; fill(u, pm, pn, kp, 14, 1 + c); return true; }
        return false;
    }
};
__device__ __forceinline__ int moe_table(const Frame& F, int mode) {
    LAS int* tab = (LAS int*)(F.lds + MOE_OFF);
    __syncthreads();
    if (F.tid == 0) { const int* TOT = wsp<int>(F.ws, WS_TOT); int rs = 0, ts = 0;
        for (int e = 0; e < 8; ++e) { const int c0 = TOT[e], c1 = TOT[8 + e]; const int st = rs + (mode == 1 ? c0 : 0), c = mode == 0 ? c0 : (mode == 1 ? c1 : c0 + c1);
            tab[e] = st; tab[8 + e] = c; tab[16 + e] = ts; rs += c0 + c1; ts += (c + 255) >> 8; }
        tab[24] = ts; }
    __syncthreads();
    return __builtin_amdgcn_readfirstlane(tab[24]);
}

constexpr size_t A_PART = A_WEGU;
__device__ __forceinline__ void moe_tail_reduce(const Frame& F, int s) {
    const int nmt = moe_table(F, s); const LAS int* tab = (const LAS int*)(F.lds + MOE_OFF);
    const int R = (nmt - 64) * 4; const int gw = F.vcu * NWAVES + F.wave, lane = F.lane;
    const float* part = wsp<float>(F.ws, A_PART + (size_t)s * 32 * MiB); const int* RTK = wsp<int>(F.ws, WS_ROWTOK); const float* RGT = wsp<float>(F.ws, WS_ROWGATE);
    for (int idx = gw; idx < R * 256; idx += F.G * NWAVES) { const int t = idx >> 8, r = idx & 255; const int pm = 64 + (t >> 2), pn = t & 3;
        int e = 0;
#pragma unroll
        for (int q = 1; q < 8; ++q) if (pm >= tab[16 + q]) e = q;
        const int mt = pm - tab[16 + e]; const int row0 = tab[e] + 256 * mt; const int nr = tab[8 + e] - 256 * mt;
        if (r < nr) { const int tok = RTK[row0 + r] & 16383; const float gt = RGT[row0 + r];
            f32x4 a = {0.f, 0.f, 0.f, 0.f};
#pragma unroll
            for (int kp = 0; kp < 4; ++kp) a += *(const f32x4*)(part + ((size_t)(t * 4 + kp) * 256 + r) * 256 + 4 * lane);
            float* op = F.out + (size_t)tok * 1024 + 256 * pn + 4 * lane; f32x4 o = *(const f32x4*)op; o += a * gt; *(f32x4*)op = o; } }
}

constexpr int N_PHASES = 21;
__global__ void __launch_bounds__(NWAVES * 64, 2) mk_fwd(Args args) {
    extern __shared__ __attribute__((aligned(16))) unsigned char lds_raw[];
    Frame F; F.lds = (LAS unsigned char*)lds_raw; F.ws = args.ws; F.in = args.in; F.out = args.out;
    F.tid = threadIdx.x; F.lane = F.tid & 63; F.wave = __builtin_amdgcn_readfirstlane(F.tid >> 6);
    F.G = gridDim.x; { const int bx = blockIdx.x; F.vcu = (F.G % 8 == 0) ? (bx % 8) * (F.G / 8) + bx / 8 : bx; }
    volatile LAS unsigned* MISC = (volatile LAS unsigned*)(F.lds + MISC_OFF);
    if (F.tid < 64) MISC[F.tid] = 0u;
    __syncthreads();
    XcdBarrier bar; bar.bar = (unsigned*)(args.ws + WS_CTL) + CW_BAR; bar.x = 0; bar.st = nullptr;
    const int lo = args.ph_lo, hi = args.ph_hi;
    const bool multi = (hi - lo) > 1;
    if (multi) bar = xcd_barrier_post((unsigned*)(args.ws + WS_CTL) + CW_BAR, MISC + 8);
#ifdef PH_ONLY
#define IN(k) ((k) == PH_ONLY && lo <= (k) && (k) < hi)
#else
#define IN(k) (lo <= (k) && (k) < hi)
#endif
#define SEAM(k) do { if (IN(k) && IN((k) + 1)) xcd_barrier(bar); } while (0)
    unsigned char* ws = args.ws; const int cid = (int)blockIdx.x;
#define REFRESH() do { int t_ = threadIdx.x; asm volatile("" : "+v"(t_)); F.tid = t_; F.lane = t_ & 63; F.wave = __builtin_amdgcn_readfirstlane(t_ >> 6); unsigned long long w_ = (unsigned long long)args.ws; asm volatile("" : "+s"(w_)); F.ws = (unsigned char*)w_; ws = F.ws; } while (0)
    LAS unsigned char* ring = F.lds;

#ifndef MK_REP_MASK
#define MK_REP_MASK 0u
#endif
#define REPS(k) ((int)(((unsigned)(MK_REP_MASK) >> (k)) & 1u))
#define PHASE(k, ...) do { if (IN(k)) { for (int rep_ = 0; rep_ <= REPS(k); ++rep_) { if (rep_) xcd_barrier(bar); REFRESH(); __VA_ARGS__ } } SEAM(k); } while (0)
    PHASE(0, phase_prologue(F););
    PHASE(1, {
        pg8::DenseSched S; S.init(wsp<bf16_t>(ws, WS_XB), wsp<bf16_t>(ws, WS_WIN0), M_TOK, E_IN, 1024, F.G, cid);
        EpiScaleBf16 E{wsp<bf16_t>(ws, A_P0), E_IN, wsp<float>(ws, WS_SSQ0)};
        pg8::gemm_phase<EpiScaleBf16, pg8::DenseSched, false>(F.tid, ring, 1024, S, E, nullptr);
        if (F.G == 256 && cid >= 128 && rep_ == 0) { REFRESH(); conv_group(F, 1, (cid - 128) * NWAVES + F.wave, 128 * NWAVES); } });
    PHASE(2, phase_prep0(F););
    PHASE(3, {
        pg8::DenseSched S; S.init(wsp<bf16_t>(ws, A_AP), wsp<bf16_t>(ws, WS_WLR), M_TOK, 2560, 256, F.G, cid);
        EpiLowRank E{ws, F.in};
        pg8::gemm_phase<EpiLowRank, pg8::DenseSched, false>(F.tid, ring, 256, S, E, nullptr); });
#ifndef MK_REP_SUB
#define MK_REP_SUB 0u
#endif
    PHASE(4, phase_scan(F););
    PHASE(5, phase_rwkv_post(F););
    PHASE(6, {
        pg8::DenseSched S; S.init(wsp<bf16_t>(ws, A_YCAT), wsp<bf16_t>(ws, WS_WOUT0), M_TOK, 1024, 1024, F.G, cid);
        EpiResidBf E{rep_ ? wsp<bf16_t>(ws, A_YF) : wsp<bf16_t>(ws, WS_XB), nullptr, rep_ ? wsp<float>(ws, WS_SSQ0) : wsp<float>(ws, WS_SSQ1)};
        pg8::gemm_phase<EpiResidBf, pg8::DenseSched, false>(F.tid, ring, 1024, S, E, nullptr); });
    PHASE(7, {
        pg8::DenseSched S; S.init(wsp<bf16_t>(ws, WS_XB), wsp<bf16_t>(ws, WS_WGU0), M_TOK, 2 * D_FF, 1024, F.G, cid);
        EpiSwiGLU E{wsp<bf16_t>(ws, A_HID0), D_FF, wsp<float>(ws, WS_SSQ1)};
        pg8::gemm_phase<EpiSwiGLU, pg8::DenseSched, false>(F.tid, ring, 1024, S, E, nullptr);
        if (F.G == 256 && cid >= 128 && rep_ == 0) { REFRESH(); conv_group(F, 2, (cid - 128) * NWAVES + F.wave, 128 * NWAVES); } });
    PHASE(8, {
        pg8::DenseSched S; S.init(wsp<bf16_t>(ws, A_HID0), wsp<bf16_t>(ws, WS_WD0), M_TOK, 1024, D_FF, F.G, cid);
        EpiResidBf E{rep_ ? wsp<bf16_t>(ws, A_YF) : wsp<bf16_t>(ws, WS_XB), nullptr, rep_ ? wsp<float>(ws, WS_SSQ0) : wsp<float>(ws, WS_SSQ2)};
        pg8::gemm_phase<EpiResidBf, pg8::DenseSched, false>(F.tid, ring, D_FF, S, E, nullptr); });
    PHASE(9, {
        pg8::DenseSched S; S.init(wsp<bf16_t>(ws, WS_XB), wsp<bf16_t>(ws, WS_WIN1), M_TOK, O_INP, 1024, F.G, cid);
        EpiScaleBf16 E{wsp<bf16_t>(ws, A_P1), O_INP, wsp<float>(ws, WS_SSQ2)};
        pg8::gemm_phase<EpiScaleBf16, pg8::DenseSched, false>(F.tid, ring, 1024, S, E, nullptr); });
    PHASE(10, phase_gla_prep(F););
    PHASE(11, phase_gla_main(F););
    PHASE(12, phase_gla_post(F););
    PHASE(13, {
        pg8::DenseSched S; S.init(wsp<bf16_t>(ws, A_GOUT), wsp<bf16_t>(ws, WS_WOUT1), M_TOK, 1024, 1024, F.G, cid);
        EpiResidBf E{rep_ ? wsp<bf16_t>(ws, A_QT) : wsp<bf16_t>(ws, WS_XB), rep_ ? wsp<float>(ws, A_OF) : F.out, nullptr};
        pg8::gemm_phase<EpiResidBf, pg8::DenseSched, false>(F.tid, ring, 1024, S, E, nullptr); });
    PHASE(14, for (int q_ = 0; q_ <= (int)(((MK_REP_SUB) >> 2) & 1u); ++q_) { phase_route(F); __syncthreads(); REFRESH(); }
              for (int q_ = 0; q_ <= (int)(((MK_REP_SUB) >> 3) & 1u); ++q_) { phase_conv_experts(F); __syncthreads(); REFRESH(); });
    PHASE(15, phase_place(F););
    PHASE(16, {
        const int nmt = moe_table(F, 2);
        MoESched S; S.go.init(nmt, 2 * D_FFE / 256, F.G, cid); S.tab = (const LAS int*)(F.lds + MOE_OFF);
        S.A = (const char*)wsp<bf16_t>(ws, WS_XB); S.Bt = (const char*)wsp<bf16_t>(ws, A_WEGU); S.a_rowbytes = 0; S.b_expert_bytes = (size_t)2 * D_FFE * 1024 * 2; S.b_tile_bytes = (size_t)256 * 1024 * 2; S.gather = true; S.nt_ = 16;
        const int* rtk = wsp<int>(ws, WS_ROWTOK);
        EpiSwiGLUMoE E{wsp<bf16_t>(ws, A_HID1), wsp<float>(ws, WS_RSTD3), rtk};
        pg8::gemm_phase<EpiSwiGLUMoE, MoESched, true>(F.tid, ring, 1024, S, E, rtk); });
#pragma unroll 1
    for (int s = 0; s < 2; ++s) {
        PHASE(17 + s, {
            const int nmt = moe_table(F, s);
            MoEDownSched S; S.tab = (const LAS int*)(F.lds + MOE_OFF); S.A = (const char*)wsp<bf16_t>(ws, A_HID1); S.Bt = (const char*)wsp<bf16_t>(ws, A_WED); S.nmt = nmt; S.c = cid; S.round = 0;
            EpiMoEDown E{F.out, wsp<int>(ws, WS_ROWTOK), wsp<float>(ws, WS_ROWGATE)};
            pg8::gemm_phase<EpiMoEDown, MoEDownSched, false>(F.tid, ring, D_FFE, S, E, nullptr);
            REFRESH(); S.round = 1; EpiPart EP{wsp<float>(ws, A_PART + (size_t)s * 32 * MiB)};
            pg8::gemm_phase<EpiPart, MoEDownSched, false>(F.tid, ring, D_FFE, S, EP, nullptr); });
    }
    PHASE(19, moe_tail_reduce(F, 0););
    PHASE(20, moe_tail_reduce(F, 1););
#undef PHASE
#undef REPS
#undef IN
#undef SEAM
}

extern "C" void kernel_launch(void* const* d_in, const int* in_sizes, int n_in, void* d_out, int out_size, void* d_ws, size_t ws_size, hipStream_t stream) {
    static int grid = 0;
    if (grid == 0) {
        if (n_in != 38 || out_size != M_TOK * D_MODEL || ws_size < WS_END) { fprintf(stderr, "kernel_launch: unexpected shapes: n_in %d out %d ws %zu (need %zu)\n", n_in, out_size, ws_size, (size_t)WS_END); grid = -1; return; }
        int dev = 0, cus = 0;
        if (hipGetDevice(&dev) != hipSuccess || hipDeviceGetAttribute(&cus, hipDeviceAttributeMultiprocessorCount, dev) != hipSuccess) { grid = -1; return; }
        if (hipFuncSetAttribute((const void*)mk_fwd, hipFuncAttributeMaxDynamicSharedMemorySize, LDS_BYTES) != hipSuccess) { fprintf(stderr, "kernel_launch: hipFuncSetAttribute failed\n"); grid = -1; return; }
        (void)hipGetLastError();
        grid = cus;
        if (grid != 256) fprintf(stderr, "kernel_launch: note: %d CUs (built for 256)\n", grid);
    }
    if (grid < 0) return;
    (void)hipMemsetAsync((char*)d_ws + WS_CTL, 0, CTL_ZERO_BYTES, stream);
    Args a{};
    for (int i = 0; i < 38; ++i) a.in[i] = (const float*)d_in[i];
    a.out = (float*)d_out; a.ws = (unsigned char*)d_ws;
#if MK_N_LAUNCHES == 1
    a.ph_lo = 0; a.ph_hi = N_PHASES - 1 + 0;
    a.ph_hi = 21;
    hipLaunchKernelGGL(mk_fwd, dim3(grid), dim3(NWAVES * 64), LDS_BYTES, stream, a);
#else
#ifndef MK_LAST_PHASE
#define MK_LAST_PHASE 20
#endif
    for (int p = 0; p < MK_LAST_PHASE; ++p) { a.ph_lo = p; a.ph_hi = p + 1; hipLaunchKernelGGL(mk_fwd, dim3(grid), dim3(NWAVES * 64), LDS_BYTES, stream, a); }
#endif
}
```

```cpp
#include <hip/hip_runtime.h>
#include <cstdio>
#include <cstdint>

#ifndef MK_N_LAUNCHES
#define MK_N_LAUNCHES 1
#define MK_REP_MASK 0u
#define MK_REP_SUB 0u
#endif

#define GAS __attribute__((address_space(1)))
#define LAS __attribute__((address_space(3)))
typedef unsigned short bf16_t;
typedef short bf16x8 __attribute__((ext_vector_type(8)));
typedef short bf16x4 __attribute__((ext_vector_type(4)));
typedef float f32x4 __attribute__((ext_vector_type(4)));
typedef float f32x2 __attribute__((ext_vector_type(2)));
typedef float f32x16 __attribute__((ext_vector_type(16)));
typedef unsigned u32x4 __attribute__((ext_vector_type(4)));
typedef unsigned u32x2 __attribute__((ext_vector_type(2)));
typedef __bf16 bf16x2_t __attribute__((ext_vector_type(2)));

constexpr int D_MODEL = 1024, BATCH = 8, SEQ = 2048, M_TOK = BATCH * SEQ;
constexpr int HD = 64;
constexpr int RW_HEADS = 8, RW_DIM = 512, RW_IN = 1792;
constexpr int ATT_HEADS = 8, ATT_KV = 2;
constexpr int E_IN = 2560;
constexpr int GLA_H = 4, GLA_DK = 512, GLA_DV = 1024, GLA_DKH = 128, GLA_DVH = 256, GLA_R = 16;
constexpr int O_IN = 3088, O_INP = 3328;
constexpr int D_FF = 2816, NEXP = 8, D_FFE = 3584;
constexpr float NORM_EPS = 1e-6f;

constexpr size_t MiB = 1u << 20;
constexpr size_t WS_CTL = 0, CTL_ZERO_BYTES = 1 * MiB;
constexpr size_t WS_SSQ0 = 1 * MiB, WS_SSQ1 = 2 * MiB, WS_SSQ2 = 3 * MiB;
constexpr size_t WS_RSTD3 = 4 * MiB;
constexpr size_t WS_TOKE = WS_RSTD3 + 65536;
constexpr size_t WS_TOKG = WS_TOKE + 131072;
constexpr size_t WS_CNT = WS_TOKG + 131072;
constexpr size_t WS_TOT = WS_CNT + 16384;
constexpr size_t WS_ROWTOK = WS_TOT + 256;
constexpr int ROWS_PER_SLOT = M_TOK + 256;
constexpr size_t WS_ROWGATE = WS_ROWTOK + (size_t)2 * ROWS_PER_SLOT * 4;
constexpr size_t WS_DECS = 6 * MiB;
constexpr size_t WS_ROPE = 7 * MiB;
constexpr size_t WS_XB = 8 * MiB;
constexpr size_t WS_WIN0 = 40 * MiB, WS_WLR = 45 * MiB, WS_WOUT0 = 47 * MiB, WS_WGU0 = 49 * MiB, WS_WD0 = 60 * MiB, WS_WIN1 = 66 * MiB, WS_WOUT1 = 73 * MiB;
constexpr size_t AR = 75 * MiB;
constexpr size_t A_P0 = AR + 0, A_RS = AR + 80 * MiB, A_KS = AR + 96 * MiB, A_VS = AR + 112 * MiB, A_NKK = AR + 128 * MiB, A_AP = AR + 144 * MiB;
constexpr size_t A_QH = AR + 152 * MiB, A_KH = AR + 168 * MiB, A_VT0 = AR + 172 * MiB;
constexpr size_t A_LWF = AR + 176 * MiB, A_LWB = AR + 192 * MiB, A_KDF = AR + 208 * MiB, A_KDB = AR + 224 * MiB, A_BBF = AR + 240 * MiB, A_BBB = AR + 256 * MiB;
constexpr size_t A_GG = AR + 272 * MiB, A_YF = AR + 0 * MiB, A_YB = AR + 16 * MiB, A_YCAT = AR + 32 * MiB;
constexpr size_t A_HID0 = AR + 0;
constexpr size_t A_P1 = AR + 0;
constexpr size_t A_QT = AR + 104 * MiB, A_KT = AR + 120 * MiB, A_QHAT = AR + 136 * MiB, A_K2T = AR + 152 * MiB;
constexpr size_t GLA_DIR_STRIDE = 64 * MiB;
constexpr size_t A_VT1 = AR + 232 * MiB, A_OF = AR + 264 * MiB, A_OB = AR + 296 * MiB, A_GOUT = AR + 168 * MiB;
constexpr size_t A_WEGU = 40 * MiB, A_WED = 404 * MiB, A_HID1 = 152 * MiB;
constexpr int ROWS_ALL = 2 * M_TOK + 256;
constexpr size_t WS_END = 460 * MiB;
static_assert(A_HID1 + (size_t)ROWS_ALL * D_FFE * 2 <= A_WED && A_WED + (size_t)NEXP * 1024 * D_FFE * 2 <= WS_END && A_WED >= AR + 328 * MiB && 2 * ROWS_PER_SLOT >= ROWS_ALL, "ws map");
static_assert(A_GOUT + 32 * MiB <= A_VT1 && A_YCAT + 32 * MiB <= A_RS, "ws map");

constexpr int CW_BAR = 4096;

constexpr int RING_BYTES = 131072;
constexpr int LDS_BYTES = 147456;
constexpr int MISC_OFF = LDS_BYTES - 512;
constexpr int MOE_OFF = LDS_BYTES - 256;

__device__ __forceinline__ unsigned pk2(float lo, float hi) { f32x2 v = {lo, hi}; bf16x2_t b = __builtin_convertvector(v, bf16x2_t); return __builtin_bit_cast(unsigned, b); }
__device__ __forceinline__ bf16_t f2bf(float f) { return (bf16_t)(pk2(f, 0.f) & 0xffffu); }
__device__ __forceinline__ float bf2f(bf16_t h) { return __uint_as_float(((unsigned)h) << 16); }
__device__ __forceinline__ float bflo(unsigned w) { return __uint_as_float(w << 16); }
__device__ __forceinline__ float bfhi(unsigned w) { return __uint_as_float(w & 0xffff0000u); }
__device__ __forceinline__ float wave_sum(float v) {
#pragma unroll
    for (int o = 1; o < 64; o <<= 1) v += __shfl_xor(v, o);
    return v;
}
__device__ __forceinline__ float sigmoidf_(float x) { return 1.f / (1.f + __expf(-x)); }
__device__ __forceinline__ float siluf_(float x) { return x / (1.f + __expf(-x)); }
#define LDS_WAIT() asm volatile("s_waitcnt lgkmcnt(0)" ::: "memory")
#define VM_WAIT() asm volatile("s_waitcnt vmcnt(0)" ::: "memory")

#define XB_TMO      128
#define XB_XCNT(j)  (256  + 64 * (j))
#define XB_XSUB(j)  (1280 + 64 * (j))
#define XB_XGEN(j)  (2304 + 64 * (j))
#define XB_TOP      3328
#define XB_TOPGEN   3392
#define XCD_BAR_WORDS 3456
#define XB_SPIN_CAP (1u << 20)
__device__ __forceinline__ unsigned xb_ld(unsigned* p)              { return __hip_atomic_load(p, __ATOMIC_RELAXED, __HIP_MEMORY_SCOPE_AGENT); }
__device__ __forceinline__ unsigned xb_add(unsigned* p, unsigned v) { return __hip_atomic_fetch_add(p, v, __ATOMIC_RELAXED, __HIP_MEMORY_SCOPE_AGENT); }
__device__ __forceinline__ unsigned xb_xcc_id() { return (unsigned)__builtin_amdgcn_s_getreg((3 << 11) | 20) & 0xFu; }
#define XB_SPIN(cond, bar) do { unsigned _sp = 0; while (cond) { __builtin_amdgcn_s_sleep(1); \
    if ((++_sp & 255u) == 0u) { if (xb_ld(&(bar)[XB_TMO])) break; if (_sp > XB_SPIN_CAP) { atomicAdd(&(bar)[XB_TMO], 1u); break; } } } } while (0)
struct XcdBarrier { unsigned* bar; unsigned x; volatile LAS unsigned* st; };
__device__ __forceinline__ XcdBarrier xcd_barrier_post(unsigned* bar, volatile LAS unsigned* st) {
    XcdBarrier b; b.bar = bar; b.x = xb_xcc_id(); b.st = st;
    if (threadIdx.x == 0) (void)xb_add(&bar[XB_XCNT(b.x)], 1u);
    return b;
}
__device__ __forceinline__ void xcd_barrier_complete(unsigned* bar, unsigned x, unsigned& nloc, unsigned& nx) {
    const unsigned G = gridDim.x * gridDim.y * gridDim.z;
    unsigned sum, cnt, mine, sp = 0u;
    for (;;) {
        sum = 0u; cnt = 0u; mine = 0u;
#pragma unroll
        for (unsigned j = 0; j < 16; ++j) { const unsigned c = xb_ld(&bar[XB_XCNT(j)]); sum += c; cnt += (c > 0u) ? 1u : 0u; mine = (j == x) ? c : mine; }
        if (sum == G) break;
        __builtin_amdgcn_s_sleep(1);
        if ((++sp & 255u) == 0u) { if (xb_ld(&bar[XB_TMO])) break; if (sp > XB_SPIN_CAP) { atomicAdd(&bar[XB_TMO], 1u); break; } }
    }
    nloc = mine > 0u ? mine : 1u; nx = cnt > 0u ? cnt : 1u;
}
__device__ __forceinline__ void xcd_barrier(const XcdBarrier& b) {
    asm volatile("s_waitcnt vmcnt(0)" ::: "memory");
    __syncthreads();
    if (threadIdx.x == 0) {
        unsigned* bar = b.bar;
        __builtin_amdgcn_s_waitcnt(0);
        unsigned nloc = b.st[0], nx = b.st[1];
        if (nloc == 0u) { xcd_barrier_complete(bar, b.x, nloc, nx); b.st[0] = nloc; b.st[1] = nx; }
        const unsigned old = xb_add(&bar[XB_XSUB(b.x)], 1u);
        const unsigned gen = old / nloc;
        if (old + 1u == (gen + 1u) * nloc) {
            __builtin_amdgcn_fence(__ATOMIC_RELEASE, "agent");
            asm volatile("s_waitcnt vmcnt(0)" ::: "memory");
            const unsigned og = xb_add(&bar[XB_TOP], 1u);
            const unsigned tg = og / nx;
            if (og + 1u == (tg + 1u) * nx) xb_add(&bar[XB_TOPGEN], 1u);
            else XB_SPIN(xb_ld(&bar[XB_TOPGEN]) == tg, bar);
            __builtin_amdgcn_fence(__ATOMIC_ACQUIRE, "agent");
            xb_add(&bar[XB_XGEN(b.x)], 1u);
            asm volatile("s_waitcnt vmcnt(0)" ::: "memory");
        } else {
            XB_SPIN(xb_ld(&bar[XB_XGEN(b.x)]) == gen, bar);
            __builtin_amdgcn_fence(__ATOMIC_ACQUIRE, "agent");
            asm volatile("s_waitcnt vmcnt(0)" ::: "memory");
        }
    }
    __syncthreads();
}

namespace pg8 {
constexpr int BM = 256, BK = 64, HALF = 128, HTB = HALF * BK * 2, STAGE_BYTES = 8 * HTB, NXCD = 8, WGM = 4;
__host__ __device__ __forceinline__ int lds_byte(int r, int c) { const int st = (r >> 4) * 2 + (c >> 5), rr = r & 15, cc = c & 31, ob = rr * 64 + cc * 2; return st * 1024 + (ob ^ (((ob >> 9) & 1) << 5)); }
__host__ __device__ __forceinline__ void stage_rc(int b, int& R, int& C) { const int st = b / 1024, sb = b % 1024, swz = sb ^ (((sb >> 9) & 1) << 5); R = (st >> 1) * 16 + swz / 64; C = (st & 1) * 32 + (swz % 64) / 2; }
__host__ __device__ __forceinline__ int perm32(int rho) { const int n = rho >> 4, i = rho & 15; return 8 * (i >> 2) + 4 * n + (i & 3); }

struct Unit { const char* a; const char* b; int pm, pn; int row0, nrows, e; int nt, flags; };

struct GridOrder {
    int nM, nN, nwg, G, c;
    __device__ void init(int nM_, int nN_, int G_, int c_) { nM = nM_; nN = nN_; nwg = nM * nN; G = G_; c = c_; }
    __device__ bool tile(int i, int& pm, int& pn) const {
        const long L = (long)i * G + c; if (L >= nwg) return false;
        int wgid = (int)L; { const int q = nwg / NXCD, r = nwg % NXCD, xcd = wgid % NXCD, off = wgid / NXCD; wgid = (xcd < r ? xcd * (q + 1) : r * (q + 1) + (xcd - r) * q) + off; }
        const int nig = WGM * nN, gid = wgid / nig, fm = gid * WGM, gsz = (nM - fm) < WGM ? (nM - fm) : WGM;
        pm = fm + ((wgid % nig) % gsz); pn = (wgid % nig) / gsz; return true;
    }
};
struct DenseSched {
    GridOrder go; const char* A; const char* Bt; size_t tstep; int nt_;
    __device__ void init(const bf16_t* A_, const bf16_t* Bt_, int M, int N, int K, int G, int c) { go.init(M / BM, N / BM, G, c); A = (const char*)A_; Bt = (const char*)Bt_; tstep = (size_t)BM * K * 2; nt_ = K / BK; }
    __device__ bool next(int i, Unit& u) const { int pm, pn; if (!go.tile(i, pm, pn)) return false; u.pm = pm; u.pn = pn; u.a = A + (size_t)pm * tstep; u.b = Bt + (size_t)pn * tstep; u.row0 = pm * BM; u.nrows = BM; u.e = 0; u.nt = nt_; u.flags = 0; return true; }
};

template <class Epi, class Sched, bool GATHER>
__device__ __forceinline__ void gemm_phase(const int tid, LAS unsigned char* lds, const int K_, const Sched& S, const Epi& E, const int* gather_rows) {
    int K = K_; asm volatile("" : "+s"(K));
    const int wid = __builtin_amdgcn_readfirstlane(tid >> 6), lane = tid & 63, wr = wid >> 2, wc = wid & 3, fr = lane & 15, fq = lane >> 4;
    int sR[2], sC[2];
    unsigned voffB[2];
#pragma unroll
    for (int i = 0; i < 2; ++i) { int R, C; stage_rc(tid * 16 + i * 8192, R, C); sR[i] = R; sC[i] = C; const int Rb = Epi::PERM ? ((R & ~31) + perm32(R & 31)) : R; voffB[i] = (unsigned)(Rb * K + C) * 2u; }
    const size_t kstep = (size_t)(BK * 2);
    const size_t hstep = (size_t)HALF * K * 2;
    const unsigned ldsw = (unsigned)wid * 1024u;
    const int aoff = lds_byte(wr * 64 + fr, fq * 8), boff = lds_byte(wc * 32 + fr, fq * 8);
    unsigned cva[2][2], nva[2][2];
#define PG8_SETVA(va, u) do { _Pragma("unroll") for (int h_ = 0; h_ < 2; ++h_) _Pragma("unroll") for (int i_ = 0; i_ < 2; ++i_) { \
        if (GATHER) { int rr_ = (u).row0 + h_ * HALF + sR[i_]; const int rmax_ = (u).row0 + (u).nrows - 1; rr_ = rr_ > rmax_ ? rmax_ : rr_; int tk_ = gather_rows[rr_]; tk_ = tk_ < 0 ? 0 : (tk_ > 16383 ? 16383 : tk_); va[h_][i_] = (unsigned)(tk_ * K + sC[i_]) * 2u; } \
        else va[h_][i_] = (unsigned)((h_ * HALF + sR[i_]) * K + sC[i_]) * 2u; } } while (0)
#define PG8_SA(b, h) (((b) * 2 + (h)) * HTB)
#define PG8_SB(b, h) ((4 + (b) * 2 + (h)) * HTB)
#define PG8_STAGE2(bufoff, gbase, v0, v1) do { \
        __builtin_amdgcn_global_load_lds((const unsigned*)((const char*)(gbase) + (v0)), (LAS unsigned*)(lds + (bufoff) + ldsw), 16, 0, 0); \
        __builtin_amdgcn_global_load_lds((const unsigned*)((const char*)(gbase) + (v1)), (LAS unsigned*)(lds + (bufoff) + ldsw + 8192), 16, 0, 0); } while (0)
#define PG8_STAGEB(bufoff, gbase) PG8_STAGE2(bufoff, gbase, voffB[0], voffB[1])
#define PG8_STAGEA(bufoff, gbase, va, h) PG8_STAGE2(bufoff, gbase, va[h][0], va[h][1])
#define PG8_LDA(dst, b, h) do { _Pragma("unroll") for (int m = 0; m < 4; ++m) _Pragma("unroll") for (int k = 0; k < 2; ++k) dst[m][k] = *(const LAS bf16x8*)(lds + PG8_SA(b, h) + aoff + m * 2048 + k * 1024); } while (0)
#define PG8_LDB(dst, b, h) do { _Pragma("unroll") for (int n = 0; n < 2; ++n) _Pragma("unroll") for (int k = 0; k < 2; ++k) dst[n][k] = *(const LAS bf16x8*)(lds + PG8_SB(b, h) + boff + n * 2048 + k * 1024); } while (0)
#define PG8_MMA(ai, bj, At, Bt) do { __builtin_amdgcn_s_setprio(1); _Pragma("unroll") for (int m = 0; m < 4; ++m) _Pragma("unroll") for (int n = 0; n < 2; ++n) _Pragma("unroll") for (int k = 0; k < 2; ++k) \
        acc[ai][bj][m][n] = __builtin_amdgcn_mfma_f32_16x16x32_bf16(Bt[n][k], At[m][k], acc[ai][bj][m][n], 0, 0, 0); __builtin_amdgcn_s_setprio(0); } while (0)
#define PG8_WAIT_V(n) asm volatile("s_waitcnt vmcnt(" #n ")" ::: "memory")
#define PG8_WAIT_L(n) asm volatile("s_waitcnt lgkmcnt(" #n ")" ::: "memory")
#define PG8_BAR __builtin_amdgcn_s_barrier()
#define PG8_SCHED __builtin_amdgcn_sched_barrier(0)
    Unit cur, nxt; int ui = 0;
    if (!S.next(0, cur)) return;
    PG8_SETVA(cva, cur);
    f32x4 acc[2][2][4][2];
#pragma unroll
    for (int a = 0; a < 2; ++a)
#pragma unroll
        for (int b = 0; b < 2; ++b)
#pragma unroll
            for (int m = 0; m < 4; ++m)
#pragma unroll
                for (int n = 0; n < 2; ++n) acc[a][b][m][n] = (f32x4){0.f, 0.f, 0.f, 0.f};
    bf16x8 At[4][2], B0[2][2], B1[2][2];
    const char* cA = cur.a; const char* cB = cur.b;
    PG8_STAGEB(PG8_SB(0, 0), cB); PG8_STAGEB(PG8_SB(0, 1), cB + hstep); PG8_STAGEA(PG8_SA(0, 0), cA, cva, 0); PG8_STAGEA(PG8_SA(0, 1), cA, cva, 1);
    if (wr == 1) PG8_BAR;
    PG8_WAIT_V(2); PG8_BAR;
    PG8_STAGEB(PG8_SB(1, 0), cB + kstep); PG8_STAGEA(PG8_SA(1, 0), cA + kstep, cva, 0); PG8_STAGEB(PG8_SB(1, 1), cB + hstep + kstep);
    PG8_WAIT_V(6); PG8_BAR;
    for (;;) {
        const bool has_next = S.next(ui + 1, nxt);
        if (has_next) PG8_SETVA(nva, nxt);
        else {
#pragma unroll
            for (int h = 0; h < 2; ++h)
#pragma unroll
                for (int i = 0; i < 2; ++i) nva[h][i] = cva[h][i];
        }
        const char* nA = has_next ? nxt.a : cA; const char* nB = has_next ? nxt.b : cB;
        const int nt = cur.nt;
        for (int t = 0; t < nt; t += 2) {
            const bool last = (t == nt - 2);
            const char* a1 = cA + (size_t)(t + 1) * kstep;
            const char* a2 = last ? nA : cA + (size_t)(t + 2) * kstep; const char* b2 = last ? nB : cB + (size_t)(t + 2) * kstep;
            const char* a3 = a2 + kstep; const char* b3 = b2 + kstep;
            unsigned va2[2][2];
#pragma unroll
            for (int h = 0; h < 2; ++h)
#pragma unroll
                for (int i = 0; i < 2; ++i) va2[h][i] = (GATHER && last) ? nva[h][i] : cva[h][i];
            PG8_LDB(B0, 0, 0); PG8_LDB(B1, 0, 1); PG8_SCHED; PG8_LDA(At, 0, 0); PG8_STAGEA(PG8_SA(1, 1), a1, cva, 1);
            PG8_WAIT_V(8); PG8_WAIT_L(0); PG8_BAR; PG8_MMA(0, 0, At, B0); PG8_MMA(0, 1, At, B1); PG8_BAR; PG8_SCHED;
            PG8_LDA(At, 0, 1); PG8_STAGEB(PG8_SB(0, 0), b2); PG8_STAGEB(PG8_SB(0, 1), b2 + hstep); PG8_STAGEA(PG8_SA(0, 0), a2, va2, 0);
            PG8_WAIT_V(8); PG8_WAIT_L(0); PG8_BAR; PG8_MMA(1, 0, At, B0); PG8_MMA(1, 1, At, B1); PG8_BAR; PG8_SCHED;
            PG8_LDB(B0, 1, 0); PG8_LDB(B1, 1, 1); PG8_SCHED; PG8_LDA(At, 1, 0); PG8_STAGEA(PG8_SA(0, 1), a2, va2, 1);
            PG8_WAIT_V(8); PG8_WAIT_L(0); PG8_BAR; PG8_MMA(0, 0, At, B0); PG8_MMA(0, 1, At, B1); PG8_BAR; PG8_SCHED;
            PG8_LDA(At, 1, 1); PG8_STAGEB(PG8_SB(1, 0), b3); PG8_STAGEB(PG8_SB(1, 1), b3 + hstep); PG8_STAGEA(PG8_SA(1, 0), a3, va2, 0);
            PG8_WAIT_V(8); PG8_WAIT_L(0); PG8_BAR; PG8_MMA(1, 0, At, B0); PG8_MMA(1, 1, At, B1); PG8_BAR; PG8_SCHED;
        }
        if (wr == 0) PG8_BAR;
        E(acc, cur, wr, wc, fr, fq);
        if (!has_next) break;
#pragma unroll
        for (int a = 0; a < 2; ++a)
#pragma unroll
            for (int b = 0; b < 2; ++b)
#pragma unroll
                for (int m = 0; m < 4; ++m)
#pragma unroll
                    for (int n = 0; n < 2; ++n) acc[a][b][m][n] = (f32x4){0.f, 0.f, 0.f, 0.f};
        cur = nxt; cA = nA; cB = nB; ++ui;
#pragma unroll
        for (int h = 0; h < 2; ++h)
#pragma unroll
            for (int i = 0; i < 2; ++i) cva[h][i] = nva[h][i];
        if (wr == 1) PG8_BAR;
    }
    PG8_WAIT_V(0);
    PG8_BAR;
#undef PG8_SETVA
#undef PG8_SA
#undef PG8_SB
#undef PG8_STAGE2
#undef PG8_STAGEA
#undef PG8_STAGEB
#undef PG8_LDA
#undef PG8_LDB
#undef PG8_MMA
#undef PG8_WAIT_V
#undef PG8_WAIT_L
#undef PG8_BAR
#undef PG8_SCHED
}
}

__device__ __forceinline__ float rstd_from_ssq(const float* ssq, int row) {
    const f32x4* p = (const f32x4*)(ssq + (size_t)row * 16);
    const f32x4 a = p[0], b = p[1], c = p[2], d = p[3];
    const float s = (((a.x + a.y) + (a.z + a.w)) + ((b.x + b.y) + (b.z + b.w))) + (((c.x + c.y) + (c.z + c.w)) + ((d.x + d.y) + (d.z + d.w)));
    return 1.0f / sqrtf(s * (1.f / 1024.f) + NORM_EPS);
}
__device__ __forceinline__ u32x4 pack8(const f32x4 v0, const f32x4 v1) { u32x4 w; w.x = pk2(v0[0], v0[1]); w.y = pk2(v0[2], v0[3]); w.z = pk2(v1[0], v1[1]); w.w = pk2(v1[2], v1[3]); return w; }

struct EpiScaleBf16 {
    static constexpr bool PERM = true;
    bf16_t* O; int ldc; const float* ssq;
    __device__ __forceinline__ void operator()(const f32x4 (&acc)[2][2][4][2], const pg8::Unit& u, int wr, int wc, int fr, int fq) const {
        const int row0 = u.pm * 256 + wr * 64 + fr, col0 = u.pn * 256 + wc * 32 + 8 * fq;
#pragma unroll
        for (int ai = 0; ai < 2; ++ai)
#pragma unroll
            for (int m = 0; m < 4; ++m) { const int row = row0 + ai * 128 + m * 16; const float rs = rstd_from_ssq(ssq, row); bf16_t* rowp = O + (size_t)row * ldc + col0;
#pragma unroll
                for (int bj = 0; bj < 2; ++bj) *(u32x4*)(rowp + bj * 128) = pack8(acc[ai][bj][m][0] * rs, acc[ai][bj][m][1] * rs); }
    }
};
struct EpiResid {
    static constexpr bool PERM = true;
    const float* base; float* out; bf16_t* xb; float* ssq;
    __device__ __forceinline__ void operator()(const f32x4 (&acc)[2][2][4][2], const pg8::Unit& u, int wr, int wc, int fr, int fq) const {
        const int row0 = u.pm * 256 + wr * 64 + fr, col0 = u.pn * 256 + wc * 32 + 8 * fq;
#pragma unroll
        for (int ai = 0; ai < 2; ++ai)
#pragma unroll
            for (int m = 0; m < 4; ++m) { const int row = row0 + ai * 128 + m * 16; const size_t off = (size_t)row * 1024 + col0; float ss = 0.f;
#pragma unroll
                for (int bj = 0; bj < 2; ++bj) { const f32x4 b0 = *(const f32x4*)(base + off + bj * 128), b1 = *(const f32x4*)(base + off + bj * 128 + 4);
                    const f32x4 o0 = b0 + acc[ai][bj][m][0], o1 = b1 + acc[ai][bj][m][1];
                    *(f32x4*)(out + off + bj * 128) = o0; *(f32x4*)(out + off + bj * 128 + 4) = o1;
                    ss += (o0[0] * o0[0] + o0[1] * o0[1]) + (o0[2] * o0[2] + o0[3] * o0[3]) + (o1[0] * o1[0] + o1[1] * o1[1]) + (o1[2] * o1[2] + o1[3] * o1[3]);
                    *(u32x4*)(xb + off + bj * 128) = pack8(o0, o1); }
                ss += __shfl_xor(ss, 16); ss += __shfl_xor(ss, 32);
                if (ssq && fq == 0) ssq[(size_t)row * 16 + u.pn * 4 + wc] = ss; }
    }
};
struct EpiResidBf {
    static constexpr bool PERM = true;
    bf16_t* xb; float* out; float* ssq;
    __device__ __forceinline__ void operator()(const f32x4 (&acc)[2][2][4][2], const pg8::Unit& u, int wr, int wc, int fr, int fq) const {
        const int row0 = u.pm * 256 + wr * 64 + fr, col0 = u.pn * 256 + wc * 32 + 8 * fq;
#pragma unroll
        for (int ai = 0; ai < 2; ++ai)
#pragma unroll
            for (int m = 0; m < 4; ++m) { const int row = row0 + ai * 128 + m * 16; const size_t off = (size_t)row * 1024 + col0; float ss = 0.f;
#pragma unroll
                for (int bj = 0; bj < 2; ++bj) { const u32x4 bw = *(const u32x4*)(xb + off + bj * 128);
                    const f32x4 b0 = {bflo(bw.x), bfhi(bw.x), bflo(bw.y), bfhi(bw.y)}, b1 = {bflo(bw.z), bfhi(bw.z), bflo(bw.w), bfhi(bw.w)};
                    const f32x4 o0 = b0 + acc[ai][bj][m][0], o1 = b1 + acc[ai][bj][m][1];
                    if (out) { *(f32x4*)(out + off + bj * 128) = o0; *(f32x4*)(out + off + bj * 128 + 4) = o1; }
                    ss += (o0[0] * o0[0] + o0[1] * o0[1]) + (o0[2] * o0[2] + o0[3] * o0[3]) + (o1[0] * o1[0] + o1[1] * o1[1]) + (o1[2] * o1[2] + o1[3] * o1[3]);
                    *(u32x4*)(xb + off + bj * 128) = pack8(o0, o1); }
                ss += __shfl_xor(ss, 16); ss += __shfl_xor(ss, 32);
                if (ssq && fq == 0) ssq[(size_t)row * 16 + u.pn * 4 + wc] = ss; }
    }
};
struct EpiSwiGLU {
    static constexpr bool PERM = true;
    bf16_t* H; int ldh; const float* ssq;
    __device__ __forceinline__ void operator()(const f32x4 (&acc)[2][2][4][2], const pg8::Unit& u, int wr, int wc, int fr, int fq) const {
        const int row0 = u.pm * 256 + wr * 64 + fr, hcol0 = u.pn * 128 + wc * 32 + 8 * fq;
#pragma unroll
        for (int ai = 0; ai < 2; ++ai)
#pragma unroll
            for (int m = 0; m < 4; ++m) { const int row = row0 + ai * 128 + m * 16; const float rs = rstd_from_ssq(ssq, row);
                f32x4 h[2];
#pragma unroll
                for (int n = 0; n < 2; ++n) { const f32x4 g = acc[ai][0][m][n] * rs, up = acc[ai][1][m][n] * rs;
#pragma unroll
                    for (int i = 0; i < 4; ++i) h[n][i] = siluf_(g[i]) * up[i]; }
                *(u32x4*)(H + (size_t)row * ldh + hcol0) = pack8(h[0], h[1]); }
    }
};
struct EpiSwiGLUMoE {
    static constexpr bool PERM = true;
    bf16_t* H; const float* rstd3; const int* row_tok;
    __device__ __forceinline__ void operator()(const f32x4 (&acc)[2][2][4][2], const pg8::Unit& u, int wr, int wc, int fr, int fq) const {
        const int hcol0 = u.pn * 128 + wc * 32 + 8 * fq;
#pragma unroll
        for (int ai = 0; ai < 2; ++ai)
#pragma unroll
            for (int m = 0; m < 4; ++m) { const int rl = ai * 128 + wr * 64 + m * 16 + fr;
                if (rl < u.nrows) { const int grow = u.row0 + rl; const float rs = rstd3[row_tok[grow] & 16383];
                    f32x4 h[2];
#pragma unroll
                    for (int n = 0; n < 2; ++n) { const f32x4 g = acc[ai][0][m][n] * rs, up = acc[ai][1][m][n] * rs;
#pragma unroll
                        for (int i = 0; i < 4; ++i) h[n][i] = siluf_(g[i]) * up[i]; }
                    *(u32x4*)(H + (size_t)grow * D_FFE + hcol0) = pack8(h[0], h[1]); } }
    }
};
struct EpiMoEDown {
    static constexpr bool PERM = true;
    float* out; const int* row_tok; const float* row_gate;
    __device__ __forceinline__ void operator()(const f32x4 (&acc)[2][2][4][2], const pg8::Unit& u, int wr, int wc, int fr, int fq) const {
        const int col0 = u.pn * 256 + wc * 32 + 8 * fq;
#pragma unroll
        for (int ai = 0; ai < 2; ++ai)
#pragma unroll
            for (int m = 0; m < 4; ++m) { const int rl = ai * 128 + wr * 64 + m * 16 + fr;
                if (rl < u.nrows) { const int grow = u.row0 + rl; const int tok = row_tok[grow] & 16383; const float gt = row_gate[grow]; float* op = out + (size_t)tok * 1024 + col0;
#pragma unroll
                    for (int bj = 0; bj < 2; ++bj) { f32x4 b0 = *(const f32x4*)(op + bj * 128), b1 = *(const f32x4*)(op + bj * 128 + 4);
                        b0 += acc[ai][bj][m][0] * gt; b1 += acc[ai][bj][m][1] * gt; *(f32x4*)(op + bj * 128) = b0; *(f32x4*)(op + bj * 128 + 4) = b1; } } }
    }
};
struct EpiPart {
    static constexpr bool PERM = true;
    float* part;
    __device__ __forceinline__ void operator()(const f32x4 (&acc)[2][2][4][2], const pg8::Unit& u, int wr, int wc, int fr, int fq) const {
        float* pb = part + (size_t)(u.flags - 1) * 65536; const unsigned o0 = (unsigned)((wr * 64 + fr) * 256 + wc * 32 + 8 * fq);
#pragma unroll
        for (int ai = 0; ai < 2; ++ai)
#pragma unroll
            for (int m = 0; m < 4; ++m)
#pragma unroll
                for (int bj = 0; bj < 2; ++bj) { float* pp = pb + o0 + (ai * 128 + m * 16) * 256 + bj * 128; *(f32x4*)pp = acc[ai][bj][m][0]; *(f32x4*)(pp + 4) = acc[ai][bj][m][1]; }
    }
};
struct EpiLowRank {
    static constexpr bool PERM = true;
    unsigned char* ws; const float* const* in;
    __device__ __forceinline__ void operator()(const f32x4 (&acc)[2][2][4][2], const pg8::Unit& u, int wr, int wc, int fr, int fq) const {
        const int kind = u.pn >> 1; const int row0 = u.pm * 256 + wr * 64 + fr; const int c0 = (u.pn & 1) * 256 + wc * 32 + 8 * fq;
        const float* zp = in[kind == 0 ? 4 : kind == 1 ? 6 : kind == 2 ? 8 : 10]; const float* k_a = in[14];
        bf16_t* o1 = (bf16_t*)(ws + (kind == 0 ? A_LWF : kind == 1 ? A_LWB : kind == 2 ? A_KDF : kind == 3 ? A_KDB : A_GG));
        bf16_t* o2 = (bf16_t*)(ws + (kind == 3 ? A_BBB : A_BBF));
        const bf16_t* KS = (const bf16_t*)(ws + A_KS); const bf16_t* NKK = (const bf16_t*)(ws + A_NKK);
#pragma unroll
        for (int bj = 0; bj < 2; ++bj)
#pragma unroll
            for (int n = 0; n < 2; ++n) { const int c = c0 + bj * 128 + 4 * n;
                if (kind < 2) { const f32x4 z = *(const f32x4*)(zp + c);
#pragma unroll
                    for (int ai = 0; ai < 2; ++ai)
#pragma unroll
                        for (int m = 0; m < 4; ++m) { const int row = row0 + ai * 128 + m * 16; f32x4 v = acc[ai][bj][m][n] + z;
#pragma unroll
                            for (int i = 0; i < 4; ++i) v[i] = -0.87506126f * sigmoidf_(v[i]);
                            u32x2 w; w.x = pk2(v[0], v[1]); w.y = pk2(v[2], v[3]); *(u32x2*)(o1 + (size_t)row * 512 + c) = w; }
                } else if (kind < 4) { const f32x4 z = *(const f32x4*)(zp + c), ka = *(const f32x4*)(k_a + c);
#pragma unroll
                    for (int ai = 0; ai < 2; ++ai)
#pragma unroll
                        for (int m = 0; m < 4; ++m) { const int row = row0 + ai * 128 + m * 16; const size_t off = (size_t)row * 512 + c;
                            const u32x2 kw = *(const u32x2*)(KS + off), nw = *(const u32x2*)(NKK + off);
                            const f32x4 av = acc[ai][bj][m][n] + z;
                            const f32x4 kv = {bflo(kw.x), bfhi(kw.x), bflo(kw.y), bfhi(kw.y)}, nv = {bflo(nw.x), bfhi(nw.x), bflo(nw.y), bfhi(nw.y)};
                            f32x4 kd, bb;
#pragma unroll
                            for (int i = 0; i < 4; ++i) { const float sg = sigmoidf_(av[i]); kd[i] = kv[i] * (1.f + (sg - 1.f) * ka[i]); bb[i] = -nv[i] * sg; }
                            u32x2 w1, w2; w1.x = pk2(kd[0], kd[1]); w1.y = pk2(kd[2], kd[3]); w2.x = pk2(bb[0], bb[1]); w2.y = pk2(bb[2], bb[3]);
                            *(u32x2*)(o1 + off) = w1; *(u32x2*)(o2 + off) = w2; }
                } else {
#pragma unroll
                    for (int ai = 0; ai < 2; ++ai)
#pragma unroll
                        for (int m = 0; m < 4; ++m) { const int row = row0 + ai * 128 + m * 16; const f32x4 v = acc[ai][bj][m][n];
                            u32x2 w; w.x = pk2(v[0], v[1]); w.y = pk2(v[2], v[3]); *(u32x2*)(o1 + (size_t)row * 512 + c) = w; }
                } }
    }
};

constexpr int NWAVES = 8;
struct Args { const float* in[38]; float* out; unsigned char* ws; int ph_lo, ph_hi; };
struct Frame {
    LAS unsigned char* lds; unsigned char* ws; const float* const* in; float* out;
    int tid, lane, wave, vcu, G;
};
template <class T> __device__ __forceinline__ T* wsp(unsigned char* ws, size_t off) { return (T*)(ws + off); }

__device__ __forceinline__ void conv_item(const float* W, int ldw, int k0, int n0, int ncols, const float* gain, bf16_t* WT, int ldk, int dst_row0, LAS float* scr, int lane) {
#pragma unroll
    for (int i = 0; i < 8; ++i) { const int kk = (lane >> 3) + 8 * i, c4 = 4 * (lane & 7);
        f32x4 v = *(const f32x4*)(W + (size_t)(k0 + kk) * ldw + n0 + c4);
        if (gain) v = v * gain[k0 + kk];
        scr[kk * 33 + c4 + 0] = v[0]; scr[kk * 33 + c4 + 1] = v[1]; scr[kk * 33 + c4 + 2] = v[2]; scr[kk * 33 + c4 + 3] = v[3]; }
    LDS_WAIT(); asm volatile("" ::: "memory");
    const int c = lane & 7;
#pragma unroll
    for (int j = 0; j < 4; ++j) { const int n = (lane >> 3) + 8 * j; const LAS float* s = scr + (8 * c) * 33 + n;
        u32x4 o; o.x = pk2(s[0 * 33], s[1 * 33]); o.y = pk2(s[2 * 33], s[3 * 33]); o.z = pk2(s[4 * 33], s[5 * 33]); o.w = pk2(s[6 * 33], s[7 * 33]);
        if (n < ncols) *(u32x4*)(WT + (size_t)(dst_row0 + n) * ldk + k0 + 8 * c) = o; }
    LDS_WAIT(); asm volatile("" ::: "memory");
}
__device__ __forceinline__ void conv_job_item(int r, const float* W, int ldw, int col0, int nblk, int ncols_last, const float* gain, bf16_t* WT, int ldk, int mode, int dst_off, LAS float* scr, int lane) {
    const int kb = r / nblk, nb = r % nblk; const int nrel = 32 * nb;
    int drow = dst_off + nrel; if (mode) drow = 256 * (nrel >> 7) + (nrel & 127) + (mode == 2 ? 128 : 0);
    conv_item(W, ldw, 64 * kb, col0 + nrel, (nb == nblk - 1) ? ncols_last : 32, gain, WT, ldk, drow, scr, lane);
}
__device__ __forceinline__ void conv_group(const Frame& F, int group, int w, int nw) {
    LAS float* scr = (LAS float*)(F.lds + F.wave * 16384);
    const int lane = F.lane; unsigned char* ws = F.ws;
    constexpr int I0 = 16 * 80, I1 = 16 * 32, I2 = 16 * 88, I3 = I2, I4 = 44 * 32, I5 = 16 * 64, I6 = 16 * 32, I7 = 16, I8 = 16 * 32;
    if (group == 0) {
        for (int r = w; r < I0; r += nw) conv_job_item(r, F.in[2], 2560, 0, 80, 32, F.in[1], wsp<bf16_t>(ws, WS_WIN0), 1024, 0, 0, scr, lane);
    } else if (group == 1) {
        for (int it = w; it < I1 + I2 + I3 + I4; it += nw) { int r = it;
            if (r < I1) { conv_job_item(r, F.in[20], 1024, 0, 32, 32, nullptr, wsp<bf16_t>(ws, WS_WOUT0), 1024, 0, 0, scr, lane); continue; } r -= I1;
            if (r < I2) { conv_job_item(r, F.in[22], 2816, 0, 88, 32, F.in[21], wsp<bf16_t>(ws, WS_WGU0), 1024, 1, 0, scr, lane); continue; } r -= I2;
            if (r < I3) { conv_job_item(r, F.in[23], 2816, 0, 88, 32, F.in[21], wsp<bf16_t>(ws, WS_WGU0), 1024, 2, 0, scr, lane); continue; } r -= I3;
            conv_job_item(r, F.in[24], 1024, 0, 32, 32, nullptr, wsp<bf16_t>(ws, WS_WD0), 2816, 0, 0, scr, lane); }
    } else {
        for (int it = w; it < I5 + I6 + I7 + I8; it += nw) { int r = it;
            if (r < I5) { conv_job_item(r, F.in[26], 3088, 0, 64, 32, F.in[25], wsp<bf16_t>(ws, WS_WIN1), 1024, 0, 0, scr, lane); continue; } r -= I5;
            if (r < I6) { conv_job_item(r, F.in[26], 3088, 2064, 32, 32, F.in[25], wsp<bf16_t>(ws, WS_WIN1), 1024, 0, 2048, scr, lane); continue; } r -= I6;
            if (r < I7) { conv_job_item(r, F.in[26], 3088, 2048, 1, 16, F.in[25], wsp<bf16_t>(ws, WS_WIN1), 1024, 0, 3072, scr, lane); continue; } r -= I7;
            conv_job_item(r, F.in[32], 1024, 0, 32, 32, nullptr, wsp<bf16_t>(ws, WS_WOUT1), 1024, 0, 0, scr, lane); }
    }
}
__device__ __forceinline__ void phase_prologue(const Frame& F) {
    const int gw = F.vcu * NWAVES + F.wave, NGW = F.G * NWAVES, lane = F.lane;
    unsigned char* ws = F.ws;
    conv_group(F, 0, gw, NGW);
    if (F.G < 256) { conv_group(F, 1, gw, NGW); conv_group(F, 2, gw, NGW); }
    const int gt = F.vcu * 512 + F.tid, NGT = F.G * 512;
    { bf16_t* wlr = wsp<bf16_t>(ws, WS_WLR);
      for (int i = gt; i < 2560 * 256; i += NGT) { const int n = i >> 8, k = i & 255; float v = 0.f;
          if (n < 512)       { if (k < 64) v = F.in[5][k * 512 + n]; }
          else if (n < 1024) { if (k < 64) v = F.in[7][k * 512 + (n - 512)]; }
          else if (n < 1536) { if (k >= 64 && k < 128) v = F.in[9][(k - 64) * 512 + (n - 1024)]; }
          else if (n < 2048) { if (k >= 64 && k < 128) v = F.in[11][(k - 64) * 512 + (n - 1536)]; }
          else               { if (k >= 128) v = F.in[12][(k - 128) * 512 + (n - 2048)]; }
          wlr[i] = f2bf(v); } }
    { f32x2* rt = wsp<f32x2>(ws, WS_ROPE);
      for (int i = gt; i < SEQ * 32; i += NGT) { const int ts = i >> 5, pi = i & 31; const float freq = expf(-(float)(pi & 15) * (9.210340371976184f / 16.f));
          const float ang = ((pi >= 16) ? (float)(ts & 63) : (float)(ts >> 6)) * freq; float sn, cs; sincosf(ang, &sn, &cs); rt[i] = (f32x2){cs, sn}; } }
    { const float* x = F.in[0]; bf16_t* xb = wsp<bf16_t>(ws, WS_XB); float* ssq = wsp<float>(ws, WS_SSQ0);
      for (int m = gw; m < M_TOK; m += NGW) { const f32x4* xr = (const f32x4*)(x + (size_t)m * 1024) + lane; f32x4 v[4]; float s = 0.f;
#pragma unroll
          for (int j = 0; j < 4; ++j) { v[j] = xr[64 * j]; s += (v[j].x * v[j].x + v[j].y * v[j].y) + (v[j].z * v[j].z + v[j].w * v[j].w); }
          s = wave_sum(s);
          u32x2* o8 = (u32x2*)(xb + (size_t)m * 1024) + lane;
#pragma unroll
          for (int j = 0; j < 4; ++j) { u32x2 w; w.x = pk2(v[j].x, v[j].y); w.y = pk2(v[j].z, v[j].w); o8[64 * j] = w; }
          if (lane < 16) ssq[(size_t)m * 16 + lane] = (lane == 0) ? s : 0.f; } }
}
__device__ __forceinline__ void conv_experts_gu(const Frame& F, int w, int nw) {
    LAS float* scr = (LAS float*)(F.lds + F.wave * 16384); const int lane = F.lane;
    constexpr int IG = 16 * 112; bf16_t* wegu = wsp<bf16_t>(F.ws, A_WEGU);
    for (int it = w; it < NEXP * 2 * IG; it += nw) { const int e = it / (2 * IG); const int r = it % (2 * IG);
        if (r < IG) conv_job_item(r, F.in[35] + (size_t)e * 1024 * D_FFE, D_FFE, 0, 112, 32, F.in[33], wegu + (size_t)e * 2 * D_FFE * 1024, 1024, 1, 0, scr, lane);
        else conv_job_item(r - IG, F.in[36] + (size_t)e * 1024 * D_FFE, D_FFE, 0, 112, 32, F.in[33], wegu + (size_t)e * 2 * D_FFE * 1024, 1024, 2, 0, scr, lane); }
}
__device__ __forceinline__ void conv_experts_down(const Frame& F, int w, int nw) {
    LAS float* scr = (LAS float*)(F.lds + F.wave * 16384); const int lane = F.lane;
    constexpr int ID = 56 * 32; bf16_t* wed = wsp<bf16_t>(F.ws, A_WED);
    for (int it = w; it < NEXP * ID; it += nw) { const int e = it / ID, r = it % ID;
        conv_job_item(r, F.in[37] + (size_t)e * D_FFE * 1024, 1024, 0, 32, 32, nullptr, wed + (size_t)e * 1024 * D_FFE, D_FFE, 0, 0, scr, lane); }
}
__device__ __forceinline__ void phase_conv_experts(const Frame& F) {
    const int gw = F.vcu * NWAVES + F.wave, NGW = F.G * NWAVES;
    conv_experts_gu(F, gw, NGW);
}

__device__ __forceinline__ float dpp8_sum(float v) {
    v += __builtin_bit_cast(float, __builtin_amdgcn_update_dpp(0, __builtin_bit_cast(int, v), 0xB1, 0xF, 0xF, false));
    v += __builtin_bit_cast(float, __builtin_amdgcn_update_dpp(0, __builtin_bit_cast(int, v), 0x4E, 0xF, 0xF, false));
    v += __builtin_bit_cast(float, __builtin_amdgcn_update_dpp(0, __builtin_bit_cast(int, v), 0x141, 0xF, 0xF, false));
    return v;
}
__device__ __forceinline__ void unpack8(const u32x4 w, float (&f)[8]) { f[0] = bflo(w.x); f[1] = bfhi(w.x); f[2] = bflo(w.y); f[3] = bfhi(w.y); f[4] = bflo(w.z); f[5] = bfhi(w.z); f[6] = bflo(w.w); f[7] = bfhi(w.w); }
__device__ __forceinline__ u32x4 pack8f(const float (&f)[8]) { u32x4 w; w.x = pk2(f[0], f[1]); w.y = pk2(f[2], f[3]); w.z = pk2(f[4], f[5]); w.w = pk2(f[6], f[7]); return w; }
__device__ __forceinline__ void phase_prep0(const Frame& F) {
    const int gw = F.vcu * NWAVES + F.wave, lane = F.lane;
    const bf16_t* P = wsp<bf16_t>(F.ws, A_P0);
    bf16_t *RS = wsp<bf16_t>(F.ws, A_RS), *KS = wsp<bf16_t>(F.ws, A_KS), *VS = wsp<bf16_t>(F.ws, A_VS), *NKK = wsp<bf16_t>(F.ws, A_NKK), *AP = wsp<bf16_t>(F.ws, A_AP);
    bf16_t *QH = wsp<bf16_t>(F.ws, A_QH), *KH = wsp<bf16_t>(F.ws, A_KH), *VT = wsp<bf16_t>(F.ws, A_VT0);
    const f32x2* ROPE = wsp<f32x2>(F.ws, WS_ROPE);
    float mu[4][8], kkw[8], qn8[8], kn8[8];
#pragma unroll
    for (int j = 0; j < 4; ++j)
#pragma unroll
        for (int e = 0; e < 8; ++e) { const int col = 8 * (lane + 64 * j) + e; mu[j][e] = col < RW_IN ? F.in[3][col] : 0.f; }
#pragma unroll
    for (int e = 0; e < 8; ++e) { kkw[e] = F.in[13][8 * lane + e]; qn8[e] = F.in[18][8 * (lane & 7) + e]; kn8[e] = F.in[19][8 * (lane & 7) + e]; }
    for (int g8 = gw; g8 < M_TOK / 8; g8 += F.G * NWAVES) {
        u32x4 prev[4], cur[5], nxt[4];
        { const int tok = g8 * 8; const int ts = tok & (SEQ - 1);
#pragma unroll
          for (int j = 0; j < 5; ++j) cur[j] = *(const u32x4*)(P + (size_t)tok * E_IN + 8 * (lane + 64 * j));
#pragma unroll
          for (int j = 0; j < 4; ++j) prev[j] = (ts > 0) ? *(const u32x4*)(P + (size_t)(tok - 1) * E_IN + 8 * (lane + 64 * j)) : (u32x4){0u, 0u, 0u, 0u}; }
        for (int tt = 0; tt < 8; ++tt) { const int tok = g8 * 8 + tt; const int ts = tok & (SEQ - 1); const int bb = tok >> 11;
            u32x4 ncur4 = (u32x4){0u, 0u, 0u, 0u};
#pragma unroll
            for (int j = 0; j < 4; ++j) nxt[j] = (ts < SEQ - 1) ? *(const u32x4*)(P + (size_t)(tok + 1) * E_IN + 8 * (lane + 64 * j)) : (u32x4){0u, 0u, 0u, 0u};
            if (tt < 7) ncur4 = *(const u32x4*)(P + (size_t)(tok + 1) * E_IN + 8 * (lane + 256));
            const f32x4 rp0 = *(const f32x4*)(ROPE + (size_t)ts * 32 + 4 * (lane & 7)), rp1 = *(const f32x4*)(ROPE + (size_t)ts * 32 + 4 * (lane & 7) + 2);
            const float cs4[4] = {rp0[0], rp0[2], rp1[0], rp1[2]}, sn4[4] = {rp0[1], rp0[3], rp1[1], rp1[3]};
            float s[4][8];
#pragma unroll
            for (int j = 0; j < 4; ++j) { float c[8], p[8], n[8]; unpack8(cur[j], c); unpack8(prev[j], p); unpack8(nxt[j], n);
#pragma unroll
                for (int e = 0; e < 8; ++e) s[j][e] = c[e] + (0.5f * (p[e] + n[e]) - c[e]) * mu[j][e]; }
            const size_t o512 = (size_t)tok * 512 + 8 * lane;
            *(u32x4*)(RS + o512) = pack8f(s[0]); *(u32x4*)(KS + o512) = pack8f(s[1]); *(u32x4*)(VS + o512) = pack8f(s[2]);
            { float kr[8]; float ss = 0.f;
#pragma unroll
              for (int e = 0; e < 8; ++e) { kr[e] = s[1][e] * kkw[e]; ss += kr[e] * kr[e]; }
              ss = dpp8_sum(ss); const float inv = -1.f / fmaxf(sqrtf(ss), 1e-12f);
#pragma unroll
              for (int e = 0; e < 8; ++e) kr[e] *= inv;
              *(u32x4*)(NKK + o512) = pack8f(kr); }
            float x3[8], x4[8]; unpack8(cur[3], x3); unpack8(cur[4], x4);
            { float ap[8];
#pragma unroll
              for (int e = 0; e < 8; ++e) ap[e] = lane < 8 ? tanhf(s[3][e]) : (lane < 16 ? s[3][e] : sigmoidf_(s[3][e]));
              if (lane < 32) *(u32x4*)(AP + (size_t)tok * 256 + 8 * lane) = pack8f(ap); }
#pragma unroll
            for (int which = 0; which < 2; ++which) { float (&x)[8] = which ? x4 : x3; float ss = 0.f;
#pragma unroll
                for (int e = 0; e < 8; ++e) ss += x[e] * x[e];
                ss = dpp8_sum(ss); const float rs = 1.0f / sqrtf(ss * (1.f / 64.f) + NORM_EPS);
                const bool isk = which && lane >= 32; float o[8];
#pragma unroll
                for (int p = 0; p < 4; ++p) { const float x0 = x[2 * p] * rs * (isk ? kn8[2 * p] : qn8[2 * p]), x1 = x[2 * p + 1] * rs * (isk ? kn8[2 * p + 1] : qn8[2 * p + 1]);
                    o[2 * p] = x0 * cs4[p] - x1 * sn4[p]; o[2 * p + 1] = x0 * sn4[p] + x1 * cs4[p]; }
                if (!isk) {
#pragma unroll
                    for (int e = 0; e < 8; ++e) o[e] *= 0.18033688011112042f; }
                if (which == 0) { if (lane >= 32) *(u32x4*)(QH + (size_t)tok * 512 + 8 * (lane - 32)) = pack8f(o); }
                else { if (lane < 32) *(u32x4*)(QH + (size_t)tok * 512 + 256 + 8 * lane) = pack8f(o);
                       else if (lane < 48) *(u32x4*)(KH + (size_t)tok * 128 + 8 * (lane - 32)) = pack8f(o); } }
            if (lane >= 48) { const int g = (lane - 48) >> 3, d0 = 8 * ((lane - 48) & 7); const unsigned w[4] = {cur[4].x, cur[4].y, cur[4].z, cur[4].w};
#pragma unroll
                for (int e = 0; e < 8; ++e) VT[((size_t)(bb * 2 + g) * 64 + d0 + e) * SEQ + ts] = (bf16_t)((e & 1) ? (w[e >> 1] >> 16) : (w[e >> 1] & 0xffffu)); }
#pragma unroll
            for (int j = 0; j < 4; ++j) { prev[j] = cur[j]; cur[j] = nxt[j]; }
            cur[4] = ncur4;
        }
    }
}

__device__ __forceinline__ float dpp_row_sum(float v) {
    v += __builtin_bit_cast(float, __builtin_amdgcn_update_dpp(0, __builtin_bit_cast(int, v), 0xB1, 0xF, 0xF, false));
    v += __builtin_bit_cast(float, __builtin_amdgcn_update_dpp(0, __builtin_bit_cast(int, v), 0x4E, 0xF, 0xF, false));
    v += __builtin_bit_cast(float, __builtin_amdgcn_update_dpp(0, __builtin_bit_cast(int, v), 0x141, 0xF, 0xF, false));
    v += __builtin_bit_cast(float, __builtin_amdgcn_update_dpp(0, __builtin_bit_cast(int, v), 0x140, 0xF, 0xF, false));
    return v;
}
constexpr int SC_STEPS = 32, SC_STRIDE = 352, SC_BUF = SC_STEPS * SC_STRIDE;
__device__ __forceinline__ float dpp_row8_sum(float v) {
    v += __builtin_bit_cast(float, __builtin_amdgcn_update_dpp(0, __builtin_bit_cast(int, v), 0xB1, 0xF, 0xF, false));
    v += __builtin_bit_cast(float, __builtin_amdgcn_update_dpp(0, __builtin_bit_cast(int, v), 0x4E, 0xF, 0xF, false));
    v += __builtin_bit_cast(float, __builtin_amdgcn_update_dpp(0, __builtin_bit_cast(int, v), 0x141, 0xF, 0xF, false));
    return v;
}
struct ScOps { f32x2 w[4], kd[4], a[4], b[4], r[4]; float v; };
__device__ __forceinline__ void sc_ld(ScOps& o, const LAS float* bs, const LAS float* vp) {
#pragma unroll
    for (int i = 0; i < 2; ++i) {
        const f32x4 w4 = *(const LAS f32x4*)(bs + 4 * i), k4 = *(const LAS f32x4*)(bs + 64 + 4 * i), a4 = *(const LAS f32x4*)(bs + 128 + 4 * i), b4 = *(const LAS f32x4*)(bs + 192 + 4 * i), r4 = *(const LAS f32x4*)(bs + 256 + 4 * i);
        o.w[2 * i] = (f32x2){w4[0], w4[1]}; o.w[2 * i + 1] = (f32x2){w4[2], w4[3]}; o.kd[2 * i] = (f32x2){k4[0], k4[1]}; o.kd[2 * i + 1] = (f32x2){k4[2], k4[3]};
        o.a[2 * i] = (f32x2){a4[0], a4[1]}; o.a[2 * i + 1] = (f32x2){a4[2], a4[3]}; o.b[2 * i] = (f32x2){b4[0], b4[1]}; o.b[2 * i + 1] = (f32x2){b4[2], b4[3]};
        o.r[2 * i] = (f32x2){r4[0], r4[1]}; o.r[2 * i + 1] = (f32x2){r4[2], r4[3]}; }
    o.v = *vp;
}
template <int DIR> __device__ __forceinline__ float sc_step(f32x2 (&s)[4], const ScOps& o) {
    f32x2 u[4];
#pragma unroll
    for (int i = 0; i < 4; ++i) u[i] = o.kd[i] * o.v;
    f32x2 p = s[0] * o.a[0], q = s[1] * o.a[1];
    p = __builtin_elementwise_fma(s[2], o.a[2], p); q = __builtin_elementwise_fma(s[3], o.a[3], q); p = p + q;
    float sa = dpp_row8_sum(p[0] + p[1]);
    f32x2 yp, yq;
    if (DIR) { yp = s[0] * o.r[0]; yq = s[1] * o.r[1]; yp = __builtin_elementwise_fma(s[2], o.r[2], yp); yq = __builtin_elementwise_fma(s[3], o.r[3], yq); }
    const f32x2 sa2 = {sa, sa};
#pragma unroll
    for (int i = 0; i < 4; ++i) { const f32x2 t = __builtin_elementwise_fma(o.b[i], sa2, u[i]); s[i] = __builtin_elementwise_fma(s[i], o.w[i], t); }
    if (!DIR) { yp = s[0] * o.r[0]; yq = s[1] * o.r[1]; yp = __builtin_elementwise_fma(s[2], o.r[2], yp); yq = __builtin_elementwise_fma(s[3], o.r[3], yq); }
    yp = yp + yq;
    return dpp_row8_sum(yp[0] + yp[1]);
}
__device__ __forceinline__ void attn_tile_step(const LAS unsigned char* kb, const LAS unsigned char* vb, const bf16x8 (&q)[4], f32x16& o0, f32x16& o1, float& mrun, float& lrun, int r32, int hi) {
    f32x16 c0 = {}, c1 = {};
#pragma unroll
    for (int s4 = 0; s4 < 4; ++s4) { const int chk = 2 * s4 + hi;
        const bf16x8 k0 = *(const LAS bf16x8*)(kb + r32 * 128 + ((chk ^ (r32 & 7)) * 16));
        const bf16x8 k1 = *(const LAS bf16x8*)(kb + (32 + r32) * 128 + ((chk ^ (r32 & 7)) * 16));
        c0 = __builtin_amdgcn_mfma_f32_32x32x16_bf16(k0, q[s4], c0, 0, 0, 0);
        c1 = __builtin_amdgcn_mfma_f32_32x32x16_bf16(k1, q[s4], c1, 0, 0, 0); }
    float mx = c0[0];
#pragma unroll
    for (int r = 0; r < 16; ++r) { mx = fmaxf(mx, c0[r]); mx = fmaxf(mx, c1[r]); }
    mx = fmaxf(mx, __shfl_xor(mx, 32));
    const float mnew = fmaxf(mrun, mx); const float alpha = __builtin_amdgcn_exp2f(mrun - mnew); mrun = mnew;
    float ls = 0.f;
#pragma unroll
    for (int r = 0; r < 16; ++r) { c0[r] = __builtin_amdgcn_exp2f(c0[r] - mnew); c1[r] = __builtin_amdgcn_exp2f(c1[r] - mnew); ls += c0[r] + c1[r]; }
    lrun = lrun * alpha + ls;
#pragma unroll
    for (int r = 0; r < 16; ++r) { o0[r] *= alpha; o1[r] *= alpha; }
    u32x4 w00, w01, w10, w11;
    w00.x = pk2(c0[0], c0[1]); w00.y = pk2(c0[2], c0[3]); w00.z = pk2(c0[4], c0[5]); w00.w = pk2(c0[6], c0[7]);
    w01.x = pk2(c0[8], c0[9]); w01.y = pk2(c0[10], c0[11]); w01.z = pk2(c0[12], c0[13]); w01.w = pk2(c0[14], c0[15]);
    w10.x = pk2(c1[0], c1[1]); w10.y = pk2(c1[2], c1[3]); w10.z = pk2(c1[4], c1[5]); w10.w = pk2(c1[6], c1[7]);
    w11.x = pk2(c1[8], c1[9]); w11.y = pk2(c1[10], c1[11]); w11.z = pk2(c1[12], c1[13]); w11.w = pk2(c1[14], c1[15]);
    const bf16x8 p00 = __builtin_bit_cast(bf16x8, w00), p01 = __builtin_bit_cast(bf16x8, w01), p10 = __builtin_bit_cast(bf16x8, w10), p11 = __builtin_bit_cast(bf16x8, w11);
#define AT_VF(dd_, chk_) ({ const int sw_ = ((dd_) >> 1) & 7; const u32x2 lo_ = *(const LAS u32x2*)(vb + (dd_) * 128 + (((chk_) ^ sw_) * 16) + hi * 8); \
        const u32x2 hh_ = *(const LAS u32x2*)(vb + (dd_) * 128 + ((((chk_) + 1) ^ sw_) * 16) + hi * 8); const u32x4 vv_ = {lo_.x, lo_.y, hh_.x, hh_.y}; __builtin_bit_cast(bf16x8, vv_); })
    o0 = __builtin_amdgcn_mfma_f32_32x32x16_bf16(AT_VF(r32, 0), p00, o0, 0, 0, 0);
    o0 = __builtin_amdgcn_mfma_f32_32x32x16_bf16(AT_VF(r32, 2), p01, o0, 0, 0, 0);
    o0 = __builtin_amdgcn_mfma_f32_32x32x16_bf16(AT_VF(r32, 4), p10, o0, 0, 0, 0);
    o0 = __builtin_amdgcn_mfma_f32_32x32x16_bf16(AT_VF(r32, 6), p11, o0, 0, 0, 0);
    o1 = __builtin_amdgcn_mfma_f32_32x32x16_bf16(AT_VF(32 + r32, 0), p00, o1, 0, 0, 0);
    o1 = __builtin_amdgcn_mfma_f32_32x32x16_bf16(AT_VF(32 + r32, 2), p01, o1, 0, 0, 0);
    o1 = __builtin_amdgcn_mfma_f32_32x32x16_bf16(AT_VF(32 + r32, 4), p10, o1, 0, 0, 0);
    o1 = __builtin_amdgcn_mfma_f32_32x32x16_bf16(AT_VF(32 + r32, 6), p11, o1, 0, 0, 0);
#undef AT_VF
}
__device__ __forceinline__ void attn_store(bf16_t* op, const f32x16& o0, const f32x16& o1, float lrun) {
    const float ltot = lrun + __shfl_xor(lrun, 32); const float inv = 1.f / ltot;
#pragma unroll
    for (int q4 = 0; q4 < 4; ++q4) { u32x2 w0, w1;
        w0.x = pk2(o0[4 * q4 + 0] * inv, o0[4 * q4 + 1] * inv); w0.y = pk2(o0[4 * q4 + 2] * inv, o0[4 * q4 + 3] * inv);
        w1.x = pk2(o1[4 * q4 + 0] * inv, o1[4 * q4 + 1] * inv); w1.y = pk2(o1[4 * q4 + 2] * inv, o1[4 * q4 + 3] * inv);
        *(u32x2*)(op + 8 * q4) = w0; *(u32x2*)(op + 32 + 8 * q4) = w1; }
}
template <int DIR> __device__ __forceinline__ void scan_job(const Frame& F, int b, int h, int half, int job) {
    LAS float* buf = (LAS float*)F.lds; LAS float* ybuf = buf + 2 * SC_BUF;
    const int tid = F.tid, lane = F.lane, wave = F.wave;
    const bf16_t* s0 = wsp<bf16_t>(F.ws, DIR ? A_LWB : A_LWF); const bf16_t* s1 = wsp<bf16_t>(F.ws, DIR ? A_KDB : A_KDF); const bf16_t* s2 = wsp<bf16_t>(F.ws, A_NKK);
    const bf16_t* s3 = wsp<bf16_t>(F.ws, DIR ? A_BBB : A_BBF); const bf16_t* s4 = wsp<bf16_t>(F.ws, A_RS); const bf16_t* s5 = wsp<bf16_t>(F.ws, A_VS);
    float* Y = wsp<float>(F.ws, DIR ? A_YB : A_YF);
    constexpr int NCH = SEQ / SC_STEPS;
    const int htid = tid - 256;
#define SC_STAGE_LD(ch) do { const int step_ = ht_ >> 3, sub_ = ht_ & 7; \
        const int sq_ = (ch) * SC_STEPS + step_; const size_t to_ = (size_t)(b * SEQ + (DIR ? (SEQ - 1 - sq_) : sq_)) * 512 + h * 64 + 8 * sub_; \
        sst[0] = *(const u32x4*)(s0 + to_); sst[1] = *(const u32x4*)(s1 + to_); sst[2] = *(const u32x4*)(s2 + to_); sst[3] = *(const u32x4*)(s3 + to_); sst[4] = *(const u32x4*)(s4 + to_); \
        if (sub_ < 4) sst[5] = *(const u32x4*)(s5 + to_ + half * 32); } while (0)
#define SC_STAGE_ST(bufp) do { const int step_ = ht_ >> 3, sub_ = ht_ & 7; LAS float* d_ = (bufp) + step_ * SC_STRIDE + 8 * sub_; \
        _Pragma("unroll") for (int i_ = 0; i_ < 6; ++i_) { if (i_ < 5 || sub_ < 4) { \
            f32x4 lo_ = {bflo(sst[i_].x), bfhi(sst[i_].x), bflo(sst[i_].y), bfhi(sst[i_].y)}, hi_ = {bflo(sst[i_].z), bfhi(sst[i_].z), bflo(sst[i_].w), bfhi(sst[i_].w)}; \
            if (i_ == 0) { _Pragma("unroll") for (int e_ = 0; e_ < 4; ++e_) { lo_[e_] = __builtin_amdgcn_exp2f(lo_[e_]); hi_[e_] = __builtin_amdgcn_exp2f(hi_[e_]); } } \
            *(LAS f32x4*)(d_ + i_ * 64) = lo_; *(LAS f32x4*)(d_ + i_ * 64 + 4) = hi_; } } } while (0)
#define SC_STAGE(ch, bufp) do { SC_STAGE_LD(ch); SC_STAGE_ST(bufp); } while (0)
#define SC_FLUSH(ch) do { const LAS float* yb_ = ybuf + ((ch) & 1) * 1024; const int step_ = ht_ >> 3, c_ = ht_ & 7; const int sq_ = (ch) * SC_STEPS + step_; const int tok_ = b * SEQ + (DIR ? (SEQ - 1 - sq_) : sq_); \
        *(f32x4*)(Y + (size_t)tok_ * 512 + h * 64 + half * 32 + 4 * c_) = *(const LAS f32x4*)(yb_ + step_ * 32 + 4 * c_); } while (0)
    LAS unsigned char* alds = F.lds + 98304;
    const int hw = wave - 4;
    const bf16_t *QH = wsp<bf16_t>(F.ws, A_QH), *KH = wsp<bf16_t>(F.ws, A_KH), *VT0 = wsp<bf16_t>(F.ws, A_VT0); bf16_t* YC = wsp<bf16_t>(F.ws, A_YCAT);
    u32x4 sst[6];
    bf16x8 qfA[4], qfB[4]; f32x16 oA0 = {}, oA1 = {}, oB0 = {}, oB1 = {}; float mA = -1e30f, mB = -1e30f, lA = 0.f, lB = 0.f;
#define AT_UNIT(ch_) (2 * job + ((ch_) >> 5))
#define AT_LOAD(ch_) do { const int u_ = AT_UNIT(ch_), t_ = (ch_) & 31; const int ab_ = u_ >> 6, ag_ = (u_ >> 5) & 1; \
        _Pragma("unroll") for (int i_ = 0; i_ < 2; ++i_) { const int p_ = ht_ + 256 * i_, key_ = p_ >> 3, c_ = p_ & 7; \
            akst[i_] = *(const u32x4*)(KH + (size_t)(ab_ * SEQ + 64 * t_ + key_) * 128 + ag_ * 64 + 8 * c_); \
            avst[i_] = *(const u32x4*)(VT0 + ((size_t)(ab_ * 2 + ag_) * 64 + key_) * SEQ + 64 * t_ + 8 * c_); } } while (0)
#define AT_STORE(ch_) do { const int bo_ = ((ch_) & 1) * 8192; \
        _Pragma("unroll") for (int i_ = 0; i_ < 2; ++i_) { const int p_ = ht_ + 256 * i_, key_ = p_ >> 3, c_ = p_ & 7; \
            *(LAS u32x4*)(alds + bo_ + key_ * 128 + ((c_ ^ (key_ & 7)) * 16)) = akst[i_]; \
            *(LAS u32x4*)(alds + 16384 + bo_ + key_ * 128 + ((c_ ^ ((key_ >> 1) & 7)) * 16)) = avst[i_]; } } while (0)
#define AT_DMA(ch_) do { const int u_ = AT_UNIT(ch_), t_ = (ch_) & 31; const int ab_ = u_ >> 6, ag_ = (u_ >> 5) & 1; const int bo_ = ((ch_) & 1) * 8192; \
        _Pragma("unroll") for (int i_ = 0; i_ < 2; ++i_) { const int p_ = (hw * 2 + i_) * 64 + ln_, row_ = p_ >> 3, cp_ = p_ & 7; \
            __builtin_amdgcn_global_load_lds((const unsigned*)(KH + (size_t)(ab_ * SEQ + 64 * t_ + row_) * 128 + ag_ * 64 + 8 * (cp_ ^ (row_ & 7))), (LAS unsigned*)(alds + bo_ + (hw * 2 + i_) * 1024), 16, 0, 0); \
            __builtin_amdgcn_global_load_lds((const unsigned*)(VT0 + ((size_t)(ab_ * 2 + ag_) * 64 + row_) * SEQ + 64 * t_ + 8 * (cp_ ^ ((row_ >> 1) & 7))), (LAS unsigned*)(alds + 16384 + bo_ + (hw * 2 + i_) * 1024), 16, 0, 0); } } while (0)
    __syncthreads();
    if (wave >= 4) { int ht_ = htid; asm volatile("" : "+v"(ht_)); const int ln_ = ht_ & 63; SC_STAGE(0, buf); AT_DMA(0); asm volatile("s_waitcnt vmcnt(0)" ::: "memory"); }
    __syncthreads();
    if (wave < 4) {
        __builtin_amdgcn_s_setprio(3);
        const int row = lane >> 3, kg = lane & 7, rowl = wave * 8 + row;
        f32x2 s[4] = {(f32x2){0.f, 0.f}, (f32x2){0.f, 0.f}, (f32x2){0.f, 0.f}, (f32x2){0.f, 0.f}};
        for (int ch = 0; ch < NCH; ++ch) {
            const LAS float* bc = buf + (ch & 1) * SC_BUF + 8 * kg; const LAS float* vc = buf + (ch & 1) * SC_BUF + 320 + rowl; LAS float* yb = ybuf + (ch & 1) * 1024 + rowl;
            ScOps oa, ob; sc_ld(oa, bc, vc);
#pragma unroll 2
            for (int step = 0; step < SC_STEPS; step += 2) {
                sc_ld(ob, bc + (step + 1) * SC_STRIDE, vc + (step + 1) * SC_STRIDE);
                const float y0 = sc_step<DIR>(s, oa); yb[step * 32] = y0;
                if (step + 2 < SC_STEPS) sc_ld(oa, bc + (step + 2) * SC_STRIDE, vc + (step + 2) * SC_STRIDE);
                const float y1 = sc_step<DIR>(s, ob); yb[(step + 1) * 32] = y1; }
            __syncthreads();
        }
        __builtin_amdgcn_s_setprio(0);
    } else {
        for (int ch = 0; ch < NCH; ++ch) {
            int ht_ = htid; asm volatile("" : "+v"(ht_));
            int ln_ = lane; asm volatile("" : "+v"(ln_)); const int r32 = ln_ & 31, hi = ln_ >> 5;
            if (ch > 0) SC_FLUSH(ch - 1);
            if (ch + 1 < NCH) { AT_DMA(ch + 1); SC_STAGE_LD(ch + 1); }
            __builtin_amdgcn_sched_barrier(0);
            const int u = AT_UNIT(ch), t = ch & 31; const int ab = u >> 6, ag = (u >> 5) & 1, aqt = u & 31; const int head = 4 * ag + hw;
            const int qrowA = ab * SEQ + aqt * 64 + r32, qrowB = qrowA + 32;
            if (t == 0) {
#pragma unroll
                for (int s4 = 0; s4 < 4; ++s4) { qfA[s4] = *(const bf16x8*)(QH + (size_t)qrowA * 512 + head * 64 + 16 * s4 + 8 * hi); qfB[s4] = *(const bf16x8*)(QH + (size_t)qrowB * 512 + head * 64 + 16 * s4 + 8 * hi); }
                oA0 = f32x16{}; oA1 = f32x16{}; oB0 = f32x16{}; oB1 = f32x16{}; mA = -1e30f; mB = -1e30f; lA = 0.f; lB = 0.f; }
            { const LAS unsigned char* kb = alds + (ch & 1) * 8192; const LAS unsigned char* vb = alds + 16384 + (ch & 1) * 8192;
              __builtin_amdgcn_sched_barrier(0);
              attn_tile_step(kb, vb, qfA, oA0, oA1, mA, lA, r32, hi);
              __builtin_amdgcn_sched_barrier(0);
              if (ch + 1 < NCH) { SC_STAGE_ST(buf + ((ch + 1) & 1) * SC_BUF); }
              __builtin_amdgcn_sched_barrier(0);
              attn_tile_step(kb, vb, qfB, oB0, oB1, mB, lB, r32, hi);
              __builtin_amdgcn_sched_barrier(0); }
            if (t == 31) { attn_store(YC + (size_t)qrowA * 1024 + 512 + head * 64 + 4 * hi, oA0, oA1, lA); attn_store(YC + (size_t)qrowB * 1024 + 512 + head * 64 + 4 * hi, oB0, oB1, lB); }
            asm volatile("s_waitcnt vmcnt(0)" ::: "memory");
            __syncthreads();
        }
        { int ht_ = htid; asm volatile("" : "+v"(ht_)); SC_FLUSH(NCH - 1); }
    }
#undef AT_UNIT
#undef AT_LOAD
#undef AT_STORE
#undef SC_STAGE
#undef SC_STAGE_LD
#undef SC_STAGE_ST
#undef SC_FLUSH
}
constexpr int CS_SLOT = 9216, CS_RS = 144;
__device__ __forceinline__ void cs_mm(f32x4 (&acc)[2], const LAS unsigned char* L, const LAS unsigned char* Rt, int mi, int ni0, int fr, int fq) {
#pragma unroll
    for (int s2 = 0; s2 < 2; ++s2) { const bf16x8 a = *(const LAS bf16x8*)(L + (16 * mi + fr) * CS_RS + (32 * s2 + 8 * fq) * 2);
#pragma unroll
        for (int jj = 0; jj < 2; ++jj) { const bf16x8 bb = *(const LAS bf16x8*)(Rt + (16 * (ni0 + jj) + fr) * CS_RS + (32 * s2 + 8 * fq) * 2);
            acc[jj] = __builtin_amdgcn_mfma_f32_16x16x32_bf16(a, bb, acc[jj], 0, 0, 0); } }
}
__device__ __forceinline__ void cs_st_t8(LAS unsigned char* dst, const f32x4 (&acc)[2], int mi, int ni0, int fr, int fq) {
#pragma unroll
    for (int jj = 0; jj < 2; ++jj) { u32x2 w; w.x = pk2(acc[jj][0], acc[jj][1]); w.y = pk2(acc[jj][2], acc[jj][3]);
        *(LAS u32x2*)(dst + (16 * (ni0 + jj) + fr) * CS_RS + (16 * mi + 4 * fq) * 2) = w; }
}
__device__ __forceinline__ void cs_st_sc(LAS unsigned char* dst, const f32x4 (&acc)[2], int mi, int ni0, int fr, int fq) {
#pragma unroll
    for (int jj = 0; jj < 2; ++jj)
#pragma unroll
        for (int r = 0; r < 4; ++r) *(LAS bf16_t*)(dst + (16 * mi + 4 * fq + r) * CS_RS + (16 * (ni0 + jj) + fr) * 2) = f2bf(acc[jj][r]);
}
__device__ __forceinline__ void cs_ld_t8(f32x4 (&acc)[2], const LAS unsigned char* src, int mi, int ni0, int fr, int fq) {
#pragma unroll
    for (int jj = 0; jj < 2; ++jj) { const u32x2 w = *(const LAS u32x2*)(src + (16 * (ni0 + jj) + fr) * CS_RS + (16 * mi + 4 * fq) * 2);
        acc[jj] = (f32x4){bflo(w.x), bfhi(w.x), bflo(w.y), bfhi(w.y)}; }
}
#define CS_ZERO(acc) do { acc[0] = (f32x4){0.f, 0.f, 0.f, 0.f}; acc[1] = acc[0]; } while (0)
typedef short v4i16_t __attribute__((ext_vector_type(4)));
__device__ __forceinline__ bf16x8 cs_afrag_tr(const LAS unsigned char* LT, int mi, int s2, int fr, int fq) {
    const LAS unsigned char* p = LT + (32 * s2 + 8 * fq + (fr >> 2)) * CS_RS + (16 * mi + 4 * (fr & 3)) * 2;
    const v4i16_t lo = __builtin_amdgcn_ds_read_tr16_b64_v4i16((LAS v4i16_t*)p);
    const v4i16_t hi = __builtin_amdgcn_ds_read_tr16_b64_v4i16((LAS v4i16_t*)(p + 4 * CS_RS));
    return (bf16x8){lo[0], lo[1], lo[2], lo[3], hi[0], hi[1], hi[2], hi[3]};
}
__device__ __forceinline__ void cs_mm_tr(f32x4 (&acc)[2], const LAS unsigned char* LT, const LAS unsigned char* Rt, int mi, int ni0, int fr, int fq) {
#pragma unroll
    for (int s2 = 0; s2 < 2; ++s2) { const bf16x8 a = cs_afrag_tr(LT, mi, s2, fr, fq);
#pragma unroll
        for (int jj = 0; jj < 2; ++jj) { const bf16x8 bb = *(const LAS bf16x8*)(Rt + (16 * (ni0 + jj) + fr) * CS_RS + (32 * s2 + 8 * fq) * 2);
            acc[jj] = __builtin_amdgcn_mfma_f32_16x16x32_bf16(a, bb, acc[jj], 0, 0, 0); } }
}
__device__ __forceinline__ void cs_mask(f32x4 (&acc)[2], int mi, int ni0, int fr, int fq, int mode) {
#pragma unroll
    for (int jj = 0; jj < 2; ++jj) { const int ni = ni0 + jj;
        const bool keep_all = (mode == 1) ? (ni < mi) : (ni > mi), diag = (ni == mi);
        if (diag) {
#pragma unroll
            for (int r = 0; r < 4; ++r) { const int ml = 4 * fq + r; const bool k = (mode == 0) ? (ml < fr) : (mode == 1) ? (fr < ml) : (ml <= fr); if (!k) acc[jj][r] = 0.f; }
        } else if (!keep_all) acc[jj] = (f32x4){0.f, 0.f, 0.f, 0.f}; }
}
template <int DIR> __device__ __forceinline__ void cscan_job(const Frame& F, int b, int h) {
    const int tid = F.tid, lane = F.lane, wave = F.wave, fr = lane & 15, fq = lane >> 4;
    LAS unsigned char* L0 = F.lds;
#define SL(i) (L0 + (i) * CS_SLOT)
    LAS float* Dl = (LAS float*)SL(15);
    const bf16_t* g0 = wsp<bf16_t>(F.ws, DIR ? A_LWB : A_LWF); const bf16_t* g1 = wsp<bf16_t>(F.ws, DIR ? A_KDB : A_KDF); const bf16_t* g2 = wsp<bf16_t>(F.ws, A_NKK);
    const bf16_t* g3 = wsp<bf16_t>(F.ws, DIR ? A_BBB : A_BBF); const bf16_t* g4 = wsp<bf16_t>(F.ws, A_RS); const bf16_t* g5 = wsp<bf16_t>(F.ws, A_VS);
    bf16_t* Y = wsp<bf16_t>(F.ws, DIR ? A_YB : A_YF);
    const int mi = wave >> 1, ni0 = 2 * (wave & 1);
    const int rt_ = tid >> 3, rc_ = tid & 7;
    const int ek = tid & 63, etq = tid >> 6;
    u32x4 raw[5], rawv, rawv_cur; bf16_t lwn[8];
#define CS_LOAD(n_) do { const int sq_ = 64 * (n_) + rt_; const size_t to_ = (size_t)(b * SEQ + (DIR ? (SEQ - 1 - sq_) : sq_)) * 512 + h * 64; \
        raw[1] = *(const u32x4*)(g1 + to_ + 8 * rc_); raw[2] = *(const u32x4*)(g2 + to_ + 8 * rc_); raw[3] = *(const u32x4*)(g3 + to_ + 8 * rc_); raw[4] = *(const u32x4*)(g4 + to_ + 8 * rc_); \
        rawv = *(const u32x4*)(g5 + to_ + 8 * rc_); \
        _Pragma("unroll") for (int j_ = 0; j_ < 8; ++j_) { const int sq2_ = 64 * (n_) + 8 * etq + j_; lwn[j_] = g0[(size_t)(b * SEQ + (DIR ? (SEQ - 1 - sq2_) : sq2_)) * 512 + h * 64 + ek]; } } while (0)
    __syncthreads();
    for (int i = tid; i < CS_SLOT / 4; i += 512) ((LAS unsigned*)SL(14))[i] = 0u;
    CS_LOAD(0);
    for (int n = 0; n < 32; ++n) {
        float lwv[8], cw[8];
#pragma unroll
        for (int j = 0; j < 8; ++j) lwv[j] = bf2f(lwn[j]);
        cw[0] = lwv[0];
#pragma unroll
        for (int j = 1; j < 8; ++j) cw[j] = cw[j - 1] + lwv[j];
        LAS float* PART = (LAS float*)SL(12);
        PART[etq * 64 + ek] = cw[7];
#pragma unroll
        for (int q = 1; q < 5; ++q) *(LAS u32x4*)(SL(7 + q) + rt_ * CS_RS + rc_ * 16) = raw[q];
        rawv_cur = rawv;
        if (n + 1 < 32) CS_LOAD(n + 1);
        __syncthreads();
        { float off = 0.f, tot = 0.f;
#pragma unroll
          for (int q = 0; q < 8; ++q) { const float p = PART[q * 64 + ek]; tot += p; if (q < etq) off += p; }
          const float ec = __builtin_amdgcn_exp2f(tot);
          if (etq == 0) Dl[ek] = ec;
          unsigned pa[4], pbh[4], pkh[4];
#pragma unroll
          for (int j = 0; j < 8; ++j) { const int t = 8 * etq + j; const float c = cw[j] + off, cp = c - lwv[j];
              const float e1 = __builtin_amdgcn_exp2f(c), em = __builtin_amdgcn_exp2f(-c), ep = __builtin_amdgcn_exp2f(cp);
              const float kdv = bf2f(*(const LAS bf16_t*)(SL(8) + t * CS_RS + ek * 2)), av = bf2f(*(const LAS bf16_t*)(SL(9) + t * CS_RS + ek * 2));
              const float bv = bf2f(*(const LAS bf16_t*)(SL(10) + t * CS_RS + ek * 2)), rv = bf2f(*(const LAS bf16_t*)(SL(11) + t * CS_RS + ek * 2));
              const float at = av * ep, bt = bv * em, kt = kdv * em, rtv = rv * (DIR ? ep : e1), bh = bt * ec, kh = kt * ec;
              const unsigned w01 = pk2(at, bt), w23 = pk2(kt, rtv);
              *(LAS bf16_t*)(SL(0) + t * CS_RS + ek * 2) = (bf16_t)(w01 & 0xffffu); *(LAS bf16_t*)(SL(1) + t * CS_RS + ek * 2) = (bf16_t)(w01 >> 16);
              *(LAS bf16_t*)(SL(2) + t * CS_RS + ek * 2) = (bf16_t)(w23 & 0xffffu); *(LAS bf16_t*)(SL(3) + t * CS_RS + ek * 2) = (bf16_t)(w23 >> 16);
              const unsigned hbk = pk2(bh, kh); const unsigned ha = w01 & 0xffffu, hb = hbk & 0xffffu, hk = hbk >> 16;
              if (j & 1) { pa[j >> 1] |= ha << 16; pbh[j >> 1] |= hb << 16; pkh[j >> 1] |= hk << 16; } else { pa[j >> 1] = ha; pbh[j >> 1] = hb; pkh[j >> 1] = hk; } }
          *(LAS u32x4*)(SL(4) + ek * CS_RS + etq * 16) = (u32x4){pa[0], pa[1], pa[2], pa[3]};
          *(LAS u32x4*)(SL(5) + ek * CS_RS + etq * 16) = (u32x4){pbh[0], pbh[1], pbh[2], pbh[3]};
          *(LAS u32x4*)(SL(6) + ek * CS_RS + etq * 16) = (u32x4){pkh[0], pkh[1], pkh[2], pkh[3]}; }
        __syncthreads();
        { f32x4 acc[2];
          CS_ZERO(acc); cs_mm(acc, SL(1), SL(0), mi, ni0, fr, fq); cs_mask(acc, mi, ni0, fr, fq, 0);
          cs_st_t8(SL(8), acc, mi, ni0, fr, fq);
          if (mi == ni0 || mi == ni0 + 1) { const int jd = mi - ni0;
#pragma unroll
              for (int jj = 0; jj < 2; ++jj)
#pragma unroll
                  for (int r = 0; r < 4; ++r) if (jj == jd && (4 * fq + r) == fr) acc[jj][r] += 1.f; }
          cs_st_t8(SL(13), acc, mi, ni0, fr, fq);
          CS_ZERO(acc); cs_mm(acc, SL(0), SL(2), mi, ni0, fr, fq); cs_mask(acc, mi, ni0, fr, fq, 1); cs_st_t8(SL(9), acc, mi, ni0, fr, fq);
          CS_ZERO(acc); cs_mm(acc, SL(1), SL(3), mi, ni0, fr, fq); cs_mask(acc, mi, ni0, fr, fq, DIR ? 0 : 2); cs_st_t8(SL(10), acc, mi, ni0, fr, fq);
          CS_ZERO(acc); cs_mm(acc, SL(2), SL(3), mi, ni0, fr, fq); cs_mask(acc, mi, ni0, fr, fq, DIR ? 0 : 2); cs_st_t8(SL(11), acc, mi, ni0, fr, fq); }
        __syncthreads();
        { f32x4 aS[2], aU[2];
          CS_ZERO(aS); cs_mm_tr(aS, SL(8), SL(8), mi, ni0, fr, fq); cs_st_t8(SL(1), aS, mi, ni0, fr, fq);
          __syncthreads();
#pragma unroll
          for (int it = 0; it < 5; ++it) { const int xc = (it & 1) ? 8 : 1, xa = (it & 1) ? 1 : 8, tc = (it & 1) ? 12 : 13, ta = (it & 1) ? 13 : 12;
              cs_ld_t8(aU, SL(tc), mi, ni0, fr, fq); cs_mm_tr(aU, SL(tc), SL(xc), mi, ni0, fr, fq);
              if (it < 4) { CS_ZERO(aS); cs_mm_tr(aS, SL(xc), SL(xc), mi, ni0, fr, fq); }
              cs_st_t8(SL(ta), aU, mi, ni0, fr, fq);
              if (it < 4) cs_st_t8(SL(xa), aS, mi, ni0, fr, fq);
              __syncthreads(); } }
        { f32x4 acc[2];
          CS_ZERO(acc); cs_mm(acc, SL(12), SL(4), mi, ni0, fr, fq); cs_st_t8(SL(0), acc, mi, ni0, fr, fq);
          CS_ZERO(acc); cs_mm(acc, SL(12), SL(9), mi, ni0, fr, fq); cs_st_t8(SL(1), acc, mi, ni0, fr, fq); }
        __syncthreads();
        { f32x4 acc[2];
          CS_ZERO(acc);
          if (mi == ni0 || mi == ni0 + 1) { const int jd = mi - ni0; const float dv = Dl[16 * mi + fr];
#pragma unroll
              for (int jj = 0; jj < 2; ++jj)
#pragma unroll
                  for (int r = 0; r < 4; ++r) if (jj == jd && (4 * fq + r) == fr) acc[jj][r] = dv; }
          cs_mm(acc, SL(0), SL(5), mi, ni0, fr, fq); cs_st_t8(SL(7), acc, mi, ni0, fr, fq);
          cs_ld_t8(acc, SL(3), mi, ni0, fr, fq); cs_mm(acc, SL(0), SL(10), mi, ni0, fr, fq); cs_st_t8(SL(8), acc, mi, ni0, fr, fq);
          cs_ld_t8(acc, SL(6), mi, ni0, fr, fq); cs_mm(acc, SL(1), SL(5), mi, ni0, fr, fq); cs_st_t8(SL(12), acc, mi, ni0, fr, fq);
          cs_ld_t8(acc, SL(11), mi, ni0, fr, fq); cs_mm(acc, SL(1), SL(10), mi, ni0, fr, fq); cs_st_t8(SL(13), acc, mi, ni0, fr, fq);
          const unsigned w4[4] = {rawv_cur.x, rawv_cur.y, rawv_cur.z, rawv_cur.w};
#pragma unroll
          for (int e = 0; e < 8; ++e) *(LAS bf16_t*)(SL(2) + (8 * rc_ + e) * CS_RS + rt_ * 2) = (bf16_t)((e & 1) ? (w4[e >> 1] >> 16) : (w4[e >> 1] & 0xffffu)); }
        __syncthreads();
        { const LAS unsigned char* PH = SL(7) + (16 * wave + fr) * CS_RS; const LAS unsigned char* PS = SL(12) + (16 * wave + fr) * CS_RS;
          f32x4 acc[4] = {(f32x4){0.f, 0.f, 0.f, 0.f}, (f32x4){0.f, 0.f, 0.f, 0.f}, (f32x4){0.f, 0.f, 0.f, 0.f}, (f32x4){0.f, 0.f, 0.f, 0.f}};
#pragma unroll
          for (int s2 = 0; s2 < 2; ++s2) { const bf16x8 bph = *(const LAS bf16x8*)(PH + (32 * s2 + 8 * fq) * 2), bps = *(const LAS bf16x8*)(PS + (32 * s2 + 8 * fq) * 2);
#pragma unroll
              for (int m2 = 0; m2 < 4; ++m2) { const bf16x8 as = cs_afrag_tr(SL(14), m2, s2, fr, fq), av = *(const LAS bf16x8*)(SL(2) + (16 * m2 + fr) * CS_RS + (32 * s2 + 8 * fq) * 2);
                  acc[m2] = __builtin_amdgcn_mfma_f32_16x16x32_bf16(as, bph, acc[m2], 0, 0, 0); acc[m2] = __builtin_amdgcn_mfma_f32_16x16x32_bf16(av, bps, acc[m2], 0, 0, 0); } }
          __syncthreads();
          if (wave < 4) {
#pragma unroll
              for (int m2 = 0; m2 < 4; ++m2) { u32x2 w; w.x = pk2(acc[m2][0], acc[m2][1]); w.y = pk2(acc[m2][2], acc[m2][3]);
                  *(LAS u32x2*)(SL(14) + (16 * wave + fr) * CS_RS + (16 * m2 + 4 * fq) * 2) = w; }
          } else { const int sq = 64 * n + 16 * (wave - 4) + fr; const size_t tok = (size_t)(b * SEQ + (DIR ? (SEQ - 1 - sq) : sq));
#pragma unroll
              for (int m2 = 0; m2 < 4; ++m2) { u32x2 w; w.x = pk2(acc[m2][0], acc[m2][1]); w.y = pk2(acc[m2][2], acc[m2][3]); *(u32x2*)(Y + tok * 512 + h * 64 + 16 * m2 + 4 * fq) = w; } } }
        __syncthreads();
    }
#undef CS_LOAD
#undef SL
}
__device__ __forceinline__ void phase_scan(const Frame& F) {
    for (int job = F.vcu; job < 256; job += F.G) {
        const int chain = job >> 1, half = job & 1, dir = chain & 1, bh = chain >> 1, b = bh >> 3, h = bh & 7;
        if (dir) scan_job<1>(F, b, h, half, job); else scan_job<0>(F, b, h, half, job);
    }
}

__device__ __forceinline__ void phase_attn_range(const Frame& F, int u_first, int u_stride) {
    const int tid = F.tid, lane = F.lane, wave = F.wave, r32 = lane & 31, hi = lane >> 5;
    LAS unsigned char* lds = F.lds;
    const bf16_t *QH = wsp<bf16_t>(F.ws, A_QH), *KH = wsp<bf16_t>(F.ws, A_KH), *VT = wsp<bf16_t>(F.ws, A_VT0); bf16_t* YC = wsp<bf16_t>(F.ws, A_YCAT);
    const int skey = tid >> 3, sc = tid & 7;
    for (int u = u_first; u < 512; u += u_stride) {
        const int b = u >> 6, g = (u >> 5) & 1, qt = u & 31;
        const int head = 4 * g + (wave >> 1); const int qrow = b * SEQ + qt * 64 + 32 * (wave & 1) + r32;
        bf16x8 qf[4];
#pragma unroll
        for (int s = 0; s < 4; ++s) qf[s] = *(const bf16x8*)(QH + (size_t)qrow * 512 + head * 64 + 16 * s + 8 * hi);
        const bf16_t* ksrc = KH + (size_t)(b * SEQ + skey) * 128 + g * 64 + 8 * sc;
        const bf16_t* vsrc = VT + ((size_t)(b * 2 + g) * 64 + skey) * SEQ + 8 * sc;
        const int kdst = skey * 128 + ((sc ^ (skey & 7)) * 16), vdst = 16384 + skey * 128 + ((sc ^ ((skey >> 1) & 7)) * 16);
        u32x4 kst = *(const u32x4*)ksrc, vst = *(const u32x4*)vsrc;
        __syncthreads();
        *(LAS u32x4*)(lds + kdst) = kst; *(LAS u32x4*)(lds + vdst) = vst;
        __syncthreads();
        f32x16 o0 = {}, o1 = {}; float mrun = -1e30f, lrun = 0.f;
        for (int t = 0; t < SEQ / 64; ++t) {
            if (t + 1 < SEQ / 64) { kst = *(const u32x4*)(ksrc + (size_t)(t + 1) * 64 * 128); vst = *(const u32x4*)(vsrc + (t + 1) * 64); }
            const int bo = (t & 1) * 8192;
            f32x16 c0 = {}, c1 = {};
#pragma unroll
            for (int s = 0; s < 4; ++s) { const int ch = 2 * s + hi;
                const bf16x8 k0 = *(const LAS bf16x8*)(lds + bo + r32 * 128 + ((ch ^ (r32 & 7)) * 16));
                const bf16x8 k1 = *(const LAS bf16x8*)(lds + bo + (32 + r32) * 128 + ((ch ^ (r32 & 7)) * 16));
                c0 = __builtin_amdgcn_mfma_f32_32x32x16_bf16(k0, qf[s], c0, 0, 0, 0);
                c1 = __builtin_amdgcn_mfma_f32_32x32x16_bf16(k1, qf[s], c1, 0, 0, 0); }
            float mx = c0[0];
#pragma unroll
            for (int r = 0; r < 16; ++r) { mx = fmaxf(mx, c0[r]); mx = fmaxf(mx, c1[r]); }
            mx = fmaxf(mx, __shfl_xor(mx, 32));
            const float mnew = fmaxf(mrun, mx); const float alpha = __builtin_amdgcn_exp2f(mrun - mnew); mrun = mnew;
            float ls = 0.f;
#pragma unroll
            for (int r = 0; r < 16; ++r) { c0[r] = __builtin_amdgcn_exp2f(c0[r] - mnew); c1[r] = __builtin_amdgcn_exp2f(c1[r] - mnew); ls += c0[r] + c1[r]; }
            lrun = lrun * alpha + ls;
#pragma unroll
            for (int r = 0; r < 16; ++r) { o0[r] *= alpha; o1[r] *= alpha; }
            bf16x8 pf[2][2];
#pragma unroll
            for (int s2 = 0; s2 < 2; ++s2) { u32x4 w0, w1;
                w0.x = pk2(c0[8 * s2 + 0], c0[8 * s2 + 1]); w0.y = pk2(c0[8 * s2 + 2], c0[8 * s2 + 3]); w0.z = pk2(c0[8 * s2 + 4], c0[8 * s2 + 5]); w0.w = pk2(c0[8 * s2 + 6], c0[8 * s2 + 7]);
                w1.x = pk2(c1[8 * s2 + 0], c1[8 * s2 + 1]); w1.y = pk2(c1[8 * s2 + 2], c1[8 * s2 + 3]); w1.z = pk2(c1[8 * s2 + 4], c1[8 * s2 + 5]); w1.w = pk2(c1[8 * s2 + 6], c1[8 * s2 + 7]);
                pf[0][s2] = __builtin_bit_cast(bf16x8, w0); pf[1][s2] = __builtin_bit_cast(bf16x8, w1); }
            const int vb = 16384 + bo;
#pragma unroll
            for (int dblk = 0; dblk < 2; ++dblk) { const int d = 32 * dblk + r32; const int sw = (d >> 1) & 7;
#pragma unroll
                for (int blk = 0; blk < 2; ++blk)
#pragma unroll
                    for (int s2 = 0; s2 < 2; ++s2) { const int ch = 4 * blk + 2 * s2;
                        const u32x2 lo = *(const LAS u32x2*)(lds + vb + d * 128 + ((ch ^ sw) * 16) + hi * 8);
                        const u32x2 hh = *(const LAS u32x2*)(lds + vb + d * 128 + (((ch + 1) ^ sw) * 16) + hi * 8);
                        const u32x4 vv = {lo.x, lo.y, hh.x, hh.y};
                        if (dblk == 0) o0 = __builtin_amdgcn_mfma_f32_32x32x16_bf16(__builtin_bit_cast(bf16x8, vv), pf[blk][s2], o0, 0, 0, 0);
                        else           o1 = __builtin_amdgcn_mfma_f32_32x32x16_bf16(__builtin_bit_cast(bf16x8, vv), pf[blk][s2], o1, 0, 0, 0); } }
            if (t + 1 < SEQ / 64) { const int nb = ((t + 1) & 1) * 8192; *(LAS u32x4*)(lds + nb + kdst) = kst; *(LAS u32x4*)(lds + nb + vdst) = vst; }
            __syncthreads();
        }
        const float ltot = lrun + __shfl_xor(lrun, 32); const float inv = 1.f / ltot;
        bf16_t* op = YC + (size_t)qrow * 1024 + 512 + head * 64 + 4 * hi;
#pragma unroll
        for (int q4 = 0; q4 < 4; ++q4) { u32x2 w0, w1;
            w0.x = pk2(o0[4 * q4 + 0] * inv, o0[4 * q4 + 1] * inv); w0.y = pk2(o0[4 * q4 + 2] * inv, o0[4 * q4 + 3] * inv);
            w1.x = pk2(o1[4 * q4 + 0] * inv, o1[4 * q4 + 1] * inv); w1.y = pk2(o1[4 * q4 + 2] * inv, o1[4 * q4 + 3] * inv);
            *(u32x2*)(op + 8 * q4) = w0; *(u32x2*)(op + 32 + 8 * q4) = w1; }
    }
}

__device__ __forceinline__ void phase_attn(const Frame& F) { phase_attn_range(F, F.vcu, F.G); }
__device__ __forceinline__ void phase_cscan_attn_split(const Frame& F) {
    const int half_g = F.G >> 1, me = F.vcu >> 1;
    if ((F.vcu & 1) == 0) {
        for (int chain = me; chain < 128; chain += half_g) { const int dir = chain & 1, bh = chain >> 1, b = bh >> 3, h = bh & 7;
            if (dir) cscan_job<1>(F, b, h); else cscan_job<0>(F, b, h); }
    } else {
        for (int u4 = me; u4 * 4 < 512; u4 += half_g) for (int q = 0; q < 4; ++q) phase_attn_range(F, u4 * 4 + q, 1 << 30);
        __syncthreads();
        conv_experts_down(F, me * NWAVES + F.wave, half_g * NWAVES);
    }
}
__device__ __forceinline__ void phase_rwkv_post(const Frame& F) {
    const int gw = F.vcu * NWAVES + F.wave, lane = F.lane;
    const bf16_t *YF = wsp<bf16_t>(F.ws, A_YF), *YB = wsp<bf16_t>(F.ws, A_YB);
    const bf16_t *RS = wsp<bf16_t>(F.ws, A_RS), *VS = wsp<bf16_t>(F.ws, A_VS), *KDF = wsp<bf16_t>(F.ws, A_KDF), *GG = wsp<bf16_t>(F.ws, A_GG);
    bf16_t* YC = wsp<bf16_t>(F.ws, A_YCAT);
    const int c0 = 8 * lane;
    float gw_[8], gb_[8], rk_[8];
#pragma unroll
    for (int i = 0; i < 8; ++i) { gw_[i] = F.in[16][c0 + i]; gb_[i] = F.in[17][c0 + i]; rk_[i] = F.in[15][c0 + i]; }
    for (int tok = gw; tok < M_TOK; tok += F.G * NWAVES) { const size_t o = (size_t)tok * 512 + c0;
        const u32x4 yfw = *(const u32x4*)(YF + o), ybw = *(const u32x4*)(YB + o);
        float y[8]; float sm = 0.f;
        y[0] = bflo(yfw.x) + bflo(ybw.x); y[1] = bfhi(yfw.x) + bfhi(ybw.x); y[2] = bflo(yfw.y) + bflo(ybw.y); y[3] = bfhi(yfw.y) + bfhi(ybw.y);
        y[4] = bflo(yfw.z) + bflo(ybw.z); y[5] = bfhi(yfw.z) + bfhi(ybw.z); y[6] = bflo(yfw.w) + bflo(ybw.w); y[7] = bfhi(yfw.w) + bfhi(ybw.w);
#pragma unroll
        for (int i = 0; i < 8; ++i) sm += y[i];
        sm += __shfl_xor(sm, 1); sm += __shfl_xor(sm, 2); sm += __shfl_xor(sm, 4);
        const float mean = sm * (1.f / 64.f); float sv = 0.f;
#pragma unroll
        for (int i = 0; i < 8; ++i) { y[i] -= mean; sv += y[i] * y[i]; }
        sv += __shfl_xor(sv, 1); sv += __shfl_xor(sv, 2); sv += __shfl_xor(sv, 4);
        const float rstd = 1.0f / sqrtf(sv * (1.f / 64.f) + 64e-5f);
        const u32x4 rw = *(const u32x4*)(RS + o), vw = *(const u32x4*)(VS + o), kw = *(const u32x4*)(KDF + o), gw4 = *(const u32x4*)(GG + o);
        const float r8[8] = {bflo(rw.x), bfhi(rw.x), bflo(rw.y), bfhi(rw.y), bflo(rw.z), bfhi(rw.z), bflo(rw.w), bfhi(rw.w)};
        const float v8[8] = {bflo(vw.x), bfhi(vw.x), bflo(vw.y), bfhi(vw.y), bflo(vw.z), bfhi(vw.z), bflo(vw.w), bfhi(vw.w)};
        const float k8[8] = {bflo(kw.x), bfhi(kw.x), bflo(kw.y), bfhi(kw.y), bflo(kw.z), bfhi(kw.z), bflo(kw.w), bfhi(kw.w)};
        const float g8[8] = {bflo(gw4.x), bfhi(gw4.x), bflo(gw4.y), bfhi(gw4.y), bflo(gw4.z), bfhi(gw4.z), bflo(gw4.w), bfhi(gw4.w)};
        float bs = 0.f;
#pragma unroll
        for (int i = 0; i < 8; ++i) bs += r8[i] * k8[i] * rk_[i];
        bs += __shfl_xor(bs, 1); bs += __shfl_xor(bs, 2); bs += __shfl_xor(bs, 4);
        float ov[8];
#pragma unroll
        for (int i = 0; i < 8; ++i) ov[i] = ((y[i] * rstd) * gw_[i] + gb_[i] + bs * v8[i]) * g8[i];
        u32x4 w; w.x = pk2(ov[0], ov[1]); w.y = pk2(ov[2], ov[3]); w.z = pk2(ov[4], ov[5]); w.w = pk2(ov[6], ov[7]);
        *(u32x4*)(YC + (size_t)tok * 1024 + c0) = w; }
}

__device__ __forceinline__ void phase_gd(const Frame& F) {
    const int tid = F.tid, lane = F.lane, wave = F.wave, fr = lane & 15, fq = lane >> 4;
    LAS f32x4* PL = (LAS f32x4*)F.lds;
    const bf16_t* XB = wsp<bf16_t>(F.ws, WS_XB); const bf16_t* WG = wsp<bf16_t>(F.ws, WS_WIN1) + (size_t)3072 * 1024; const float* ssq = wsp<float>(F.ws, WS_SSQ2); bf16_t* P1 = wsp<bf16_t>(F.ws, A_P1);
    const int tpb = M_TOK / F.G;
    for (int t0 = F.vcu * tpb; t0 < (F.vcu + 1) * tpb; t0 += 64) {
        f32x4 acc[4];
#pragma unroll
        for (int t = 0; t < 4; ++t) acc[t] = (f32x4){0.f, 0.f, 0.f, 0.f};
#pragma unroll
        for (int s4 = 0; s4 < 4; ++s4) { const int k0 = 32 * (4 * wave + s4) + 8 * fq;
            const bf16x8 bfr = *(const bf16x8*)(WG + (size_t)fr * 1024 + k0);
#pragma unroll
            for (int t = 0; t < 4; ++t) { const bf16x8 afr = *(const bf16x8*)(XB + (size_t)(t0 + 16 * t + fr) * 1024 + k0);
                acc[t] = __builtin_amdgcn_mfma_f32_16x16x32_bf16(afr, bfr, acc[t], 0, 0, 0); } }
        __syncthreads();
#pragma unroll
        for (int t = 0; t < 4; ++t) PL[(wave * 4 + t) * 64 + lane] = acc[t];
        __syncthreads();
        if (tid < 256) { const int t = tid >> 6, l = tid & 63; f32x4 sum = PL[t * 64 + l];
#pragma unroll
            for (int w = 1; w < 8; ++w) sum += PL[(w * 4 + t) * 64 + l];
            const int lfr = l & 15, lfq = l >> 4;
#pragma unroll
            for (int r = 0; r < 4; ++r) { const int tok = t0 + 16 * t + 4 * lfq + r; P1[(size_t)tok * O_INP + 3072 + lfr] = f2bf(sum[r] * rstd_from_ssq(ssq, tok)); } }
    }
}

constexpr float GLA_QSCALE = 0.08838834764831845f;
__device__ __forceinline__ size_t gla_dir(size_t base, int dir) { return base + (size_t)dir * GLA_DIR_STRIDE; }
__device__ __forceinline__ float logsig16(float z) { return (fminf(z, 0.f) - __logf(1.f + __expf(-fabsf(z)))) * (1.f / 16.f); }
__device__ __forceinline__ void phase_gla_prep(const Frame& F) {
    const int tid = F.tid, lane = F.lane, wave = F.wave, fr = lane & 15, fq = lane >> 4;
    LAS float* GD = (LAS float*)F.lds;
    LAS float* PT = (LAS float*)(F.lds + 4096);
    LAS unsigned char* QTt = F.lds + 10240;
    LAS unsigned char* KTt = F.lds + 10240 + 17408;
    LAS unsigned char* RV = F.lds + 10240;
    LAS unsigned char* RQ = F.lds + 45056; LAS unsigned char* RK = F.lds + 45056 + 16384;
    LAS unsigned char* ATT = F.lds + 45056;
    LAS unsigned char* QHl = F.lds + 45056 + 9216;
    LAS unsigned char* VTt = F.lds + 77824;
    const bf16_t* P1 = wsp<bf16_t>(F.ws, A_P1);
    bf16_t* VT = wsp<bf16_t>(F.ws, A_VT1); float* DECS = wsp<float>(F.ws, WS_DECS); bf16_t* OF = wsp<bf16_t>(F.ws, A_OF);
    const int d = tid & 127, qr = tid >> 7;
    for (int unit = F.vcu; unit < BATCH * GLA_H * 32; unit += F.G) {
        const int n = unit & 31, h = (unit >> 5) & 3, b = unit >> 7; const int T0 = b * SEQ + 64 * n; const size_t tile = (size_t)(b * 4 + h) * 32 + n;
        __syncthreads();
        for (int i = tid; i < 1024; i += 512) GD[i] = bf2f(P1[(size_t)(T0 + (i >> 4)) * O_INP + 3072 + (i & 15)]);
#pragma unroll
        for (int i = 0; i < 2; ++i) { const int p = tid + 512 * i, row = p >> 4, c = p & 15; const bf16_t* src = P1 + (size_t)(T0 + row) * O_INP + h * 128 + 8 * c;
            *(LAS u32x4*)(RQ + row * 256 + c * 16) = *(const u32x4*)src; *(LAS u32x4*)(RK + row * 256 + c * 16) = *(const u32x4*)(src + 512); }
#pragma unroll
        for (int i = 0; i < 4; ++i) { const int p = tid + 512 * i, row = p >> 5, c = p & 31;
            *(LAS u32x4*)(RV + row * 512 + c * 16) = *(const u32x4*)(P1 + (size_t)(T0 + row) * O_INP + 1024 + h * 256 + 8 * c); }
        float upf[16], upb[16];
#pragma unroll
        for (int r = 0; r < 16; ++r) { upf[r] = F.in[27][r * 512 + h * 128 + d]; upb[r] = F.in[29][r * 512 + h * 128 + d]; }
        const float bif = F.in[28][h * 128 + d], bib = F.in[30][h * 128 + d];
        __syncthreads();
        bf16_t qraw[16], kraw[16];
#pragma unroll
        for (int j = 0; j < 16; ++j) { qraw[j] = *(const LAS bf16_t*)(RQ + (16 * qr + j) * 256 + d * 2); kraw[j] = *(const LAS bf16_t*)(RK + (16 * qr + j) * 256 + d * 2); }
        { const int dv = tid & 255, th = tid >> 8; unsigned pk[16];
#pragma unroll
          for (int j = 0; j < 16; ++j) pk[j] = (unsigned)*(const LAS bf16_t*)(RV + (32 * th + 2 * j) * 512 + dv * 2) | ((unsigned)*(const LAS bf16_t*)(RV + (32 * th + 2 * j + 1) * 512 + dv * 2) << 16);
          bf16_t* gdst = VT + tile * 16384 + dv * 64 + 32 * th;
#pragma unroll
          for (int q = 0; q < 4; ++q) { const u32x4 w = {pk[4 * q], pk[4 * q + 1], pk[4 * q + 2], pk[4 * q + 3]}; *(u32x4*)(gdst + 8 * q) = w; *(LAS u32x4*)(VTt + dv * 144 + (32 * th + 8 * q) * 2) = w; } }
        float Bf[16], Bb[16];
#pragma unroll
        for (int j = 0; j < 16; ++j) { const LAS f32x4* gp = (const LAS f32x4*)(GD + (16 * qr + j) * 16); float zf = bif, zb = bib;
#pragma unroll
            for (int q = 0; q < 4; ++q) { const f32x4 g4 = gp[q];
#pragma unroll
                for (int e = 0; e < 4; ++e) { zf += g4[e] * upf[4 * q + e]; zb += g4[e] * upb[4 * q + e]; } }
            Bf[j] = logsig16(zf); Bb[j] = logsig16(zb); }
#pragma unroll
        for (int j = 1; j < 16; ++j) Bf[j] += Bf[j - 1];
#pragma unroll
        for (int j = 14; j >= 0; --j) Bb[j] += Bb[j + 1];
        PT[(0 * 4 + qr) * 128 + d] = Bf[15]; PT[(1 * 4 + qr) * 128 + d] = Bb[0];
        if (qr == 2) PT[1024 + d] = Bf[0];
        if (qr == 1) PT[1024 + 128 + d] = Bb[15];
        __syncthreads();
        float offf = 0.f, offb = 0.f, totf = 0.f, totb = 0.f, pre2f = 0.f, suf2b = 0.f;
#pragma unroll
        for (int q = 0; q < 4; ++q) { const float pf = PT[q * 128 + d], pb = PT[(4 + q) * 128 + d]; totf += pf; totb += pb; if (q < qr) offf += pf; if (q > qr) offb += pb; if (q < 2) pre2f += pf; if (q >= 2) suf2b += pb; }
        const float bmf = pre2f + PT[1024 + d], bmb = suf2b + PT[1024 + 128 + d];
#pragma unroll
        for (int j = 0; j < 16; ++j) { Bf[j] += offf; Bb[j] += offb; }
        f32x4 oacc[2][4];
#pragma unroll
        for (int x = 0; x < 2; ++x)
#pragma unroll
            for (int y = 0; y < 4; ++y) oacc[x][y] = (f32x4){0.f, 0.f, 0.f, 0.f};
#pragma unroll
        for (int dir = 0; dir < 2; ++dir) {
            const float bm = dir ? bmb : bmf, bl = dir ? totb : totf; const float ebm = __expf(bm), ebl = __expf(bl - bm);
            bf16_t* QHT = wsp<bf16_t>(F.ws, gla_dir(A_QHAT, dir)) + tile * 8192; bf16_t* K2T = wsp<bf16_t>(F.ws, gla_dir(A_K2T, dir)) + tile * 8192;
            unsigned k2pk[8];
#pragma unroll
            for (int j = 0; j < 16; ++j) { const float bv = dir ? Bb[j] : Bf[j]; const float e1 = __expf(bv - bm), r1 = __builtin_amdgcn_rcpf(e1);
                const float qs = bf2f(qraw[j]) * GLA_QSCALE, kk = bf2f(kraw[j]); const int tk = 16 * qr + j;
                const float qt = qs * e1, kt = kk * r1, qh = qt * ebm, k2 = kt * ebl;
                *(LAS bf16_t*)(QTt + tk * 272 + d * 2) = f2bf(qt); *(LAS bf16_t*)(KTt + tk * 272 + d * 2) = f2bf(kt); *(LAS bf16_t*)(QHl + tk * 272 + d * 2) = f2bf(qh);
                if (j & 1) k2pk[j >> 1] |= ((unsigned)f2bf(k2)) << 16; else k2pk[j >> 1] = (unsigned)f2bf(k2); }
            { bf16_t* kd = K2T + d * 64 + 16 * qr;
              *(u32x4*)kd = (u32x4){k2pk[0], k2pk[1], k2pk[2], k2pk[3]}; *(u32x4*)(kd + 8) = (u32x4){k2pk[4], k2pk[5], k2pk[6], k2pk[7]}; }
            if (qr == 0) DECS[((size_t)((b * 4 + h) * 2 + dir) * 32 + n) * 128 + d] = __expf(bl);
            __syncthreads();
#pragma unroll
            for (int i = 0; i < 2; ++i) { const int p = tid + 512 * i, row = p >> 4, c = p & 15; *(u32x4*)(QHT + row * 128 + c * 8) = *(const LAS u32x4*)(QHl + row * 272 + c * 16); }
            { const int ib = wave >> 1, jb0 = 2 * (wave & 1); f32x4 at[2] = {(f32x4){0.f, 0.f, 0.f, 0.f}, (f32x4){0.f, 0.f, 0.f, 0.f}};
#pragma unroll
              for (int s2 = 0; s2 < 4; ++s2) { const bf16x8 a = *(const LAS bf16x8*)(QTt + (16 * ib + fr) * 272 + (32 * s2 + 8 * fq) * 2);
#pragma unroll
                  for (int jj = 0; jj < 2; ++jj) { const bf16x8 bb = *(const LAS bf16x8*)(KTt + (16 * (jb0 + jj) + fr) * 272 + (32 * s2 + 8 * fq) * 2);
                      at[jj] = __builtin_amdgcn_mfma_f32_16x16x32_bf16(a, bb, at[jj], 0, 0, 0); } }
#pragma unroll
              for (int jj = 0; jj < 2; ++jj)
#pragma unroll
                  for (int r = 0; r < 4; ++r) { const int i = 16 * ib + 4 * fq + r, j = 16 * (jb0 + jj) + fr; const bool keep = dir ? (j > i) : (j <= i);
                      *(LAS bf16_t*)(ATT + i * 144 + j * 2) = f2bf(keep ? at[jj][r] : 0.f); } }
            __syncthreads();
#pragma unroll
            for (int s2 = 0; s2 < 2; ++s2) { bf16x8 bfr[4];
#pragma unroll
                for (int ib = 0; ib < 4; ++ib) bfr[ib] = *(const LAS bf16x8*)(ATT + (16 * ib + fr) * 144 + (32 * s2 + 8 * fq) * 2);
#pragma unroll
                for (int x = 0; x < 2; ++x) { const bf16x8 a = *(const LAS bf16x8*)(VTt + (16 * (2 * wave + x) + fr) * 144 + (32 * s2 + 8 * fq) * 2);
#pragma unroll
                    for (int ib = 0; ib < 4; ++ib) oacc[x][ib] = __builtin_amdgcn_mfma_f32_16x16x32_bf16(a, bfr[ib], oacc[x][ib], 0, 0, 0); } }
        }
#pragma unroll
        for (int x = 0; x < 2; ++x)
#pragma unroll
            for (int ib = 0; ib < 4; ++ib) { u32x2 w; w.x = pk2(oacc[x][ib][0], oacc[x][ib][1]); w.y = pk2(oacc[x][ib][2], oacc[x][ib][3]);
                *(u32x2*)(OF + (size_t)(T0 + 16 * ib + fr) * 1024 + h * 256 + 16 * (2 * wave + x) + 4 * fq) = w; }
    }
}

template <int DIR> __device__ __forceinline__ void gla_seq_job(const Frame& F, int b, int h, int vs) {
    const int tid = F.tid, lane = F.lane, wave = F.wave, fr = lane & 15, fq = lane >> 4;
    LAS unsigned char* ST0 = F.lds; LAS unsigned char* ST1 = F.lds + 17408;
    LAS unsigned char* BUF = F.lds + 34816;
    constexpr int BQ = 0, BK2 = 17408, BVT = 17408 + 18432, BSZ = 45056;
    const bf16_t* QHT = wsp<bf16_t>(F.ws, gla_dir(A_QHAT, DIR)); const bf16_t* K2T = wsp<bf16_t>(F.ws, gla_dir(A_K2T, DIR));
    const bf16_t* VT = wsp<bf16_t>(F.ws, A_VT1); const float* DECS = wsp<float>(F.ws, WS_DECS); bf16_t* OF = wsp<bf16_t>(F.ws, A_OF); bf16_t* O = DIR ? wsp<bf16_t>(F.ws, A_OB) : OF;
    const int dvb = wave >> 1, ib0 = 2 * (wave & 1);
    const size_t tile0 = (size_t)(b * 4 + h) * 32;
    const int q0 = tid, q1 = tid + 512;
    const int dq0 = BQ + (q0 >> 4) * 272 + (q0 & 15) * 16, dq1 = BQ + (q1 >> 4) * 272 + (q1 & 15) * 16;
    const int dk0 = BK2 + (q0 >> 3) * 144 + (q0 & 7) * 16, dk1 = BK2 + (q1 >> 3) * 144 + (q1 & 7) * 16;
    const int dv0 = BVT + (q0 >> 3) * 144 + (q0 & 7) * 16;
    u32x4 sg[5]; f32x4 dec, decn; u32x2 oold[2], ooldn[2];
#define GL_LD(n_) do { const size_t t_ = tile0 + (n_); \
        sg[0] = *(const u32x4*)(QHT + t_ * 8192 + q0 * 8); sg[1] = *(const u32x4*)(QHT + t_ * 8192 + q1 * 8); \
        sg[2] = *(const u32x4*)(K2T + t_ * 8192 + q0 * 8); sg[3] = *(const u32x4*)(K2T + t_ * 8192 + q1 * 8); \
        sg[4] = *(const u32x4*)(VT + t_ * 16384 + vs * 4096 + q0 * 8); \
        decn = *(const f32x4*)(DECS + ((size_t)((b * 4 + h) * 2 + DIR) * 32 + (n_)) * 128 + 16 * wave + 4 * fq); \
        if (!DIR) { _Pragma("unroll") for (int ii = 0; ii < 2; ++ii) ooldn[ii] = *(const u32x2*)(OF + (size_t)(b * SEQ + 64 * (n_) + 16 * (ib0 + ii) + fr) * 1024 + h * 256 + 64 * vs + 16 * dvb + 4 * fq); } } while (0)
#define GL_ST(bp) do { *(LAS u32x4*)((bp) + dq0) = sg[0]; *(LAS u32x4*)((bp) + dq1) = sg[1]; *(LAS u32x4*)((bp) + dk0) = sg[2]; *(LAS u32x4*)((bp) + dk1) = sg[3]; *(LAS u32x4*)((bp) + dv0) = sg[4]; } while (0)
    __syncthreads();
    for (int i = tid; i < 17408 / 4; i += 512) ((LAS unsigned*)ST0)[i] = 0u;
    f32x4 st[4];
#pragma unroll
    for (int k = 0; k < 4; ++k) st[k] = (f32x4){0.f, 0.f, 0.f, 0.f};
    GL_LD(DIR ? 31 : 0); GL_ST(BUF); dec = decn; oold[0] = ooldn[0]; oold[1] = ooldn[1];
    __syncthreads();
    for (int cc = 0; cc < 32; ++cc) { const int n = DIR ? 31 - cc : cc, nn = DIR ? 30 - cc : cc + 1; const int T0 = b * SEQ + 64 * n;
        LAS unsigned char* STr = (cc & 1) ? ST1 : ST0; LAS unsigned char* STw = (cc & 1) ? ST0 : ST1;
        LAS unsigned char* bc = BUF + (cc & 1) * BSZ; LAS unsigned char* bn = BUF + ((cc + 1) & 1) * BSZ;
        if (cc + 1 < 32) GL_LD(nn);
#pragma unroll
        for (int x = 0; x < 4; ++x) st[x] = st[x] * dec;
        f32x4 oo[2] = {(f32x4){0.f, 0.f, 0.f, 0.f}, (f32x4){0.f, 0.f, 0.f, 0.f}};
#pragma unroll
        for (int s2 = 0; s2 < 4; ++s2) { const bf16x8 a = *(const LAS bf16x8*)(STr + (16 * dvb + fr) * 272 + (32 * s2 + 8 * fq) * 2);
#pragma unroll
            for (int ii = 0; ii < 2; ++ii) { const bf16x8 qf = *(const LAS bf16x8*)(bc + BQ + (16 * (ib0 + ii) + fr) * 272 + (32 * s2 + 8 * fq) * 2);
                oo[ii] = __builtin_amdgcn_mfma_f32_16x16x32_bf16(a, qf, oo[ii], 0, 0, 0); } }
#pragma unroll
        for (int s2 = 0; s2 < 2; ++s2) { const bf16x8 kf = *(const LAS bf16x8*)(bc + BK2 + (16 * wave + fr) * 144 + (32 * s2 + 8 * fq) * 2);
#pragma unroll
            for (int x = 0; x < 4; ++x) { const bf16x8 vf = *(const LAS bf16x8*)(bc + BVT + (16 * x + fr) * 144 + (32 * s2 + 8 * fq) * 2);
                st[x] = __builtin_amdgcn_mfma_f32_16x16x32_bf16(kf, vf, st[x], 0, 0, 0); } }
#pragma unroll
        for (int x = 0; x < 4; ++x) { u32x2 w; w.x = pk2(st[x][0], st[x][1]); w.y = pk2(st[x][2], st[x][3]); *(LAS u32x2*)(STw + (16 * x + fr) * 272 + (16 * wave + 4 * fq) * 2) = w; }
#pragma unroll
        for (int ii = 0; ii < 2; ++ii) { f32x4 v = oo[ii];
            if (!DIR) { v[0] += bflo(oold[ii].x); v[1] += bfhi(oold[ii].x); v[2] += bflo(oold[ii].y); v[3] += bfhi(oold[ii].y); }
            u32x2 w; w.x = pk2(v[0], v[1]); w.y = pk2(v[2], v[3]);
            *(u32x2*)(O + (size_t)(T0 + 16 * (ib0 + ii) + fr) * 1024 + h * 256 + 64 * vs + 16 * dvb + 4 * fq) = w; }
        if (cc + 1 < 32) { GL_ST(bn); dec = decn; oold[0] = ooldn[0]; oold[1] = ooldn[1]; }
        __syncthreads(); }
#undef GL_LD
#undef GL_ST
}
__device__ __forceinline__ void phase_gla_main(const Frame& F) {
    for (int job = F.vcu; job < 256; job += F.G) { const int vs = job & 3, dir = (job >> 2) & 1, h = (job >> 3) & 3, b = job >> 5;
        if (dir) gla_seq_job<1>(F, b, h, vs); else gla_seq_job<0>(F, b, h, vs); }
}

__device__ __forceinline__ void phase_gla_post(const Frame& F) {
    const int gw = F.vcu * NWAVES + F.wave, lane = F.lane; const int c0 = 16 * lane;
    const bf16_t *OF = wsp<bf16_t>(F.ws, A_OF), *OB = wsp<bf16_t>(F.ws, A_OB), *P1 = wsp<bf16_t>(F.ws, A_P1); bf16_t* GO = wsp<bf16_t>(F.ws, A_GOUT);
    float gn[16];
#pragma unroll
    for (int i = 0; i < 16; ++i) gn[i] = F.in[31][(c0 + i) & 255];
    for (int tok = gw; tok < M_TOK; tok += F.G * NWAVES) { const size_t o = (size_t)tok * 1024 + c0;
        float v[16]; float ss = 0.f;
#pragma unroll
        for (int hh = 0; hh < 2; ++hh) { const u32x4 a = *(const u32x4*)(OF + o + 8 * hh), bq = *(const u32x4*)(OB + o + 8 * hh);
            v[8 * hh + 0] = bflo(a.x) + bflo(bq.x); v[8 * hh + 1] = bfhi(a.x) + bfhi(bq.x); v[8 * hh + 2] = bflo(a.y) + bflo(bq.y); v[8 * hh + 3] = bfhi(a.y) + bfhi(bq.y);
            v[8 * hh + 4] = bflo(a.z) + bflo(bq.z); v[8 * hh + 5] = bfhi(a.z) + bfhi(bq.z); v[8 * hh + 6] = bflo(a.w) + bflo(bq.w); v[8 * hh + 7] = bfhi(a.w) + bfhi(bq.w); }
#pragma unroll
        for (int i = 0; i < 16; ++i) ss += v[i] * v[i];
        ss = dpp_row_sum(ss);
        const float rs = 1.0f / sqrtf(ss * (1.f / 256.f) + NORM_EPS);
        float og[16];
#pragma unroll
        for (int hh = 0; hh < 2; ++hh) { const u32x4 g = *(const u32x4*)(P1 + (size_t)tok * O_INP + 2048 + c0 + 8 * hh);
            og[8 * hh + 0] = bflo(g.x); og[8 * hh + 1] = bfhi(g.x); og[8 * hh + 2] = bflo(g.y); og[8 * hh + 3] = bfhi(g.y); og[8 * hh + 4] = bflo(g.z); og[8 * hh + 5] = bfhi(g.z); og[8 * hh + 6] = bflo(g.w); og[8 * hh + 7] = bfhi(g.w); }
        float r[16];
#pragma unroll
        for (int i = 0; i < 16; ++i) r[i] = v[i] * rs * gn[i] * siluf_(og[i]);
#pragma unroll
        for (int hh = 0; hh < 2; ++hh) { u32x4 w; w.x = pk2(r[8 * hh + 0], r[8 * hh + 1]); w.y = pk2(r[8 * hh + 2], r[8 * hh + 3]); w.z = pk2(r[8 * hh + 4], r[8 * hh + 5]); w.w = pk2(r[8 * hh + 6], r[8 * hh + 7]);
            *(u32x4*)(GO + o + 8 * hh) = w; } }
}

__device__ __forceinline__ void phase_route(const Frame& F) {
    const int tid = F.tid, lane = F.lane, wave = F.wave;
    LAS int* lcnt = (LAS int*)(F.lds + MOE_OFF);
    LAS float* RL = (LAS float*)F.lds;
    __syncthreads();
    if (tid < 16) lcnt[tid] = 0;
    const float* X = F.out; const float* g2 = F.in[33]; const float* RT = F.in[34];
    for (int i = tid; i < 2048; i += 512) { const int k = i >> 1; const f32x4 r = *(const f32x4*)(RT + (size_t)i * 4); *(LAS f32x4*)(RL + i * 4) = r * g2[k]; }
    __syncthreads();
    int* TE = wsp<int>(F.ws, WS_TOKE); float* TG = wsp<float>(F.ws, WS_TOKG); float* R3 = wsp<float>(F.ws, WS_RSTD3);
    const int tpb = M_TOK / F.G, tpw = tpb / NWAVES;
    for (int i0 = 0; i0 < tpw; i0 += 4) { const int tok0 = F.vcu * tpb + wave * tpw + i0;
        float acc[4][8], ss[4];
#pragma unroll
        for (int t = 0; t < 4; ++t) { ss[t] = 0.f;
#pragma unroll
            for (int e = 0; e < 8; ++e) acc[t][e] = 0.f; }
#pragma unroll
        for (int j = 0; j < 4; ++j) { const int k0 = 4 * lane + 256 * j; f32x4 xv[4];
#pragma unroll
            for (int t = 0; t < 4; ++t) xv[t] = *(const f32x4*)(X + (size_t)(tok0 + t) * 1024 + k0);
#pragma unroll
            for (int q = 0; q < 4; ++q) { const f32x4 r0 = *(const LAS f32x4*)(RL + (k0 + q) * 8), r1 = *(const LAS f32x4*)(RL + (k0 + q) * 8 + 4);
#pragma unroll
                for (int t = 0; t < 4; ++t) { const float xx = xv[t][q]; ss[t] += xx * xx;
                    acc[t][0] += xx * r0[0]; acc[t][1] += xx * r0[1]; acc[t][2] += xx * r0[2]; acc[t][3] += xx * r0[3]; acc[t][4] += xx * r1[0]; acc[t][5] += xx * r1[1]; acc[t][6] += xx * r1[2]; acc[t][7] += xx * r1[3]; } } }
#pragma unroll
        for (int t = 0; t < 4; ++t) { ss[t] = wave_sum(ss[t]);
#pragma unroll
            for (int e = 0; e < 8; ++e) acc[t][e] = wave_sum(acc[t][e]); }
        float lg[8]; float mss = 0.f;
#pragma unroll
        for (int t = 0; t < 4; ++t) { if (lane == t) { mss = ss[t];
#pragma unroll
                for (int e = 0; e < 8; ++e) lg[e] = acc[t][e]; } }
        if (lane < 4) { const int tok = tok0 + lane;
            const float rstd = 1.0f / sqrtf(mss * (1.f / 1024.f) + NORM_EPS);
            int i1 = 0; float l1 = lg[0] * rstd;
#pragma unroll
            for (int e = 1; e < 8; ++e) { const float l = lg[e] * rstd; if (l > l1) { l1 = l; i1 = e; } }
            int i2 = -1; float l2 = -3.0e38f;
#pragma unroll
            for (int e = 0; e < 8; ++e) { const float l = lg[e] * rstd; if (e != i1 && l > l2) { l2 = l; i2 = e; } }
            const float e2 = __expf(l2 - l1); const float ga = 1.f / (1.f + e2), gb = e2 / (1.f + e2);
            TE[tok * 2] = i1; TE[tok * 2 + 1] = i2; TG[tok * 2] = ga; TG[tok * 2 + 1] = gb; R3[tok] = rstd;
            atomicAdd((int*)&lcnt[i1], 1); atomicAdd((int*)&lcnt[8 + i2], 1); } }
    __syncthreads();
    if (tid < 16) wsp<int>(F.ws, WS_CNT)[F.vcu * 16 + tid] = lcnt[tid];
}
__device__ __forceinline__ void phase_place(const Frame& F) {
    const int tid = F.tid;
    LAS int* tab = (LAS int*)(F.lds + MOE_OFF);
    LAS int* C = (LAS int*)F.lds;
    LAS int* TEl = (LAS int*)(F.lds + 32768); LAS float* TGl = (LAS float*)(F.lds + 32768 + 1024);
    const int* CNT = wsp<int>(F.ws, WS_CNT); const int tpb = M_TOK / F.G;
    __syncthreads();
    for (int i = tid; i < F.G * 16; i += 512) C[i] = CNT[i];
    if (tid < 2 * tpb) { TEl[tid] = wsp<int>(F.ws, WS_TOKE)[F.vcu * tpb * 2 + tid]; TGl[tid] = wsp<float>(F.ws, WS_TOKG)[F.vcu * tpb * 2 + tid]; }
    __syncthreads();
    if (tid < 16) { int off = 0, tot = 0; for (int bb = 0; bb < F.G; ++bb) { const int c = C[bb * 16 + tid]; if (bb < F.vcu) off += c; tot += c; } tab[tid] = off; tab[16 + tid] = tot;
        if (F.vcu == 0) wsp<int>(F.ws, WS_TOT)[tid] = tot; }
    __syncthreads();
    if (tid < 16) { const int s = tid >> 3, e = tid & 7; int run = tab[tid]; for (int q = 0; q < e; ++q) run += tab[16 + q] + tab[24 + q];
        if (s) run += tab[16 + e];
        int* RTK = wsp<int>(F.ws, WS_ROWTOK); float* RGT = wsp<float>(F.ws, WS_ROWGATE);
        for (int i = 0; i < tpb; ++i) { if (TEl[i * 2 + s] == e) { RTK[run] = F.vcu * tpb + i; RGT[run] = TGl[i * 2 + s]; ++run; } } }
}
struct MoESched {
    pg8::GridOrder go; const LAS int* tab;
    const char* A; const char* Bt; size_t a_rowbytes, b_expert_bytes, b_tile_bytes; bool gather; int nt_;
    __device__ bool next(int i, pg8::Unit& u) const {
        int pm, pn; if (!go.tile(i, pm, pn)) return false;
        int e = 0;
#pragma unroll
        for (int q = 1; q < 8; ++q) if (pm >= tab[16 + q]) e = q;
        e = __builtin_amdgcn_readfirstlane(e);
        const int mt = pm - __builtin_amdgcn_readfirstlane(tab[16 + e]); const int row0 = __builtin_amdgcn_readfirstlane(tab[e]) + 256 * mt; int nr = __builtin_amdgcn_readfirstlane(tab[8 + e]) - 256 * mt; nr = nr > 256 ? 256 : nr;
        u.pm = pm; u.pn = pn; u.e = e; u.row0 = row0; u.nrows = nr; u.nt = nt_; u.flags = 0;
        u.a = gather ? A : A + (size_t)row0 * a_rowbytes; u.b = Bt + (size_t)e * b_expert_bytes + (size_t)pn * b_tile_bytes; return true;
    }
};
struct MoEDownSched {
    const LAS int* tab; const char* A; const char* Bt; int nmt, c, round;
    __device__ void fill(pg8::Unit& u, int pm, int pn, int kp, int nt, int flags) const {
        int e = 0;
#pragma unroll
        for (int q = 1; q < 8; ++q) if (pm >= tab[16 + q]) e = q;
        e = __builtin_amdgcn_readfirstlane(e);
        const int mt = pm - __builtin_amdgcn_readfirstlane(tab[16 + e]); const int row0 = __builtin_amdgcn_readfirstlane(tab[e]) + 256 * mt; int nr = __builtin_amdgcn_readfirstlane(tab[8 + e]) - 256 * mt; nr = nr > 256 ? 256 : nr;
        u.pm = pm; u.pn = pn; u.e = e; u.row0 = row0; u.nrows = nr; u.nt = nt; u.flags = flags;
        u.a = A + (size_t)row0 * (D_FFE * 2) + (size_t)kp * 896 * 2; u.b = Bt + (size_t)e * ((size_t)1024 * D_FFE * 2) + (size_t)pn * ((size_t)256 * D_FFE * 2) + (size_t)kp * 896 * 2;
    }
    __device__ bool next(int i, pg8::Unit& u) const {
        if (i != 0) return false;
        if (round == 0) { const int pm = 8 * (c & 7) + ((c >> 3) & 7), pn = c >> 6; if (pm >= nmt) return false; fill(u, pm, pn, 0, D_FFE / 64, 0); return true; }
        { const int t = c >> 2, kp = c & 3; const int pm = 64 + (t >> 2), pn = t & 3; if (pm >= nmt) return false; fill(u, pm, pn, kp, 14, 1 + c); return true; }
        return false;
    }
};
__device__ __forceinline__ int moe_table(const Frame& F, int mode) {
    LAS int* tab = (LAS int*)(F.lds + MOE_OFF);
    __syncthreads();
    if (F.tid == 0) { const int* TOT = wsp<int>(F.ws, WS_TOT); int rs = 0, ts = 0;
        for (int e = 0; e < 8; ++e) { const int c0 = TOT[e], c1 = TOT[8 + e]; const int st = rs + (mode == 1 ? c0 : 0), c = mode == 0 ? c0 : (mode == 1 ? c1 : c0 + c1);
            tab[e] = st; tab[8 + e] = c; tab[16 + e] = ts; rs += c0 + c1; ts += (c + 255) >> 8; }
        tab[24] = ts; }
    __syncthreads();
    return __builtin_amdgcn_readfirstlane(tab[24]);
}

constexpr size_t A_PART = A_WEGU;
__device__ __forceinline__ void moe_tail_reduce(const Frame& F, int s) {
    const int nmt = moe_table(F, s); const LAS int* tab = (const LAS int*)(F.lds + MOE_OFF);
    const int R = (nmt - 64) * 4; const int gw = F.vcu * NWAVES + F.wave, lane = F.lane;
    const float* part = wsp<float>(F.ws, A_PART + (size_t)s * 32 * MiB); const int* RTK = wsp<int>(F.ws, WS_ROWTOK); const float* RGT = wsp<float>(F.ws, WS_ROWGATE);
    for (int idx = gw; idx < R * 256; idx += F.G * NWAVES) { const int t = idx >> 8, r = idx & 255; const int pm = 64 + (t >> 2), pn = t & 3;
        int e = 0;
#pragma unroll
        for (int q = 1; q < 8; ++q) if (pm >= tab[16 + q]) e = q;
        const int mt = pm - tab[16 + e]; const int row0 = tab[e] + 256 * mt; const int nr = tab[8 + e] - 256 * mt;
        if (r < nr) { const int tok = RTK[row0 + r] & 16383; const float gt = RGT[row0 + r];
            f32x4 a = {0.f, 0.f, 0.f, 0.f};
#pragma unroll
            for (int kp = 0; kp < 4; ++kp) a += *(const f32x4*)(part + ((size_t)(t * 4 + kp) * 256 + r) * 256 + 4 * lane);
            float* op = F.out + (size_t)tok * 1024 + 256 * pn + 4 * lane; f32x4 o = *(const f32x4*)op; o += a * gt; *(f32x4*)op = o; } }
}

constexpr int N_PHASES = 21;
__global__ void __launch_bounds__(NWAVES * 64, 2) mk_fwd(Args args) {
    extern __shared__ __attribute__((aligned(16))) unsigned char lds_raw[];
    Frame F; F.lds = (LAS unsigned char*)lds_raw; F.ws = args.ws; F.in = args.in; F.out = args.out;
    F.tid = threadIdx.x; F.lane = F.tid & 63; F.wave = __builtin_amdgcn_readfirstlane(F.tid >> 6);
    F.G = gridDim.x; { const int bx = blockIdx.x; F.vcu = (F.G % 8 == 0) ? (bx % 8) * (F.G / 8) + bx / 8 : bx; }
    volatile LAS unsigned* MISC = (volatile LAS unsigned*)(F.lds + MISC_OFF);
    if (F.tid < 64) MISC[F.tid] = 0u;
    __syncthreads();
    XcdBarrier bar; bar.bar = (unsigned*)(args.ws + WS_CTL) + CW_BAR; bar.x = 0; bar.st = nullptr;
    const int lo = args.ph_lo, hi = args.ph_hi;
    const bool multi = (hi - lo) > 1;
    if (multi) bar = xcd_barrier_post((unsigned*)(args.ws + WS_CTL) + CW_BAR, MISC + 8);
#ifdef PH_ONLY
#define IN(k) ((k) == PH_ONLY && lo <= (k) && (k) < hi)
#else
#define IN(k) (lo <= (k) && (k) < hi)
#endif
#define SEAM(k) do { if (IN(k) && IN((k) + 1)) xcd_barrier(bar); } while (0)
    unsigned char* ws = args.ws; const int cid = (int)blockIdx.x;
#define REFRESH() do { int t_ = threadIdx.x; asm volatile("" : "+v"(t_)); F.tid = t_; F.lane = t_ & 63; F.wave = __builtin_amdgcn_readfirstlane(t_ >> 6); unsigned long long w_ = (unsigned long long)args.ws; asm volatile("" : "+s"(w_)); F.ws = (unsigned char*)w_; ws = F.ws; } while (0)
    LAS unsigned char* ring = F.lds;

#ifndef MK_REP_MASK
#define MK_REP_MASK 0u
#endif
#define REPS(k) ((int)(((unsigned)(MK_REP_MASK) >> (k)) & 1u))
#define PHASE(k, ...) do { if (IN(k)) { for (int rep_ = 0; rep_ <= REPS(k); ++rep_) { if (rep_) xcd_barrier(bar); REFRESH(); __VA_ARGS__ } } SEAM(k); } while (0)
    PHASE(0, phase_prologue(F););
    PHASE(1, {
        pg8::DenseSched S; S.init(wsp<bf16_t>(ws, WS_XB), wsp<bf16_t>(ws, WS_WIN0), M_TOK, E_IN, 1024, F.G, cid);
        EpiScaleBf16 E{wsp<bf16_t>(ws, A_P0), E_IN, wsp<float>(ws, WS_SSQ0)};
        pg8::gemm_phase<EpiScaleBf16, pg8::DenseSched, false>(F.tid, ring, 1024, S, E, nullptr);
        if (F.G == 256 && cid >= 128 && rep_ == 0) { REFRESH(); conv_group(F, 1, (cid - 128) * NWAVES + F.wave, 128 * NWAVES); } });
    PHASE(2, phase_prep0(F););
    PHASE(3, {
        pg8::DenseSched S; S.init(wsp<bf16_t>(ws, A_AP), wsp<bf16_t>(ws, WS_WLR), M_TOK, 2560, 256, F.G, cid);
        EpiLowRank E{ws, F.in};
        pg8::gemm_phase<EpiLowRank, pg8::DenseSched, false>(F.tid, ring, 256, S, E, nullptr); });
#ifndef MK_REP_SUB
#define MK_REP_SUB 0u
#endif
    PHASE(4, phase_cscan_attn_split(F););
    PHASE(5, phase_rwkv_post(F););
    PHASE(6, {
        pg8::DenseSched S; S.init(wsp<bf16_t>(ws, A_YCAT), wsp<bf16_t>(ws, WS_WOUT0), M_TOK, 1024, 1024, F.G, cid);
        EpiResidBf E{rep_ ? wsp<bf16_t>(ws, A_YF) : wsp<bf16_t>(ws, WS_XB), nullptr, rep_ ? wsp<float>(ws, WS_SSQ0) : wsp<float>(ws, WS_SSQ1)};
        pg8::gemm_phase<EpiResidBf, pg8::DenseSched, false>(F.tid, ring, 1024, S, E, nullptr); });
    PHASE(7, {
        pg8::DenseSched S; S.init(wsp<bf16_t>(ws, WS_XB), wsp<bf16_t>(ws, WS_WGU0), M_TOK, 2 * D_FF, 1024, F.G, cid);
        EpiSwiGLU E{wsp<bf16_t>(ws, A_HID0), D_FF, wsp<float>(ws, WS_SSQ1)};
        pg8::gemm_phase<EpiSwiGLU, pg8::DenseSched, false>(F.tid, ring, 1024, S, E, nullptr);
        if (F.G == 256 && cid >= 128 && rep_ == 0) { REFRESH(); conv_group(F, 2, (cid - 128) * NWAVES + F.wave, 128 * NWAVES); } });
    PHASE(8, {
        pg8::DenseSched S; S.init(wsp<bf16_t>(ws, A_HID0), wsp<bf16_t>(ws, WS_WD0), M_TOK, 1024, D_FF, F.G, cid);
        EpiResidBf E{rep_ ? wsp<bf16_t>(ws, A_YF) : wsp<bf16_t>(ws, WS_XB), nullptr, rep_ ? wsp<float>(ws, WS_SSQ0) : wsp<float>(ws, WS_SSQ2)};
        pg8::gemm_phase<EpiResidBf, pg8::DenseSched, false>(F.tid, ring, D_FF, S, E, nullptr); });
    PHASE(9, {
        pg8::DenseSched S; S.init(wsp<bf16_t>(ws, WS_XB), wsp<bf16_t>(ws, WS_WIN1), M_TOK, 3072, 1024, F.G, cid);
        EpiScaleBf16 E{wsp<bf16_t>(ws, A_P1), O_INP, wsp<float>(ws, WS_SSQ2)};
        pg8::gemm_phase<EpiScaleBf16, pg8::DenseSched, false>(F.tid, ring, 1024, S, E, nullptr);
        REFRESH(); phase_gd(F); });
    PHASE(10, phase_gla_prep(F););
    PHASE(11, phase_gla_main(F););
    PHASE(12, phase_gla_post(F););
    PHASE(13, {
        pg8::DenseSched S; S.init(wsp<bf16_t>(ws, A_GOUT), wsp<bf16_t>(ws, WS_WOUT1), M_TOK, 1024, 1024, F.G, cid);
        EpiResidBf E{rep_ ? wsp<bf16_t>(ws, A_QT) : wsp<bf16_t>(ws, WS_XB), rep_ ? wsp<float>(ws, A_OF) : F.out, nullptr};
        pg8::gemm_phase<EpiResidBf, pg8::DenseSched, false>(F.tid, ring, 1024, S, E, nullptr); });
    PHASE(14, for (int q_ = 0; q_ <= (int)(((MK_REP_SUB) >> 2) & 1u); ++q_) { phase_route(F); __syncthreads(); REFRESH(); }
              for (int q_ = 0; q_ <= (int)(((MK_REP_SUB) >> 3) & 1u); ++q_) { phase_conv_experts(F); __syncthreads(); REFRESH(); });
    PHASE(15, phase_place(F););
    PHASE(16, {
        const int nmt = moe_table(F, 2);
        MoESched S; S.go.init(nmt, 2 * D_FFE / 256, F.G, cid); S.tab = (const LAS int*)(F.lds + MOE_OFF);
        S.A = (const char*)wsp<bf16_t>(ws, WS_XB); S.Bt = (const char*)wsp<bf16_t>(ws, A_WEGU); S.a_rowbytes = 0; S.b_expert_bytes = (size_t)2 * D_FFE * 1024 * 2; S.b_tile_bytes = (size_t)256 * 1024 * 2; S.gather = true; S.nt_ = 16;
        const int* rtk = wsp<int>(ws, WS_ROWTOK);
        EpiSwiGLUMoE E{wsp<bf16_t>(ws, A_HID1), wsp<float>(ws, WS_RSTD3), rtk};
        pg8::gemm_phase<EpiSwiGLUMoE, MoESched, true>(F.tid, ring, 1024, S, E, rtk); });
#pragma unroll 1
    for (int s = 0; s < 2; ++s) {
        PHASE(17 + s, {
            const int nmt = moe_table(F, s);
            MoEDownSched S; S.tab = (const LAS int*)(F.lds + MOE_OFF); S.A = (const char*)wsp<bf16_t>(ws, A_HID1); S.Bt = (const char*)wsp<bf16_t>(ws, A_WED); S.nmt = nmt; S.c = cid; S.round = 0;
            EpiMoEDown E{F.out, wsp<int>(ws, WS_ROWTOK), wsp<float>(ws, WS_ROWGATE)};
            pg8::gemm_phase<EpiMoEDown, MoEDownSched, false>(F.tid, ring, D_FFE, S, E, nullptr);
            REFRESH(); S.round = 1; EpiPart EP{wsp<float>(ws, A_PART + (size_t)s * 32 * MiB)};
            pg8::gemm_phase<EpiPart, MoEDownSched, false>(F.tid, ring, D_FFE, S, EP, nullptr); });
    }
    PHASE(19, moe_tail_reduce(F, 0););
    PHASE(20, moe_tail_reduce(F, 1););
#undef PHASE
#undef REPS
#undef IN
#undef SEAM
}

extern "C" void kernel_launch(void* const* d_in, const int* in_sizes, int n_in, void* d_out, int out_size, void* d_ws, size_t ws_size, hipStream_t stream) {
    static int grid = 0;
    if (grid == 0) {
        if (n_in != 38 || out_size != M_TOK * D_MODEL || ws_size < WS_END) { fprintf(stderr, "kernel_launch: unexpected shapes: n_in %d out %d ws %zu (need %zu)\n", n_in, out_size, ws_size, (size_t)WS_END); grid = -1; return; }
        int dev = 0, cus = 0;
        if (hipGetDevice(&dev) != hipSuccess || hipDeviceGetAttribute(&cus, hipDeviceAttributeMultiprocessorCount, dev) != hipSuccess) { grid = -1; return; }
        if (hipFuncSetAttribute((const void*)mk_fwd, hipFuncAttributeMaxDynamicSharedMemorySize, LDS_BYTES) != hipSuccess) { fprintf(stderr, "kernel_launch: hipFuncSetAttribute failed\n"); grid = -1; return; }
        (void)hipGetLastError();
        grid = cus;
        if (grid != 256) fprintf(stderr, "kernel_launch: note: %d CUs (built for 256)\n", grid);
    }
    if (grid < 0) return;
    (void)hipMemsetAsync((char*)d_ws + WS_CTL, 0, CTL_ZERO_BYTES, stream);
    Args a{};
    for (int i = 0; i < 38; ++i) a.in[i] = (const float*)d_in[i];
    a.out = (float*)d_out; a.ws = (unsigned char*)d_ws;
#if MK_N_LAUNCHES == 1
    a.ph_lo = 0; a.ph_hi = N_PHASES - 1 + 0;
    a.ph_hi = 21;
    hipLaunchKernelGGL(mk_fwd, dim3(grid), dim3(NWAVES * 64), LDS_BYTES, stream, a);
#else
#ifndef MK_LAST_PHASE
#define MK_LAST_PHASE 20
#endif
    for (int p = 0; p < MK_LAST_PHASE; ++p) { a.ph_lo = p; a.ph_hi = p + 1; hipLaunchKernelGGL(mk_fwd, dim3(grid), dim3(NWAVES * 64), LDS_BYTES, stream, a); }
#endif
}
```

```cpp
#include <hip/hip_runtime.h>
#include <cstdio>
#include <cstdint>

#ifndef MK_N_LAUNCHES
#define MK_N_LAUNCHES 1
#define MK_REP_MASK 0u
#define MK_REP_SUB 0u
#endif

#define GAS __attribute__((address_space(1)))
#define LAS __attribute__((address_space(3)))
typedef unsigned short bf16_t;
typedef short bf16x8 __attribute__((ext_vector_type(8)));
typedef short bf16x4 __attribute__((ext_vector_type(4)));
typedef float f32x4 __attribute__((ext_vector_type(4)));
typedef float f32x2 __attribute__((ext_vector_type(2)));
typedef float f32x16 __attribute__((ext_vector_type(16)));
typedef unsigned u32x4 __attribute__((ext_vector_type(4)));
typedef unsigned u32x2 __attribute__((ext_vector_type(2)));
typedef __bf16 bf16x2_t __attribute__((ext_vector_type(2)));

constexpr int D_MODEL = 1024, BATCH = 8, SEQ = 2048, M_TOK = BATCH * SEQ;
constexpr int HD = 64;
constexpr int RW_HEADS = 8, RW_DIM = 512, RW_IN = 1792;
constexpr int ATT_HEADS = 8, ATT_KV = 2;
constexpr int E_IN = 2560;
constexpr int GLA_H = 4, GLA_DK = 512, GLA_DV = 1024, GLA_DKH = 128, GLA_DVH = 256, GLA_R = 16;
constexpr int O_IN = 3088, O_INP = 3328;
constexpr int D_FF = 2816, NEXP = 8, D_FFE = 3584;
constexpr float NORM_EPS = 1e-6f;

constexpr size_t MiB = 1u << 20;
constexpr size_t WS_CTL = 0, CTL_ZERO_BYTES = 1 * MiB;
constexpr size_t WS_SSQ0 = 1 * MiB, WS_SSQ1 = 2 * MiB, WS_SSQ2 = 3 * MiB;
constexpr size_t WS_RSTD3 = 4 * MiB;
constexpr size_t WS_TOKE = WS_RSTD3 + 65536;
constexpr size_t WS_TOKG = WS_TOKE + 131072;
constexpr size_t WS_CNT = WS_TOKG + 131072;
constexpr size_t WS_TOT = WS_CNT + 16384;
constexpr size_t WS_ROWTOK = WS_TOT + 256;
constexpr int ROWS_PER_SLOT = M_TOK + 256;
constexpr size_t WS_ROWGATE = WS_ROWTOK + (size_t)2 * ROWS_PER_SLOT * 4;
constexpr size_t WS_DECS = 6 * MiB;
constexpr size_t WS_ROPE = 7 * MiB;
constexpr size_t WS_XB = 8 * MiB;
constexpr size_t WS_WIN0 = 40 * MiB, WS_WLR = 45 * MiB, WS_WOUT0 = 47 * MiB, WS_WGU0 = 49 * MiB, WS_WD0 = 60 * MiB, WS_WIN1 = 66 * MiB, WS_WOUT1 = 73 * MiB;
constexpr size_t AR = 75 * MiB;
constexpr size_t A_P0 = AR + 0, A_RS = AR + 80 * MiB, A_KS = AR + 96 * MiB, A_VS = AR + 112 * MiB, A_NKK = AR + 128 * MiB, A_AP = AR + 144 * MiB;
constexpr size_t A_QH = AR + 152 * MiB, A_KH = AR + 168 * MiB, A_VT0 = AR + 172 * MiB;
constexpr size_t A_LWF = AR + 176 * MiB, A_LWB = AR + 192 * MiB, A_KDF = AR + 208 * MiB, A_KDB = AR + 224 * MiB, A_BBF = AR + 240 * MiB, A_BBB = AR + 256 * MiB;
constexpr size_t A_GG = AR + 272 * MiB, A_YF = AR + 0 * MiB, A_YB = AR + 16 * MiB, A_YCAT = AR + 32 * MiB;
constexpr size_t A_HID0 = AR + 0;
constexpr size_t A_P1 = AR + 0;
constexpr size_t A_QT = AR + 104 * MiB, A_KT = AR + 120 * MiB, A_QHAT = AR + 136 * MiB, A_K2T = AR + 152 * MiB;
constexpr size_t GLA_DIR_STRIDE = 64 * MiB;
constexpr size_t A_VT1 = AR + 232 * MiB, A_OF = AR + 264 * MiB, A_OB = AR + 296 * MiB, A_GOUT = AR + 168 * MiB;
constexpr size_t A_WEGU = 40 * MiB, A_WED = 404 * MiB, A_HID1 = 152 * MiB;
constexpr int ROWS_ALL = 2 * M_TOK + 256;
constexpr size_t WS_END = 460 * MiB;
static_assert(A_HID1 + (size_t)ROWS_ALL * D_FFE * 2 <= A_WED && A_WED + (size_t)NEXP * 1024 * D_FFE * 2 <= WS_END && A_WED >= AR + 328 * MiB && 2 * ROWS_PER_SLOT >= ROWS_ALL, "ws map");
static_assert(A_GOUT + 32 * MiB <= A_VT1 && A_YCAT + 32 * MiB <= A_RS, "ws map");

constexpr int CW_BAR = 4096;

constexpr int RING_BYTES = 131072;
constexpr int LDS_BYTES = 147456;
constexpr int MISC_OFF = LDS_BYTES - 512;
constexpr int MOE_OFF = LDS_BYTES - 256;

__device__ __forceinline__ unsigned pk2(float lo, float hi) { f32x2 v = {lo, hi}; bf16x2_t b = __builtin_convertvector(v, bf16x2_t); return __builtin_bit_cast(unsigned, b); }
__device__ __forceinline__ bf16_t f2bf(float f) { return (bf16_t)(pk2(f, 0.f) & 0xffffu); }
__device__ __forceinline__ float bf2f(bf16_t h) { return __uint_as_float(((unsigned)h) << 16); }
__device__ __forceinline__ float bflo(unsigned w) { return __uint_as_float(w << 16); }
__device__ __forceinline__ float bfhi(unsigned w) { return __uint_as_float(w & 0xffff0000u); }
__device__ __forceinline__ float wave_sum(float v) {
#pragma unroll
    for (int o = 1; o < 64; o <<= 1) v += __shfl_xor(v, o);
    return v;
}
__device__ __forceinline__ float sigmoidf_(float x) { return 1.f / (1.f + __expf(-x)); }
__device__ __forceinline__ float siluf_(float x) { return x / (1.f + __expf(-x)); }
#define LDS_WAIT() asm volatile("s_waitcnt lgkmcnt(0)" ::: "memory")
#define VM_WAIT() asm volatile("s_waitcnt vmcnt(0)" ::: "memory")

#define XB_TMO      128
#define XB_XCNT(j)  (256  + 64 * (j))
#define XB_XSUB(j)  (1280 + 64 * (j))
#define XB_XGEN(j)  (2304 + 64 * (j))
#define XB_TOP      3328
#define XB_TOPGEN   3392
#define XCD_BAR_WORDS 3456
#define XB_SPIN_CAP (1u << 20)
__device__ __forceinline__ unsigned xb_ld(unsigned* p)              { return __hip_atomic_load(p, __ATOMIC_RELAXED, __HIP_MEMORY_SCOPE_AGENT); }
__device__ __forceinline__ unsigned xb_add(unsigned* p, unsigned v) { return __hip_atomic_fetch_add(p, v, __ATOMIC_RELAXED, __HIP_MEMORY_SCOPE_AGENT); }
__device__ __forceinline__ unsigned xb_xcc_id() { return (unsigned)__builtin_amdgcn_s_getreg((3 << 11) | 20) & 0xFu; }
#define XB_SPIN(cond, bar) do { unsigned _sp = 0; while (cond) { __builtin_amdgcn_s_sleep(1); \
    if ((++_sp & 255u) == 0u) { if (xb_ld(&(bar)[XB_TMO])) break; if (_sp > XB_SPIN_CAP) { atomicAdd(&(bar)[XB_TMO], 1u); break; } } } } while (0)
struct XcdBarrier { unsigned* bar; unsigned x; volatile LAS unsigned* st; };
__device__ __forceinline__ XcdBarrier xcd_barrier_post(unsigned* bar, volatile LAS unsigned* st) {
    XcdBarrier b; b.bar = bar; b.x = xb_xcc_id(); b.st = st;
    if (threadIdx.x == 0) (void)xb_add(&bar[XB_XCNT(b.x)], 1u);
    return b;
}
__device__ __forceinline__ void xcd_barrier_complete(unsigned* bar, unsigned x, unsigned& nloc, unsigned& nx) {
    const unsigned G = gridDim.x * gridDim.y * gridDim.z;
    unsigned sum, cnt, mine, sp = 0u;
    for (;;) {
        sum = 0u; cnt = 0u; mine = 0u;
#pragma unroll
        for (unsigned j = 0; j < 16; ++j) { const unsigned c = xb_ld(&bar[XB_XCNT(j)]); sum += c; cnt += (c > 0u) ? 1u : 0u; mine = (j == x) ? c : mine; }
        if (sum == G) break;
        __builtin_amdgcn_s_sleep(1);
        if ((++sp & 255u) == 0u) { if (xb_ld(&bar[XB_TMO])) break; if (sp > XB_SPIN_CAP) { atomicAdd(&bar[XB_TMO], 1u); break; } }
    }
    nloc = mine > 0u ? mine : 1u; nx = cnt > 0u ? cnt : 1u;
}
__device__ __forceinline__ void xcd_barrier(const XcdBarrier& b) {
    asm volatile("s_waitcnt vmcnt(0)" ::: "memory");
    __syncthreads();
    if (threadIdx.x == 0) {
        unsigned* bar = b.bar;
        __builtin_amdgcn_s_waitcnt(0);
        unsigned nloc = b.st[0], nx = b.st[1];
        if (nloc == 0u) { xcd_barrier_complete(bar, b.x, nloc, nx); b.st[0] = nloc; b.st[1] = nx; }
        const unsigned old = xb_add(&bar[XB_XSUB(b.x)], 1u);
        const unsigned gen = old / nloc;
        if (old + 1u == (gen + 1u) * nloc) {
            __builtin_amdgcn_fence(__ATOMIC_RELEASE, "agent");
            asm volatile("s_waitcnt vmcnt(0)" ::: "memory");
            const unsigned og = xb_add(&bar[XB_TOP], 1u);
            const unsigned tg = og / nx;
            if (og + 1u == (tg + 1u) * nx) xb_add(&bar[XB_TOPGEN], 1u);
            else XB_SPIN(xb_ld(&bar[XB_TOPGEN]) == tg, bar);
            __builtin_amdgcn_fence(__ATOMIC_ACQUIRE, "agent");
            xb_add(&bar[XB_XGEN(b.x)], 1u);
            asm volatile("s_waitcnt vmcnt(0)" ::: "memory");
        } else {
            XB_SPIN(xb_ld(&bar[XB_XGEN(b.x)]) == gen, bar);
            __builtin_amdgcn_fence(__ATOMIC_ACQUIRE, "agent");
            asm volatile("s_waitcnt vmcnt(0)" ::: "memory");
        }
    }
    __syncthreads();
}

namespace pg8 {
constexpr int BM = 256, BK = 64, HALF = 128, HTB = HALF * BK * 2, STAGE_BYTES = 8 * HTB, NXCD = 8, WGM = 4;
__host__ __device__ __forceinline__ int lds_byte(int r, int c) { const int st = (r >> 4) * 2 + (c >> 5), rr = r & 15, cc = c & 31, ob = rr * 64 + cc * 2; return st * 1024 + (ob ^ (((ob >> 9) & 1) << 5)); }
__host__ __device__ __forceinline__ void stage_rc(int b, int& R, int& C) { const int st = b / 1024, sb = b % 1024, swz = sb ^ (((sb >> 9) & 1) << 5); R = (st >> 1) * 16 + swz / 64; C = (st & 1) * 32 + (swz % 64) / 2; }
__host__ __device__ __forceinline__ int perm32(int rho) { const int n = rho >> 4, i = rho & 15; return 8 * (i >> 2) + 4 * n + (i & 3); }

struct Unit { const char* a; const char* b; int pm, pn; int row0, nrows, e; int nt, flags; };

struct GridOrder {
    int nM, nN, nwg, G, c;
    __device__ void init(int nM_, int nN_, int G_, int c_) { nM = nM_; nN = nN_; nwg = nM * nN; G = G_; c = c_; }
    __device__ bool tile(int i, int& pm, int& pn) const {
        const long L = (long)i * G + c; if (L >= nwg) return false;
        int wgid = (int)L; { const int q = nwg / NXCD, r = nwg % NXCD, xcd = wgid % NXCD, off = wgid / NXCD; wgid = (xcd < r ? xcd * (q + 1) : r * (q + 1) + (xcd - r) * q) + off; }
        const int nig = WGM * nN, gid = wgid / nig, fm = gid * WGM, gsz = (nM - fm) < WGM ? (nM - fm) : WGM;
        pm = fm + ((wgid % nig) % gsz); pn = (wgid % nig) / gsz; return true;
    }
};
struct DenseSched {
    GridOrder go; const char* A; const char* Bt; size_t tstep; int nt_;
    __device__ void init(const bf16_t* A_, const bf16_t* Bt_, int M, int N, int K, int G, int c) { go.init(M / BM, N / BM, G, c); A = (const char*)A_; Bt = (const char*)Bt_; tstep = (size_t)BM * K * 2; nt_ = K / BK; }
    __device__ bool next(int i, Unit& u) const { int pm, pn; if (!go.tile(i, pm, pn)) return false; u.pm = pm; u.pn = pn; u.a = A + (size_t)pm * tstep; u.b = Bt + (size_t)pn * tstep; u.row0 = pm * BM; u.nrows = BM; u.e = 0; u.nt = nt_; u.flags = 0; return true; }
};

template <class Epi, class Sched, bool GATHER>
__device__ __forceinline__ void gemm_phase(const int tid, LAS unsigned char* lds, const int K_, const Sched& S, const Epi& E, const int* gather_rows) {
    int K = K_; asm volatile("" : "+s"(K));
    const int wid = __builtin_amdgcn_readfirstlane(tid >> 6), lane = tid & 63, wr = wid >> 2, wc = wid & 3, fr = lane & 15, fq = lane >> 4;
    int sR[2], sC[2];
    unsigned voffB[2];
#pragma unroll
    for (int i = 0; i < 2; ++i) { int R, C; stage_rc(tid * 16 + i * 8192, R, C); sR[i] = R; sC[i] = C; const int Rb = Epi::PERM ? ((R & ~31) + perm32(R & 31)) : R; voffB[i] = (unsigned)(Rb * K + C) * 2u; }
    const size_t kstep = (size_t)(BK * 2);
    const size_t hstep = (size_t)HALF * K * 2;
    const unsigned ldsw = (unsigned)wid * 1024u;
    const int aoff = lds_byte(wr * 64 + fr, fq * 8), boff = lds_byte(wc * 32 + fr, fq * 8);
    unsigned cva[2][2], nva[2][2];
#define PG8_SETVA(va, u) do { _Pragma("unroll") for (int h_ = 0; h_ < 2; ++h_) _Pragma("unroll") for (int i_ = 0; i_ < 2; ++i_) { \
        if (GATHER) { int rr_ = (u).row0 + h_ * HALF + sR[i_]; const int rmax_ = (u).row0 + (u).nrows - 1; rr_ = rr_ > rmax_ ? rmax_ : rr_; int tk_ = gather_rows[rr_]; tk_ = tk_ < 0 ? 0 : (tk_ > 16383 ? 16383 : tk_); va[h_][i_] = (unsigned)(tk_ * K + sC[i_]) * 2u; } \
        else va[h_][i_] = (unsigned)((h_ * HALF + sR[i_]) * K + sC[i_]) * 2u; } } while (0)
#define PG8_SA(b, h) (((b) * 2 + (h)) * HTB)
#define PG8_SB(b, h) ((4 + (b) * 2 + (h)) * HTB)
#define PG8_STAGE2(bufoff, gbase, v0, v1) do { \
        __builtin_amdgcn_global_load_lds((const unsigned*)((const char*)(gbase) + (v0)), (LAS unsigned*)(lds + (bufoff) + ldsw), 16, 0, 0); \
        __builtin_amdgcn_global_load_lds((const unsigned*)((const char*)(gbase) + (v1)), (LAS unsigned*)(lds + (bufoff) + ldsw + 8192), 16, 0, 0); } while (0)
#define PG8_STAGEB(bufoff, gbase) PG8_STAGE2(bufoff, gbase, voffB[0], voffB[1])
#define PG8_STAGEA(bufoff, gbase, va, h) PG8_STAGE2(bufoff, gbase, va[h][0], va[h][1])
#define PG8_LDA(dst, b, h) do { _Pragma("unroll") for (int m = 0; m < 4; ++m) _Pragma("unroll") for (int k = 0; k < 2; ++k) dst[m][k] = *(const LAS bf16x8*)(lds + PG8_SA(b, h) + aoff + m * 2048 + k * 1024); } while (0)
#define PG8_LDB(dst, b, h) do { _Pragma("unroll") for (int n = 0; n < 2; ++n) _Pragma("unroll") for (int k = 0; k < 2; ++k) dst[n][k] = *(const LAS bf16x8*)(lds + PG8_SB(b, h) + boff + n * 2048 + k * 1024); } while (0)
#define PG8_MMA(ai, bj, At, Bt) do { __builtin_amdgcn_s_setprio(1); _Pragma("unroll") for (int m = 0; m < 4; ++m) _Pragma("unroll") for (int n = 0; n < 2; ++n) _Pragma("unroll") for (int k = 0; k < 2; ++k) \
        acc[ai][bj][m][n] = __builtin_amdgcn_mfma_f32_16x16x32_bf16(Bt[n][k], At[m][k], acc[ai][bj][m][n], 0, 0, 0); __builtin_amdgcn_s_setprio(0); } while (0)
#define PG8_WAIT_V(n) asm volatile("s_waitcnt vmcnt(" #n ")" ::: "memory")
#define PG8_WAIT_L(n) asm volatile("s_waitcnt lgkmcnt(" #n ")" ::: "memory")
#define PG8_BAR __builtin_amdgcn_s_barrier()
#define PG8_SCHED __builtin_amdgcn_sched_barrier(0)
    Unit cur, nxt; int ui = 0;
    if (!S.next(0, cur)) return;
    PG8_SETVA(cva, cur);
    f32x4 acc[2][2][4][2];
#pragma unroll
    for (int a = 0; a < 2; ++a)
#pragma unroll
        for (int b = 0; b < 2; ++b)
#pragma unroll
            for (int m = 0; m < 4; ++m)
#pragma unroll
                for (int n = 0; n < 2; ++n) acc[a][b][m][n] = (f32x4){0.f, 0.f, 0.f, 0.f};
    bf16x8 At[4][2], B0[2][2], B1[2][2];
    const char* cA = cur.a; const char* cB = cur.b;
    PG8_STAGEB(PG8_SB(0, 0), cB); PG8_STAGEB(PG8_SB(0, 1), cB + hstep); PG8_STAGEA(PG8_SA(0, 0), cA, cva, 0); PG8_STAGEA(PG8_SA(0, 1), cA, cva, 1);
    if (wr == 1) PG8_BAR;
    PG8_WAIT_V(2); PG8_BAR;
    PG8_STAGEB(PG8_SB(1, 0), cB + kstep); PG8_STAGEA(PG8_SA(1, 0), cA + kstep, cva, 0); PG8_STAGEB(PG8_SB(1, 1), cB + hstep + kstep);
    PG8_WAIT_V(6); PG8_BAR;
    for (;;) {
        const bool has_next = S.next(ui + 1, nxt);
        if (has_next) PG8_SETVA(nva, nxt);
        else {
#pragma unroll
            for (int h = 0; h < 2; ++h)
#pragma unroll
                for (int i = 0; i < 2; ++i) nva[h][i] = cva[h][i];
        }
        const char* nA = has_next ? nxt.a : cA; const char* nB = has_next ? nxt.b : cB;
        const int nt = cur.nt;
        for (int t = 0; t < nt; t += 2) {
            const bool last = (t == nt - 2);
            const char* a1 = cA + (size_t)(t + 1) * kstep;
            const char* a2 = last ? nA : cA + (size_t)(t + 2) * kstep; const char* b2 = last ? nB : cB + (size_t)(t + 2) * kstep;
            const char* a3 = a2 + kstep; const char* b3 = b2 + kstep;
            unsigned va2[2][2];
#pragma unroll
            for (int h = 0; h < 2; ++h)
#pragma unroll
                for (int i = 0; i < 2; ++i) va2[h][i] = (GATHER && last) ? nva[h][i] : cva[h][i];
            PG8_LDB(B0, 0, 0); PG8_LDB(B1, 0, 1); PG8_SCHED; PG8_LDA(At, 0, 0); PG8_STAGEA(PG8_SA(1, 1), a1, cva, 1);
            PG8_WAIT_V(8); PG8_WAIT_L(0); PG8_BAR; PG8_MMA(0, 0, At, B0); PG8_MMA(0, 1, At, B1); PG8_BAR; PG8_SCHED;
            PG8_LDA(At, 0, 1); PG8_STAGEB(PG8_SB(0, 0), b2); PG8_STAGEB(PG8_SB(0, 1), b2 + hstep); PG8_STAGEA(PG8_SA(0, 0), a2, va2, 0);
            PG8_WAIT_V(8); PG8_WAIT_L(0); PG8_BAR; PG8_MMA(1, 0, At, B0); PG8_MMA(1, 1, At, B1); PG8_BAR; PG8_SCHED;
            PG8_LDB(B0, 1, 0); PG8_LDB(B1, 1, 1); PG8_SCHED; PG8_LDA(At, 1, 0); PG8_STAGEA(PG8_SA(0, 1), a2, va2, 1);
            PG8_WAIT_V(8); PG8_WAIT_L(0); PG8_BAR; PG8_MMA(0, 0, At, B0); PG8_MMA(0, 1, At, B1); PG8_BAR; PG8_SCHED;
            PG8_LDA(At, 1, 1); PG8_STAGEB(PG8_SB(1, 0), b3); PG8_STAGEB(PG8_SB(1, 1), b3 + hstep); PG8_STAGEA(PG8_SA(1, 0), a3, va2, 0);
            PG8_WAIT_V(8); PG8_WAIT_L(0); PG8_BAR; PG8_MMA(1, 0, At, B0); PG8_MMA(1, 1, At, B1); PG8_BAR; PG8_SCHED;
        }
        if (wr == 0) PG8_BAR;
        E(acc, cur, wr, wc, fr, fq);
        if (!has_next) break;
#pragma unroll
        for (int a = 0; a < 2; ++a)
#pragma unroll
            for (int b = 0; b < 2; ++b)
#pragma unroll
                for (int m = 0; m < 4; ++m)
#pragma unroll
                    for (int n = 0; n < 2; ++n) acc[a][b][m][n] = (f32x4){0.f, 0.f, 0.f, 0.f};
        cur = nxt; cA = nA; cB = nB; ++ui;
#pragma unroll
        for (int h = 0; h < 2; ++h)
#pragma unroll
            for (int i = 0; i < 2; ++i) cva[h][i] = nva[h][i];
        if (wr == 1) PG8_BAR;
    }
    PG8_WAIT_V(0);
    PG8_BAR;
#undef PG8_SETVA
#undef PG8_SA
#undef PG8_SB
#undef PG8_STAGE2
#undef PG8_STAGEA
#undef PG8_STAGEB
#undef PG8_LDA
#undef PG8_LDB
#undef PG8_MMA
#undef PG8_WAIT_V
#undef PG8_WAIT_L
#undef PG8_BAR
#undef PG8_SCHED
}
}

__device__ __forceinline__ float rstd_from_ssq(const float* ssq, int row) {
    const f32x4* p = (const f32x4*)(ssq + (size_t)row * 16);
    const f32x4 a = p[0], b = p[1], c = p[2], d = p[3];
    const float s = (((a.x + a.y) + (a.z + a.w)) + ((b.x + b.y) + (b.z + b.w))) + (((c.x + c.y) + (c.z + c.w)) + ((d.x + d.y) + (d.z + d.w)));
    return 1.0f / sqrtf(s * (1.f / 1024.f) + NORM_EPS);
}
__device__ __forceinline__ u32x4 pack8(const f32x4 v0, const f32x4 v1) { u32x4 w; w.x = pk2(v0[0], v0[1]); w.y = pk2(v0[2], v0[3]); w.z = pk2(v1[0], v1[1]); w.w = pk2(v1[2], v1[3]); return w; }

struct EpiScaleBf16 {
    static constexpr bool PERM = true;
    bf16_t* O; int ldc; const float* ssq;
    __device__ __forceinline__ void operator()(const f32x4 (&acc)[2][2][4][2], const pg8::Unit& u, int wr, int wc, int fr, int fq) const {
        const int row0 = u.pm * 256 + wr * 64 + fr, col0 = u.pn * 256 + wc * 32 + 8 * fq;
#pragma unroll
        for (int ai = 0; ai < 2; ++ai)
#pragma unroll
            for (int m = 0; m < 4; ++m) { const int row = row0 + ai * 128 + m * 16; const float rs = rstd_from_ssq(ssq, row); bf16_t* rowp = O + (size_t)row * ldc + col0;
#pragma unroll
                for (int bj = 0; bj < 2; ++bj) *(u32x4*)(rowp + bj * 128) = pack8(acc[ai][bj][m][0] * rs, acc[ai][bj][m][1] * rs); }
    }
};
struct EpiResid {
    static constexpr bool PERM = true;
    const float* base; float* out; bf16_t* xb; float* ssq;
    __device__ __forceinline__ void operator()(const f32x4 (&acc)[2][2][4][2], const pg8::Unit& u, int wr, int wc, int fr, int fq) const {
        const int row0 = u.pm * 256 + wr * 64 + fr, col0 = u.pn * 256 + wc * 32 + 8 * fq;
#pragma unroll
        for (int ai = 0; ai < 2; ++ai)
#pragma unroll
            for (int m = 0; m < 4; ++m) { const int row = row0 + ai * 128 + m * 16; const size_t off = (size_t)row * 1024 + col0; float ss = 0.f;
#pragma unroll
                for (int bj = 0; bj < 2; ++bj) { const f32x4 b0 = *(const f32x4*)(base + off + bj * 128), b1 = *(const f32x4*)(base + off + bj * 128 + 4);
                    const f32x4 o0 = b0 + acc[ai][bj][m][0], o1 = b1 + acc[ai][bj][m][1];
                    *(f32x4*)(out + off + bj * 128) = o0; *(f32x4*)(out + off + bj * 128 + 4) = o1;
                    ss += (o0[0] * o0[0] + o0[1] * o0[1]) + (o0[2] * o0[2] + o0[3] * o0[3]) + (o1[0] * o1[0] + o1[1] * o1[1]) + (o1[2] * o1[2] + o1[3] * o1[3]);
                    *(u32x4*)(xb + off + bj * 128) = pack8(o0, o1); }
                ss += __shfl_xor(ss, 16); ss += __shfl_xor(ss, 32);
                if (ssq && fq == 0) ssq[(size_t)row * 16 + u.pn * 4 + wc] = ss; }
    }
};
struct EpiResidBf {
    static constexpr bool PERM = true;
    bf16_t* xb; float* out; float* ssq;
    __device__ __forceinline__ void operator()(const f32x4 (&acc)[2][2][4][2], const pg8::Unit& u, int wr, int wc, int fr, int fq) const {
        const int row0 = u.pm * 256 + wr * 64 + fr, col0 = u.pn * 256 + wc * 32 + 8 * fq;
#pragma unroll
        for (int ai = 0; ai < 2; ++ai)
#pragma unroll
            for (int m = 0; m < 4; ++m) { const int row = row0 + ai * 128 + m * 16; const size_t off = (size_t)row * 1024 + col0; float ss = 0.f;
#pragma unroll
                for (int bj = 0; bj < 2; ++bj) { const u32x4 bw = *(const u32x4*)(xb + off + bj * 128);
                    const f32x4 b0 = {bflo(bw.x), bfhi(bw.x), bflo(bw.y), bfhi(bw.y)}, b1 = {bflo(bw.z), bfhi(bw.z), bflo(bw.w), bfhi(bw.w)};
                    const f32x4 o0 = b0 + acc[ai][bj][m][0], o1 = b1 + acc[ai][bj][m][1];
                    if (out) { *(f32x4*)(out + off + bj * 128) = o0; *(f32x4*)(out + off + bj * 128 + 4) = o1; }
                    ss += (o0[0] * o0[0] + o0[1] * o0[1]) + (o0[2] * o0[2] + o0[3] * o0[3]) + (o1[0] * o1[0] + o1[1] * o1[1]) + (o1[2] * o1[2] + o1[3] * o1[3]);
                    *(u32x4*)(xb + off + bj * 128) = pack8(o0, o1); }
                ss += __shfl_xor(ss, 16); ss += __shfl_xor(ss, 32);
                if (ssq && fq == 0) ssq[(size_t)row * 16 + u.pn * 4 + wc] = ss; }
    }
};
struct EpiSwiGLU {
    static constexpr bool PERM = true;
    bf16_t* H; int ldh; const float* ssq;
    __device__ __forceinline__ void operator()(const f32x4 (&acc)[2][2][4][2], const pg8::Unit& u, int wr, int wc, int fr, int fq) const {
        const int row0 = u.pm * 256 + wr * 64 + fr, hcol0 = u.pn * 128 + wc * 32 + 8 * fq;
#pragma unroll
        for (int ai = 0; ai < 2; ++ai)
#pragma unroll
            for (int m = 0; m < 4; ++m) { const int row = row0 + ai * 128 + m * 16; const float rs = rstd_from_ssq(ssq, row);
                f32x4 h[2];
#pragma unroll
                for (int n = 0; n < 2; ++n) { const f32x4 g = acc[ai][0][m][n] * rs, up = acc[ai][1][m][n] * rs;
#pragma unroll
                    for (int i = 0; i < 4; ++i) h[n][i] = siluf_(g[i]) * up[i]; }
                *(u32x4*)(H + (size_t)row * ldh + hcol0) = pack8(h[0], h[1]); }
    }
};
struct EpiSwiGLUMoE {
    static constexpr bool PERM = true;
    bf16_t* H; const float* rstd3; const int* row_tok;
    __device__ __forceinline__ void operator()(const f32x4 (&acc)[2][2][4][2], const pg8::Unit& u, int wr, int wc, int fr, int fq) const {
        const int hcol0 = u.pn * 128 + wc * 32 + 8 * fq;
#pragma unroll
        for (int ai = 0; ai < 2; ++ai)
#pragma unroll
            for (int m = 0; m < 4; ++m) { const int rl = ai * 128 + wr * 64 + m * 16 + fr;
                if (rl < u.nrows) { const int grow = u.row0 + rl; const float rs = rstd3[row_tok[grow] & 16383];
                    f32x4 h[2];
#pragma unroll
                    for (int n = 0; n < 2; ++n) { const f32x4 g = acc[ai][0][m][n] * rs, up = acc[ai][1][m][n] * rs;
#pragma unroll
                        for (int i = 0; i < 4; ++i) h[n][i] = siluf_(g[i]) * up[i]; }
                    *(u32x4*)(H + (size_t)grow * D_FFE + hcol0) = pack8(h[0], h[1]); } }
    }
};
struct EpiMoEDown {
    static constexpr bool PERM = true;
    float* out; const int* row_tok; const float* row_gate;
    __device__ __forceinline__ void operator()(const f32x4 (&acc)[2][2][4][2], const pg8::Unit& u, int wr, int wc, int fr, int fq) const {
        const int col0 = u.pn * 256 + wc * 32 + 8 * fq;
#pragma unroll
        for (int ai = 0; ai < 2; ++ai)
#pragma unroll
            for (int m = 0; m < 4; ++m) { const int rl = ai * 128 + wr * 64 + m * 16 + fr;
                if (rl < u.nrows) { const int grow = u.row0 + rl; const int tok = row_tok[grow] & 16383; const float gt = row_gate[grow]; float* op = out + (size_t)tok * 1024 + col0;
#pragma unroll
                    for (int bj = 0; bj < 2; ++bj) { f32x4 b0 = *(const f32x4*)(op + bj * 128), b1 = *(const f32x4*)(op + bj * 128 + 4);
                        b0 += acc[ai][bj][m][0] * gt; b1 += acc[ai][bj][m][1] * gt; *(f32x4*)(op + bj * 128) = b0; *(f32x4*)(op + bj * 128 + 4) = b1; } } }
    }
};
struct EpiPart {
    static constexpr bool PERM = true;
    float* part;
    __device__ __forceinline__ void operator()(const f32x4 (&acc)[2][2][4][2], const pg8::Unit& u, int wr, int wc, int fr, int fq) const {
        float* pb = part + (size_t)(u.flags - 1) * 65536; const unsigned o0 = (unsigned)((wr * 64 + fr) * 256 + wc * 32 + 8 * fq);
#pragma unroll
        for (int ai = 0; ai < 2; ++ai)
#pragma unroll
            for (int m = 0; m < 4; ++m)
#pragma unroll
                for (int bj = 0; bj < 2; ++bj) { float* pp = pb + o0 + (ai * 128 + m * 16) * 256 + bj * 128; *(f32x4*)pp = acc[ai][bj][m][0]; *(f32x4*)(pp + 4) = acc[ai][bj][m][1]; }
    }
};
struct EpiLowRank {
    static constexpr bool PERM = true;
    unsigned char* ws; const float* const* in;
    __device__ __forceinline__ void operator()(const f32x4 (&acc)[2][2][4][2], const pg8::Unit& u, int wr, int wc, int fr, int fq) const {
        const int kind = u.pn >> 1; const int row0 = u.pm * 256 + wr * 64 + fr; const int c0 = (u.pn & 1) * 256 + wc * 32 + 8 * fq;
        const float* zp = in[kind == 0 ? 4 : kind == 1 ? 6 : kind == 2 ? 8 : 10]; const float* k_a = in[14];
        bf16_t* o1 = (bf16_t*)(ws + (kind == 0 ? A_LWF : kind == 1 ? A_LWB : kind == 2 ? A_KDF : kind == 3 ? A_KDB : A_GG));
        bf16_t* o2 = (bf16_t*)(ws + (kind == 3 ? A_BBB : A_BBF));
        const bf16_t* KS = (const bf16_t*)(ws + A_KS); const bf16_t* NKK = (const bf16_t*)(ws + A_NKK);
#pragma unroll
        for (int bj = 0; bj < 2; ++bj)
#pragma unroll
            for (int n = 0; n < 2; ++n) { const int c = c0 + bj * 128 + 4 * n;
                if (kind < 2) { const f32x4 z = *(const f32x4*)(zp + c);
#pragma unroll
                    for (int ai = 0; ai < 2; ++ai)
#pragma unroll
                        for (int m = 0; m < 4; ++m) { const int row = row0 + ai * 128 + m * 16; f32x4 v = acc[ai][bj][m][n] + z;
#pragma unroll
                            for (int i = 0; i < 4; ++i) v[i] = -0.87506126f * sigmoidf_(v[i]);
                            u32x2 w; w.x = pk2(v[0], v[1]); w.y = pk2(v[2], v[3]); *(u32x2*)(o1 + (size_t)row * 512 + c) = w; }
                } else if (kind < 4) { const f32x4 z = *(const f32x4*)(zp + c), ka = *(const f32x4*)(k_a + c);
#pragma unroll
                    for (int ai = 0; ai < 2; ++ai)
#pragma unroll
                        for (int m = 0; m < 4; ++m) { const int row = row0 + ai * 128 + m * 16; const size_t off = (size_t)row * 512 + c;
                            const u32x2 kw = *(const u32x2*)(KS + off), nw = *(const u32x2*)(NKK + off);
                            const f32x4 av = acc[ai][bj][m][n] + z;
                            const f32x4 kv = {bflo(kw.x), bfhi(kw.x), bflo(kw.y), bfhi(kw.y)}, nv = {bflo(nw.x), bfhi(nw.x), bflo(nw.y), bfhi(nw.y)};
                            f32x4 kd, bb;
#pragma unroll
                            for (int i = 0; i < 4; ++i) { const float sg = sigmoidf_(av[i]); kd[i] = kv[i] * (1.f + (sg - 1.f) * ka[i]); bb[i] = -nv[i] * sg; }
                            u32x2 w1, w2; w1.x = pk2(kd[0], kd[1]); w1.y = pk2(kd[2], kd[3]); w2.x = pk2(bb[0], bb[1]); w2.y = pk2(bb[2], bb[3]);
                            *(u32x2*)(o1 + off) = w1; *(u32x2*)(o2 + off) = w2; }
                } else {
#pragma unroll
                    for (int ai = 0; ai < 2; ++ai)
#pragma unroll
                        for (int m = 0; m < 4; ++m) { const int row = row0 + ai * 128 + m * 16; const f32x4 v = acc[ai][bj][m][n];
                            u32x2 w; w.x = pk2(v[0], v[1]); w.y = pk2(v[2], v[3]); *(u32x2*)(o1 + (size_t)row * 512 + c) = w; }
                } }
    }
};

constexpr int NWAVES = 8;
struct Args { const float* in[38]; float* out; unsigned char* ws; int ph_lo, ph_hi; };
struct Frame {
    LAS unsigned char* lds; unsigned char* ws; const float* const* in; float* out;
    int tid, lane, wave, vcu, G;
};
template <class T> __device__ __forceinline__ T* wsp(unsigned char* ws, size_t off) { return (T*)(ws + off); }

__device__ __forceinline__ void conv_item(const float* W, int ldw, int k0, int n0, int ncols, const float* gain, bf16_t* WT, int ldk, int dst_row0, LAS float* scr, int lane) {
#pragma unroll
    for (int i = 0; i < 8; ++i) { const int kk = (lane >> 3) + 8 * i, c4 = 4 * (lane & 7);
        f32x4 v = __builtin_nontemporal_load((const f32x4*)(W + (size_t)(k0 + kk) * ldw + n0 + c4));
        if (gain) v = v * gain[k0 + kk];
        scr[kk * 33 + c4 + 0] = v[0]; scr[kk * 33 + c4 + 1] = v[1]; scr[kk * 33 + c4 + 2] = v[2]; scr[kk * 33 + c4 + 3] = v[3]; }
    LDS_WAIT(); asm volatile("" ::: "memory");
    const int c = lane & 7;
#pragma unroll
    for (int j = 0; j < 4; ++j) { const int n = (lane >> 3) + 8 * j; const LAS float* s = scr + (8 * c) * 33 + n;
        u32x4 o; o.x = pk2(s[0 * 33], s[1 * 33]); o.y = pk2(s[2 * 33], s[3 * 33]); o.z = pk2(s[4 * 33], s[5 * 33]); o.w = pk2(s[6 * 33], s[7 * 33]);
        if (n < ncols) *(u32x4*)(WT + (size_t)(dst_row0 + n) * ldk + k0 + 8 * c) = o; }
    LDS_WAIT(); asm volatile("" ::: "memory");
}
__device__ __forceinline__ void conv_job_item(int r, const float* W, int ldw, int col0, int nblk, int ncols_last, const float* gain, bf16_t* WT, int ldk, int mode, int dst_off, LAS float* scr, int lane) {
    const int kb = r / nblk, nb = r % nblk; const int nrel = 32 * nb;
    int drow = dst_off + nrel; if (mode) drow = 256 * (nrel >> 7) + (nrel & 127) + (mode == 2 ? 128 : 0);
    conv_item(W, ldw, 64 * kb, col0 + nrel, (nb == nblk - 1) ? ncols_last : 32, gain, WT, ldk, drow, scr, lane);
}
struct ConvItem { const float* src; const float* gain; bf16_t* dst; int ldw, ldk, ncols; };
__device__ __forceinline__ ConvItem conv_desc(int r, const float* W, int ldw, int col0, int nblk, int ncols_last, const float* gain, bf16_t* WT, int ldk, int mode, int dst_off) {
    const int kb = r / nblk, nb = r % nblk; const int nrel = 32 * nb;
    int drow = dst_off + nrel; if (mode) drow = 256 * (nrel >> 7) + (nrel & 127) + (mode == 2 ? 128 : 0);
    ConvItem c; c.src = W + (size_t)(64 * kb) * ldw + col0 + nrel; c.gain = gain ? gain + 64 * kb : nullptr; c.dst = WT + (size_t)drow * ldk + 64 * kb; c.ldw = ldw; c.ldk = ldk; c.ncols = (nb == nblk - 1) ? ncols_last : 32; return c;
}
__device__ __forceinline__ void conv_ld(f32x4 (&v)[8], const ConvItem& c, int lane) {
#pragma unroll
    for (int i = 0; i < 8; ++i) { const int kk = (lane >> 3) + 8 * i, c4 = 4 * (lane & 7); v[i] = __builtin_nontemporal_load((const f32x4*)(c.src + (size_t)kk * c.ldw + c4)); }
}
__device__ __forceinline__ void conv_fin(const f32x4 (&v)[8], const ConvItem& c, LAS float* scr, int lane) {
#pragma unroll
    for (int i = 0; i < 8; ++i) { const int kk = (lane >> 3) + 8 * i, c4 = 4 * (lane & 7); f32x4 x = v[i]; if (c.gain) x = x * c.gain[kk];
        scr[kk * 33 + c4 + 0] = x[0]; scr[kk * 33 + c4 + 1] = x[1]; scr[kk * 33 + c4 + 2] = x[2]; scr[kk * 33 + c4 + 3] = x[3]; }
    LDS_WAIT(); asm volatile("" ::: "memory");
    const int cc = lane & 7;
#pragma unroll
    for (int j = 0; j < 4; ++j) { const int n = (lane >> 3) + 8 * j; const LAS float* sp = scr + (8 * cc) * 33 + n;
        u32x4 o; o.x = pk2(sp[0 * 33], sp[1 * 33]); o.y = pk2(sp[2 * 33], sp[3 * 33]); o.z = pk2(sp[4 * 33], sp[5 * 33]); o.w = pk2(sp[6 * 33], sp[7 * 33]);
        if (n < c.ncols) *(u32x4*)(c.dst + (size_t)n * c.ldk + 8 * cc) = o; }
    LDS_WAIT(); asm volatile("" ::: "memory");
}
template <class D> __device__ __forceinline__ void conv_run(const D& d, int w, int nw, int nitems, LAS float* scr, int lane) {
    f32x4 va[8], vb[8];
    int it = w; if (it >= nitems) return;
    ConvItem ca = d(it), cb = ca; conv_ld(va, ca, lane);
    for (;;) {
        const int it2 = it + nw; const bool h2 = it2 < nitems;
        if (h2) { cb = d(it2); conv_ld(vb, cb, lane); }
        conv_fin(va, ca, scr, lane);
        if (!h2) break;
        const int it3 = it2 + nw; const bool h3 = it3 < nitems;
        if (h3) { ca = d(it3); conv_ld(va, ca, lane); }
        conv_fin(vb, cb, scr, lane);
        if (!h3) break;
        it = it3;
    }
}
struct ConvG0 { const float* const* in; unsigned char* ws; __device__ __forceinline__ ConvItem operator()(int r) const { return conv_desc(r, in[2], 2560, 0, 80, 32, in[1], wsp<bf16_t>(ws, WS_WIN0), 1024, 0, 0); } };
struct ConvG1 { const float* const* in; unsigned char* ws; __device__ __forceinline__ ConvItem operator()(int it) const { constexpr int I1 = 16 * 32, I2 = 16 * 88; int r = it;
    if (r < I1) return conv_desc(r, in[20], 1024, 0, 32, 32, nullptr, wsp<bf16_t>(ws, WS_WOUT0), 1024, 0, 0); r -= I1;
    if (r < I2) return conv_desc(r, in[22], 2816, 0, 88, 32, in[21], wsp<bf16_t>(ws, WS_WGU0), 1024, 1, 0); r -= I2;
    if (r < I2) return conv_desc(r, in[23], 2816, 0, 88, 32, in[21], wsp<bf16_t>(ws, WS_WGU0), 1024, 2, 0); r -= I2;
    return conv_desc(r, in[24], 1024, 0, 32, 32, nullptr, wsp<bf16_t>(ws, WS_WD0), 2816, 0, 0); } };
struct ConvG2 { const float* const* in; unsigned char* ws; __device__ __forceinline__ ConvItem operator()(int it) const { constexpr int I5 = 16 * 64, I6 = 16 * 32, I7 = 16; int r = it;
    if (r < I5) return conv_desc(r, in[26], 3088, 0, 64, 32, in[25], wsp<bf16_t>(ws, WS_WIN1), 1024, 0, 0); r -= I5;
    if (r < I6) return conv_desc(r, in[26], 3088, 2064, 32, 32, in[25], wsp<bf16_t>(ws, WS_WIN1), 1024, 0, 2048); r -= I6;
    if (r < I7) return conv_desc(r, in[26], 3088, 2048, 1, 16, in[25], wsp<bf16_t>(ws, WS_WIN1), 1024, 0, 3072); r -= I7;
    return conv_desc(r, in[32], 1024, 0, 32, 32, nullptr, wsp<bf16_t>(ws, WS_WOUT1), 1024, 0, 0); } };
__device__ __forceinline__ void conv_group(const Frame& F, int group, int w, int nw) {
    LAS float* scr = (LAS float*)(F.lds + F.wave * 16384); const int lane = F.lane;
    if (group == 0) { ConvG0 d{F.in, F.ws}; conv_run(d, w, nw, 16 * 80, scr, lane); }
    else if (group == 1) { ConvG1 d{F.in, F.ws}; conv_run(d, w, nw, 16 * 32 + 2 * 16 * 88 + 44 * 32, scr, lane); }
    else { ConvG2 d{F.in, F.ws}; conv_run(d, w, nw, 16 * 64 + 16 * 32 + 16 + 16 * 32, scr, lane); }
}
__device__ __forceinline__ void phase_prologue(const Frame& F) {
    const int gw = F.vcu * NWAVES + F.wave, NGW = F.G * NWAVES, lane = F.lane;
    unsigned char* ws = F.ws;
    conv_group(F, 0, gw, NGW);
    if (F.G < 256) { conv_group(F, 1, gw, NGW); conv_group(F, 2, gw, NGW); }
    const int gt = F.vcu * 512 + F.tid, NGT = F.G * 512;
    { bf16_t* wlr = wsp<bf16_t>(ws, WS_WLR);
      for (int i = gt; i < 2560 * 256; i += NGT) { const int n = i >> 8, k = i & 255; float v = 0.f;
          if (n < 512)       { if (k < 64) v = F.in[5][k * 512 + n]; }
          else if (n < 1024) { if (k < 64) v = F.in[7][k * 512 + (n - 512)]; }
          else if (n < 1536) { if (k >= 64 && k < 128) v = F.in[9][(k - 64) * 512 + (n - 1024)]; }
          else if (n < 2048) { if (k >= 64 && k < 128) v = F.in[11][(k - 64) * 512 + (n - 1536)]; }
          else               { if (k >= 128) v = F.in[12][(k - 128) * 512 + (n - 2048)]; }
          wlr[i] = f2bf(v); } }
    { f32x2* rt = wsp<f32x2>(ws, WS_ROPE);
      for (int i = gt; i < SEQ * 32; i += NGT) { const int ts = i >> 5, pi = i & 31; const float freq = expf(-(float)(pi & 15) * (9.210340371976184f / 16.f));
          const float ang = ((pi >= 16) ? (float)(ts & 63) : (float)(ts >> 6)) * freq; float sn, cs; sincosf(ang, &sn, &cs); rt[i] = (f32x2){cs, sn}; } }
    { const float* x = F.in[0]; bf16_t* xb = wsp<bf16_t>(ws, WS_XB); float* ssq = wsp<float>(ws, WS_SSQ0);
      for (int m = gw; m < M_TOK; m += NGW) { const f32x4* xr = (const f32x4*)(x + (size_t)m * 1024) + lane; f32x4 v[4]; float s = 0.f;
#pragma unroll
          for (int j = 0; j < 4; ++j) { v[j] = xr[64 * j]; s += (v[j].x * v[j].x + v[j].y * v[j].y) + (v[j].z * v[j].z + v[j].w * v[j].w); }
          s = wave_sum(s);
          u32x2* o8 = (u32x2*)(xb + (size_t)m * 1024) + lane;
#pragma unroll
          for (int j = 0; j < 4; ++j) { u32x2 w; w.x = pk2(v[j].x, v[j].y); w.y = pk2(v[j].z, v[j].w); o8[64 * j] = w; }
          if (lane < 16) ssq[(size_t)m * 16 + lane] = (lane == 0) ? s : 0.f; } }
}
struct ConvEGU { const float* const* in; unsigned char* ws; __device__ __forceinline__ ConvItem operator()(int it) const { constexpr int IG = 16 * 112; const int e = it / (2 * IG), r = it % (2 * IG);
    bf16_t* wegu = wsp<bf16_t>(ws, A_WEGU) + (size_t)e * 2 * D_FFE * 1024;
    if (r < IG) return conv_desc(r, in[35] + (size_t)e * 1024 * D_FFE, D_FFE, 0, 112, 32, in[33], wegu, 1024, 1, 0);
    return conv_desc(r - IG, in[36] + (size_t)e * 1024 * D_FFE, D_FFE, 0, 112, 32, in[33], wegu, 1024, 2, 0); } };
struct ConvED { const float* const* in; unsigned char* ws; __device__ __forceinline__ ConvItem operator()(int it) const { constexpr int ID = 56 * 32; const int e = it / ID, r = it % ID;
    return conv_desc(r, in[37] + (size_t)e * D_FFE * 1024, 1024, 0, 32, 32, nullptr, wsp<bf16_t>(ws, A_WED) + (size_t)e * 1024 * D_FFE, D_FFE, 0, 0); } };
__device__ __forceinline__ void conv_experts_gu(const Frame& F, int w, int nw) { ConvEGU d{F.in, F.ws}; conv_run(d, w, nw, NEXP * 2 * 16 * 112, (LAS float*)(F.lds + F.wave * 16384), F.lane); }
__device__ __forceinline__ void conv_experts_down(const Frame& F, int w, int nw) { ConvED d{F.in, F.ws}; conv_run(d, w, nw, NEXP * 56 * 32, (LAS float*)(F.lds + F.wave * 16384), F.lane); }
__device__ __forceinline__ void phase_conv_experts(const Frame& F) {
    const int gw = F.vcu * NWAVES + F.wave, NGW = F.G * NWAVES;
    conv_experts_gu(F, gw, NGW);
}

__device__ __forceinline__ float dpp8_sum(float v) {
    v += __builtin_bit_cast(float, __builtin_amdgcn_update_dpp(0, __builtin_bit_cast(int, v), 0xB1, 0xF, 0xF, false));
    v += __builtin_bit_cast(float, __builtin_amdgcn_update_dpp(0, __builtin_bit_cast(int, v), 0x4E, 0xF, 0xF, false));
    v += __builtin_bit_cast(float, __builtin_amdgcn_update_dpp(0, __builtin_bit_cast(int, v), 0x141, 0xF, 0xF, false));
    return v;
}
__device__ __forceinline__ void unpack8(const u32x4 w, float (&f)[8]) { f[0] = bflo(w.x); f[1] = bfhi(w.x); f[2] = bflo(w.y); f[3] = bfhi(w.y); f[4] = bflo(w.z); f[5] = bfhi(w.z); f[6] = bflo(w.w); f[7] = bfhi(w.w); }
__device__ __forceinline__ u32x4 pack8f(const float (&f)[8]) { u32x4 w; w.x = pk2(f[0], f[1]); w.y = pk2(f[2], f[3]); w.z = pk2(f[4], f[5]); w.w = pk2(f[6], f[7]); return w; }
__device__ __forceinline__ void phase_prep0(const Frame& F) {
    const int gw = F.vcu * NWAVES + F.wave, lane = F.lane;
    const bf16_t* P = wsp<bf16_t>(F.ws, A_P0);
    bf16_t *RS = wsp<bf16_t>(F.ws, A_RS), *KS = wsp<bf16_t>(F.ws, A_KS), *VS = wsp<bf16_t>(F.ws, A_VS), *NKK = wsp<bf16_t>(F.ws, A_NKK), *AP = wsp<bf16_t>(F.ws, A_AP);
    bf16_t *QH = wsp<bf16_t>(F.ws, A_QH), *KH = wsp<bf16_t>(F.ws, A_KH), *VT = wsp<bf16_t>(F.ws, A_VT0);
    const f32x2* ROPE = wsp<f32x2>(F.ws, WS_ROPE);
    float mu[4][8], kkw[8], qn8[8], kn8[8];
#pragma unroll
    for (int j = 0; j < 4; ++j)
#pragma unroll
        for (int e = 0; e < 8; ++e) { const int col = 8 * (lane + 64 * j) + e; mu[j][e] = col < RW_IN ? F.in[3][col] : 0.f; }
#pragma unroll
    for (int e = 0; e < 8; ++e) { kkw[e] = F.in[13][8 * lane + e]; qn8[e] = F.in[18][8 * (lane & 7) + e]; kn8[e] = F.in[19][8 * (lane & 7) + e]; }
    for (int g8 = gw; g8 < M_TOK / 8; g8 += F.G * NWAVES) {
        u32x4 prev[4], cur[5], nxt[4];
        { const int tok = g8 * 8; const int ts = tok & (SEQ - 1);
#pragma unroll
          for (int j = 0; j < 5; ++j) cur[j] = *(const u32x4*)(P + (size_t)tok * E_IN + 8 * (lane + 64 * j));
#pragma unroll
          for (int j = 0; j < 4; ++j) prev[j] = (ts > 0) ? *(const u32x4*)(P + (size_t)(tok - 1) * E_IN + 8 * (lane + 64 * j)) : (u32x4){0u, 0u, 0u, 0u}; }
        for (int tt = 0; tt < 8; ++tt) { const int tok = g8 * 8 + tt; const int ts = tok & (SEQ - 1); const int bb = tok >> 11;
            u32x4 ncur4 = (u32x4){0u, 0u, 0u, 0u};
#pragma unroll
            for (int j = 0; j < 4; ++j) nxt[j] = (ts < SEQ - 1) ? *(const u32x4*)(P + (size_t)(tok + 1) * E_IN + 8 * (lane + 64 * j)) : (u32x4){0u, 0u, 0u, 0u};
            if (tt < 7) ncur4 = *(const u32x4*)(P + (size_t)(tok + 1) * E_IN + 8 * (lane + 256));
            const f32x4 rp0 = *(const f32x4*)(ROPE + (size_t)ts * 32 + 4 * (lane & 7)), rp1 = *(const f32x4*)(ROPE + (size_t)ts * 32 + 4 * (lane & 7) + 2);
            const float cs4[4] = {rp0[0], rp0[2], rp1[0], rp1[2]}, sn4[4] = {rp0[1], rp0[3], rp1[1], rp1[3]};
            float s[4][8];
#pragma unroll
            for (int j = 0; j < 4; ++j) { float c[8], p[8], n[8]; unpack8(cur[j], c); unpack8(prev[j], p); unpack8(nxt[j], n);
#pragma unroll
                for (int e = 0; e < 8; ++e) s[j][e] = c[e] + (0.5f * (p[e] + n[e]) - c[e]) * mu[j][e]; }
            const size_t o512 = (size_t)tok * 512 + 8 * lane;
            *(u32x4*)(RS + o512) = pack8f(s[0]); *(u32x4*)(KS + o512) = pack8f(s[1]); *(u32x4*)(VS + o512) = pack8f(s[2]);
            { float kr[8]; float ss = 0.f;
#pragma unroll
              for (int e = 0; e < 8; ++e) { kr[e] = s[1][e] * kkw[e]; ss += kr[e] * kr[e]; }
              ss = dpp8_sum(ss); const float inv = -1.f / fmaxf(sqrtf(ss), 1e-12f);
#pragma unroll
              for (int e = 0; e < 8; ++e) kr[e] *= inv;
              *(u32x4*)(NKK + o512) = pack8f(kr); }
            float x3[8], x4[8]; unpack8(cur[3], x3); unpack8(cur[4], x4);
            { float ap[8];
#pragma unroll
              for (int e = 0; e < 8; ++e) ap[e] = lane < 8 ? tanhf(s[3][e]) : (lane < 16 ? s[3][e] : sigmoidf_(s[3][e]));
              if (lane < 32) *(u32x4*)(AP + (size_t)tok * 256 + 8 * lane) = pack8f(ap); }
#pragma unroll
            for (int which = 0; which < 2; ++which) { float (&x)[8] = which ? x4 : x3; float ss = 0.f;
#pragma unroll
                for (int e = 0; e < 8; ++e) ss += x[e] * x[e];
                ss = dpp8_sum(ss); const float rs = 1.0f / sqrtf(ss * (1.f / 64.f) + NORM_EPS);
                const bool isk = which && lane >= 32; float o[8];
#pragma unroll
                for (int p = 0; p < 4; ++p) { const float x0 = x[2 * p] * rs * (isk ? kn8[2 * p] : qn8[2 * p]), x1 = x[2 * p + 1] * rs * (isk ? kn8[2 * p + 1] : qn8[2 * p + 1]);
                    o[2 * p] = x0 * cs4[p] - x1 * sn4[p]; o[2 * p + 1] = x0 * sn4[p] + x1 * cs4[p]; }
                if (!isk) {
#pragma unroll
                    for (int e = 0; e < 8; ++e) o[e] *= 0.18033688011112042f; }
                if (which == 0) { if (lane >= 32) *(u32x4*)(QH + (size_t)tok * 512 + 8 * (lane - 32)) = pack8f(o); }
                else { if (lane < 32) *(u32x4*)(QH + (size_t)tok * 512 + 256 + 8 * lane) = pack8f(o);
                       else if (lane < 48) *(u32x4*)(KH + (size_t)tok * 128 + 8 * (lane - 32)) = pack8f(o); } }
            if (lane >= 48) { const int g = (lane - 48) >> 3, d0 = 8 * ((lane - 48) & 7); const unsigned w[4] = {cur[4].x, cur[4].y, cur[4].z, cur[4].w};
#pragma unroll
                for (int e = 0; e < 8; ++e) VT[((size_t)(bb * 2 + g) * 64 + d0 + e) * SEQ + ts] = (bf16_t)((e & 1) ? (w[e >> 1] >> 16) : (w[e >> 1] & 0xffffu)); }
#pragma unroll
            for (int j = 0; j < 4; ++j) { prev[j] = cur[j]; cur[j] = nxt[j]; }
            cur[4] = ncur4;
        }
    }
}

__device__ __forceinline__ float dpp_row_sum(float v) {
    v += __builtin_bit_cast(float, __builtin_amdgcn_update_dpp(0, __builtin_bit_cast(int, v), 0xB1, 0xF, 0xF, false));
    v += __builtin_bit_cast(float, __builtin_amdgcn_update_dpp(0, __builtin_bit_cast(int, v), 0x4E, 0xF, 0xF, false));
    v += __builtin_bit_cast(float, __builtin_amdgcn_update_dpp(0, __builtin_bit_cast(int, v), 0x141, 0xF, 0xF, false));
    v += __builtin_bit_cast(float, __builtin_amdgcn_update_dpp(0, __builtin_bit_cast(int, v), 0x140, 0xF, 0xF, false));
    return v;
}
constexpr int SC_STEPS = 32, SC_STRIDE = 352, SC_BUF = SC_STEPS * SC_STRIDE;
__device__ __forceinline__ float dpp_row8_sum(float v) {
    v += __builtin_bit_cast(float, __builtin_amdgcn_update_dpp(0, __builtin_bit_cast(int, v), 0xB1, 0xF, 0xF, false));
    v += __builtin_bit_cast(float, __builtin_amdgcn_update_dpp(0, __builtin_bit_cast(int, v), 0x4E, 0xF, 0xF, false));
    v += __builtin_bit_cast(float, __builtin_amdgcn_update_dpp(0, __builtin_bit_cast(int, v), 0x141, 0xF, 0xF, false));
    return v;
}
struct ScOps { f32x2 w[4], kd[4], a[4], b[4], r[4]; float v; };
__device__ __forceinline__ void sc_ld(ScOps& o, const LAS float* bs, const LAS float* vp) {
#pragma unroll
    for (int i = 0; i < 2; ++i) {
        const f32x4 w4 = *(const LAS f32x4*)(bs + 4 * i), k4 = *(const LAS f32x4*)(bs + 64 + 4 * i), a4 = *(const LAS f32x4*)(bs + 128 + 4 * i), b4 = *(const LAS f32x4*)(bs + 192 + 4 * i), r4 = *(const LAS f32x4*)(bs + 256 + 4 * i);
        o.w[2 * i] = (f32x2){w4[0], w4[1]}; o.w[2 * i + 1] = (f32x2){w4[2], w4[3]}; o.kd[2 * i] = (f32x2){k4[0], k4[1]}; o.kd[2 * i + 1] = (f32x2){k4[2], k4[3]};
        o.a[2 * i] = (f32x2){a4[0], a4[1]}; o.a[2 * i + 1] = (f32x2){a4[2], a4[3]}; o.b[2 * i] = (f32x2){b4[0], b4[1]}; o.b[2 * i + 1] = (f32x2){b4[2], b4[3]};
        o.r[2 * i] = (f32x2){r4[0], r4[1]}; o.r[2 * i + 1] = (f32x2){r4[2], r4[3]}; }
    o.v = *vp;
}
template <int DIR> __device__ __forceinline__ float sc_step(f32x2 (&s)[4], const ScOps& o) {
    f32x2 u[4];
#pragma unroll
    for (int i = 0; i < 4; ++i) u[i] = o.kd[i] * o.v;
    f32x2 p = s[0] * o.a[0], q = s[1] * o.a[1];
    p = __builtin_elementwise_fma(s[2], o.a[2], p); q = __builtin_elementwise_fma(s[3], o.a[3], q); p = p + q;
    float sa = dpp_row8_sum(p[0] + p[1]);
    f32x2 yp, yq;
    if (DIR) { yp = s[0] * o.r[0]; yq = s[1] * o.r[1]; yp = __builtin_elementwise_fma(s[2], o.r[2], yp); yq = __builtin_elementwise_fma(s[3], o.r[3], yq); }
    const f32x2 sa2 = {sa, sa};
#pragma unroll
    for (int i = 0; i < 4; ++i) { const f32x2 t = __builtin_elementwise_fma(o.b[i], sa2, u[i]); s[i] = __builtin_elementwise_fma(s[i], o.w[i], t); }
    if (!DIR) { yp = s[0] * o.r[0]; yq = s[1] * o.r[1]; yp = __builtin_elementwise_fma(s[2], o.r[2], yp); yq = __builtin_elementwise_fma(s[3], o.r[3], yq); }
    yp = yp + yq;
    return dpp_row8_sum(yp[0] + yp[1]);
}
__device__ __forceinline__ void attn_tile_step(const LAS unsigned char* kb, const LAS unsigned char* vb, const bf16x8 (&q)[4], f32x16& o0, f32x16& o1, float& mrun, float& lrun, int r32, int hi) {
    f32x16 c0 = {}, c1 = {};
#pragma unroll
    for (int s4 = 0; s4 < 4; ++s4) { const int chk = 2 * s4 + hi;
        const bf16x8 k0 = *(const LAS bf16x8*)(kb + r32 * 128 + ((chk ^ (r32 & 7)) * 16));
        const bf16x8 k1 = *(const LAS bf16x8*)(kb + (32 + r32) * 128 + ((chk ^ (r32 & 7)) * 16));
        c0 = __builtin_amdgcn_mfma_f32_32x32x16_bf16(k0, q[s4], c0, 0, 0, 0);
        c1 = __builtin_amdgcn_mfma_f32_32x32x16_bf16(k1, q[s4], c1, 0, 0, 0); }
    float mx = c0[0];
#pragma unroll
    for (int r = 0; r < 16; ++r) { mx = fmaxf(mx, c0[r]); mx = fmaxf(mx, c1[r]); }
    mx = fmaxf(mx, __shfl_xor(mx, 32));
    const float mnew = fmaxf(mrun, mx); const float alpha = __builtin_amdgcn_exp2f(mrun - mnew); mrun = mnew;
    float ls = 0.f;
#pragma unroll
    for (int r = 0; r < 16; ++r) { c0[r] = __builtin_amdgcn_exp2f(c0[r] - mnew); c1[r] = __builtin_amdgcn_exp2f(c1[r] - mnew); ls += c0[r] + c1[r]; }
    lrun = lrun * alpha + ls;
#pragma unroll
    for (int r = 0; r < 16; ++r) { o0[r] *= alpha; o1[r] *= alpha; }
    u32x4 w00, w01, w10, w11;
    w00.x = pk2(c0[0], c0[1]); w00.y = pk2(c0[2], c0[3]); w00.z = pk2(c0[4], c0[5]); w00.w = pk2(c0[6], c0[7]);
    w01.x = pk2(c0[8], c0[9]); w01.y = pk2(c0[10], c0[11]); w01.z = pk2(c0[12], c0[13]); w01.w = pk2(c0[14], c0[15]);
    w10.x = pk2(c1[0], c1[1]); w10.y = pk2(c1[2], c1[3]); w10.z = pk2(c1[4], c1[5]); w10.w = pk2(c1[6], c1[7]);
    w11.x = pk2(c1[8], c1[9]); w11.y = pk2(c1[10], c1[11]); w11.z = pk2(c1[12], c1[13]); w11.w = pk2(c1[14], c1[15]);
    const bf16x8 p00 = __builtin_bit_cast(bf16x8, w00), p01 = __builtin_bit_cast(bf16x8, w01), p10 = __builtin_bit_cast(bf16x8, w10), p11 = __builtin_bit_cast(bf16x8, w11);
#define AT_VF(dd_, chk_) ({ const int sw_ = ((dd_) >> 1) & 7; const u32x2 lo_ = *(const LAS u32x2*)(vb + (dd_) * 128 + (((chk_) ^ sw_) * 16) + hi * 8); \
        const u32x2 hh_ = *(const LAS u32x2*)(vb + (dd_) * 128 + ((((chk_) + 1) ^ sw_) * 16) + hi * 8); const u32x4 vv_ = {lo_.x, lo_.y, hh_.x, hh_.y}; __builtin_bit_cast(bf16x8, vv_); })
    o0 = __builtin_amdgcn_mfma_f32_32x32x16_bf16(AT_VF(r32, 0), p00, o0, 0, 0, 0);
    o0 = __builtin_amdgcn_mfma_f32_32x32x16_bf16(AT_VF(r32, 2), p01, o0, 0, 0, 0);
    o0 = __builtin_amdgcn_mfma_f32_32x32x16_bf16(AT_VF(r32, 4), p10, o0, 0, 0, 0);
    o0 = __builtin_amdgcn_mfma_f32_32x32x16_bf16(AT_VF(r32, 6), p11, o0, 0, 0, 0);
    o1 = __builtin_amdgcn_mfma_f32_32x32x16_bf16(AT_VF(32 + r32, 0), p00, o1, 0, 0, 0);
    o1 = __builtin_amdgcn_mfma_f32_32x32x16_bf16(AT_VF(32 + r32, 2), p01, o1, 0, 0, 0);
    o1 = __builtin_amdgcn_mfma_f32_32x32x16_bf16(AT_VF(32 + r32, 4), p10, o1, 0, 0, 0);
    o1 = __builtin_amdgcn_mfma_f32_32x32x16_bf16(AT_VF(32 + r32, 6), p11, o1, 0, 0, 0);
#undef AT_VF
}
__device__ __forceinline__ void attn_store(bf16_t* op, const f32x16& o0, const f32x16& o1, float lrun) {
    const float ltot = lrun + __shfl_xor(lrun, 32); const float inv = 1.f / ltot;
#pragma unroll
    for (int q4 = 0; q4 < 4; ++q4) { u32x2 w0, w1;
        w0.x = pk2(o0[4 * q4 + 0] * inv, o0[4 * q4 + 1] * inv); w0.y = pk2(o0[4 * q4 + 2] * inv, o0[4 * q4 + 3] * inv);
        w1.x = pk2(o1[4 * q4 + 0] * inv, o1[4 * q4 + 1] * inv); w1.y = pk2(o1[4 * q4 + 2] * inv, o1[4 * q4 + 3] * inv);
        *(u32x2*)(op + 8 * q4) = w0; *(u32x2*)(op + 32 + 8 * q4) = w1; }
}
template <int DIR> __device__ __forceinline__ void scan_job(const Frame& F, int b, int h, int half, int job) {
    LAS float* buf = (LAS float*)F.lds; LAS float* ybuf = buf + 2 * SC_BUF;
    const int tid = F.tid, lane = F.lane, wave = F.wave;
    const bf16_t* s0 = wsp<bf16_t>(F.ws, DIR ? A_LWB : A_LWF); const bf16_t* s1 = wsp<bf16_t>(F.ws, DIR ? A_KDB : A_KDF); const bf16_t* s2 = wsp<bf16_t>(F.ws, A_NKK);
    const bf16_t* s3 = wsp<bf16_t>(F.ws, DIR ? A_BBB : A_BBF); const bf16_t* s4 = wsp<bf16_t>(F.ws, A_RS); const bf16_t* s5 = wsp<bf16_t>(F.ws, A_VS);
    float* Y = wsp<float>(F.ws, DIR ? A_YB : A_YF);
    constexpr int NCH = SEQ / SC_STEPS;
    const int htid = tid - 256;
#define SC_STAGE_LD(ch) do { const int step_ = ht_ >> 3, sub_ = ht_ & 7; \
        const int sq_ = (ch) * SC_STEPS + step_; const size_t to_ = (size_t)(b * SEQ + (DIR ? (SEQ - 1 - sq_) : sq_)) * 512 + h * 64 + 8 * sub_; \
        sst[0] = *(const u32x4*)(s0 + to_); sst[1] = *(const u32x4*)(s1 + to_); sst[2] = *(const u32x4*)(s2 + to_); sst[3] = *(const u32x4*)(s3 + to_); sst[4] = *(const u32x4*)(s4 + to_); \
        if (sub_ < 4) sst[5] = *(const u32x4*)(s5 + to_ + half * 32); } while (0)
#define SC_STAGE_ST(bufp) do { const int step_ = ht_ >> 3, sub_ = ht_ & 7; LAS float* d_ = (bufp) + step_ * SC_STRIDE + 8 * sub_; \
        _Pragma("unroll") for (int i_ = 0; i_ < 6; ++i_) { if (i_ < 5 || sub_ < 4) { \
            f32x4 lo_ = {bflo(sst[i_].x), bfhi(sst[i_].x), bflo(sst[i_].y), bfhi(sst[i_].y)}, hi_ = {bflo(sst[i_].z), bfhi(sst[i_].z), bflo(sst[i_].w), bfhi(sst[i_].w)}; \
            if (i_ == 0) { _Pragma("unroll") for (int e_ = 0; e_ < 4; ++e_) { lo_[e_] = __builtin_amdgcn_exp2f(lo_[e_]); hi_[e_] = __builtin_amdgcn_exp2f(hi_[e_]); } } \
            *(LAS f32x4*)(d_ + i_ * 64) = lo_; *(LAS f32x4*)(d_ + i_ * 64 + 4) = hi_; } } } while (0)
#define SC_STAGE(ch, bufp) do { SC_STAGE_LD(ch); SC_STAGE_ST(bufp); } while (0)
#define SC_FLUSH(ch) do { const LAS float* yb_ = ybuf + ((ch) & 1) * 1024; const int step_ = ht_ >> 3, c_ = ht_ & 7; const int sq_ = (ch) * SC_STEPS + step_; const int tok_ = b * SEQ + (DIR ? (SEQ - 1 - sq_) : sq_); \
        *(f32x4*)(Y + (size_t)tok_ * 512 + h * 64 + half * 32 + 4 * c_) = *(const LAS f32x4*)(yb_ + step_ * 32 + 4 * c_); } while (0)
    LAS unsigned char* alds = F.lds + 98304;
    const int hw = wave - 4;
    const bf16_t *QH = wsp<bf16_t>(F.ws, A_QH), *KH = wsp<bf16_t>(F.ws, A_KH), *VT0 = wsp<bf16_t>(F.ws, A_VT0); bf16_t* YC = wsp<bf16_t>(F.ws, A_YCAT);
    u32x4 sst[6];
    bf16x8 qfA[4], qfB[4]; f32x16 oA0 = {}, oA1 = {}, oB0 = {}, oB1 = {}; float mA = -1e30f, mB = -1e30f, lA = 0.f, lB = 0.f;
#define AT_UNIT(ch_) (2 * job + ((ch_) >> 5))
#define AT_LOAD(ch_) do { const int u_ = AT_UNIT(ch_), t_ = (ch_) & 31; const int ab_ = u_ >> 6, ag_ = (u_ >> 5) & 1; \
        _Pragma("unroll") for (int i_ = 0; i_ < 2; ++i_) { const int p_ = ht_ + 256 * i_, key_ = p_ >> 3, c_ = p_ & 7; \
            akst[i_] = *(const u32x4*)(KH + (size_t)(ab_ * SEQ + 64 * t_ + key_) * 128 + ag_ * 64 + 8 * c_); \
            avst[i_] = *(const u32x4*)(VT0 + ((size_t)(ab_ * 2 + ag_) * 64 + key_) * SEQ + 64 * t_ + 8 * c_); } } while (0)
#define AT_STORE(ch_) do { const int bo_ = ((ch_) & 1) * 8192; \
        _Pragma("unroll") for (int i_ = 0; i_ < 2; ++i_) { const int p_ = ht_ + 256 * i_, key_ = p_ >> 3, c_ = p_ & 7; \
            *(LAS u32x4*)(alds + bo_ + key_ * 128 + ((c_ ^ (key_ & 7)) * 16)) = akst[i_]; \
            *(LAS u32x4*)(alds + 16384 + bo_ + key_ * 128 + ((c_ ^ ((key_ >> 1) & 7)) * 16)) = avst[i_]; } } while (0)
#define AT_DMA(ch_) do { const int u_ = AT_UNIT(ch_), t_ = (ch_) & 31; const int ab_ = u_ >> 6, ag_ = (u_ >> 5) & 1; const int bo_ = ((ch_) & 1) * 8192; \
        _Pragma("unroll") for (int i_ = 0; i_ < 2; ++i_) { const int p_ = (hw * 2 + i_) * 64 + ln_, row_ = p_ >> 3, cp_ = p_ & 7; \
            __builtin_amdgcn_global_load_lds((const unsigned*)(KH + (size_t)(ab_ * SEQ + 64 * t_ + row_) * 128 + ag_ * 64 + 8 * (cp_ ^ (row_ & 7))), (LAS unsigned*)(alds + bo_ + (hw * 2 + i_) * 1024), 16, 0, 0); \
            __builtin_amdgcn_global_load_lds((const unsigned*)(VT0 + ((size_t)(ab_ * 2 + ag_) * 64 + row_) * SEQ + 64 * t_ + 8 * (cp_ ^ ((row_ >> 1) & 7))), (LAS unsigned*)(alds + 16384 + bo_ + (hw * 2 + i_) * 1024), 16, 0, 0); } } while (0)
    __syncthreads();
    if (wave >= 4) { int ht_ = htid; asm volatile("" : "+v"(ht_)); const int ln_ = ht_ & 63; SC_STAGE(0, buf); AT_DMA(0); asm volatile("s_waitcnt vmcnt(0)" ::: "memory"); }
    __syncthreads();
    if (wave < 4) {
        __builtin_amdgcn_s_setprio(3);
        const int row = lane >> 3, kg = lane & 7, rowl = wave * 8 + row;
        f32x2 s[4] = {(f32x2){0.f, 0.f}, (f32x2){0.f, 0.f}, (f32x2){0.f, 0.f}, (f32x2){0.f, 0.f}};
        for (int ch = 0; ch < NCH; ++ch) {
            const LAS float* bc = buf + (ch & 1) * SC_BUF + 8 * kg; const LAS float* vc = buf + (ch & 1) * SC_BUF + 320 + rowl; LAS float* yb = ybuf + (ch & 1) * 1024 + rowl;
            ScOps oa, ob; sc_ld(oa, bc, vc);
#pragma unroll 2
            for (int step = 0; step < SC_STEPS; step += 2) {
                sc_ld(ob, bc + (step + 1) * SC_STRIDE, vc + (step + 1) * SC_STRIDE);
                const float y0 = sc_step<DIR>(s, oa); yb[step * 32] = y0;
                if (step + 2 < SC_STEPS) sc_ld(oa, bc + (step + 2) * SC_STRIDE, vc + (step + 2) * SC_STRIDE);
                const float y1 = sc_step<DIR>(s, ob); yb[(step + 1) * 32] = y1; }
            __syncthreads();
        }
        __builtin_amdgcn_s_setprio(0);
    } else {
        for (int ch = 0; ch < NCH; ++ch) {
            int ht_ = htid; asm volatile("" : "+v"(ht_));
            int ln_ = lane; asm volatile("" : "+v"(ln_)); const int r32 = ln_ & 31, hi = ln_ >> 5;
            if (ch > 0) SC_FLUSH(ch - 1);
            if (ch + 1 < NCH) { AT_DMA(ch + 1); SC_STAGE_LD(ch + 1); }
            __builtin_amdgcn_sched_barrier(0);
            const int u = AT_UNIT(ch), t = ch & 31; const int ab = u >> 6, ag = (u >> 5) & 1, aqt = u & 31; const int head = 4 * ag + hw;
            const int qrowA = ab * SEQ + aqt * 64 + r32, qrowB = qrowA + 32;
            if (t == 0) {
#pragma unroll
                for (int s4 = 0; s4 < 4; ++s4) { qfA[s4] = *(const bf16x8*)(QH + (size_t)qrowA * 512 + head * 64 + 16 * s4 + 8 * hi); qfB[s4] = *(const bf16x8*)(QH + (size_t)qrowB * 512 + head * 64 + 16 * s4 + 8 * hi); }
                oA0 = f32x16{}; oA1 = f32x16{}; oB0 = f32x16{}; oB1 = f32x16{}; mA = -1e30f; mB = -1e30f; lA = 0.f; lB = 0.f; }
            { const LAS unsigned char* kb = alds + (ch & 1) * 8192; const LAS unsigned char* vb = alds + 16384 + (ch & 1) * 8192;
              __builtin_amdgcn_sched_barrier(0);
              attn_tile_step(kb, vb, qfA, oA0, oA1, mA, lA, r32, hi);
              __builtin_amdgcn_sched_barrier(0);
              if (ch + 1 < NCH) { SC_STAGE_ST(buf + ((ch + 1) & 1) * SC_BUF); }
              __builtin_amdgcn_sched_barrier(0);
              attn_tile_step(kb, vb, qfB, oB0, oB1, mB, lB, r32, hi);
              __builtin_amdgcn_sched_barrier(0); }
            if (t == 31) { attn_store(YC + (size_t)qrowA * 1024 + 512 + head * 64 + 4 * hi, oA0, oA1, lA); attn_store(YC + (size_t)qrowB * 1024 + 512 + head * 64 + 4 * hi, oB0, oB1, lB); }
            asm volatile("s_waitcnt vmcnt(0)" ::: "memory");
            __syncthreads();
        }
        { int ht_ = htid; asm volatile("" : "+v"(ht_)); SC_FLUSH(NCH - 1); }
    }
#undef AT_UNIT
#undef AT_LOAD
#undef AT_STORE
#undef SC_STAGE
#undef SC_STAGE_LD
#undef SC_STAGE_ST
#undef SC_FLUSH
}
constexpr int CS_SLOT = 9216, CS_RS = 144;
__device__ __forceinline__ void cs_mm(f32x4 (&acc)[2], const LAS unsigned char* L, const LAS unsigned char* Rt, int mi, int ni0, int fr, int fq) {
#pragma unroll
    for (int s2 = 0; s2 < 2; ++s2) { const bf16x8 a = *(const LAS bf16x8*)(L + (16 * mi + fr) * CS_RS + (32 * s2 + 8 * fq) * 2);
#pragma unroll
        for (int jj = 0; jj < 2; ++jj) { const bf16x8 bb = *(const LAS bf16x8*)(Rt + (16 * (ni0 + jj) + fr) * CS_RS + (32 * s2 + 8 * fq) * 2);
            acc[jj] = __builtin_amdgcn_mfma_f32_16x16x32_bf16(a, bb, acc[jj], 0, 0, 0); } }
}
__device__ __forceinline__ void cs_st_t8(LAS unsigned char* dst, const f32x4 (&acc)[2], int mi, int ni0, int fr, int fq) {
#pragma unroll
    for (int jj = 0; jj < 2; ++jj) { u32x2 w; w.x = pk2(acc[jj][0], acc[jj][1]); w.y = pk2(acc[jj][2], acc[jj][3]);
        *(LAS u32x2*)(dst + (16 * (ni0 + jj) + fr) * CS_RS + (16 * mi + 4 * fq) * 2) = w; }
}
__device__ __forceinline__ void cs_st_sc(LAS unsigned char* dst, const f32x4 (&acc)[2], int mi, int ni0, int fr, int fq) {
#pragma unroll
    for (int jj = 0; jj < 2; ++jj)
#pragma unroll
        for (int r = 0; r < 4; ++r) *(LAS bf16_t*)(dst + (16 * mi + 4 * fq + r) * CS_RS + (16 * (ni0 + jj) + fr) * 2) = f2bf(acc[jj][r]);
}
__device__ __forceinline__ void cs_ld_t8(f32x4 (&acc)[2], const LAS unsigned char* src, int mi, int ni0, int fr, int fq) {
#pragma unroll
    for (int jj = 0; jj < 2; ++jj) { const u32x2 w = *(const LAS u32x2*)(src + (16 * (ni0 + jj) + fr) * CS_RS + (16 * mi + 4 * fq) * 2);
        acc[jj] = (f32x4){bflo(w.x), bfhi(w.x), bflo(w.y), bfhi(w.y)}; }
}
#define CS_ZERO(acc) do { acc[0] = (f32x4){0.f, 0.f, 0.f, 0.f}; acc[1] = acc[0]; } while (0)
typedef short v4i16_t __attribute__((ext_vector_type(4)));
template <int RS = CS_RS> __device__ __forceinline__ bf16x8 cs_afrag_tr(const LAS unsigned char* LT, int mi, int s2, int fr, int fq) {
    const LAS unsigned char* p = LT + (32 * s2 + 8 * fq + (fr >> 2)) * RS + (16 * mi + 4 * (fr & 3)) * 2;
    const v4i16_t lo = __builtin_amdgcn_ds_read_tr16_b64_v4i16((LAS v4i16_t*)p);
    const v4i16_t hi = __builtin_amdgcn_ds_read_tr16_b64_v4i16((LAS v4i16_t*)(p + 4 * RS));
    return (bf16x8){lo[0], lo[1], lo[2], lo[3], hi[0], hi[1], hi[2], hi[3]};
}
__device__ __forceinline__ void cs_mm_tr(f32x4 (&acc)[2], const LAS unsigned char* LT, const LAS unsigned char* Rt, int mi, int ni0, int fr, int fq) {
#pragma unroll
    for (int s2 = 0; s2 < 2; ++s2) { const bf16x8 a = cs_afrag_tr(LT, mi, s2, fr, fq);
#pragma unroll
        for (int jj = 0; jj < 2; ++jj) { const bf16x8 bb = *(const LAS bf16x8*)(Rt + (16 * (ni0 + jj) + fr) * CS_RS + (32 * s2 + 8 * fq) * 2);
            acc[jj] = __builtin_amdgcn_mfma_f32_16x16x32_bf16(a, bb, acc[jj], 0, 0, 0); } }
}
__device__ __forceinline__ void cs_mm_tr2(f32x4 (&aU)[2], f32x4 (&aS)[2], const LAS unsigned char* LUT, const LAS unsigned char* LST, const LAS unsigned char* Rt, bool doS, int mi, int ni0, int fr, int fq) {
#pragma unroll
    for (int s2 = 0; s2 < 2; ++s2) { const bf16x8 au = cs_afrag_tr(LUT, mi, s2, fr, fq); const bf16x8 as = cs_afrag_tr(LST, mi, s2, fr, fq);
#pragma unroll
        for (int jj = 0; jj < 2; ++jj) { const bf16x8 bb = *(const LAS bf16x8*)(Rt + (16 * (ni0 + jj) + fr) * CS_RS + (32 * s2 + 8 * fq) * 2);
            aU[jj] = __builtin_amdgcn_mfma_f32_16x16x32_bf16(au, bb, aU[jj], 0, 0, 0);
            if (doS) aS[jj] = __builtin_amdgcn_mfma_f32_16x16x32_bf16(as, bb, aS[jj], 0, 0, 0); } }
}
__device__ __forceinline__ void cs_mask(f32x4 (&acc)[2], int mi, int ni0, int fr, int fq, int mode) {
#pragma unroll
    for (int jj = 0; jj < 2; ++jj) { const int ni = ni0 + jj;
        const bool keep_all = (mode == 1) ? (ni < mi) : (ni > mi), diag = (ni == mi);
        if (diag) {
#pragma unroll
            for (int r = 0; r < 4; ++r) { const int ml = 4 * fq + r; const bool k = (mode == 0) ? (ml < fr) : (mode == 1) ? (fr < ml) : (ml <= fr); if (!k) acc[jj][r] = 0.f; }
        } else if (!keep_all) acc[jj] = (f32x4){0.f, 0.f, 0.f, 0.f}; }
}
template <int DIR> __device__ __forceinline__ void cscan_job(const Frame& F, int b, int h) {
    const int tid = F.tid, lane = F.lane, wave = F.wave, fr = lane & 15, fq = lane >> 4;
    LAS unsigned char* L0 = F.lds;
#define SL(i) (L0 + (i) * CS_SLOT)
    LAS float* Dl = (LAS float*)(SL(14) + 8704);
    const bf16_t* g0 = wsp<bf16_t>(F.ws, DIR ? A_LWB : A_LWF); const bf16_t* g1 = wsp<bf16_t>(F.ws, DIR ? A_KDB : A_KDF); const bf16_t* g2 = wsp<bf16_t>(F.ws, A_NKK);
    const bf16_t* g3 = wsp<bf16_t>(F.ws, DIR ? A_BBB : A_BBF); const bf16_t* g4 = wsp<bf16_t>(F.ws, A_RS); const bf16_t* g5 = wsp<bf16_t>(F.ws, A_VS);
    bf16_t* Y = wsp<bf16_t>(F.ws, DIR ? A_YB : A_YF);
    const int mi = wave >> 1, ni0 = 2 * (wave & 1);
    const int rt_ = tid >> 3, rc_ = tid & 7;
    const int ek = tid & 63, etq = tid >> 6;
    u32x4 raw[5], rawv, rawv_cur; bf16_t lwn[8];
#define CS_LOAD(n_) do { const int sq_ = 64 * (n_) + rt_; const size_t to_ = (size_t)(b * SEQ + (DIR ? (SEQ - 1 - sq_) : sq_)) * 512 + h * 64; \
        raw[1] = *(const u32x4*)(g1 + to_ + 8 * rc_); raw[2] = *(const u32x4*)(g2 + to_ + 8 * rc_); raw[3] = *(const u32x4*)(g3 + to_ + 8 * rc_); raw[4] = *(const u32x4*)(g4 + to_ + 8 * rc_); \
        rawv = *(const u32x4*)(g5 + to_ + 8 * rc_); \
        _Pragma("unroll") for (int j_ = 0; j_ < 8; ++j_) { const int sq2_ = 64 * (n_) + 8 * etq + j_; lwn[j_] = g0[(size_t)(b * SEQ + (DIR ? (SEQ - 1 - sq2_) : sq2_)) * 512 + h * 64 + ek]; } } while (0)
    __syncthreads();
    for (int i = tid; i < 8704 / 4; i += 512) ((LAS unsigned*)SL(14))[i] = 0u;
    CS_LOAD(0);
    for (int n = 0; n < 32; ++n) {
        float lwv[8], cw[8];
#pragma unroll
        for (int j = 0; j < 8; ++j) lwv[j] = bf2f(lwn[j]);
        cw[0] = lwv[0];
#pragma unroll
        for (int j = 1; j < 8; ++j) cw[j] = cw[j - 1] + lwv[j];
        LAS float* PART = (LAS float*)SL(12);
        PART[etq * 64 + ek] = cw[7];
#pragma unroll
        for (int q = 1; q < 5; ++q) *(LAS u32x4*)(SL(7 + q) + rt_ * CS_RS + rc_ * 16) = raw[q];
        rawv_cur = rawv;
        if (n + 1 < 32) CS_LOAD(n + 1);
        __syncthreads();
        { float off = 0.f, tot = 0.f;
#pragma unroll
          for (int q = 0; q < 8; ++q) { const float p = PART[q * 64 + ek]; tot += p; if (q < etq) off += p; }
          const float ec = __builtin_amdgcn_exp2f(tot);
          if (etq == 0) Dl[ek] = ec;
          unsigned pa[4], pbh[4], pkh[4];
#pragma unroll
          for (int j = 0; j < 8; ++j) { const int t = 8 * etq + j; const float c = cw[j] + off, cp = c - lwv[j];
              const float e1 = __builtin_amdgcn_exp2f(c), em = __builtin_amdgcn_exp2f(-c), ep = __builtin_amdgcn_exp2f(cp);
              const float kdv = bf2f(*(const LAS bf16_t*)(SL(8) + t * CS_RS + ek * 2)), av = bf2f(*(const LAS bf16_t*)(SL(9) + t * CS_RS + ek * 2));
              const float bv = bf2f(*(const LAS bf16_t*)(SL(10) + t * CS_RS + ek * 2)), rv = bf2f(*(const LAS bf16_t*)(SL(11) + t * CS_RS + ek * 2));
              const float at = av * ep, bt = bv * em, kt = kdv * em, rtv = rv * (DIR ? ep : e1), bh = bt * ec, kh = kt * ec;
              const unsigned w01 = pk2(at, bt), w23 = pk2(kt, rtv);
              *(LAS bf16_t*)(SL(0) + t * CS_RS + ek * 2) = (bf16_t)(w01 & 0xffffu); *(LAS bf16_t*)(SL(1) + t * CS_RS + ek * 2) = (bf16_t)(w01 >> 16);
              *(LAS bf16_t*)(SL(2) + t * CS_RS + ek * 2) = (bf16_t)(w23 & 0xffffu); *(LAS bf16_t*)(SL(3) + t * CS_RS + ek * 2) = (bf16_t)(w23 >> 16);
              const unsigned hbk = pk2(bh, kh); const unsigned ha = w01 & 0xffffu, hb = hbk & 0xffffu, hk = hbk >> 16;
              if (j & 1) { pa[j >> 1] |= ha << 16; pbh[j >> 1] |= hb << 16; pkh[j >> 1] |= hk << 16; } else { pa[j >> 1] = ha; pbh[j >> 1] = hb; pkh[j >> 1] = hk; } }
          *(LAS u32x4*)(SL(4) + ek * CS_RS + etq * 16) = (u32x4){pa[0], pa[1], pa[2], pa[3]};
          *(LAS u32x4*)(SL(5) + ek * CS_RS + etq * 16) = (u32x4){pbh[0], pbh[1], pbh[2], pbh[3]};
          *(LAS u32x4*)(SL(6) + ek * CS_RS + etq * 16) = (u32x4){pkh[0], pkh[1], pkh[2], pkh[3]}; }
        __syncthreads();
        { f32x4 acc[2];
          CS_ZERO(acc); cs_mm(acc, SL(1), SL(0), mi, ni0, fr, fq); cs_mask(acc, mi, ni0, fr, fq, 0);
          cs_st_t8(SL(8), acc, mi, ni0, fr, fq);
          if (mi == ni0 || mi == ni0 + 1) { const int jd = mi - ni0;
#pragma unroll
              for (int jj = 0; jj < 2; ++jj)
#pragma unroll
                  for (int r = 0; r < 4; ++r) if (jj == jd && (4 * fq + r) == fr) acc[jj][r] += 1.f; }
          cs_st_t8(SL(13), acc, mi, ni0, fr, fq);
          CS_ZERO(acc); cs_mm(acc, SL(0), SL(2), mi, ni0, fr, fq); cs_mask(acc, mi, ni0, fr, fq, 1); cs_st_t8(SL(9), acc, mi, ni0, fr, fq);
          CS_ZERO(acc); cs_mm(acc, SL(1), SL(3), mi, ni0, fr, fq); cs_mask(acc, mi, ni0, fr, fq, DIR ? 0 : 2); cs_st_t8(SL(10), acc, mi, ni0, fr, fq);
          CS_ZERO(acc); cs_mm(acc, SL(2), SL(3), mi, ni0, fr, fq); cs_mask(acc, mi, ni0, fr, fq, DIR ? 0 : 2); cs_st_t8(SL(11), acc, mi, ni0, fr, fq); }
        __syncthreads();
        { f32x4 aS[2], aU[2];
          CS_ZERO(aS); cs_mm_tr(aS, SL(8), SL(8), mi, ni0, fr, fq); cs_st_t8(SL(1), aS, mi, ni0, fr, fq);
          __syncthreads();
#pragma unroll
          for (int it = 0; it < 5; ++it) { const int xc = (it & 1) ? 8 : 1, xa = (it & 1) ? 1 : 8, tc = (it & 1) ? 12 : 13, ta = (it & 1) ? 13 : 12;
              cs_ld_t8(aU, SL(tc), mi, ni0, fr, fq); CS_ZERO(aS); cs_mm_tr2(aU, aS, SL(tc), SL(xc), SL(xc), it < 4, mi, ni0, fr, fq);
              cs_st_t8(SL(ta), aU, mi, ni0, fr, fq);
              if (it < 4) cs_st_t8(SL(xa), aS, mi, ni0, fr, fq);
              __syncthreads(); } }
        { f32x4 acc[2];
          CS_ZERO(acc); cs_mm(acc, SL(12), SL(4), mi, ni0, fr, fq); cs_st_t8(SL(0), acc, mi, ni0, fr, fq);
          CS_ZERO(acc); cs_mm(acc, SL(12), SL(9), mi, ni0, fr, fq); cs_st_t8(SL(1), acc, mi, ni0, fr, fq); }
        __syncthreads();
        { f32x4 acc[2];
          CS_ZERO(acc);
          if (mi == ni0 || mi == ni0 + 1) { const int jd = mi - ni0; const float dv = Dl[16 * mi + fr];
#pragma unroll
              for (int jj = 0; jj < 2; ++jj)
#pragma unroll
                  for (int r = 0; r < 4; ++r) if (jj == jd && (4 * fq + r) == fr) acc[jj][r] = dv; }
          cs_mm(acc, SL(0), SL(5), mi, ni0, fr, fq); cs_st_t8(SL(7), acc, mi, ni0, fr, fq);
          cs_ld_t8(acc, SL(3), mi, ni0, fr, fq); cs_mm(acc, SL(0), SL(10), mi, ni0, fr, fq); cs_st_t8(SL(8), acc, mi, ni0, fr, fq);
          cs_ld_t8(acc, SL(6), mi, ni0, fr, fq); cs_mm(acc, SL(1), SL(5), mi, ni0, fr, fq); cs_st_t8(SL(12), acc, mi, ni0, fr, fq);
          cs_ld_t8(acc, SL(11), mi, ni0, fr, fq); cs_mm(acc, SL(1), SL(10), mi, ni0, fr, fq); cs_st_t8(SL(13), acc, mi, ni0, fr, fq);
          const unsigned w4[4] = {rawv_cur.x, rawv_cur.y, rawv_cur.z, rawv_cur.w};
#pragma unroll
          for (int e = 0; e < 8; ++e) *(LAS bf16_t*)(SL(2) + (8 * rc_ + e) * CS_RS + rt_ * 2) = (bf16_t)((e & 1) ? (w4[e >> 1] >> 16) : (w4[e >> 1] & 0xffffu)); }
        __syncthreads();
        { const LAS unsigned char* PH = SL(7) + (16 * wave + fr) * CS_RS; const LAS unsigned char* PS = SL(12) + (16 * wave + fr) * CS_RS;
          const LAS unsigned char* Sr = (n & 1) ? SL(15) : SL(14); LAS unsigned char* Sw = (n & 1) ? SL(14) : SL(15);
          f32x4 acc[4] = {(f32x4){0.f, 0.f, 0.f, 0.f}, (f32x4){0.f, 0.f, 0.f, 0.f}, (f32x4){0.f, 0.f, 0.f, 0.f}, (f32x4){0.f, 0.f, 0.f, 0.f}};
#pragma unroll
          for (int s2 = 0; s2 < 2; ++s2) { const bf16x8 bph = *(const LAS bf16x8*)(PH + (32 * s2 + 8 * fq) * 2), bps = *(const LAS bf16x8*)(PS + (32 * s2 + 8 * fq) * 2);
#pragma unroll
              for (int m2 = 0; m2 < 4; ++m2) { const bf16x8 as = cs_afrag_tr<136>(Sr, m2, s2, fr, fq), av = *(const LAS bf16x8*)(SL(2) + (16 * m2 + fr) * CS_RS + (32 * s2 + 8 * fq) * 2);
                  acc[m2] = __builtin_amdgcn_mfma_f32_16x16x32_bf16(as, bph, acc[m2], 0, 0, 0); acc[m2] = __builtin_amdgcn_mfma_f32_16x16x32_bf16(av, bps, acc[m2], 0, 0, 0); } }
          if (wave < 4) {
#pragma unroll
              for (int m2 = 0; m2 < 4; ++m2) { u32x2 w; w.x = pk2(acc[m2][0], acc[m2][1]); w.y = pk2(acc[m2][2], acc[m2][3]);
                  *(LAS u32x2*)(Sw + (16 * wave + fr) * 136 + (16 * m2 + 4 * fq) * 2) = w; }
          } else { const int sq = 64 * n + 16 * (wave - 4) + fr; const size_t tok = (size_t)(b * SEQ + (DIR ? (SEQ - 1 - sq) : sq));
#pragma unroll
              for (int m2 = 0; m2 < 4; ++m2) { u32x2 w; w.x = pk2(acc[m2][0], acc[m2][1]); w.y = pk2(acc[m2][2], acc[m2][3]); *(u32x2*)(Y + tok * 512 + h * 64 + 16 * m2 + 4 * fq) = w; } } }
        __syncthreads();
    }
#undef CS_LOAD
#undef SL
}
__device__ __forceinline__ void phase_scan(const Frame& F) {
    for (int job = F.vcu; job < 256; job += F.G) {
        const int chain = job >> 1, half = job & 1, dir = chain & 1, bh = chain >> 1, b = bh >> 3, h = bh & 7;
        if (dir) scan_job<1>(F, b, h, half, job); else scan_job<0>(F, b, h, half, job);
    }
}

__device__ __forceinline__ void phase_attn_range(const Frame& F, int u_first, int u_stride) {
    const int tid = F.tid, lane = F.lane, wave = F.wave, r32 = lane & 31, hi = lane >> 5;
    LAS unsigned char* lds = F.lds;
    const bf16_t *QH = wsp<bf16_t>(F.ws, A_QH), *KH = wsp<bf16_t>(F.ws, A_KH), *VT = wsp<bf16_t>(F.ws, A_VT0); bf16_t* YC = wsp<bf16_t>(F.ws, A_YCAT);
    const int skey = tid >> 3, sc = tid & 7;
    for (int u = u_first; u < 512; u += u_stride) {
        const int b = u >> 6, g = (u >> 5) & 1, qt = u & 31;
        const int head = 4 * g + (wave >> 1); const int qrow = b * SEQ + qt * 64 + 32 * (wave & 1) + r32;
        bf16x8 qf[4];
#pragma unroll
        for (int s = 0; s < 4; ++s) qf[s] = *(const bf16x8*)(QH + (size_t)qrow * 512 + head * 64 + 16 * s + 8 * hi);
        const bf16_t* ksrc = KH + (size_t)(b * SEQ + skey) * 128 + g * 64 + 8 * sc;
        const bf16_t* vsrc = VT + ((size_t)(b * 2 + g) * 64 + skey) * SEQ + 8 * sc;
        const int kdst = skey * 128 + ((sc ^ (skey & 7)) * 16), vdst = 16384 + skey * 128 + ((sc ^ ((skey >> 1) & 7)) * 16);
        u32x4 kst = *(const u32x4*)ksrc, vst = *(const u32x4*)vsrc;
        __syncthreads();
        *(LAS u32x4*)(lds + kdst) = kst; *(LAS u32x4*)(lds + vdst) = vst;
        __syncthreads();
        f32x16 o0 = {}, o1 = {}; float mrun = -1e30f, lrun = 0.f;
        for (int t = 0; t < SEQ / 64; ++t) {
            if (t + 1 < SEQ / 64) { kst = *(const u32x4*)(ksrc + (size_t)(t + 1) * 64 * 128); vst = *(const u32x4*)(vsrc + (t + 1) * 64); }
            const int bo = (t & 1) * 8192;
            f32x16 c0 = {}, c1 = {};
#pragma unroll
            for (int s = 0; s < 4; ++s) { const int ch = 2 * s + hi;
                const bf16x8 k0 = *(const LAS bf16x8*)(lds + bo + r32 * 128 + ((ch ^ (r32 & 7)) * 16));
                const bf16x8 k1 = *(const LAS bf16x8*)(lds + bo + (32 + r32) * 128 + ((ch ^ (r32 & 7)) * 16));
                c0 = __builtin_amdgcn_mfma_f32_32x32x16_bf16(k0, qf[s], c0, 0, 0, 0);
                c1 = __builtin_amdgcn_mfma_f32_32x32x16_bf16(k1, qf[s], c1, 0, 0, 0); }
            float mx = c0[0];
#pragma unroll
            for (int r = 0; r < 16; ++r) { mx = fmaxf(mx, c0[r]); mx = fmaxf(mx, c1[r]); }
            mx = fmaxf(mx, __shfl_xor(mx, 32));
            const float mnew = fmaxf(mrun, mx); const float alpha = __builtin_amdgcn_exp2f(mrun - mnew); mrun = mnew;
            float ls = 0.f;
#pragma unroll
            for (int r = 0; r < 16; ++r) { c0[r] = __builtin_amdgcn_exp2f(c0[r] - mnew); c1[r] = __builtin_amdgcn_exp2f(c1[r] - mnew); ls += c0[r] + c1[r]; }
            lrun = lrun * alpha + ls;
#pragma unroll
            for (int r = 0; r < 16; ++r) { o0[r] *= alpha; o1[r] *= alpha; }
            bf16x8 pf[2][2];
#pragma unroll
            for (int s2 = 0; s2 < 2; ++s2) { u32x4 w0, w1;
                w0.x = pk2(c0[8 * s2 + 0], c0[8 * s2 + 1]); w0.y = pk2(c0[8 * s2 + 2], c0[8 * s2 + 3]); w0.z = pk2(c0[8 * s2 + 4], c0[8 * s2 + 5]); w0.w = pk2(c0[8 * s2 + 6], c0[8 * s2 + 7]);
                w1.x = pk2(c1[8 * s2 + 0], c1[8 * s2 + 1]); w1.y = pk2(c1[8 * s2 + 2], c1[8 * s2 + 3]); w1.z = pk2(c1[8 * s2 + 4], c1[8 * s2 + 5]); w1.w = pk2(c1[8 * s2 + 6], c1[8 * s2 + 7]);
                pf[0][s2] = __builtin_bit_cast(bf16x8, w0); pf[1][s2] = __builtin_bit_cast(bf16x8, w1); }
            const int vb = 16384 + bo;
#pragma unroll
            for (int dblk = 0; dblk < 2; ++dblk) { const int d = 32 * dblk + r32; const int sw = (d >> 1) & 7;
#pragma unroll
                for (int blk = 0; blk < 2; ++blk)
#pragma unroll
                    for (int s2 = 0; s2 < 2; ++s2) { const int ch = 4 * blk + 2 * s2;
                        const u32x2 lo = *(const LAS u32x2*)(lds + vb + d * 128 + ((ch ^ sw) * 16) + hi * 8);
                        const u32x2 hh = *(const LAS u32x2*)(lds + vb + d * 128 + (((ch + 1) ^ sw) * 16) + hi * 8);
                        const u32x4 vv = {lo.x, lo.y, hh.x, hh.y};
                        if (dblk == 0) o0 = __builtin_amdgcn_mfma_f32_32x32x16_bf16(__builtin_bit_cast(bf16x8, vv), pf[blk][s2], o0, 0, 0, 0);
                        else           o1 = __builtin_amdgcn_mfma_f32_32x32x16_bf16(__builtin_bit_cast(bf16x8, vv), pf[blk][s2], o1, 0, 0, 0); } }
            if (t + 1 < SEQ / 64) { const int nb = ((t + 1) & 1) * 8192; *(LAS u32x4*)(lds + nb + kdst) = kst; *(LAS u32x4*)(lds + nb + vdst) = vst; }
            __syncthreads();
        }
        const float ltot = lrun + __shfl_xor(lrun, 32); const float inv = 1.f / ltot;
        bf16_t* op = YC + (size_t)qrow * 1024 + 512 + head * 64 + 4 * hi;
#pragma unroll
        for (int q4 = 0; q4 < 4; ++q4) { u32x2 w0, w1;
            w0.x = pk2(o0[4 * q4 + 0] * inv, o0[4 * q4 + 1] * inv); w0.y = pk2(o0[4 * q4 + 2] * inv, o0[4 * q4 + 3] * inv);
            w1.x = pk2(o1[4 * q4 + 0] * inv, o1[4 * q4 + 1] * inv); w1.y = pk2(o1[4 * q4 + 2] * inv, o1[4 * q4 + 3] * inv);
            *(u32x2*)(op + 8 * q4) = w0; *(u32x2*)(op + 32 + 8 * q4) = w1; }
    }
}

__device__ __forceinline__ void phase_attn(const Frame& F) { phase_attn_range(F, F.vcu, F.G); }
__device__ __forceinline__ void phase_cscan_attn_split(const Frame& F) {
    const int half_g = F.G >> 1, me = F.vcu >> 1;
    if ((F.vcu & 1) == 0) {
        for (int chain = me; chain < 128; chain += half_g) { const int dir = chain & 1, bh = chain >> 1, b = bh >> 3, h = bh & 7;
            if (dir) cscan_job<1>(F, b, h); else cscan_job<0>(F, b, h); }
    } else {
        for (int u4 = me; u4 * 4 < 512; u4 += half_g) for (int q = 0; q < 4; ++q) phase_attn_range(F, u4 * 4 + q, 1 << 30);
        __syncthreads();
        conv_experts_down(F, me * NWAVES + F.wave, half_g * NWAVES);
    }
}
__device__ __forceinline__ void phase_rwkv_post(const Frame& F) {
    const int gw = F.vcu * NWAVES + F.wave, lane = F.lane;
    const bf16_t *YF = wsp<bf16_t>(F.ws, A_YF), *YB = wsp<bf16_t>(F.ws, A_YB);
    const bf16_t *RS = wsp<bf16_t>(F.ws, A_RS), *VS = wsp<bf16_t>(F.ws, A_VS), *KDF = wsp<bf16_t>(F.ws, A_KDF), *GG = wsp<bf16_t>(F.ws, A_GG);
    bf16_t* YC = wsp<bf16_t>(F.ws, A_YCAT);
    const int c0 = 8 * lane;
    float gw_[8], gb_[8], rk_[8];
#pragma unroll
    for (int i = 0; i < 8; ++i) { gw_[i] = F.in[16][c0 + i]; gb_[i] = F.in[17][c0 + i]; rk_[i] = F.in[15][c0 + i]; }
    for (int tok = gw; tok < M_TOK; tok += F.G * NWAVES) { const size_t o = (size_t)tok * 512 + c0;
        const u32x4 yfw = *(const u32x4*)(YF + o), ybw = *(const u32x4*)(YB + o);
        float y[8]; float sm = 0.f;
        y[0] = bflo(yfw.x) + bflo(ybw.x); y[1] = bfhi(yfw.x) + bfhi(ybw.x); y[2] = bflo(yfw.y) + bflo(ybw.y); y[3] = bfhi(yfw.y) + bfhi(ybw.y);
        y[4] = bflo(yfw.z) + bflo(ybw.z); y[5] = bfhi(yfw.z) + bfhi(ybw.z); y[6] = bflo(yfw.w) + bflo(ybw.w); y[7] = bfhi(yfw.w) + bfhi(ybw.w);
#pragma unroll
        for (int i = 0; i < 8; ++i) sm += y[i];
        sm += __shfl_xor(sm, 1); sm += __shfl_xor(sm, 2); sm += __shfl_xor(sm, 4);
        const float mean = sm * (1.f / 64.f); float sv = 0.f;
#pragma unroll
        for (int i = 0; i < 8; ++i) { y[i] -= mean; sv += y[i] * y[i]; }
        sv += __shfl_xor(sv, 1); sv += __shfl_xor(sv, 2); sv += __shfl_xor(sv, 4);
        const float rstd = 1.0f / sqrtf(sv * (1.f / 64.f) + 64e-5f);
        const u32x4 rw = *(const u32x4*)(RS + o), vw = *(const u32x4*)(VS + o), kw = *(const u32x4*)(KDF + o), gw4 = *(const u32x4*)(GG + o);
        const float r8[8] = {bflo(rw.x), bfhi(rw.x), bflo(rw.y), bfhi(rw.y), bflo(rw.z), bfhi(rw.z), bflo(rw.w), bfhi(rw.w)};
        const float v8[8] = {bflo(vw.x), bfhi(vw.x), bflo(vw.y), bfhi(vw.y), bflo(vw.z), bfhi(vw.z), bflo(vw.w), bfhi(vw.w)};
        const float k8[8] = {bflo(kw.x), bfhi(kw.x), bflo(kw.y), bfhi(kw.y), bflo(kw.z), bfhi(kw.z), bflo(kw.w), bfhi(kw.w)};
        const float g8[8] = {bflo(gw4.x), bfhi(gw4.x), bflo(gw4.y), bfhi(gw4.y), bflo(gw4.z), bfhi(gw4.z), bflo(gw4.w), bfhi(gw4.w)};
        float bs = 0.f;
#pragma unroll
        for (int i = 0; i < 8; ++i) bs += r8[i] * k8[i] * rk_[i];
        bs += __shfl_xor(bs, 1); bs += __shfl_xor(bs, 2); bs += __shfl_xor(bs, 4);
        float ov[8];
#pragma unroll
        for (int i = 0; i < 8; ++i) ov[i] = ((y[i] * rstd) * gw_[i] + gb_[i] + bs * v8[i]) * g8[i];
        u32x4 w; w.x = pk2(ov[0], ov[1]); w.y = pk2(ov[2], ov[3]); w.z = pk2(ov[4], ov[5]); w.w = pk2(ov[6], ov[7]);
        *(u32x4*)(YC + (size_t)tok * 1024 + c0) = w; }
}

__device__ __forceinline__ void phase_gd(const Frame& F) {
    const int tid = F.tid, lane = F.lane, wave = F.wave, fr = lane & 15, fq = lane >> 4;
    LAS f32x4* PL = (LAS f32x4*)F.lds;
    const bf16_t* XB = wsp<bf16_t>(F.ws, WS_XB); const bf16_t* WG = wsp<bf16_t>(F.ws, WS_WIN1) + (size_t)3072 * 1024; const float* ssq = wsp<float>(F.ws, WS_SSQ2); bf16_t* P1 = wsp<bf16_t>(F.ws, A_P1);
    const int tpb = M_TOK / F.G;
    for (int t0 = F.vcu * tpb; t0 < (F.vcu + 1) * tpb; t0 += 64) {
        f32x4 acc[4];
#pragma unroll
        for (int t = 0; t < 4; ++t) acc[t] = (f32x4){0.f, 0.f, 0.f, 0.f};
#pragma unroll
        for (int s4 = 0; s4 < 4; ++s4) { const int k0 = 32 * (4 * wave + s4) + 8 * fq;
            const bf16x8 bfr = *(const bf16x8*)(WG + (size_t)fr * 1024 + k0);
#pragma unroll
            for (int t = 0; t < 4; ++t) { const bf16x8 afr = *(const bf16x8*)(XB + (size_t)(t0 + 16 * t + fr) * 1024 + k0);
                acc[t] = __builtin_amdgcn_mfma_f32_16x16x32_bf16(afr, bfr, acc[t], 0, 0, 0); } }
        __syncthreads();
#pragma unroll
        for (int t = 0; t < 4; ++t) PL[(wave * 4 + t) * 64 + lane] = acc[t];
        __syncthreads();
        if (tid < 256) { const int t = tid >> 6, l = tid & 63; f32x4 sum = PL[t * 64 + l];
#pragma unroll
            for (int w = 1; w < 8; ++w) sum += PL[(w * 4 + t) * 64 + l];
            const int lfr = l & 15, lfq = l >> 4;
#pragma unroll
            for (int r = 0; r < 4; ++r) { const int tok = t0 + 16 * t + 4 * lfq + r; P1[(size_t)tok * O_INP + 3072 + lfr] = f2bf(sum[r] * rstd_from_ssq(ssq, tok)); } }
    }
}

constexpr float GLA_QSCALE = 0.08838834764831845f;
__device__ __forceinline__ size_t gla_dir(size_t base, int dir) { return base + (size_t)dir * GLA_DIR_STRIDE; }
__device__ __forceinline__ float logsig16(float z) { return (fminf(z, 0.f) - __logf(1.f + __expf(-fabsf(z)))) * (1.f / 16.f); }
__device__ __forceinline__ void phase_gla_prep(const Frame& F) {
    const int tid = F.tid, lane = F.lane, wave = F.wave, fr = lane & 15, fq = lane >> 4;
    LAS float* GD = (LAS float*)F.lds;
    LAS float* PT = (LAS float*)(F.lds + 4096);
    LAS unsigned char* QTt = F.lds + 10240;
    LAS unsigned char* KTt = F.lds + 10240 + 17408;
    LAS unsigned char* RV = F.lds + 10240;
    LAS unsigned char* RQ = F.lds + 45056; LAS unsigned char* RK = F.lds + 45056 + 16384;
    LAS unsigned char* ATT = F.lds + 45056;
    LAS unsigned char* QHl = F.lds + 45056 + 9216;
    LAS unsigned char* VTt = F.lds + 77824;
    const bf16_t* P1 = wsp<bf16_t>(F.ws, A_P1);
    bf16_t* VT = wsp<bf16_t>(F.ws, A_VT1); float* DECS = wsp<float>(F.ws, WS_DECS); bf16_t* OF = wsp<bf16_t>(F.ws, A_OF);
    const int d = tid & 127, qr = tid >> 7;
    for (int unit = F.vcu; unit < BATCH * GLA_H * 32; unit += F.G) {
        const int n = unit & 31, h = (unit >> 5) & 3, b = unit >> 7; const int T0 = b * SEQ + 64 * n; const size_t tile = (size_t)(b * 4 + h) * 32 + n;
        __syncthreads();
        for (int i = tid; i < 1024; i += 512) GD[i] = bf2f(P1[(size_t)(T0 + (i >> 4)) * O_INP + 3072 + (i & 15)]);
#pragma unroll
        for (int i = 0; i < 2; ++i) { const int p = tid + 512 * i, row = p >> 4, c = p & 15; const bf16_t* src = P1 + (size_t)(T0 + row) * O_INP + h * 128 + 8 * c;
            *(LAS u32x4*)(RQ + row * 256 + c * 16) = *(const u32x4*)src; *(LAS u32x4*)(RK + row * 256 + c * 16) = *(const u32x4*)(src + 512); }
#pragma unroll
        for (int i = 0; i < 4; ++i) { const int p = tid + 512 * i, row = p >> 5, c = p & 31;
            *(LAS u32x4*)(RV + row * 512 + c * 16) = *(const u32x4*)(P1 + (size_t)(T0 + row) * O_INP + 1024 + h * 256 + 8 * c); }
        float upf[16], upb[16];
#pragma unroll
        for (int r = 0; r < 16; ++r) { upf[r] = F.in[27][r * 512 + h * 128 + d]; upb[r] = F.in[29][r * 512 + h * 128 + d]; }
        const float bif = F.in[28][h * 128 + d], bib = F.in[30][h * 128 + d];
        __syncthreads();
        bf16_t qraw[16], kraw[16];
#pragma unroll
        for (int j = 0; j < 16; ++j) { qraw[j] = *(const LAS bf16_t*)(RQ + (16 * qr + j) * 256 + d * 2); kraw[j] = *(const LAS bf16_t*)(RK + (16 * qr + j) * 256 + d * 2); }
        { const int dv = tid & 255, th = tid >> 8; unsigned pk[16];
#pragma unroll
          for (int j = 0; j < 16; ++j) pk[j] = (unsigned)*(const LAS bf16_t*)(RV + (32 * th + 2 * j) * 512 + dv * 2) | ((unsigned)*(const LAS bf16_t*)(RV + (32 * th + 2 * j + 1) * 512 + dv * 2) << 16);
          bf16_t* gdst = VT + tile * 16384 + dv * 64 + 32 * th;
#pragma unroll
          for (int q = 0; q < 4; ++q) { const u32x4 w = {pk[4 * q], pk[4 * q + 1], pk[4 * q + 2], pk[4 * q + 3]}; *(u32x4*)(gdst + 8 * q) = w; *(LAS u32x4*)(VTt + dv * 144 + (32 * th + 8 * q) * 2) = w; } }
        float Bf[16], Bb[16];
#pragma unroll
        for (int j = 0; j < 16; ++j) { const LAS f32x4* gp = (const LAS f32x4*)(GD + (16 * qr + j) * 16); float zf = bif, zb = bib;
#pragma unroll
            for (int q = 0; q < 4; ++q) { const f32x4 g4 = gp[q];
#pragma unroll
                for (int e = 0; e < 4; ++e) { zf += g4[e] * upf[4 * q + e]; zb += g4[e] * upb[4 * q + e]; } }
            Bf[j] = logsig16(zf); Bb[j] = logsig16(zb); }
#pragma unroll
        for (int j = 1; j < 16; ++j) Bf[j] += Bf[j - 1];
#pragma unroll
        for (int j = 14; j >= 0; --j) Bb[j] += Bb[j + 1];
        PT[(0 * 4 + qr) * 128 + d] = Bf[15]; PT[(1 * 4 + qr) * 128 + d] = Bb[0];
        if (qr == 2) PT[1024 + d] = Bf[0];
        if (qr == 1) PT[1024 + 128 + d] = Bb[15];
        __syncthreads();
        float offf = 0.f, offb = 0.f, totf = 0.f, totb = 0.f, pre2f = 0.f, suf2b = 0.f;
#pragma unroll
        for (int q = 0; q < 4; ++q) { const float pf = PT[q * 128 + d], pb = PT[(4 + q) * 128 + d]; totf += pf; totb += pb; if (q < qr) offf += pf; if (q > qr) offb += pb; if (q < 2) pre2f += pf; if (q >= 2) suf2b += pb; }
        const float bmf = pre2f + PT[1024 + d], bmb = suf2b + PT[1024 + 128 + d];
#pragma unroll
        for (int j = 0; j < 16; ++j) { Bf[j] += offf; Bb[j] += offb; }
        f32x4 oacc[2][4];
#pragma unroll
        for (int x = 0; x < 2; ++x)
#pragma unroll
            for (int y = 0; y < 4; ++y) oacc[x][y] = (f32x4){0.f, 0.f, 0.f, 0.f};
#pragma unroll
        for (int dir = 0; dir < 2; ++dir) {
            const float bm = dir ? bmb : bmf, bl = dir ? totb : totf; const float ebm = __expf(bm), ebl = __expf(bl - bm);
            bf16_t* QHT = wsp<bf16_t>(F.ws, gla_dir(A_QHAT, dir)) + tile * 8192; bf16_t* K2T = wsp<bf16_t>(F.ws, gla_dir(A_K2T, dir)) + tile * 8192;
            unsigned k2pk[8];
#pragma unroll
            for (int j = 0; j < 16; ++j) { const float bv = dir ? Bb[j] : Bf[j]; const float e1 = __expf(bv - bm), r1 = __builtin_amdgcn_rcpf(e1);
                const float qs = bf2f(qraw[j]) * GLA_QSCALE, kk = bf2f(kraw[j]); const int tk = 16 * qr + j;
                const float qt = qs * e1, kt = kk * r1, qh = qt * ebm, k2 = kt * ebl;
                *(LAS bf16_t*)(QTt + tk * 272 + d * 2) = f2bf(qt); *(LAS bf16_t*)(KTt + tk * 272 + d * 2) = f2bf(kt); *(LAS bf16_t*)(QHl + tk * 272 + d * 2) = f2bf(qh);
                if (j & 1) k2pk[j >> 1] |= ((unsigned)f2bf(k2)) << 16; else k2pk[j >> 1] = (unsigned)f2bf(k2); }
            { bf16_t* kd = K2T + d * 64 + 16 * qr;
              *(u32x4*)kd = (u32x4){k2pk[0], k2pk[1], k2pk[2], k2pk[3]}; *(u32x4*)(kd + 8) = (u32x4){k2pk[4], k2pk[5], k2pk[6], k2pk[7]}; }
            if (qr == 0) DECS[((size_t)((b * 4 + h) * 2 + dir) * 32 + n) * 128 + d] = __expf(bl);
            __syncthreads();
#pragma unroll
            for (int i = 0; i < 2; ++i) { const int p = tid + 512 * i, row = p >> 4, c = p & 15; *(u32x4*)(QHT + row * 128 + c * 8) = *(const LAS u32x4*)(QHl + row * 272 + c * 16); }
            { const int ib = wave >> 1, jb0 = 2 * (wave & 1); f32x4 at[2] = {(f32x4){0.f, 0.f, 0.f, 0.f}, (f32x4){0.f, 0.f, 0.f, 0.f}};
#pragma unroll
              for (int s2 = 0; s2 < 4; ++s2) { const bf16x8 a = *(const LAS bf16x8*)(QTt + (16 * ib + fr) * 272 + (32 * s2 + 8 * fq) * 2);
#pragma unroll
                  for (int jj = 0; jj < 2; ++jj) { const bf16x8 bb = *(const LAS bf16x8*)(KTt + (16 * (jb0 + jj) + fr) * 272 + (32 * s2 + 8 * fq) * 2);
                      at[jj] = __builtin_amdgcn_mfma_f32_16x16x32_bf16(a, bb, at[jj], 0, 0, 0); } }
#pragma unroll
              for (int jj = 0; jj < 2; ++jj)
#pragma unroll
                  for (int r = 0; r < 4; ++r) { const int i = 16 * ib + 4 * fq + r, j = 16 * (jb0 + jj) + fr; const bool keep = dir ? (j > i) : (j <= i);
                      *(LAS bf16_t*)(ATT + i * 144 + j * 2) = f2bf(keep ? at[jj][r] : 0.f); } }
            __syncthreads();
#pragma unroll
            for (int s2 = 0; s2 < 2; ++s2) { bf16x8 bfr[4];
#pragma unroll
                for (int ib = 0; ib < 4; ++ib) bfr[ib] = *(const LAS bf16x8*)(ATT + (16 * ib + fr) * 144 + (32 * s2 + 8 * fq) * 2);
#pragma unroll
                for (int x = 0; x < 2; ++x) { const bf16x8 a = *(const LAS bf16x8*)(VTt + (16 * (2 * wave + x) + fr) * 144 + (32 * s2 + 8 * fq) * 2);
#pragma unroll
                    for (int ib = 0; ib < 4; ++ib) oacc[x][ib] = __builtin_amdgcn_mfma_f32_16x16x32_bf16(a, bfr[ib], oacc[x][ib], 0, 0, 0); } }
        }
#pragma unroll
        for (int x = 0; x < 2; ++x)
#pragma unroll
            for (int ib = 0; ib < 4; ++ib) { u32x2 w; w.x = pk2(oacc[x][ib][0], oacc[x][ib][1]); w.y = pk2(oacc[x][ib][2], oacc[x][ib][3]);
                *(u32x2*)(OF + (size_t)(T0 + 16 * ib + fr) * 1024 + h * 256 + 16 * (2 * wave + x) + 4 * fq) = w; }
    }
}

template <int DIR> __device__ __forceinline__ void gla_seq_job(const Frame& F, int b, int h, int vs) {
    const int tid = F.tid, lane = F.lane, wave = F.wave, fr = lane & 15, fq = lane >> 4;
    LAS unsigned char* ST0 = F.lds; LAS unsigned char* ST1 = F.lds + 17408;
    LAS unsigned char* BUF = F.lds + 34816;
    constexpr int BQ = 0, BK2 = 17408, BVT = 17408 + 18432, BSZ = 45056;
    const bf16_t* QHT = wsp<bf16_t>(F.ws, gla_dir(A_QHAT, DIR)); const bf16_t* K2T = wsp<bf16_t>(F.ws, gla_dir(A_K2T, DIR));
    const bf16_t* VT = wsp<bf16_t>(F.ws, A_VT1); const float* DECS = wsp<float>(F.ws, WS_DECS); bf16_t* OF = wsp<bf16_t>(F.ws, A_OF); bf16_t* O = DIR ? wsp<bf16_t>(F.ws, A_OB) : OF;
    const int dvb = wave >> 1, ib0 = 2 * (wave & 1);
    const size_t tile0 = (size_t)(b * 4 + h) * 32;
    const int q0 = tid, q1 = tid + 512;
    const int dq0 = BQ + (q0 >> 4) * 272 + (q0 & 15) * 16, dq1 = BQ + (q1 >> 4) * 272 + (q1 & 15) * 16;
    const int dk0 = BK2 + (q0 >> 3) * 144 + (q0 & 7) * 16, dk1 = BK2 + (q1 >> 3) * 144 + (q1 & 7) * 16;
    const int dv0 = BVT + (q0 >> 3) * 144 + (q0 & 7) * 16;
    u32x4 sg[5]; f32x4 dec, decn; u32x2 oold[2], ooldn[2];
#define GL_LD(n_) do { const size_t t_ = tile0 + (n_); \
        sg[0] = *(const u32x4*)(QHT + t_ * 8192 + q0 * 8); sg[1] = *(const u32x4*)(QHT + t_ * 8192 + q1 * 8); \
        sg[2] = *(const u32x4*)(K2T + t_ * 8192 + q0 * 8); sg[3] = *(const u32x4*)(K2T + t_ * 8192 + q1 * 8); \
        sg[4] = *(const u32x4*)(VT + t_ * 16384 + vs * 4096 + q0 * 8); \
        decn = *(const f32x4*)(DECS + ((size_t)((b * 4 + h) * 2 + DIR) * 32 + (n_)) * 128 + 16 * wave + 4 * fq); \
        if (!DIR) { _Pragma("unroll") for (int ii = 0; ii < 2; ++ii) ooldn[ii] = *(const u32x2*)(OF + (size_t)(b * SEQ + 64 * (n_) + 16 * (ib0 + ii) + fr) * 1024 + h * 256 + 64 * vs + 16 * dvb + 4 * fq); } } while (0)
#define GL_ST(bp) do { *(LAS u32x4*)((bp) + dq0) = sg[0]; *(LAS u32x4*)((bp) + dq1) = sg[1]; *(LAS u32x4*)((bp) + dk0) = sg[2]; *(LAS u32x4*)((bp) + dk1) = sg[3]; *(LAS u32x4*)((bp) + dv0) = sg[4]; } while (0)
    __syncthreads();
    for (int i = tid; i < 17408 / 4; i += 512) ((LAS unsigned*)ST0)[i] = 0u;
    f32x4 st[4];
#pragma unroll
    for (int k = 0; k < 4; ++k) st[k] = (f32x4){0.f, 0.f, 0.f, 0.f};
    GL_LD(DIR ? 31 : 0); GL_ST(BUF); dec = decn; oold[0] = ooldn[0]; oold[1] = ooldn[1];
    __syncthreads();
    for (int cc = 0; cc < 32; ++cc) { const int n = DIR ? 31 - cc : cc, nn = DIR ? 30 - cc : cc + 1; const int T0 = b * SEQ + 64 * n;
        LAS unsigned char* STr = (cc & 1) ? ST1 : ST0; LAS unsigned char* STw = (cc & 1) ? ST0 : ST1;
        LAS unsigned char* bc = BUF + (cc & 1) * BSZ; LAS unsigned char* bn = BUF + ((cc + 1) & 1) * BSZ;
        if (cc + 1 < 32) GL_LD(nn);
#pragma unroll
        for (int x = 0; x < 4; ++x) st[x] = st[x] * dec;
        f32x4 oo[2] = {(f32x4){0.f, 0.f, 0.f, 0.f}, (f32x4){0.f, 0.f, 0.f, 0.f}};
#pragma unroll
        for (int s2 = 0; s2 < 4; ++s2) { const bf16x8 a = *(const LAS bf16x8*)(STr + (16 * dvb + fr) * 272 + (32 * s2 + 8 * fq) * 2);
#pragma unroll
            for (int ii = 0; ii < 2; ++ii) { const bf16x8 qf = *(const LAS bf16x8*)(bc + BQ + (16 * (ib0 + ii) + fr) * 272 + (32 * s2 + 8 * fq) * 2);
                oo[ii] = __builtin_amdgcn_mfma_f32_16x16x32_bf16(a, qf, oo[ii], 0, 0, 0); } }
#pragma unroll
        for (int s2 = 0; s2 < 2; ++s2) { const bf16x8 kf = *(const LAS bf16x8*)(bc + BK2 + (16 * wave + fr) * 144 + (32 * s2 + 8 * fq) * 2);
#pragma unroll
            for (int x = 0; x < 4; ++x) { const bf16x8 vf = *(const LAS bf16x8*)(bc + BVT + (16 * x + fr) * 144 + (32 * s2 + 8 * fq) * 2);
                st[x] = __builtin_amdgcn_mfma_f32_16x16x32_bf16(kf, vf, st[x], 0, 0, 0); } }
#pragma unroll
        for (int x = 0; x < 4; ++x) { u32x2 w; w.x = pk2(st[x][0], st[x][1]); w.y = pk2(st[x][2], st[x][3]); *(LAS u32x2*)(STw + (16 * x + fr) * 272 + (16 * wave + 4 * fq) * 2) = w; }
#pragma unroll
        for (int ii = 0; ii < 2; ++ii) { f32x4 v = oo[ii];
            if (!DIR) { v[0] += bflo(oold[ii].x); v[1] += bfhi(oold[ii].x); v[2] += bflo(oold[ii].y); v[3] += bfhi(oold[ii].y); }
            u32x2 w; w.x = pk2(v[0], v[1]); w.y = pk2(v[2], v[3]);
            *(u32x2*)(O + (size_t)(T0 + 16 * (ib0 + ii) + fr) * 1024 + h * 256 + 64 * vs + 16 * dvb + 4 * fq) = w; }
        if (cc + 1 < 32) { GL_ST(bn); dec = decn; oold[0] = ooldn[0]; oold[1] = ooldn[1]; }
        __syncthreads(); }
#undef GL_LD
#undef GL_ST
}
__device__ __forceinline__ void phase_gla_main(const Frame& F) {
    for (int job = F.vcu; job < 256; job += F.G) { const int vs = job & 3, dir = (job >> 2) & 1, h = (job >> 3) & 3, b = job >> 5;
        if (dir) gla_seq_job<1>(F, b, h, vs); else gla_seq_job<0>(F, b, h, vs); }
}

__device__ __forceinline__ void phase_gla_post(const Frame& F) {
    const int gw = F.vcu * NWAVES + F.wave, lane = F.lane; const int c0 = 16 * lane;
    const bf16_t *OF = wsp<bf16_t>(F.ws, A_OF), *OB = wsp<bf16_t>(F.ws, A_OB), *P1 = wsp<bf16_t>(F.ws, A_P1); bf16_t* GO = wsp<bf16_t>(F.ws, A_GOUT);
    float gn[16];
#pragma unroll
    for (int i = 0; i < 16; ++i) gn[i] = F.in[31][(c0 + i) & 255];
    for (int tok = gw; tok < M_TOK; tok += F.G * NWAVES) { const size_t o = (size_t)tok * 1024 + c0;
        float v[16]; float ss = 0.f;
#pragma unroll
        for (int hh = 0; hh < 2; ++hh) { const u32x4 a = *(const u32x4*)(OF + o + 8 * hh), bq = *(const u32x4*)(OB + o + 8 * hh);
            v[8 * hh + 0] = bflo(a.x) + bflo(bq.x); v[8 * hh + 1] = bfhi(a.x) + bfhi(bq.x); v[8 * hh + 2] = bflo(a.y) + bflo(bq.y); v[8 * hh + 3] = bfhi(a.y) + bfhi(bq.y);
            v[8 * hh + 4] = bflo(a.z) + bflo(bq.z); v[8 * hh + 5] = bfhi(a.z) + bfhi(bq.z); v[8 * hh + 6] = bflo(a.w) + bflo(bq.w); v[8 * hh + 7] = bfhi(a.w) + bfhi(bq.w); }
#pragma unroll
        for (int i = 0; i < 16; ++i) ss += v[i] * v[i];
        ss = dpp_row_sum(ss);
        const float rs = 1.0f / sqrtf(ss * (1.f / 256.f) + NORM_EPS);
        float og[16];
#pragma unroll
        for (int hh = 0; hh < 2; ++hh) { const u32x4 g = *(const u32x4*)(P1 + (size_t)tok * O_INP + 2048 + c0 + 8 * hh);
            og[8 * hh + 0] = bflo(g.x); og[8 * hh + 1] = bfhi(g.x); og[8 * hh + 2] = bflo(g.y); og[8 * hh + 3] = bfhi(g.y); og[8 * hh + 4] = bflo(g.z); og[8 * hh + 5] = bfhi(g.z); og[8 * hh + 6] = bflo(g.w); og[8 * hh + 7] = bfhi(g.w); }
        float r[16];
#pragma unroll
        for (int i = 0; i < 16; ++i) r[i] = v[i] * rs * gn[i] * siluf_(og[i]);
#pragma unroll
        for (int hh = 0; hh < 2; ++hh) { u32x4 w; w.x = pk2(r[8 * hh + 0], r[8 * hh + 1]); w.y = pk2(r[8 * hh + 2], r[8 * hh + 3]); w.z = pk2(r[8 * hh + 4], r[8 * hh + 5]); w.w = pk2(r[8 * hh + 6], r[8 * hh + 7]);
            *(u32x4*)(GO + o + 8 * hh) = w; } }
}

__device__ __forceinline__ void phase_route(const Frame& F) {
    const int tid = F.tid, lane = F.lane, wave = F.wave;
    LAS int* lcnt = (LAS int*)(F.lds + MOE_OFF);
    LAS float* RL = (LAS float*)F.lds;
    __syncthreads();
    if (tid < 16) lcnt[tid] = 0;
    const float* X = F.out; const float* g2 = F.in[33]; const float* RT = F.in[34];
    for (int i = tid; i < 2048; i += 512) { const int k = i >> 1; const f32x4 r = *(const f32x4*)(RT + (size_t)i * 4); *(LAS f32x4*)(RL + i * 4) = r * g2[k]; }
    __syncthreads();
    int* TE = wsp<int>(F.ws, WS_TOKE); float* TG = wsp<float>(F.ws, WS_TOKG); float* R3 = wsp<float>(F.ws, WS_RSTD3);
    const int tpb = M_TOK / F.G, tpw = tpb / NWAVES;
    for (int i0 = 0; i0 < tpw; i0 += 4) { const int tok0 = F.vcu * tpb + wave * tpw + i0;
        float acc[4][8], ss[4];
#pragma unroll
        for (int t = 0; t < 4; ++t) { ss[t] = 0.f;
#pragma unroll
            for (int e = 0; e < 8; ++e) acc[t][e] = 0.f; }
#pragma unroll
        for (int j = 0; j < 4; ++j) { const int k0 = 4 * lane + 256 * j; f32x4 xv[4];
#pragma unroll
            for (int t = 0; t < 4; ++t) xv[t] = *(const f32x4*)(X + (size_t)(tok0 + t) * 1024 + k0);
#pragma unroll
            for (int q = 0; q < 4; ++q) { const f32x4 r0 = *(const LAS f32x4*)(RL + (k0 + q) * 8), r1 = *(const LAS f32x4*)(RL + (k0 + q) * 8 + 4);
#pragma unroll
                for (int t = 0; t < 4; ++t) { const float xx = xv[t][q]; ss[t] += xx * xx;
                    acc[t][0] += xx * r0[0]; acc[t][1] += xx * r0[1]; acc[t][2] += xx * r0[2]; acc[t][3] += xx * r0[3]; acc[t][4] += xx * r1[0]; acc[t][5] += xx * r1[1]; acc[t][6] += xx * r1[2]; acc[t][7] += xx * r1[3]; } } }
#pragma unroll
        for (int t = 0; t < 4; ++t) { ss[t] = wave_sum(ss[t]);
#pragma unroll
            for (int e = 0; e < 8; ++e) acc[t][e] = wave_sum(acc[t][e]); }
        float lg[8]; float mss = 0.f;
#pragma unroll
        for (int t = 0; t < 4; ++t) { if (lane == t) { mss = ss[t];
#pragma unroll
                for (int e = 0; e < 8; ++e) lg[e] = acc[t][e]; } }
        if (lane < 4) { const int tok = tok0 + lane;
            const float rstd = 1.0f / sqrtf(mss * (1.f / 1024.f) + NORM_EPS);
            int i1 = 0; float l1 = lg[0] * rstd;
#pragma unroll
            for (int e = 1; e < 8; ++e) { const float l = lg[e] * rstd; if (l > l1) { l1 = l; i1 = e; } }
            int i2 = -1; float l2 = -3.0e38f;
#pragma unroll
            for (int e = 0; e < 8; ++e) { const float l = lg[e] * rstd; if (e != i1 && l > l2) { l2 = l; i2 = e; } }
            const float e2 = __expf(l2 - l1); const float ga = 1.f / (1.f + e2), gb = e2 / (1.f + e2);
            TE[tok * 2] = i1; TE[tok * 2 + 1] = i2; TG[tok * 2] = ga; TG[tok * 2 + 1] = gb; R3[tok] = rstd;
            atomicAdd((int*)&lcnt[i1], 1); atomicAdd((int*)&lcnt[8 + i2], 1); } }
    __syncthreads();
    if (tid < 16) wsp<int>(F.ws, WS_CNT)[F.vcu * 16 + tid] = lcnt[tid];
}
__device__ __forceinline__ void phase_place(const Frame& F) {
    const int tid = F.tid;
    LAS int* tab = (LAS int*)(F.lds + MOE_OFF);
    LAS int* C = (LAS int*)F.lds;
    LAS int* TEl = (LAS int*)(F.lds + 32768); LAS float* TGl = (LAS float*)(F.lds + 32768 + 1024);
    const int* CNT = wsp<int>(F.ws, WS_CNT); const int tpb = M_TOK / F.G;
    __syncthreads();
    for (int i = tid; i < F.G * 16; i += 512) C[i] = CNT[i];
    if (tid < 2 * tpb) { TEl[tid] = wsp<int>(F.ws, WS_TOKE)[F.vcu * tpb * 2 + tid]; TGl[tid] = wsp<float>(F.ws, WS_TOKG)[F.vcu * tpb * 2 + tid]; }
    __syncthreads();
    if (tid < 16) { int off = 0, tot = 0; for (int bb = 0; bb < F.G; ++bb) { const int c = C[bb * 16 + tid]; if (bb < F.vcu) off += c; tot += c; } tab[tid] = off; tab[16 + tid] = tot;
        if (F.vcu == 0) wsp<int>(F.ws, WS_TOT)[tid] = tot; }
    __syncthreads();
    if (tid < 16) { const int s = tid >> 3, e = tid & 7; int run = tab[tid]; for (int q = 0; q < e; ++q) run += tab[16 + q] + tab[24 + q];
        if (s) run += tab[16 + e];
        int* RTK = wsp<int>(F.ws, WS_ROWTOK); float* RGT = wsp<float>(F.ws, WS_ROWGATE);
        for (int i = 0; i < tpb; ++i) { if (TEl[i * 2 + s] == e) { RTK[run] = F.vcu * tpb + i; RGT[run] = TGl[i * 2 + s]; ++run; } } }
}
struct MoESched {
    pg8::GridOrder go; const LAS int* tab;
    const char* A; const char* Bt; size_t a_rowbytes, b_expert_bytes, b_tile_bytes; bool gather; int nt_;
    __device__ bool next(int i, pg8::Unit& u) const {
        int pm, pn; if (!go.tile(i, pm, pn)) return false;
        int e = 0;
#pragma unroll
        for (int q = 1; q < 8; ++q) if (pm >= tab[16 + q]) e = q;
        e = __builtin_amdgcn_readfirstlane(e);
        const int mt = pm - __builtin_amdgcn_readfirstlane(tab[16 + e]); const int row0 = __builtin_amdgcn_readfirstlane(tab[e]) + 256 * mt; int nr = __builtin_amdgcn_readfirstlane(tab[8 + e]) - 256 * mt; nr = nr > 256 ? 256 : nr;
        u.pm = pm; u.pn = pn; u.e = e; u.row0 = row0; u.nrows = nr; u.nt = nt_; u.flags = 0;
        u.a = gather ? A : A + (size_t)row0 * a_rowbytes; u.b = Bt + (size_t)e * b_expert_bytes + (size_t)pn * b_tile_bytes; return true;
    }
};
struct MoEDownSched {
    const LAS int* tab; const char* A; const char* Bt; int nmt, c, round;
    __device__ void fill(pg8::Unit& u, int pm, int pn, int kp, int nt, int flags) const {
        int e = 0;
#pragma unroll
        for (int q = 1; q < 8; ++q) if (pm >= tab[16 + q]) e = q;
        e = __builtin_amdgcn_readfirstlane(e);
        const int mt = pm - __builtin_amdgcn_readfirstlane(tab[16 + e]); const int row0 = __builtin_amdgcn_readfirstlane(tab[e]) + 256 * mt; int nr = __builtin_amdgcn_readfirstlane(tab[8 + e]) - 256 * mt; nr = nr > 256 ? 256 : nr;
        u.pm = pm; u.pn = pn; u.e = e; u.row0 = row0; u.nrows = nr; u.nt = nt; u.flags = flags;
        u.a = A + (size_t)row0 * (D_FFE * 2) + (size_t)kp * 896 * 2; u.b = Bt + (size_t)e * ((size_t)1024 * D_FFE * 2) + (size_t)pn * ((size_t)256 * D_FFE * 2) + (size_t)kp * 896 * 2;
    }
    __device__ bool next(int i, pg8::Unit& u) const {
        if (i != 0) return false;
        if (round == 0) { const int pm = 8 * (c & 7) + ((c >> 3) & 7), pn = c >> 6; if (pm >= nmt) return false; fill(u, pm, pn, 0, D_FFE / 64, 0); return true; }
        { const int t = c >> 2, kp = c & 3; const int pm = 64 + (t >> 2), pn = t & 3; if (pm >= nmt) return false; fill(u, pm, pn, kp, 14, 1 + c); return true; }
        return false;
    }
};
__device__ __forceinline__ int moe_table(const Frame& F, int mode) {
    LAS int* tab = (LAS int*)(F.lds + MOE_OFF);
    __syncthreads();
    if (F.tid == 0) { const int* TOT = wsp<int>(F.ws, WS_TOT); int rs = 0, ts = 0;
        for (int e = 0; e < 8; ++e) { const int c0 = TOT[e], c1 = TOT[8 + e]; const int st = rs + (mode == 1 ? c0 : 0), c = mode == 0 ? c0 : (mode == 1 ? c1 : c0 + c1);
            tab[e] = st; tab[8 + e] = c; tab[16 + e] = ts; rs += c0 + c1; ts += (c + 255) >> 8; }
        tab[24] = ts; }
    __syncthreads();
    return __builtin_amdgcn_readfirstlane(tab[24]);
}

constexpr size_t A_PART = A_WEGU;
__device__ __forceinline__ void moe_tail_reduce(const Frame& F, int s) {
    const int nmt = moe_table(F, s); const LAS int* tab = (const LAS int*)(F.lds + MOE_OFF);
    const int R = (nmt - 64) * 4; const int gw = F.vcu * NWAVES + F.wave, lane = F.lane;
    const float* part = wsp<float>(F.ws, A_PART + (size_t)s * 32 * MiB); const int* RTK = wsp<int>(F.ws, WS_ROWTOK); const float* RGT = wsp<float>(F.ws, WS_ROWGATE);
    for (int idx = gw; idx < R * 256; idx += F.G * NWAVES) { const int t = idx >> 8, r = idx & 255; const int pm = 64 + (t >> 2), pn = t & 3;
        int e = 0;
#pragma unroll
        for (int q = 1; q < 8; ++q) if (pm >= tab[16 + q]) e = q;
        const int mt = pm - tab[16 + e]; const int row0 = tab[e] + 256 * mt; const int nr = tab[8 + e] - 256 * mt;
        if (r < nr) { const int tok = RTK[row0 + r] & 16383; const float gt = RGT[row0 + r];
            f32x4 a = {0.f, 0.f, 0.f, 0.f};
#pragma unroll
            for (int kp = 0; kp < 4; ++kp) a += *(const f32x4*)(part + ((size_t)(t * 4 + kp) * 256 + r) * 256 + 4 * lane);
            float* op = F.out + (size_t)tok * 1024 + 256 * pn + 4 * lane; f32x4 o = *(const f32x4*)op; o += a * gt; *(f32x4*)op = o; } }
}

constexpr int N_PHASES = 21;
__global__ void __launch_bounds__(NWAVES * 64, 2) mk_fwd(Args args) {
    extern __shared__ __attribute__((aligned(16))) unsigned char lds_raw[];
    Frame F; F.lds = (LAS unsigned char*)lds_raw; F.ws = args.ws; F.in = args.in; F.out = args.out;
    F.tid = threadIdx.x; F.lane = F.tid & 63; F.wave = __builtin_amdgcn_readfirstlane(F.tid >> 6);
    F.G = gridDim.x; { const int bx = blockIdx.x; F.vcu = (F.G % 8 == 0) ? (bx % 8) * (F.G / 8) + bx / 8 : bx; }
    volatile LAS unsigned* MISC = (volatile LAS unsigned*)(F.lds + MISC_OFF);
    if (F.tid < 64) MISC[F.tid] = 0u;
    __syncthreads();
    XcdBarrier bar; bar.bar = (unsigned*)(args.ws + WS_CTL) + CW_BAR; bar.x = 0; bar.st = nullptr;
    const int lo = args.ph_lo, hi = args.ph_hi;
    const bool multi = (hi - lo) > 1;
    if (multi) bar = xcd_barrier_post((unsigned*)(args.ws + WS_CTL) + CW_BAR, MISC + 8);
#ifdef PH_ONLY
#define IN(k) ((k) == PH_ONLY && lo <= (k) && (k) < hi)
#else
#define IN(k) (lo <= (k) && (k) < hi)
#endif
#define SEAM(k) do { if (IN(k) && IN((k) + 1)) xcd_barrier(bar); } while (0)
    unsigned char* ws = args.ws; const int cid = (int)blockIdx.x;
#define REFRESH() do { int t_ = threadIdx.x; asm volatile("" : "+v"(t_)); F.tid = t_; F.lane = t_ & 63; F.wave = __builtin_amdgcn_readfirstlane(t_ >> 6); unsigned long long w_ = (unsigned long long)args.ws; asm volatile("" : "+s"(w_)); F.ws = (unsigned char*)w_; ws = F.ws; } while (0)
    LAS unsigned char* ring = F.lds;

#ifndef MK_REP_MASK
#define MK_REP_MASK 0u
#endif
#define REPS(k) ((int)(((unsigned)(MK_REP_MASK) >> (k)) & 1u))
#define PHASE(k, ...) do { if (IN(k)) { for (int rep_ = 0; rep_ <= REPS(k); ++rep_) { if (rep_) xcd_barrier(bar); REFRESH(); __VA_ARGS__ } } SEAM(k); } while (0)
    PHASE(0, phase_prologue(F););
    PHASE(1, {
        pg8::DenseSched S; S.init(wsp<bf16_t>(ws, WS_XB), wsp<bf16_t>(ws, WS_WIN0), M_TOK, E_IN, 1024, F.G, cid);
        EpiScaleBf16 E{wsp<bf16_t>(ws, A_P0), E_IN, wsp<float>(ws, WS_SSQ0)};
        pg8::gemm_phase<EpiScaleBf16, pg8::DenseSched, false>(F.tid, ring, 1024, S, E, nullptr);
        if (F.G == 256 && cid >= 128 && rep_ == 0) { REFRESH(); conv_group(F, 1, (cid - 128) * NWAVES + F.wave, 128 * NWAVES); } });
    PHASE(2, phase_prep0(F););
    PHASE(3, {
        pg8::DenseSched S; S.init(wsp<bf16_t>(ws, A_AP), wsp<bf16_t>(ws, WS_WLR), M_TOK, 2560, 256, F.G, cid);
        EpiLowRank E{ws, F.in};
        pg8::gemm_phase<EpiLowRank, pg8::DenseSched, false>(F.tid, ring, 256, S, E, nullptr); });
#ifndef MK_REP_SUB
#define MK_REP_SUB 0u
#endif
    PHASE(4, phase_cscan_attn_split(F););
    PHASE(5, phase_rwkv_post(F););
    PHASE(6, {
        pg8::DenseSched S; S.init(wsp<bf16_t>(ws, A_YCAT), wsp<bf16_t>(ws, WS_WOUT0), M_TOK, 1024, 1024, F.G, cid);
        EpiResidBf E{rep_ ? wsp<bf16_t>(ws, A_YF) : wsp<bf16_t>(ws, WS_XB), nullptr, rep_ ? wsp<float>(ws, WS_SSQ0) : wsp<float>(ws, WS_SSQ1)};
        pg8::gemm_phase<EpiResidBf, pg8::DenseSched, false>(F.tid, ring, 1024, S, E, nullptr); });
    PHASE(7, {
        pg8::DenseSched S; S.init(wsp<bf16_t>(ws, WS_XB), wsp<bf16_t>(ws, WS_WGU0), M_TOK, 2 * D_FF, 1024, F.G, cid);
        EpiSwiGLU E{wsp<bf16_t>(ws, A_HID0), D_FF, wsp<float>(ws, WS_SSQ1)};
        pg8::gemm_phase<EpiSwiGLU, pg8::DenseSched, false>(F.tid, ring, 1024, S, E, nullptr);
        if (F.G == 256 && cid >= 128 && rep_ == 0) { REFRESH(); conv_group(F, 2, (cid - 128) * NWAVES + F.wave, 128 * NWAVES); } });
    PHASE(8, {
        pg8::DenseSched S; S.init(wsp<bf16_t>(ws, A_HID0), wsp<bf16_t>(ws, WS_WD0), M_TOK, 1024, D_FF, F.G, cid);
        EpiResidBf E{rep_ ? wsp<bf16_t>(ws, A_YF) : wsp<bf16_t>(ws, WS_XB), nullptr, rep_ ? wsp<float>(ws, WS_SSQ0) : wsp<float>(ws, WS_SSQ2)};
        pg8::gemm_phase<EpiResidBf, pg8::DenseSched, false>(F.tid, ring, D_FF, S, E, nullptr); });
    PHASE(9, {
        pg8::DenseSched S; S.init(wsp<bf16_t>(ws, WS_XB), wsp<bf16_t>(ws, WS_WIN1), M_TOK, 3072, 1024, F.G, cid);
        EpiScaleBf16 E{wsp<bf16_t>(ws, A_P1), O_INP, wsp<float>(ws, WS_SSQ2)};
        pg8::gemm_phase<EpiScaleBf16, pg8::DenseSched, false>(F.tid, ring, 1024, S, E, nullptr);
        REFRESH(); phase_gd(F); });
    PHASE(10, phase_gla_prep(F););
    PHASE(11, phase_gla_main(F););
    PHASE(12, phase_gla_post(F););
    PHASE(13, {
        pg8::DenseSched S; S.init(wsp<bf16_t>(ws, A_GOUT), wsp<bf16_t>(ws, WS_WOUT1), M_TOK, 1024, 1024, F.G, cid);
        EpiResidBf E{rep_ ? wsp<bf16_t>(ws, A_QT) : wsp<bf16_t>(ws, WS_XB), rep_ ? wsp<float>(ws, A_OF) : F.out, nullptr};
        pg8::gemm_phase<EpiResidBf, pg8::DenseSched, false>(F.tid, ring, 1024, S, E, nullptr); });
    PHASE(14, for (int q_ = 0; q_ <= (int)(((MK_REP_SUB) >> 2) & 1u); ++q_) { phase_route(F); __syncthreads(); REFRESH(); }
              for (int q_ = 0; q_ <= (int)(((MK_REP_SUB) >> 3) & 1u); ++q_) { phase_conv_experts(F); __syncthreads(); REFRESH(); });
    PHASE(15, phase_place(F););
    PHASE(16, {
        const int nmt = moe_table(F, 2);
        MoESched S; S.go.init(nmt, 2 * D_FFE / 256, F.G, cid); S.tab = (const LAS int*)(F.lds + MOE_OFF);
        S.A = (const char*)wsp<bf16_t>(ws, WS_XB); S.Bt = (const char*)wsp<bf16_t>(ws, A_WEGU); S.a_rowbytes = 0; S.b_expert_bytes = (size_t)2 * D_FFE * 1024 * 2; S.b_tile_bytes = (size_t)256 * 1024 * 2; S.gather = true; S.nt_ = 16;
        const int* rtk = wsp<int>(ws, WS_ROWTOK);
        EpiSwiGLUMoE E{wsp<bf16_t>(ws, A_HID1), wsp<float>(ws, WS_RSTD3), rtk};
        pg8::gemm_phase<EpiSwiGLUMoE, MoESched, true>(F.tid, ring, 1024, S, E, rtk); });
#pragma unroll 1
    for (int s = 0; s < 2; ++s) {
        PHASE(17 + s, {
            const int nmt = moe_table(F, s);
            MoEDownSched S; S.tab = (const LAS int*)(F.lds + MOE_OFF); S.A = (const char*)wsp<bf16_t>(ws, A_HID1); S.Bt = (const char*)wsp<bf16_t>(ws, A_WED); S.nmt = nmt; S.c = cid; S.round = 0;
            EpiMoEDown E{F.out, wsp<int>(ws, WS_ROWTOK), wsp<float>(ws, WS_ROWGATE)};
            pg8::gemm_phase<EpiMoEDown, MoEDownSched, false>(F.tid, ring, D_FFE, S, E, nullptr);
            REFRESH(); S.round = 1; EpiPart EP{wsp<float>(ws, A_PART + (size_t)s * 32 * MiB)};
            pg8::gemm_phase<EpiPart, MoEDownSched, false>(F.tid, ring, D_FFE, S, EP, nullptr); });
    }
    PHASE(19, moe_tail_reduce(F, 0););
    PHASE(20, moe_tail_reduce(F, 1););
#undef PHASE
#undef REPS
#undef IN
#undef SEAM
}

extern "C" void kernel_launch(void* const* d_in, const int* in_sizes, int n_in, void* d_out, int out_size, void* d_ws, size_t ws_size, hipStream_t stream) {
    static int grid = 0;
    if (grid == 0) {
        if (n_in != 38 || out_size != M_TOK * D_MODEL || ws_size < WS_END) { fprintf(stderr, "kernel_launch: unexpected shapes: n_in %d out %d ws %zu (need %zu)\n", n_in, out_size, ws_size, (size_t)WS_END); grid = -1; return; }
        int dev = 0, cus = 0;
        if (hipGetDevice(&dev) != hipSuccess || hipDeviceGetAttribute(&cus, hipDeviceAttributeMultiprocessorCount, dev) != hipSuccess) { grid = -1; return; }
        if (hipFuncSetAttribute((const void*)mk_fwd, hipFuncAttributeMaxDynamicSharedMemorySize, LDS_BYTES) != hipSuccess) { fprintf(stderr, "kernel_launch: hipFuncSetAttribute failed\n"); grid = -1; return; }
        (void)hipGetLastError();
        grid = cus;
        if (grid != 256) fprintf(stderr, "kernel_launch: note: %d CUs (built for 256)\n", grid);
    }
    if (grid < 0) return;
    (void)hipMemsetAsync((char*)d_ws + WS_CTL, 0, CTL_ZERO_BYTES, stream);
    Args a{};
    for (int i = 0; i < 38; ++i) a.in[i] = (const float*)d_in[i];
    a.out = (float*)d_out; a.ws = (unsigned char*)d_ws;
#if MK_N_LAUNCHES == 1
    a.ph_lo = 0; a.ph_hi = N_PHASES - 1 + 0;
    a.ph_hi = 21;
    hipLaunchKernelGGL(mk_fwd, dim3(grid), dim3(NWAVES * 64), LDS_BYTES, stream, a);
#else
#ifndef MK_LAST_PHASE
#define MK_LAST_PHASE 20
#endif
    for (int p = 0; p < MK_LAST_PHASE; ++p) { a.ph_lo = p; a.ph_hi = p + 1; hipLaunchKernelGGL(mk_fwd, dim3(grid), dim3(NWAVES * 64), LDS_BYTES, stream, a); }
#endif
}
```

```cpp
#include <hip/hip_runtime.h>
#include <cstdio>
#include <cstdint>

#ifndef MK_N_LAUNCHES
#define MK_N_LAUNCHES 1
#define MK_REP_MASK 0u
#define MK_REP_SUB 0u
#ifndef MK_REP_SUB
#define MK_REP_SUB 0u
#endif
#endif

#define GAS __attribute__((address_space(1)))
#define LAS __attribute__((address_space(3)))
typedef unsigned short bf16_t;
typedef short bf16x8 __attribute__((ext_vector_type(8)));
typedef short bf16x4 __attribute__((ext_vector_type(4)));
typedef float f32x4 __attribute__((ext_vector_type(4)));
typedef float f32x2 __attribute__((ext_vector_type(2)));
typedef float f32x16 __attribute__((ext_vector_type(16)));
typedef unsigned u32x4 __attribute__((ext_vector_type(4)));
typedef unsigned u32x2 __attribute__((ext_vector_type(2)));
typedef __bf16 bf16x2_t __attribute__((ext_vector_type(2)));

constexpr int D_MODEL = 1024, BATCH = 8, SEQ = 2048, M_TOK = BATCH * SEQ;
constexpr int HD = 64;
constexpr int RW_HEADS = 8, RW_DIM = 512, RW_IN = 1792;
constexpr int ATT_HEADS = 8, ATT_KV = 2;
constexpr int E_IN = 2560;
constexpr int GLA_H = 4, GLA_DK = 512, GLA_DV = 1024, GLA_DKH = 128, GLA_DVH = 256, GLA_R = 16;
constexpr int O_IN = 3088, O_INP = 3328;
constexpr int D_FF = 2816, NEXP = 8, D_FFE = 3584;
constexpr float NORM_EPS = 1e-6f;

constexpr size_t MiB = 1u << 20;
constexpr size_t WS_CTL = 0, CTL_ZERO_BYTES = 1 * MiB;
constexpr size_t WS_SSQ0 = 1 * MiB, WS_SSQ1 = 2 * MiB, WS_SSQ2 = 3 * MiB;
constexpr size_t WS_RSTD3 = 4 * MiB;
constexpr size_t WS_TOKE = WS_RSTD3 + 65536;
constexpr size_t WS_TOKG = WS_TOKE + 131072;
constexpr size_t WS_CNT = WS_TOKG + 131072;
constexpr size_t WS_TOT = WS_CNT + 16384;
constexpr size_t WS_ROWTOK = WS_TOT + 256;
constexpr int ROWS_PER_SLOT = M_TOK + 256;
constexpr size_t WS_ROWGATE = WS_ROWTOK + (size_t)2 * ROWS_PER_SLOT * 4;
constexpr size_t WS_DECS = 6 * MiB;
constexpr size_t WS_ROPE = 7 * MiB;
constexpr size_t WS_XB = 8 * MiB;
constexpr size_t WS_WIN0 = 40 * MiB, WS_WLR = 45 * MiB, WS_WOUT0 = 47 * MiB, WS_WGU0 = 49 * MiB, WS_WD0 = 60 * MiB, WS_WIN1 = 66 * MiB, WS_WOUT1 = 73 * MiB;
constexpr size_t AR = 75 * MiB;
constexpr size_t A_P0 = AR + 0, A_RS = AR + 80 * MiB, A_KS = AR + 96 * MiB, A_VS = AR + 112 * MiB, A_NKK = AR + 128 * MiB, A_AP = AR + 144 * MiB;
constexpr size_t A_QH = AR + 152 * MiB, A_KH = AR + 168 * MiB, A_VT0 = AR + 172 * MiB;
constexpr size_t A_LWF = AR + 176 * MiB, A_LWB = AR + 192 * MiB, A_KDF = AR + 208 * MiB, A_KDB = AR + 224 * MiB, A_BBF = AR + 240 * MiB, A_BBB = AR + 256 * MiB;
constexpr size_t A_GG = AR + 272 * MiB, A_YF = AR + 0 * MiB, A_YB = AR + 16 * MiB, A_YCAT = AR + 32 * MiB;
constexpr size_t A_HID0 = AR + 0;
constexpr size_t A_P1 = AR + 0;
constexpr size_t A_QHAT = AR + 104 * MiB, A_K2T = AR + 120 * MiB;
constexpr size_t GLA_DIR_STRIDE = 32 * MiB;
constexpr size_t A_VT1 = AR + 200 * MiB, A_OF = AR + 232 * MiB, A_OB = AR + 264 * MiB, A_GOUT = AR + 168 * MiB;
constexpr size_t A_WEGU = 40 * MiB, A_WED = 407 * MiB, A_HID1 = 152 * MiB, A_WEGU2 = 378 * MiB;
constexpr size_t WEGU_HI_SHIFT = A_WEGU2 - (A_WEGU + (size_t)6 * 14 * MiB);
constexpr int ROWS_ALL = 2 * M_TOK + 256;
constexpr size_t WS_END = 463 * MiB;
static_assert(A_HID1 + (size_t)ROWS_ALL * D_FFE * 2 <= A_WED && A_WED + (size_t)NEXP * 1024 * D_FFE * 2 <= WS_END && A_WEGU2 >= AR + 296 * MiB && A_WEGU2 >= A_HID1 + (size_t)ROWS_ALL * D_FFE * 2 && A_WEGU2 + 28 * MiB <= A_WED && 2 * ROWS_PER_SLOT >= ROWS_ALL, "ws map");
static_assert(A_GOUT + 32 * MiB <= A_VT1 && A_YCAT + 32 * MiB <= A_RS, "ws map");

constexpr int CW_BAR = 4096;

constexpr int RING_BYTES = 131072;
constexpr int LDS_BYTES = 147456;
constexpr int MISC_OFF = LDS_BYTES - 512;
constexpr int MOE_OFF = LDS_BYTES - 256;

__device__ __forceinline__ unsigned pk2(float lo, float hi) { f32x2 v = {lo, hi}; bf16x2_t b = __builtin_convertvector(v, bf16x2_t); return __builtin_bit_cast(unsigned, b); }
__device__ __forceinline__ bf16_t f2bf(float f) { return (bf16_t)(pk2(f, 0.f) & 0xffffu); }
__device__ __forceinline__ float bf2f(bf16_t h) { return __uint_as_float(((unsigned)h) << 16); }
__device__ __forceinline__ float bflo(unsigned w) { return __uint_as_float(w << 16); }
__device__ __forceinline__ float bfhi(unsigned w) { return __uint_as_float(w & 0xffff0000u); }
__device__ __forceinline__ float wave_sum(float v) {
#pragma unroll
    for (int o = 1; o < 64; o <<= 1) v += __shfl_xor(v, o);
    return v;
}
__device__ __forceinline__ float sigmoidf_(float x) { return 1.f / (1.f + __expf(-x)); }
__device__ __forceinline__ float siluf_(float x) { return x / (1.f + __expf(-x)); }
#define LDS_WAIT() asm volatile("s_waitcnt lgkmcnt(0)" ::: "memory")
#define VM_WAIT() asm volatile("s_waitcnt vmcnt(0)" ::: "memory")

#define XB_TMO      128
#define XB_XCNT(j)  (256  + 64 * (j))
#define XB_XSUB(j)  (1280 + 64 * (j))
#define XB_XGEN(j)  (2304 + 64 * (j))
#define XB_TOP      3328
#define XB_TOPGEN   3392
#define XCD_BAR_WORDS 3456
#define XB_SPIN_CAP (1u << 20)
__device__ __forceinline__ unsigned xb_ld(unsigned* p)              { return __hip_atomic_load(p, __ATOMIC_RELAXED, __HIP_MEMORY_SCOPE_AGENT); }
__device__ __forceinline__ unsigned xb_add(unsigned* p, unsigned v) { return __hip_atomic_fetch_add(p, v, __ATOMIC_RELAXED, __HIP_MEMORY_SCOPE_AGENT); }
__device__ __forceinline__ unsigned xb_xcc_id() { return (unsigned)__builtin_amdgcn_s_getreg((3 << 11) | 20) & 0xFu; }
#define XB_SPIN(cond, bar) do { unsigned _sp = 0; while (cond) { __builtin_amdgcn_s_sleep(1); \
    if ((++_sp & 255u) == 0u) { if (xb_ld(&(bar)[XB_TMO])) break; if (_sp > XB_SPIN_CAP) { atomicAdd(&(bar)[XB_TMO], 1u); break; } } } } while (0)
struct XcdBarrier { unsigned* bar; unsigned x; volatile LAS unsigned* st; };
__device__ __forceinline__ XcdBarrier xcd_barrier_post(unsigned* bar, volatile LAS unsigned* st) {
    XcdBarrier b; b.bar = bar; b.x = xb_xcc_id(); b.st = st;
    if (threadIdx.x == 0) (void)xb_add(&bar[XB_XCNT(b.x)], 1u);
    return b;
}
__device__ __forceinline__ void xcd_barrier_complete(unsigned* bar, unsigned x, unsigned& nloc, unsigned& nx) {
    const unsigned G = gridDim.x * gridDim.y * gridDim.z;
    unsigned sum, cnt, mine, sp = 0u;
    for (;;) {
        sum = 0u; cnt = 0u; mine = 0u;
#pragma unroll
        for (unsigned j = 0; j < 16; ++j) { const unsigned c = xb_ld(&bar[XB_XCNT(j)]); sum += c; cnt += (c > 0u) ? 1u : 0u; mine = (j == x) ? c : mine; }
        if (sum == G) break;
        __builtin_amdgcn_s_sleep(1);
        if ((++sp & 255u) == 0u) { if (xb_ld(&bar[XB_TMO])) break; if (sp > XB_SPIN_CAP) { atomicAdd(&bar[XB_TMO], 1u); break; } }
    }
    nloc = mine > 0u ? mine : 1u; nx = cnt > 0u ? cnt : 1u;
}
__device__ __forceinline__ void xcd_barrier(const XcdBarrier& b) {
    asm volatile("s_waitcnt vmcnt(0)" ::: "memory");
    __syncthreads();
    if (threadIdx.x == 0) {
        unsigned* bar = b.bar;
        __builtin_amdgcn_s_waitcnt(0);
        unsigned nloc = b.st[0], nx = b.st[1];
        if (nloc == 0u) { xcd_barrier_complete(bar, b.x, nloc, nx); b.st[0] = nloc; b.st[1] = nx; }
        const unsigned old = xb_add(&bar[XB_XSUB(b.x)], 1u);
        const unsigned gen = old / nloc;
        if (old + 1u == (gen + 1u) * nloc) {
            __builtin_amdgcn_fence(__ATOMIC_RELEASE, "agent");
            asm volatile("s_waitcnt vmcnt(0)" ::: "memory");
            const unsigned og = xb_add(&bar[XB_TOP], 1u);
            const unsigned tg = og / nx;
            if (og + 1u == (tg + 1u) * nx) xb_add(&bar[XB_TOPGEN], 1u);
            else XB_SPIN(xb_ld(&bar[XB_TOPGEN]) == tg, bar);
            __builtin_amdgcn_fence(__ATOMIC_ACQUIRE, "agent");
            xb_add(&bar[XB_XGEN(b.x)], 1u);
            asm volatile("s_waitcnt vmcnt(0)" ::: "memory");
        } else {
            XB_SPIN(xb_ld(&bar[XB_XGEN(b.x)]) == gen, bar);
            __builtin_amdgcn_fence(__ATOMIC_ACQUIRE, "agent");
            asm volatile("s_waitcnt vmcnt(0)" ::: "memory");
        }
    }
    __syncthreads();
}

namespace pg8 {
constexpr int BM = 256, BK = 64, HALF = 128, HTB = HALF * BK * 2, STAGE_BYTES = 8 * HTB, NXCD = 8, WGM = 4;
__host__ __device__ __forceinline__ int lds_byte(int r, int c) { const int st = (r >> 4) * 2 + (c >> 5), rr = r & 15, cc = c & 31, ob = rr * 64 + cc * 2; return st * 1024 + (ob ^ (((ob >> 9) & 1) << 5)); }
__host__ __device__ __forceinline__ void stage_rc(int b, int& R, int& C) { const int st = b / 1024, sb = b % 1024, swz = sb ^ (((sb >> 9) & 1) << 5); R = (st >> 1) * 16 + swz / 64; C = (st & 1) * 32 + (swz % 64) / 2; }
__host__ __device__ __forceinline__ int perm32(int rho) { const int n = rho >> 4, i = rho & 15; return 8 * (i >> 2) + 4 * n + (i & 3); }

struct Unit { const char* a; const char* b; int pm, pn; int row0, nrows, e; int nt, flags; };

struct GridOrder {
    int nM, nN, nwg, G, c;
    __device__ void init(int nM_, int nN_, int G_, int c_) { nM = nM_; nN = nN_; nwg = nM * nN; G = G_; c = c_; }
    __device__ bool tile(int i, int& pm, int& pn) const {
        const long L = (long)i * G + c; if (L >= nwg) return false;
        int wgid = (int)L; { const int q = nwg / NXCD, r = nwg % NXCD, xcd = wgid % NXCD, off = wgid / NXCD; wgid = (xcd < r ? xcd * (q + 1) : r * (q + 1) + (xcd - r) * q) + off; }
        const int nig = WGM * nN, gid = wgid / nig, fm = gid * WGM, gsz = (nM - fm) < WGM ? (nM - fm) : WGM;
        pm = fm + ((wgid % nig) % gsz); pn = (wgid % nig) / gsz; return true;
    }
};
struct DenseSched {
    GridOrder go; const char* A; const char* Bt; size_t tstep; int nt_;
    __device__ void init(const bf16_t* A_, const bf16_t* Bt_, int M, int N, int K, int G, int c) { go.init(M / BM, N / BM, G, c); A = (const char*)A_; Bt = (const char*)Bt_; tstep = (size_t)BM * K * 2; nt_ = K / BK; }
    __device__ bool next(int i, Unit& u) const { int pm, pn; if (!go.tile(i, pm, pn)) return false; u.pm = pm; u.pn = pn; u.a = A + (size_t)pm * tstep; u.b = Bt + (size_t)pn * tstep; u.row0 = pm * BM; u.nrows = BM; u.e = 0; u.nt = nt_; u.flags = 0; return true; }
};

template <class Epi, class Sched, bool GATHER>
__device__ __forceinline__ void gemm_phase(const int tid, LAS unsigned char* lds, const int K_, const Sched& S, const Epi& E, const int* gather_rows) {
    int K = K_; asm volatile("" : "+s"(K));
    const int wid = __builtin_amdgcn_readfirstlane(tid >> 6), lane = tid & 63, wr = wid >> 2, wc = wid & 3, fr = lane & 15, fq = lane >> 4;
    int sR[2], sC[2];
    unsigned voffB[2];
#pragma unroll
    for (int i = 0; i < 2; ++i) { int R, C; stage_rc(tid * 16 + i * 8192, R, C); sR[i] = R; sC[i] = C; const int Rb = Epi::PERM ? ((R & ~31) + perm32(R & 31)) : R; voffB[i] = (unsigned)(Rb * K + C) * 2u; }
    const size_t kstep = (size_t)(BK * 2);
    const size_t hstep = (size_t)HALF * K * 2;
    const unsigned ldsw = (unsigned)wid * 1024u;
    const int aoff = lds_byte(wr * 64 + fr, fq * 8), boff = lds_byte(wc * 32 + fr, fq * 8);
    unsigned cva[2][2], nva[2][2];
#define PG8_SETVA(va, u) do { _Pragma("unroll") for (int h_ = 0; h_ < 2; ++h_) _Pragma("unroll") for (int i_ = 0; i_ < 2; ++i_) { \
        if (GATHER) { int rr_ = (u).row0 + h_ * HALF + sR[i_]; const int rmax_ = (u).row0 + (u).nrows - 1; rr_ = rr_ > rmax_ ? rmax_ : rr_; int tk_ = gather_rows[rr_]; tk_ = tk_ < 0 ? 0 : (tk_ > 16383 ? 16383 : tk_); va[h_][i_] = (unsigned)(tk_ * K + sC[i_]) * 2u; } \
        else va[h_][i_] = (unsigned)((h_ * HALF + sR[i_]) * K + sC[i_]) * 2u; } } while (0)
#define PG8_SA(b, h) (((b) * 2 + (h)) * HTB)
#define PG8_SB(b, h) ((4 + (b) * 2 + (h)) * HTB)
#define PG8_STAGE2(bufoff, gbase, v0, v1) do { \
        __builtin_amdgcn_global_load_lds((const unsigned*)((const char*)(gbase) + (v0)), (LAS unsigned*)(lds + (bufoff) + ldsw), 16, 0, 0); \
        __builtin_amdgcn_global_load_lds((const unsigned*)((const char*)(gbase) + (v1)), (LAS unsigned*)(lds + (bufoff) + ldsw + 8192), 16, 0, 0); } while (0)
#define PG8_STAGEB(bufoff, gbase) PG8_STAGE2(bufoff, gbase, voffB[0], voffB[1])
#define PG8_STAGEA(bufoff, gbase, va, h) PG8_STAGE2(bufoff, gbase, va[h][0], va[h][1])
#define PG8_LDA(dst, b, h) do { _Pragma("unroll") for (int m = 0; m < 4; ++m) _Pragma("unroll") for (int k = 0; k < 2; ++k) dst[m][k] = *(const LAS bf16x8*)(lds + PG8_SA(b, h) + aoff + m * 2048 + k * 1024); } while (0)
#define PG8_LDB(dst, b, h) do { _Pragma("unroll") for (int n = 0; n < 2; ++n) _Pragma("unroll") for (int k = 0; k < 2; ++k) dst[n][k] = *(const LAS bf16x8*)(lds + PG8_SB(b, h) + boff + n * 2048 + k * 1024); } while (0)
#define PG8_MMA(ai, bj, At, Bt) do { __builtin_amdgcn_s_setprio(1); _Pragma("unroll") for (int m = 0; m < 4; ++m) _Pragma("unroll") for (int n = 0; n < 2; ++n) _Pragma("unroll") for (int k = 0; k < 2; ++k) \
        acc[ai][bj][m][n] = __builtin_amdgcn_mfma_f32_16x16x32_bf16(Bt[n][k], At[m][k], acc[ai][bj][m][n], 0, 0, 0); __builtin_amdgcn_s_setprio(0); } while (0)
#define PG8_WAIT_V(n) asm volatile("s_waitcnt vmcnt(" #n ")" ::: "memory")
#define PG8_WAIT_L(n) asm volatile("s_waitcnt lgkmcnt(" #n ")" ::: "memory")
#define PG8_BAR __builtin_amdgcn_s_barrier()
#define PG8_SCHED __builtin_amdgcn_sched_barrier(0)
    Unit cur, nxt; int ui = 0;
    if (!S.next(0, cur)) return;
    PG8_SETVA(cva, cur);
    f32x4 acc[2][2][4][2];
#pragma unroll
    for (int a = 0; a < 2; ++a)
#pragma unroll
        for (int b = 0; b < 2; ++b)
#pragma unroll
            for (int m = 0; m < 4; ++m)
#pragma unroll
                for (int n = 0; n < 2; ++n) acc[a][b][m][n] = (f32x4){0.f, 0.f, 0.f, 0.f};
    bf16x8 At[4][2], B0[2][2], B1[2][2];
    const char* cA = cur.a; const char* cB = cur.b;
    PG8_STAGEB(PG8_SB(0, 0), cB); PG8_STAGEB(PG8_SB(0, 1), cB + hstep); PG8_STAGEA(PG8_SA(0, 0), cA, cva, 0); PG8_STAGEA(PG8_SA(0, 1), cA, cva, 1);
    if (wr == 1) PG8_BAR;
    PG8_WAIT_V(2); PG8_BAR;
    PG8_STAGEB(PG8_SB(1, 0), cB + kstep); PG8_STAGEA(PG8_SA(1, 0), cA + kstep, cva, 0); PG8_STAGEB(PG8_SB(1, 1), cB + hstep + kstep);
    PG8_WAIT_V(6); PG8_BAR;
    for (;;) {
        const bool has_next = S.next(ui + 1, nxt);
        if (has_next) PG8_SETVA(nva, nxt);
        else {
#pragma unroll
            for (int h = 0; h < 2; ++h)
#pragma unroll
                for (int i = 0; i < 2; ++i) nva[h][i] = cva[h][i];
        }
        const char* nA = has_next ? nxt.a : cA; const char* nB = has_next ? nxt.b : cB;
        const int nt = cur.nt;
        for (int t = 0; t < nt; t += 2) {
            const bool last = (t == nt - 2);
            const char* a1 = cA + (size_t)(t + 1) * kstep;
            const char* a2 = last ? nA : cA + (size_t)(t + 2) * kstep; const char* b2 = last ? nB : cB + (size_t)(t + 2) * kstep;
            const char* a3 = a2 + kstep; const char* b3 = b2 + kstep;
            unsigned va2[2][2];
#pragma unroll
            for (int h = 0; h < 2; ++h)
#pragma unroll
                for (int i = 0; i < 2; ++i) va2[h][i] = (GATHER && last) ? nva[h][i] : cva[h][i];
            PG8_LDB(B0, 0, 0); PG8_LDB(B1, 0, 1); PG8_SCHED; PG8_LDA(At, 0, 0); PG8_STAGEA(PG8_SA(1, 1), a1, cva, 1);
            PG8_WAIT_V(8); PG8_WAIT_L(0); PG8_BAR; PG8_MMA(0, 0, At, B0); PG8_MMA(0, 1, At, B1); PG8_BAR; PG8_SCHED;
            PG8_LDA(At, 0, 1); PG8_STAGEB(PG8_SB(0, 0), b2); PG8_STAGEB(PG8_SB(0, 1), b2 + hstep); PG8_STAGEA(PG8_SA(0, 0), a2, va2, 0);
            PG8_WAIT_V(8); PG8_WAIT_L(0); PG8_BAR; PG8_MMA(1, 0, At, B0); PG8_MMA(1, 1, At, B1); PG8_BAR; PG8_SCHED;
            PG8_LDB(B0, 1, 0); PG8_LDB(B1, 1, 1); PG8_SCHED; PG8_LDA(At, 1, 0); PG8_STAGEA(PG8_SA(0, 1), a2, va2, 1);
            PG8_WAIT_V(8); PG8_WAIT_L(0); PG8_BAR; PG8_MMA(0, 0, At, B0); PG8_MMA(0, 1, At, B1); PG8_BAR; PG8_SCHED;
            PG8_LDA(At, 1, 1); PG8_STAGEB(PG8_SB(1, 0), b3); PG8_STAGEB(PG8_SB(1, 1), b3 + hstep); PG8_STAGEA(PG8_SA(1, 0), a3, va2, 0);
            PG8_WAIT_V(8); PG8_WAIT_L(0); PG8_BAR; PG8_MMA(1, 0, At, B0); PG8_MMA(1, 1, At, B1); PG8_BAR; PG8_SCHED;
        }
        if (wr == 0) PG8_BAR;
        E(acc, cur, wr, wc, fr, fq);
        if (!has_next) break;
#pragma unroll
        for (int a = 0; a < 2; ++a)
#pragma unroll
            for (int b = 0; b < 2; ++b)
#pragma unroll
                for (int m = 0; m < 4; ++m)
#pragma unroll
                    for (int n = 0; n < 2; ++n) acc[a][b][m][n] = (f32x4){0.f, 0.f, 0.f, 0.f};
        cur = nxt; cA = nA; cB = nB; ++ui;
#pragma unroll
        for (int h = 0; h < 2; ++h)
#pragma unroll
            for (int i = 0; i < 2; ++i) cva[h][i] = nva[h][i];
        if (wr == 1) PG8_BAR;
    }
    PG8_WAIT_V(0);
    PG8_BAR;
#undef PG8_SETVA
#undef PG8_SA
#undef PG8_SB
#undef PG8_STAGE2
#undef PG8_STAGEA
#undef PG8_STAGEB
#undef PG8_LDA
#undef PG8_LDB
#undef PG8_MMA
#undef PG8_WAIT_V
#undef PG8_WAIT_L
#undef PG8_BAR
#undef PG8_SCHED
}
}

__device__ __forceinline__ float rstd_from_ssq(const float* ssq, int row) {
    const f32x4* p = (const f32x4*)(ssq + (size_t)row * 16);
    const f32x4 a = p[0], b = p[1], c = p[2], d = p[3];
    const float s = (((a.x + a.y) + (a.z + a.w)) + ((b.x + b.y) + (b.z + b.w))) + (((c.x + c.y) + (c.z + c.w)) + ((d.x + d.y) + (d.z + d.w)));
    return 1.0f / sqrtf(s * (1.f / 1024.f) + NORM_EPS);
}
__device__ __forceinline__ u32x4 pack8(const f32x4 v0, const f32x4 v1) { u32x4 w; w.x = pk2(v0[0], v0[1]); w.y = pk2(v0[2], v0[3]); w.z = pk2(v1[0], v1[1]); w.w = pk2(v1[2], v1[3]); return w; }
__device__ __forceinline__ void unpack8(const u32x4 w, float (&f)[8]) { f[0] = bflo(w.x); f[1] = bfhi(w.x); f[2] = bflo(w.y); f[3] = bfhi(w.y); f[4] = bflo(w.z); f[5] = bfhi(w.z); f[6] = bflo(w.w); f[7] = bfhi(w.w); }
__device__ __forceinline__ u32x4 pack8f(const float (&f)[8]) { u32x4 w; w.x = pk2(f[0], f[1]); w.y = pk2(f[2], f[3]); w.z = pk2(f[4], f[5]); w.w = pk2(f[6], f[7]); return w; }

struct EpiScaleBf16 {
    static constexpr bool PERM = true;
    bf16_t* O; int ldc; const float* ssq;
    __device__ __forceinline__ void operator()(const f32x4 (&acc)[2][2][4][2], const pg8::Unit& u, int wr, int wc, int fr, int fq) const {
        const int row0 = u.pm * 256 + wr * 64 + fr, col0 = u.pn * 256 + wc * 32 + 8 * fq;
#pragma unroll
        for (int ai = 0; ai < 2; ++ai)
#pragma unroll
            for (int m = 0; m < 4; ++m) { const int row = row0 + ai * 128 + m * 16; const float rs = rstd_from_ssq(ssq, row); bf16_t* rowp = O + (size_t)row * ldc + col0;
#pragma unroll
                for (int bj = 0; bj < 2; ++bj) *(u32x4*)(rowp + bj * 128) = pack8(acc[ai][bj][m][0] * rs, acc[ai][bj][m][1] * rs); }
    }
};
struct EpiResid {
    static constexpr bool PERM = true;
    const float* base; float* out; bf16_t* xb; float* ssq;
    __device__ __forceinline__ void operator()(const f32x4 (&acc)[2][2][4][2], const pg8::Unit& u, int wr, int wc, int fr, int fq) const {
        const int row0 = u.pm * 256 + wr * 64 + fr, col0 = u.pn * 256 + wc * 32 + 8 * fq;
#pragma unroll
        for (int ai = 0; ai < 2; ++ai)
#pragma unroll
            for (int m = 0; m < 4; ++m) { const int row = row0 + ai * 128 + m * 16; const size_t off = (size_t)row * 1024 + col0; float ss = 0.f;
#pragma unroll
                for (int bj = 0; bj < 2; ++bj) { const f32x4 b0 = *(const f32x4*)(base + off + bj * 128), b1 = *(const f32x4*)(base + off + bj * 128 + 4);
                    const f32x4 o0 = b0 + acc[ai][bj][m][0], o1 = b1 + acc[ai][bj][m][1];
                    *(f32x4*)(out + off + bj * 128) = o0; *(f32x4*)(out + off + bj * 128 + 4) = o1;
                    ss += (o0[0] * o0[0] + o0[1] * o0[1]) + (o0[2] * o0[2] + o0[3] * o0[3]) + (o1[0] * o1[0] + o1[1] * o1[1]) + (o1[2] * o1[2] + o1[3] * o1[3]);
                    *(u32x4*)(xb + off + bj * 128) = pack8(o0, o1); }
                ss += __shfl_xor(ss, 16); ss += __shfl_xor(ss, 32);
                if (ssq && fq == 0) ssq[(size_t)row * 16 + u.pn * 4 + wc] = ss; }
    }
};
struct EpiResidBf {
    static constexpr bool PERM = true;
    bf16_t* xb; float* out; float* ssq;
    __device__ __forceinline__ void operator()(const f32x4 (&acc)[2][2][4][2], const pg8::Unit& u, int wr, int wc, int fr, int fq) const {
        const int row0 = u.pm * 256 + wr * 64 + fr, col0 = u.pn * 256 + wc * 32 + 8 * fq;
#pragma unroll
        for (int ai = 0; ai < 2; ++ai)
#pragma unroll
            for (int m = 0; m < 4; ++m) { const int row = row0 + ai * 128 + m * 16; const size_t off = (size_t)row * 1024 + col0; float ss = 0.f;
#pragma unroll
                for (int bj = 0; bj < 2; ++bj) { const u32x4 bw = *(const u32x4*)(xb + off + bj * 128);
                    const f32x4 b0 = {bflo(bw.x), bfhi(bw.x), bflo(bw.y), bfhi(bw.y)}, b1 = {bflo(bw.z), bfhi(bw.z), bflo(bw.w), bfhi(bw.w)};
                    const f32x4 o0 = b0 + acc[ai][bj][m][0], o1 = b1 + acc[ai][bj][m][1];
                    if (out) { *(f32x4*)(out + off + bj * 128) = o0; *(f32x4*)(out + off + bj * 128 + 4) = o1; }
                    ss += (o0[0] * o0[0] + o0[1] * o0[1]) + (o0[2] * o0[2] + o0[3] * o0[3]) + (o1[0] * o1[0] + o1[1] * o1[1]) + (o1[2] * o1[2] + o1[3] * o1[3]);
                    *(u32x4*)(xb + off + bj * 128) = pack8(o0, o1); }
                ss += __shfl_xor(ss, 16); ss += __shfl_xor(ss, 32);
                if (ssq && fq == 0) ssq[(size_t)row * 16 + u.pn * 4 + wc] = ss; }
    }
};
struct EpiSwiGLU {
    static constexpr bool PERM = true;
    bf16_t* H; int ldh; const float* ssq;
    __device__ __forceinline__ void operator()(const f32x4 (&acc)[2][2][4][2], const pg8::Unit& u, int wr, int wc, int fr, int fq) const {
        const int row0 = u.pm * 256 + wr * 64 + fr, hcol0 = u.pn * 128 + wc * 32 + 8 * fq;
#pragma unroll
        for (int ai = 0; ai < 2; ++ai)
#pragma unroll
            for (int m = 0; m < 4; ++m) { const int row = row0 + ai * 128 + m * 16; const float rs = rstd_from_ssq(ssq, row);
                f32x4 h[2];
#pragma unroll
                for (int n = 0; n < 2; ++n) { const f32x4 g = acc[ai][0][m][n] * rs, up = acc[ai][1][m][n] * rs;
#pragma unroll
                    for (int i = 0; i < 4; ++i) h[n][i] = siluf_(g[i]) * up[i]; }
                *(u32x4*)(H + (size_t)row * ldh + hcol0) = pack8(h[0], h[1]); }
    }
};
struct EpiSwiGLUMoE {
    static constexpr bool PERM = true;
    bf16_t* H; const float* rstd3; const int* row_tok;
    __device__ __forceinline__ void operator()(const f32x4 (&acc)[2][2][4][2], const pg8::Unit& u, int wr, int wc, int fr, int fq) const {
        const int hcol0 = u.pn * 128 + wc * 32 + 8 * fq;
#pragma unroll
        for (int ai = 0; ai < 2; ++ai)
#pragma unroll
            for (int m = 0; m < 4; ++m) { const int rl = ai * 128 + wr * 64 + m * 16 + fr;
                if (rl < u.nrows) { const int grow = u.row0 + rl; const float rs = rstd3[row_tok[grow] & 16383];
                    f32x4 h[2];
#pragma unroll
                    for (int n = 0; n < 2; ++n) { const f32x4 g = acc[ai][0][m][n] * rs, up = acc[ai][1][m][n] * rs;
#pragma unroll
                        for (int i = 0; i < 4; ++i) h[n][i] = siluf_(g[i]) * up[i]; }
                    *(u32x4*)(H + (size_t)grow * D_FFE + hcol0) = pack8(h[0], h[1]); } }
    }
};
struct EpiMoEDown {
    static constexpr bool PERM = true;
    float* out; const int* row_tok; const float* row_gate;
    __device__ __forceinline__ void operator()(const f32x4 (&acc)[2][2][4][2], const pg8::Unit& u, int wr, int wc, int fr, int fq) const {
        const int col0 = u.pn * 256 + wc * 32 + 8 * fq;
#pragma unroll
        for (int ai = 0; ai < 2; ++ai)
#pragma unroll
            for (int m = 0; m < 4; ++m) { const int rl = ai * 128 + wr * 64 + m * 16 + fr;
                if (rl < u.nrows) { const int grow = u.row0 + rl; const int tok = row_tok[grow] & 16383; const float gt = row_gate[grow]; float* op = out + (size_t)tok * 1024 + col0;
#pragma unroll
                    for (int bj = 0; bj < 2; ++bj) { f32x4 b0 = *(const f32x4*)(op + bj * 128), b1 = *(const f32x4*)(op + bj * 128 + 4);
                        b0 += acc[ai][bj][m][0] * gt; b1 += acc[ai][bj][m][1] * gt; *(f32x4*)(op + bj * 128) = b0; *(f32x4*)(op + bj * 128 + 4) = b1; } } }
    }
};
struct EpiPart {
    static constexpr bool PERM = true;
    float* part;
    __device__ __forceinline__ void operator()(const f32x4 (&acc)[2][2][4][2], const pg8::Unit& u, int wr, int wc, int fr, int fq) const {
        float* pb = part + (size_t)(u.flags - 1) * 65536; const unsigned o0 = (unsigned)((wr * 64 + fr) * 256 + wc * 32 + 8 * fq);
#pragma unroll
        for (int ai = 0; ai < 2; ++ai)
#pragma unroll
            for (int m = 0; m < 4; ++m)
#pragma unroll
                for (int bj = 0; bj < 2; ++bj) { float* pp = pb + o0 + (ai * 128 + m * 16) * 256 + bj * 128; *(f32x4*)pp = acc[ai][bj][m][0]; *(f32x4*)(pp + 4) = acc[ai][bj][m][1]; }
    }
};
struct LowRankSched {
    pg8::GridOrder go; const char* A; const char* Bt;
    __device__ void init(const bf16_t* A_, const bf16_t* Bt_, int G, int c) { go.init(M_TOK / 256, 8, G, c); A = (const char*)A_; Bt = (const char*)Bt_; }
    __device__ bool next(int i, pg8::Unit& u) const { int pm, pn; if (!go.tile(i, pm, pn)) return false; u.pm = pm; u.pn = pn; u.a = A + (size_t)pm * (256 * 256 * 2); u.b = Bt + (size_t)pn * (256 * 256 * 2);
        u.row0 = pm * 256; u.nrows = 256; u.e = 0; int two = 2; asm volatile("" : "+s"(two)); u.nt = two; u.flags = 0; return true; }
};
struct EpiLowRank {
    static constexpr bool PERM = true;
    unsigned char* ws; const float* const* in;
    __device__ __forceinline__ void operator()(const f32x4 (&acc)[2][2][4][2], const pg8::Unit& u, int wr, int wc, int fr, int fq) const {
        const int kind = u.pn >> 1; const int row0 = u.pm * 256 + wr * 64 + fr; const int c0 = (u.pn & 1) * 256 + wc * 32 + 8 * fq;
        const float* zp = in[kind == 0 ? 4 : kind == 1 ? 6 : kind == 2 ? 8 : 10]; const float* k_a = in[14];
        bf16_t* o1 = (bf16_t*)(ws + (kind == 0 ? A_LWF : kind == 1 ? A_LWB : kind == 2 ? A_KDF : A_KDB));
        bf16_t* o2 = (bf16_t*)(ws + (kind == 3 ? A_BBB : A_BBF));
        const bf16_t* KS = (const bf16_t*)(ws + A_KS); const bf16_t* NKK = (const bf16_t*)(ws + A_NKK);
#pragma unroll
        for (int bj = 0; bj < 2; ++bj) { const int c = c0 + bj * 128;
            const f32x4 z0 = *(const f32x4*)(zp + c), z1 = *(const f32x4*)(zp + c + 4);
            if (kind < 2) {
#pragma unroll
                for (int ai = 0; ai < 2; ++ai)
#pragma unroll
                    for (int m = 0; m < 4; ++m) { const int row = row0 + ai * 128 + m * 16; f32x4 v0 = acc[ai][bj][m][0] + z0, v1 = acc[ai][bj][m][1] + z1;
#pragma unroll
                        for (int i = 0; i < 4; ++i) { v0[i] = -0.87506126f * sigmoidf_(v0[i]); v1[i] = -0.87506126f * sigmoidf_(v1[i]); }
                        *(u32x4*)(o1 + (size_t)row * 512 + c) = pack8(v0, v1); }
            } else { const f32x4 ka0 = *(const f32x4*)(k_a + c), ka1 = *(const f32x4*)(k_a + c + 4);
#pragma unroll
                for (int ai = 0; ai < 2; ++ai)
#pragma unroll
                    for (int m = 0; m < 4; ++m) { const int row = row0 + ai * 128 + m * 16; const size_t off = (size_t)row * 512 + c;
                        const u32x4 kw = *(const u32x4*)(KS + off), nw = *(const u32x4*)(NKK + off);
                        float kv[8], nv[8], kd[8], bb[8]; unpack8(kw, kv); unpack8(nw, nv);
                        const f32x4 a0 = acc[ai][bj][m][0] + z0, a1 = acc[ai][bj][m][1] + z1;
#pragma unroll
                        for (int i = 0; i < 4; ++i) { const float s0 = sigmoidf_(a0[i]), s1 = sigmoidf_(a1[i]);
                            kd[i] = kv[i] * (1.f + (s0 - 1.f) * ka0[i]); bb[i] = -nv[i] * s0; kd[4 + i] = kv[4 + i] * (1.f + (s1 - 1.f) * ka1[i]); bb[4 + i] = -nv[4 + i] * s1; }
                        *(u32x4*)(o1 + off) = pack8f(kd); *(u32x4*)(o2 + off) = pack8f(bb); }
            } }
    }
};

constexpr int NWAVES = 8;
struct Args { const float* in[38]; float* out; unsigned char* ws; int ph_lo, ph_hi; };
struct Frame {
    LAS unsigned char* lds; unsigned char* ws; const float* const* in; float* out;
    int tid, lane, wave, vcu, G;
};
template <class T> __device__ __forceinline__ T* wsp(unsigned char* ws, size_t off) { return (T*)(ws + off); }

__device__ __forceinline__ void conv_item(const float* W, int ldw, int k0, int n0, int ncols, const float* gain, bf16_t* WT, int ldk, int dst_row0, LAS float* scr, int lane) {
#pragma unroll
    for (int i = 0; i < 8; ++i) { const int kk = (lane >> 3) + 8 * i, c4 = 4 * (lane & 7);
        f32x4 v = __builtin_nontemporal_load((const f32x4*)(W + (size_t)(k0 + kk) * ldw + n0 + c4));
        if (gain) v = v * gain[k0 + kk];
        scr[kk * 33 + c4 + 0] = v[0]; scr[kk * 33 + c4 + 1] = v[1]; scr[kk * 33 + c4 + 2] = v[2]; scr[kk * 33 + c4 + 3] = v[3]; }
    LDS_WAIT(); asm volatile("" ::: "memory");
    const int c = lane & 7;
#pragma unroll
    for (int j = 0; j < 4; ++j) { const int n = (lane >> 3) + 8 * j; const LAS float* s = scr + (8 * c) * 33 + n;
        u32x4 o; o.x = pk2(s[0 * 33], s[1 * 33]); o.y = pk2(s[2 * 33], s[3 * 33]); o.z = pk2(s[4 * 33], s[5 * 33]); o.w = pk2(s[6 * 33], s[7 * 33]);
        if (n < ncols) *(u32x4*)(WT + (size_t)(dst_row0 + n) * ldk + k0 + 8 * c) = o; }
    LDS_WAIT(); asm volatile("" ::: "memory");
}
__device__ __forceinline__ void conv_job_item(int r, const float* W, int ldw, int col0, int nblk, int ncols_last, const float* gain, bf16_t* WT, int ldk, int mode, int dst_off, LAS float* scr, int lane) {
    const int kb = r / nblk, nb = r % nblk; const int nrel = 32 * nb;
    int drow = dst_off + nrel; if (mode) drow = 256 * (nrel >> 7) + (nrel & 127) + (mode == 2 ? 128 : 0);
    conv_item(W, ldw, 64 * kb, col0 + nrel, (nb == nblk - 1) ? ncols_last : 32, gain, WT, ldk, drow, scr, lane);
}
struct ConvItem { const float* src; const float* gain; bf16_t* dst; int ldw, ldk, ncols; };
__device__ __forceinline__ ConvItem conv_desc(int r, const float* W, int ldw, int col0, int nblk, int ncols_last, const float* gain, bf16_t* WT, int ldk, int mode, int dst_off) {
    const int kb = r / nblk, nb = r % nblk; const int nrel = 32 * nb;
    int drow = dst_off + nrel; if (mode) drow = 256 * (nrel >> 7) + (nrel & 127) + (mode == 2 ? 128 : 0);
    ConvItem c; c.src = W + (size_t)(64 * kb) * ldw + col0 + nrel; c.gain = gain ? gain + 64 * kb : nullptr; c.dst = WT + (size_t)drow * ldk + 64 * kb; c.ldw = ldw; c.ldk = ldk; c.ncols = (nb == nblk - 1) ? ncols_last : 32; return c;
}
__device__ __forceinline__ void conv_ld(f32x4 (&v)[8], const ConvItem& c, int lane) {
#pragma unroll
    for (int i = 0; i < 8; ++i) { const int kk = (lane >> 3) + 8 * i, c4 = 4 * (lane & 7); v[i] = __builtin_nontemporal_load((const f32x4*)(c.src + (size_t)kk * c.ldw + c4)); }
}
__device__ __forceinline__ void conv_fin(const f32x4 (&v)[8], const ConvItem& c, LAS float* scr, int lane) {
#pragma unroll
    for (int i = 0; i < 8; ++i) { const int kk = (lane >> 3) + 8 * i, c4 = 4 * (lane & 7); f32x4 x = v[i]; if (c.gain) x = x * c.gain[kk];
        scr[kk * 33 + c4 + 0] = x[0]; scr[kk * 33 + c4 + 1] = x[1]; scr[kk * 33 + c4 + 2] = x[2]; scr[kk * 33 + c4 + 3] = x[3]; }
    LDS_WAIT(); asm volatile("" ::: "memory");
    const int cc = lane & 7;
#pragma unroll
    for (int j = 0; j < 4; ++j) { const int n = (lane >> 3) + 8 * j; const LAS float* sp = scr + (8 * cc) * 33 + n;
        u32x4 o; o.x = pk2(sp[0 * 33], sp[1 * 33]); o.y = pk2(sp[2 * 33], sp[3 * 33]); o.z = pk2(sp[4 * 33], sp[5 * 33]); o.w = pk2(sp[6 * 33], sp[7 * 33]);
        if (n < c.ncols) *(u32x4*)(c.dst + (size_t)n * c.ldk + 8 * cc) = o; }
    LDS_WAIT(); asm volatile("" ::: "memory");
}
template <class D> __device__ __forceinline__ void conv_run(const D& d, int w, int nw, int nitems, LAS float* scr, int lane) {
    f32x4 va[8], vb[8];
    int it = w; if (it >= nitems) return;
    ConvItem ca = d(it), cb = ca; conv_ld(va, ca, lane);
    for (;;) {
        const int it2 = it + nw; const bool h2 = it2 < nitems;
        if (h2) { cb = d(it2); conv_ld(vb, cb, lane); }
        conv_fin(va, ca, scr, lane);
        if (!h2) break;
        const int it3 = it2 + nw; const bool h3 = it3 < nitems;
        if (h3) { ca = d(it3); conv_ld(va, ca, lane); }
        conv_fin(vb, cb, scr, lane);
        if (!h3) break;
        it = it3;
    }
}
struct ConvG0 { const float* const* in; unsigned char* ws; __device__ __forceinline__ ConvItem operator()(int r) const { return conv_desc(r, in[2], 2560, 0, 80, 32, in[1], wsp<bf16_t>(ws, WS_WIN0), 1024, 0, 0); } };
struct ConvG1 { const float* const* in; unsigned char* ws; __device__ __forceinline__ ConvItem operator()(int it) const { constexpr int I1 = 16 * 32, I2 = 16 * 88; int r = it;
    if (r < I1) return conv_desc(r, in[20], 1024, 0, 32, 32, nullptr, wsp<bf16_t>(ws, WS_WOUT0), 1024, 0, 0); r -= I1;
    if (r < I2) return conv_desc(r, in[22], 2816, 0, 88, 32, in[21], wsp<bf16_t>(ws, WS_WGU0), 1024, 1, 0); r -= I2;
    if (r < I2) return conv_desc(r, in[23], 2816, 0, 88, 32, in[21], wsp<bf16_t>(ws, WS_WGU0), 1024, 2, 0); r -= I2;
    return conv_desc(r, in[24], 1024, 0, 32, 32, nullptr, wsp<bf16_t>(ws, WS_WD0), 2816, 0, 0); } };
struct ConvG2 { const float* const* in; unsigned char* ws; __device__ __forceinline__ ConvItem operator()(int it) const { constexpr int I5 = 16 * 64, I6 = 16 * 32, I7 = 16; int r = it;
    if (r < I5) return conv_desc(r, in[26], 3088, 0, 64, 32, in[25], wsp<bf16_t>(ws, WS_WIN1), 1024, 0, 0); r -= I5;
    if (r < I6) return conv_desc(r, in[26], 3088, 2064, 32, 32, in[25], wsp<bf16_t>(ws, WS_WIN1), 1024, 0, 2048); r -= I6;
    if (r < I7) return conv_desc(r, in[26], 3088, 2048, 1, 16, in[25], wsp<bf16_t>(ws, WS_WIN1), 1024, 0, 3072); r -= I7;
    return conv_desc(r, in[32], 1024, 0, 32, 32, nullptr, wsp<bf16_t>(ws, WS_WOUT1), 1024, 0, 0); } };
__device__ __forceinline__ void conv_group(const Frame& F, int group, int w, int nw) {
    LAS float* scr = (LAS float*)(F.lds + F.wave * 16384); const int lane = F.lane;
    if (group == 0) { ConvG0 d{F.in, F.ws}; conv_run(d, w, nw, 16 * 80, scr, lane); }
    else if (group == 1) { ConvG1 d{F.in, F.ws}; conv_run(d, w, nw, 16 * 32 + 2 * 16 * 88 + 44 * 32, scr, lane); }
    else { ConvG2 d{F.in, F.ws}; conv_run(d, w, nw, 16 * 64 + 16 * 32 + 16 + 16 * 32, scr, lane); }
}
__device__ __forceinline__ void phase_prologue(const Frame& F) {
    const int gw = F.vcu * NWAVES + F.wave, NGW = F.G * NWAVES, lane = F.lane;
    unsigned char* ws = F.ws;
    conv_group(F, 0, gw, NGW);
    if (F.G < 256) { conv_group(F, 1, gw, NGW); conv_group(F, 2, gw, NGW); }
    const int gt = F.vcu * 512 + F.tid, NGT = F.G * 512;
    { bf16_t* wlr = wsp<bf16_t>(ws, WS_WLR);
      for (int i = gt; i < 2560 * 256; i += NGT) { const int n = i >> 8, k = i & 255; float v = 0.f;
          if (n < 512)       { if (k < 64) v = F.in[5][k * 512 + n]; }
          else if (n < 1024) { if (k < 64) v = F.in[7][k * 512 + (n - 512)]; }
          else if (n < 1536) { if (k >= 64 && k < 128) v = F.in[9][(k - 64) * 512 + (n - 1024)]; }
          else if (n < 2048) { if (k >= 64 && k < 128) v = F.in[11][(k - 64) * 512 + (n - 1536)]; }
          else               { if (k >= 128) v = F.in[12][(k - 128) * 512 + (n - 2048)]; }
          wlr[i] = f2bf(v); } }
    { f32x2* rt = wsp<f32x2>(ws, WS_ROPE);
      for (int i = gt; i < SEQ * 32; i += NGT) { const int ts = i >> 5, pi = i & 31; const float freq = expf(-(float)(pi & 15) * (9.210340371976184f / 16.f));
          const float ang = ((pi >= 16) ? (float)(ts & 63) : (float)(ts >> 6)) * freq; float sn, cs; sincosf(ang, &sn, &cs); rt[i] = (f32x2){cs, sn}; } }
    { const float* x = F.in[0]; bf16_t* xb = wsp<bf16_t>(ws, WS_XB); float* ssq = wsp<float>(ws, WS_SSQ0);
      for (int m = gw; m < M_TOK; m += NGW) { const f32x4* xr = (const f32x4*)(x + (size_t)m * 1024) + lane; f32x4 v[4]; float s = 0.f;
#pragma unroll
          for (int j = 0; j < 4; ++j) { v[j] = xr[64 * j]; s += (v[j].x * v[j].x + v[j].y * v[j].y) + (v[j].z * v[j].z + v[j].w * v[j].w); }
          s = wave_sum(s);
          u32x2* o8 = (u32x2*)(xb + (size_t)m * 1024) + lane;
#pragma unroll
          for (int j = 0; j < 4; ++j) { u32x2 w; w.x = pk2(v[j].x, v[j].y); w.y = pk2(v[j].z, v[j].w); o8[64 * j] = w; }
          if (lane < 16) ssq[(size_t)m * 16 + lane] = (lane == 0) ? s : 0.f; } }
}
struct ConvEGU { const float* const* in; unsigned char* ws; int base; __device__ __forceinline__ ConvItem operator()(int it_) const { constexpr int IG = 16 * 112; const int it = it_ + base; const int e = it / (2 * IG), r = it % (2 * IG);
    bf16_t* wegu = wsp<bf16_t>(ws, A_WEGU + (e >= 6 ? WEGU_HI_SHIFT : 0)) + (size_t)e * 2 * D_FFE * 1024;
    if (r < IG) return conv_desc(r, in[35] + (size_t)e * 1024 * D_FFE, D_FFE, 0, 112, 32, in[33], wegu, 1024, 1, 0);
    return conv_desc(r - IG, in[36] + (size_t)e * 1024 * D_FFE, D_FFE, 0, 112, 32, in[33], wegu, 1024, 2, 0); } };
struct ConvED { const float* const* in; unsigned char* ws; __device__ __forceinline__ ConvItem operator()(int it) const { constexpr int ID = 56 * 32; const int e = it / ID, r = it % ID;
    return conv_desc(r, in[37] + (size_t)e * D_FFE * 1024, 1024, 0, 32, 32, nullptr, wsp<bf16_t>(ws, A_WED) + (size_t)e * 1024 * D_FFE, D_FFE, 0, 0); } };
__device__ __forceinline__ void conv_experts_gu(const Frame& F, int w, int nw, int e_lo, int e_hi) { ConvEGU d{F.in, F.ws, e_lo * 2 * 16 * 112}; conv_run(d, w, nw, (e_hi - e_lo) * 2 * 16 * 112, (LAS float*)(F.lds + F.wave * 16384), F.lane); }
__device__ __forceinline__ void conv_experts_down(const Frame& F, int w, int nw) { ConvED d{F.in, F.ws}; conv_run(d, w, nw, NEXP * 56 * 32, (LAS float*)(F.lds + F.wave * 16384), F.lane); }
__device__ __forceinline__ void phase_conv_experts(const Frame& F) {
    const int gw = F.vcu * NWAVES + F.wave, NGW = F.G * NWAVES;
    conv_experts_gu(F, gw, NGW, 0, 6);
}

__device__ __forceinline__ float dpp8_sum(float v) {
    v += __builtin_bit_cast(float, __builtin_amdgcn_update_dpp(0, __builtin_bit_cast(int, v), 0xB1, 0xF, 0xF, false));
    v += __builtin_bit_cast(float, __builtin_amdgcn_update_dpp(0, __builtin_bit_cast(int, v), 0x4E, 0xF, 0xF, false));
    v += __builtin_bit_cast(float, __builtin_amdgcn_update_dpp(0, __builtin_bit_cast(int, v), 0x141, 0xF, 0xF, false));
    return v;
}
__device__ __forceinline__ void phase_prep0(const Frame& F) {
    const int gw = F.vcu * NWAVES + F.wave, lane = F.lane;
    const bf16_t* P = wsp<bf16_t>(F.ws, A_P0);
    bf16_t *RS = wsp<bf16_t>(F.ws, A_RS), *KS = wsp<bf16_t>(F.ws, A_KS), *VS = wsp<bf16_t>(F.ws, A_VS), *NKK = wsp<bf16_t>(F.ws, A_NKK), *AP = wsp<bf16_t>(F.ws, A_AP);
    bf16_t *QH = wsp<bf16_t>(F.ws, A_QH), *KH = wsp<bf16_t>(F.ws, A_KH), *VT = wsp<bf16_t>(F.ws, A_VT0);
    const f32x2* ROPE = wsp<f32x2>(F.ws, WS_ROPE);
    float mu[4][8], kkw[8], qn8[8], kn8[8];
#pragma unroll
    for (int j = 0; j < 4; ++j)
#pragma unroll
        for (int e = 0; e < 8; ++e) { const int col = 8 * (lane + 64 * j) + e; mu[j][e] = col < RW_IN ? F.in[3][col] : 0.f; }
#pragma unroll
    for (int e = 0; e < 8; ++e) { kkw[e] = F.in[13][8 * lane + e]; qn8[e] = F.in[18][8 * (lane & 7) + e]; kn8[e] = F.in[19][8 * (lane & 7) + e]; }
    for (int g8 = gw; g8 < M_TOK / 8; g8 += F.G * NWAVES) {
        u32x4 prev[4], cur[5], nxt[4];
        { const int tok = g8 * 8; const int ts = tok & (SEQ - 1);
#pragma unroll
          for (int j = 0; j < 5; ++j) cur[j] = *(const u32x4*)(P + (size_t)tok * E_IN + 8 * (lane + 64 * j));
#pragma unroll
          for (int j = 0; j < 4; ++j) prev[j] = (ts > 0) ? *(const u32x4*)(P + (size_t)(tok - 1) * E_IN + 8 * (lane + 64 * j)) : (u32x4){0u, 0u, 0u, 0u}; }
        for (int tt = 0; tt < 8; ++tt) { const int tok = g8 * 8 + tt; const int ts = tok & (SEQ - 1); const int bb = tok >> 11;
            u32x4 ncur4 = (u32x4){0u, 0u, 0u, 0u};
#pragma unroll
            for (int j = 0; j < 4; ++j) nxt[j] = (ts < SEQ - 1) ? *(const u32x4*)(P + (size_t)(tok + 1) * E_IN + 8 * (lane + 64 * j)) : (u32x4){0u, 0u, 0u, 0u};
            if (tt < 7) ncur4 = *(const u32x4*)(P + (size_t)(tok + 1) * E_IN + 8 * (lane + 256));
            const f32x4 rp0 = *(const f32x4*)(ROPE + (size_t)ts * 32 + 4 * (lane & 7)), rp1 = *(const f32x4*)(ROPE + (size_t)ts * 32 + 4 * (lane & 7) + 2);
            const float cs4[4] = {rp0[0], rp0[2], rp1[0], rp1[2]}, sn4[4] = {rp0[1], rp0[3], rp1[1], rp1[3]};
            float s[4][8];
#pragma unroll
            for (int j = 0; j < 4; ++j) { float c[8], p[8], n[8]; unpack8(cur[j], c); unpack8(prev[j], p); unpack8(nxt[j], n);
#pragma unroll
                for (int e = 0; e < 8; ++e) s[j][e] = c[e] + (0.5f * (p[e] + n[e]) - c[e]) * mu[j][e]; }
            const size_t o512 = (size_t)tok * 512 + 8 * lane;
            *(u32x4*)(RS + o512) = pack8f(s[0]); *(u32x4*)(KS + o512) = pack8f(s[1]); *(u32x4*)(VS + o512) = pack8f(s[2]);
            { float kr[8]; float ss = 0.f;
#pragma unroll
              for (int e = 0; e < 8; ++e) { kr[e] = s[1][e] * kkw[e]; ss += kr[e] * kr[e]; }
              ss = dpp8_sum(ss); const float inv = -1.f / fmaxf(sqrtf(ss), 1e-12f);
#pragma unroll
              for (int e = 0; e < 8; ++e) kr[e] *= inv;
              *(u32x4*)(NKK + o512) = pack8f(kr); }
            float x3[8], x4[8]; unpack8(cur[3], x3); unpack8(cur[4], x4);
            { float ap[8];
#pragma unroll
              for (int e = 0; e < 8; ++e) ap[e] = lane < 8 ? tanhf(s[3][e]) : (lane < 16 ? s[3][e] : sigmoidf_(s[3][e]));
              if (lane < 32) *(u32x4*)(AP + (size_t)tok * 256 + 8 * lane) = pack8f(ap); }
#pragma unroll
            for (int which = 0; which < 2; ++which) { float (&x)[8] = which ? x4 : x3; float ss = 0.f;
#pragma unroll
                for (int e = 0; e < 8; ++e) ss += x[e] * x[e];
                ss = dpp8_sum(ss); const float rs = 1.0f / sqrtf(ss * (1.f / 64.f) + NORM_EPS);
                const bool isk = which && lane >= 32; float o[8];
#pragma unroll
                for (int p = 0; p < 4; ++p) { const float x0 = x[2 * p] * rs * (isk ? kn8[2 * p] : qn8[2 * p]), x1 = x[2 * p + 1] * rs * (isk ? kn8[2 * p + 1] : qn8[2 * p + 1]);
                    o[2 * p] = x0 * cs4[p] - x1 * sn4[p]; o[2 * p + 1] = x0 * sn4[p] + x1 * cs4[p]; }
                if (!isk) {
#pragma unroll
                    for (int e = 0; e < 8; ++e) o[e] *= 0.18033688011112042f; }
                if (which == 0) { if (lane >= 32) *(u32x4*)(QH + (size_t)tok * 512 + 8 * (lane - 32)) = pack8f(o); }
                else { if (lane < 32) *(u32x4*)(QH + (size_t)tok * 512 + 256 + 8 * lane) = pack8f(o);
                       else if (lane < 48) *(u32x4*)(KH + (size_t)tok * 128 + 8 * (lane - 32)) = pack8f(o); } }
            if (lane >= 48) { const int g = (lane - 48) >> 3, d0 = 8 * ((lane - 48) & 7); const unsigned w[4] = {cur[4].x, cur[4].y, cur[4].z, cur[4].w};
#pragma unroll
                for (int e = 0; e < 8; ++e) VT[((size_t)(bb * 2 + g) * 64 + d0 + e) * SEQ + ts] = (bf16_t)((e & 1) ? (w[e >> 1] >> 16) : (w[e >> 1] & 0xffffu)); }
#pragma unroll
            for (int j = 0; j < 4; ++j) { prev[j] = cur[j]; cur[j] = nxt[j]; }
            cur[4] = ncur4;
        }
    }
}

__device__ __forceinline__ float dpp_row_sum(float v) {
    v += __builtin_bit_cast(float, __builtin_amdgcn_update_dpp(0, __builtin_bit_cast(int, v), 0xB1, 0xF, 0xF, false));
    v += __builtin_bit_cast(float, __builtin_amdgcn_update_dpp(0, __builtin_bit_cast(int, v), 0x4E, 0xF, 0xF, false));
    v += __builtin_bit_cast(float, __builtin_amdgcn_update_dpp(0, __builtin_bit_cast(int, v), 0x141, 0xF, 0xF, false));
    v += __builtin_bit_cast(float, __builtin_amdgcn_update_dpp(0, __builtin_bit_cast(int, v), 0x140, 0xF, 0xF, false));
    return v;
}
constexpr int SC_STEPS = 32, SC_STRIDE = 352, SC_BUF = SC_STEPS * SC_STRIDE;
__device__ __forceinline__ float dpp_row8_sum(float v) {
    v += __builtin_bit_cast(float, __builtin_amdgcn_update_dpp(0, __builtin_bit_cast(int, v), 0xB1, 0xF, 0xF, false));
    v += __builtin_bit_cast(float, __builtin_amdgcn_update_dpp(0, __builtin_bit_cast(int, v), 0x4E, 0xF, 0xF, false));
    v += __builtin_bit_cast(float, __builtin_amdgcn_update_dpp(0, __builtin_bit_cast(int, v), 0x141, 0xF, 0xF, false));
    return v;
}
struct ScOps { f32x2 w[4], kd[4], a[4], b[4], r[4]; float v; };
__device__ __forceinline__ void sc_ld(ScOps& o, const LAS float* bs, const LAS float* vp) {
#pragma unroll
    for (int i = 0; i < 2; ++i) {
        const f32x4 w4 = *(const LAS f32x4*)(bs + 4 * i), k4 = *(const LAS f32x4*)(bs + 64 + 4 * i), a4 = *(const LAS f32x4*)(bs + 128 + 4 * i), b4 = *(const LAS f32x4*)(bs + 192 + 4 * i), r4 = *(const LAS f32x4*)(bs + 256 + 4 * i);
        o.w[2 * i] = (f32x2){w4[0], w4[1]}; o.w[2 * i + 1] = (f32x2){w4[2], w4[3]}; o.kd[2 * i] = (f32x2){k4[0], k4[1]}; o.kd[2 * i + 1] = (f32x2){k4[2], k4[3]};
        o.a[2 * i] = (f32x2){a4[0], a4[1]}; o.a[2 * i + 1] = (f32x2){a4[2], a4[3]}; o.b[2 * i] = (f32x2){b4[0], b4[1]}; o.b[2 * i + 1] = (f32x2){b4[2], b4[3]};
        o.r[2 * i] = (f32x2){r4[0], r4[1]}; o.r[2 * i + 1] = (f32x2){r4[2], r4[3]}; }
    o.v = *vp;
}
template <int DIR> __device__ __forceinline__ float sc_step(f32x2 (&s)[4], const ScOps& o) {
    f32x2 u[4];
#pragma unroll
    for (int i = 0; i < 4; ++i) u[i] = o.kd[i] * o.v;
    f32x2 p = s[0] * o.a[0], q = s[1] * o.a[1];
    p = __builtin_elementwise_fma(s[2], o.a[2], p); q = __builtin_elementwise_fma(s[3], o.a[3], q); p = p + q;
    float sa = dpp_row8_sum(p[0] + p[1]);
    f32x2 yp, yq;
    if (DIR) { yp = s[0] * o.r[0]; yq = s[1] * o.r[1]; yp = __builtin_elementwise_fma(s[2], o.r[2], yp); yq = __builtin_elementwise_fma(s[3], o.r[3], yq); }
    const f32x2 sa2 = {sa, sa};
#pragma unroll
    for (int i = 0; i < 4; ++i) { const f32x2 t = __builtin_elementwise_fma(o.b[i], sa2, u[i]); s[i] = __builtin_elementwise_fma(s[i], o.w[i], t); }
    if (!DIR) { yp = s[0] * o.r[0]; yq = s[1] * o.r[1]; yp = __builtin_elementwise_fma(s[2], o.r[2], yp); yq = __builtin_elementwise_fma(s[3], o.r[3], yq); }
    yp = yp + yq;
    return dpp_row8_sum(yp[0] + yp[1]);
}
__device__ __forceinline__ void attn_tile_step(const LAS unsigned char* kb, const LAS unsigned char* vb, const bf16x8 (&q)[4], f32x16& o0, f32x16& o1, float& mrun, float& lrun, int r32, int hi) {
    f32x16 c0 = {}, c1 = {};
#pragma unroll
    for (int s4 = 0; s4 < 4; ++s4) { const int chk = 2 * s4 + hi;
        const bf16x8 k0 = *(const LAS bf16x8*)(kb + r32 * 128 + ((chk ^ (r32 & 7)) * 16));
        const bf16x8 k1 = *(const LAS bf16x8*)(kb + (32 + r32) * 128 + ((chk ^ (r32 & 7)) * 16));
        c0 = __builtin_amdgcn_mfma_f32_32x32x16_bf16(k0, q[s4], c0, 0, 0, 0);
        c1 = __builtin_amdgcn_mfma_f32_32x32x16_bf16(k1, q[s4], c1, 0, 0, 0); }
    float mx = c0[0];
#pragma unroll
    for (int r = 0; r < 16; ++r) { mx = fmaxf(mx, c0[r]); mx = fmaxf(mx, c1[r]); }
    mx = fmaxf(mx, __shfl_xor(mx, 32));
    const float mnew = fmaxf(mrun, mx); const float alpha = __builtin_amdgcn_exp2f(mrun - mnew); mrun = mnew;
    float ls = 0.f;
#pragma unroll
    for (int r = 0; r < 16; ++r) { c0[r] = __builtin_amdgcn_exp2f(c0[r] - mnew); c1[r] = __builtin_amdgcn_exp2f(c1[r] - mnew); ls += c0[r] + c1[r]; }
    lrun = lrun * alpha + ls;
#pragma unroll
    for (int r = 0; r < 16; ++r) { o0[r] *= alpha; o1[r] *= alpha; }
    u32x4 w00, w01, w10, w11;
    w00.x = pk2(c0[0], c0[1]); w00.y = pk2(c0[2], c0[3]); w00.z = pk2(c0[4], c0[5]); w00.w = pk2(c0[6], c0[7]);
    w01.x = pk2(c0[8], c0[9]); w01.y = pk2(c0[10], c0[11]); w01.z = pk2(c0[12], c0[13]); w01.w = pk2(c0[14], c0[15]);
    w10.x = pk2(c1[0], c1[1]); w10.y = pk2(c1[2], c1[3]); w10.z = pk2(c1[4], c1[5]); w10.w = pk2(c1[6], c1[7]);
    w11.x = pk2(c1[8], c1[9]); w11.y = pk2(c1[10], c1[11]); w11.z = pk2(c1[12], c1[13]); w11.w = pk2(c1[14], c1[15]);
    const bf16x8 p00 = __builtin_bit_cast(bf16x8, w00), p01 = __builtin_bit_cast(bf16x8, w01), p10 = __builtin_bit_cast(bf16x8, w10), p11 = __builtin_bit_cast(bf16x8, w11);
#define AT_VF(dd_, chk_) ({ const int sw_ = ((dd_) >> 1) & 7; const u32x2 lo_ = *(const LAS u32x2*)(vb + (dd_) * 128 + (((chk_) ^ sw_) * 16) + hi * 8); \
        const u32x2 hh_ = *(const LAS u32x2*)(vb + (dd_) * 128 + ((((chk_) + 1) ^ sw_) * 16) + hi * 8); const u32x4 vv_ = {lo_.x, lo_.y, hh_.x, hh_.y}; __builtin_bit_cast(bf16x8, vv_); })
    o0 = __builtin_amdgcn_mfma_f32_32x32x16_bf16(AT_VF(r32, 0), p00, o0, 0, 0, 0);
    o0 = __builtin_amdgcn_mfma_f32_32x32x16_bf16(AT_VF(r32, 2), p01, o0, 0, 0, 0);
    o0 = __builtin_amdgcn_mfma_f32_32x32x16_bf16(AT_VF(r32, 4), p10, o0, 0, 0, 0);
    o0 = __builtin_amdgcn_mfma_f32_32x32x16_bf16(AT_VF(r32, 6), p11, o0, 0, 0, 0);
    o1 = __builtin_amdgcn_mfma_f32_32x32x16_bf16(AT_VF(32 + r32, 0), p00, o1, 0, 0, 0);
    o1 = __builtin_amdgcn_mfma_f32_32x32x16_bf16(AT_VF(32 + r32, 2), p01, o1, 0, 0, 0);
    o1 = __builtin_amdgcn_mfma_f32_32x32x16_bf16(AT_VF(32 + r32, 4), p10, o1, 0, 0, 0);
    o1 = __builtin_amdgcn_mfma_f32_32x32x16_bf16(AT_VF(32 + r32, 6), p11, o1, 0, 0, 0);
#undef AT_VF
}
__device__ __forceinline__ void attn_store(bf16_t* op, const f32x16& o0, const f32x16& o1, float lrun) {
    const float ltot = lrun + __shfl_xor(lrun, 32); const float inv = 1.f / ltot;
#pragma unroll
    for (int q4 = 0; q4 < 4; ++q4) { u32x2 w0, w1;
        w0.x = pk2(o0[4 * q4 + 0] * inv, o0[4 * q4 + 1] * inv); w0.y = pk2(o0[4 * q4 + 2] * inv, o0[4 * q4 + 3] * inv);
        w1.x = pk2(o1[4 * q4 + 0] * inv, o1[4 * q4 + 1] * inv); w1.y = pk2(o1[4 * q4 + 2] * inv, o1[4 * q4 + 3] * inv);
        *(u32x2*)(op + 8 * q4) = w0; *(u32x2*)(op + 32 + 8 * q4) = w1; }
}
template <int DIR> __device__ __forceinline__ void scan_job(const Frame& F, int b, int h, int half, int job) {
    LAS float* buf = (LAS float*)F.lds; LAS float* ybuf = buf + 2 * SC_BUF;
    const int tid = F.tid, lane = F.lane, wave = F.wave;
    const bf16_t* s0 = wsp<bf16_t>(F.ws, DIR ? A_LWB : A_LWF); const bf16_t* s1 = wsp<bf16_t>(F.ws, DIR ? A_KDB : A_KDF); const bf16_t* s2 = wsp<bf16_t>(F.ws, A_NKK);
    const bf16_t* s3 = wsp<bf16_t>(F.ws, DIR ? A_BBB : A_BBF); const bf16_t* s4 = wsp<bf16_t>(F.ws, A_RS); const bf16_t* s5 = wsp<bf16_t>(F.ws, A_VS);
    float* Y = wsp<float>(F.ws, DIR ? A_YB : A_YF);
    constexpr int NCH = SEQ / SC_STEPS;
    const int htid = tid - 256;
#define SC_STAGE_LD(ch) do { const int step_ = ht_ >> 3, sub_ = ht_ & 7; \
        const int sq_ = (ch) * SC_STEPS + step_; const size_t to_ = (size_t)(b * SEQ + (DIR ? (SEQ - 1 - sq_) : sq_)) * 512 + h * 64 + 8 * sub_; \
        sst[0] = *(const u32x4*)(s0 + to_); sst[1] = *(const u32x4*)(s1 + to_); sst[2] = *(const u32x4*)(s2 + to_); sst[3] = *(const u32x4*)(s3 + to_); sst[4] = *(const u32x4*)(s4 + to_); \
        if (sub_ < 4) sst[5] = *(const u32x4*)(s5 + to_ + half * 32); } while (0)
#define SC_STAGE_ST(bufp) do { const int step_ = ht_ >> 3, sub_ = ht_ & 7; LAS float* d_ = (bufp) + step_ * SC_STRIDE + 8 * sub_; \
        _Pragma("unroll") for (int i_ = 0; i_ < 6; ++i_) { if (i_ < 5 || sub_ < 4) { \
            f32x4 lo_ = {bflo(sst[i_].x), bfhi(sst[i_].x), bflo(sst[i_].y), bfhi(sst[i_].y)}, hi_ = {bflo(sst[i_].z), bfhi(sst[i_].z), bflo(sst[i_].w), bfhi(sst[i_].w)}; \
            if (i_ == 0) { _Pragma("unroll") for (int e_ = 0; e_ < 4; ++e_) { lo_[e_] = __builtin_amdgcn_exp2f(lo_[e_]); hi_[e_] = __builtin_amdgcn_exp2f(hi_[e_]); } } \
            *(LAS f32x4*)(d_ + i_ * 64) = lo_; *(LAS f32x4*)(d_ + i_ * 64 + 4) = hi_; } } } while (0)
#define SC_STAGE(ch, bufp) do { SC_STAGE_LD(ch); SC_STAGE_ST(bufp); } while (0)
#define SC_FLUSH(ch) do { const LAS float* yb_ = ybuf + ((ch) & 1) * 1024; const int step_ = ht_ >> 3, c_ = ht_ & 7; const int sq_ = (ch) * SC_STEPS + step_; const int tok_ = b * SEQ + (DIR ? (SEQ - 1 - sq_) : sq_); \
        *(f32x4*)(Y + (size_t)tok_ * 512 + h * 64 + half * 32 + 4 * c_) = *(const LAS f32x4*)(yb_ + step_ * 32 + 4 * c_); } while (0)
    LAS unsigned char* alds = F.lds + 98304;
    const int hw = wave - 4;
    const bf16_t *QH = wsp<bf16_t>(F.ws, A_QH), *KH = wsp<bf16_t>(F.ws, A_KH), *VT0 = wsp<bf16_t>(F.ws, A_VT0); bf16_t* YC = wsp<bf16_t>(F.ws, A_YCAT);
    u32x4 sst[6];
    bf16x8 qfA[4], qfB[4]; f32x16 oA0 = {}, oA1 = {}, oB0 = {}, oB1 = {}; float mA = -1e30f, mB = -1e30f, lA = 0.f, lB = 0.f;
#define AT_UNIT(ch_) (2 * job + ((ch_) >> 5))
#define AT_LOAD(ch_) do { const int u_ = AT_UNIT(ch_), t_ = (ch_) & 31; const int ab_ = u_ >> 6, ag_ = (u_ >> 5) & 1; \
        _Pragma("unroll") for (int i_ = 0; i_ < 2; ++i_) { const int p_ = ht_ + 256 * i_, key_ = p_ >> 3, c_ = p_ & 7; \
            akst[i_] = *(const u32x4*)(KH + (size_t)(ab_ * SEQ + 64 * t_ + key_) * 128 + ag_ * 64 + 8 * c_); \
            avst[i_] = *(const u32x4*)(VT0 + ((size_t)(ab_ * 2 + ag_) * 64 + key_) * SEQ + 64 * t_ + 8 * c_); } } while (0)
#define AT_STORE(ch_) do { const int bo_ = ((ch_) & 1) * 8192; \
        _Pragma("unroll") for (int i_ = 0; i_ < 2; ++i_) { const int p_ = ht_ + 256 * i_, key_ = p_ >> 3, c_ = p_ & 7; \
            *(LAS u32x4*)(alds + bo_ + key_ * 128 + ((c_ ^ (key_ & 7)) * 16)) = akst[i_]; \
            *(LAS u32x4*)(alds + 16384 + bo_ + key_ * 128 + ((c_ ^ ((key_ >> 1) & 7)) * 16)) = avst[i_]; } } while (0)
#define AT_DMA(ch_) do { const int u_ = AT_UNIT(ch_), t_ = (ch_) & 31; const int ab_ = u_ >> 6, ag_ = (u_ >> 5) & 1; const int bo_ = ((ch_) & 1) * 8192; \
        _Pragma("unroll") for (int i_ = 0; i_ < 2; ++i_) { const int p_ = (hw * 2 + i_) * 64 + ln_, row_ = p_ >> 3, cp_ = p_ & 7; \
            __builtin_amdgcn_global_load_lds((const unsigned*)(KH + (size_t)(ab_ * SEQ + 64 * t_ + row_) * 128 + ag_ * 64 + 8 * (cp_ ^ (row_ & 7))), (LAS unsigned*)(alds + bo_ + (hw * 2 + i_) * 1024), 16, 0, 0); \
            __builtin_amdgcn_global_load_lds((const unsigned*)(VT0 + ((size_t)(ab_ * 2 + ag_) * 64 + row_) * SEQ + 64 * t_ + 8 * (cp_ ^ ((row_ >> 1) & 7))), (LAS unsigned*)(alds + 16384 + bo_ + (hw * 2 + i_) * 1024), 16, 0, 0); } } while (0)
    __syncthreads();
    if (wave >= 4) { int ht_ = htid; asm volatile("" : "+v"(ht_)); const int ln_ = ht_ & 63; SC_STAGE(0, buf); AT_DMA(0); asm volatile("s_waitcnt vmcnt(0)" ::: "memory"); }
    __syncthreads();
    if (wave < 4) {
        __builtin_amdgcn_s_setprio(3);
        const int row = lane >> 3, kg = lane & 7, rowl = wave * 8 + row;
        f32x2 s[4] = {(f32x2){0.f, 0.f}, (f32x2){0.f, 0.f}, (f32x2){0.f, 0.f}, (f32x2){0.f, 0.f}};
        for (int ch = 0; ch < NCH; ++ch) {
            const LAS float* bc = buf + (ch & 1) * SC_BUF + 8 * kg; const LAS float* vc = buf + (ch & 1) * SC_BUF + 320 + rowl; LAS float* yb = ybuf + (ch & 1) * 1024 + rowl;
            ScOps oa, ob; sc_ld(oa, bc, vc);
#pragma unroll 2
            for (int step = 0; step < SC_STEPS; step += 2) {
                sc_ld(ob, bc + (step + 1) * SC_STRIDE, vc + (step + 1) * SC_STRIDE);
                const float y0 = sc_step<DIR>(s, oa); yb[step * 32] = y0;
                if (step + 2 < SC_STEPS) sc_ld(oa, bc + (step + 2) * SC_STRIDE, vc + (step + 2) * SC_STRIDE);
                const float y1 = sc_step<DIR>(s, ob); yb[(step + 1) * 32] = y1; }
            __syncthreads();
        }
        __builtin_amdgcn_s_setprio(0);
    } else {
        for (int ch = 0; ch < NCH; ++ch) {
            int ht_ = htid; asm volatile("" : "+v"(ht_));
            int ln_ = lane; asm volatile("" : "+v"(ln_)); const int r32 = ln_ & 31, hi = ln_ >> 5;
            if (ch > 0) SC_FLUSH(ch - 1);
            if (ch + 1 < NCH) { AT_DMA(ch + 1); SC_STAGE_LD(ch + 1); }
            __builtin_amdgcn_sched_barrier(0);
            const int u = AT_UNIT(ch), t = ch & 31; const int ab = u >> 6, ag = (u >> 5) & 1, aqt = u & 31; const int head = 4 * ag + hw;
            const int qrowA = ab * SEQ + aqt * 64 + r32, qrowB = qrowA + 32;
            if (t == 0) {
#pragma unroll
                for (int s4 = 0; s4 < 4; ++s4) { qfA[s4] = *(const bf16x8*)(QH + (size_t)qrowA * 512 + head * 64 + 16 * s4 + 8 * hi); qfB[s4] = *(const bf16x8*)(QH + (size_t)qrowB * 512 + head * 64 + 16 * s4 + 8 * hi); }
                oA0 = f32x16{}; oA1 = f32x16{}; oB0 = f32x16{}; oB1 = f32x16{}; mA = -1e30f; mB = -1e30f; lA = 0.f; lB = 0.f; }
            { const LAS unsigned char* kb = alds + (ch & 1) * 8192; const LAS unsigned char* vb = alds + 16384 + (ch & 1) * 8192;
              __builtin_amdgcn_sched_barrier(0);
              attn_tile_step(kb, vb, qfA, oA0, oA1, mA, lA, r32, hi);
              __builtin_amdgcn_sched_barrier(0);
              if (ch + 1 < NCH) { SC_STAGE_ST(buf + ((ch + 1) & 1) * SC_BUF); }
              __builtin_amdgcn_sched_barrier(0);
              attn_tile_step(kb, vb, qfB, oB0, oB1, mB, lB, r32, hi);
              __builtin_amdgcn_sched_barrier(0); }
            if (t == 31) { attn_store(YC + (size_t)qrowA * 1024 + 512 + head * 64 + 4 * hi, oA0, oA1, lA); attn_store(YC + (size_t)qrowB * 1024 + 512 + head * 64 + 4 * hi, oB0, oB1, lB); }
            asm volatile("s_waitcnt vmcnt(0)" ::: "memory");
            __syncthreads();
        }
        { int ht_ = htid; asm volatile("" : "+v"(ht_)); SC_FLUSH(NCH - 1); }
    }
#undef AT_UNIT
#undef AT_LOAD
#undef AT_STORE
#undef SC_STAGE
#undef SC_STAGE_LD
#undef SC_STAGE_ST
#undef SC_FLUSH
}
constexpr int CS_SLOT = 9216, CS_RS = 144;
__device__ __forceinline__ void cs_mm(f32x4 (&acc)[2], const LAS unsigned char* L, const LAS unsigned char* Rt, int mi, int ni0, int fr, int fq) {
#pragma unroll
    for (int s2 = 0; s2 < 2; ++s2) { const bf16x8 a = *(const LAS bf16x8*)(L + (16 * mi + fr) * CS_RS + (32 * s2 + 8 * fq) * 2);
#pragma unroll
        for (int jj = 0; jj < 2; ++jj) { const bf16x8 bb = *(const LAS bf16x8*)(Rt + (16 * (ni0 + jj) + fr) * CS_RS + (32 * s2 + 8 * fq) * 2);
            acc[jj] = __builtin_amdgcn_mfma_f32_16x16x32_bf16(a, bb, acc[jj], 0, 0, 0); } }
}
__device__ __forceinline__ void cs_st_t8(LAS unsigned char* dst, const f32x4 (&acc)[2], int mi, int ni0, int fr, int fq) {
#pragma unroll
    for (int jj = 0; jj < 2; ++jj) { u32x2 w; w.x = pk2(acc[jj][0], acc[jj][1]); w.y = pk2(acc[jj][2], acc[jj][3]);
        *(LAS u32x2*)(dst + (16 * (ni0 + jj) + fr) * CS_RS + (16 * mi + 4 * fq) * 2) = w; }
}
__device__ __forceinline__ void cs_st_sc(LAS unsigned char* dst, const f32x4 (&acc)[2], int mi, int ni0, int fr, int fq) {
#pragma unroll
    for (int jj = 0; jj < 2; ++jj)
#pragma unroll
        for (int r = 0; r < 4; ++r) *(LAS bf16_t*)(dst + (16 * mi + 4 * fq + r) * CS_RS + (16 * (ni0 + jj) + fr) * 2) = f2bf(acc[jj][r]);
}
__device__ __forceinline__ void cs_ld_t8(f32x4 (&acc)[2], const LAS unsigned char* src, int mi, int ni0, int fr, int fq) {
#pragma unroll
    for (int jj = 0; jj < 2; ++jj) { const u32x2 w = *(const LAS u32x2*)(src + (16 * (ni0 + jj) + fr) * CS_RS + (16 * mi + 4 * fq) * 2);
        acc[jj] = (f32x4){bflo(w.x), bfhi(w.x), bflo(w.y), bfhi(w.y)}; }
}
#define CS_ZERO(acc) do { acc[0] = (f32x4){0.f, 0.f, 0.f, 0.f}; acc[1] = acc[0]; } while (0)
typedef short v4i16_t __attribute__((ext_vector_type(4)));
template <int RS = CS_RS> __device__ __forceinline__ bf16x8 cs_afrag_tr(const LAS unsigned char* LT, int mi, int s2, int fr, int fq) {
    const LAS unsigned char* p = LT + (32 * s2 + 8 * fq + (fr >> 2)) * RS + (16 * mi + 4 * (fr & 3)) * 2;
    const v4i16_t lo = __builtin_amdgcn_ds_read_tr16_b64_v4i16((LAS v4i16_t*)p);
    const v4i16_t hi = __builtin_amdgcn_ds_read_tr16_b64_v4i16((LAS v4i16_t*)(p + 4 * RS));
    return (bf16x8){lo[0], lo[1], lo[2], lo[3], hi[0], hi[1], hi[2], hi[3]};
}
__device__ __forceinline__ void cs_mm_tr(f32x4 (&acc)[2], const LAS unsigned char* LT, const LAS unsigned char* Rt, int mi, int ni0, int fr, int fq) {
#pragma unroll
    for (int s2 = 0; s2 < 2; ++s2) { const bf16x8 a = cs_afrag_tr(LT, mi, s2, fr, fq);
#pragma unroll
        for (int jj = 0; jj < 2; ++jj) { const bf16x8 bb = *(const LAS bf16x8*)(Rt + (16 * (ni0 + jj) + fr) * CS_RS + (32 * s2 + 8 * fq) * 2);
            acc[jj] = __builtin_amdgcn_mfma_f32_16x16x32_bf16(a, bb, acc[jj], 0, 0, 0); } }
}
__device__ __forceinline__ void cs_mm_tr2(f32x4 (&aU)[2], f32x4 (&aS)[2], const LAS unsigned char* LUT, const LAS unsigned char* LST, const LAS unsigned char* Rt, bool doS, int mi, int ni0, int fr, int fq) {
#pragma unroll
    for (int s2 = 0; s2 < 2; ++s2) { const bf16x8 au = cs_afrag_tr(LUT, mi, s2, fr, fq); const bf16x8 as = cs_afrag_tr(LST, mi, s2, fr, fq);
#pragma unroll
        for (int jj = 0; jj < 2; ++jj) { const bf16x8 bb = *(const LAS bf16x8*)(Rt + (16 * (ni0 + jj) + fr) * CS_RS + (32 * s2 + 8 * fq) * 2);
            aU[jj] = __builtin_amdgcn_mfma_f32_16x16x32_bf16(au, bb, aU[jj], 0, 0, 0);
            if (doS) aS[jj] = __builtin_amdgcn_mfma_f32_16x16x32_bf16(as, bb, aS[jj], 0, 0, 0); } }
}
__device__ __forceinline__ void cs_mask(f32x4 (&acc)[2], int mi, int ni0, int fr, int fq, int mode) {
#pragma unroll
    for (int jj = 0; jj < 2; ++jj) { const int ni = ni0 + jj;
        const bool keep_all = (mode == 1) ? (ni < mi) : (ni > mi), diag = (ni == mi);
        if (diag) {
#pragma unroll
            for (int r = 0; r < 4; ++r) { const int ml = 4 * fq + r; const bool k = (mode == 0) ? (ml < fr) : (mode == 1) ? (fr < ml) : (ml <= fr); if (!k) acc[jj][r] = 0.f; }
        } else if (!keep_all) acc[jj] = (f32x4){0.f, 0.f, 0.f, 0.f}; }
}
template <int DIR> __device__ __forceinline__ void cscan_job(const Frame& F, int b, int h) {
    const int tid = F.tid, lane = F.lane, wave = F.wave, fr = lane & 15, fq = lane >> 4;
    LAS unsigned char* L0 = F.lds;
#define SL(i) (L0 + (i) * CS_SLOT)
    LAS float* Dl = (LAS float*)(SL(14) + 8704);
    const bf16_t* g0 = wsp<bf16_t>(F.ws, DIR ? A_LWB : A_LWF); const bf16_t* g1 = wsp<bf16_t>(F.ws, DIR ? A_KDB : A_KDF); const bf16_t* g2 = wsp<bf16_t>(F.ws, A_NKK);
    const bf16_t* g3 = wsp<bf16_t>(F.ws, DIR ? A_BBB : A_BBF); const bf16_t* g4 = wsp<bf16_t>(F.ws, A_RS); const bf16_t* g5 = wsp<bf16_t>(F.ws, A_VS);
    bf16_t* Y = wsp<bf16_t>(F.ws, DIR ? A_YB : A_YF);
    const int mi = wave >> 1, ni0 = 2 * (wave & 1);
    const int rt_ = tid >> 3, rc_ = tid & 7;
    const int ek = tid & 63, etq = tid >> 6;
    u32x4 raw[5], rawv, rawv_cur; bf16_t lwn[8];
#define CS_LOAD(n_) do { const int sq_ = 64 * (n_) + rt_; const size_t to_ = (size_t)(b * SEQ + (DIR ? (SEQ - 1 - sq_) : sq_)) * 512 + h * 64; \
        raw[1] = *(const u32x4*)(g1 + to_ + 8 * rc_); raw[2] = *(const u32x4*)(g2 + to_ + 8 * rc_); raw[3] = *(const u32x4*)(g3 + to_ + 8 * rc_); raw[4] = *(const u32x4*)(g4 + to_ + 8 * rc_); \
        rawv = *(const u32x4*)(g5 + to_ + 8 * rc_); \
        _Pragma("unroll") for (int j_ = 0; j_ < 8; ++j_) { const int sq2_ = 64 * (n_) + 8 * etq + j_; lwn[j_] = g0[(size_t)(b * SEQ + (DIR ? (SEQ - 1 - sq2_) : sq2_)) * 512 + h * 64 + ek]; } } while (0)
    __syncthreads();
    for (int i = tid; i < 8704 / 4; i += 512) ((LAS unsigned*)SL(14))[i] = 0u;
    CS_LOAD(0);
    for (int n = 0; n < 32; ++n) {
        float lwv[8], cw[8];
#pragma unroll
        for (int j = 0; j < 8; ++j) lwv[j] = bf2f(lwn[j]);
        cw[0] = lwv[0];
#pragma unroll
        for (int j = 1; j < 8; ++j) cw[j] = cw[j - 1] + lwv[j];
        LAS float* PART = (LAS float*)SL(12);
        PART[etq * 64 + ek] = cw[7];
#pragma unroll
        for (int q = 1; q < 5; ++q) *(LAS u32x4*)(SL(7 + q) + rt_ * CS_RS + rc_ * 16) = raw[q];
        rawv_cur = rawv;
        if (n + 1 < 32) CS_LOAD(n + 1);
        __syncthreads();
        { float off = 0.f, tot = 0.f;
#pragma unroll
          for (int q = 0; q < 8; ++q) { const float p = PART[q * 64 + ek]; tot += p; if (q < etq) off += p; }
          const float ec = __builtin_amdgcn_exp2f(tot);
          if (etq == 0) Dl[ek] = ec;
          unsigned pa[4], pbh[4], pkh[4];
#pragma unroll
          for (int j = 0; j < 8; ++j) { const int t = 8 * etq + j; const float c = cw[j] + off, cp = c - lwv[j];
              const float e1 = __builtin_amdgcn_exp2f(c), em = __builtin_amdgcn_exp2f(-c), ep = __builtin_amdgcn_exp2f(cp);
              const float kdv = bf2f(*(const LAS bf16_t*)(SL(8) + t * CS_RS + ek * 2)), av = bf2f(*(const LAS bf16_t*)(SL(9) + t * CS_RS + ek * 2));
              const float bv = bf2f(*(const LAS bf16_t*)(SL(10) + t * CS_RS + ek * 2)), rv = bf2f(*(const LAS bf16_t*)(SL(11) + t * CS_RS + ek * 2));
              const float at = av * ep, bt = bv * em, kt = kdv * em, rtv = rv * (DIR ? ep : e1), bh = bt * ec, kh = kt * ec;
              const unsigned w01 = pk2(at, bt), w23 = pk2(kt, rtv);
              *(LAS bf16_t*)(SL(0) + t * CS_RS + ek * 2) = (bf16_t)(w01 & 0xffffu); *(LAS bf16_t*)(SL(1) + t * CS_RS + ek * 2) = (bf16_t)(w01 >> 16);
              *(LAS bf16_t*)(SL(2) + t * CS_RS + ek * 2) = (bf16_t)(w23 & 0xffffu); *(LAS bf16_t*)(SL(3) + t * CS_RS + ek * 2) = (bf16_t)(w23 >> 16);
              const unsigned hbk = pk2(bh, kh); const unsigned ha = w01 & 0xffffu, hb = hbk & 0xffffu, hk = hbk >> 16;
              if (j & 1) { pa[j >> 1] |= ha << 16; pbh[j >> 1] |= hb << 16; pkh[j >> 1] |= hk << 16; } else { pa[j >> 1] = ha; pbh[j >> 1] = hb; pkh[j >> 1] = hk; } }
          *(LAS u32x4*)(SL(4) + ek * CS_RS + etq * 16) = (u32x4){pa[0], pa[1], pa[2], pa[3]};
          *(LAS u32x4*)(SL(5) + ek * CS_RS + etq * 16) = (u32x4){pbh[0], pbh[1], pbh[2], pbh[3]};
          *(LAS u32x4*)(SL(6) + ek * CS_RS + etq * 16) = (u32x4){pkh[0], pkh[1], pkh[2], pkh[3]}; }
        __syncthreads();
        { f32x4 acc[2];
          CS_ZERO(acc); cs_mm(acc, SL(1), SL(0), mi, ni0, fr, fq); cs_mask(acc, mi, ni0, fr, fq, 0);
          cs_st_t8(SL(8), acc, mi, ni0, fr, fq);
          if (mi == ni0 || mi == ni0 + 1) { const int jd = mi - ni0;
#pragma unroll
              for (int jj = 0; jj < 2; ++jj)
#pragma unroll
                  for (int r = 0; r < 4; ++r) if (jj == jd && (4 * fq + r) == fr) acc[jj][r] += 1.f; }
          cs_st_t8(SL(13), acc, mi, ni0, fr, fq);
          CS_ZERO(acc); cs_mm(acc, SL(0), SL(2), mi, ni0, fr, fq); cs_mask(acc, mi, ni0, fr, fq, 1); cs_st_t8(SL(9), acc, mi, ni0, fr, fq);
          CS_ZERO(acc); cs_mm(acc, SL(1), SL(3), mi, ni0, fr, fq); cs_mask(acc, mi, ni0, fr, fq, DIR ? 0 : 2); cs_st_t8(SL(10), acc, mi, ni0, fr, fq);
          CS_ZERO(acc); cs_mm(acc, SL(2), SL(3), mi, ni0, fr, fq); cs_mask(acc, mi, ni0, fr, fq, DIR ? 0 : 2); cs_st_t8(SL(11), acc, mi, ni0, fr, fq); }
        __syncthreads();
        { f32x4 aS[2], aU[2];
          CS_ZERO(aS); cs_mm_tr(aS, SL(8), SL(8), mi, ni0, fr, fq); cs_st_t8(SL(1), aS, mi, ni0, fr, fq);
          __syncthreads();
#pragma unroll
          for (int it = 0; it < 5; ++it) { const int xc = (it & 1) ? 8 : 1, xa = (it & 1) ? 1 : 8, tc = (it & 1) ? 12 : 13, ta = (it & 1) ? 13 : 12;
              cs_ld_t8(aU, SL(tc), mi, ni0, fr, fq); CS_ZERO(aS); cs_mm_tr2(aU, aS, SL(tc), SL(xc), SL(xc), it < 4, mi, ni0, fr, fq);
              cs_st_t8(SL(ta), aU, mi, ni0, fr, fq);
              if (it < 4) cs_st_t8(SL(xa), aS, mi, ni0, fr, fq);
              __syncthreads(); } }
        { f32x4 acc[2];
          CS_ZERO(acc); cs_mm(acc, SL(12), SL(4), mi, ni0, fr, fq); cs_st_t8(SL(0), acc, mi, ni0, fr, fq);
          CS_ZERO(acc); cs_mm(acc, SL(12), SL(9), mi, ni0, fr, fq); cs_st_t8(SL(1), acc, mi, ni0, fr, fq); }
        __syncthreads();
        { f32x4 acc[2];
          CS_ZERO(acc);
          if (mi == ni0 || mi == ni0 + 1) { const int jd = mi - ni0; const float dv = Dl[16 * mi + fr];
#pragma unroll
              for (int jj = 0; jj < 2; ++jj)
#pragma unroll
                  for (int r = 0; r < 4; ++r) if (jj == jd && (4 * fq + r) == fr) acc[jj][r] = dv; }
          cs_mm(acc, SL(0), SL(5), mi, ni0, fr, fq); cs_st_t8(SL(7), acc, mi, ni0, fr, fq);
          cs_ld_t8(acc, SL(3), mi, ni0, fr, fq); cs_mm(acc, SL(0), SL(10), mi, ni0, fr, fq); cs_st_t8(SL(8), acc, mi, ni0, fr, fq);
          cs_ld_t8(acc, SL(6), mi, ni0, fr, fq); cs_mm(acc, SL(1), SL(5), mi, ni0, fr, fq); cs_st_t8(SL(12), acc, mi, ni0, fr, fq);
          cs_ld_t8(acc, SL(11), mi, ni0, fr, fq); cs_mm(acc, SL(1), SL(10), mi, ni0, fr, fq); cs_st_t8(SL(13), acc, mi, ni0, fr, fq);
          const unsigned w4[4] = {rawv_cur.x, rawv_cur.y, rawv_cur.z, rawv_cur.w};
#pragma unroll
          for (int e = 0; e < 8; ++e) *(LAS bf16_t*)(SL(2) + (8 * rc_ + e) * CS_RS + rt_ * 2) = (bf16_t)((e & 1) ? (w4[e >> 1] >> 16) : (w4[e >> 1] & 0xffffu)); }
        __syncthreads();
        { const LAS unsigned char* PH = SL(7) + (16 * wave + fr) * CS_RS; const LAS unsigned char* PS = SL(12) + (16 * wave + fr) * CS_RS;
          const LAS unsigned char* Sr = (n & 1) ? SL(15) : SL(14); LAS unsigned char* Sw = (n & 1) ? SL(14) : SL(15);
          f32x4 acc[4] = {(f32x4){0.f, 0.f, 0.f, 0.f}, (f32x4){0.f, 0.f, 0.f, 0.f}, (f32x4){0.f, 0.f, 0.f, 0.f}, (f32x4){0.f, 0.f, 0.f, 0.f}};
#pragma unroll
          for (int s2 = 0; s2 < 2; ++s2) { const bf16x8 bph = *(const LAS bf16x8*)(PH + (32 * s2 + 8 * fq) * 2), bps = *(const LAS bf16x8*)(PS + (32 * s2 + 8 * fq) * 2);
#pragma unroll
              for (int m2 = 0; m2 < 4; ++m2) { const bf16x8 as = cs_afrag_tr<136>(Sr, m2, s2, fr, fq), av = *(const LAS bf16x8*)(SL(2) + (16 * m2 + fr) * CS_RS + (32 * s2 + 8 * fq) * 2);
                  acc[m2] = __builtin_amdgcn_mfma_f32_16x16x32_bf16(as, bph, acc[m2], 0, 0, 0); acc[m2] = __builtin_amdgcn_mfma_f32_16x16x32_bf16(av, bps, acc[m2], 0, 0, 0); } }
          if (wave < 4) {
#pragma unroll
              for (int m2 = 0; m2 < 4; ++m2) { u32x2 w; w.x = pk2(acc[m2][0], acc[m2][1]); w.y = pk2(acc[m2][2], acc[m2][3]);
                  *(LAS u32x2*)(Sw + (16 * wave + fr) * 136 + (16 * m2 + 4 * fq) * 2) = w; }
          } else { const int sq = 64 * n + 16 * (wave - 4) + fr; const size_t tok = (size_t)(b * SEQ + (DIR ? (SEQ - 1 - sq) : sq));
#pragma unroll
              for (int m2 = 0; m2 < 4; ++m2) { u32x2 w; w.x = pk2(acc[m2][0], acc[m2][1]); w.y = pk2(acc[m2][2], acc[m2][3]); *(u32x2*)(Y + tok * 512 + h * 64 + 16 * m2 + 4 * fq) = w; } } }
        __syncthreads();
    }
#undef CS_LOAD
#undef SL
}
__device__ __forceinline__ void phase_scan(const Frame& F) {
    for (int job = F.vcu; job < 256; job += F.G) {
        const int chain = job >> 1, half = job & 1, dir = chain & 1, bh = chain >> 1, b = bh >> 3, h = bh & 7;
        if (dir) scan_job<1>(F, b, h, half, job); else scan_job<0>(F, b, h, half, job);
    }
}

__device__ __forceinline__ void phase_attn_range(const Frame& F, int u_first, int u_stride) {
    const int tid = F.tid, lane = F.lane, wave = F.wave, r32 = lane & 31, hi = lane >> 5;
    LAS unsigned char* lds = F.lds;
    const bf16_t *QH = wsp<bf16_t>(F.ws, A_QH), *KH = wsp<bf16_t>(F.ws, A_KH), *VT = wsp<bf16_t>(F.ws, A_VT0); bf16_t* YC = wsp<bf16_t>(F.ws, A_YCAT);
    const int skey = tid >> 3, sc = tid & 7;
    for (int u = u_first; u < 512; u += u_stride) {
        const int b = u >> 6, g = (u >> 5) & 1, qt = u & 31;
        const int head = 4 * g + (wave >> 1); const int qrow = b * SEQ + qt * 64 + 32 * (wave & 1) + r32;
        bf16x8 qf[4];
#pragma unroll
        for (int s = 0; s < 4; ++s) qf[s] = *(const bf16x8*)(QH + (size_t)qrow * 512 + head * 64 + 16 * s + 8 * hi);
        const bf16_t* ksrc = KH + (size_t)(b * SEQ + skey) * 128 + g * 64 + 8 * sc;
        const bf16_t* vsrc = VT + ((size_t)(b * 2 + g) * 64 + skey) * SEQ + 8 * sc;
        const int kdst = skey * 128 + ((sc ^ (skey & 7)) * 16), vdst = 16384 + skey * 128 + ((sc ^ ((skey >> 1) & 7)) * 16);
        u32x4 kst = *(const u32x4*)ksrc, vst = *(const u32x4*)vsrc;
        __syncthreads();
        *(LAS u32x4*)(lds + kdst) = kst; *(LAS u32x4*)(lds + vdst) = vst;
        __syncthreads();
        f32x16 o0 = {}, o1 = {}; float mrun = -1e30f, lrun = 0.f;
        for (int t = 0; t < SEQ / 64; ++t) {
            if (t + 1 < SEQ / 64) { kst = *(const u32x4*)(ksrc + (size_t)(t + 1) * 64 * 128); vst = *(const u32x4*)(vsrc + (t + 1) * 64); }
            const int bo = (t & 1) * 8192;
            f32x16 c0 = {}, c1 = {};
#pragma unroll
            for (int s = 0; s < 4; ++s) { const int ch = 2 * s + hi;
                const bf16x8 k0 = *(const LAS bf16x8*)(lds + bo + r32 * 128 + ((ch ^ (r32 & 7)) * 16));
                const bf16x8 k1 = *(const LAS bf16x8*)(lds + bo + (32 + r32) * 128 + ((ch ^ (r32 & 7)) * 16));
                c0 = __builtin_amdgcn_mfma_f32_32x32x16_bf16(k0, qf[s], c0, 0, 0, 0);
                c1 = __builtin_amdgcn_mfma_f32_32x32x16_bf16(k1, qf[s], c1, 0, 0, 0); }
            float mx = c0[0];
#pragma unroll
            for (int r = 0; r < 16; ++r) { mx = fmaxf(mx, c0[r]); mx = fmaxf(mx, c1[r]); }
            mx = fmaxf(mx, __shfl_xor(mx, 32));
            const float mnew = fmaxf(mrun, mx); const float alpha = __builtin_amdgcn_exp2f(mrun - mnew); mrun = mnew;
            float ls = 0.f;
#pragma unroll
            for (int r = 0; r < 16; ++r) { c0[r] = __builtin_amdgcn_exp2f(c0[r] - mnew); c1[r] = __builtin_amdgcn_exp2f(c1[r] - mnew); ls += c0[r] + c1[r]; }
            lrun = lrun * alpha + ls;
#pragma unroll
            for (int r = 0; r < 16; ++r) { o0[r] *= alpha; o1[r] *= alpha; }
            bf16x8 pf[2][2];
#pragma unroll
            for (int s2 = 0; s2 < 2; ++s2) { u32x4 w0, w1;
                w0.x = pk2(c0[8 * s2 + 0], c0[8 * s2 + 1]); w0.y = pk2(c0[8 * s2 + 2], c0[8 * s2 + 3]); w0.z = pk2(c0[8 * s2 + 4], c0[8 * s2 + 5]); w0.w = pk2(c0[8 * s2 + 6], c0[8 * s2 + 7]);
                w1.x = pk2(c1[8 * s2 + 0], c1[8 * s2 + 1]); w1.y = pk2(c1[8 * s2 + 2], c1[8 * s2 + 3]); w1.z = pk2(c1[8 * s2 + 4], c1[8 * s2 + 5]); w1.w = pk2(c1[8 * s2 + 6], c1[8 * s2 + 7]);
                pf[0][s2] = __builtin_bit_cast(bf16x8, w0); pf[1][s2] = __builtin_bit_cast(bf16x8, w1); }
            const int vb = 16384 + bo;
#pragma unroll
            for (int dblk = 0; dblk < 2; ++dblk) { const int d = 32 * dblk + r32; const int sw = (d >> 1) & 7;
#pragma unroll
                for (int blk = 0; blk < 2; ++blk)
#pragma unroll
                    for (int s2 = 0; s2 < 2; ++s2) { const int ch = 4 * blk + 2 * s2;
                        const u32x2 lo = *(const LAS u32x2*)(lds + vb + d * 128 + ((ch ^ sw) * 16) + hi * 8);
                        const u32x2 hh = *(const LAS u32x2*)(lds + vb + d * 128 + (((ch + 1) ^ sw) * 16) + hi * 8);
                        const u32x4 vv = {lo.x, lo.y, hh.x, hh.y};
                        if (dblk == 0) o0 = __builtin_amdgcn_mfma_f32_32x32x16_bf16(__builtin_bit_cast(bf16x8, vv), pf[blk][s2], o0, 0, 0, 0);
                        else           o1 = __builtin_amdgcn_mfma_f32_32x32x16_bf16(__builtin_bit_cast(bf16x8, vv), pf[blk][s2], o1, 0, 0, 0); } }
            if (t + 1 < SEQ / 64) { const int nb = ((t + 1) & 1) * 8192; *(LAS u32x4*)(lds + nb + kdst) = kst; *(LAS u32x4*)(lds + nb + vdst) = vst; }
            __syncthreads();
        }
        const float ltot = lrun + __shfl_xor(lrun, 32); const float inv = 1.f / ltot;
        bf16_t* op = YC + (size_t)qrow * 1024 + 512 + head * 64 + 4 * hi;
#pragma unroll
        for (int q4 = 0; q4 < 4; ++q4) { u32x2 w0, w1;
            w0.x = pk2(o0[4 * q4 + 0] * inv, o0[4 * q4 + 1] * inv); w0.y = pk2(o0[4 * q4 + 2] * inv, o0[4 * q4 + 3] * inv);
            w1.x = pk2(o1[4 * q4 + 0] * inv, o1[4 * q4 + 1] * inv); w1.y = pk2(o1[4 * q4 + 2] * inv, o1[4 * q4 + 3] * inv);
            *(u32x2*)(op + 8 * q4) = w0; *(u32x2*)(op + 32 + 8 * q4) = w1; }
    }
}

__device__ __forceinline__ void phase_attn(const Frame& F) { phase_attn_range(F, F.vcu, F.G); }
__device__ __forceinline__ void phase_cscan_attn_split(const Frame& F) {
    const int half_g = F.G >> 1, me = F.vcu >> 1;
    if ((F.vcu & 1) == 0) {
        for (int chain = me; chain < 128; chain += half_g) { const int dir = chain & 1, bh = chain >> 1, b = bh >> 3, h = bh & 7;
            for (int q_ = 0; q_ <= (int)((MK_REP_SUB) & 1u); ++q_) { if (dir) cscan_job<1>(F, b, h); else cscan_job<0>(F, b, h); } }
    } else {
        for (int q_ = 0; q_ <= (int)(((MK_REP_SUB) >> 1) & 1u); ++q_)
        for (int u4 = me; u4 * 4 < 512; u4 += half_g) for (int q = 0; q < 4; ++q) phase_attn_range(F, u4 * 4 + q, 1 << 30);
        __syncthreads();
        for (int q_ = 0; q_ <= (int)(((MK_REP_SUB) >> 4) & 1u); ++q_)
        { conv_experts_down(F, me * NWAVES + F.wave, half_g * NWAVES); conv_experts_gu(F, me * NWAVES + F.wave, half_g * NWAVES, 6, 8); }
    }
}
__device__ __forceinline__ void phase_rwkv_post(const Frame& F) {
    const int lane = F.lane, wave = F.wave, fr = lane & 15, fq = lane >> 4;
    const bf16_t *YF = wsp<bf16_t>(F.ws, A_YF), *YB = wsp<bf16_t>(F.ws, A_YB);
    const bf16_t *RS = wsp<bf16_t>(F.ws, A_RS), *VS = wsp<bf16_t>(F.ws, A_VS), *KDF = wsp<bf16_t>(F.ws, A_KDF);
    const bf16_t* AP = wsp<bf16_t>(F.ws, A_AP) + 128; const bf16_t* WG = wsp<bf16_t>(F.ws, WS_WLR) + (size_t)2048 * 256 + 128;
    bf16_t* YC = wsp<bf16_t>(F.ws, A_YCAT);
    constexpr int GRS = 1040;
    LAS unsigned char* GL = F.lds;
    const int c0 = 8 * lane;
    float gw_[8], gb_[8], rk_[8];
#pragma unroll
    for (int i = 0; i < 8; ++i) { gw_[i] = F.in[16][c0 + i]; gb_[i] = F.in[17][c0 + i]; rk_[i] = F.in[15][c0 + i]; }
    for (int tile = F.vcu; tile < M_TOK / 64; tile += F.G) { const int t0 = tile * 64;
        { f32x4 acc[4][4];
#pragma unroll
          for (int nt = 0; nt < 4; ++nt)
#pragma unroll
              for (int mt = 0; mt < 4; ++mt) acc[nt][mt] = (f32x4){0.f, 0.f, 0.f, 0.f};
#pragma unroll
          for (int ks = 0; ks < 4; ++ks) { bf16x8 a[4], b[4];
#pragma unroll
              for (int nt = 0; nt < 4; ++nt) a[nt] = *(const bf16x8*)(WG + (size_t)(64 * wave + 16 * nt + fr) * 256 + 32 * ks + 8 * fq);
#pragma unroll
              for (int mt = 0; mt < 4; ++mt) b[mt] = *(const bf16x8*)(AP + (size_t)(t0 + 16 * mt + fr) * 256 + 32 * ks + 8 * fq);
#pragma unroll
              for (int nt = 0; nt < 4; ++nt)
#pragma unroll
                  for (int mt = 0; mt < 4; ++mt) acc[nt][mt] = __builtin_amdgcn_mfma_f32_16x16x32_bf16(a[nt], b[mt], acc[nt][mt], 0, 0, 0); }
#pragma unroll
          for (int nt = 0; nt < 4; ++nt)
#pragma unroll
              for (int mt = 0; mt < 4; ++mt) { u32x2 w; w.x = pk2(acc[nt][mt][0], acc[nt][mt][1]); w.y = pk2(acc[nt][mt][2], acc[nt][mt][3]);
                  *(LAS u32x2*)(GL + (16 * mt + fr) * GRS + (64 * wave + 16 * nt + 4 * fq) * 2) = w; } }
        __syncthreads();
        for (int j = 0; j < 8; ++j) { const int tl = 8 * wave + j; const size_t o = (size_t)(t0 + tl) * 512 + c0;
            const u32x4 yfw = *(const u32x4*)(YF + o), ybw = *(const u32x4*)(YB + o);
            float y[8]; float sm = 0.f;
            y[0] = bflo(yfw.x) + bflo(ybw.x); y[1] = bfhi(yfw.x) + bfhi(ybw.x); y[2] = bflo(yfw.y) + bflo(ybw.y); y[3] = bfhi(yfw.y) + bfhi(ybw.y);
            y[4] = bflo(yfw.z) + bflo(ybw.z); y[5] = bfhi(yfw.z) + bfhi(ybw.z); y[6] = bflo(yfw.w) + bflo(ybw.w); y[7] = bfhi(yfw.w) + bfhi(ybw.w);
#pragma unroll
            for (int i = 0; i < 8; ++i) sm += y[i];
            sm += __shfl_xor(sm, 1); sm += __shfl_xor(sm, 2); sm += __shfl_xor(sm, 4);
            const float mean = sm * (1.f / 64.f); float sv = 0.f;
#pragma unroll
            for (int i = 0; i < 8; ++i) { y[i] -= mean; sv += y[i] * y[i]; }
            sv += __shfl_xor(sv, 1); sv += __shfl_xor(sv, 2); sv += __shfl_xor(sv, 4);
            const float rstd = 1.0f / sqrtf(sv * (1.f / 64.f) + 64e-5f);
            const u32x4 rw = *(const u32x4*)(RS + o), vw = *(const u32x4*)(VS + o), kw = *(const u32x4*)(KDF + o), gw4 = *(const LAS u32x4*)(GL + tl * GRS + c0 * 2);
            float r8[8], v8[8], k8[8], g8[8]; unpack8(rw, r8); unpack8(vw, v8); unpack8(kw, k8); unpack8(gw4, g8);
            float bs = 0.f;
#pragma unroll
            for (int i = 0; i < 8; ++i) bs += r8[i] * k8[i] * rk_[i];
            bs += __shfl_xor(bs, 1); bs += __shfl_xor(bs, 2); bs += __shfl_xor(bs, 4);
            float ov[8];
#pragma unroll
            for (int i = 0; i < 8; ++i) ov[i] = ((y[i] * rstd) * gw_[i] + gb_[i] + bs * v8[i]) * g8[i];
            *(u32x4*)(YC + (size_t)(t0 + tl) * 1024 + c0) = pack8f(ov); }
        __syncthreads(); }
}

__device__ __forceinline__ void phase_gd(const Frame& F) {
    const int tid = F.tid, lane = F.lane, wave = F.wave, fr = lane & 15, fq = lane >> 4;
    LAS f32x4* PL = (LAS f32x4*)F.lds;
    const bf16_t* XB = wsp<bf16_t>(F.ws, WS_XB); const bf16_t* WG = wsp<bf16_t>(F.ws, WS_WIN1) + (size_t)3072 * 1024; const float* ssq = wsp<float>(F.ws, WS_SSQ2); bf16_t* P1 = wsp<bf16_t>(F.ws, A_P1);
    const int tpb = M_TOK / F.G;
    for (int t0 = F.vcu * tpb; t0 < (F.vcu + 1) * tpb; t0 += 64) {
        f32x4 acc[4];
#pragma unroll
        for (int t = 0; t < 4; ++t) acc[t] = (f32x4){0.f, 0.f, 0.f, 0.f};
#pragma unroll
        for (int s4 = 0; s4 < 4; ++s4) { const int k0 = 32 * (4 * wave + s4) + 8 * fq;
            const bf16x8 bfr = *(const bf16x8*)(WG + (size_t)fr * 1024 + k0);
#pragma unroll
            for (int t = 0; t < 4; ++t) { const bf16x8 afr = *(const bf16x8*)(XB + (size_t)(t0 + 16 * t + fr) * 1024 + k0);
                acc[t] = __builtin_amdgcn_mfma_f32_16x16x32_bf16(afr, bfr, acc[t], 0, 0, 0); } }
        __syncthreads();
#pragma unroll
        for (int t = 0; t < 4; ++t) PL[(wave * 4 + t) * 64 + lane] = acc[t];
        __syncthreads();
        if (tid < 256) { const int t = tid >> 6, l = tid & 63; f32x4 sum = PL[t * 64 + l];
#pragma unroll
            for (int w = 1; w < 8; ++w) sum += PL[(w * 4 + t) * 64 + l];
            const int lfr = l & 15, lfq = l >> 4;
#pragma unroll
            for (int r = 0; r < 4; ++r) { const int tok = t0 + 16 * t + 4 * lfq + r; P1[(size_t)tok * O_INP + 3072 + lfr] = f2bf(sum[r] * rstd_from_ssq(ssq, tok)); } }
    }
}

constexpr float GLA_QSCALE = 0.08838834764831845f;
__device__ __forceinline__ size_t gla_dir(size_t base, int dir) { return base + (size_t)dir * GLA_DIR_STRIDE; }
__device__ __forceinline__ float logsig16(float z) { return (fminf(z, 0.f) - __logf(1.f + __expf(-fabsf(z)))) * (1.f / 16.f); }
__device__ __forceinline__ void phase_gla_prep(const Frame& F) {
    const int tid = F.tid, lane = F.lane, wave = F.wave, fr = lane & 15, fq = lane >> 4;
    LAS float* GD = (LAS float*)F.lds;
    LAS float* PT = (LAS float*)(F.lds + 4096);
    LAS unsigned char* QTt = F.lds + 10240;
    LAS unsigned char* KTt = F.lds + 10240 + 17408;
    LAS unsigned char* RV = F.lds + 10240;
    LAS unsigned char* RQ = F.lds + 45056; LAS unsigned char* RK = F.lds + 45056 + 16384;
    LAS unsigned char* ATT = F.lds + 45056;
    LAS unsigned char* QHl = F.lds + 45056 + 9216;
    LAS unsigned char* VTt = F.lds + 77824;
    const bf16_t* P1 = wsp<bf16_t>(F.ws, A_P1);
    bf16_t* VT = wsp<bf16_t>(F.ws, A_VT1); float* DECS = wsp<float>(F.ws, WS_DECS); bf16_t* OF = wsp<bf16_t>(F.ws, A_OF);
    const int d = tid & 127, qr = tid >> 7;
    for (int unit = F.vcu; unit < BATCH * GLA_H * 32; unit += F.G) {
        const int n = unit & 31, h = (unit >> 5) & 3, b = unit >> 7; const int T0 = b * SEQ + 64 * n; const size_t tile = (size_t)(b * 4 + h) * 32 + n;
        __syncthreads();
        for (int i = tid; i < 1024; i += 512) GD[i] = bf2f(P1[(size_t)(T0 + (i >> 4)) * O_INP + 3072 + (i & 15)]);
#pragma unroll
        for (int i = 0; i < 2; ++i) { const int p = tid + 512 * i, row = p >> 4, c = p & 15; const bf16_t* src = P1 + (size_t)(T0 + row) * O_INP + h * 128 + 8 * c;
            *(LAS u32x4*)(RQ + row * 256 + c * 16) = *(const u32x4*)src; *(LAS u32x4*)(RK + row * 256 + c * 16) = *(const u32x4*)(src + 512); }
#pragma unroll
        for (int i = 0; i < 4; ++i) { const int p = tid + 512 * i, row = p >> 5, c = p & 31;
            *(LAS u32x4*)(RV + row * 512 + c * 16) = *(const u32x4*)(P1 + (size_t)(T0 + row) * O_INP + 1024 + h * 256 + 8 * c); }
        float upf[16], upb[16];
#pragma unroll
        for (int r = 0; r < 16; ++r) { upf[r] = F.in[27][r * 512 + h * 128 + d]; upb[r] = F.in[29][r * 512 + h * 128 + d]; }
        const float bif = F.in[28][h * 128 + d], bib = F.in[30][h * 128 + d];
        __syncthreads();
        bf16_t qraw[16], kraw[16];
#pragma unroll
        for (int j = 0; j < 16; ++j) { qraw[j] = *(const LAS bf16_t*)(RQ + (16 * qr + j) * 256 + d * 2); kraw[j] = *(const LAS bf16_t*)(RK + (16 * qr + j) * 256 + d * 2); }
        { const int dv = tid & 255, th = tid >> 8; unsigned pk[16];
#pragma unroll
          for (int j = 0; j < 16; ++j) pk[j] = (unsigned)*(const LAS bf16_t*)(RV + (32 * th + 2 * j) * 512 + dv * 2) | ((unsigned)*(const LAS bf16_t*)(RV + (32 * th + 2 * j + 1) * 512 + dv * 2) << 16);
          bf16_t* gdst = VT + tile * 16384 + dv * 64 + 32 * th;
#pragma unroll
          for (int q = 0; q < 4; ++q) { const u32x4 w = {pk[4 * q], pk[4 * q + 1], pk[4 * q + 2], pk[4 * q + 3]}; *(u32x4*)(gdst + 8 * q) = w; *(LAS u32x4*)(VTt + dv * 144 + (32 * th + 8 * q) * 2) = w; } }
        float Bf[16], Bb[16];
#pragma unroll
        for (int j = 0; j < 16; ++j) { const LAS f32x4* gp = (const LAS f32x4*)(GD + (16 * qr + j) * 16); float zf = bif, zb = bib;
#pragma unroll
            for (int q = 0; q < 4; ++q) { const f32x4 g4 = gp[q];
#pragma unroll
                for (int e = 0; e < 4; ++e) { zf += g4[e] * upf[4 * q + e]; zb += g4[e] * upb[4 * q + e]; } }
            Bf[j] = logsig16(zf); Bb[j] = logsig16(zb); }
#pragma unroll
        for (int j = 1; j < 16; ++j) Bf[j] += Bf[j - 1];
#pragma unroll
        for (int j = 14; j >= 0; --j) Bb[j] += Bb[j + 1];
        PT[(0 * 4 + qr) * 128 + d] = Bf[15]; PT[(1 * 4 + qr) * 128 + d] = Bb[0];
        if (qr == 2) PT[1024 + d] = Bf[0];
        if (qr == 1) PT[1024 + 128 + d] = Bb[15];
        __syncthreads();
        float offf = 0.f, offb = 0.f, totf = 0.f, totb = 0.f, pre2f = 0.f, suf2b = 0.f;
#pragma unroll
        for (int q = 0; q < 4; ++q) { const float pf = PT[q * 128 + d], pb = PT[(4 + q) * 128 + d]; totf += pf; totb += pb; if (q < qr) offf += pf; if (q > qr) offb += pb; if (q < 2) pre2f += pf; if (q >= 2) suf2b += pb; }
        const float bmf = pre2f + PT[1024 + d], bmb = suf2b + PT[1024 + 128 + d];
#pragma unroll
        for (int j = 0; j < 16; ++j) { Bf[j] += offf; Bb[j] += offb; }
        f32x4 oacc[2][4];
#pragma unroll
        for (int x = 0; x < 2; ++x)
#pragma unroll
            for (int y = 0; y < 4; ++y) oacc[x][y] = (f32x4){0.f, 0.f, 0.f, 0.f};
#pragma unroll
        for (int dir = 0; dir < 2; ++dir) {
            const float bm = dir ? bmb : bmf, bl = dir ? totb : totf; const float ebm = __expf(bm), ebl = __expf(bl - bm);
            bf16_t* QHT = wsp<bf16_t>(F.ws, gla_dir(A_QHAT, dir)) + tile * 8192; bf16_t* K2T = wsp<bf16_t>(F.ws, gla_dir(A_K2T, dir)) + tile * 8192;
            unsigned k2pk[8];
#pragma unroll
            for (int j = 0; j < 16; ++j) { const float bv = dir ? Bb[j] : Bf[j]; const float e1 = __expf(bv - bm), r1 = __builtin_amdgcn_rcpf(e1);
                const float qs = bf2f(qraw[j]) * GLA_QSCALE, kk = bf2f(kraw[j]); const int tk = 16 * qr + j;
                const float qt = qs * e1, kt = kk * r1, qh = qt * ebm, k2 = kt * ebl;
                *(LAS bf16_t*)(QTt + tk * 272 + d * 2) = f2bf(qt); *(LAS bf16_t*)(KTt + tk * 272 + d * 2) = f2bf(kt); *(LAS bf16_t*)(QHl + tk * 272 + d * 2) = f2bf(qh);
                if (j & 1) k2pk[j >> 1] |= ((unsigned)f2bf(k2)) << 16; else k2pk[j >> 1] = (unsigned)f2bf(k2); }
            { bf16_t* kd = K2T + d * 64 + 16 * qr;
              *(u32x4*)kd = (u32x4){k2pk[0], k2pk[1], k2pk[2], k2pk[3]}; *(u32x4*)(kd + 8) = (u32x4){k2pk[4], k2pk[5], k2pk[6], k2pk[7]}; }
            if (qr == 0) DECS[((size_t)((b * 4 + h) * 2 + dir) * 32 + n) * 128 + d] = __expf(bl);
            __syncthreads();
#pragma unroll
            for (int i = 0; i < 2; ++i) { const int p = tid + 512 * i, row = p >> 4, c = p & 15; *(u32x4*)(QHT + row * 128 + c * 8) = *(const LAS u32x4*)(QHl + row * 272 + c * 16); }
            { const int ib = wave >> 1, jb0 = 2 * (wave & 1); f32x4 at[2] = {(f32x4){0.f, 0.f, 0.f, 0.f}, (f32x4){0.f, 0.f, 0.f, 0.f}};
#pragma unroll
              for (int s2 = 0; s2 < 4; ++s2) { const bf16x8 a = *(const LAS bf16x8*)(QTt + (16 * ib + fr) * 272 + (32 * s2 + 8 * fq) * 2);
#pragma unroll
                  for (int jj = 0; jj < 2; ++jj) { const bf16x8 bb = *(const LAS bf16x8*)(KTt + (16 * (jb0 + jj) + fr) * 272 + (32 * s2 + 8 * fq) * 2);
                      at[jj] = __builtin_amdgcn_mfma_f32_16x16x32_bf16(a, bb, at[jj], 0, 0, 0); } }
#pragma unroll
              for (int jj = 0; jj < 2; ++jj)
#pragma unroll
                  for (int r = 0; r < 4; ++r) { const int i = 16 * ib + 4 * fq + r, j = 16 * (jb0 + jj) + fr; const bool keep = dir ? (j > i) : (j <= i);
                      *(LAS bf16_t*)(ATT + i * 144 + j * 2) = f2bf(keep ? at[jj][r] : 0.f); } }
            __syncthreads();
#pragma unroll
            for (int s2 = 0; s2 < 2; ++s2) { bf16x8 bfr[4];
#pragma unroll
                for (int ib = 0; ib < 4; ++ib) bfr[ib] = *(const LAS bf16x8*)(ATT + (16 * ib + fr) * 144 + (32 * s2 + 8 * fq) * 2);
#pragma unroll
                for (int x = 0; x < 2; ++x) { const bf16x8 a = *(const LAS bf16x8*)(VTt + (16 * (2 * wave + x) + fr) * 144 + (32 * s2 + 8 * fq) * 2);
#pragma unroll
                    for (int ib = 0; ib < 4; ++ib) oacc[x][ib] = __builtin_amdgcn_mfma_f32_16x16x32_bf16(a, bfr[ib], oacc[x][ib], 0, 0, 0); } }
        }
#pragma unroll
        for (int x = 0; x < 2; ++x)
#pragma unroll
            for (int ib = 0; ib < 4; ++ib) { u32x2 w; w.x = pk2(oacc[x][ib][0], oacc[x][ib][1]); w.y = pk2(oacc[x][ib][2], oacc[x][ib][3]);
                *(u32x2*)(OF + (size_t)(T0 + 16 * ib + fr) * 1024 + h * 256 + 16 * (2 * wave + x) + 4 * fq) = w; }
    }
}

template <int DIR> __device__ __forceinline__ void gla_seq_job(const Frame& F, int b, int h, int vs) {
    const int tid = F.tid, lane = F.lane, wave = F.wave, fr = lane & 15, fq = lane >> 4;
    LAS unsigned char* ST0 = F.lds; LAS unsigned char* ST1 = F.lds + 17408;
    LAS unsigned char* BUF = F.lds + 34816;
    constexpr int BQ = 0, BK2 = 17408, BVT = 17408 + 18432, BSZ = 45056;
    const bf16_t* QHT = wsp<bf16_t>(F.ws, gla_dir(A_QHAT, DIR)); const bf16_t* K2T = wsp<bf16_t>(F.ws, gla_dir(A_K2T, DIR));
    const bf16_t* VT = wsp<bf16_t>(F.ws, A_VT1); const float* DECS = wsp<float>(F.ws, WS_DECS); bf16_t* OF = wsp<bf16_t>(F.ws, A_OF); bf16_t* O = DIR ? wsp<bf16_t>(F.ws, A_OB) : OF;
    const int dvb = wave >> 1, ib0 = 2 * (wave & 1);
    const size_t tile0 = (size_t)(b * 4 + h) * 32;
    const int q0 = tid, q1 = tid + 512;
    const int dq0 = BQ + (q0 >> 4) * 272 + (q0 & 15) * 16, dq1 = BQ + (q1 >> 4) * 272 + (q1 & 15) * 16;
    const int dk0 = BK2 + (q0 >> 3) * 144 + (q0 & 7) * 16, dk1 = BK2 + (q1 >> 3) * 144 + (q1 & 7) * 16;
    const int dv0 = BVT + (q0 >> 3) * 144 + (q0 & 7) * 16;
    u32x4 sg[5]; f32x4 dec, decn; u32x2 oold[2], ooldn[2];
#define GL_LD(n_) do { const size_t t_ = tile0 + (n_); \
        sg[0] = *(const u32x4*)(QHT + t_ * 8192 + q0 * 8); sg[1] = *(const u32x4*)(QHT + t_ * 8192 + q1 * 8); \
        sg[2] = *(const u32x4*)(K2T + t_ * 8192 + q0 * 8); sg[3] = *(const u32x4*)(K2T + t_ * 8192 + q1 * 8); \
        sg[4] = *(const u32x4*)(VT + t_ * 16384 + vs * 4096 + q0 * 8); \
        decn = *(const f32x4*)(DECS + ((size_t)((b * 4 + h) * 2 + DIR) * 32 + (n_)) * 128 + 16 * wave + 4 * fq); \
        if (!DIR) { _Pragma("unroll") for (int ii = 0; ii < 2; ++ii) ooldn[ii] = *(const u32x2*)(OF + (size_t)(b * SEQ + 64 * (n_) + 16 * (ib0 + ii) + fr) * 1024 + h * 256 + 64 * vs + 16 * dvb + 4 * fq); } } while (0)
#define GL_ST(bp) do { *(LAS u32x4*)((bp) + dq0) = sg[0]; *(LAS u32x4*)((bp) + dq1) = sg[1]; *(LAS u32x4*)((bp) + dk0) = sg[2]; *(LAS u32x4*)((bp) + dk1) = sg[3]; *(LAS u32x4*)((bp) + dv0) = sg[4]; } while (0)
    __syncthreads();
    for (int i = tid; i < 17408 / 4; i += 512) ((LAS unsigned*)ST0)[i] = 0u;
    f32x4 st[4];
#pragma unroll
    for (int k = 0; k < 4; ++k) st[k] = (f32x4){0.f, 0.f, 0.f, 0.f};
    GL_LD(DIR ? 31 : 0); GL_ST(BUF); dec = decn; oold[0] = ooldn[0]; oold[1] = ooldn[1];
    __syncthreads();
    for (int cc = 0; cc < 32; ++cc) { const int n = DIR ? 31 - cc : cc, nn = DIR ? 30 - cc : cc + 1; const int T0 = b * SEQ + 64 * n;
        LAS unsigned char* STr = (cc & 1) ? ST1 : ST0; LAS unsigned char* STw = (cc & 1) ? ST0 : ST1;
        LAS unsigned char* bc = BUF + (cc & 1) * BSZ; LAS unsigned char* bn = BUF + ((cc + 1) & 1) * BSZ;
        if (cc + 1 < 32) GL_LD(nn);
#pragma unroll
        for (int x = 0; x < 4; ++x) st[x] = st[x] * dec;
        f32x4 oo[2] = {(f32x4){0.f, 0.f, 0.f, 0.f}, (f32x4){0.f, 0.f, 0.f, 0.f}};
#pragma unroll
        for (int s2 = 0; s2 < 4; ++s2) { const bf16x8 a = *(const LAS bf16x8*)(STr + (16 * dvb + fr) * 272 + (32 * s2 + 8 * fq) * 2);
#pragma unroll
            for (int ii = 0; ii < 2; ++ii) { const bf16x8 qf = *(const LAS bf16x8*)(bc + BQ + (16 * (ib0 + ii) + fr) * 272 + (32 * s2 + 8 * fq) * 2);
                oo[ii] = __builtin_amdgcn_mfma_f32_16x16x32_bf16(a, qf, oo[ii], 0, 0, 0); } }
#pragma unroll
        for (int s2 = 0; s2 < 2; ++s2) { const bf16x8 kf = *(const LAS bf16x8*)(bc + BK2 + (16 * wave + fr) * 144 + (32 * s2 + 8 * fq) * 2);
#pragma unroll
            for (int x = 0; x < 4; ++x) { const bf16x8 vf = *(const LAS bf16x8*)(bc + BVT + (16 * x + fr) * 144 + (32 * s2 + 8 * fq) * 2);
                st[x] = __builtin_amdgcn_mfma_f32_16x16x32_bf16(kf, vf, st[x], 0, 0, 0); } }
#pragma unroll
        for (int x = 0; x < 4; ++x) { u32x2 w; w.x = pk2(st[x][0], st[x][1]); w.y = pk2(st[x][2], st[x][3]); *(LAS u32x2*)(STw + (16 * x + fr) * 272 + (16 * wave + 4 * fq) * 2) = w; }
#pragma unroll
        for (int ii = 0; ii < 2; ++ii) { f32x4 v = oo[ii];
            if (!DIR) { v[0] += bflo(oold[ii].x); v[1] += bfhi(oold[ii].x); v[2] += bflo(oold[ii].y); v[3] += bfhi(oold[ii].y); }
            u32x2 w; w.x = pk2(v[0], v[1]); w.y = pk2(v[2], v[3]);
            *(u32x2*)(O + (size_t)(T0 + 16 * (ib0 + ii) + fr) * 1024 + h * 256 + 64 * vs + 16 * dvb + 4 * fq) = w; }
        if (cc + 1 < 32) { GL_ST(bn); dec = decn; oold[0] = ooldn[0]; oold[1] = ooldn[1]; }
        __syncthreads(); }
#undef GL_LD
#undef GL_ST
}
__device__ __forceinline__ void phase_gla_main(const Frame& F) {
    for (int job = F.vcu; job < 256; job += F.G) { const int vs = job & 3, dir = (job >> 2) & 1, h = (job >> 3) & 3, b = job >> 5;
        if (dir) gla_seq_job<1>(F, b, h, vs); else gla_seq_job<0>(F, b, h, vs); }
}

__device__ __forceinline__ void phase_gla_post(const Frame& F) {
    const int gw = F.vcu * NWAVES + F.wave, lane = F.lane; const int c0 = 16 * lane;
    const bf16_t *OF = wsp<bf16_t>(F.ws, A_OF), *OB = wsp<bf16_t>(F.ws, A_OB), *P1 = wsp<bf16_t>(F.ws, A_P1); bf16_t* GO = wsp<bf16_t>(F.ws, A_GOUT);
    float gn[16];
#pragma unroll
    for (int i = 0; i < 16; ++i) gn[i] = F.in[31][(c0 + i) & 255];
    for (int tok = gw; tok < M_TOK; tok += F.G * NWAVES) { const size_t o = (size_t)tok * 1024 + c0;
        float v[16]; float ss = 0.f;
#pragma unroll
        for (int hh = 0; hh < 2; ++hh) { const u32x4 a = *(const u32x4*)(OF + o + 8 * hh), bq = *(const u32x4*)(OB + o + 8 * hh);
            v[8 * hh + 0] = bflo(a.x) + bflo(bq.x); v[8 * hh + 1] = bfhi(a.x) + bfhi(bq.x); v[8 * hh + 2] = bflo(a.y) + bflo(bq.y); v[8 * hh + 3] = bfhi(a.y) + bfhi(bq.y);
            v[8 * hh + 4] = bflo(a.z) + bflo(bq.z); v[8 * hh + 5] = bfhi(a.z) + bfhi(bq.z); v[8 * hh + 6] = bflo(a.w) + bflo(bq.w); v[8 * hh + 7] = bfhi(a.w) + bfhi(bq.w); }
#pragma unroll
        for (int i = 0; i < 16; ++i) ss += v[i] * v[i];
        ss = dpp_row_sum(ss);
        const float rs = 1.0f / sqrtf(ss * (1.f / 256.f) + NORM_EPS);
        float og[16];
#pragma unroll
        for (int hh = 0; hh < 2; ++hh) { const u32x4 g = *(const u32x4*)(P1 + (size_t)tok * O_INP + 2048 + c0 + 8 * hh);
            og[8 * hh + 0] = bflo(g.x); og[8 * hh + 1] = bfhi(g.x); og[8 * hh + 2] = bflo(g.y); og[8 * hh + 3] = bfhi(g.y); og[8 * hh + 4] = bflo(g.z); og[8 * hh + 5] = bfhi(g.z); og[8 * hh + 6] = bflo(g.w); og[8 * hh + 7] = bfhi(g.w); }
        float r[16];
#pragma unroll
        for (int i = 0; i < 16; ++i) r[i] = v[i] * rs * gn[i] * siluf_(og[i]);
#pragma unroll
        for (int hh = 0; hh < 2; ++hh) { u32x4 w; w.x = pk2(r[8 * hh + 0], r[8 * hh + 1]); w.y = pk2(r[8 * hh + 2], r[8 * hh + 3]); w.z = pk2(r[8 * hh + 4], r[8 * hh + 5]); w.w = pk2(r[8 * hh + 6], r[8 * hh + 7]);
            *(u32x4*)(GO + o + 8 * hh) = w; } }
}

__device__ __forceinline__ void phase_route(const Frame& F) {
    const int tid = F.tid, lane = F.lane, wave = F.wave;
    LAS int* lcnt = (LAS int*)(F.lds + MOE_OFF);
    LAS float* RL = (LAS float*)F.lds;
    __syncthreads();
    if (tid < 16) lcnt[tid] = 0;
    const float* X = F.out; const float* g2 = F.in[33]; const float* RT = F.in[34];
    for (int i = tid; i < 2048; i += 512) { const int k = i >> 1; const f32x4 r = *(const f32x4*)(RT + (size_t)i * 4); *(LAS f32x4*)(RL + i * 4) = r * g2[k]; }
    __syncthreads();
    int* TE = wsp<int>(F.ws, WS_TOKE); float* TG = wsp<float>(F.ws, WS_TOKG); float* R3 = wsp<float>(F.ws, WS_RSTD3);
    const int tpb = M_TOK / F.G, tpw = tpb / NWAVES;
    for (int i0 = 0; i0 < tpw; i0 += 4) { const int tok0 = F.vcu * tpb + wave * tpw + i0;
        float acc[4][8], ss[4];
#pragma unroll
        for (int t = 0; t < 4; ++t) { ss[t] = 0.f;
#pragma unroll
            for (int e = 0; e < 8; ++e) acc[t][e] = 0.f; }
#pragma unroll
        for (int j = 0; j < 4; ++j) { const int k0 = 4 * lane + 256 * j; f32x4 xv[4];
#pragma unroll
            for (int t = 0; t < 4; ++t) xv[t] = *(const f32x4*)(X + (size_t)(tok0 + t) * 1024 + k0);
#pragma unroll
            for (int q = 0; q < 4; ++q) { const f32x4 r0 = *(const LAS f32x4*)(RL + (k0 + q) * 8), r1 = *(const LAS f32x4*)(RL + (k0 + q) * 8 + 4);
#pragma unroll
                for (int t = 0; t < 4; ++t) { const float xx = xv[t][q]; ss[t] += xx * xx;
                    acc[t][0] += xx * r0[0]; acc[t][1] += xx * r0[1]; acc[t][2] += xx * r0[2]; acc[t][3] += xx * r0[3]; acc[t][4] += xx * r1[0]; acc[t][5] += xx * r1[1]; acc[t][6] += xx * r1[2]; acc[t][7] += xx * r1[3]; } } }
#pragma unroll
        for (int t = 0; t < 4; ++t) { ss[t] = wave_sum(ss[t]);
#pragma unroll
            for (int e = 0; e < 8; ++e) acc[t][e] = wave_sum(acc[t][e]); }
        float lg[8]; float mss = 0.f;
#pragma unroll
        for (int t = 0; t < 4; ++t) { if (lane == t) { mss = ss[t];
#pragma unroll
                for (int e = 0; e < 8; ++e) lg[e] = acc[t][e]; } }
        if (lane < 4) { const int tok = tok0 + lane;
            const float rstd = 1.0f / sqrtf(mss * (1.f / 1024.f) + NORM_EPS);
            int i1 = 0; float l1 = lg[0] * rstd;
#pragma unroll
            for (int e = 1; e < 8; ++e) { const float l = lg[e] * rstd; if (l > l1) { l1 = l; i1 = e; } }
            int i2 = -1; float l2 = -3.0e38f;
#pragma unroll
            for (int e = 0; e < 8; ++e) { const float l = lg[e] * rstd; if (e != i1 && l > l2) { l2 = l; i2 = e; } }
            const float e2 = __expf(l2 - l1); const float ga = 1.f / (1.f + e2), gb = e2 / (1.f + e2);
            TE[tok * 2] = i1; TE[tok * 2 + 1] = i2; TG[tok * 2] = ga; TG[tok * 2 + 1] = gb; R3[tok] = rstd;
            atomicAdd((int*)&lcnt[i1], 1); atomicAdd((int*)&lcnt[8 + i2], 1); } }
    __syncthreads();
    if (tid < 16) wsp<int>(F.ws, WS_CNT)[F.vcu * 16 + tid] = lcnt[tid];
}
__device__ __forceinline__ void phase_place(const Frame& F) {
    const int tid = F.tid;
    LAS int* tab = (LAS int*)(F.lds + MOE_OFF);
    LAS int* C = (LAS int*)F.lds;
    LAS int* TEl = (LAS int*)(F.lds + 32768); LAS float* TGl = (LAS float*)(F.lds + 32768 + 1024);
    const int* CNT = wsp<int>(F.ws, WS_CNT); const int tpb = M_TOK / F.G;
    __syncthreads();
    for (int i = tid; i < F.G * 16; i += 512) C[i] = CNT[i];
    if (tid < 2 * tpb) { TEl[tid] = wsp<int>(F.ws, WS_TOKE)[F.vcu * tpb * 2 + tid]; TGl[tid] = wsp<float>(F.ws, WS_TOKG)[F.vcu * tpb * 2 + tid]; }
    __syncthreads();
    if (tid < 16) { int off = 0, tot = 0; for (int bb = 0; bb < F.G; ++bb) { const int c = C[bb * 16 + tid]; if (bb < F.vcu) off += c; tot += c; } tab[tid] = off; tab[16 + tid] = tot;
        if (F.vcu == 0) wsp<int>(F.ws, WS_TOT)[tid] = tot; }
    __syncthreads();
    if (tid < 16) { const int s = tid >> 3, e = tid & 7; int run = tab[tid]; for (int q = 0; q < e; ++q) run += tab[16 + q] + tab[24 + q];
        if (s) run += tab[16 + e];
        int* RTK = wsp<int>(F.ws, WS_ROWTOK); float* RGT = wsp<float>(F.ws, WS_ROWGATE);
        for (int i = 0; i < tpb; ++i) { if (TEl[i * 2 + s] == e) { RTK[run] = F.vcu * tpb + i; RGT[run] = TGl[i * 2 + s]; ++run; } } }
}
struct MoESched {
    pg8::GridOrder go; const LAS int* tab;
    const char* A; const char* Bt; size_t a_rowbytes, b_expert_bytes, b_tile_bytes; bool gather; int nt_;
    __device__ bool next(int i, pg8::Unit& u) const {
        int pm, pn; if (!go.tile(i, pm, pn)) return false;
        int e = 0;
#pragma unroll
        for (int q = 1; q < 8; ++q) if (pm >= tab[16 + q]) e = q;
        e = __builtin_amdgcn_readfirstlane(e);
        const int mt = pm - __builtin_amdgcn_readfirstlane(tab[16 + e]); const int row0 = __builtin_amdgcn_readfirstlane(tab[e]) + 256 * mt; int nr = __builtin_amdgcn_readfirstlane(tab[8 + e]) - 256 * mt; nr = nr > 256 ? 256 : nr;
        u.pm = pm; u.pn = pn; u.e = e; u.row0 = row0; u.nrows = nr; u.nt = nt_; u.flags = 0;
        u.a = gather ? A : A + (size_t)row0 * a_rowbytes; u.b = Bt + (size_t)e * b_expert_bytes + (size_t)pn * b_tile_bytes + (e >= 6 ? WEGU_HI_SHIFT : (size_t)0); return true;
    }
};
struct MoEDownSched {
    const LAS int* tab; const char* A; const char* Bt; int nmt, c, round;
    __device__ void fill(pg8::Unit& u, int pm, int pn, int kp, int nt, int flags) const {
        int e = 0;
#pragma unroll
        for (int q = 1; q < 8; ++q) if (pm >= tab[16 + q]) e = q;
        e = __builtin_amdgcn_readfirstlane(e);
        const int mt = pm - __builtin_amdgcn_readfirstlane(tab[16 + e]); const int row0 = __builtin_amdgcn_readfirstlane(tab[e]) + 256 * mt; int nr = __builtin_amdgcn_readfirstlane(tab[8 + e]) - 256 * mt; nr = nr > 256 ? 256 : nr;
        u.pm = pm; u.pn = pn; u.e = e; u.row0 = row0; u.nrows = nr; u.nt = nt; u.flags = flags;
        u.a = A + (size_t)row0 * (D_FFE * 2) + (size_t)kp * 512 * 2; u.b = Bt + (size_t)e * ((size_t)1024 * D_FFE * 2) + (size_t)pn * ((size_t)256 * D_FFE * 2) + (size_t)kp * 512 * 2;
    }
    __device__ bool next(int i, pg8::Unit& u) const {
        if (i != 0) return false;
        if (round == 0) { const int pm = 8 * (c & 7) + ((c >> 3) & 7), pn = c >> 6; if (pm >= nmt) return false; fill(u, pm, pn, 0, D_FFE / 64, 0); return true; }
        { const int t = c / 7, kp = c % 7; const int pm = 64 + (t >> 2), pn = t & 3; if (pm >= nmt || t >= 36) return false; fill(u, pm, pn, kp, 8, 1 + c); return true; }
        return false;
    }
};
__device__ __forceinline__ int moe_table(const Frame& F, int mode) {
    LAS int* tab = (LAS int*)(F.lds + MOE_OFF);
    __syncthreads();
    if (F.tid == 0) { const int* TOT = wsp<int>(F.ws, WS_TOT); int rs = 0, ts = 0;
        for (int e = 0; e < 8; ++e) { const int c0 = TOT[e], c1 = TOT[8 + e]; const int st = rs + (mode == 1 ? c0 : 0), c = mode == 0 ? c0 : (mode == 1 ? c1 : c0 + c1);
            tab[e] = st; tab[8 + e] = c; tab[16 + e] = ts; rs += c0 + c1; ts += (c + 255) >> 8; }
        tab[24] = ts; }
    __syncthreads();
    return __builtin_amdgcn_readfirstlane(tab[24]);
}

constexpr size_t A_PART = A_WEGU;
__device__ __forceinline__ void moe_tail_reduce(const Frame& F, int s) {
    const int nmt = moe_table(F, s); const LAS int* tab = (const LAS int*)(F.lds + MOE_OFF);
    const int R = (nmt - 64) * 4; const int gw = F.vcu * NWAVES + F.wave, lane = F.lane;
    const float* part = wsp<float>(F.ws, A_PART + (size_t)s * 56 * MiB); const int* RTK = wsp<int>(F.ws, WS_ROWTOK); const float* RGT = wsp<float>(F.ws, WS_ROWGATE);
    for (int idx = gw; idx < R * 256; idx += F.G * NWAVES) { const int t = idx >> 8, r = idx & 255; const int pm = 64 + (t >> 2), pn = t & 3;
        int e = 0;
#pragma unroll
        for (int q = 1; q < 8; ++q) if (pm >= tab[16 + q]) e = q;
        const int mt = pm - tab[16 + e]; const int row0 = tab[e] + 256 * mt; const int nr = tab[8 + e] - 256 * mt;
        if (r < nr) { const int tok = RTK[row0 + r] & 16383; const float gt = RGT[row0 + r];
            f32x4 a = {0.f, 0.f, 0.f, 0.f};
#pragma unroll
            for (int kp = 0; kp < 7; ++kp) a += *(const f32x4*)(part + ((size_t)(t * 7 + kp) * 256 + r) * 256 + 4 * lane);
            float* op = F.out + (size_t)tok * 1024 + 256 * pn + 4 * lane; f32x4 o = *(const f32x4*)op; o += a * gt; *(f32x4*)op = o; } }
}

constexpr int N_PHASES = 21;
__global__ void __launch_bounds__(NWAVES * 64, 2) mk_fwd(Args args) {
    extern __shared__ __attribute__((aligned(16))) unsigned char lds_raw[];
    Frame F; F.lds = (LAS unsigned char*)lds_raw; F.ws = args.ws; F.in = args.in; F.out = args.out;
    F.tid = threadIdx.x; F.lane = F.tid & 63; F.wave = __builtin_amdgcn_readfirstlane(F.tid >> 6);
    F.G = gridDim.x; { const int bx = blockIdx.x; F.vcu = (F.G % 8 == 0) ? (bx % 8) * (F.G / 8) + bx / 8 : bx; }
    volatile LAS unsigned* MISC = (volatile LAS unsigned*)(F.lds + MISC_OFF);
    if (F.tid < 64) MISC[F.tid] = 0u;
    __syncthreads();
    XcdBarrier bar; bar.bar = (unsigned*)(args.ws + WS_CTL) + CW_BAR; bar.x = 0; bar.st = nullptr;
    const int lo = args.ph_lo, hi = args.ph_hi;
    const bool multi = (hi - lo) > 1;
    if (multi) bar = xcd_barrier_post((unsigned*)(args.ws + WS_CTL) + CW_BAR, MISC + 8);
#ifdef PH_ONLY
#define IN(k) ((k) == PH_ONLY && lo <= (k) && (k) < hi)
#else
#define IN(k) (lo <= (k) && (k) < hi)
#endif
#define SEAM(k) do { if (IN(k) && IN((k) + 1)) xcd_barrier(bar); } while (0)
    unsigned char* ws = args.ws; const int cid = (int)blockIdx.x;
#define REFRESH() do { int t_ = threadIdx.x; asm volatile("" : "+v"(t_)); F.tid = t_; F.lane = t_ & 63; F.wave = __builtin_amdgcn_readfirstlane(t_ >> 6); unsigned long long w_ = (unsigned long long)args.ws; asm volatile("" : "+s"(w_)); F.ws = (unsigned char*)w_; ws = F.ws; } while (0)
    LAS unsigned char* ring = F.lds;

#ifndef MK_REP_MASK
#define MK_REP_MASK 0u
#endif
#define REPS(k) ((int)(((unsigned)(MK_REP_MASK) >> (k)) & 1u))
#define PHASE(k, ...) do { if (IN(k)) { for (int rep_ = 0; rep_ <= REPS(k); ++rep_) { if (rep_) xcd_barrier(bar); REFRESH(); __VA_ARGS__ } } SEAM(k); } while (0)
    PHASE(0, phase_prologue(F););
    PHASE(1, {
        pg8::DenseSched S; S.init(wsp<bf16_t>(ws, WS_XB), wsp<bf16_t>(ws, WS_WIN0), M_TOK, E_IN, 1024, F.G, cid);
        EpiScaleBf16 E{wsp<bf16_t>(ws, A_P0), E_IN, wsp<float>(ws, WS_SSQ0)};
        pg8::gemm_phase<EpiScaleBf16, pg8::DenseSched, false>(F.tid, ring, 1024, S, E, nullptr);
        if (F.G == 256 && cid >= 128 && rep_ == 0) { REFRESH(); conv_group(F, 1, (cid - 128) * NWAVES + F.wave, 128 * NWAVES); } });
    PHASE(2, phase_prep0(F););
    PHASE(3, {
        LowRankSched S; S.init(wsp<bf16_t>(ws, A_AP), wsp<bf16_t>(ws, WS_WLR), F.G, cid);
        EpiLowRank E{ws, F.in};
        pg8::gemm_phase<EpiLowRank, LowRankSched, false>(F.tid, ring, 256, S, E, nullptr); });
    PHASE(4, phase_cscan_attn_split(F););
    PHASE(5, phase_rwkv_post(F););
    PHASE(6, {
        pg8::DenseSched S; S.init(wsp<bf16_t>(ws, A_YCAT), wsp<bf16_t>(ws, WS_WOUT0), M_TOK, 1024, 1024, F.G, cid);
        EpiResidBf E{rep_ ? wsp<bf16_t>(ws, A_YF) : wsp<bf16_t>(ws, WS_XB), nullptr, rep_ ? wsp<float>(ws, WS_SSQ0) : wsp<float>(ws, WS_SSQ1)};
        pg8::gemm_phase<EpiResidBf, pg8::DenseSched, false>(F.tid, ring, 1024, S, E, nullptr); });
    PHASE(7, {
        pg8::DenseSched S; S.init(wsp<bf16_t>(ws, WS_XB), wsp<bf16_t>(ws, WS_WGU0), M_TOK, 2 * D_FF, 1024, F.G, cid);
        EpiSwiGLU E{wsp<bf16_t>(ws, A_HID0), D_FF, wsp<float>(ws, WS_SSQ1)};
        pg8::gemm_phase<EpiSwiGLU, pg8::DenseSched, false>(F.tid, ring, 1024, S, E, nullptr);
        if (F.G == 256 && cid >= 128 && rep_ == 0) { REFRESH(); conv_group(F, 2, (cid - 128) * NWAVES + F.wave, 128 * NWAVES); } });
    PHASE(8, {
        pg8::DenseSched S; S.init(wsp<bf16_t>(ws, A_HID0), wsp<bf16_t>(ws, WS_WD0), M_TOK, 1024, D_FF, F.G, cid);
        EpiResidBf E{rep_ ? wsp<bf16_t>(ws, A_YF) : wsp<bf16_t>(ws, WS_XB), nullptr, rep_ ? wsp<float>(ws, WS_SSQ0) : wsp<float>(ws, WS_SSQ2)};
        pg8::gemm_phase<EpiResidBf, pg8::DenseSched, false>(F.tid, ring, D_FF, S, E, nullptr); });
    PHASE(9, {
        pg8::DenseSched S; S.init(wsp<bf16_t>(ws, WS_XB), wsp<bf16_t>(ws, WS_WIN1), M_TOK, 3072, 1024, F.G, cid);
        EpiScaleBf16 E{wsp<bf16_t>(ws, A_P1), O_INP, wsp<float>(ws, WS_SSQ2)};
        pg8::gemm_phase<EpiScaleBf16, pg8::DenseSched, false>(F.tid, ring, 1024, S, E, nullptr);
        REFRESH(); phase_gd(F); });
    PHASE(10, phase_gla_prep(F););
    PHASE(11, phase_gla_main(F););
    PHASE(12, phase_gla_post(F););
    PHASE(13, {
        pg8::DenseSched S; S.init(wsp<bf16_t>(ws, A_GOUT), wsp<bf16_t>(ws, WS_WOUT1), M_TOK, 1024, 1024, F.G, cid);
        EpiResidBf E{rep_ ? wsp<bf16_t>(ws, A_QHAT) : wsp<bf16_t>(ws, WS_XB), rep_ ? wsp<float>(ws, A_OF) : F.out, nullptr};
        pg8::gemm_phase<EpiResidBf, pg8::DenseSched, false>(F.tid, ring, 1024, S, E, nullptr); });
    PHASE(14, for (int q_ = 0; q_ <= (int)(((MK_REP_SUB) >> 2) & 1u); ++q_) { phase_route(F); __syncthreads(); REFRESH(); }
              for (int q_ = 0; q_ <= (int)(((MK_REP_SUB) >> 3) & 1u); ++q_) { phase_conv_experts(F); __syncthreads(); REFRESH(); });
    PHASE(15, phase_place(F););
    PHASE(16, {
        const int nmt = moe_table(F, 2);
        MoESched S; S.go.init(nmt, 2 * D_FFE / 256, F.G, cid); S.tab = (const LAS int*)(F.lds + MOE_OFF);
        S.A = (const char*)wsp<bf16_t>(ws, WS_XB); S.Bt = (const char*)wsp<bf16_t>(ws, A_WEGU); S.a_rowbytes = 0; S.b_expert_bytes = (size_t)2 * D_FFE * 1024 * 2; S.b_tile_bytes = (size_t)256 * 1024 * 2; S.gather = true; S.nt_ = 16;
        const int* rtk = wsp<int>(ws, WS_ROWTOK);
        EpiSwiGLUMoE E{wsp<bf16_t>(ws, A_HID1), wsp<float>(ws, WS_RSTD3), rtk};
        pg8::gemm_phase<EpiSwiGLUMoE, MoESched, true>(F.tid, ring, 1024, S, E, rtk); });
#pragma unroll 1
    for (int s = 0; s < 2; ++s) {
        PHASE(17 + s, {
            const int nmt = moe_table(F, s);
            MoEDownSched S; S.tab = (const LAS int*)(F.lds + MOE_OFF); S.A = (const char*)wsp<bf16_t>(ws, A_HID1); S.Bt = (const char*)wsp<bf16_t>(ws, A_WED); S.nmt = nmt; S.c = cid; S.round = 0;
            EpiMoEDown E{F.out, wsp<int>(ws, WS_ROWTOK), wsp<float>(ws, WS_ROWGATE)};
            pg8::gemm_phase<EpiMoEDown, MoEDownSched, false>(F.tid, ring, D_FFE, S, E, nullptr);
            REFRESH(); S.round = 1; EpiPart EP{wsp<float>(ws, A_PART + (size_t)s * 56 * MiB)};
            pg8::gemm_phase<EpiPart, MoEDownSched, false>(F.tid, ring, D_FFE, S, EP, nullptr); });
    }
    PHASE(19, moe_tail_reduce(F, 0););
    PHASE(20, moe_tail_reduce(F, 1););
#undef PHASE
#undef REPS
#undef IN
#undef SEAM
}

extern "C" void kernel_launch(void* const* d_in, const int* in_sizes, int n_in, void* d_out, int out_size, void* d_ws, size_t ws_size, hipStream_t stream) {
    static int grid = 0;
    if (grid == 0) {
        if (n_in != 38 || out_size != M_TOK * D_MODEL || ws_size < WS_END) { fprintf(stderr, "kernel_launch: unexpected shapes: n_in %d out %d ws %zu (need %zu)\n", n_in, out_size, ws_size, (size_t)WS_END); grid = -1; return; }
        int dev = 0, cus = 0;
        if (hipGetDevice(&dev) != hipSuccess || hipDeviceGetAttribute(&cus, hipDeviceAttributeMultiprocessorCount, dev) != hipSuccess) { grid = -1; return; }
        if (hipFuncSetAttribute((const void*)mk_fwd, hipFuncAttributeMaxDynamicSharedMemorySize, LDS_BYTES) != hipSuccess) { fprintf(stderr, "kernel_launch: hipFuncSetAttribute failed\n"); grid = -1; return; }
        (void)hipGetLastError();
        grid = cus;
        if (grid != 256) fprintf(stderr, "kernel_launch: note: %d CUs (built for 256)\n", grid);
    }
    if (grid < 0) return;
    (void)hipMemsetAsync((char*)d_ws + WS_CTL, 0, CTL_ZERO_BYTES, stream);
    Args a{};
    for (int i = 0; i < 38; ++i) a.in[i] = (const float*)d_in[i];
    a.out = (float*)d_out; a.ws = (unsigned char*)d_ws;
#if MK_N_LAUNCHES == 1
    a.ph_lo = 0; a.ph_hi = N_PHASES - 1 + 0;
    a.ph_hi = 21;
    hipLaunchKernelGGL(mk_fwd, dim3(grid), dim3(NWAVES * 64), LDS_BYTES, stream, a);
#else
#ifndef MK_LAST_PHASE
#define MK_LAST_PHASE 20
#endif
    for (int p = 0; p < MK_LAST_PHASE; ++p) { a.ph_lo = p; a.ph_hi = p + 1; hipLaunchKernelGGL(mk_fwd, dim3(grid), dim3(NWAVES * 64), LDS_BYTES, stream, a); }
#endif
}
```

```cpp
#include <hip/hip_runtime.h>
#include <cstdio>
#include <cstdint>

#ifndef MK_N_LAUNCHES
#define MK_N_LAUNCHES 1
#define MK_REP_MASK 0u
#define MK_REP_SUB 0u
#ifndef MK_REP_SUB
#define MK_REP_SUB 0u
#endif
#endif

#define GAS __attribute__((address_space(1)))
#define LAS __attribute__((address_space(3)))
typedef unsigned short bf16_t;
typedef short bf16x8 __attribute__((ext_vector_type(8)));
typedef short bf16x4 __attribute__((ext_vector_type(4)));
typedef float f32x4 __attribute__((ext_vector_type(4)));
typedef float f32x2 __attribute__((ext_vector_type(2)));
typedef float f32x16 __attribute__((ext_vector_type(16)));
typedef unsigned u32x4 __attribute__((ext_vector_type(4)));
typedef unsigned u32x2 __attribute__((ext_vector_type(2)));
typedef __bf16 bf16x2_t __attribute__((ext_vector_type(2)));

constexpr int D_MODEL = 1024, BATCH = 8, SEQ = 2048, M_TOK = BATCH * SEQ;
constexpr int HD = 64;
constexpr int RW_HEADS = 8, RW_DIM = 512, RW_IN = 1792;
constexpr int ATT_HEADS = 8, ATT_KV = 2;
constexpr int E_IN = 2560;
constexpr int GLA_H = 4, GLA_DK = 512, GLA_DV = 1024, GLA_DKH = 128, GLA_DVH = 256, GLA_R = 16;
constexpr int O_IN = 3088, O_INP = 3328;
constexpr int D_FF = 2816, NEXP = 8, D_FFE = 3584;
constexpr float NORM_EPS = 1e-6f;

constexpr size_t MiB = 1u << 20;
constexpr size_t WS_CTL = 0, CTL_ZERO_BYTES = 1 * MiB;
constexpr size_t WS_SSQ0 = 1 * MiB, WS_SSQ1 = 2 * MiB, WS_SSQ2 = 3 * MiB;
constexpr size_t WS_RSTD3 = 4 * MiB;
constexpr size_t WS_TOKE = WS_RSTD3 + 65536;
constexpr size_t WS_TOKG = WS_TOKE + 131072;
constexpr size_t WS_CNT = WS_TOKG + 131072;
constexpr size_t WS_TOT = WS_CNT + 16384;
constexpr size_t WS_ROWTOK = WS_TOT + 256;
constexpr int ROWS_PER_SLOT = M_TOK + 256;
constexpr size_t WS_ROWGATE = WS_ROWTOK + (size_t)2 * ROWS_PER_SLOT * 4;
constexpr size_t WS_DECS = 6 * MiB;
constexpr size_t WS_ROPE = 7 * MiB;
constexpr size_t WS_XB = 8 * MiB;
constexpr size_t WS_WIN0 = 40 * MiB, WS_WLR = 45 * MiB, WS_WOUT0 = 47 * MiB, WS_WGU0 = 49 * MiB, WS_WD0 = 60 * MiB, WS_WIN1 = 66 * MiB, WS_WOUT1 = 73 * MiB;
constexpr size_t AR = 75 * MiB;
constexpr size_t A_P0 = AR + 0, A_RS = AR + 80 * MiB, A_KS = AR + 96 * MiB, A_VS = AR + 112 * MiB, A_NKK = AR + 128 * MiB, A_AP = AR + 144 * MiB;
constexpr size_t A_QH = AR + 152 * MiB, A_KH = AR + 168 * MiB, A_VT0 = AR + 172 * MiB;
constexpr size_t A_LWF = AR + 176 * MiB, A_LWB = AR + 192 * MiB, A_SGF = AR + 208 * MiB, A_SGB = AR + 224 * MiB;
constexpr size_t A_GG = AR + 272 * MiB, A_YF = AR + 0 * MiB, A_YB = AR + 16 * MiB, A_YCAT = AR + 32 * MiB;
constexpr size_t A_HID0 = AR + 0;
constexpr size_t A_P1 = AR + 0;
constexpr size_t A_QHAT = AR + 104 * MiB, A_K2T = AR + 120 * MiB;
constexpr size_t GLA_DIR_STRIDE = 32 * MiB;
constexpr size_t A_VT1 = AR + 168 * MiB, A_OF = AR + 200 * MiB, A_OB = AR + 232 * MiB, A_GOUT = AR + 104 * MiB;
constexpr size_t A_WEGU = 40 * MiB, A_HID1 = 96 * MiB, A_WEGU2 = 339 * MiB, A_WED = 395 * MiB;
constexpr int EGU_EARLY = 4;
constexpr size_t WEGU_HI_SHIFT = A_WEGU2 - (A_WEGU + (size_t)EGU_EARLY * 14 * MiB);
constexpr int ROWS_ALL = 2 * M_TOK + 256;
constexpr size_t WS_END = 451 * MiB;
static_assert(A_WEGU + (size_t)EGU_EARLY * 14 * MiB <= A_HID1 && A_HID1 + (size_t)ROWS_ALL * D_FFE * 2 <= A_WEGU2 && A_WEGU2 >= AR + 264 * MiB && A_WEGU2 + (size_t)(NEXP - EGU_EARLY) * 14 * MiB <= A_WED && A_WED + (size_t)NEXP * 1024 * D_FFE * 2 <= WS_END && 2 * ROWS_PER_SLOT >= ROWS_ALL, "ws map");
static_assert(A_GOUT + 32 * MiB <= A_VT1 && A_YCAT + 32 * MiB <= A_RS, "ws map");

constexpr int CW_BAR = 4096;

constexpr int RING_BYTES = 131072;
constexpr int LDS_BYTES = 147456;
constexpr int MISC_OFF = LDS_BYTES - 512;
constexpr int MOE_OFF = LDS_BYTES - 256;

__device__ __forceinline__ unsigned pk2(float lo, float hi) { f32x2 v = {lo, hi}; bf16x2_t b = __builtin_convertvector(v, bf16x2_t); return __builtin_bit_cast(unsigned, b); }
__device__ __forceinline__ bf16_t f2bf(float f) { return (bf16_t)(pk2(f, 0.f) & 0xffffu); }
__device__ __forceinline__ float bf2f(bf16_t h) { return __uint_as_float(((unsigned)h) << 16); }
__device__ __forceinline__ float bflo(unsigned w) { return __uint_as_float(w << 16); }
__device__ __forceinline__ float bfhi(unsigned w) { return __uint_as_float(w & 0xffff0000u); }
__device__ __forceinline__ float wave_sum(float v) {
#pragma unroll
    for (int o = 1; o < 64; o <<= 1) v += __shfl_xor(v, o);
    return v;
}
__device__ __forceinline__ float sigmoidf_(float x) { return 1.f / (1.f + __expf(-x)); }
__device__ __forceinline__ float siluf_(float x) { return x / (1.f + __expf(-x)); }
#define LDS_WAIT() asm volatile("s_waitcnt lgkmcnt(0)" ::: "memory")
#define VM_WAIT() asm volatile("s_waitcnt vmcnt(0)" ::: "memory")

#define XB_TMO      128
#define XB_XCNT(j)  (256  + 64 * (j))
#define XB_XSUB(j)  (1280 + 64 * (j))
#define XB_XGEN(j)  (2304 + 64 * (j))
#define XB_TOP      3328
#define XB_TOPGEN   3392
#define XCD_BAR_WORDS 3456
#define XB_SPIN_CAP (1u << 20)
__device__ __forceinline__ unsigned xb_ld(unsigned* p)              { return __hip_atomic_load(p, __ATOMIC_RELAXED, __HIP_MEMORY_SCOPE_AGENT); }
__device__ __forceinline__ unsigned xb_add(unsigned* p, unsigned v) { return __hip_atomic_fetch_add(p, v, __ATOMIC_RELAXED, __HIP_MEMORY_SCOPE_AGENT); }
__device__ __forceinline__ unsigned xb_xcc_id() { return (unsigned)__builtin_amdgcn_s_getreg((3 << 11) | 20) & 0xFu; }
#define XB_SPIN(cond, bar) do { unsigned _sp = 0; while (cond) { __builtin_amdgcn_s_sleep(1); \
    if ((++_sp & 255u) == 0u) { if (xb_ld(&(bar)[XB_TMO])) break; if (_sp > XB_SPIN_CAP) { atomicAdd(&(bar)[XB_TMO], 1u); break; } } } } while (0)
struct XcdBarrier { unsigned* bar; unsigned x; volatile LAS unsigned* st; };
__device__ __forceinline__ XcdBarrier xcd_barrier_post(unsigned* bar, volatile LAS unsigned* st) {
    XcdBarrier b; b.bar = bar; b.x = xb_xcc_id(); b.st = st;
    if (threadIdx.x == 0) (void)xb_add(&bar[XB_XCNT(b.x)], 1u);
    return b;
}
__device__ __forceinline__ void xcd_barrier_complete(unsigned* bar, unsigned x, unsigned& nloc, unsigned& nx) {
    const unsigned G = gridDim.x * gridDim.y * gridDim.z;
    unsigned sum, cnt, mine, sp = 0u;
    for (;;) {
        sum = 0u; cnt = 0u; mine = 0u;
#pragma unroll
        for (unsigned j = 0; j < 16; ++j) { const unsigned c = xb_ld(&bar[XB_XCNT(j)]); sum += c; cnt += (c > 0u) ? 1u : 0u; mine = (j == x) ? c : mine; }
        if (sum == G) break;
        __builtin_amdgcn_s_sleep(1);
        if ((++sp & 255u) == 0u) { if (xb_ld(&bar[XB_TMO])) break; if (sp > XB_SPIN_CAP) { atomicAdd(&bar[XB_TMO], 1u); break; } }
    }
    nloc = mine > 0u ? mine : 1u; nx = cnt > 0u ? cnt : 1u;
}
__device__ __forceinline__ void xcd_barrier(const XcdBarrier& b) {
    asm volatile("s_waitcnt vmcnt(0)" ::: "memory");
    __syncthreads();
    if (threadIdx.x == 0) {
        unsigned* bar = b.bar;
        __builtin_amdgcn_s_waitcnt(0);
        unsigned nloc = b.st[0], nx = b.st[1];
        if (nloc == 0u) { xcd_barrier_complete(bar, b.x, nloc, nx); b.st[0] = nloc; b.st[1] = nx; }
        const unsigned old = xb_add(&bar[XB_XSUB(b.x)], 1u);
        const unsigned gen = old / nloc;
        if (old + 1u == (gen + 1u) * nloc) {
            __builtin_amdgcn_fence(__ATOMIC_RELEASE, "agent");
            asm volatile("s_waitcnt vmcnt(0)" ::: "memory");
            const unsigned og = xb_add(&bar[XB_TOP], 1u);
            const unsigned tg = og / nx;
            if (og + 1u == (tg + 1u) * nx) xb_add(&bar[XB_TOPGEN], 1u);
            else XB_SPIN(xb_ld(&bar[XB_TOPGEN]) == tg, bar);
            __builtin_amdgcn_fence(__ATOMIC_ACQUIRE, "agent");
            xb_add(&bar[XB_XGEN(b.x)], 1u);
            asm volatile("s_waitcnt vmcnt(0)" ::: "memory");
        } else {
            XB_SPIN(xb_ld(&bar[XB_XGEN(b.x)]) == gen, bar);
            __builtin_amdgcn_fence(__ATOMIC_ACQUIRE, "agent");
            asm volatile("s_waitcnt vmcnt(0)" ::: "memory");
        }
    }
    __syncthreads();
}

namespace pg8 {
constexpr int BM = 256, BK = 64, HALF = 128, HTB = HALF * BK * 2, STAGE_BYTES = 8 * HTB, NXCD = 8, WGM = 4;
__host__ __device__ __forceinline__ int lds_byte(int r, int c) { const int st = (r >> 4) * 2 + (c >> 5), rr = r & 15, cc = c & 31, ob = rr * 64 + cc * 2; return st * 1024 + (ob ^ (((ob >> 9) & 1) << 5)); }
__host__ __device__ __forceinline__ void stage_rc(int b, int& R, int& C) { const int st = b / 1024, sb = b % 1024, swz = sb ^ (((sb >> 9) & 1) << 5); R = (st >> 1) * 16 + swz / 64; C = (st & 1) * 32 + (swz % 64) / 2; }
__host__ __device__ __forceinline__ int perm32(int rho) { const int n = rho >> 4, i = rho & 15; return 8 * (i >> 2) + 4 * n + (i & 3); }

struct Unit { const char* a; const char* b; int pm, pn; int row0, nrows, e; int nt, flags; };

struct GridOrder {
    int nM, nN, nwg, G, c;
    __device__ void init(int nM_, int nN_, int G_, int c_) { nM = nM_; nN = nN_; nwg = nM * nN; G = G_; c = c_; }
    __device__ bool tile(int i, int& pm, int& pn) const {
        const long L = (long)i * G + c; if (L >= nwg) return false;
        int wgid = (int)L; { const int q = nwg / NXCD, r = nwg % NXCD, xcd = wgid % NXCD, off = wgid / NXCD; wgid = (xcd < r ? xcd * (q + 1) : r * (q + 1) + (xcd - r) * q) + off; }
        const int nig = WGM * nN, gid = wgid / nig, fm = gid * WGM, gsz = (nM - fm) < WGM ? (nM - fm) : WGM;
        pm = fm + ((wgid % nig) % gsz); pn = (wgid % nig) / gsz; return true;
    }
};
struct DenseSched {
    GridOrder go; const char* A; const char* Bt; size_t tstep; int nt_;
    __device__ void init(const bf16_t* A_, const bf16_t* Bt_, int M, int N, int K, int G, int c) { go.init(M / BM, N / BM, G, c); A = (const char*)A_; Bt = (const char*)Bt_; tstep = (size_t)BM * K * 2; nt_ = K / BK; }
    __device__ bool next(int i, Unit& u) const { int pm, pn; if (!go.tile(i, pm, pn)) return false; u.pm = pm; u.pn = pn; u.a = A + (size_t)pm * tstep; u.b = Bt + (size_t)pn * tstep; u.row0 = pm * BM; u.nrows = BM; u.e = 0; u.nt = nt_; u.flags = 0; return true; }
};

template <class Epi, class Sched, bool GATHER>
__device__ __forceinline__ void gemm_phase(const int tid, LAS unsigned char* lds, const int K_, const Sched& S, const Epi& E, const int* gather_rows) {
    int K = K_; asm volatile("" : "+s"(K));
    const int wid = __builtin_amdgcn_readfirstlane(tid >> 6), lane = tid & 63, wr = wid >> 2, wc = wid & 3, fr = lane & 15, fq = lane >> 4;
    int sR[2], sC[2];
    unsigned voffB[2];
#pragma unroll
    for (int i = 0; i < 2; ++i) { int R, C; stage_rc(tid * 16 + i * 8192, R, C); sR[i] = R; sC[i] = C; const int Rb = Epi::PERM ? ((R & ~31) + perm32(R & 31)) : R; voffB[i] = (unsigned)(Rb * K + C) * 2u; }
    const size_t kstep = (size_t)(BK * 2);
    const size_t hstep = (size_t)HALF * K * 2;
    const unsigned ldsw = (unsigned)wid * 1024u;
    const int aoff = lds_byte(wr * 64 + fr, fq * 8), boff = lds_byte(wc * 32 + fr, fq * 8);
    unsigned cva[2][2], nva[2][2];
#define PG8_SETVA(va, u) do { _Pragma("unroll") for (int h_ = 0; h_ < 2; ++h_) _Pragma("unroll") for (int i_ = 0; i_ < 2; ++i_) { \
        if (GATHER) { int rr_ = (u).row0 + h_ * HALF + sR[i_]; const int rmax_ = (u).row0 + (u).nrows - 1; rr_ = rr_ > rmax_ ? rmax_ : rr_; int tk_ = gather_rows[rr_]; tk_ = tk_ < 0 ? 0 : (tk_ > 16383 ? 16383 : tk_); va[h_][i_] = (unsigned)(tk_ * K + sC[i_]) * 2u; } \
        else va[h_][i_] = (unsigned)((h_ * HALF + sR[i_]) * K + sC[i_]) * 2u; } } while (0)
#define PG8_SA(b, h) (((b) * 2 + (h)) * HTB)
#define PG8_SB(b, h) ((4 + (b) * 2 + (h)) * HTB)
#define PG8_STAGE2(bufoff, gbase, v0, v1) do { \
        __builtin_amdgcn_global_load_lds((const unsigned*)((const char*)(gbase) + (v0)), (LAS unsigned*)(lds + (bufoff) + ldsw), 16, 0, 0); \
        __builtin_amdgcn_global_load_lds((const unsigned*)((const char*)(gbase) + (v1)), (LAS unsigned*)(lds + (bufoff) + ldsw + 8192), 16, 0, 0); } while (0)
#define PG8_STAGEB(bufoff, gbase) PG8_STAGE2(bufoff, gbase, voffB[0], voffB[1])
#define PG8_STAGEA(bufoff, gbase, va, h) PG8_STAGE2(bufoff, gbase, va[h][0], va[h][1])
#define PG8_LDA(dst, b, h) do { _Pragma("unroll") for (int m = 0; m < 4; ++m) _Pragma("unroll") for (int k = 0; k < 2; ++k) dst[m][k] = *(const LAS bf16x8*)(lds + PG8_SA(b, h) + aoff + m * 2048 + k * 1024); } while (0)
#define PG8_LDB(dst, b, h) do { _Pragma("unroll") for (int n = 0; n < 2; ++n) _Pragma("unroll") for (int k = 0; k < 2; ++k) dst[n][k] = *(const LAS bf16x8*)(lds + PG8_SB(b, h) + boff + n * 2048 + k * 1024); } while (0)
#define PG8_MMA(ai, bj, At, Bt) do { __builtin_amdgcn_s_setprio(1); _Pragma("unroll") for (int m = 0; m < 4; ++m) _Pragma("unroll") for (int n = 0; n < 2; ++n) _Pragma("unroll") for (int k = 0; k < 2; ++k) \
        acc[ai][bj][m][n] = __builtin_amdgcn_mfma_f32_16x16x32_bf16(Bt[n][k], At[m][k], acc[ai][bj][m][n], 0, 0, 0); __builtin_amdgcn_s_setprio(0); } while (0)
#define PG8_WAIT_V(n) asm volatile("s_waitcnt vmcnt(" #n ")" ::: "memory")
#define PG8_WAIT_L(n) asm volatile("s_waitcnt lgkmcnt(" #n ")" ::: "memory")
#define PG8_BAR __builtin_amdgcn_s_barrier()
#define PG8_SCHED __builtin_amdgcn_sched_barrier(0)
    Unit cur, nxt; int ui = 0;
    if (!S.next(0, cur)) return;
    PG8_SETVA(cva, cur);
    f32x4 acc[2][2][4][2];
#pragma unroll
    for (int a = 0; a < 2; ++a)
#pragma unroll
        for (int b = 0; b < 2; ++b)
#pragma unroll
            for (int m = 0; m < 4; ++m)
#pragma unroll
                for (int n = 0; n < 2; ++n) acc[a][b][m][n] = (f32x4){0.f, 0.f, 0.f, 0.f};
    bf16x8 At[4][2], B0[2][2], B1[2][2];
    const char* cA = cur.a; const char* cB = cur.b;
    PG8_STAGEB(PG8_SB(0, 0), cB); PG8_STAGEB(PG8_SB(0, 1), cB + hstep); PG8_STAGEA(PG8_SA(0, 0), cA, cva, 0); PG8_STAGEA(PG8_SA(0, 1), cA, cva, 1);
    if (wr == 1) PG8_BAR;
    PG8_WAIT_V(2); PG8_BAR;
    PG8_STAGEB(PG8_SB(1, 0), cB + kstep); PG8_STAGEA(PG8_SA(1, 0), cA + kstep, cva, 0); PG8_STAGEB(PG8_SB(1, 1), cB + hstep + kstep);
    PG8_WAIT_V(6); PG8_BAR;
    for (;;) {
        const bool has_next = S.next(ui + 1, nxt);
        if (has_next) PG8_SETVA(nva, nxt);
        else {
#pragma unroll
            for (int h = 0; h < 2; ++h)
#pragma unroll
                for (int i = 0; i < 2; ++i) nva[h][i] = cva[h][i];
        }
        const char* nA = has_next ? nxt.a : cA; const char* nB = has_next ? nxt.b : cB;
        const int nt = cur.nt;
        for (int t = 0; t < nt; t += 2) {
            const bool last = (t == nt - 2);
            const char* a1 = cA + (size_t)(t + 1) * kstep;
            const char* a2 = last ? nA : cA + (size_t)(t + 2) * kstep; const char* b2 = last ? nB : cB + (size_t)(t + 2) * kstep;
            const char* a3 = a2 + kstep; const char* b3 = b2 + kstep;
            unsigned va2[2][2];
#pragma unroll
            for (int h = 0; h < 2; ++h)
#pragma unroll
                for (int i = 0; i < 2; ++i) va2[h][i] = (GATHER && last) ? nva[h][i] : cva[h][i];
            PG8_LDB(B0, 0, 0); PG8_LDB(B1, 0, 1); PG8_SCHED; PG8_LDA(At, 0, 0); PG8_STAGEA(PG8_SA(1, 1), a1, cva, 1);
            PG8_WAIT_V(8); PG8_WAIT_L(0); PG8_BAR; PG8_MMA(0, 0, At, B0); PG8_MMA(0, 1, At, B1); PG8_BAR; PG8_SCHED;
            PG8_LDA(At, 0, 1); PG8_STAGEB(PG8_SB(0, 0), b2); PG8_STAGEB(PG8_SB(0, 1), b2 + hstep); PG8_STAGEA(PG8_SA(0, 0), a2, va2, 0);
            PG8_WAIT_V(8); PG8_WAIT_L(0); PG8_BAR; PG8_MMA(1, 0, At, B0); PG8_MMA(1, 1, At, B1); PG8_BAR; PG8_SCHED;
            PG8_LDB(B0, 1, 0); PG8_LDB(B1, 1, 1); PG8_SCHED; PG8_LDA(At, 1, 0); PG8_STAGEA(PG8_SA(0, 1), a2, va2, 1);
            PG8_WAIT_V(8); PG8_WAIT_L(0); PG8_BAR; PG8_MMA(0, 0, At, B0); PG8_MMA(0, 1, At, B1); PG8_BAR; PG8_SCHED;
            PG8_LDA(At, 1, 1); PG8_STAGEB(PG8_SB(1, 0), b3); PG8_STAGEB(PG8_SB(1, 1), b3 + hstep); PG8_STAGEA(PG8_SA(1, 0), a3, va2, 0);
            PG8_WAIT_V(8); PG8_WAIT_L(0); PG8_BAR; PG8_MMA(1, 0, At, B0); PG8_MMA(1, 1, At, B1); PG8_BAR; PG8_SCHED;
        }
        if (wr == 0) PG8_BAR;
        E(acc, cur, wr, wc, fr, fq);
#if ((MK_REP_SUB) >> 5) & 1
        if constexpr (Epi::PURE) { asm volatile("" ::: "memory"); E(acc, cur, wr, wc, fr, fq); }
#endif
        if (!has_next) break;
#pragma unroll
        for (int a = 0; a < 2; ++a)
#pragma unroll
            for (int b = 0; b < 2; ++b)
#pragma unroll
                for (int m = 0; m < 4; ++m)
#pragma unroll
                    for (int n = 0; n < 2; ++n) acc[a][b][m][n] = (f32x4){0.f, 0.f, 0.f, 0.f};
        cur = nxt; cA = nA; cB = nB; ++ui;
#pragma unroll
        for (int h = 0; h < 2; ++h)
#pragma unroll
            for (int i = 0; i < 2; ++i) cva[h][i] = nva[h][i];
        if (wr == 1) PG8_BAR;
    }
    PG8_WAIT_V(0);
    PG8_BAR;
#undef PG8_SETVA
#undef PG8_SA
#undef PG8_SB
#undef PG8_STAGE2
#undef PG8_STAGEA
#undef PG8_STAGEB
#undef PG8_LDA
#undef PG8_LDB
#undef PG8_MMA
#undef PG8_WAIT_V
#undef PG8_WAIT_L
#undef PG8_BAR
#undef PG8_SCHED
}
}

__device__ __forceinline__ float rstd_from_ssq(const float* ssq, int row) {
    const f32x4* p = (const f32x4*)(ssq + (size_t)row * 16);
    const f32x4 a = p[0], b = p[1], c = p[2], d = p[3];
    const float s = (((a.x + a.y) + (a.z + a.w)) + ((b.x + b.y) + (b.z + b.w))) + (((c.x + c.y) + (c.z + c.w)) + ((d.x + d.y) + (d.z + d.w)));
    return 1.0f / sqrtf(s * (1.f / 1024.f) + NORM_EPS);
}
__device__ __forceinline__ u32x4 pack8(const f32x4 v0, const f32x4 v1) { u32x4 w; w.x = pk2(v0[0], v0[1]); w.y = pk2(v0[2], v0[3]); w.z = pk2(v1[0], v1[1]); w.w = pk2(v1[2], v1[3]); return w; }
__device__ __forceinline__ void unpack8(const u32x4 w, float (&f)[8]) { f[0] = bflo(w.x); f[1] = bfhi(w.x); f[2] = bflo(w.y); f[3] = bfhi(w.y); f[4] = bflo(w.z); f[5] = bfhi(w.z); f[6] = bflo(w.w); f[7] = bfhi(w.w); }
__device__ __forceinline__ u32x4 pack8f(const float (&f)[8]) { u32x4 w; w.x = pk2(f[0], f[1]); w.y = pk2(f[2], f[3]); w.z = pk2(f[4], f[5]); w.w = pk2(f[6], f[7]); return w; }

struct EpiScaleBf16 {
    static constexpr bool PERM = true; static constexpr bool PURE = true;
    bf16_t* O; int ldc; const float* ssq;
    __device__ __forceinline__ void operator()(const f32x4 (&acc)[2][2][4][2], const pg8::Unit& u, int wr, int wc, int fr, int fq) const {
        const int row0 = u.pm * 256 + wr * 64 + fr, col0 = u.pn * 256 + wc * 32 + 8 * fq;
#pragma unroll
        for (int ai = 0; ai < 2; ++ai)
#pragma unroll
            for (int m = 0; m < 4; ++m) { const int row = row0 + ai * 128 + m * 16; const float rs = rstd_from_ssq(ssq, row); bf16_t* rowp = O + (size_t)row * ldc + col0;
#pragma unroll
                for (int bj = 0; bj < 2; ++bj) *(u32x4*)(rowp + bj * 128) = pack8(acc[ai][bj][m][0] * rs, acc[ai][bj][m][1] * rs); }
    }
};
struct EpiResid {
    static constexpr bool PERM = true; static constexpr bool PURE = false;
    const float* base; float* out; bf16_t* xb; float* ssq;
    __device__ __forceinline__ void operator()(const f32x4 (&acc)[2][2][4][2], const pg8::Unit& u, int wr, int wc, int fr, int fq) const {
        const int row0 = u.pm * 256 + wr * 64 + fr, col0 = u.pn * 256 + wc * 32 + 8 * fq;
#pragma unroll
        for (int ai = 0; ai < 2; ++ai)
#pragma unroll
            for (int m = 0; m < 4; ++m) { const int row = row0 + ai * 128 + m * 16; const size_t off = (size_t)row * 1024 + col0; float ss = 0.f;
#pragma unroll
                for (int bj = 0; bj < 2; ++bj) { const f32x4 b0 = *(const f32x4*)(base + off + bj * 128), b1 = *(const f32x4*)(base + off + bj * 128 + 4);
                    const f32x4 o0 = b0 + acc[ai][bj][m][0], o1 = b1 + acc[ai][bj][m][1];
                    *(f32x4*)(out + off + bj * 128) = o0; *(f32x4*)(out + off + bj * 128 + 4) = o1;
                    ss += (o0[0] * o0[0] + o0[1] * o0[1]) + (o0[2] * o0[2] + o0[3] * o0[3]) + (o1[0] * o1[0] + o1[1] * o1[1]) + (o1[2] * o1[2] + o1[3] * o1[3]);
                    *(u32x4*)(xb + off + bj * 128) = pack8(o0, o1); }
                ss += __shfl_xor(ss, 16); ss += __shfl_xor(ss, 32);
                if (ssq && fq == 0) ssq[(size_t)row * 16 + u.pn * 4 + wc] = ss; }
    }
};
struct EpiResidBf {
    static constexpr bool PERM = true; static constexpr bool PURE = false;
    bf16_t* xb; float* out; float* ssq;
    __device__ __forceinline__ void operator()(const f32x4 (&acc)[2][2][4][2], const pg8::Unit& u, int wr, int wc, int fr, int fq) const {
        const int row0 = u.pm * 256 + wr * 64 + fr, col0 = u.pn * 256 + wc * 32 + 8 * fq;
#pragma unroll
        for (int ai = 0; ai < 2; ++ai)
#pragma unroll
            for (int m = 0; m < 4; ++m) { const int row = row0 + ai * 128 + m * 16; const size_t off = (size_t)row * 1024 + col0; float ss = 0.f;
#pragma unroll
                for (int bj = 0; bj < 2; ++bj) { const u32x4 bw = *(const u32x4*)(xb + off + bj * 128);
                    const f32x4 b0 = {bflo(bw.x), bfhi(bw.x), bflo(bw.y), bfhi(bw.y)}, b1 = {bflo(bw.z), bfhi(bw.z), bflo(bw.w), bfhi(bw.w)};
                    const f32x4 o0 = b0 + acc[ai][bj][m][0], o1 = b1 + acc[ai][bj][m][1];
                    if (out) { *(f32x4*)(out + off + bj * 128) = o0; *(f32x4*)(out + off + bj * 128 + 4) = o1; }
                    ss += (o0[0] * o0[0] + o0[1] * o0[1]) + (o0[2] * o0[2] + o0[3] * o0[3]) + (o1[0] * o1[0] + o1[1] * o1[1]) + (o1[2] * o1[2] + o1[3] * o1[3]);
                    *(u32x4*)(xb + off + bj * 128) = pack8(o0, o1); }
                ss += __shfl_xor(ss, 16); ss += __shfl_xor(ss, 32);
                if (ssq && fq == 0) ssq[(size_t)row * 16 + u.pn * 4 + wc] = ss; }
    }
};
struct EpiSwiGLU {
    static constexpr bool PERM = true; static constexpr bool PURE = true;
    bf16_t* H; int ldh; const float* ssq;
    __device__ __forceinline__ void operator()(const f32x4 (&acc)[2][2][4][2], const pg8::Unit& u, int wr, int wc, int fr, int fq) const {
        const int row0 = u.pm * 256 + wr * 64 + fr, hcol0 = u.pn * 128 + wc * 32 + 8 * fq;
#pragma unroll
        for (int ai = 0; ai < 2; ++ai)
#pragma unroll
            for (int m = 0; m < 4; ++m) { const int row = row0 + ai * 128 + m * 16; const float rs = rstd_from_ssq(ssq, row);
                f32x4 h[2];
#pragma unroll
                for (int n = 0; n < 2; ++n) { const f32x4 g = acc[ai][0][m][n] * rs, up = acc[ai][1][m][n] * rs;
#pragma unroll
                    for (int i = 0; i < 4; ++i) h[n][i] = siluf_(g[i]) * up[i]; }
                *(u32x4*)(H + (size_t)row * ldh + hcol0) = pack8(h[0], h[1]); }
    }
};
struct EpiSwiGLUMoE {
    static constexpr bool PERM = true; static constexpr bool PURE = true;
    bf16_t* H; const float* rstd3; const int* row_tok;
    __device__ __forceinline__ void operator()(const f32x4 (&acc)[2][2][4][2], const pg8::Unit& u, int wr, int wc, int fr, int fq) const {
        const int hcol0 = u.pn * 128 + wc * 32 + 8 * fq;
#pragma unroll
        for (int ai = 0; ai < 2; ++ai)
#pragma unroll
            for (int m = 0; m < 4; ++m) { const int rl = ai * 128 + wr * 64 + m * 16 + fr;
                if (rl < u.nrows) { const int grow = u.row0 + rl; const float rs = rstd3[row_tok[grow] & 16383];
                    f32x4 h[2];
#pragma unroll
                    for (int n = 0; n < 2; ++n) { const f32x4 g = acc[ai][0][m][n] * rs, up = acc[ai][1][m][n] * rs;
#pragma unroll
                        for (int i = 0; i < 4; ++i) h[n][i] = siluf_(g[i]) * up[i]; }
                    *(u32x4*)(H + (size_t)grow * D_FFE + hcol0) = pack8(h[0], h[1]); } }
    }
};
struct EpiMoEDown {
    static constexpr bool PERM = true; static constexpr bool PURE = false;
    float* out; const int* row_tok; const float* row_gate;
    __device__ __forceinline__ void operator()(const f32x4 (&acc)[2][2][4][2], const pg8::Unit& u, int wr, int wc, int fr, int fq) const {
        const int col0 = u.pn * 256 + wc * 32 + 8 * fq;
#pragma unroll
        for (int ai = 0; ai < 2; ++ai)
#pragma unroll
            for (int m = 0; m < 4; ++m) { const int rl = ai * 128 + wr * 64 + m * 16 + fr;
                if (rl < u.nrows) { const int grow = u.row0 + rl; const int tok = row_tok[grow] & 16383; const float gt = row_gate[grow]; float* op = out + (size_t)tok * 1024 + col0;
#pragma unroll
                    for (int bj = 0; bj < 2; ++bj) { f32x4 b0 = *(const f32x4*)(op + bj * 128), b1 = *(const f32x4*)(op + bj * 128 + 4);
                        b0 += acc[ai][bj][m][0] * gt; b1 += acc[ai][bj][m][1] * gt; *(f32x4*)(op + bj * 128) = b0; *(f32x4*)(op + bj * 128 + 4) = b1; } } }
    }
};
struct EpiPart {
    static constexpr bool PERM = true; static constexpr bool PURE = true;
    float* part;
    __device__ __forceinline__ void operator()(const f32x4 (&acc)[2][2][4][2], const pg8::Unit& u, int wr, int wc, int fr, int fq) const {
        float* pb = part + (size_t)(u.flags - 1) * 65536; const unsigned o0 = (unsigned)((wr * 64 + fr) * 256 + wc * 32 + 8 * fq);
#pragma unroll
        for (int ai = 0; ai < 2; ++ai)
#pragma unroll
            for (int m = 0; m < 4; ++m)
#pragma unroll
                for (int bj = 0; bj < 2; ++bj) { float* pp = pb + o0 + (ai * 128 + m * 16) * 256 + bj * 128; *(f32x4*)pp = acc[ai][bj][m][0]; *(f32x4*)(pp + 4) = acc[ai][bj][m][1]; }
    }
};
struct LowRankSched {
    pg8::GridOrder go; const char* A; const char* Bt;
    __device__ void init(const bf16_t* A_, const bf16_t* Bt_, int G, int c) { go.init(M_TOK / 256, 8, G, c); A = (const char*)A_; Bt = (const char*)Bt_; }
    __device__ bool next(int i, pg8::Unit& u) const { int pm, pn; if (!go.tile(i, pm, pn)) return false; u.pm = pm; u.pn = pn; u.a = A + (size_t)pm * (256 * 256 * 2); u.b = Bt + (size_t)pn * (256 * 256 * 2);
        u.row0 = pm * 256; u.nrows = 256; u.e = 0; int two = 2; asm volatile("" : "+s"(two)); u.nt = two; u.flags = 0; return true; }
};
struct EpiLowRank {
    static constexpr bool PERM = true; static constexpr bool PURE = true;
    unsigned char* ws; const float* const* in;
    __device__ __forceinline__ void operator()(const f32x4 (&acc)[2][2][4][2], const pg8::Unit& u, int wr, int wc, int fr, int fq) const {
        const int kind = u.pn >> 1; const int row0 = u.pm * 256 + wr * 64 + fr; const int c0 = (u.pn & 1) * 256 + wc * 32 + 8 * fq;
        const float* zp = in[kind == 0 ? 4 : kind == 1 ? 6 : kind == 2 ? 8 : 10];
        bf16_t* o1 = (bf16_t*)(ws + (kind == 0 ? A_LWF : kind == 1 ? A_LWB : kind == 2 ? A_SGF : A_SGB));
        const float sc = kind < 2 ? -0.87506126f : 1.f;
#pragma unroll
        for (int bj = 0; bj < 2; ++bj) { const int c = c0 + bj * 128;
            const f32x4 z0 = *(const f32x4*)(zp + c), z1 = *(const f32x4*)(zp + c + 4);
#pragma unroll
            for (int ai = 0; ai < 2; ++ai)
#pragma unroll
                for (int m = 0; m < 4; ++m) { const int row = row0 + ai * 128 + m * 16; f32x4 v0 = acc[ai][bj][m][0] + z0, v1 = acc[ai][bj][m][1] + z1;
#pragma unroll
                    for (int i = 0; i < 4; ++i) { v0[i] = sc * sigmoidf_(v0[i]); v1[i] = sc * sigmoidf_(v1[i]); }
                    *(u32x4*)(o1 + (size_t)row * 512 + c) = pack8(v0, v1); } }
    }
};

constexpr int NWAVES = 8;
struct Args { const float* in[38]; float* out; unsigned char* ws; int ph_lo, ph_hi; };
struct Frame {
    LAS unsigned char* lds; unsigned char* ws; const float* const* in; float* out;
    int tid, lane, wave, vcu, G;
};
template <class T> __device__ __forceinline__ T* wsp(unsigned char* ws, size_t off) { return (T*)(ws + off); }

__device__ __forceinline__ void conv_item(const float* W, int ldw, int k0, int n0, int ncols, const float* gain, bf16_t* WT, int ldk, int dst_row0, LAS float* scr, int lane) {
#pragma unroll
    for (int i = 0; i < 8; ++i) { const int kk = (lane >> 3) + 8 * i, c4 = 4 * (lane & 7);
        f32x4 v = __builtin_nontemporal_load((const f32x4*)(W + (size_t)(k0 + kk) * ldw + n0 + c4));
        if (gain) v = v * gain[k0 + kk];
        scr[kk * 33 + c4 + 0] = v[0]; scr[kk * 33 + c4 + 1] = v[1]; scr[kk * 33 + c4 + 2] = v[2]; scr[kk * 33 + c4 + 3] = v[3]; }
    LDS_WAIT(); asm volatile("" ::: "memory");
    const int c = lane & 7;
#pragma unroll
    for (int j = 0; j < 4; ++j) { const int n = (lane >> 3) + 8 * j; const LAS float* s = scr + (8 * c) * 33 + n;
        u32x4 o; o.x = pk2(s[0 * 33], s[1 * 33]); o.y = pk2(s[2 * 33], s[3 * 33]); o.z = pk2(s[4 * 33], s[5 * 33]); o.w = pk2(s[6 * 33], s[7 * 33]);
        if (n < ncols) *(u32x4*)(WT + (size_t)(dst_row0 + n) * ldk + k0 + 8 * c) = o; }
    LDS_WAIT(); asm volatile("" ::: "memory");
}
__device__ __forceinline__ void conv_job_item(int r, const float* W, int ldw, int col0, int nblk, int ncols_last, const float* gain, bf16_t* WT, int ldk, int mode, int dst_off, LAS float* scr, int lane) {
    const int kb = r / nblk, nb = r % nblk; const int nrel = 32 * nb;
    int drow = dst_off + nrel; if (mode) drow = 256 * (nrel >> 7) + (nrel & 127) + (mode == 2 ? 128 : 0);
    conv_item(W, ldw, 64 * kb, col0 + nrel, (nb == nblk - 1) ? ncols_last : 32, gain, WT, ldk, drow, scr, lane);
}
struct ConvItem { const float* src; const float* gain; bf16_t* dst; int ldw, ldk, ncols; };
__device__ __forceinline__ ConvItem conv_desc(int r, const float* W, int ldw, int col0, int nblk, int ncols_last, const float* gain, bf16_t* WT, int ldk, int mode, int dst_off) {
    const int kb = r / nblk, nb = r % nblk; const int nrel = 32 * nb;
    int drow = dst_off + nrel; if (mode) drow = 256 * (nrel >> 7) + (nrel & 127) + (mode == 2 ? 128 : 0);
    ConvItem c; c.src = W + (size_t)(64 * kb) * ldw + col0 + nrel; c.gain = gain ? gain + 64 * kb : nullptr; c.dst = WT + (size_t)drow * ldk + 64 * kb; c.ldw = ldw; c.ldk = ldk; c.ncols = (nb == nblk - 1) ? ncols_last : 32; return c;
}
__device__ __forceinline__ void conv_ld(f32x4 (&v)[8], const ConvItem& c, int lane) {
#pragma unroll
    for (int i = 0; i < 8; ++i) { const int kk = (lane >> 3) + 8 * i, c4 = 4 * (lane & 7); v[i] = __builtin_nontemporal_load((const f32x4*)(c.src + (size_t)kk * c.ldw + c4)); }
}
__device__ __forceinline__ void conv_fin(const f32x4 (&v)[8], const ConvItem& c, LAS float* scr, int lane) {
#pragma unroll
    for (int i = 0; i < 8; ++i) { const int kk = (lane >> 3) + 8 * i, c4 = 4 * (lane & 7); f32x4 x = v[i]; if (c.gain) x = x * c.gain[kk];
        scr[kk * 33 + c4 + 0] = x[0]; scr[kk * 33 + c4 + 1] = x[1]; scr[kk * 33 + c4 + 2] = x[2]; scr[kk * 33 + c4 + 3] = x[3]; }
    LDS_WAIT(); asm volatile("" ::: "memory");
    const int cc = lane & 7;
#pragma unroll
    for (int j = 0; j < 4; ++j) { const int n = (lane >> 3) + 8 * j; const LAS float* sp = scr + (8 * cc) * 33 + n;
        u32x4 o; o.x = pk2(sp[0 * 33], sp[1 * 33]); o.y = pk2(sp[2 * 33], sp[3 * 33]); o.z = pk2(sp[4 * 33], sp[5 * 33]); o.w = pk2(sp[6 * 33], sp[7 * 33]);
        if (n < c.ncols) *(u32x4*)(c.dst + (size_t)n * c.ldk + 8 * cc) = o; }
    LDS_WAIT(); asm volatile("" ::: "memory");
}
template <class D> __device__ __forceinline__ void conv_run(const D& d, int w, int nw, int nitems, LAS float* scr, int lane) {
    f32x4 va[8], vb[8];
    int it = w; if (it >= nitems) return;
    ConvItem ca = d(it), cb = ca; conv_ld(va, ca, lane);
    for (;;) {
        const int it2 = it + nw; const bool h2 = it2 < nitems;
        if (h2) { cb = d(it2); conv_ld(vb, cb, lane); }
        conv_fin(va, ca, scr, lane);
        if (!h2) break;
        const int it3 = it2 + nw; const bool h3 = it3 < nitems;
        if (h3) { ca = d(it3); conv_ld(va, ca, lane); }
        conv_fin(vb, cb, scr, lane);
        if (!h3) break;
        it = it3;
    }
}
struct ConvG0 { const float* const* in; unsigned char* ws; __device__ __forceinline__ ConvItem operator()(int r) const { return conv_desc(r, in[2], 2560, 0, 80, 32, in[1], wsp<bf16_t>(ws, WS_WIN0), 1024, 0, 0); } };
struct ConvG1 { const float* const* in; unsigned char* ws; __device__ __forceinline__ ConvItem operator()(int it) const { constexpr int I1 = 16 * 32, I2 = 16 * 88; int r = it;
    if (r < I1) return conv_desc(r, in[20], 1024, 0, 32, 32, nullptr, wsp<bf16_t>(ws, WS_WOUT0), 1024, 0, 0); r -= I1;
    if (r < I2) return conv_desc(r, in[22], 2816, 0, 88, 32, in[21], wsp<bf16_t>(ws, WS_WGU0), 1024, 1, 0); r -= I2;
    if (r < I2) return conv_desc(r, in[23], 2816, 0, 88, 32, in[21], wsp<bf16_t>(ws, WS_WGU0), 1024, 2, 0); r -= I2;
    return conv_desc(r, in[24], 1024, 0, 32, 32, nullptr, wsp<bf16_t>(ws, WS_WD0), 2816, 0, 0); } };
struct ConvG2 { const float* const* in; unsigned char* ws; __device__ __forceinline__ ConvItem operator()(int it) const { constexpr int I5 = 16 * 64, I6 = 16 * 32, I7 = 16; int r = it;
    if (r < I5) return conv_desc(r, in[26], 3088, 0, 64, 32, in[25], wsp<bf16_t>(ws, WS_WIN1), 1024, 0, 0); r -= I5;
    if (r < I6) return conv_desc(r, in[26], 3088, 2064, 32, 32, in[25], wsp<bf16_t>(ws, WS_WIN1), 1024, 0, 2048); r -= I6;
    if (r < I7) return conv_desc(r, in[26], 3088, 2048, 1, 16, in[25], wsp<bf16_t>(ws, WS_WIN1), 1024, 0, 3072); r -= I7;
    return conv_desc(r, in[32], 1024, 0, 32, 32, nullptr, wsp<bf16_t>(ws, WS_WOUT1), 1024, 0, 0); } };
__device__ __forceinline__ void conv_group(const Frame& F, int group, int w, int nw) {
    LAS float* scr = (LAS float*)(F.lds + F.wave * 16384); const int lane = F.lane;
    if (group == 0) { ConvG0 d{F.in, F.ws}; conv_run(d, w, nw, 16 * 80, scr, lane); }
    else if (group == 1) { ConvG1 d{F.in, F.ws}; conv_run(d, w, nw, 16 * 32 + 2 * 16 * 88 + 44 * 32, scr, lane); }
    else { ConvG2 d{F.in, F.ws}; conv_run(d, w, nw, 16 * 64 + 16 * 32 + 16 + 16 * 32, scr, lane); }
}
__device__ __forceinline__ void phase_prologue(const Frame& F) {
    const int gw = F.vcu * NWAVES + F.wave, NGW = F.G * NWAVES, lane = F.lane;
    unsigned char* ws = F.ws;
    conv_group(F, 0, gw, NGW);
    if (F.G < 256) { conv_group(F, 1, gw, NGW); conv_group(F, 2, gw, NGW); }
    const int gt = F.vcu * 512 + F.tid, NGT = F.G * 512;
    { bf16_t* wlr = wsp<bf16_t>(ws, WS_WLR);
      for (int i = gt; i < 2560 * 256; i += NGT) { const int n = i >> 8, k = i & 255; float v = 0.f;
          if (n < 512)       { if (k < 64) v = F.in[5][k * 512 + n]; }
          else if (n < 1024) { if (k < 64) v = F.in[7][k * 512 + (n - 512)]; }
          else if (n < 1536) { if (k >= 64 && k < 128) v = F.in[9][(k - 64) * 512 + (n - 1024)]; }
          else if (n < 2048) { if (k >= 64 && k < 128) v = F.in[11][(k - 64) * 512 + (n - 1536)]; }
          else               { if (k >= 128) v = F.in[12][(k - 128) * 512 + (n - 2048)]; }
          wlr[i] = f2bf(v); } }
    { f32x2* rt = wsp<f32x2>(ws, WS_ROPE);
      for (int i = gt; i < SEQ * 32; i += NGT) { const int ts = i >> 5, pi = i & 31; const float freq = expf(-(float)(pi & 15) * (9.210340371976184f / 16.f));
          const float ang = ((pi >= 16) ? (float)(ts & 63) : (float)(ts >> 6)) * freq; float sn, cs; sincosf(ang, &sn, &cs); rt[i] = (f32x2){cs, sn}; } }
    { const float* x = F.in[0]; bf16_t* xb = wsp<bf16_t>(ws, WS_XB); float* ssq = wsp<float>(ws, WS_SSQ0);
      for (int m = gw; m < M_TOK; m += NGW) { const f32x4* xr = (const f32x4*)(x + (size_t)m * 1024) + lane; f32x4 v[4]; float s = 0.f;
#pragma unroll
          for (int j = 0; j < 4; ++j) { v[j] = xr[64 * j]; s += (v[j].x * v[j].x + v[j].y * v[j].y) + (v[j].z * v[j].z + v[j].w * v[j].w); }
          s = wave_sum(s);
          u32x2* o8 = (u32x2*)(xb + (size_t)m * 1024) + lane;
#pragma unroll
          for (int j = 0; j < 4; ++j) { u32x2 w; w.x = pk2(v[j].x, v[j].y); w.y = pk2(v[j].z, v[j].w); o8[64 * j] = w; }
          if (lane < 16) ssq[(size_t)m * 16 + lane] = (lane == 0) ? s : 0.f; } }
}
struct ConvEGU { const float* const* in; unsigned char* ws; int base; __device__ __forceinline__ ConvItem operator()(int it_) const { constexpr int IG = 16 * 112; const int it = it_ + base; const int e = it / (2 * IG), r = it % (2 * IG);
    bf16_t* wegu = wsp<bf16_t>(ws, A_WEGU + (e >= EGU_EARLY ? WEGU_HI_SHIFT : 0)) + (size_t)e * 2 * D_FFE * 1024;
    if (r < IG) return conv_desc(r, in[35] + (size_t)e * 1024 * D_FFE, D_FFE, 0, 112, 32, in[33], wegu, 1024, 1, 0);
    return conv_desc(r - IG, in[36] + (size_t)e * 1024 * D_FFE, D_FFE, 0, 112, 32, in[33], wegu, 1024, 2, 0); } };
struct ConvED { const float* const* in; unsigned char* ws; __device__ __forceinline__ ConvItem operator()(int it) const { constexpr int ID = 56 * 32; const int e = it / ID, r = it % ID;
    return conv_desc(r, in[37] + (size_t)e * D_FFE * 1024, 1024, 0, 32, 32, nullptr, wsp<bf16_t>(ws, A_WED) + (size_t)e * 1024 * D_FFE, D_FFE, 0, 0); } };
__device__ __forceinline__ void conv_experts_gu(const Frame& F, int w, int nw, int e_lo, int e_hi) { ConvEGU d{F.in, F.ws, e_lo * 2 * 16 * 112}; conv_run(d, w, nw, (e_hi - e_lo) * 2 * 16 * 112, (LAS float*)(F.lds + F.wave * 16384), F.lane); }
__device__ __forceinline__ void conv_experts_down(const Frame& F, int w, int nw) { ConvED d{F.in, F.ws}; conv_run(d, w, nw, NEXP * 56 * 32, (LAS float*)(F.lds + F.wave * 16384), F.lane); }
__device__ __forceinline__ void phase_conv_experts(const Frame& F) {
    const int gw = F.vcu * NWAVES + F.wave, NGW = F.G * NWAVES;
    conv_experts_gu(F, gw, NGW, 0, EGU_EARLY);
}

__device__ __forceinline__ float dpp8_sum(float v) {
    v += __builtin_bit_cast(float, __builtin_amdgcn_update_dpp(0, __builtin_bit_cast(int, v), 0xB1, 0xF, 0xF, false));
    v += __builtin_bit_cast(float, __builtin_amdgcn_update_dpp(0, __builtin_bit_cast(int, v), 0x4E, 0xF, 0xF, false));
    v += __builtin_bit_cast(float, __builtin_amdgcn_update_dpp(0, __builtin_bit_cast(int, v), 0x141, 0xF, 0xF, false));
    return v;
}
__device__ __forceinline__ void phase_prep0(const Frame& F) {
    const int gw = F.vcu * NWAVES + F.wave, lane = F.lane;
    const bf16_t* P = wsp<bf16_t>(F.ws, A_P0);
    bf16_t *RS = wsp<bf16_t>(F.ws, A_RS), *KS = wsp<bf16_t>(F.ws, A_KS), *VS = wsp<bf16_t>(F.ws, A_VS), *NKK = wsp<bf16_t>(F.ws, A_NKK), *AP = wsp<bf16_t>(F.ws, A_AP);
    bf16_t *QH = wsp<bf16_t>(F.ws, A_QH), *KH = wsp<bf16_t>(F.ws, A_KH), *VT = wsp<bf16_t>(F.ws, A_VT0);
    const f32x2* ROPE = wsp<f32x2>(F.ws, WS_ROPE);
    float mu[4][8], kkw[8], qn8[8], kn8[8];
#pragma unroll
    for (int j = 0; j < 4; ++j)
#pragma unroll
        for (int e = 0; e < 8; ++e) { const int col = 8 * (lane + 64 * j) + e; mu[j][e] = col < RW_IN ? F.in[3][col] : 0.f; }
#pragma unroll
    for (int e = 0; e < 8; ++e) { kkw[e] = F.in[13][8 * lane + e]; qn8[e] = F.in[18][8 * (lane & 7) + e]; kn8[e] = F.in[19][8 * (lane & 7) + e]; }
    for (int g8 = gw; g8 < M_TOK / 8; g8 += F.G * NWAVES) {
        u32x4 prev[4], cur[5], nxt[4];
        { const int tok = g8 * 8; const int ts = tok & (SEQ - 1);
#pragma unroll
          for (int j = 0; j < 5; ++j) cur[j] = *(const u32x4*)(P + (size_t)tok * E_IN + 8 * (lane + 64 * j));
#pragma unroll
          for (int j = 0; j < 4; ++j) prev[j] = (ts > 0) ? *(const u32x4*)(P + (size_t)(tok - 1) * E_IN + 8 * (lane + 64 * j)) : (u32x4){0u, 0u, 0u, 0u}; }
        for (int tt = 0; tt < 8; ++tt) { const int tok = g8 * 8 + tt; const int ts = tok & (SEQ - 1); const int bb = tok >> 11;
            u32x4 ncur4 = (u32x4){0u, 0u, 0u, 0u};
#pragma unroll
            for (int j = 0; j < 4; ++j) nxt[j] = (ts < SEQ - 1) ? *(const u32x4*)(P + (size_t)(tok + 1) * E_IN + 8 * (lane + 64 * j)) : (u32x4){0u, 0u, 0u, 0u};
            if (tt < 7) ncur4 = *(const u32x4*)(P + (size_t)(tok + 1) * E_IN + 8 * (lane + 256));
            const f32x4 rp0 = *(const f32x4*)(ROPE + (size_t)ts * 32 + 4 * (lane & 7)), rp1 = *(const f32x4*)(ROPE + (size_t)ts * 32 + 4 * (lane & 7) + 2);
            const float cs4[4] = {rp0[0], rp0[2], rp1[0], rp1[2]}, sn4[4] = {rp0[1], rp0[3], rp1[1], rp1[3]};
            float s[4][8];
#pragma unroll
            for (int j = 0; j < 4; ++j) { float c[8], p[8], n[8]; unpack8(cur[j], c); unpack8(prev[j], p); unpack8(nxt[j], n);
#pragma unroll
                for (int e = 0; e < 8; ++e) s[j][e] = c[e] + (0.5f * (p[e] + n[e]) - c[e]) * mu[j][e]; }
            const size_t o512 = (size_t)tok * 512 + 8 * lane;
            *(u32x4*)(RS + o512) = pack8f(s[0]); *(u32x4*)(KS + o512) = pack8f(s[1]); *(u32x4*)(VS + o512) = pack8f(s[2]);
            { float kr[8]; float ss = 0.f;
#pragma unroll
              for (int e = 0; e < 8; ++e) { kr[e] = s[1][e] * kkw[e]; ss += kr[e] * kr[e]; }
              ss = dpp8_sum(ss); const float inv = -1.f / fmaxf(sqrtf(ss), 1e-12f);
#pragma unroll
              for (int e = 0; e < 8; ++e) kr[e] *= inv;
              *(u32x4*)(NKK + o512) = pack8f(kr); }
            float x3[8], x4[8]; unpack8(cur[3], x3); unpack8(cur[4], x4);
            { float ap[8];
#pragma unroll
              for (int e = 0; e < 8; ++e) ap[e] = lane < 8 ? tanhf(s[3][e]) : (lane < 16 ? s[3][e] : sigmoidf_(s[3][e]));
              if (lane < 32) *(u32x4*)(AP + (size_t)tok * 256 + 8 * lane) = pack8f(ap); }
#pragma unroll
            for (int which = 0; which < 2; ++which) { float (&x)[8] = which ? x4 : x3; float ss = 0.f;
#pragma unroll
                for (int e = 0; e < 8; ++e) ss += x[e] * x[e];
                ss = dpp8_sum(ss); const float rs = 1.0f / sqrtf(ss * (1.f / 64.f) + NORM_EPS);
                const bool isk = which && lane >= 32; float o[8];
#pragma unroll
                for (int p = 0; p < 4; ++p) { const float x0 = x[2 * p] * rs * (isk ? kn8[2 * p] : qn8[2 * p]), x1 = x[2 * p + 1] * rs * (isk ? kn8[2 * p + 1] : qn8[2 * p + 1]);
                    o[2 * p] = x0 * cs4[p] - x1 * sn4[p]; o[2 * p + 1] = x0 * sn4[p] + x1 * cs4[p]; }
                if (!isk) {
#pragma unroll
                    for (int e = 0; e < 8; ++e) o[e] *= 0.18033688011112042f; }
                if (which == 0) { if (lane >= 32) *(u32x4*)(QH + (size_t)tok * 512 + 8 * (lane - 32)) = pack8f(o); }
                else { if (lane < 32) *(u32x4*)(QH + (size_t)tok * 512 + 256 + 8 * lane) = pack8f(o);
                       else if (lane < 48) *(u32x4*)(KH + (size_t)tok * 128 + 8 * (lane - 32)) = pack8f(o); } }
            if (lane >= 48) { const int g = (lane - 48) >> 3, d0 = 8 * ((lane - 48) & 7); const unsigned w[4] = {cur[4].x, cur[4].y, cur[4].z, cur[4].w};
#pragma unroll
                for (int e = 0; e < 8; ++e) VT[((size_t)(bb * 2 + g) * 64 + d0 + e) * SEQ + ts] = (bf16_t)((e & 1) ? (w[e >> 1] >> 16) : (w[e >> 1] & 0xffffu)); }
#pragma unroll
            for (int j = 0; j < 4; ++j) { prev[j] = cur[j]; cur[j] = nxt[j]; }
            cur[4] = ncur4;
        }
    }
}

__device__ __forceinline__ float dpp_row_sum(float v) {
    v += __builtin_bit_cast(float, __builtin_amdgcn_update_dpp(0, __builtin_bit_cast(int, v), 0xB1, 0xF, 0xF, false));
    v += __builtin_bit_cast(float, __builtin_amdgcn_update_dpp(0, __builtin_bit_cast(int, v), 0x4E, 0xF, 0xF, false));
    v += __builtin_bit_cast(float, __builtin_amdgcn_update_dpp(0, __builtin_bit_cast(int, v), 0x141, 0xF, 0xF, false));
    v += __builtin_bit_cast(float, __builtin_amdgcn_update_dpp(0, __builtin_bit_cast(int, v), 0x140, 0xF, 0xF, false));
    return v;
}
constexpr int SC_STEPS = 32, SC_STRIDE = 352, SC_BUF = SC_STEPS * SC_STRIDE;
__device__ __forceinline__ float dpp_row8_sum(float v) {
    v += __builtin_bit_cast(float, __builtin_amdgcn_update_dpp(0, __builtin_bit_cast(int, v), 0xB1, 0xF, 0xF, false));
    v += __builtin_bit_cast(float, __builtin_amdgcn_update_dpp(0, __builtin_bit_cast(int, v), 0x4E, 0xF, 0xF, false));
    v += __builtin_bit_cast(float, __builtin_amdgcn_update_dpp(0, __builtin_bit_cast(int, v), 0x141, 0xF, 0xF, false));
    return v;
}
struct ScOps { f32x2 w[4], kd[4], a[4], b[4], r[4]; float v; };
__device__ __forceinline__ void sc_ld(ScOps& o, const LAS float* bs, const LAS float* vp) {
#pragma unroll
    for (int i = 0; i < 2; ++i) {
        const f32x4 w4 = *(const LAS f32x4*)(bs + 4 * i), k4 = *(const LAS f32x4*)(bs + 64 + 4 * i), a4 = *(const LAS f32x4*)(bs + 128 + 4 * i), b4 = *(const LAS f32x4*)(bs + 192 + 4 * i), r4 = *(const LAS f32x4*)(bs + 256 + 4 * i);
        o.w[2 * i] = (f32x2){w4[0], w4[1]}; o.w[2 * i + 1] = (f32x2){w4[2], w4[3]}; o.kd[2 * i] = (f32x2){k4[0], k4[1]}; o.kd[2 * i + 1] = (f32x2){k4[2], k4[3]};
        o.a[2 * i] = (f32x2){a4[0], a4[1]}; o.a[2 * i + 1] = (f32x2){a4[2], a4[3]}; o.b[2 * i] = (f32x2){b4[0], b4[1]}; o.b[2 * i + 1] = (f32x2){b4[2], b4[3]};
        o.r[2 * i] = (f32x2){r4[0], r4[1]}; o.r[2 * i + 1] = (f32x2){r4[2], r4[3]}; }
    o.v = *vp;
}
template <int DIR> __device__ __forceinline__ float sc_step(f32x2 (&s)[4], const ScOps& o) {
    f32x2 u[4];
#pragma unroll
    for (int i = 0; i < 4; ++i) u[i] = o.kd[i] * o.v;
    f32x2 p = s[0] * o.a[0], q = s[1] * o.a[1];
    p = __builtin_elementwise_fma(s[2], o.a[2], p); q = __builtin_elementwise_fma(s[3], o.a[3], q); p = p + q;
    float sa = dpp_row8_sum(p[0] + p[1]);
    f32x2 yp, yq;
    if (DIR) { yp = s[0] * o.r[0]; yq = s[1] * o.r[1]; yp = __builtin_elementwise_fma(s[2], o.r[2], yp); yq = __builtin_elementwise_fma(s[3], o.r[3], yq); }
    const f32x2 sa2 = {sa, sa};
#pragma unroll
    for (int i = 0; i < 4; ++i) { const f32x2 t = __builtin_elementwise_fma(o.b[i], sa2, u[i]); s[i] = __builtin_elementwise_fma(s[i], o.w[i], t); }
    if (!DIR) { yp = s[0] * o.r[0]; yq = s[1] * o.r[1]; yp = __builtin_elementwise_fma(s[2], o.r[2], yp); yq = __builtin_elementwise_fma(s[3], o.r[3], yq); }
    yp = yp + yq;
    return dpp_row8_sum(yp[0] + yp[1]);
}
__device__ __forceinline__ void attn_tile_step(const LAS unsigned char* kb, const LAS unsigned char* vb, const bf16x8 (&q)[4], f32x16& o0, f32x16& o1, float& mrun, float& lrun, int r32, int hi) {
    f32x16 c0 = {}, c1 = {};
#pragma unroll
    for (int s4 = 0; s4 < 4; ++s4) { const int chk = 2 * s4 + hi;
        const bf16x8 k0 = *(const LAS bf16x8*)(kb + r32 * 128 + ((chk ^ (r32 & 7)) * 16));
        const bf16x8 k1 = *(const LAS bf16x8*)(kb + (32 + r32) * 128 + ((chk ^ (r32 & 7)) * 16));
        c0 = __builtin_amdgcn_mfma_f32_32x32x16_bf16(k0, q[s4], c0, 0, 0, 0);
        c1 = __builtin_amdgcn_mfma_f32_32x32x16_bf16(k1, q[s4], c1, 0, 0, 0); }
    float mx = c0[0];
#pragma unroll
    for (int r = 0; r < 16; ++r) { mx = fmaxf(mx, c0[r]); mx = fmaxf(mx, c1[r]); }
    mx = fmaxf(mx, __shfl_xor(mx, 32));
    const float mnew = fmaxf(mrun, mx); const float alpha = __builtin_amdgcn_exp2f(mrun - mnew); mrun = mnew;
    float ls = 0.f;
#pragma unroll
    for (int r = 0; r < 16; ++r) { c0[r] = __builtin_amdgcn_exp2f(c0[r] - mnew); c1[r] = __builtin_amdgcn_exp2f(c1[r] - mnew); ls += c0[r] + c1[r]; }
    lrun = lrun * alpha + ls;
#pragma unroll
    for (int r = 0; r < 16; ++r) { o0[r] *= alpha; o1[r] *= alpha; }
    u32x4 w00, w01, w10, w11;
    w00.x = pk2(c0[0], c0[1]); w00.y = pk2(c0[2], c0[3]); w00.z = pk2(c0[4], c0[5]); w00.w = pk2(c0[6], c0[7]);
    w01.x = pk2(c0[8], c0[9]); w01.y = pk2(c0[10], c0[11]); w01.z = pk2(c0[12], c0[13]); w01.w = pk2(c0[14], c0[15]);
    w10.x = pk2(c1[0], c1[1]); w10.y = pk2(c1[2], c1[3]); w10.z = pk2(c1[4], c1[5]); w10.w = pk2(c1[6], c1[7]);
    w11.x = pk2(c1[8], c1[9]); w11.y = pk2(c1[10], c1[11]); w11.z = pk2(c1[12], c1[13]); w11.w = pk2(c1[14], c1[15]);
    const bf16x8 p00 = __builtin_bit_cast(bf16x8, w00), p01 = __builtin_bit_cast(bf16x8, w01), p10 = __builtin_bit_cast(bf16x8, w10), p11 = __builtin_bit_cast(bf16x8, w11);
#define AT_VF(dd_, chk_) ({ const int sw_ = ((dd_) >> 1) & 7; const u32x2 lo_ = *(const LAS u32x2*)(vb + (dd_) * 128 + (((chk_) ^ sw_) * 16) + hi * 8); \
        const u32x2 hh_ = *(const LAS u32x2*)(vb + (dd_) * 128 + ((((chk_) + 1) ^ sw_) * 16) + hi * 8); const u32x4 vv_ = {lo_.x, lo_.y, hh_.x, hh_.y}; __builtin_bit_cast(bf16x8, vv_); })
    o0 = __builtin_amdgcn_mfma_f32_32x32x16_bf16(AT_VF(r32, 0), p00, o0, 0, 0, 0);
    o0 = __builtin_amdgcn_mfma_f32_32x32x16_bf16(AT_VF(r32, 2), p01, o0, 0, 0, 0);
    o0 = __builtin_amdgcn_mfma_f32_32x32x16_bf16(AT_VF(r32, 4), p10, o0, 0, 0, 0);
    o0 = __builtin_amdgcn_mfma_f32_32x32x16_bf16(AT_VF(r32, 6), p11, o0, 0, 0, 0);
    o1 = __builtin_amdgcn_mfma_f32_32x32x16_bf16(AT_VF(32 + r32, 0), p00, o1, 0, 0, 0);
    o1 = __builtin_amdgcn_mfma_f32_32x32x16_bf16(AT_VF(32 + r32, 2), p01, o1, 0, 0, 0);
    o1 = __builtin_amdgcn_mfma_f32_32x32x16_bf16(AT_VF(32 + r32, 4), p10, o1, 0, 0, 0);
    o1 = __builtin_amdgcn_mfma_f32_32x32x16_bf16(AT_VF(32 + r32, 6), p11, o1, 0, 0, 0);
#undef AT_VF
}
__device__ __forceinline__ void attn_store(bf16_t* op, const f32x16& o0, const f32x16& o1, float lrun) {
    const float ltot = lrun + __shfl_xor(lrun, 32); const float inv = 1.f / ltot;
#pragma unroll
    for (int q4 = 0; q4 < 4; ++q4) { u32x2 w0, w1;
        w0.x = pk2(o0[4 * q4 + 0] * inv, o0[4 * q4 + 1] * inv); w0.y = pk2(o0[4 * q4 + 2] * inv, o0[4 * q4 + 3] * inv);
        w1.x = pk2(o1[4 * q4 + 0] * inv, o1[4 * q4 + 1] * inv); w1.y = pk2(o1[4 * q4 + 2] * inv, o1[4 * q4 + 3] * inv);
        *(u32x2*)(op + 8 * q4) = w0; *(u32x2*)(op + 32 + 8 * q4) = w1; }
}
constexpr int CS_SLOT = 9216, CS_RS = 144;
__device__ __forceinline__ void cs_mm(f32x4 (&acc)[2], const LAS unsigned char* L, const LAS unsigned char* Rt, int mi, int ni0, int fr, int fq) {
#pragma unroll
    for (int s2 = 0; s2 < 2; ++s2) { const bf16x8 a = *(const LAS bf16x8*)(L + (16 * mi + fr) * CS_RS + (32 * s2 + 8 * fq) * 2);
#pragma unroll
        for (int jj = 0; jj < 2; ++jj) { const bf16x8 bb = *(const LAS bf16x8*)(Rt + (16 * (ni0 + jj) + fr) * CS_RS + (32 * s2 + 8 * fq) * 2);
            acc[jj] = __builtin_amdgcn_mfma_f32_16x16x32_bf16(a, bb, acc[jj], 0, 0, 0); } }
}
__device__ __forceinline__ void cs_st_t8(LAS unsigned char* dst, const f32x4 (&acc)[2], int mi, int ni0, int fr, int fq) {
#pragma unroll
    for (int jj = 0; jj < 2; ++jj) { u32x2 w; w.x = pk2(acc[jj][0], acc[jj][1]); w.y = pk2(acc[jj][2], acc[jj][3]);
        *(LAS u32x2*)(dst + (16 * (ni0 + jj) + fr) * CS_RS + (16 * mi + 4 * fq) * 2) = w; }
}
__device__ __forceinline__ void cs_st_sc(LAS unsigned char* dst, const f32x4 (&acc)[2], int mi, int ni0, int fr, int fq) {
#pragma unroll
    for (int jj = 0; jj < 2; ++jj)
#pragma unroll
        for (int r = 0; r < 4; ++r) *(LAS bf16_t*)(dst + (16 * mi + 4 * fq + r) * CS_RS + (16 * (ni0 + jj) + fr) * 2) = f2bf(acc[jj][r]);
}
__device__ __forceinline__ void cs_ld_t8(f32x4 (&acc)[2], const LAS unsigned char* src, int mi, int ni0, int fr, int fq) {
#pragma unroll
    for (int jj = 0; jj < 2; ++jj) { const u32x2 w = *(const LAS u32x2*)(src + (16 * (ni0 + jj) + fr) * CS_RS + (16 * mi + 4 * fq) * 2);
        acc[jj] = (f32x4){bflo(w.x), bfhi(w.x), bflo(w.y), bfhi(w.y)}; }
}
#define CS_ZERO(acc) do { acc[0] = (f32x4){0.f, 0.f, 0.f, 0.f}; acc[1] = acc[0]; } while (0)
typedef short v4i16_t __attribute__((ext_vector_type(4)));
template <int RS = CS_RS> __device__ __forceinline__ bf16x8 cs_afrag_tr(const LAS unsigned char* LT, int mi, int s2, int fr, int fq) {
    const LAS unsigned char* p = LT + (32 * s2 + 8 * fq + (fr >> 2)) * RS + (16 * mi + 4 * (fr & 3)) * 2;
    const v4i16_t lo = __builtin_amdgcn_ds_read_tr16_b64_v4i16((LAS v4i16_t*)p);
    const v4i16_t hi = __builtin_amdgcn_ds_read_tr16_b64_v4i16((LAS v4i16_t*)(p + 4 * RS));
    return (bf16x8){lo[0], lo[1], lo[2], lo[3], hi[0], hi[1], hi[2], hi[3]};
}
__device__ __forceinline__ void cs_mm_tr(f32x4 (&acc)[2], const LAS unsigned char* LT, const LAS unsigned char* Rt, int mi, int ni0, int fr, int fq) {
#pragma unroll
    for (int s2 = 0; s2 < 2; ++s2) { const bf16x8 a = cs_afrag_tr(LT, mi, s2, fr, fq);
#pragma unroll
        for (int jj = 0; jj < 2; ++jj) { const bf16x8 bb = *(const LAS bf16x8*)(Rt + (16 * (ni0 + jj) + fr) * CS_RS + (32 * s2 + 8 * fq) * 2);
            acc[jj] = __builtin_amdgcn_mfma_f32_16x16x32_bf16(a, bb, acc[jj], 0, 0, 0); } }
}
__device__ __forceinline__ void cs_mm_tr2(f32x4 (&aU)[2], f32x4 (&aS)[2], const LAS unsigned char* LUT, const LAS unsigned char* LST, const LAS unsigned char* Rt, bool doS, int mi, int ni0, int fr, int fq) {
#pragma unroll
    for (int s2 = 0; s2 < 2; ++s2) { const bf16x8 au = cs_afrag_tr(LUT, mi, s2, fr, fq); const bf16x8 as = cs_afrag_tr(LST, mi, s2, fr, fq);
#pragma unroll
        for (int jj = 0; jj < 2; ++jj) { const bf16x8 bb = *(const LAS bf16x8*)(Rt + (16 * (ni0 + jj) + fr) * CS_RS + (32 * s2 + 8 * fq) * 2);
            aU[jj] = __builtin_amdgcn_mfma_f32_16x16x32_bf16(au, bb, aU[jj], 0, 0, 0);
            if (doS) aS[jj] = __builtin_amdgcn_mfma_f32_16x16x32_bf16(as, bb, aS[jj], 0, 0, 0); } }
}
__device__ __forceinline__ void cs_mask(f32x4 (&acc)[2], int mi, int ni0, int fr, int fq, int mode) {
#pragma unroll
    for (int jj = 0; jj < 2; ++jj) { const int ni = ni0 + jj;
        const bool keep_all = (mode == 1) ? (ni < mi) : (ni > mi), diag = (ni == mi);
        if (diag) {
#pragma unroll
            for (int r = 0; r < 4; ++r) { const int ml = 4 * fq + r; const bool k = (mode == 0) ? (ml < fr) : (mode == 1) ? (fr < ml) : (ml <= fr); if (!k) acc[jj][r] = 0.f; }
        } else if (!keep_all) acc[jj] = (f32x4){0.f, 0.f, 0.f, 0.f}; }
}
template <int DIR> __device__ __forceinline__ void cscan_job(const Frame& F, int b, int h) {
    const int tid = F.tid, lane = F.lane, wave = F.wave, fr = lane & 15, fq = lane >> 4;
    LAS unsigned char* L0 = F.lds;
#define SL(i) (L0 + (i) * CS_SLOT)
    LAS float* Dl = (LAS float*)(SL(14) + 8704);
    const bf16_t* g0 = wsp<bf16_t>(F.ws, DIR ? A_LWB : A_LWF); const bf16_t* g1 = wsp<bf16_t>(F.ws, A_KS); const bf16_t* g2 = wsp<bf16_t>(F.ws, A_NKK);
    const bf16_t* g3 = wsp<bf16_t>(F.ws, DIR ? A_SGB : A_SGF); const bf16_t* g4 = wsp<bf16_t>(F.ws, A_RS); const bf16_t* g5 = wsp<bf16_t>(F.ws, A_VS);
    bf16_t* Y = wsp<bf16_t>(F.ws, DIR ? A_YB : A_YF);
    const int mi = wave >> 1, ni0 = 2 * (wave & 1);
    const int rt_ = tid >> 3, rc_ = tid & 7;
    const int ek = tid & 63, etq = tid >> 6;
    u32x4 raw[5], rawv, rawv_cur; bf16_t lwn[8];
    const float ka_k = F.in[14][h * 64 + ek];
#define CS_LOAD(n_) do { const int sq_ = 64 * (n_) + rt_; const size_t to_ = (size_t)(b * SEQ + (DIR ? (SEQ - 1 - sq_) : sq_)) * 512 + h * 64; \
        raw[1] = *(const u32x4*)(g1 + to_ + 8 * rc_); raw[2] = *(const u32x4*)(g2 + to_ + 8 * rc_); raw[3] = *(const u32x4*)(g3 + to_ + 8 * rc_); raw[4] = *(const u32x4*)(g4 + to_ + 8 * rc_); \
        rawv = *(const u32x4*)(g5 + to_ + 8 * rc_); \
        _Pragma("unroll") for (int j_ = 0; j_ < 8; ++j_) { const int sq2_ = 64 * (n_) + 8 * etq + j_; lwn[j_] = g0[(size_t)(b * SEQ + (DIR ? (SEQ - 1 - sq2_) : sq2_)) * 512 + h * 64 + ek]; } } while (0)
    __syncthreads();
    for (int i = tid; i < 8704 / 4; i += 512) ((LAS unsigned*)SL(14))[i] = 0u;
    CS_LOAD(0);
    for (int n = 0; n < 32; ++n) {
        float lwv[8], cw[8];
#pragma unroll
        for (int j = 0; j < 8; ++j) lwv[j] = bf2f(lwn[j]);
        cw[0] = lwv[0];
#pragma unroll
        for (int j = 1; j < 8; ++j) cw[j] = cw[j - 1] + lwv[j];
        LAS float* PART = (LAS float*)SL(12);
        PART[etq * 64 + ek] = cw[7];
#pragma unroll
        for (int q = 1; q < 5; ++q) *(LAS u32x4*)(SL(7 + q) + rt_ * CS_RS + rc_ * 16) = raw[q];
        rawv_cur = rawv;
        if (n + 1 < 32) CS_LOAD(n + 1);
        __syncthreads();
        { float off = 0.f, tot = 0.f;
#pragma unroll
          for (int q = 0; q < 8; ++q) { const float p = PART[q * 64 + ek]; tot += p; if (q < etq) off += p; }
          const float ec = __builtin_amdgcn_exp2f(tot);
          if (etq == 0) Dl[ek] = ec;
          unsigned pa[4], pbh[4], pkh[4];
#pragma unroll
          for (int j = 0; j < 8; ++j) { const int t = 8 * etq + j; const float c = cw[j] + off, cp = c - lwv[j];
              const float e1 = __builtin_amdgcn_exp2f(c), em = __builtin_amdgcn_exp2f(-c), ep = __builtin_amdgcn_exp2f(cp);
              const float kdv = bf2f(*(const LAS bf16_t*)(SL(8) + t * CS_RS + ek * 2)), av = bf2f(*(const LAS bf16_t*)(SL(9) + t * CS_RS + ek * 2));
              const float bv = bf2f(*(const LAS bf16_t*)(SL(10) + t * CS_RS + ek * 2)), rv = bf2f(*(const LAS bf16_t*)(SL(11) + t * CS_RS + ek * 2));
              const float sgv = bv; const float kd2 = kdv * (1.f + (sgv - 1.f) * ka_k), bb2 = -av * sgv;
              const float at = av * ep, bt = bb2 * em, kt = kd2 * em, rtv = rv * (DIR ? ep : e1), bh = bt * ec, kh = kt * ec;
              const unsigned w01 = pk2(at, bt), w23 = pk2(kt, rtv);
              *(LAS bf16_t*)(SL(0) + t * CS_RS + ek * 2) = (bf16_t)(w01 & 0xffffu); *(LAS bf16_t*)(SL(1) + t * CS_RS + ek * 2) = (bf16_t)(w01 >> 16);
              *(LAS bf16_t*)(SL(2) + t * CS_RS + ek * 2) = (bf16_t)(w23 & 0xffffu); *(LAS bf16_t*)(SL(3) + t * CS_RS + ek * 2) = (bf16_t)(w23 >> 16);
              const unsigned hbk = pk2(bh, kh); const unsigned ha = w01 & 0xffffu, hb = hbk & 0xffffu, hk = hbk >> 16;
              if (j & 1) { pa[j >> 1] |= ha << 16; pbh[j >> 1] |= hb << 16; pkh[j >> 1] |= hk << 16; } else { pa[j >> 1] = ha; pbh[j >> 1] = hb; pkh[j >> 1] = hk; } }
          *(LAS u32x4*)(SL(4) + ek * CS_RS + etq * 16) = (u32x4){pa[0], pa[1], pa[2], pa[3]};
          *(LAS u32x4*)(SL(5) + ek * CS_RS + etq * 16) = (u32x4){pbh[0], pbh[1], pbh[2], pbh[3]};
          *(LAS u32x4*)(SL(6) + ek * CS_RS + etq * 16) = (u32x4){pkh[0], pkh[1], pkh[2], pkh[3]}; }
        __syncthreads();
        { f32x4 acc[2];
          CS_ZERO(acc); cs_mm(acc, SL(1), SL(0), mi, ni0, fr, fq); cs_mask(acc, mi, ni0, fr, fq, 0);
          cs_st_t8(SL(8), acc, mi, ni0, fr, fq);
          if (mi == ni0 || mi == ni0 + 1) { const int jd = mi - ni0;
#pragma unroll
              for (int jj = 0; jj < 2; ++jj)
#pragma unroll
                  for (int r = 0; r < 4; ++r) if (jj == jd && (4 * fq + r) == fr) acc[jj][r] += 1.f; }
          cs_st_t8(SL(13), acc, mi, ni0, fr, fq);
          CS_ZERO(acc); cs_mm(acc, SL(0), SL(2), mi, ni0, fr, fq); cs_mask(acc, mi, ni0, fr, fq, 1); cs_st_t8(SL(9), acc, mi, ni0, fr, fq);
          CS_ZERO(acc); cs_mm(acc, SL(1), SL(3), mi, ni0, fr, fq); cs_mask(acc, mi, ni0, fr, fq, DIR ? 0 : 2); cs_st_t8(SL(10), acc, mi, ni0, fr, fq);
          CS_ZERO(acc); cs_mm(acc, SL(2), SL(3), mi, ni0, fr, fq); cs_mask(acc, mi, ni0, fr, fq, DIR ? 0 : 2); cs_st_t8(SL(11), acc, mi, ni0, fr, fq); }
        __syncthreads();
        { f32x4 aS[2], aU[2];
          CS_ZERO(aS); cs_mm_tr(aS, SL(8), SL(8), mi, ni0, fr, fq); cs_st_t8(SL(1), aS, mi, ni0, fr, fq);
          __syncthreads();
#pragma unroll
          for (int it = 0; it < 5; ++it) { const int xc = (it & 1) ? 8 : 1, xa = (it & 1) ? 1 : 8, tc = (it & 1) ? 12 : 13, ta = (it & 1) ? 13 : 12;
              cs_ld_t8(aU, SL(tc), mi, ni0, fr, fq); CS_ZERO(aS); cs_mm_tr2(aU, aS, SL(tc), SL(xc), SL(xc), it < 4, mi, ni0, fr, fq);
              cs_st_t8(SL(ta), aU, mi, ni0, fr, fq);
              if (it < 4) cs_st_t8(SL(xa), aS, mi, ni0, fr, fq);
              __syncthreads(); } }
        { f32x4 acc[2];
          CS_ZERO(acc); cs_mm(acc, SL(12), SL(4), mi, ni0, fr, fq); cs_st_t8(SL(0), acc, mi, ni0, fr, fq);
          CS_ZERO(acc); cs_mm(acc, SL(12), SL(9), mi, ni0, fr, fq); cs_st_t8(SL(1), acc, mi, ni0, fr, fq); }
        __syncthreads();
        { f32x4 acc[2];
          CS_ZERO(acc);
          if (mi == ni0 || mi == ni0 + 1) { const int jd = mi - ni0; const float dv = Dl[16 * mi + fr];
#pragma unroll
              for (int jj = 0; jj < 2; ++jj)
#pragma unroll
                  for (int r = 0; r < 4; ++r) if (jj == jd && (4 * fq + r) == fr) acc[jj][r] = dv; }
          cs_mm(acc, SL(0), SL(5), mi, ni0, fr, fq); cs_st_t8(SL(7), acc, mi, ni0, fr, fq);
          cs_ld_t8(acc, SL(3), mi, ni0, fr, fq); cs_mm(acc, SL(0), SL(10), mi, ni0, fr, fq); cs_st_t8(SL(8), acc, mi, ni0, fr, fq);
          cs_ld_t8(acc, SL(6), mi, ni0, fr, fq); cs_mm(acc, SL(1), SL(5), mi, ni0, fr, fq); cs_st_t8(SL(12), acc, mi, ni0, fr, fq);
          cs_ld_t8(acc, SL(11), mi, ni0, fr, fq); cs_mm(acc, SL(1), SL(10), mi, ni0, fr, fq); cs_st_t8(SL(13), acc, mi, ni0, fr, fq);
          const unsigned w4[4] = {rawv_cur.x, rawv_cur.y, rawv_cur.z, rawv_cur.w};
#pragma unroll
          for (int e = 0; e < 8; ++e) *(LAS bf16_t*)(SL(2) + (8 * rc_ + e) * CS_RS + rt_ * 2) = (bf16_t)((e & 1) ? (w4[e >> 1] >> 16) : (w4[e >> 1] & 0xffffu)); }
        __syncthreads();
        { const LAS unsigned char* PH = SL(7) + (16 * wave + fr) * CS_RS; const LAS unsigned char* PS = SL(12) + (16 * wave + fr) * CS_RS;
          const LAS unsigned char* Sr = (n & 1) ? SL(15) : SL(14); LAS unsigned char* Sw = (n & 1) ? SL(14) : SL(15);
          f32x4 acc[4] = {(f32x4){0.f, 0.f, 0.f, 0.f}, (f32x4){0.f, 0.f, 0.f, 0.f}, (f32x4){0.f, 0.f, 0.f, 0.f}, (f32x4){0.f, 0.f, 0.f, 0.f}};
#pragma unroll
          for (int s2 = 0; s2 < 2; ++s2) { const bf16x8 bph = *(const LAS bf16x8*)(PH + (32 * s2 + 8 * fq) * 2), bps = *(const LAS bf16x8*)(PS + (32 * s2 + 8 * fq) * 2);
#pragma unroll
              for (int m2 = 0; m2 < 4; ++m2) { const bf16x8 as = cs_afrag_tr<136>(Sr, m2, s2, fr, fq), av = *(const LAS bf16x8*)(SL(2) + (16 * m2 + fr) * CS_RS + (32 * s2 + 8 * fq) * 2);
                  acc[m2] = __builtin_amdgcn_mfma_f32_16x16x32_bf16(as, bph, acc[m2], 0, 0, 0); acc[m2] = __builtin_amdgcn_mfma_f32_16x16x32_bf16(av, bps, acc[m2], 0, 0, 0); } }
          if (wave < 4) {
#pragma unroll
              for (int m2 = 0; m2 < 4; ++m2) { u32x2 w; w.x = pk2(acc[m2][0], acc[m2][1]); w.y = pk2(acc[m2][2], acc[m2][3]);
                  *(LAS u32x2*)(Sw + (16 * wave + fr) * 136 + (16 * m2 + 4 * fq) * 2) = w; }
          } else { const int sq = 64 * n + 16 * (wave - 4) + fr; const size_t tok = (size_t)(b * SEQ + (DIR ? (SEQ - 1 - sq) : sq));
#pragma unroll
              for (int m2 = 0; m2 < 4; ++m2) { u32x2 w; w.x = pk2(acc[m2][0], acc[m2][1]); w.y = pk2(acc[m2][2], acc[m2][3]); *(u32x2*)(Y + tok * 512 + h * 64 + 16 * m2 + 4 * fq) = w; } } }
        __syncthreads();
    }
#undef CS_LOAD
#undef SL
}

__device__ __forceinline__ void phase_attn_range(const Frame& F, int u_first, int u_stride) {
    const int tid = F.tid, lane = F.lane, wave = F.wave, r32 = lane & 31, hi = lane >> 5;
    LAS unsigned char* lds = F.lds;
    const bf16_t *QH = wsp<bf16_t>(F.ws, A_QH), *KH = wsp<bf16_t>(F.ws, A_KH), *VT = wsp<bf16_t>(F.ws, A_VT0); bf16_t* YC = wsp<bf16_t>(F.ws, A_YCAT);
    const int skey = tid >> 3, sc = tid & 7;
#define AT_QK(C0, C1, bo_) do { C0 = (f32x16){}; C1 = (f32x16){}; \
        _Pragma("unroll") for (int s = 0; s < 4; ++s) { const int ch = 2 * s + hi; \
            const bf16x8 k0 = *(const LAS bf16x8*)(lds + (bo_) + r32 * 128 + ((ch ^ (r32 & 7)) * 16)); \
            const bf16x8 k1 = *(const LAS bf16x8*)(lds + (bo_) + (32 + r32) * 128 + ((ch ^ (r32 & 7)) * 16)); \
            C0 = __builtin_amdgcn_mfma_f32_32x32x16_bf16(k0, qf[s], C0, 0, 0, 0); \
            C1 = __builtin_amdgcn_mfma_f32_32x32x16_bf16(k1, qf[s], C1, 0, 0, 0); } } while (0)
#define AT_ITER(t_, CA0, CA1, CB0, CB1) do { const int t = (t_); \
        if (t + 1 < SEQ / 64) AT_QK(CB0, CB1, ((t + 1) & 1) * 8192); \
        __builtin_amdgcn_sched_barrier(0); \
        float mx = CA0[0]; \
        _Pragma("unroll") for (int r = 0; r < 16; ++r) { mx = fmaxf(mx, CA0[r]); mx = fmaxf(mx, CA1[r]); } \
        mx = fmaxf(mx, __shfl_xor(mx, 32)); \
        const float mnew = fmaxf(mrun, mx); const float alpha = __builtin_amdgcn_exp2f(mrun - mnew); mrun = mnew; \
        float ls = 0.f; \
        _Pragma("unroll") for (int r = 0; r < 16; ++r) { CA0[r] = __builtin_amdgcn_exp2f(CA0[r] - mnew); CA1[r] = __builtin_amdgcn_exp2f(CA1[r] - mnew); ls += CA0[r] + CA1[r]; } \
        lrun = lrun * alpha + ls; \
        _Pragma("unroll") for (int r = 0; r < 16; ++r) { o0[r] *= alpha; o1[r] *= alpha; } \
        bf16x8 pf[2][2]; \
        _Pragma("unroll") for (int s2 = 0; s2 < 2; ++s2) { u32x4 w0, w1; \
            w0.x = pk2(CA0[8 * s2 + 0], CA0[8 * s2 + 1]); w0.y = pk2(CA0[8 * s2 + 2], CA0[8 * s2 + 3]); w0.z = pk2(CA0[8 * s2 + 4], CA0[8 * s2 + 5]); w0.w = pk2(CA0[8 * s2 + 6], CA0[8 * s2 + 7]); \
            w1.x = pk2(CA1[8 * s2 + 0], CA1[8 * s2 + 1]); w1.y = pk2(CA1[8 * s2 + 2], CA1[8 * s2 + 3]); w1.z = pk2(CA1[8 * s2 + 4], CA1[8 * s2 + 5]); w1.w = pk2(CA1[8 * s2 + 6], CA1[8 * s2 + 7]); \
            pf[0][s2] = __builtin_bit_cast(bf16x8, w0); pf[1][s2] = __builtin_bit_cast(bf16x8, w1); } \
        const int vb = 16384 + (t & 1) * 8192; \
        _Pragma("unroll") for (int dblk = 0; dblk < 2; ++dblk) { const int d = 32 * dblk + r32; const int sw = (d >> 1) & 7; \
            _Pragma("unroll") for (int blk = 0; blk < 2; ++blk) \
                _Pragma("unroll") for (int s2 = 0; s2 < 2; ++s2) { const int ch = 4 * blk + 2 * s2; \
                    const u32x2 lo = *(const LAS u32x2*)(lds + vb + d * 128 + ((ch ^ sw) * 16) + hi * 8); \
                    const u32x2 hh = *(const LAS u32x2*)(lds + vb + d * 128 + (((ch + 1) ^ sw) * 16) + hi * 8); \
                    const u32x4 vv = {lo.x, lo.y, hh.x, hh.y}; \
                    if (dblk == 0) o0 = __builtin_amdgcn_mfma_f32_32x32x16_bf16(__builtin_bit_cast(bf16x8, vv), pf[blk][s2], o0, 0, 0, 0); \
                    else           o1 = __builtin_amdgcn_mfma_f32_32x32x16_bf16(__builtin_bit_cast(bf16x8, vv), pf[blk][s2], o1, 0, 0, 0); } } \
        if (t + 2 < SEQ / 64) *(LAS u32x4*)(lds + (t & 1) * 8192 + kdst) = kst; \
        if (t + 1 < SEQ / 64) *(LAS u32x4*)(lds + ((t + 1) & 1) * 8192 + vdst) = vst; \
        if (t + 3 < SEQ / 64) kst = *(const u32x4*)(ksrc + (size_t)(t + 3) * 64 * 128); \
        if (t + 2 < SEQ / 64) vst = *(const u32x4*)(vsrc + (t + 2) * 64); \
        __syncthreads(); } while (0)
    for (int u = u_first; u < 512; u += u_stride) {
        const int b = u >> 6, g = (u >> 5) & 1, qt = u & 31;
        const int head = 4 * g + (wave >> 1); const int qrow = b * SEQ + qt * 64 + 32 * (wave & 1) + r32;
        bf16x8 qf[4];
#pragma unroll
        for (int s = 0; s < 4; ++s) qf[s] = *(const bf16x8*)(QH + (size_t)qrow * 512 + head * 64 + 16 * s + 8 * hi);
        const bf16_t* ksrc = KH + (size_t)(b * SEQ + skey) * 128 + g * 64 + 8 * sc;
        const bf16_t* vsrc = VT + ((size_t)(b * 2 + g) * 64 + skey) * SEQ + 8 * sc;
        const int kdst = skey * 128 + ((sc ^ (skey & 7)) * 16), vdst = 16384 + skey * 128 + ((sc ^ ((skey >> 1) & 7)) * 16);
        u32x4 kst = *(const u32x4*)ksrc, vst = *(const u32x4*)vsrc;
        const u32x4 kst1 = *(const u32x4*)(ksrc + (size_t)64 * 128);
        __syncthreads();
        *(LAS u32x4*)(lds + kdst) = kst; *(LAS u32x4*)(lds + vdst) = vst; *(LAS u32x4*)(lds + 8192 + kdst) = kst1;
        kst = *(const u32x4*)(ksrc + (size_t)2 * 64 * 128); vst = *(const u32x4*)(vsrc + 64);
        __syncthreads();
        f32x16 o0 = {}, o1 = {}; float mrun = -1e30f, lrun = 0.f;
        f32x16 ca0, ca1, cb0, cb1;
        AT_QK(ca0, ca1, 0);
        __syncthreads();
        for (int t2 = 0; t2 < SEQ / 64; t2 += 2) { AT_ITER(t2, ca0, ca1, cb0, cb1); AT_ITER(t2 + 1, cb0, cb1, ca0, ca1); }
        const float ltot = lrun + __shfl_xor(lrun, 32); const float inv = 1.f / ltot;
        bf16_t* op = YC + (size_t)qrow * 1024 + 512 + head * 64 + 4 * hi;
#pragma unroll
        for (int q4 = 0; q4 < 4; ++q4) { u32x2 w0, w1;
            w0.x = pk2(o0[4 * q4 + 0] * inv, o0[4 * q4 + 1] * inv); w0.y = pk2(o0[4 * q4 + 2] * inv, o0[4 * q4 + 3] * inv);
            w1.x = pk2(o1[4 * q4 + 0] * inv, o1[4 * q4 + 1] * inv); w1.y = pk2(o1[4 * q4 + 2] * inv, o1[4 * q4 + 3] * inv);
            *(u32x2*)(op + 8 * q4) = w0; *(u32x2*)(op + 32 + 8 * q4) = w1; }
    }
#undef AT_QK
#undef AT_ITER
}

__device__ __forceinline__ void phase_attn(const Frame& F) { phase_attn_range(F, F.vcu, F.G); }
__device__ __forceinline__ void phase_cscan_attn_split(const Frame& F) {
    const int half_g = F.G >> 1, me = F.vcu >> 1;
    if ((F.vcu & 1) == 0) {
        for (int chain = me; chain < 128; chain += half_g) { const int dir = chain & 1, bh = chain >> 1, b = bh >> 3, h = bh & 7;
            for (int q_ = 0; q_ <= (int)((MK_REP_SUB) & 1u); ++q_) { if (dir) cscan_job<1>(F, b, h); else cscan_job<0>(F, b, h); } }
    } else {
        for (int q_ = 0; q_ <= (int)(((MK_REP_SUB) >> 1) & 1u); ++q_)
        for (int u4 = me; u4 * 4 < 512; u4 += half_g) for (int q = 0; q < 4; ++q) phase_attn_range(F, u4 * 4 + q, 1 << 30);
        __syncthreads();
        for (int q_ = 0; q_ <= (int)(((MK_REP_SUB) >> 4) & 1u); ++q_)
        { conv_experts_down(F, me * NWAVES + F.wave, half_g * NWAVES); conv_experts_gu(F, me * NWAVES + F.wave, half_g * NWAVES, EGU_EARLY, NEXP); }
    }
}
__device__ __forceinline__ void phase_rwkv_post(const Frame& F) {
    const int lane = F.lane, wave = F.wave, fr = lane & 15, fq = lane >> 4;
    const bf16_t *YF = wsp<bf16_t>(F.ws, A_YF), *YB = wsp<bf16_t>(F.ws, A_YB);
    const bf16_t *RS = wsp<bf16_t>(F.ws, A_RS), *VS = wsp<bf16_t>(F.ws, A_VS), *KSP = wsp<bf16_t>(F.ws, A_KS), *SGF = wsp<bf16_t>(F.ws, A_SGF);
    const bf16_t* AP = wsp<bf16_t>(F.ws, A_AP) + 128; const bf16_t* WG = wsp<bf16_t>(F.ws, WS_WLR) + (size_t)2048 * 256 + 128;
    bf16_t* YC = wsp<bf16_t>(F.ws, A_YCAT);
    constexpr int GRS = 1040;
    LAS unsigned char* GL = F.lds;
    const int c0 = 8 * lane;
    float gw_[8], gb_[8], rk_[8], ka_[8];
#pragma unroll
    for (int i = 0; i < 8; ++i) { gw_[i] = F.in[16][c0 + i]; gb_[i] = F.in[17][c0 + i]; rk_[i] = F.in[15][c0 + i]; ka_[i] = F.in[14][c0 + i]; }
    for (int tile = F.vcu; tile < M_TOK / 64; tile += F.G) { const int t0 = tile * 64;
        { f32x4 acc[4][4];
#pragma unroll
          for (int nt = 0; nt < 4; ++nt)
#pragma unroll
              for (int mt = 0; mt < 4; ++mt) acc[nt][mt] = (f32x4){0.f, 0.f, 0.f, 0.f};
#pragma unroll
          for (int ks = 0; ks < 4; ++ks) { bf16x8 a[4], b[4];
#pragma unroll
              for (int nt = 0; nt < 4; ++nt) a[nt] = *(const bf16x8*)(WG + (size_t)(64 * wave + 16 * nt + fr) * 256 + 32 * ks + 8 * fq);
#pragma unroll
              for (int mt = 0; mt < 4; ++mt) b[mt] = *(const bf16x8*)(AP + (size_t)(t0 + 16 * mt + fr) * 256 + 32 * ks + 8 * fq);
#pragma unroll
              for (int nt = 0; nt < 4; ++nt)
#pragma unroll
                  for (int mt = 0; mt < 4; ++mt) acc[nt][mt] = __builtin_amdgcn_mfma_f32_16x16x32_bf16(a[nt], b[mt], acc[nt][mt], 0, 0, 0); }
#pragma unroll
          for (int nt = 0; nt < 4; ++nt)
#pragma unroll
              for (int mt = 0; mt < 4; ++mt) { u32x2 w; w.x = pk2(acc[nt][mt][0], acc[nt][mt][1]); w.y = pk2(acc[nt][mt][2], acc[nt][mt][3]);
                  *(LAS u32x2*)(GL + (16 * mt + fr) * GRS + (64 * wave + 16 * nt + 4 * fq) * 2) = w; } }
        __syncthreads();
        for (int j = 0; j < 8; ++j) { const int tl = 8 * wave + j; const size_t o = (size_t)(t0 + tl) * 512 + c0;
            const u32x4 yfw = *(const u32x4*)(YF + o), ybw = *(const u32x4*)(YB + o);
            float y[8]; float sm = 0.f;
            y[0] = bflo(yfw.x) + bflo(ybw.x); y[1] = bfhi(yfw.x) + bfhi(ybw.x); y[2] = bflo(yfw.y) + bflo(ybw.y); y[3] = bfhi(yfw.y) + bfhi(ybw.y);
            y[4] = bflo(yfw.z) + bflo(ybw.z); y[5] = bfhi(yfw.z) + bfhi(ybw.z); y[6] = bflo(yfw.w) + bflo(ybw.w); y[7] = bfhi(yfw.w) + bfhi(ybw.w);
#pragma unroll
            for (int i = 0; i < 8; ++i) sm += y[i];
            sm += __shfl_xor(sm, 1); sm += __shfl_xor(sm, 2); sm += __shfl_xor(sm, 4);
            const float mean = sm * (1.f / 64.f); float sv = 0.f;
#pragma unroll
            for (int i = 0; i < 8; ++i) { y[i] -= mean; sv += y[i] * y[i]; }
            sv += __shfl_xor(sv, 1); sv += __shfl_xor(sv, 2); sv += __shfl_xor(sv, 4);
            const float rstd = 1.0f / sqrtf(sv * (1.f / 64.f) + 64e-5f);
            const u32x4 rw = *(const u32x4*)(RS + o), vw = *(const u32x4*)(VS + o), kw = *(const u32x4*)(KSP + o), sw = *(const u32x4*)(SGF + o), gw4 = *(const LAS u32x4*)(GL + tl * GRS + c0 * 2);
            float r8[8], v8[8], k8[8], g8[8], s8[8]; unpack8(rw, r8); unpack8(vw, v8); unpack8(kw, k8); unpack8(gw4, g8); unpack8(sw, s8);
#pragma unroll
            for (int i = 0; i < 8; ++i) k8[i] = bf2f(f2bf(k8[i] * (1.f + (s8[i] - 1.f) * ka_[i])));
            float bs = 0.f;
#pragma unroll
            for (int i = 0; i < 8; ++i) bs += r8[i] * k8[i] * rk_[i];
            bs += __shfl_xor(bs, 1); bs += __shfl_xor(bs, 2); bs += __shfl_xor(bs, 4);
            float ov[8];
#pragma unroll
            for (int i = 0; i < 8; ++i) ov[i] = ((y[i] * rstd) * gw_[i] + gb_[i] + bs * v8[i]) * g8[i];
            *(u32x4*)(YC + (size_t)(t0 + tl) * 1024 + c0) = pack8f(ov); }
        __syncthreads(); }
}

__device__ __forceinline__ void phase_gd(const Frame& F) {
    const int tid = F.tid, lane = F.lane, wave = F.wave, fr = lane & 15, fq = lane >> 4;
    LAS f32x4* PL = (LAS f32x4*)F.lds;
    const bf16_t* XB = wsp<bf16_t>(F.ws, WS_XB); const bf16_t* WG = wsp<bf16_t>(F.ws, WS_WIN1) + (size_t)3072 * 1024; const float* ssq = wsp<float>(F.ws, WS_SSQ2); bf16_t* P1 = wsp<bf16_t>(F.ws, A_P1);
    const int tpb = M_TOK / F.G;
    for (int t0 = F.vcu * tpb; t0 < (F.vcu + 1) * tpb; t0 += 64) {
        f32x4 acc[4];
#pragma unroll
        for (int t = 0; t < 4; ++t) acc[t] = (f32x4){0.f, 0.f, 0.f, 0.f};
#pragma unroll
        for (int s4 = 0; s4 < 4; ++s4) { const int k0 = 32 * (4 * wave + s4) + 8 * fq;
            const bf16x8 bfr = *(const bf16x8*)(WG + (size_t)fr * 1024 + k0);
#pragma unroll
            for (int t = 0; t < 4; ++t) { const bf16x8 afr = *(const bf16x8*)(XB + (size_t)(t0 + 16 * t + fr) * 1024 + k0);
                acc[t] = __builtin_amdgcn_mfma_f32_16x16x32_bf16(afr, bfr, acc[t], 0, 0, 0); } }
        __syncthreads();
#pragma unroll
        for (int t = 0; t < 4; ++t) PL[(wave * 4 + t) * 64 + lane] = acc[t];
        __syncthreads();
        if (tid < 256) { const int t = tid >> 6, l = tid & 63; f32x4 sum = PL[t * 64 + l];
#pragma unroll
            for (int w = 1; w < 8; ++w) sum += PL[(w * 4 + t) * 64 + l];
            const int lfr = l & 15, lfq = l >> 4;
#pragma unroll
            for (int r = 0; r < 4; ++r) { const int tok = t0 + 16 * t + 4 * lfq + r; P1[(size_t)tok * O_INP + 3072 + lfr] = f2bf(sum[r] * rstd_from_ssq(ssq, tok)); } }
    }
}

constexpr float GLA_QSCALE = 0.08838834764831845f;
__device__ __forceinline__ size_t gla_dir(size_t base, int dir) { return base + (size_t)dir * GLA_DIR_STRIDE; }
__device__ __forceinline__ float logsig16(float z) { return (fminf(z, 0.f) - __logf(1.f + __expf(-fabsf(z)))) * (1.f / 16.f); }
__device__ __forceinline__ void phase_gla_prep(const Frame& F) {
    const int tid = F.tid, lane = F.lane, wave = F.wave, fr = lane & 15, fq = lane >> 4;
    LAS float* GD = (LAS float*)F.lds;
    LAS float* PT = (LAS float*)(F.lds + 4096);
    LAS unsigned char* QTt = F.lds + 10240;
    LAS unsigned char* KTt = F.lds + 10240 + 17408;
    LAS unsigned char* RV = F.lds + 10240;
    LAS unsigned char* RQ = F.lds + 45056; LAS unsigned char* RK = F.lds + 45056 + 16384;
    LAS unsigned char* ATT = F.lds + 45056;
    LAS unsigned char* QHl = F.lds + 45056 + 9216;
    LAS unsigned char* VTt = F.lds + 77824;
    const bf16_t* P1 = wsp<bf16_t>(F.ws, A_P1);
    bf16_t* VT = wsp<bf16_t>(F.ws, A_VT1); float* DECS = wsp<float>(F.ws, WS_DECS); bf16_t* OF = wsp<bf16_t>(F.ws, A_OF);
    const int d = tid & 127, qr = tid >> 7;
    u32x4 pq[2], pk_[2], pv[4]; bf16_t pg[2];
#define GP_FETCH(u_) do { const int n_ = (u_) & 31, h_ = ((u_) >> 5) & 3, b_ = (u_) >> 7; const int T_ = b_ * SEQ + 64 * n_; \
        _Pragma("unroll") for (int i = 0; i < 2; ++i) { const int p = tid + 512 * i; pg[i] = P1[(size_t)(T_ + (p >> 4)) * O_INP + 3072 + (p & 15)]; \
            const int row = p >> 4, c = p & 15; const bf16_t* src = P1 + (size_t)(T_ + row) * O_INP + h_ * 128 + 8 * c; pq[i] = *(const u32x4*)src; pk_[i] = *(const u32x4*)(src + 512); } \
        _Pragma("unroll") for (int i = 0; i < 4; ++i) { const int p = tid + 512 * i, row = p >> 5, c = p & 31; pv[i] = *(const u32x4*)(P1 + (size_t)(T_ + row) * O_INP + 1024 + h_ * 256 + 8 * c); } } while (0)
    float upf[16], upb[16]; float bif = 0.f, bib = 0.f; int h_cur = -1;
    if (F.vcu < BATCH * GLA_H * 32) GP_FETCH(F.vcu);
    for (int unit = F.vcu; unit < BATCH * GLA_H * 32; unit += F.G) {
        const int n = unit & 31, h = (unit >> 5) & 3, b = unit >> 7; const int T0 = b * SEQ + 64 * n; const size_t tile = (size_t)(b * 4 + h) * 32 + n;
        __syncthreads();
#pragma unroll
        for (int i = 0; i < 2; ++i) { const int p = tid + 512 * i, row = p >> 4, c = p & 15; GD[p] = bf2f(pg[i]);
            *(LAS u32x4*)(RQ + row * 256 + c * 16) = pq[i]; *(LAS u32x4*)(RK + row * 256 + c * 16) = pk_[i]; }
#pragma unroll
        for (int i = 0; i < 4; ++i) { const int p = tid + 512 * i, row = p >> 5, c = p & 31; *(LAS u32x4*)(RV + row * 512 + c * 16) = pv[i]; }
        if (h != h_cur) { h_cur = h;
#pragma unroll
            for (int r = 0; r < 16; ++r) { upf[r] = F.in[27][r * 512 + h * 128 + d]; upb[r] = F.in[29][r * 512 + h * 128 + d]; }
            bif = F.in[28][h * 128 + d]; bib = F.in[30][h * 128 + d]; }
        if (unit + F.G < BATCH * GLA_H * 32) GP_FETCH(unit + F.G);
        __syncthreads();
        bf16_t qraw[16], kraw[16];
#pragma unroll
        for (int j = 0; j < 16; ++j) { qraw[j] = *(const LAS bf16_t*)(RQ + (16 * qr + j) * 256 + d * 2); kraw[j] = *(const LAS bf16_t*)(RK + (16 * qr + j) * 256 + d * 2); }
        { const int dv = tid & 255, th = tid >> 8; unsigned pk[16];
#pragma unroll
          for (int j = 0; j < 16; ++j) pk[j] = (unsigned)*(const LAS bf16_t*)(RV + (32 * th + 2 * j) * 512 + dv * 2) | ((unsigned)*(const LAS bf16_t*)(RV + (32 * th + 2 * j + 1) * 512 + dv * 2) << 16);
          bf16_t* gdst = VT + tile * 16384 + dv * 64 + 32 * th;
#pragma unroll
          for (int q = 0; q < 4; ++q) { const u32x4 w = {pk[4 * q], pk[4 * q + 1], pk[4 * q + 2], pk[4 * q + 3]}; *(u32x4*)(gdst + 8 * q) = w; *(LAS u32x4*)(VTt + dv * 144 + (32 * th + 8 * q) * 2) = w; } }
        float Bf[16], Bb[16];
#pragma unroll
        for (int j = 0; j < 16; ++j) { const LAS f32x4* gp = (const LAS f32x4*)(GD + (16 * qr + j) * 16); float zf = bif, zb = bib;
#pragma unroll
            for (int q = 0; q < 4; ++q) { const f32x4 g4 = gp[q];
#pragma unroll
                for (int e = 0; e < 4; ++e) { zf += g4[e] * upf[4 * q + e]; zb += g4[e] * upb[4 * q + e]; } }
            Bf[j] = logsig16(zf); Bb[j] = logsig16(zb); }
#pragma unroll
        for (int j = 1; j < 16; ++j) Bf[j] += Bf[j - 1];
#pragma unroll
        for (int j = 14; j >= 0; --j) Bb[j] += Bb[j + 1];
        PT[(0 * 4 + qr) * 128 + d] = Bf[15]; PT[(1 * 4 + qr) * 128 + d] = Bb[0];
        if (qr == 2) PT[1024 + d] = Bf[0];
        if (qr == 1) PT[1024 + 128 + d] = Bb[15];
        __syncthreads();
        float offf = 0.f, offb = 0.f, totf = 0.f, totb = 0.f, pre2f = 0.f, suf2b = 0.f;
#pragma unroll
        for (int q = 0; q < 4; ++q) { const float pf = PT[q * 128 + d], pb = PT[(4 + q) * 128 + d]; totf += pf; totb += pb; if (q < qr) offf += pf; if (q > qr) offb += pb; if (q < 2) pre2f += pf; if (q >= 2) suf2b += pb; }
        const float bmf = pre2f + PT[1024 + d], bmb = suf2b + PT[1024 + 128 + d];
#pragma unroll
        for (int j = 0; j < 16; ++j) { Bf[j] += offf; Bb[j] += offb; }
        f32x4 oacc[2][4];
#pragma unroll
        for (int x = 0; x < 2; ++x)
#pragma unroll
            for (int y = 0; y < 4; ++y) oacc[x][y] = (f32x4){0.f, 0.f, 0.f, 0.f};
#pragma unroll
        for (int dir = 0; dir < 2; ++dir) {
            const float bm = dir ? bmb : bmf, bl = dir ? totb : totf; const float ebm = __expf(bm), ebl = __expf(bl - bm);
            bf16_t* QHT = wsp<bf16_t>(F.ws, gla_dir(A_QHAT, dir)) + tile * 8192; bf16_t* K2T = wsp<bf16_t>(F.ws, gla_dir(A_K2T, dir)) + tile * 8192;
            unsigned k2pk[8];
#pragma unroll
            for (int j = 0; j < 16; ++j) { const float bv = dir ? Bb[j] : Bf[j]; const float e1 = __expf(bv - bm), r1 = __builtin_amdgcn_rcpf(e1);
                const float qs = bf2f(qraw[j]) * GLA_QSCALE, kk = bf2f(kraw[j]); const int tk = 16 * qr + j;
                const float qt = qs * e1, kt = kk * r1, qh = qt * ebm, k2 = kt * ebl;
                *(LAS bf16_t*)(QTt + tk * 272 + d * 2) = f2bf(qt); *(LAS bf16_t*)(KTt + tk * 272 + d * 2) = f2bf(kt); *(LAS bf16_t*)(QHl + tk * 272 + d * 2) = f2bf(qh);
                if (j & 1) k2pk[j >> 1] |= ((unsigned)f2bf(k2)) << 16; else k2pk[j >> 1] = (unsigned)f2bf(k2); }
            { bf16_t* kd = K2T + d * 64 + 16 * qr;
              *(u32x4*)kd = (u32x4){k2pk[0], k2pk[1], k2pk[2], k2pk[3]}; *(u32x4*)(kd + 8) = (u32x4){k2pk[4], k2pk[5], k2pk[6], k2pk[7]}; }
            if (qr == 0) DECS[((size_t)((b * 4 + h) * 2 + dir) * 32 + n) * 128 + d] = __expf(bl);
            __syncthreads();
#pragma unroll
            for (int i = 0; i < 2; ++i) { const int p = tid + 512 * i, row = p >> 4, c = p & 15; *(u32x4*)(QHT + row * 128 + c * 8) = *(const LAS u32x4*)(QHl + row * 272 + c * 16); }
            { const int ib = wave >> 1, jb0 = 2 * (wave & 1); f32x4 at[2] = {(f32x4){0.f, 0.f, 0.f, 0.f}, (f32x4){0.f, 0.f, 0.f, 0.f}};
#pragma unroll
              for (int s2 = 0; s2 < 4; ++s2) { const bf16x8 a = *(const LAS bf16x8*)(QTt + (16 * ib + fr) * 272 + (32 * s2 + 8 * fq) * 2);
#pragma unroll
                  for (int jj = 0; jj < 2; ++jj) { const bf16x8 bb = *(const LAS bf16x8*)(KTt + (16 * (jb0 + jj) + fr) * 272 + (32 * s2 + 8 * fq) * 2);
                      at[jj] = __builtin_amdgcn_mfma_f32_16x16x32_bf16(a, bb, at[jj], 0, 0, 0); } }
#pragma unroll
              for (int jj = 0; jj < 2; ++jj)
#pragma unroll
                  for (int r = 0; r < 4; ++r) { const int i = 16 * ib + 4 * fq + r, j = 16 * (jb0 + jj) + fr; const bool keep = dir ? (j > i) : (j <= i);
                      *(LAS bf16_t*)(ATT + i * 144 + j * 2) = f2bf(keep ? at[jj][r] : 0.f); } }
            __syncthreads();
#pragma unroll
            for (int s2 = 0; s2 < 2; ++s2) { bf16x8 bfr[4];
#pragma unroll
                for (int ib = 0; ib < 4; ++ib) bfr[ib] = *(const LAS bf16x8*)(ATT + (16 * ib + fr) * 144 + (32 * s2 + 8 * fq) * 2);
#pragma unroll
                for (int x = 0; x < 2; ++x) { const bf16x8 a = *(const LAS bf16x8*)(VTt + (16 * (2 * wave + x) + fr) * 144 + (32 * s2 + 8 * fq) * 2);
#pragma unroll
                    for (int ib = 0; ib < 4; ++ib) oacc[x][ib] = __builtin_amdgcn_mfma_f32_16x16x32_bf16(a, bfr[ib], oacc[x][ib], 0, 0, 0); } }
        }
#pragma unroll
        for (int x = 0; x < 2; ++x)
#pragma unroll
            for (int ib = 0; ib < 4; ++ib) { u32x2 w; w.x = pk2(oacc[x][ib][0], oacc[x][ib][1]); w.y = pk2(oacc[x][ib][2], oacc[x][ib][3]);
                *(u32x2*)(OF + (size_t)(T0 + 16 * ib + fr) * 1024 + h * 256 + 16 * (2 * wave + x) + 4 * fq) = w; }
    }
}
#undef GP_FETCH

template <int DIR> __device__ __forceinline__ void gla_seq_job(const Frame& F, int b, int h, int vs) {
    const int tid = F.tid, lane = F.lane, wave = F.wave, fr = lane & 15, fq = lane >> 4;
    LAS unsigned char* ST0 = F.lds; LAS unsigned char* ST1 = F.lds + 17408;
    LAS unsigned char* BUF = F.lds + 34816;
    constexpr int BQ = 0, BK2 = 17408, BVT = 17408 + 18432, BSZ = 45056;
    const bf16_t* QHT = wsp<bf16_t>(F.ws, gla_dir(A_QHAT, DIR)); const bf16_t* K2T = wsp<bf16_t>(F.ws, gla_dir(A_K2T, DIR));
    const bf16_t* VT = wsp<bf16_t>(F.ws, A_VT1); const float* DECS = wsp<float>(F.ws, WS_DECS); bf16_t* OF = wsp<bf16_t>(F.ws, A_OF); bf16_t* O = DIR ? wsp<bf16_t>(F.ws, A_OB) : OF;
    const int dvb = wave >> 1, ib0 = 2 * (wave & 1);
    const size_t tile0 = (size_t)(b * 4 + h) * 32;
    const int q0 = tid, q1 = tid + 512;
    const int dq0 = BQ + (q0 >> 4) * 272 + (q0 & 15) * 16, dq1 = BQ + (q1 >> 4) * 272 + (q1 & 15) * 16;
    const int dk0 = BK2 + (q0 >> 3) * 144 + (q0 & 7) * 16, dk1 = BK2 + (q1 >> 3) * 144 + (q1 & 7) * 16;
    const int dv0 = BVT + (q0 >> 3) * 144 + (q0 & 7) * 16;
    u32x4 sg[5]; f32x4 dec, decn; u32x2 oold[2], ooldn[2];
#define GL_LD(n_) do { const size_t t_ = tile0 + (n_); \
        sg[0] = *(const u32x4*)(QHT + t_ * 8192 + q0 * 8); sg[1] = *(const u32x4*)(QHT + t_ * 8192 + q1 * 8); \
        sg[2] = *(const u32x4*)(K2T + t_ * 8192 + q0 * 8); sg[3] = *(const u32x4*)(K2T + t_ * 8192 + q1 * 8); \
        sg[4] = *(const u32x4*)(VT + t_ * 16384 + vs * 4096 + q0 * 8); \
        decn = *(const f32x4*)(DECS + ((size_t)((b * 4 + h) * 2 + DIR) * 32 + (n_)) * 128 + 16 * wave + 4 * fq); \
        if (!DIR) { _Pragma("unroll") for (int ii = 0; ii < 2; ++ii) ooldn[ii] = *(const u32x2*)(OF + (size_t)(b * SEQ + 64 * (n_) + 16 * (ib0 + ii) + fr) * 1024 + h * 256 + 64 * vs + 16 * dvb + 4 * fq); } } while (0)
#define GL_ST(bp) do { *(LAS u32x4*)((bp) + dq0) = sg[0]; *(LAS u32x4*)((bp) + dq1) = sg[1]; *(LAS u32x4*)((bp) + dk0) = sg[2]; *(LAS u32x4*)((bp) + dk1) = sg[3]; *(LAS u32x4*)((bp) + dv0) = sg[4]; } while (0)
    __syncthreads();
    for (int i = tid; i < 17408 / 4; i += 512) ((LAS unsigned*)ST0)[i] = 0u;
    f32x4 st[4];
#pragma unroll
    for (int k = 0; k < 4; ++k) st[k] = (f32x4){0.f, 0.f, 0.f, 0.f};
    GL_LD(DIR ? 31 : 0); GL_ST(BUF); dec = decn; oold[0] = ooldn[0]; oold[1] = ooldn[1];
    __syncthreads();
    for (int cc = 0; cc < 32; ++cc) { const int n = DIR ? 31 - cc : cc, nn = DIR ? 30 - cc : cc + 1; const int T0 = b * SEQ + 64 * n;
        LAS unsigned char* STr = (cc & 1) ? ST1 : ST0; LAS unsigned char* STw = (cc & 1) ? ST0 : ST1;
        LAS unsigned char* bc = BUF + (cc & 1) * BSZ; LAS unsigned char* bn = BUF + ((cc + 1) & 1) * BSZ;
        if (cc + 1 < 32) GL_LD(nn);
#pragma unroll
        for (int x = 0; x < 4; ++x) st[x] = st[x] * dec;
        f32x4 oo[2] = {(f32x4){0.f, 0.f, 0.f, 0.f}, (f32x4){0.f, 0.f, 0.f, 0.f}};
#pragma unroll
        for (int s2 = 0; s2 < 4; ++s2) { const bf16x8 a = *(const LAS bf16x8*)(STr + (16 * dvb + fr) * 272 + (32 * s2 + 8 * fq) * 2);
#pragma unroll
            for (int ii = 0; ii < 2; ++ii) { const bf16x8 qf = *(const LAS bf16x8*)(bc + BQ + (16 * (ib0 + ii) + fr) * 272 + (32 * s2 + 8 * fq) * 2);
                oo[ii] = __builtin_amdgcn_mfma_f32_16x16x32_bf16(a, qf, oo[ii], 0, 0, 0); } }
#pragma unroll
        for (int s2 = 0; s2 < 2; ++s2) { const bf16x8 kf = *(const LAS bf16x8*)(bc + BK2 + (16 * wave + fr) * 144 + (32 * s2 + 8 * fq) * 2);
#pragma unroll
            for (int x = 0; x < 4; ++x) { const bf16x8 vf = *(const LAS bf16x8*)(bc + BVT + (16 * x + fr) * 144 + (32 * s2 + 8 * fq) * 2);
                st[x] = __builtin_amdgcn_mfma_f32_16x16x32_bf16(kf, vf, st[x], 0, 0, 0); } }
#pragma unroll
        for (int x = 0; x < 4; ++x) { u32x2 w; w.x = pk2(st[x][0], st[x][1]); w.y = pk2(st[x][2], st[x][3]); *(LAS u32x2*)(STw + (16 * x + fr) * 272 + (16 * wave + 4 * fq) * 2) = w; }
#pragma unroll
        for (int ii = 0; ii < 2; ++ii) { f32x4 v = oo[ii];
            if (!DIR) { v[0] += bflo(oold[ii].x); v[1] += bfhi(oold[ii].x); v[2] += bflo(oold[ii].y); v[3] += bfhi(oold[ii].y); }
            u32x2 w; w.x = pk2(v[0], v[1]); w.y = pk2(v[2], v[3]);
            *(u32x2*)(O + (size_t)(T0 + 16 * (ib0 + ii) + fr) * 1024 + h * 256 + 64 * vs + 16 * dvb + 4 * fq) = w; }
        if (cc + 1 < 32) { GL_ST(bn); dec = decn; oold[0] = ooldn[0]; oold[1] = ooldn[1]; }
        __syncthreads(); }
#undef GL_LD
#undef GL_ST
}
__device__ __forceinline__ void phase_gla_main(const Frame& F) {
    for (int job = F.vcu; job < 256; job += F.G) { const int vs = job & 3, dir = (job >> 2) & 1, h = (job >> 3) & 3, b = job >> 5;
        if (dir) gla_seq_job<1>(F, b, h, vs); else gla_seq_job<0>(F, b, h, vs); }
}

__device__ __forceinline__ void phase_gla_post(const Frame& F) {
    const int gw = F.vcu * NWAVES + F.wave, lane = F.lane; const int c0 = 16 * lane;
    const bf16_t *OF = wsp<bf16_t>(F.ws, A_OF), *OB = wsp<bf16_t>(F.ws, A_OB), *P1 = wsp<bf16_t>(F.ws, A_P1); bf16_t* GO = wsp<bf16_t>(F.ws, A_GOUT);
    float gn[16];
#pragma unroll
    for (int i = 0; i < 16; ++i) gn[i] = F.in[31][(c0 + i) & 255];
    for (int tok = gw; tok < M_TOK; tok += F.G * NWAVES) { const size_t o = (size_t)tok * 1024 + c0;
        float v[16]; float ss = 0.f;
#pragma unroll
        for (int hh = 0; hh < 2; ++hh) { const u32x4 a = *(const u32x4*)(OF + o + 8 * hh), bq = *(const u32x4*)(OB + o + 8 * hh);
            v[8 * hh + 0] = bflo(a.x) + bflo(bq.x); v[8 * hh + 1] = bfhi(a.x) + bfhi(bq.x); v[8 * hh + 2] = bflo(a.y) + bflo(bq.y); v[8 * hh + 3] = bfhi(a.y) + bfhi(bq.y);
            v[8 * hh + 4] = bflo(a.z) + bflo(bq.z); v[8 * hh + 5] = bfhi(a.z) + bfhi(bq.z); v[8 * hh + 6] = bflo(a.w) + bflo(bq.w); v[8 * hh + 7] = bfhi(a.w) + bfhi(bq.w); }
#pragma unroll
        for (int i = 0; i < 16; ++i) ss += v[i] * v[i];
        ss = dpp_row_sum(ss);
        const float rs = 1.0f / sqrtf(ss * (1.f / 256.f) + NORM_EPS);
        float og[16];
#pragma unroll
        for (int hh = 0; hh < 2; ++hh) { const u32x4 g = *(const u32x4*)(P1 + (size_t)tok * O_INP + 2048 + c0 + 8 * hh);
            og[8 * hh + 0] = bflo(g.x); og[8 * hh + 1] = bfhi(g.x); og[8 * hh + 2] = bflo(g.y); og[8 * hh + 3] = bfhi(g.y); og[8 * hh + 4] = bflo(g.z); og[8 * hh + 5] = bfhi(g.z); og[8 * hh + 6] = bflo(g.w); og[8 * hh + 7] = bfhi(g.w); }
        float r[16];
#pragma unroll
        for (int i = 0; i < 16; ++i) r[i] = v[i] * rs * gn[i] * siluf_(og[i]);
#pragma unroll
        for (int hh = 0; hh < 2; ++hh) { u32x4 w; w.x = pk2(r[8 * hh + 0], r[8 * hh + 1]); w.y = pk2(r[8 * hh + 2], r[8 * hh + 3]); w.z = pk2(r[8 * hh + 4], r[8 * hh + 5]); w.w = pk2(r[8 * hh + 6], r[8 * hh + 7]);
            *(u32x4*)(GO + o + 8 * hh) = w; } }
}

__device__ __forceinline__ void phase_route(const Frame& F) {
    const int tid = F.tid, lane = F.lane, wave = F.wave;
    LAS int* lcnt = (LAS int*)(F.lds + MOE_OFF);
    LAS float* RL = (LAS float*)F.lds;
    __syncthreads();
    if (tid < 16) lcnt[tid] = 0;
    const float* X = F.out; const float* g2 = F.in[33]; const float* RT = F.in[34];
    for (int i = tid; i < 2048; i += 512) { const int k = i >> 1; const f32x4 r = *(const f32x4*)(RT + (size_t)i * 4); *(LAS f32x4*)(RL + i * 4) = r * g2[k]; }
    __syncthreads();
    int* TE = wsp<int>(F.ws, WS_TOKE); float* TG = wsp<float>(F.ws, WS_TOKG); float* R3 = wsp<float>(F.ws, WS_RSTD3);
    const int tpb = M_TOK / F.G, tpw = tpb / NWAVES;
    for (int i0 = 0; i0 < tpw; i0 += 4) { const int tok0 = F.vcu * tpb + wave * tpw + i0;
        float acc[4][8], ss[4];
#pragma unroll
        for (int t = 0; t < 4; ++t) { ss[t] = 0.f;
#pragma unroll
            for (int e = 0; e < 8; ++e) acc[t][e] = 0.f; }
#pragma unroll
        for (int j = 0; j < 4; ++j) { const int k0 = 4 * lane + 256 * j; f32x4 xv[4];
#pragma unroll
            for (int t = 0; t < 4; ++t) xv[t] = *(const f32x4*)(X + (size_t)(tok0 + t) * 1024 + k0);
#pragma unroll
            for (int q = 0; q < 4; ++q) { const f32x4 r0 = *(const LAS f32x4*)(RL + (k0 + q) * 8), r1 = *(const LAS f32x4*)(RL + (k0 + q) * 8 + 4);
#pragma unroll
                for (int t = 0; t < 4; ++t) { const float xx = xv[t][q]; ss[t] += xx * xx;
                    acc[t][0] += xx * r0[0]; acc[t][1] += xx * r0[1]; acc[t][2] += xx * r0[2]; acc[t][3] += xx * r0[3]; acc[t][4] += xx * r1[0]; acc[t][5] += xx * r1[1]; acc[t][6] += xx * r1[2]; acc[t][7] += xx * r1[3]; } } }
#pragma unroll
        for (int t = 0; t < 4; ++t) { ss[t] = wave_sum(ss[t]);
#pragma unroll
            for (int e = 0; e < 8; ++e) acc[t][e] = wave_sum(acc[t][e]); }
        float lg[8]; float mss = 0.f;
#pragma unroll
        for (int t = 0; t < 4; ++t) { if (lane == t) { mss = ss[t];
#pragma unroll
                for (int e = 0; e < 8; ++e) lg[e] = acc[t][e]; } }
        if (lane < 4) { const int tok = tok0 + lane;
            const float rstd = 1.0f / sqrtf(mss * (1.f / 1024.f) + NORM_EPS);
            int i1 = 0; float l1 = lg[0] * rstd;
#pragma unroll
            for (int e = 1; e < 8; ++e) { const float l = lg[e] * rstd; if (l > l1) { l1 = l; i1 = e; } }
            int i2 = -1; float l2 = -3.0e38f;
#pragma unroll
            for (int e = 0; e < 8; ++e) { const float l = lg[e] * rstd; if (e != i1 && l > l2) { l2 = l; i2 = e; } }
            const float e2 = __expf(l2 - l1); const float ga = 1.f / (1.f + e2), gb = e2 / (1.f + e2);
            TE[tok * 2] = i1; TE[tok * 2 + 1] = i2; TG[tok * 2] = ga; TG[tok * 2 + 1] = gb; R3[tok] = rstd;
            atomicAdd((int*)&lcnt[i1], 1); atomicAdd((int*)&lcnt[8 + i2], 1); } }
    __syncthreads();
    if (tid < 16) wsp<int>(F.ws, WS_CNT)[F.vcu * 16 + tid] = lcnt[tid];
}
__device__ __forceinline__ void phase_place(const Frame& F) {
    const int tid = F.tid;
    LAS int* tab = (LAS int*)(F.lds + MOE_OFF);
    LAS int* C = (LAS int*)F.lds;
    LAS int* TEl = (LAS int*)(F.lds + 32768); LAS float* TGl = (LAS float*)(F.lds + 32768 + 1024);
    const int* CNT = wsp<int>(F.ws, WS_CNT); const int tpb = M_TOK / F.G;
    __syncthreads();
    for (int i = tid; i < F.G * 16; i += 512) C[i] = CNT[i];
    if (tid < 2 * tpb) { TEl[tid] = wsp<int>(F.ws, WS_TOKE)[F.vcu * tpb * 2 + tid]; TGl[tid] = wsp<float>(F.ws, WS_TOKG)[F.vcu * tpb * 2 + tid]; }
    __syncthreads();
    if (tid < 16) { int off = 0, tot = 0; for (int bb = 0; bb < F.G; ++bb) { const int c = C[bb * 16 + tid]; if (bb < F.vcu) off += c; tot += c; } tab[tid] = off; tab[16 + tid] = tot;
        if (F.vcu == 0) wsp<int>(F.ws, WS_TOT)[tid] = tot; }
    __syncthreads();
    if (tid < 16) { const int s = tid >> 3, e = tid & 7; int run = tab[tid]; for (int q = 0; q < e; ++q) run += tab[16 + q] + tab[24 + q];
        if (s) run += tab[16 + e];
        int* RTK = wsp<int>(F.ws, WS_ROWTOK); float* RGT = wsp<float>(F.ws, WS_ROWGATE);
        for (int i = 0; i < tpb; ++i) { if (TEl[i * 2 + s] == e) { RTK[run] = F.vcu * tpb + i; RGT[run] = TGl[i * 2 + s]; ++run; } } }
}
struct MoESched {
    pg8::GridOrder go; const LAS int* tab;
    const char* A; const char* Bt; size_t a_rowbytes, b_expert_bytes, b_tile_bytes; bool gather; int nt_;
    __device__ bool next(int i, pg8::Unit& u) const {
        int pm, pn; if (!go.tile(i, pm, pn)) return false;
        int e = 0;
#pragma unroll
        for (int q = 1; q < 8; ++q) if (pm >= tab[16 + q]) e = q;
        e = __builtin_amdgcn_readfirstlane(e);
        const int mt = pm - __builtin_amdgcn_readfirstlane(tab[16 + e]); const int row0 = __builtin_amdgcn_readfirstlane(tab[e]) + 256 * mt; int nr = __builtin_amdgcn_readfirstlane(tab[8 + e]) - 256 * mt; nr = nr > 256 ? 256 : nr;
        u.pm = pm; u.pn = pn; u.e = e; u.row0 = row0; u.nrows = nr; u.nt = nt_; u.flags = 0;
        u.a = gather ? A : A + (size_t)row0 * a_rowbytes; u.b = Bt + (size_t)e * b_expert_bytes + (size_t)pn * b_tile_bytes + (e >= EGU_EARLY ? WEGU_HI_SHIFT : (size_t)0); return true;
    }
};
struct MoEDownSched {
    const LAS int* tab; const char* A; const char* Bt; int nmt, c, round;
    __device__ void fill(pg8::Unit& u, int pm, int pn, int kp, int nt, int flags) const {
        int e = 0;
#pragma unroll
        for (int q = 1; q < 8; ++q) if (pm >= tab[16 + q]) e = q;
        e = __builtin_amdgcn_readfirstlane(e);
        const int mt = pm - __builtin_amdgcn_readfirstlane(tab[16 + e]); const int row0 = __builtin_amdgcn_readfirstlane(tab[e]) + 256 * mt; int nr = __builtin_amdgcn_readfirstlane(tab[8 + e]) - 256 * mt; nr = nr > 256 ? 256 : nr;
        u.pm = pm; u.pn = pn; u.e = e; u.row0 = row0; u.nrows = nr; u.nt = nt; u.flags = flags;
        u.a = A + (size_t)row0 * (D_FFE * 2) + (size_t)kp * 512 * 2; u.b = Bt + (size_t)e * ((size_t)1024 * D_FFE * 2) + (size_t)pn * ((size_t)256 * D_FFE * 2) + (size_t)kp * 512 * 2;
    }
    __device__ bool next(int i, pg8::Unit& u) const {
        if (i != 0) return false;
        if (round == 0) { const int pm = 8 * (c & 7) + ((c >> 3) & 7), pn = c >> 6; if (pm >= nmt) return false; fill(u, pm, pn, 0, D_FFE / 64, 0); return true; }
        { const int t = c / 7, kp = c % 7; const int pm = 64 + (t >> 2), pn = t & 3; if (pm >= nmt || t >= 36) return false; fill(u, pm, pn, kp, 8, 1 + c); return true; }
        return false;
    }
};
__device__ __forceinline__ int moe_table(const Frame& F, int mode) {
    LAS int* tab = (LAS int*)(F.lds + MOE_OFF);
    __syncthreads();
    if (F.tid == 0) { const int* TOT = wsp<int>(F.ws, WS_TOT); int rs = 0, ts = 0;
        for (int e = 0; e < 8; ++e) { const int c0 = TOT[e], c1 = TOT[8 + e]; const int st = rs + (mode == 1 ? c0 : 0), c = mode == 0 ? c0 : (mode == 1 ? c1 : c0 + c1);
            tab[e] = st; tab[8 + e] = c; tab[16 + e] = ts; rs += c0 + c1; ts += (c + 255) >> 8; }
        tab[24] = ts; }
    __syncthreads();
    return __builtin_amdgcn_readfirstlane(tab[24]);
}

__device__ __forceinline__ void moe_tail_reduce(const Frame& F, int s) {
    const int nmt = moe_table(F, s); const LAS int* tab = (const LAS int*)(F.lds + MOE_OFF);
    const int R = (nmt - 64) * 4; const int gw = F.vcu * NWAVES + F.wave, lane = F.lane;
    const float* part = wsp<float>(F.ws, s ? A_WEGU2 : A_WEGU); const int* RTK = wsp<int>(F.ws, WS_ROWTOK); const float* RGT = wsp<float>(F.ws, WS_ROWGATE);
    for (int idx = gw; idx < R * 256; idx += F.G * NWAVES) { const int t = idx >> 8, r = idx & 255; const int pm = 64 + (t >> 2), pn = t & 3;
        int e = 0;
#pragma unroll
        for (int q = 1; q < 8; ++q) if (pm >= tab[16 + q]) e = q;
        const int mt = pm - tab[16 + e]; const int row0 = tab[e] + 256 * mt; const int nr = tab[8 + e] - 256 * mt;
        if (r < nr) { const int tok = RTK[row0 + r] & 16383; const float gt = RGT[row0 + r];
            f32x4 a = {0.f, 0.f, 0.f, 0.f};
#pragma unroll
            for (int kp = 0; kp < 7; ++kp) a += *(const f32x4*)(part + ((size_t)(t * 7 + kp) * 256 + r) * 256 + 4 * lane);
            float* op = F.out + (size_t)tok * 1024 + 256 * pn + 4 * lane; f32x4 o = *(const f32x4*)op; o += a * gt; *(f32x4*)op = o; } }
}

constexpr int N_PHASES = 21;
__global__ void __launch_bounds__(NWAVES * 64, 2) mk_fwd(Args args) {
    extern __shared__ __attribute__((aligned(16))) unsigned char lds_raw[];
    Frame F; F.lds = (LAS unsigned char*)lds_raw; F.ws = args.ws; F.in = args.in; F.out = args.out;
    F.tid = threadIdx.x; F.lane = F.tid & 63; F.wave = __builtin_amdgcn_readfirstlane(F.tid >> 6);
    F.G = gridDim.x; { const int bx = blockIdx.x; F.vcu = (F.G % 8 == 0) ? (bx % 8) * (F.G / 8) + bx / 8 : bx; }
    volatile LAS unsigned* MISC = (volatile LAS unsigned*)(F.lds + MISC_OFF);
    if (F.tid < 64) MISC[F.tid] = 0u;
    __syncthreads();
    XcdBarrier bar; bar.bar = (unsigned*)(args.ws + WS_CTL) + CW_BAR; bar.x = 0; bar.st = nullptr;
    const int lo = args.ph_lo, hi = args.ph_hi;
    const bool multi = (hi - lo) > 1;
    if (multi) bar = xcd_barrier_post((unsigned*)(args.ws + WS_CTL) + CW_BAR, MISC + 8);
#ifdef PH_ONLY
#define IN(k) ((k) == PH_ONLY && lo <= (k) && (k) < hi)
#else
#define IN(k) (lo <= (k) && (k) < hi)
#endif
#define SEAM(k) do { if (IN(k) && IN((k) + 1)) xcd_barrier(bar); } while (0)
    unsigned char* ws = args.ws; const int cid = (int)blockIdx.x;
#define REFRESH() do { int t_ = threadIdx.x; asm volatile("" : "+v"(t_)); F.tid = t_; F.lane = t_ & 63; F.wave = __builtin_amdgcn_readfirstlane(t_ >> 6); unsigned long long w_ = (unsigned long long)args.ws; asm volatile("" : "+s"(w_)); F.ws = (unsigned char*)w_; ws = F.ws; } while (0)
    LAS unsigned char* ring = F.lds;

#ifndef MK_REP_MASK
#define MK_REP_MASK 0u
#endif
#define REPS(k) ((int)(((unsigned)(MK_REP_MASK) >> (k)) & 1u))
#define PHASE(k, ...) do { if (IN(k)) { for (int rep_ = 0; rep_ <= REPS(k); ++rep_) { if (rep_) xcd_barrier(bar); REFRESH(); __VA_ARGS__ } } SEAM(k); } while (0)
    PHASE(0, phase_prologue(F););
    PHASE(1, {
        pg8::DenseSched S; S.init(wsp<bf16_t>(ws, WS_XB), wsp<bf16_t>(ws, WS_WIN0), M_TOK, E_IN, 1024, F.G, cid);
        EpiScaleBf16 E{wsp<bf16_t>(ws, A_P0), E_IN, wsp<float>(ws, WS_SSQ0)};
        pg8::gemm_phase<EpiScaleBf16, pg8::DenseSched, false>(F.tid, ring, 1024, S, E, nullptr);
        if (F.G == 256 && cid >= 128 && rep_ == 0) { REFRESH(); conv_group(F, 1, (cid - 128) * NWAVES + F.wave, 128 * NWAVES); } });
    PHASE(2, phase_prep0(F););
    PHASE(3, {
        LowRankSched S; S.init(wsp<bf16_t>(ws, A_AP), wsp<bf16_t>(ws, WS_WLR), F.G, cid);
        EpiLowRank E{ws, F.in};
        pg8::gemm_phase<EpiLowRank, LowRankSched, false>(F.tid, ring, 256, S, E, nullptr); });
    PHASE(4, phase_cscan_attn_split(F););
    PHASE(5, phase_rwkv_post(F););
    PHASE(6, {
        pg8::DenseSched S; S.init(wsp<bf16_t>(ws, A_YCAT), wsp<bf16_t>(ws, WS_WOUT0), M_TOK, 1024, 1024, F.G, cid);
        EpiResidBf E{rep_ ? wsp<bf16_t>(ws, A_YF) : wsp<bf16_t>(ws, WS_XB), nullptr, rep_ ? wsp<float>(ws, WS_SSQ0) : wsp<float>(ws, WS_SSQ1)};
        pg8::gemm_phase<EpiResidBf, pg8::DenseSched, false>(F.tid, ring, 1024, S, E, nullptr); });
    PHASE(7, {
        pg8::DenseSched S; S.init(wsp<bf16_t>(ws, WS_XB), wsp<bf16_t>(ws, WS_WGU0), M_TOK, 2 * D_FF, 1024, F.G, cid);
        EpiSwiGLU E{wsp<bf16_t>(ws, A_HID0), D_FF, wsp<float>(ws, WS_SSQ1)};
        pg8::gemm_phase<EpiSwiGLU, pg8::DenseSched, false>(F.tid, ring, 1024, S, E, nullptr);
        if (F.G == 256 && cid >= 128 && rep_ == 0) { REFRESH(); conv_group(F, 2, (cid - 128) * NWAVES + F.wave, 128 * NWAVES); } });
    PHASE(8, {
        pg8::DenseSched S; S.init(wsp<bf16_t>(ws, A_HID0), wsp<bf16_t>(ws, WS_WD0), M_TOK, 1024, D_FF, F.G, cid);
        EpiResidBf E{rep_ ? wsp<bf16_t>(ws, A_YF) : wsp<bf16_t>(ws, WS_XB), nullptr, rep_ ? wsp<float>(ws, WS_SSQ0) : wsp<float>(ws, WS_SSQ2)};
        pg8::gemm_phase<EpiResidBf, pg8::DenseSched, false>(F.tid, ring, D_FF, S, E, nullptr); });
    PHASE(9, {
        pg8::DenseSched S; S.init(wsp<bf16_t>(ws, WS_XB), wsp<bf16_t>(ws, WS_WIN1), M_TOK, 3072, 1024, F.G, cid);
        EpiScaleBf16 E{wsp<bf16_t>(ws, A_P1), O_INP, wsp<float>(ws, WS_SSQ2)};
        pg8::gemm_phase<EpiScaleBf16, pg8::DenseSched, false>(F.tid, ring, 1024, S, E, nullptr);
        REFRESH(); phase_gd(F); });
    PHASE(10, phase_gla_prep(F););
    PHASE(11, phase_gla_main(F););
    PHASE(12, phase_gla_post(F););
    PHASE(13, {
        pg8::DenseSched S; S.init(wsp<bf16_t>(ws, A_GOUT), wsp<bf16_t>(ws, WS_WOUT1), M_TOK, 1024, 1024, F.G, cid);
        EpiResidBf E{rep_ ? wsp<bf16_t>(ws, A_VT1) : wsp<bf16_t>(ws, WS_XB), rep_ ? wsp<float>(ws, A_OF) : F.out, nullptr};
        pg8::gemm_phase<EpiResidBf, pg8::DenseSched, false>(F.tid, ring, 1024, S, E, nullptr); });
    PHASE(14, for (int q_ = 0; q_ <= (int)(((MK_REP_SUB) >> 2) & 1u); ++q_) { phase_route(F); __syncthreads(); REFRESH(); }
              for (int q_ = 0; q_ <= (int)(((MK_REP_SUB) >> 3) & 1u); ++q_) { phase_conv_experts(F); __syncthreads(); REFRESH(); });
    PHASE(15, phase_place(F););
    PHASE(16, {
        const int nmt = moe_table(F, 2);
        MoESched S; S.go.init(nmt, 2 * D_FFE / 256, F.G, cid); S.tab = (const LAS int*)(F.lds + MOE_OFF);
        S.A = (const char*)wsp<bf16_t>(ws, WS_XB); S.Bt = (const char*)wsp<bf16_t>(ws, A_WEGU); S.a_rowbytes = 0; S.b_expert_bytes = (size_t)2 * D_FFE * 1024 * 2; S.b_tile_bytes = (size_t)256 * 1024 * 2; S.gather = true; S.nt_ = 16;
        const int* rtk = wsp<int>(ws, WS_ROWTOK);
        EpiSwiGLUMoE E{wsp<bf16_t>(ws, A_HID1), wsp<float>(ws, WS_RSTD3), rtk};
        pg8::gemm_phase<EpiSwiGLUMoE, MoESched, true>(F.tid, ring, 1024, S, E, rtk); });
#pragma unroll 1
    for (int s = 0; s < 2; ++s) {
        PHASE(17 + s, {
            const int nmt = moe_table(F, s);
            MoEDownSched S; S.tab = (const LAS int*)(F.lds + MOE_OFF); S.A = (const char*)wsp<bf16_t>(ws, A_HID1); S.Bt = (const char*)wsp<bf16_t>(ws, A_WED); S.nmt = nmt; S.c = cid; S.round = 0;
            EpiMoEDown E{F.out, wsp<int>(ws, WS_ROWTOK), wsp<float>(ws, WS_ROWGATE)};
            pg8::gemm_phase<EpiMoEDown, MoEDownSched, false>(F.tid, ring, D_FFE, S, E, nullptr);
            REFRESH(); S.round = 1; EpiPart EP{wsp<float>(ws, s ? A_WEGU2 : A_WEGU)};
            pg8::gemm_phase<EpiPart, MoEDownSched, false>(F.tid, ring, D_FFE, S, EP, nullptr); });
    }
    PHASE(19, moe_tail_reduce(F, 0););
    PHASE(20, moe_tail_reduce(F, 1););
#undef PHASE
#undef REPS
#undef IN
#undef SEAM
}

extern "C" void kernel_launch(void* const* d_in, const int* in_sizes, int n_in, void* d_out, int out_size, void* d_ws, size_t ws_size, hipStream_t stream) {
    static int grid = 0;
    if (grid == 0) {
        if (n_in != 38 || out_size != M_TOK * D_MODEL || ws_size < WS_END) { fprintf(stderr, "kernel_launch: unexpected shapes: n_in %d out %d ws %zu (need %zu)\n", n_in, out_size, ws_size, (size_t)WS_END); grid = -1; return; }
        int dev = 0, cus = 0;
        if (hipGetDevice(&dev) != hipSuccess || hipDeviceGetAttribute(&cus, hipDeviceAttributeMultiprocessorCount, dev) != hipSuccess) { grid = -1; return; }
        if (hipFuncSetAttribute((const void*)mk_fwd, hipFuncAttributeMaxDynamicSharedMemorySize, LDS_BYTES) != hipSuccess) { fprintf(stderr, "kernel_launch: hipFuncSetAttribute failed\n"); grid = -1; return; }
        (void)hipGetLastError();
        grid = cus;
        if (grid != 256) fprintf(stderr, "kernel_launch: note: %d CUs (built for 256)\n", grid);
    }
    if (grid < 0) return;
    (void)hipMemsetAsync((char*)d_ws + WS_CTL, 0, CTL_ZERO_BYTES, stream);
    Args a{};
    for (int i = 0; i < 38; ++i) a.in[i] = (const float*)d_in[i];
    a.out = (float*)d_out; a.ws = (unsigned char*)d_ws;
#if MK_N_LAUNCHES == 1
    a.ph_lo = 0; a.ph_hi = N_PHASES - 1 + 0;
    a.ph_hi = 21;
    hipLaunchKernelGGL(mk_fwd, dim3(grid), dim3(NWAVES * 64), LDS_BYTES, stream, a);
#else
#ifndef MK_LAST_PHASE
#define MK_LAST_PHASE 20
#endif
    for (int p = 0; p < MK_LAST_PHASE; ++p) { a.ph_lo = p; a.ph_hi = p + 1; hipLaunchKernelGGL(mk_fwd, dim3(grid), dim3(NWAVES * 64), LDS_BYTES, stream, a); }
#endif
}
```

```cpp
#include <hip/hip_runtime.h>
#include <cstdio>
#include <cstdint>

#ifndef MK_N_LAUNCHES
#define MK_N_LAUNCHES 1
#define MK_REP_MASK 0u
#define MK_REP_SUB 0u
#ifndef MK_REP_SUB
#define MK_REP_SUB 0u
#endif
#endif

#define GAS __attribute__((address_space(1)))
#define LAS __attribute__((address_space(3)))
typedef unsigned short bf16_t;
typedef short bf16x8 __attribute__((ext_vector_type(8)));
typedef short bf16x4 __attribute__((ext_vector_type(4)));
typedef float f32x4 __attribute__((ext_vector_type(4)));
typedef float f32x2 __attribute__((ext_vector_type(2)));
typedef float f32x16 __attribute__((ext_vector_type(16)));
typedef unsigned u32x4 __attribute__((ext_vector_type(4)));
typedef unsigned u32x2 __attribute__((ext_vector_type(2)));
typedef __bf16 bf16x2_t __attribute__((ext_vector_type(2)));

constexpr int D_MODEL = 1024, BATCH = 8, SEQ = 2048, M_TOK = BATCH * SEQ;
constexpr int HD = 64;
constexpr int RW_HEADS = 8, RW_DIM = 512, RW_IN = 1792;
constexpr int ATT_HEADS = 8, ATT_KV = 2;
constexpr int E_IN = 2560;
constexpr int GLA_H = 4, GLA_DK = 512, GLA_DV = 1024, GLA_DKH = 128, GLA_DVH = 256, GLA_R = 16;
constexpr int O_IN = 3088, O_INP = 3328;
constexpr int D_FF = 2816, NEXP = 8, D_FFE = 3584;
constexpr float NORM_EPS = 1e-6f;

constexpr size_t MiB = 1u << 20;
constexpr size_t WS_CTL = 0, CTL_ZERO_BYTES = 1 * MiB;
constexpr size_t WS_SSQ0 = 1 * MiB, WS_SSQ1 = 2 * MiB, WS_SSQ2 = 3 * MiB;
constexpr size_t WS_RSTD3 = 4 * MiB;
constexpr size_t WS_TOKE = WS_RSTD3 + 65536;
constexpr size_t WS_TOKG = WS_TOKE + 131072;
constexpr size_t WS_CNT = WS_TOKG + 131072;
constexpr size_t WS_TOT = WS_CNT + 16384;
constexpr size_t WS_ROWTOK = WS_TOT + 256;
constexpr int ROWS_PER_SLOT = M_TOK + 256;
constexpr size_t WS_ROWGATE = WS_ROWTOK + (size_t)2 * ROWS_PER_SLOT * 4;
constexpr size_t WS_DECS = 6 * MiB;
constexpr size_t WS_ROPE = 7 * MiB;
constexpr size_t WS_XB = 8 * MiB;
constexpr size_t WS_WIN0 = 40 * MiB, WS_WLR = 45 * MiB, WS_WOUT0 = 47 * MiB, WS_WGU0 = 49 * MiB, WS_WD0 = 60 * MiB, WS_WIN1 = 66 * MiB, WS_WOUT1 = 73 * MiB;
constexpr size_t AR = 75 * MiB;
constexpr size_t A_P0 = AR + 0, A_RS = AR + 80 * MiB, A_KS = AR + 96 * MiB, A_VS = AR + 112 * MiB, A_NKK = AR + 128 * MiB, A_AP = AR + 144 * MiB;
constexpr size_t A_QH = AR + 152 * MiB, A_KH = AR + 168 * MiB, A_VT0 = AR + 172 * MiB;
constexpr size_t A_LWF = AR + 176 * MiB, A_LWB = AR + 192 * MiB, A_SGF = AR + 208 * MiB, A_SGB = AR + 224 * MiB;
constexpr size_t A_GG = AR + 272 * MiB, A_YF = AR + 0 * MiB, A_YB = AR + 16 * MiB, A_YCAT = AR + 32 * MiB;
constexpr size_t A_HID0 = AR + 0;
constexpr size_t A_P1 = AR + 0;
constexpr size_t A_QHAT = AR + 104 * MiB, A_K2T = AR + 120 * MiB;
constexpr size_t GLA_DIR_STRIDE = 32 * MiB;
constexpr size_t A_VT1 = AR + 168 * MiB, A_OF = AR + 200 * MiB, A_OB = AR + 232 * MiB, A_GOUT = AR + 104 * MiB;
constexpr size_t A_WEGU = 40 * MiB, A_HID1 = 96 * MiB, A_WEGU2 = 339 * MiB, A_WED = 395 * MiB;
constexpr int EGU_EARLY = 4;
constexpr size_t WEGU_HI_SHIFT = A_WEGU2 - (A_WEGU + (size_t)EGU_EARLY * 14 * MiB);
constexpr int ROWS_ALL = 2 * M_TOK + 256;
constexpr size_t WS_END = 451 * MiB;
static_assert(A_WEGU + (size_t)EGU_EARLY * 14 * MiB <= A_HID1 && A_HID1 + (size_t)ROWS_ALL * D_FFE * 2 <= A_WEGU2 && A_WEGU2 >= AR + 264 * MiB && A_WEGU2 + (size_t)(NEXP - EGU_EARLY) * 14 * MiB <= A_WED && A_WED + (size_t)NEXP * 1024 * D_FFE * 2 <= WS_END && 2 * ROWS_PER_SLOT >= ROWS_ALL, "ws map");
static_assert(A_GOUT + 32 * MiB <= A_VT1 && A_YCAT + 32 * MiB <= A_RS, "ws map");

constexpr int CW_BAR = 4096;

constexpr int RING_BYTES = 131072;
constexpr int LDS_BYTES = 147456;
constexpr int MISC_OFF = LDS_BYTES - 512;
constexpr int MOE_OFF = LDS_BYTES - 256;

__device__ __forceinline__ unsigned pk2(float lo, float hi) { f32x2 v = {lo, hi}; bf16x2_t b = __builtin_convertvector(v, bf16x2_t); return __builtin_bit_cast(unsigned, b); }
__device__ __forceinline__ bf16_t f2bf(float f) { return (bf16_t)(pk2(f, 0.f) & 0xffffu); }
__device__ __forceinline__ float bf2f(bf16_t h) { return __uint_as_float(((unsigned)h) << 16); }
__device__ __forceinline__ float bflo(unsigned w) { return __uint_as_float(w << 16); }
__device__ __forceinline__ float bfhi(unsigned w) { return __uint_as_float(w & 0xffff0000u); }
__device__ __forceinline__ float wave_sum(float v) {
#pragma unroll
    for (int o = 1; o < 64; o <<= 1) v += __shfl_xor(v, o);
    return v;
}
__device__ __forceinline__ float sigmoidf_(float x) { return 1.f / (1.f + __expf(-x)); }
__device__ __forceinline__ float siluf_(float x) { return x / (1.f + __expf(-x)); }
#define LDS_WAIT() asm volatile("s_waitcnt lgkmcnt(0)" ::: "memory")
#define VM_WAIT() asm volatile("s_waitcnt vmcnt(0)" ::: "memory")

#define XB_TMO      128
#define XB_XCNT(j)  (256  + 64 * (j))
#define XB_XSUB(j)  (1280 + 64 * (j))
#define XB_XGEN(j)  (2304 + 64 * (j))
#define XB_TOP      3328
#define XB_TOPGEN   3392
#define XCD_BAR_WORDS 3456
#define XB_SPIN_CAP (1u << 20)
__device__ __forceinline__ unsigned xb_ld(unsigned* p)              { return __hip_atomic_load(p, __ATOMIC_RELAXED, __HIP_MEMORY_SCOPE_AGENT); }
__device__ __forceinline__ unsigned xb_add(unsigned* p, unsigned v) { return __hip_atomic_fetch_add(p, v, __ATOMIC_RELAXED, __HIP_MEMORY_SCOPE_AGENT); }
__device__ __forceinline__ unsigned xb_xcc_id() { return (unsigned)__builtin_amdgcn_s_getreg((3 << 11) | 20) & 0xFu; }
#define XB_SPIN(cond, bar) do { unsigned _sp = 0; while (cond) { __builtin_amdgcn_s_sleep(1); \
    if ((++_sp & 255u) == 0u) { if (xb_ld(&(bar)[XB_TMO])) break; if (_sp > XB_SPIN_CAP) { atomicAdd(&(bar)[XB_TMO], 1u); break; } } } } while (0)
struct XcdBarrier { unsigned* bar; unsigned x; volatile LAS unsigned* st; };
__device__ __forceinline__ XcdBarrier xcd_barrier_post(unsigned* bar, volatile LAS unsigned* st) {
    XcdBarrier b; b.bar = bar; b.x = xb_xcc_id(); b.st = st;
    if (threadIdx.x == 0) (void)xb_add(&bar[XB_XCNT(b.x)], 1u);
    return b;
}
__device__ __forceinline__ void xcd_barrier_complete(unsigned* bar, unsigned x, unsigned& nloc, unsigned& nx) {
    const unsigned G = gridDim.x * gridDim.y * gridDim.z;
    unsigned sum, cnt, mine, sp = 0u;
    for (;;) {
        sum = 0u; cnt = 0u; mine = 0u;
#pragma unroll
        for (unsigned j = 0; j < 16; ++j) { const unsigned c = xb_ld(&bar[XB_XCNT(j)]); sum += c; cnt += (c > 0u) ? 1u : 0u; mine = (j == x) ? c : mine; }
        if (sum == G) break;
        __builtin_amdgcn_s_sleep(1);
        if ((++sp & 255u) == 0u) { if (xb_ld(&bar[XB_TMO])) break; if (sp > XB_SPIN_CAP) { atomicAdd(&bar[XB_TMO], 1u); break; } }
    }
    nloc = mine > 0u ? mine : 1u; nx = cnt > 0u ? cnt : 1u;
}
__device__ __forceinline__ void xcd_barrier(const XcdBarrier& b) {
    asm volatile("s_waitcnt vmcnt(0)" ::: "memory");
    __syncthreads();
    if (threadIdx.x == 0) {
        unsigned* bar = b.bar;
        __builtin_amdgcn_s_waitcnt(0);
        unsigned nloc = b.st[0], nx = b.st[1];
        if (nloc == 0u) { xcd_barrier_complete(bar, b.x, nloc, nx); b.st[0] = nloc; b.st[1] = nx; }
        const unsigned old = xb_add(&bar[XB_XSUB(b.x)], 1u);
        const unsigned gen = old / nloc;
        if (old + 1u == (gen + 1u) * nloc) {
            __builtin_amdgcn_fence(__ATOMIC_RELEASE, "agent");
            asm volatile("s_waitcnt vmcnt(0)" ::: "memory");
            const unsigned og = xb_add(&bar[XB_TOP], 1u);
            const unsigned tg = og / nx;
            if (og + 1u == (tg + 1u) * nx) xb_add(&bar[XB_TOPGEN], 1u);
            else XB_SPIN(xb_ld(&bar[XB_TOPGEN]) == tg, bar);
            __builtin_amdgcn_fence(__ATOMIC_ACQUIRE, "agent");
            xb_add(&bar[XB_XGEN(b.x)], 1u);
            asm volatile("s_waitcnt vmcnt(0)" ::: "memory");
        } else {
            XB_SPIN(xb_ld(&bar[XB_XGEN(b.x)]) == gen, bar);
            __builtin_amdgcn_fence(__ATOMIC_ACQUIRE, "agent");
            asm volatile("s_waitcnt vmcnt(0)" ::: "memory");
        }
    }
    __syncthreads();
}

namespace pg8 {
constexpr int BM = 256, BK = 64, HALF = 128, HTB = HALF * BK * 2, STAGE_BYTES = 8 * HTB, NXCD = 8, WGM = 4;
__host__ __device__ __forceinline__ int lds_byte(int r, int c) { const int st = (r >> 4) * 2 + (c >> 5), rr = r & 15, cc = c & 31, ob = rr * 64 + cc * 2; return st * 1024 + (ob ^ (((ob >> 9) & 1) << 5)); }
__host__ __device__ __forceinline__ void stage_rc(int b, int& R, int& C) { const int st = b / 1024, sb = b % 1024, swz = sb ^ (((sb >> 9) & 1) << 5); R = (st >> 1) * 16 + swz / 64; C = (st & 1) * 32 + (swz % 64) / 2; }
__host__ __device__ __forceinline__ int perm32(int rho) { const int n = rho >> 4, i = rho & 15; return 8 * (i >> 2) + 4 * n + (i & 3); }

struct Unit { const char* a; const char* b; int pm, pn; int row0, nrows, e; int nt, flags; };

struct GridOrder {
    int nM, nN, nwg, G, c;
    __device__ void init(int nM_, int nN_, int G_, int c_) { nM = nM_; nN = nN_; nwg = nM * nN; G = G_; c = c_; }
    __device__ bool tile(int i, int& pm, int& pn) const {
        const long L = (long)i * G + c; if (L >= nwg) return false;
        int wgid = (int)L; { const int q = nwg / NXCD, r = nwg % NXCD, xcd = wgid % NXCD, off = wgid / NXCD; wgid = (xcd < r ? xcd * (q + 1) : r * (q + 1) + (xcd - r) * q) + off; }
        const int nig = WGM * nN, gid = wgid / nig, fm = gid * WGM, gsz = (nM - fm) < WGM ? (nM - fm) : WGM;
        pm = fm + ((wgid % nig) % gsz); pn = (wgid % nig) / gsz; return true;
    }
};
struct DenseSched {
    GridOrder go; const char* A; const char* Bt; size_t tstep; int nt_;
    __device__ void init(const bf16_t* A_, const bf16_t* Bt_, int M, int N, int K, int G, int c) { go.init(M / BM, N / BM, G, c); A = (const char*)A_; Bt = (const char*)Bt_; tstep = (size_t)BM * K * 2; nt_ = K / BK; }
    __device__ bool next(int i, Unit& u) const { int pm, pn; if (!go.tile(i, pm, pn)) return false; u.pm = pm; u.pn = pn; u.a = A + (size_t)pm * tstep; u.b = Bt + (size_t)pn * tstep; u.row0 = pm * BM; u.nrows = BM; u.e = 0; u.nt = nt_; u.flags = 0; return true; }
};

template <class Epi, class Sched, bool GATHER>
__device__ __forceinline__ void gemm_phase(const int tid, LAS unsigned char* lds, const int K_, const Sched& S, const Epi& E, const int* gather_rows) {
    int K = K_; asm volatile("" : "+s"(K));
    const int wid = __builtin_amdgcn_readfirstlane(tid >> 6), lane = tid & 63, wr = wid >> 2, wc = wid & 3, fr = lane & 15, fq = lane >> 4;
    int sR[2], sC[2];
    unsigned voffB[2];
#pragma unroll
    for (int i = 0; i < 2; ++i) { int R, C; stage_rc(tid * 16 + i * 8192, R, C); sR[i] = R; sC[i] = C; const int Rb = Epi::PERM ? ((R & ~31) + perm32(R & 31)) : R; voffB[i] = (unsigned)(Rb * K + C) * 2u; }
    const size_t kstep = (size_t)(BK * 2);
    const size_t hstep = (size_t)HALF * K * 2;
    const unsigned ldsw = (unsigned)wid * 1024u;
    const int aoff = lds_byte(wr * 64 + fr, fq * 8), boff = lds_byte(wc * 32 + fr, fq * 8);
    unsigned cva[2][2], nva[2][2];
#define PG8_SETVA(va, u) do { _Pragma("unroll") for (int h_ = 0; h_ < 2; ++h_) _Pragma("unroll") for (int i_ = 0; i_ < 2; ++i_) { \
        if (GATHER) { int rr_ = (u).row0 + h_ * HALF + sR[i_]; const int rmax_ = (u).row0 + (u).nrows - 1; rr_ = rr_ > rmax_ ? rmax_ : rr_; int tk_ = gather_rows[rr_]; tk_ = tk_ < 0 ? 0 : (tk_ > 16383 ? 16383 : tk_); va[h_][i_] = (unsigned)(tk_ * K + sC[i_]) * 2u; } \
        else va[h_][i_] = (unsigned)((h_ * HALF + sR[i_]) * K + sC[i_]) * 2u; } } while (0)
#define PG8_SA(b, h) (((b) * 2 + (h)) * HTB)
#define PG8_SB(b, h) ((4 + (b) * 2 + (h)) * HTB)
#define PG8_STAGE2(bufoff, gbase, v0, v1) do { \
        __builtin_amdgcn_global_load_lds((const unsigned*)((const char*)(gbase) + (v0)), (LAS unsigned*)(lds + (bufoff) + ldsw), 16, 0, 0); \
        __builtin_amdgcn_global_load_lds((const unsigned*)((const char*)(gbase) + (v1)), (LAS unsigned*)(lds + (bufoff) + ldsw + 8192), 16, 0, 0); } while (0)
#define PG8_STAGEB(bufoff, gbase) PG8_STAGE2(bufoff, gbase, voffB[0], voffB[1])
#define PG8_STAGEA(bufoff, gbase, va, h) PG8_STAGE2(bufoff, gbase, va[h][0], va[h][1])
#define PG8_LDA(dst, b, h) do { _Pragma("unroll") for (int m = 0; m < 4; ++m) _Pragma("unroll") for (int k = 0; k < 2; ++k) dst[m][k] = *(const LAS bf16x8*)(lds + PG8_SA(b, h) + aoff + m * 2048 + k * 1024); } while (0)
#define PG8_LDB(dst, b, h) do { _Pragma("unroll") for (int n = 0; n < 2; ++n) _Pragma("unroll") for (int k = 0; k < 2; ++k) dst[n][k] = *(const LAS bf16x8*)(lds + PG8_SB(b, h) + boff + n * 2048 + k * 1024); } while (0)
#define PG8_MMA(ai, bj, At, Bt) do { __builtin_amdgcn_s_setprio(1); _Pragma("unroll") for (int m = 0; m < 4; ++m) _Pragma("unroll") for (int n = 0; n < 2; ++n) _Pragma("unroll") for (int k = 0; k < 2; ++k) \
        acc[ai][bj][m][n] = __builtin_amdgcn_mfma_f32_16x16x32_bf16(Bt[n][k], At[m][k], acc[ai][bj][m][n], 0, 0, 0); __builtin_amdgcn_s_setprio(0); } while (0)
#define PG8_WAIT_V(n) asm volatile("s_waitcnt vmcnt(" #n ")" ::: "memory")
#define PG8_WAIT_L(n) asm volatile("s_waitcnt lgkmcnt(" #n ")" ::: "memory")
#define PG8_BAR __builtin_amdgcn_s_barrier()
#define PG8_SCHED __builtin_amdgcn_sched_barrier(0)
    Unit cur, nxt; int ui = 0;
    if (!S.next(0, cur)) return;
    PG8_SETVA(cva, cur);
    f32x4 acc[2][2][4][2];
#pragma unroll
    for (int a = 0; a < 2; ++a)
#pragma unroll
        for (int b = 0; b < 2; ++b)
#pragma unroll
            for (int m = 0; m < 4; ++m)
#pragma unroll
                for (int n = 0; n < 2; ++n) acc[a][b][m][n] = (f32x4){0.f, 0.f, 0.f, 0.f};
    bf16x8 At[4][2], B0[2][2], B1[2][2];
    const char* cA = cur.a; const char* cB = cur.b;
    PG8_STAGEB(PG8_SB(0, 0), cB); PG8_STAGEB(PG8_SB(0, 1), cB + hstep); PG8_STAGEA(PG8_SA(0, 0), cA, cva, 0); PG8_STAGEA(PG8_SA(0, 1), cA, cva, 1);
    if (wr == 1) PG8_BAR;
    PG8_WAIT_V(2); PG8_BAR;
    PG8_STAGEB(PG8_SB(1, 0), cB + kstep); PG8_STAGEA(PG8_SA(1, 0), cA + kstep, cva, 0); PG8_STAGEB(PG8_SB(1, 1), cB + hstep + kstep);
    PG8_WAIT_V(6); PG8_BAR;
    for (;;) {
        const bool has_next = S.next(ui + 1, nxt);
        if (has_next) PG8_SETVA(nva, nxt);
        else {
#pragma unroll
            for (int h = 0; h < 2; ++h)
#pragma unroll
                for (int i = 0; i < 2; ++i) nva[h][i] = cva[h][i];
        }
        const char* nA = has_next ? nxt.a : cA; const char* nB = has_next ? nxt.b : cB;
        const int nt = cur.nt;
        for (int t = 0; t < nt; t += 2) {
            const bool last = (t == nt - 2);
            const char* a1 = cA + (size_t)(t + 1) * kstep;
            const char* a2 = last ? nA : cA + (size_t)(t + 2) * kstep; const char* b2 = last ? nB : cB + (size_t)(t + 2) * kstep;
            const char* a3 = a2 + kstep; const char* b3 = b2 + kstep;
            unsigned va2[2][2];
#pragma unroll
            for (int h = 0; h < 2; ++h)
#pragma unroll
                for (int i = 0; i < 2; ++i) va2[h][i] = (GATHER && last) ? nva[h][i] : cva[h][i];
            PG8_LDB(B0, 0, 0); PG8_LDB(B1, 0, 1); PG8_SCHED; PG8_LDA(At, 0, 0); PG8_STAGEA(PG8_SA(1, 1), a1, cva, 1);
            PG8_WAIT_V(8); PG8_WAIT_L(0); PG8_BAR; PG8_MMA(0, 0, At, B0); PG8_MMA(0, 1, At, B1); PG8_BAR; PG8_SCHED;
            PG8_LDA(At, 0, 1); PG8_STAGEB(PG8_SB(0, 0), b2); PG8_STAGEB(PG8_SB(0, 1), b2 + hstep); PG8_STAGEA(PG8_SA(0, 0), a2, va2, 0);
            PG8_WAIT_V(8); PG8_WAIT_L(0); PG8_BAR; PG8_MMA(1, 0, At, B0); PG8_MMA(1, 1, At, B1); PG8_BAR; PG8_SCHED;
            PG8_LDB(B0, 1, 0); PG8_LDB(B1, 1, 1); PG8_SCHED; PG8_LDA(At, 1, 0); PG8_STAGEA(PG8_SA(0, 1), a2, va2, 1);
            PG8_WAIT_V(8); PG8_WAIT_L(0); PG8_BAR; PG8_MMA(0, 0, At, B0); PG8_MMA(0, 1, At, B1); PG8_BAR; PG8_SCHED;
            PG8_LDA(At, 1, 1); PG8_STAGEB(PG8_SB(1, 0), b3); PG8_STAGEB(PG8_SB(1, 1), b3 + hstep); PG8_STAGEA(PG8_SA(1, 0), a3, va2, 0);
            PG8_WAIT_V(8); PG8_WAIT_L(0); PG8_BAR; PG8_MMA(1, 0, At, B0); PG8_MMA(1, 1, At, B1); PG8_BAR; PG8_SCHED;
        }
        if (wr == 0) PG8_BAR;
        E(acc, cur, wr, wc, fr, fq);
#if ((MK_REP_SUB) >> 5) & 1
        if constexpr (Epi::PURE) { asm volatile("" ::: "memory"); E(acc, cur, wr, wc, fr, fq); }
#endif
        if (!has_next) break;
#pragma unroll
        for (int a = 0; a < 2; ++a)
#pragma unroll
            for (int b = 0; b < 2; ++b)
#pragma unroll
                for (int m = 0; m < 4; ++m)
#pragma unroll
                    for (int n = 0; n < 2; ++n) acc[a][b][m][n] = (f32x4){0.f, 0.f, 0.f, 0.f};
        cur = nxt; cA = nA; cB = nB; ++ui;
#pragma unroll
        for (int h = 0; h < 2; ++h)
#pragma unroll
            for (int i = 0; i < 2; ++i) cva[h][i] = nva[h][i];
        if (wr == 1) PG8_BAR;
    }
    PG8_WAIT_V(0);
    PG8_BAR;
#undef PG8_SETVA
#undef PG8_SA
#undef PG8_SB
#undef PG8_STAGE2
#undef PG8_STAGEA
#undef PG8_STAGEB
#undef PG8_LDA
#undef PG8_LDB
#undef PG8_MMA
#undef PG8_WAIT_V
#undef PG8_WAIT_L
#undef PG8_BAR
#undef PG8_SCHED
}
}

__device__ __forceinline__ float rstd_from_ssq(const float* ssq, int row) {
    const f32x4* p = (const f32x4*)(ssq + (size_t)row * 16);
    const f32x4 a = p[0], b = p[1], c = p[2], d = p[3];
    const float s = (((a.x + a.y) + (a.z + a.w)) + ((b.x + b.y) + (b.z + b.w))) + (((c.x + c.y) + (c.z + c.w)) + ((d.x + d.y) + (d.z + d.w)));
    return 1.0f / sqrtf(s * (1.f / 1024.f) + NORM_EPS);
}
__device__ __forceinline__ u32x4 pack8(const f32x4 v0, const f32x4 v1) { u32x4 w; w.x = pk2(v0[0], v0[1]); w.y = pk2(v0[2], v0[3]); w.z = pk2(v1[0], v1[1]); w.w = pk2(v1[2], v1[3]); return w; }
__device__ __forceinline__ void unpack8(const u32x4 w, float (&f)[8]) { f[0] = bflo(w.x); f[1] = bfhi(w.x); f[2] = bflo(w.y); f[3] = bfhi(w.y); f[4] = bflo(w.z); f[5] = bfhi(w.z); f[6] = bflo(w.w); f[7] = bfhi(w.w); }
__device__ __forceinline__ u32x4 pack8f(const float (&f)[8]) { u32x4 w; w.x = pk2(f[0], f[1]); w.y = pk2(f[2], f[3]); w.z = pk2(f[4], f[5]); w.w = pk2(f[6], f[7]); return w; }

struct EpiScaleBf16 {
    static constexpr bool PERM = true; static constexpr bool PURE = true;
    bf16_t* O; int ldc; const float* ssq;
    __device__ __forceinline__ void operator()(const f32x4 (&acc)[2][2][4][2], const pg8::Unit& u, int wr, int wc, int fr, int fq) const {
        const int row0 = u.pm * 256 + wr * 64 + fr, col0 = u.pn * 256 + wc * 32 + 8 * fq;
#pragma unroll
        for (int ai = 0; ai < 2; ++ai)
#pragma unroll
            for (int m = 0; m < 4; ++m) { const int row = row0 + ai * 128 + m * 16; const float rs = rstd_from_ssq(ssq, row); bf16_t* rowp = O + (size_t)row * ldc + col0;
#pragma unroll
                for (int bj = 0; bj < 2; ++bj) *(u32x4*)(rowp + bj * 128) = pack8(acc[ai][bj][m][0] * rs, acc[ai][bj][m][1] * rs); }
    }
};
struct EpiResid {
    static constexpr bool PERM = true; static constexpr bool PURE = false;
    const float* base; float* out; bf16_t* xb; float* ssq;
    __device__ __forceinline__ void operator()(const f32x4 (&acc)[2][2][4][2], const pg8::Unit& u, int wr, int wc, int fr, int fq) const {
        const int row0 = u.pm * 256 + wr * 64 + fr, col0 = u.pn * 256 + wc * 32 + 8 * fq;
#pragma unroll
        for (int ai = 0; ai < 2; ++ai)
#pragma unroll
            for (int m = 0; m < 4; ++m) { const int row = row0 + ai * 128 + m * 16; const size_t off = (size_t)row * 1024 + col0; float ss = 0.f;
#pragma unroll
                for (int bj = 0; bj < 2; ++bj) { const f32x4 b0 = *(const f32x4*)(base + off + bj * 128), b1 = *(const f32x4*)(base + off + bj * 128 + 4);
                    const f32x4 o0 = b0 + acc[ai][bj][m][0], o1 = b1 + acc[ai][bj][m][1];
                    *(f32x4*)(out + off + bj * 128) = o0; *(f32x4*)(out + off + bj * 128 + 4) = o1;
                    ss += (o0[0] * o0[0] + o0[1] * o0[1]) + (o0[2] * o0[2] + o0[3] * o0[3]) + (o1[0] * o1[0] + o1[1] * o1[1]) + (o1[2] * o1[2] + o1[3] * o1[3]);
                    *(u32x4*)(xb + off + bj * 128) = pack8(o0, o1); }
                ss += __shfl_xor(ss, 16); ss += __shfl_xor(ss, 32);
                if (ssq && fq == 0) ssq[(size_t)row * 16 + u.pn * 4 + wc] = ss; }
    }
};
struct EpiResidBf {
    static constexpr bool PERM = true; static constexpr bool PURE = false;
    bf16_t* xb; float* out; float* ssq;
    __device__ __forceinline__ void operator()(const f32x4 (&acc)[2][2][4][2], const pg8::Unit& u, int wr, int wc, int fr, int fq) const {
        const int row0 = u.pm * 256 + wr * 64 + fr, col0 = u.pn * 256 + wc * 32 + 8 * fq;
#pragma unroll
        for (int ai = 0; ai < 2; ++ai)
#pragma unroll
            for (int m = 0; m < 4; ++m) { const int row = row0 + ai * 128 + m * 16; const size_t off = (size_t)row * 1024 + col0; float ss = 0.f;
#pragma unroll
                for (int bj = 0; bj < 2; ++bj) { const u32x4 bw = *(const u32x4*)(xb + off + bj * 128);
                    const f32x4 b0 = {bflo(bw.x), bfhi(bw.x), bflo(bw.y), bfhi(bw.y)}, b1 = {bflo(bw.z), bfhi(bw.z), bflo(bw.w), bfhi(bw.w)};
                    const f32x4 o0 = b0 + acc[ai][bj][m][0], o1 = b1 + acc[ai][bj][m][1];
                    if (out) { *(f32x4*)(out + off + bj * 128) = o0; *(f32x4*)(out + off + bj * 128 + 4) = o1; }
                    ss += (o0[0] * o0[0] + o0[1] * o0[1]) + (o0[2] * o0[2] + o0[3] * o0[3]) + (o1[0] * o1[0] + o1[1] * o1[1]) + (o1[2] * o1[2] + o1[3] * o1[3]);
                    *(u32x4*)(xb + off + bj * 128) = pack8(o0, o1); }
                ss += __shfl_xor(ss, 16); ss += __shfl_xor(ss, 32);
                if (ssq && fq == 0) ssq[(size_t)row * 16 + u.pn * 4 + wc] = ss; }
    }
};
struct EpiSwiGLU {
    static constexpr bool PERM = true; static constexpr bool PURE = true;
    bf16_t* H; int ldh; const float* ssq;
    __device__ __forceinline__ void operator()(const f32x4 (&acc)[2][2][4][2], const pg8::Unit& u, int wr, int wc, int fr, int fq) const {
        const int row0 = u.pm * 256 + wr * 64 + fr, hcol0 = u.pn * 128 + wc * 32 + 8 * fq;
#pragma unroll
        for (int ai = 0; ai < 2; ++ai)
#pragma unroll
            for (int m = 0; m < 4; ++m) { const int row = row0 + ai * 128 + m * 16; const float rs = rstd_from_ssq(ssq, row);
                f32x4 h[2];
#pragma unroll
                for (int n = 0; n < 2; ++n) { const f32x4 g = acc[ai][0][m][n] * rs, up = acc[ai][1][m][n] * rs;
#pragma unroll
                    for (int i = 0; i < 4; ++i) h[n][i] = siluf_(g[i]) * up[i]; }
                *(u32x4*)(H + (size_t)row * ldh + hcol0) = pack8(h[0], h[1]); }
    }
};
struct EpiSwiGLUMoE {
    static constexpr bool PERM = true; static constexpr bool PURE = true;
    bf16_t* H; const float* rstd3; const int* row_tok;
    __device__ __forceinline__ void operator()(const f32x4 (&acc)[2][2][4][2], const pg8::Unit& u, int wr, int wc, int fr, int fq) const {
        const int hcol0 = u.pn * 128 + wc * 32 + 8 * fq;
#pragma unroll
        for (int ai = 0; ai < 2; ++ai)
#pragma unroll
            for (int m = 0; m < 4; ++m) { const int rl = ai * 128 + wr * 64 + m * 16 + fr;
                if (rl < u.nrows) { const int grow = u.row0 + rl; const float rs = rstd3[row_tok[grow] & 16383];
                    f32x4 h[2];
#pragma unroll
                    for (int n = 0; n < 2; ++n) { const f32x4 g = acc[ai][0][m][n] * rs, up = acc[ai][1][m][n] * rs;
#pragma unroll
                        for (int i = 0; i < 4; ++i) h[n][i] = siluf_(g[i]) * up[i]; }
                    *(u32x4*)(H + (size_t)grow * D_FFE + hcol0) = pack8(h[0], h[1]); } }
    }
};
struct EpiMoEDown {
    static constexpr bool PERM = true; static constexpr bool PURE = false;
    float* out; const int* row_tok; const float* row_gate; const bf16_t* xb;
    __device__ __forceinline__ void operator()(const f32x4 (&acc)[2][2][4][2], const pg8::Unit& u, int wr, int wc, int fr, int fq) const {
        const int col0 = u.pn * 256 + wc * 32 + 8 * fq;
        if (xb) {
#pragma unroll
            for (int ai = 0; ai < 2; ++ai)
#pragma unroll
                for (int m = 0; m < 4; ++m) { const int rl = ai * 128 + wr * 64 + m * 16 + fr;
                    if (rl < u.nrows) { const int grow = u.row0 + rl; const int tok = row_tok[grow] & 16383; const float gt = row_gate[grow]; const size_t o = (size_t)tok * 1024 + col0;
#pragma unroll
                        for (int bj = 0; bj < 2; ++bj) { const u32x4 bw = *(const u32x4*)(xb + o + bj * 128);
                            f32x4 b0 = {bflo(bw.x), bfhi(bw.x), bflo(bw.y), bfhi(bw.y)}, b1 = {bflo(bw.z), bfhi(bw.z), bflo(bw.w), bfhi(bw.w)};
                            b0 += acc[ai][bj][m][0] * gt; b1 += acc[ai][bj][m][1] * gt; *(f32x4*)(out + o + bj * 128) = b0; *(f32x4*)(out + o + bj * 128 + 4) = b1; } } }
        } else {
#pragma unroll
            for (int ai = 0; ai < 2; ++ai)
#pragma unroll
                for (int m = 0; m < 4; ++m) { const int rl = ai * 128 + wr * 64 + m * 16 + fr;
                    if (rl < u.nrows) { const int grow = u.row0 + rl; const int tok = row_tok[grow] & 16383; const float gt = row_gate[grow]; float* op = out + (size_t)tok * 1024 + col0;
#pragma unroll
                        for (int bj = 0; bj < 2; ++bj) { f32x4 b0 = *(const f32x4*)(op + bj * 128), b1 = *(const f32x4*)(op + bj * 128 + 4);
                            b0 += acc[ai][bj][m][0] * gt; b1 += acc[ai][bj][m][1] * gt; *(f32x4*)(op + bj * 128) = b0; *(f32x4*)(op + bj * 128 + 4) = b1; } } }
        }
    }
};
struct EpiPart {
    static constexpr bool PERM = true; static constexpr bool PURE = true;
    float* part;
    __device__ __forceinline__ void operator()(const f32x4 (&acc)[2][2][4][2], const pg8::Unit& u, int wr, int wc, int fr, int fq) const {
        float* pb = part + (size_t)(u.flags - 1) * 65536; const unsigned o0 = (unsigned)((wr * 64 + fr) * 256 + wc * 32 + 8 * fq);
#pragma unroll
        for (int ai = 0; ai < 2; ++ai)
#pragma unroll
            for (int m = 0; m < 4; ++m)
#pragma unroll
                for (int bj = 0; bj < 2; ++bj) { float* pp = pb + o0 + (ai * 128 + m * 16) * 256 + bj * 128; *(f32x4*)pp = acc[ai][bj][m][0]; *(f32x4*)(pp + 4) = acc[ai][bj][m][1]; }
    }
};
struct LowRankSched {
    pg8::GridOrder go; const char* A; const char* Bt;
    __device__ void init(const bf16_t* A_, const bf16_t* Bt_, int G, int c) { go.init(M_TOK / 256, 8, G, c); A = (const char*)A_; Bt = (const char*)Bt_; }
    __device__ bool next(int i, pg8::Unit& u) const { int pm, pn; if (!go.tile(i, pm, pn)) return false; u.pm = pm; u.pn = pn; u.a = A + (size_t)pm * (256 * 256 * 2); u.b = Bt + (size_t)pn * (256 * 256 * 2);
        u.row0 = pm * 256; u.nrows = 256; u.e = 0; int two = 2; asm volatile("" : "+s"(two)); u.nt = two; u.flags = 0; return true; }
};
struct EpiLowRank {
    static constexpr bool PERM = true; static constexpr bool PURE = true;
    unsigned char* ws; const float* const* in;
    __device__ __forceinline__ void operator()(const f32x4 (&acc)[2][2][4][2], const pg8::Unit& u, int wr, int wc, int fr, int fq) const {
        const int kind = u.pn >> 1; const int row0 = u.pm * 256 + wr * 64 + fr; const int c0 = (u.pn & 1) * 256 + wc * 32 + 8 * fq;
        const float* zp = in[kind == 0 ? 4 : kind == 1 ? 6 : kind == 2 ? 8 : 10];
        bf16_t* o1 = (bf16_t*)(ws + (kind == 0 ? A_LWF : kind == 1 ? A_LWB : kind == 2 ? A_SGF : A_SGB));
        const float sc = kind < 2 ? -0.87506126f : 1.f;
#pragma unroll
        for (int bj = 0; bj < 2; ++bj) { const int c = c0 + bj * 128;
            const f32x4 z0 = *(const f32x4*)(zp + c), z1 = *(const f32x4*)(zp + c + 4);
#pragma unroll
            for (int ai = 0; ai < 2; ++ai)
#pragma unroll
                for (int m = 0; m < 4; ++m) { const int row = row0 + ai * 128 + m * 16; f32x4 v0 = acc[ai][bj][m][0] + z0, v1 = acc[ai][bj][m][1] + z1;
#pragma unroll
                    for (int i = 0; i < 4; ++i) { v0[i] = sc * sigmoidf_(v0[i]); v1[i] = sc * sigmoidf_(v1[i]); }
                    *(u32x4*)(o1 + (size_t)row * 512 + c) = pack8(v0, v1); } }
    }
};

constexpr int NWAVES = 8;
struct Args { const float* in[38]; float* out; unsigned char* ws; int ph_lo, ph_hi; };
struct Frame {
    LAS unsigned char* lds; unsigned char* ws; const float* const* in; float* out;
    int tid, lane, wave, vcu, G;
};
template <class T> __device__ __forceinline__ T* wsp(unsigned char* ws, size_t off) { return (T*)(ws + off); }

__device__ __forceinline__ void conv_item(const float* W, int ldw, int k0, int n0, int ncols, const float* gain, bf16_t* WT, int ldk, int dst_row0, LAS float* scr, int lane) {
#pragma unroll
    for (int i = 0; i < 8; ++i) { const int kk = (lane >> 3) + 8 * i, c4 = 4 * (lane & 7);
        f32x4 v = __builtin_nontemporal_load((const f32x4*)(W + (size_t)(k0 + kk) * ldw + n0 + c4));
        if (gain) v = v * gain[k0 + kk];
        scr[kk * 33 + c4 + 0] = v[0]; scr[kk * 33 + c4 + 1] = v[1]; scr[kk * 33 + c4 + 2] = v[2]; scr[kk * 33 + c4 + 3] = v[3]; }
    LDS_WAIT(); asm volatile("" ::: "memory");
    const int c = lane & 7;
#pragma unroll
    for (int j = 0; j < 4; ++j) { const int n = (lane >> 3) + 8 * j; const LAS float* s = scr + (8 * c) * 33 + n;
        u32x4 o; o.x = pk2(s[0 * 33], s[1 * 33]); o.y = pk2(s[2 * 33], s[3 * 33]); o.z = pk2(s[4 * 33], s[5 * 33]); o.w = pk2(s[6 * 33], s[7 * 33]);
        if (n < ncols) *(u32x4*)(WT + (size_t)(dst_row0 + n) * ldk + k0 + 8 * c) = o; }
    LDS_WAIT(); asm volatile("" ::: "memory");
}
__device__ __forceinline__ void conv_job_item(int r, const float* W, int ldw, int col0, int nblk, int ncols_last, const float* gain, bf16_t* WT, int ldk, int mode, int dst_off, LAS float* scr, int lane) {
    const int kb = r / nblk, nb = r % nblk; const int nrel = 32 * nb;
    int drow = dst_off + nrel; if (mode) drow = 256 * (nrel >> 7) + (nrel & 127) + (mode == 2 ? 128 : 0);
    conv_item(W, ldw, 64 * kb, col0 + nrel, (nb == nblk - 1) ? ncols_last : 32, gain, WT, ldk, drow, scr, lane);
}
struct ConvItem { const float* src; const float* gain; bf16_t* dst; int ldw, ldk, ncols; };
__device__ __forceinline__ ConvItem conv_desc(int r, const float* W, int ldw, int col0, int nblk, int ncols_last, const float* gain, bf16_t* WT, int ldk, int mode, int dst_off) {
    const int kb = r / nblk, nb = r % nblk; const int nrel = 32 * nb;
    int drow = dst_off + nrel; if (mode) drow = 256 * (nrel >> 7) + (nrel & 127) + (mode == 2 ? 128 : 0);
    ConvItem c; c.src = W + (size_t)(64 * kb) * ldw + col0 + nrel; c.gain = gain ? gain + 64 * kb : nullptr; c.dst = WT + (size_t)drow * ldk + 64 * kb; c.ldw = ldw; c.ldk = ldk; c.ncols = (nb == nblk - 1) ? ncols_last : 32; return c;
}
__device__ __forceinline__ void conv_ld(f32x4 (&v)[8], const ConvItem& c, int lane) {
#pragma unroll
    for (int i = 0; i < 8; ++i) { const int kk = (lane >> 3) + 8 * i, c4 = 4 * (lane & 7); v[i] = __builtin_nontemporal_load((const f32x4*)(c.src + (size_t)kk * c.ldw + c4)); }
}
typedef short v4i16_t __attribute__((ext_vector_type(4)));
__device__ __forceinline__ void conv_fin(const f32x4 (&v)[8], const ConvItem& c, LAS float* scr, int lane) {
#pragma unroll
    for (int i = 0; i < 8; ++i) { const int kk = (lane >> 3) + 8 * i, c4 = 4 * (lane & 7); f32x4 x = v[i]; if (c.gain) x = x * c.gain[kk];
        scr[kk * 33 + c4 + 0] = x[0]; scr[kk * 33 + c4 + 1] = x[1]; scr[kk * 33 + c4 + 2] = x[2]; scr[kk * 33 + c4 + 3] = x[3]; }
    LDS_WAIT(); asm volatile("" ::: "memory");
    const int cc = lane & 7;
#pragma unroll
    for (int j = 0; j < 4; ++j) { const int n = (lane >> 3) + 8 * j; const LAS float* sp = scr + (8 * cc) * 33 + n;
        u32x4 o; o.x = pk2(sp[0 * 33], sp[1 * 33]); o.y = pk2(sp[2 * 33], sp[3 * 33]); o.z = pk2(sp[4 * 33], sp[5 * 33]); o.w = pk2(sp[6 * 33], sp[7 * 33]);
        if (n < c.ncols) *(u32x4*)(c.dst + (size_t)n * c.ldk + 8 * cc) = o; }
    LDS_WAIT(); asm volatile("" ::: "memory");
}
template <class D> __device__ __forceinline__ void conv_run(const D& d, int w, int nw, int nitems, LAS float* scr, int lane) {
    f32x4 va[8], vb[8];
    int it = w; if (it >= nitems) return;
    ConvItem ca = d(it), cb = ca; conv_ld(va, ca, lane);
    for (;;) {
        const int it2 = it + nw; const bool h2 = it2 < nitems;
        if (h2) { cb = d(it2); conv_ld(vb, cb, lane); }
        conv_fin(va, ca, scr, lane);
        if (!h2) break;
        const int it3 = it2 + nw; const bool h3 = it3 < nitems;
        if (h3) { ca = d(it3); conv_ld(va, ca, lane); }
        conv_fin(vb, cb, scr, lane);
        if (!h3) break;
        it = it3;
    }
}
struct ConvG0 { const float* const* in; unsigned char* ws; __device__ __forceinline__ ConvItem operator()(int r) const { return conv_desc(r, in[2], 2560, 0, 80, 32, in[1], wsp<bf16_t>(ws, WS_WIN0), 1024, 0, 0); } };
struct ConvG1 { const float* const* in; unsigned char* ws; __device__ __forceinline__ ConvItem operator()(int it) const { constexpr int I1 = 16 * 32, I2 = 16 * 88; int r = it;
    if (r < I1) return conv_desc(r, in[20], 1024, 0, 32, 32, nullptr, wsp<bf16_t>(ws, WS_WOUT0), 1024, 0, 0); r -= I1;
    if (r < I2) return conv_desc(r, in[22], 2816, 0, 88, 32, in[21], wsp<bf16_t>(ws, WS_WGU0), 1024, 1, 0); r -= I2;
    if (r < I2) return conv_desc(r, in[23], 2816, 0, 88, 32, in[21], wsp<bf16_t>(ws, WS_WGU0), 1024, 2, 0); r -= I2;
    return conv_desc(r, in[24], 1024, 0, 32, 32, nullptr, wsp<bf16_t>(ws, WS_WD0), 2816, 0, 0); } };
struct ConvG2 { const float* const* in; unsigned char* ws; __device__ __forceinline__ ConvItem operator()(int it) const { constexpr int I5 = 16 * 64, I6 = 16 * 32, I7 = 16; int r = it;
    if (r < I5) return conv_desc(r, in[26], 3088, 0, 64, 32, in[25], wsp<bf16_t>(ws, WS_WIN1), 1024, 0, 0); r -= I5;
    if (r < I6) return conv_desc(r, in[26], 3088, 2064, 32, 32, in[25], wsp<bf16_t>(ws, WS_WIN1), 1024, 0, 2048); r -= I6;
    if (r < I7) return conv_desc(r, in[26], 3088, 2048, 1, 16, in[25], wsp<bf16_t>(ws, WS_WIN1), 1024, 0, 3072); r -= I7;
    return conv_desc(r, in[32], 1024, 0, 32, 32, nullptr, wsp<bf16_t>(ws, WS_WOUT1), 1024, 0, 0); } };
__device__ __forceinline__ void conv_group(const Frame& F, int group, int w, int nw) {
    LAS float* scr = (LAS float*)(F.lds + F.wave * 16384); const int lane = F.lane;
    if (group == 0) { ConvG0 d{F.in, F.ws}; conv_run(d, w, nw, 16 * 80, scr, lane); }
    else if (group == 1) { ConvG1 d{F.in, F.ws}; conv_run(d, w, nw, 16 * 32 + 2 * 16 * 88 + 44 * 32, scr, lane); }
    else { ConvG2 d{F.in, F.ws}; conv_run(d, w, nw, 16 * 64 + 16 * 32 + 16 + 16 * 32, scr, lane); }
}
__device__ __forceinline__ void phase_prologue(const Frame& F) {
    const int gw = F.vcu * NWAVES + F.wave, NGW = F.G * NWAVES, lane = F.lane;
    unsigned char* ws = F.ws;
    conv_group(F, 0, gw, NGW);
    if (F.G < 256) { conv_group(F, 1, gw, NGW); conv_group(F, 2, gw, NGW); }
    const int gt = F.vcu * 512 + F.tid, NGT = F.G * 512;
    { bf16_t* wlr = wsp<bf16_t>(ws, WS_WLR);
      for (int i = gt; i < 2560 * 256; i += NGT) { const int n = i >> 8, k = i & 255; float v = 0.f;
          if (n < 512)       { if (k < 64) v = F.in[5][k * 512 + n]; }
          else if (n < 1024) { if (k < 64) v = F.in[7][k * 512 + (n - 512)]; }
          else if (n < 1536) { if (k >= 64 && k < 128) v = F.in[9][(k - 64) * 512 + (n - 1024)]; }
          else if (n < 2048) { if (k >= 64 && k < 128) v = F.in[11][(k - 64) * 512 + (n - 1536)]; }
          else               { if (k >= 128) v = F.in[12][(k - 128) * 512 + (n - 2048)]; }
          wlr[i] = f2bf(v); } }
    { f32x2* rt = wsp<f32x2>(ws, WS_ROPE);
      for (int i = gt; i < SEQ * 32; i += NGT) { const int ts = i >> 5, pi = i & 31; const float freq = expf(-(float)(pi & 15) * (9.210340371976184f / 16.f));
          const float ang = ((pi >= 16) ? (float)(ts & 63) : (float)(ts >> 6)) * freq; float sn, cs; sincosf(ang, &sn, &cs); rt[i] = (f32x2){cs, sn}; } }
    { const float* x = F.in[0]; bf16_t* xb = wsp<bf16_t>(ws, WS_XB); float* ssq = wsp<float>(ws, WS_SSQ0);
      for (int m = gw; m < M_TOK; m += NGW) { const f32x4* xr = (const f32x4*)(x + (size_t)m * 1024) + lane; f32x4 v[4]; float s = 0.f;
#pragma unroll
          for (int j = 0; j < 4; ++j) { v[j] = xr[64 * j]; s += (v[j].x * v[j].x + v[j].y * v[j].y) + (v[j].z * v[j].z + v[j].w * v[j].w); }
          s = wave_sum(s);
          u32x2* o8 = (u32x2*)(xb + (size_t)m * 1024) + lane;
#pragma unroll
          for (int j = 0; j < 4; ++j) { u32x2 w; w.x = pk2(v[j].x, v[j].y); w.y = pk2(v[j].z, v[j].w); o8[64 * j] = w; }
          if (lane < 16) ssq[(size_t)m * 16 + lane] = (lane == 0) ? s : 0.f; } }
}
struct ConvEGU { const float* const* in; unsigned char* ws; int base; __device__ __forceinline__ ConvItem operator()(int it_) const { constexpr int IG = 16 * 112; const int it = it_ + base; const int e = it / (2 * IG), r = it % (2 * IG);
    bf16_t* wegu = wsp<bf16_t>(ws, A_WEGU + (e >= EGU_EARLY ? WEGU_HI_SHIFT : 0)) + (size_t)e * 2 * D_FFE * 1024;
    if (r < IG) return conv_desc(r, in[35] + (size_t)e * 1024 * D_FFE, D_FFE, 0, 112, 32, in[33], wegu, 1024, 1, 0);
    return conv_desc(r - IG, in[36] + (size_t)e * 1024 * D_FFE, D_FFE, 0, 112, 32, in[33], wegu, 1024, 2, 0); } };
struct ConvED { const float* const* in; unsigned char* ws; __device__ __forceinline__ ConvItem operator()(int it) const { constexpr int ID = 56 * 32; const int e = it / ID, r = it % ID;
    return conv_desc(r, in[37] + (size_t)e * D_FFE * 1024, 1024, 0, 32, 32, nullptr, wsp<bf16_t>(ws, A_WED) + (size_t)e * 1024 * D_FFE, D_FFE, 0, 0); } };
__device__ __forceinline__ void conv_experts_gu(const Frame& F, int w, int nw, int e_lo, int e_hi) { ConvEGU d{F.in, F.ws, e_lo * 2 * 16 * 112}; conv_run(d, w, nw, (e_hi - e_lo) * 2 * 16 * 112, (LAS float*)(F.lds + F.wave * 16384), F.lane); }
__device__ __forceinline__ void conv_experts_down(const Frame& F, int w, int nw) { ConvED d{F.in, F.ws}; conv_run(d, w, nw, NEXP * 56 * 32, (LAS float*)(F.lds + F.wave * 16384), F.lane); }
__device__ __forceinline__ void phase_conv_experts(const Frame& F) {
    const int gw = F.vcu * NWAVES + F.wave, NGW = F.G * NWAVES;
    conv_experts_gu(F, gw, NGW, 0, EGU_EARLY);
}

__device__ __forceinline__ float dpp8_sum(float v) {
    v += __builtin_bit_cast(float, __builtin_amdgcn_update_dpp(0, __builtin_bit_cast(int, v), 0xB1, 0xF, 0xF, false));
    v += __builtin_bit_cast(float, __builtin_amdgcn_update_dpp(0, __builtin_bit_cast(int, v), 0x4E, 0xF, 0xF, false));
    v += __builtin_bit_cast(float, __builtin_amdgcn_update_dpp(0, __builtin_bit_cast(int, v), 0x141, 0xF, 0xF, false));
    return v;
}
__device__ __forceinline__ void phase_prep0(const Frame& F) {
    const int gw = F.vcu * NWAVES + F.wave, lane = F.lane;
    const bf16_t* P = wsp<bf16_t>(F.ws, A_P0);
    bf16_t *RS = wsp<bf16_t>(F.ws, A_RS), *KS = wsp<bf16_t>(F.ws, A_KS), *VS = wsp<bf16_t>(F.ws, A_VS), *NKK = wsp<bf16_t>(F.ws, A_NKK), *AP = wsp<bf16_t>(F.ws, A_AP);
    bf16_t *QH = wsp<bf16_t>(F.ws, A_QH), *KH = wsp<bf16_t>(F.ws, A_KH), *VT = wsp<bf16_t>(F.ws, A_VT0);
    const f32x2* ROPE = wsp<f32x2>(F.ws, WS_ROPE);
    float mu[4][8], kkw[8], qn8[8], kn8[8];
#pragma unroll
    for (int j = 0; j < 4; ++j)
#pragma unroll
        for (int e = 0; e < 8; ++e) { const int col = 8 * (lane + 64 * j) + e; mu[j][e] = col < RW_IN ? F.in[3][col] : 0.f; }
#pragma unroll
    for (int e = 0; e < 8; ++e) { kkw[e] = F.in[13][8 * lane + e]; qn8[e] = F.in[18][8 * (lane & 7) + e]; kn8[e] = F.in[19][8 * (lane & 7) + e]; }
    for (int g8 = gw; g8 < M_TOK / 8; g8 += F.G * NWAVES) {
        u32x4 prev[4], cur[5], nxt[4], nn[4];
        { const int tok = g8 * 8; const int ts = tok & (SEQ - 1);
#pragma unroll
          for (int j = 0; j < 5; ++j) cur[j] = *(const u32x4*)(P + (size_t)tok * E_IN + 8 * (lane + 64 * j));
#pragma unroll
          for (int j = 0; j < 4; ++j) nxt[j] = *(const u32x4*)(P + (size_t)(tok + 1) * E_IN + 8 * (lane + 64 * j));
#pragma unroll
          for (int j = 0; j < 4; ++j) prev[j] = (ts > 0) ? *(const u32x4*)(P + (size_t)(tok - 1) * E_IN + 8 * (lane + 64 * j)) : (u32x4){0u, 0u, 0u, 0u}; }
        for (int tt = 0; tt < 8; ++tt) { const int tok = g8 * 8 + tt; const int ts = tok & (SEQ - 1); const int bb = tok >> 11;
            u32x4 ncur4 = (u32x4){0u, 0u, 0u, 0u};
#pragma unroll
            for (int j = 0; j < 4; ++j) nn[j] = (u32x4){0u, 0u, 0u, 0u};
            if (tt < 7 && ts + 2 < SEQ) {
#pragma unroll
                for (int j = 0; j < 4; ++j) nn[j] = *(const u32x4*)(P + (size_t)(tok + 2) * E_IN + 8 * (lane + 64 * j)); }
            if (tt < 7) ncur4 = *(const u32x4*)(P + (size_t)(tok + 1) * E_IN + 8 * (lane + 256));
            const f32x4 rp0 = *(const f32x4*)(ROPE + (size_t)ts * 32 + 4 * (lane & 7)), rp1 = *(const f32x4*)(ROPE + (size_t)ts * 32 + 4 * (lane & 7) + 2);
            const float cs4[4] = {rp0[0], rp0[2], rp1[0], rp1[2]}, sn4[4] = {rp0[1], rp0[3], rp1[1], rp1[3]};
            float s[4][8];
#pragma unroll
            for (int j = 0; j < 4; ++j) { float c[8], p[8], n[8]; unpack8(cur[j], c); unpack8(prev[j], p); unpack8(nxt[j], n);
#pragma unroll
                for (int e = 0; e < 8; ++e) s[j][e] = c[e] + (0.5f * (p[e] + n[e]) - c[e]) * mu[j][e]; }
            const size_t o512 = (size_t)tok * 512 + 8 * lane;
            *(u32x4*)(RS + o512) = pack8f(s[0]); *(u32x4*)(KS + o512) = pack8f(s[1]); *(u32x4*)(VS + o512) = pack8f(s[2]);
            { float kr[8]; float ss = 0.f;
#pragma unroll
              for (int e = 0; e < 8; ++e) { kr[e] = s[1][e] * kkw[e]; ss += kr[e] * kr[e]; }
              ss = dpp8_sum(ss); const float inv = -1.f / fmaxf(sqrtf(ss), 1e-12f);
#pragma unroll
              for (int e = 0; e < 8; ++e) kr[e] *= inv;
              *(u32x4*)(NKK + o512) = pack8f(kr); }
            float x3[8], x4[8]; unpack8(cur[3], x3); unpack8(cur[4], x4);
            { float ap[8];
#pragma unroll
              for (int e = 0; e < 8; ++e) ap[e] = lane < 8 ? tanhf(s[3][e]) : (lane < 16 ? s[3][e] : sigmoidf_(s[3][e]));
              if (lane < 32) *(u32x4*)(AP + (size_t)tok * 256 + 8 * lane) = pack8f(ap); }
#pragma unroll
            for (int which = 0; which < 2; ++which) { float (&x)[8] = which ? x4 : x3; float ss = 0.f;
#pragma unroll
                for (int e = 0; e < 8; ++e) ss += x[e] * x[e];
                ss = dpp8_sum(ss); const float rs = 1.0f / sqrtf(ss * (1.f / 64.f) + NORM_EPS);
                const bool isk = which && lane >= 32; float o[8];
#pragma unroll
                for (int p = 0; p < 4; ++p) { const float x0 = x[2 * p] * rs * (isk ? kn8[2 * p] : qn8[2 * p]), x1 = x[2 * p + 1] * rs * (isk ? kn8[2 * p + 1] : qn8[2 * p + 1]);
                    o[2 * p] = x0 * cs4[p] - x1 * sn4[p]; o[2 * p + 1] = x0 * sn4[p] + x1 * cs4[p]; }
                if (!isk) {
#pragma unroll
                    for (int e = 0; e < 8; ++e) o[e] *= 0.18033688011112042f; }
                if (which == 0) { if (lane >= 32) *(u32x4*)(QH + (size_t)tok * 512 + 8 * (lane - 32)) = pack8f(o); }
                else { if (lane < 32) *(u32x4*)(QH + (size_t)tok * 512 + 256 + 8 * lane) = pack8f(o);
                       else if (lane < 48) *(u32x4*)(KH + (size_t)tok * 128 + 8 * (lane - 32)) = pack8f(o); } }
            if (lane >= 48) { const int g = (lane - 48) >> 3, d0 = 8 * ((lane - 48) & 7); const unsigned w[4] = {cur[4].x, cur[4].y, cur[4].z, cur[4].w};
#pragma unroll
                for (int e = 0; e < 8; ++e) VT[((size_t)(bb * 2 + g) * 64 + d0 + e) * SEQ + ts] = (bf16_t)((e & 1) ? (w[e >> 1] >> 16) : (w[e >> 1] & 0xffffu)); }
#pragma unroll
            for (int j = 0; j < 4; ++j) prev[j] = cur[j];
#pragma unroll
            for (int j = 0; j < 4; ++j) { cur[j] = nxt[j]; nxt[j] = nn[j]; }
            cur[4] = ncur4;
        }
    }
}

__device__ __forceinline__ float dpp_row_sum(float v) {
    v += __builtin_bit_cast(float, __builtin_amdgcn_update_dpp(0, __builtin_bit_cast(int, v), 0xB1, 0xF, 0xF, false));
    v += __builtin_bit_cast(float, __builtin_amdgcn_update_dpp(0, __builtin_bit_cast(int, v), 0x4E, 0xF, 0xF, false));
    v += __builtin_bit_cast(float, __builtin_amdgcn_update_dpp(0, __builtin_bit_cast(int, v), 0x141, 0xF, 0xF, false));
    v += __builtin_bit_cast(float, __builtin_amdgcn_update_dpp(0, __builtin_bit_cast(int, v), 0x140, 0xF, 0xF, false));
    return v;
}
constexpr int SC_STEPS = 32, SC_STRIDE = 352, SC_BUF = SC_STEPS * SC_STRIDE;
__device__ __forceinline__ float dpp_row8_sum(float v) {
    v += __builtin_bit_cast(float, __builtin_amdgcn_update_dpp(0, __builtin_bit_cast(int, v), 0xB1, 0xF, 0xF, false));
    v += __builtin_bit_cast(float, __builtin_amdgcn_update_dpp(0, __builtin_bit_cast(int, v), 0x4E, 0xF, 0xF, false));
    v += __builtin_bit_cast(float, __builtin_amdgcn_update_dpp(0, __builtin_bit_cast(int, v), 0x141, 0xF, 0xF, false));
    return v;
}
struct ScOps { f32x2 w[4], kd[4], a[4], b[4], r[4]; float v; };
__device__ __forceinline__ void sc_ld(ScOps& o, const LAS float* bs, const LAS float* vp) {
#pragma unroll
    for (int i = 0; i < 2; ++i) {
        const f32x4 w4 = *(const LAS f32x4*)(bs + 4 * i), k4 = *(const LAS f32x4*)(bs + 64 + 4 * i), a4 = *(const LAS f32x4*)(bs + 128 + 4 * i), b4 = *(const LAS f32x4*)(bs + 192 + 4 * i), r4 = *(const LAS f32x4*)(bs + 256 + 4 * i);
        o.w[2 * i] = (f32x2){w4[0], w4[1]}; o.w[2 * i + 1] = (f32x2){w4[2], w4[3]}; o.kd[2 * i] = (f32x2){k4[0], k4[1]}; o.kd[2 * i + 1] = (f32x2){k4[2], k4[3]};
        o.a[2 * i] = (f32x2){a4[0], a4[1]}; o.a[2 * i + 1] = (f32x2){a4[2], a4[3]}; o.b[2 * i] = (f32x2){b4[0], b4[1]}; o.b[2 * i + 1] = (f32x2){b4[2], b4[3]};
        o.r[2 * i] = (f32x2){r4[0], r4[1]}; o.r[2 * i + 1] = (f32x2){r4[2], r4[3]}; }
    o.v = *vp;
}
template <int DIR> __device__ __forceinline__ float sc_step(f32x2 (&s)[4], const ScOps& o) {
    f32x2 u[4];
#pragma unroll
    for (int i = 0; i < 4; ++i) u[i] = o.kd[i] * o.v;
    f32x2 p = s[0] * o.a[0], q = s[1] * o.a[1];
    p = __builtin_elementwise_fma(s[2], o.a[2], p); q = __builtin_elementwise_fma(s[3], o.a[3], q); p = p + q;
    float sa = dpp_row8_sum(p[0] + p[1]);
    f32x2 yp, yq;
    if (DIR) { yp = s[0] * o.r[0]; yq = s[1] * o.r[1]; yp = __builtin_elementwise_fma(s[2], o.r[2], yp); yq = __builtin_elementwise_fma(s[3], o.r[3], yq); }
    const f32x2 sa2 = {sa, sa};
#pragma unroll
    for (int i = 0; i < 4; ++i) { const f32x2 t = __builtin_elementwise_fma(o.b[i], sa2, u[i]); s[i] = __builtin_elementwise_fma(s[i], o.w[i], t); }
    if (!DIR) { yp = s[0] * o.r[0]; yq = s[1] * o.r[1]; yp = __builtin_elementwise_fma(s[2], o.r[2], yp); yq = __builtin_elementwise_fma(s[3], o.r[3], yq); }
    yp = yp + yq;
    return dpp_row8_sum(yp[0] + yp[1]);
}
__device__ __forceinline__ void attn_tile_step(const LAS unsigned char* kb, const LAS unsigned char* vb, const bf16x8 (&q)[4], f32x16& o0, f32x16& o1, float& mrun, float& lrun, int r32, int hi) {
    f32x16 c0 = {}, c1 = {};
#pragma unroll
    for (int s4 = 0; s4 < 4; ++s4) { const int chk = 2 * s4 + hi;
        const bf16x8 k0 = *(const LAS bf16x8*)(kb + r32 * 128 + ((chk ^ (r32 & 7)) * 16));
        const bf16x8 k1 = *(const LAS bf16x8*)(kb + (32 + r32) * 128 + ((chk ^ (r32 & 7)) * 16));
        c0 = __builtin_amdgcn_mfma_f32_32x32x16_bf16(k0, q[s4], c0, 0, 0, 0);
        c1 = __builtin_amdgcn_mfma_f32_32x32x16_bf16(k1, q[s4], c1, 0, 0, 0); }
    float mx = c0[0];
#pragma unroll
    for (int r = 0; r < 16; ++r) { mx = fmaxf(mx, c0[r]); mx = fmaxf(mx, c1[r]); }
    mx = fmaxf(mx, __shfl_xor(mx, 32));
    const float mnew = fmaxf(mrun, mx); const float alpha = __builtin_amdgcn_exp2f(mrun - mnew); mrun = mnew;
    float ls = 0.f;
#pragma unroll
    for (int r = 0; r < 16; ++r) { c0[r] = __builtin_amdgcn_exp2f(c0[r] - mnew); c1[r] = __builtin_amdgcn_exp2f(c1[r] - mnew); ls += c0[r] + c1[r]; }
    lrun = lrun * alpha + ls;
#pragma unroll
    for (int r = 0; r < 16; ++r) { o0[r] *= alpha; o1[r] *= alpha; }
    u32x4 w00, w01, w10, w11;
    w00.x = pk2(c0[0], c0[1]); w00.y = pk2(c0[2], c0[3]); w00.z = pk2(c0[4], c0[5]); w00.w = pk2(c0[6], c0[7]);
    w01.x = pk2(c0[8], c0[9]); w01.y = pk2(c0[10], c0[11]); w01.z = pk2(c0[12], c0[13]); w01.w = pk2(c0[14], c0[15]);
    w10.x = pk2(c1[0], c1[1]); w10.y = pk2(c1[2], c1[3]); w10.z = pk2(c1[4], c1[5]); w10.w = pk2(c1[6], c1[7]);
    w11.x = pk2(c1[8], c1[9]); w11.y = pk2(c1[10], c1[11]); w11.z = pk2(c1[12], c1[13]); w11.w = pk2(c1[14], c1[15]);
    const bf16x8 p00 = __builtin_bit_cast(bf16x8, w00), p01 = __builtin_bit_cast(bf16x8, w01), p10 = __builtin_bit_cast(bf16x8, w10), p11 = __builtin_bit_cast(bf16x8, w11);
#define AT_VF(dd_, chk_) ({ const int sw_ = ((dd_) >> 1) & 7; const u32x2 lo_ = *(const LAS u32x2*)(vb + (dd_) * 128 + (((chk_) ^ sw_) * 16) + hi * 8); \
        const u32x2 hh_ = *(const LAS u32x2*)(vb + (dd_) * 128 + ((((chk_) + 1) ^ sw_) * 16) + hi * 8); const u32x4 vv_ = {lo_.x, lo_.y, hh_.x, hh_.y}; __builtin_bit_cast(bf16x8, vv_); })
    o0 = __builtin_amdgcn_mfma_f32_32x32x16_bf16(AT_VF(r32, 0), p00, o0, 0, 0, 0);
    o0 = __builtin_amdgcn_mfma_f32_32x32x16_bf16(AT_VF(r32, 2), p01, o0, 0, 0, 0);
    o0 = __builtin_amdgcn_mfma_f32_32x32x16_bf16(AT_VF(r32, 4), p10, o0, 0, 0, 0);
    o0 = __builtin_amdgcn_mfma_f32_32x32x16_bf16(AT_VF(r32, 6), p11, o0, 0, 0, 0);
    o1 = __builtin_amdgcn_mfma_f32_32x32x16_bf16(AT_VF(32 + r32, 0), p00, o1, 0, 0, 0);
    o1 = __builtin_amdgcn_mfma_f32_32x32x16_bf16(AT_VF(32 + r32, 2), p01, o1, 0, 0, 0);
    o1 = __builtin_amdgcn_mfma_f32_32x32x16_bf16(AT_VF(32 + r32, 4), p10, o1, 0, 0, 0);
    o1 = __builtin_amdgcn_mfma_f32_32x32x16_bf16(AT_VF(32 + r32, 6), p11, o1, 0, 0, 0);
#undef AT_VF
}
__device__ __forceinline__ void attn_store(bf16_t* op, const f32x16& o0, const f32x16& o1, float lrun) {
    const float ltot = lrun + __shfl_xor(lrun, 32); const float inv = 1.f / ltot;
#pragma unroll
    for (int q4 = 0; q4 < 4; ++q4) { u32x2 w0, w1;
        w0.x = pk2(o0[4 * q4 + 0] * inv, o0[4 * q4 + 1] * inv); w0.y = pk2(o0[4 * q4 + 2] * inv, o0[4 * q4 + 3] * inv);
        w1.x = pk2(o1[4 * q4 + 0] * inv, o1[4 * q4 + 1] * inv); w1.y = pk2(o1[4 * q4 + 2] * inv, o1[4 * q4 + 3] * inv);
        *(u32x2*)(op + 8 * q4) = w0; *(u32x2*)(op + 32 + 8 * q4) = w1; }
}
constexpr int CS_SLOT = 9216, CS_RS = 144;
__device__ __forceinline__ void cs_mm(f32x4 (&acc)[2], const LAS unsigned char* L, const LAS unsigned char* Rt, int mi, int ni0, int fr, int fq) {
#pragma unroll
    for (int s2 = 0; s2 < 2; ++s2) { const bf16x8 a = *(const LAS bf16x8*)(L + (16 * mi + fr) * CS_RS + (32 * s2 + 8 * fq) * 2);
#pragma unroll
        for (int jj = 0; jj < 2; ++jj) { const bf16x8 bb = *(const LAS bf16x8*)(Rt + (16 * (ni0 + jj) + fr) * CS_RS + (32 * s2 + 8 * fq) * 2);
            acc[jj] = __builtin_amdgcn_mfma_f32_16x16x32_bf16(a, bb, acc[jj], 0, 0, 0); } }
}
__device__ __forceinline__ void cs_st_t8(LAS unsigned char* dst, const f32x4 (&acc)[2], int mi, int ni0, int fr, int fq) {
#pragma unroll
    for (int jj = 0; jj < 2; ++jj) { u32x2 w; w.x = pk2(acc[jj][0], acc[jj][1]); w.y = pk2(acc[jj][2], acc[jj][3]);
        *(LAS u32x2*)(dst + (16 * (ni0 + jj) + fr) * CS_RS + (16 * mi + 4 * fq) * 2) = w; }
}
__device__ __forceinline__ void cs_st_sc(LAS unsigned char* dst, const f32x4 (&acc)[2], int mi, int ni0, int fr, int fq) {
#pragma unroll
    for (int jj = 0; jj < 2; ++jj)
#pragma unroll
        for (int r = 0; r < 4; ++r) *(LAS bf16_t*)(dst + (16 * mi + 4 * fq + r) * CS_RS + (16 * (ni0 + jj) + fr) * 2) = f2bf(acc[jj][r]);
}
__device__ __forceinline__ void cs_ld_t8(f32x4 (&acc)[2], const LAS unsigned char* src, int mi, int ni0, int fr, int fq) {
#pragma unroll
    for (int jj = 0; jj < 2; ++jj) { const u32x2 w = *(const LAS u32x2*)(src + (16 * (ni0 + jj) + fr) * CS_RS + (16 * mi + 4 * fq) * 2);
        acc[jj] = (f32x4){bflo(w.x), bfhi(w.x), bflo(w.y), bfhi(w.y)}; }
}
#define CS_ZERO(acc) do { acc[0] = (f32x4){0.f, 0.f, 0.f, 0.f}; acc[1] = acc[0]; } while (0)
template <int RS = CS_RS> __device__ __forceinline__ bf16x8 cs_afrag_tr(const LAS unsigned char* LT, int mi, int s2, int fr, int fq) {
    const LAS unsigned char* p = LT + (32 * s2 + 8 * fq + (fr >> 2)) * RS + (16 * mi + 4 * (fr & 3)) * 2;
    const v4i16_t lo = __builtin_amdgcn_ds_read_tr16_b64_v4i16((LAS v4i16_t*)p);
    const v4i16_t hi = __builtin_amdgcn_ds_read_tr16_b64_v4i16((LAS v4i16_t*)(p + 4 * RS));
    return (bf16x8){lo[0], lo[1], lo[2], lo[3], hi[0], hi[1], hi[2], hi[3]};
}
__device__ __forceinline__ void cs_mm_tr(f32x4 (&acc)[2], const LAS unsigned char* LT, const LAS unsigned char* Rt, int mi, int ni0, int fr, int fq) {
#pragma unroll
    for (int s2 = 0; s2 < 2; ++s2) { const bf16x8 a = cs_afrag_tr(LT, mi, s2, fr, fq);
#pragma unroll
        for (int jj = 0; jj < 2; ++jj) { const bf16x8 bb = *(const LAS bf16x8*)(Rt + (16 * (ni0 + jj) + fr) * CS_RS + (32 * s2 + 8 * fq) * 2);
            acc[jj] = __builtin_amdgcn_mfma_f32_16x16x32_bf16(a, bb, acc[jj], 0, 0, 0); } }
}
__device__ __forceinline__ void cs_mm_tr2(f32x4 (&aU)[2], f32x4 (&aS)[2], const LAS unsigned char* LUT, const LAS unsigned char* LST, const LAS unsigned char* Rt, bool doS, int mi, int ni0, int fr, int fq) {
#pragma unroll
    for (int s2 = 0; s2 < 2; ++s2) { const bf16x8 au = cs_afrag_tr(LUT, mi, s2, fr, fq); const bf16x8 as = cs_afrag_tr(LST, mi, s2, fr, fq);
#pragma unroll
        for (int jj = 0; jj < 2; ++jj) { const bf16x8 bb = *(const LAS bf16x8*)(Rt + (16 * (ni0 + jj) + fr) * CS_RS + (32 * s2 + 8 * fq) * 2);
            aU[jj] = __builtin_amdgcn_mfma_f32_16x16x32_bf16(au, bb, aU[jj], 0, 0, 0);
            if (doS) aS[jj] = __builtin_amdgcn_mfma_f32_16x16x32_bf16(as, bb, aS[jj], 0, 0, 0); } }
}
__device__ __forceinline__ void cs_mask(f32x4 (&acc)[2], int mi, int ni0, int fr, int fq, int mode) {
#pragma unroll
    for (int jj = 0; jj < 2; ++jj) { const int ni = ni0 + jj;
        const bool keep_all = (mode == 1) ? (ni < mi) : (ni > mi), diag = (ni == mi);
        if (diag) {
#pragma unroll
            for (int r = 0; r < 4; ++r) { const int ml = 4 * fq + r; const bool k = (mode == 0) ? (ml < fr) : (mode == 1) ? (fr < ml) : (ml <= fr); if (!k) acc[jj][r] = 0.f; }
        } else if (!keep_all) acc[jj] = (f32x4){0.f, 0.f, 0.f, 0.f}; }
}
template <int DIR> __device__ __forceinline__ void cscan_job(const Frame& F, int b, int h) {
    const int tid = F.tid, lane = F.lane, wave = F.wave, fr = lane & 15, fq = lane >> 4;
    LAS unsigned char* L0 = F.lds;
#define SL(i) (L0 + (i) * CS_SLOT)
    LAS float* Dl = (LAS float*)(SL(14) + 8704);
    const bf16_t* g0 = wsp<bf16_t>(F.ws, DIR ? A_LWB : A_LWF); const bf16_t* g1 = wsp<bf16_t>(F.ws, A_KS); const bf16_t* g2 = wsp<bf16_t>(F.ws, A_NKK);
    const bf16_t* g3 = wsp<bf16_t>(F.ws, DIR ? A_SGB : A_SGF); const bf16_t* g4 = wsp<bf16_t>(F.ws, A_RS); const bf16_t* g5 = wsp<bf16_t>(F.ws, A_VS);
    bf16_t* Y = wsp<bf16_t>(F.ws, DIR ? A_YB : A_YF);
    const int mi = wave >> 1, ni0 = 2 * (wave & 1);
    const int rt_ = tid >> 3, rc_ = tid & 7;
    const int ek = tid & 63, etq = tid >> 6;
    u32x4 raw[5], rawv, rawv_cur; bf16_t lwn[8];
    const float ka_k = F.in[14][h * 64 + ek];
#define CS_LOAD(n_) do { const int sq_ = 64 * (n_) + rt_; const size_t to_ = (size_t)(b * SEQ + (DIR ? (SEQ - 1 - sq_) : sq_)) * 512 + h * 64; \
        raw[1] = *(const u32x4*)(g1 + to_ + 8 * rc_); raw[2] = *(const u32x4*)(g2 + to_ + 8 * rc_); raw[3] = *(const u32x4*)(g3 + to_ + 8 * rc_); raw[4] = *(const u32x4*)(g4 + to_ + 8 * rc_); \
        rawv = *(const u32x4*)(g5 + to_ + 8 * rc_); \
        _Pragma("unroll") for (int j_ = 0; j_ < 8; ++j_) { const int sq2_ = 64 * (n_) + 8 * etq + j_; lwn[j_] = g0[(size_t)(b * SEQ + (DIR ? (SEQ - 1 - sq2_) : sq2_)) * 512 + h * 64 + ek]; } } while (0)
    __syncthreads();
    for (int i = tid; i < 8704 / 4; i += 512) ((LAS unsigned*)SL(14))[i] = 0u;
    CS_LOAD(0);
    float lwv[8], cw[8];
    LAS float* PART = (LAS float*)SL(12);
#define CS_STAGE0(nn_) do { \
        _Pragma("unroll") for (int j = 0; j < 8; ++j) lwv[j] = bf2f(lwn[j]); \
        cw[0] = lwv[0]; \
        _Pragma("unroll") for (int j = 1; j < 8; ++j) cw[j] = cw[j - 1] + lwv[j]; \
        PART[etq * 64 + ek] = cw[7]; \
        _Pragma("unroll") for (int q = 1; q < 5; ++q) *(LAS u32x4*)(SL(7 + q) + rt_ * CS_RS + rc_ * 16) = raw[q]; \
        rawv_cur = rawv; \
        if ((nn_) + 1 < 32) CS_LOAD((nn_) + 1); } while (0)
    CS_STAGE0(0);
    __syncthreads();
    for (int n = 0; n < 32; ++n) {
        { float off = 0.f, tot = 0.f;
#pragma unroll
          for (int q = 0; q < 8; ++q) { const float p = PART[q * 64 + ek]; tot += p; if (q < etq) off += p; }
          const float ec = __builtin_amdgcn_exp2f(tot);
          if (etq == 0) Dl[ek] = ec;
          unsigned pa[4], pbh[4], pkh[4];
#pragma unroll
          for (int j = 0; j < 8; ++j) { const int t = 8 * etq + j; const float c = cw[j] + off, cp = c - lwv[j];
              const float e1 = __builtin_amdgcn_exp2f(c), em = __builtin_amdgcn_exp2f(-c), ep = __builtin_amdgcn_exp2f(cp);
              const float kdv = bf2f(*(const LAS bf16_t*)(SL(8) + t * CS_RS + ek * 2)), av = bf2f(*(const LAS bf16_t*)(SL(9) + t * CS_RS + ek * 2));
              const float bv = bf2f(*(const LAS bf16_t*)(SL(10) + t * CS_RS + ek * 2)), rv = bf2f(*(const LAS bf16_t*)(SL(11) + t * CS_RS + ek * 2));
              const float sgv = bv; const float kd2 = kdv * (1.f + (sgv - 1.f) * ka_k), bb2 = -av * sgv;
              const float at = av * ep, bt = bb2 * em, kt = kd2 * em, rtv = rv * (DIR ? ep : e1), bh = bt * ec, kh = kt * ec;
              const unsigned w01 = pk2(at, bt), w23 = pk2(kt, rtv);
              *(LAS bf16_t*)(SL(0) + t * CS_RS + ek * 2) = (bf16_t)(w01 & 0xffffu); *(LAS bf16_t*)(SL(1) + t * CS_RS + ek * 2) = (bf16_t)(w01 >> 16);
              *(LAS bf16_t*)(SL(2) + t * CS_RS + ek * 2) = (bf16_t)(w23 & 0xffffu); *(LAS bf16_t*)(SL(3) + t * CS_RS + ek * 2) = (bf16_t)(w23 >> 16);
              const unsigned hbk = pk2(bh, kh); const unsigned ha = w01 & 0xffffu, hb = hbk & 0xffffu, hk = hbk >> 16;
              if (j & 1) { pa[j >> 1] |= ha << 16; pbh[j >> 1] |= hb << 16; pkh[j >> 1] |= hk << 16; } else { pa[j >> 1] = ha; pbh[j >> 1] = hb; pkh[j >> 1] = hk; } }
          *(LAS u32x4*)(SL(4) + ek * CS_RS + etq * 16) = (u32x4){pa[0], pa[1], pa[2], pa[3]};
          *(LAS u32x4*)(SL(5) + ek * CS_RS + etq * 16) = (u32x4){pbh[0], pbh[1], pbh[2], pbh[3]};
          *(LAS u32x4*)(SL(6) + ek * CS_RS + etq * 16) = (u32x4){pkh[0], pkh[1], pkh[2], pkh[3]}; }
        __syncthreads();
        { f32x4 acc[2];
          CS_ZERO(acc); cs_mm(acc, SL(1), SL(0), mi, ni0, fr, fq); cs_mask(acc, mi, ni0, fr, fq, 0);
          cs_st_t8(SL(8), acc, mi, ni0, fr, fq);
          if (mi == ni0 || mi == ni0 + 1) { const int jd = mi - ni0;
#pragma unroll
              for (int jj = 0; jj < 2; ++jj)
#pragma unroll
                  for (int r = 0; r < 4; ++r) if (jj == jd && (4 * fq + r) == fr) acc[jj][r] += 1.f; }
          cs_st_t8(SL(13), acc, mi, ni0, fr, fq);
          CS_ZERO(acc); cs_mm(acc, SL(0), SL(2), mi, ni0, fr, fq); cs_mask(acc, mi, ni0, fr, fq, 1); cs_st_t8(SL(9), acc, mi, ni0, fr, fq);
          CS_ZERO(acc); cs_mm(acc, SL(1), SL(3), mi, ni0, fr, fq); cs_mask(acc, mi, ni0, fr, fq, DIR ? 0 : 2); cs_st_t8(SL(10), acc, mi, ni0, fr, fq);
          CS_ZERO(acc); cs_mm(acc, SL(2), SL(3), mi, ni0, fr, fq); cs_mask(acc, mi, ni0, fr, fq, DIR ? 0 : 2); cs_st_t8(SL(11), acc, mi, ni0, fr, fq); }
        __syncthreads();
        { f32x4 aS[2], aU[2];
          CS_ZERO(aS); cs_mm_tr(aS, SL(8), SL(8), mi, ni0, fr, fq); cs_st_t8(SL(1), aS, mi, ni0, fr, fq);
          __syncthreads();
#pragma unroll
          for (int it = 0; it < 5; ++it) { const int xc = (it & 1) ? 8 : 1, xa = (it & 1) ? 1 : 8, tc = (it & 1) ? 12 : 13, ta = (it & 1) ? 13 : 12;
              cs_ld_t8(aU, SL(tc), mi, ni0, fr, fq); CS_ZERO(aS); cs_mm_tr2(aU, aS, SL(tc), SL(xc), SL(xc), it < 4, mi, ni0, fr, fq);
              cs_st_t8(SL(ta), aU, mi, ni0, fr, fq);
              if (it < 4) cs_st_t8(SL(xa), aS, mi, ni0, fr, fq);
              __syncthreads(); } }
        { f32x4 acc[2];
          CS_ZERO(acc); cs_mm(acc, SL(12), SL(4), mi, ni0, fr, fq); cs_st_t8(SL(0), acc, mi, ni0, fr, fq);
          CS_ZERO(acc); cs_mm(acc, SL(12), SL(9), mi, ni0, fr, fq); cs_st_t8(SL(1), acc, mi, ni0, fr, fq); }
        __syncthreads();
        { f32x4 acc[2];
          CS_ZERO(acc);
          if (mi == ni0 || mi == ni0 + 1) { const int jd = mi - ni0; const float dv = Dl[16 * mi + fr];
#pragma unroll
              for (int jj = 0; jj < 2; ++jj)
#pragma unroll
                  for (int r = 0; r < 4; ++r) if (jj == jd && (4 * fq + r) == fr) acc[jj][r] = dv; }
          cs_mm(acc, SL(0), SL(5), mi, ni0, fr, fq); cs_st_t8(SL(7), acc, mi, ni0, fr, fq);
          cs_ld_t8(acc, SL(3), mi, ni0, fr, fq); cs_mm(acc, SL(0), SL(10), mi, ni0, fr, fq); cs_st_t8(SL(3), acc, mi, ni0, fr, fq);
          cs_ld_t8(acc, SL(6), mi, ni0, fr, fq); cs_mm(acc, SL(1), SL(5), mi, ni0, fr, fq); cs_st_t8(SL(6), acc, mi, ni0, fr, fq);
          cs_ld_t8(acc, SL(11), mi, ni0, fr, fq); cs_mm(acc, SL(1), SL(10), mi, ni0, fr, fq); cs_st_t8(SL(13), acc, mi, ni0, fr, fq);
          const unsigned w4[4] = {rawv_cur.x, rawv_cur.y, rawv_cur.z, rawv_cur.w};
#pragma unroll
          for (int e = 0; e < 8; ++e) *(LAS bf16_t*)(SL(2) + (8 * rc_ + e) * CS_RS + rt_ * 2) = (bf16_t)((e & 1) ? (w4[e >> 1] >> 16) : (w4[e >> 1] & 0xffffu)); }
        __syncthreads();
        if (n + 1 < 32) CS_STAGE0(n + 1);
        { const LAS unsigned char* PH = (wave < 4 ? SL(7) : SL(3)) + (16 * (wave & 3) + fr) * CS_RS; const LAS unsigned char* PS = (wave < 4 ? SL(6) : SL(13)) + (16 * (wave & 3) + fr) * CS_RS;
          const LAS unsigned char* Sr = (n & 1) ? SL(15) : SL(14); LAS unsigned char* Sw = (n & 1) ? SL(14) : SL(15);
          f32x4 acc[4] = {(f32x4){0.f, 0.f, 0.f, 0.f}, (f32x4){0.f, 0.f, 0.f, 0.f}, (f32x4){0.f, 0.f, 0.f, 0.f}, (f32x4){0.f, 0.f, 0.f, 0.f}};
#pragma unroll
          for (int s2 = 0; s2 < 2; ++s2) { const bf16x8 bph = *(const LAS bf16x8*)(PH + (32 * s2 + 8 * fq) * 2), bps = *(const LAS bf16x8*)(PS + (32 * s2 + 8 * fq) * 2);
#pragma unroll
              for (int m2 = 0; m2 < 4; ++m2) { const bf16x8 as = cs_afrag_tr<136>(Sr, m2, s2, fr, fq), av = *(const LAS bf16x8*)(SL(2) + (16 * m2 + fr) * CS_RS + (32 * s2 + 8 * fq) * 2);
                  acc[m2] = __builtin_amdgcn_mfma_f32_16x16x32_bf16(as, bph, acc[m2], 0, 0, 0); acc[m2] = __builtin_amdgcn_mfma_f32_16x16x32_bf16(av, bps, acc[m2], 0, 0, 0); } }
          if (wave < 4) {
#pragma unroll
              for (int m2 = 0; m2 < 4; ++m2) { u32x2 w; w.x = pk2(acc[m2][0], acc[m2][1]); w.y = pk2(acc[m2][2], acc[m2][3]);
                  *(LAS u32x2*)(Sw + (16 * wave + fr) * 136 + (16 * m2 + 4 * fq) * 2) = w; }
          } else { const int sq = 64 * n + 16 * (wave - 4) + fr; const size_t tok = (size_t)(b * SEQ + (DIR ? (SEQ - 1 - sq) : sq));
#pragma unroll
              for (int m2 = 0; m2 < 4; ++m2) { u32x2 w; w.x = pk2(acc[m2][0], acc[m2][1]); w.y = pk2(acc[m2][2], acc[m2][3]); *(u32x2*)(Y + tok * 512 + h * 64 + 16 * m2 + 4 * fq) = w; } } }
        __syncthreads();
    }
#undef CS_LOAD
#undef CS_STAGE0
#undef SL
}

__device__ __forceinline__ void phase_attn_range(const Frame& F, int u_first, int u_stride) {
    const int tid = F.tid, lane = F.lane, wave = F.wave, r32 = lane & 31, hi = lane >> 5;
    LAS unsigned char* lds = F.lds;
    const bf16_t *QH = wsp<bf16_t>(F.ws, A_QH), *KH = wsp<bf16_t>(F.ws, A_KH), *VT = wsp<bf16_t>(F.ws, A_VT0); bf16_t* YC = wsp<bf16_t>(F.ws, A_YCAT);
    const int skey = tid >> 3, sc = tid & 7;
#define AT_QK(C0, C1, bo_) do { C0 = (f32x16){}; C1 = (f32x16){}; bf16x8 kf_[2][4]; \
        _Pragma("unroll") for (int s = 0; s < 4; ++s) { const int ch = 2 * s + hi; \
            kf_[0][s] = *(const LAS bf16x8*)(lds + (bo_) + r32 * 128 + ((ch ^ (r32 & 7)) * 16)); \
            kf_[1][s] = *(const LAS bf16x8*)(lds + (bo_) + (32 + r32) * 128 + ((ch ^ (r32 & 7)) * 16)); } \
        __builtin_amdgcn_sched_barrier(0); \
        _Pragma("unroll") for (int s = 0; s < 4; ++s) { \
            C0 = __builtin_amdgcn_mfma_f32_32x32x16_bf16(kf_[0][s], qf[s], C0, 0, 0, 0); \
            C1 = __builtin_amdgcn_mfma_f32_32x32x16_bf16(kf_[1][s], qf[s], C1, 0, 0, 0); } } while (0)
#define AT_ITER(t_, CA0, CA1, CB0, CB1) do { const int t = (t_); \
        if (t + 1 < SEQ / 64) AT_QK(CB0, CB1, ((t + 1) & 1) * 8192); \
        __builtin_amdgcn_sched_barrier(0); \
        float mx = CA0[0]; \
        _Pragma("unroll") for (int r = 0; r < 16; ++r) { mx = fmaxf(mx, CA0[r]); mx = fmaxf(mx, CA1[r]); } \
        mx = fmaxf(mx, __shfl_xor(mx, 32)); \
        const float mnew = fmaxf(mrun, mx); const float alpha = __builtin_amdgcn_exp2f(mrun - mnew); mrun = mnew; \
        float ls = 0.f; \
        _Pragma("unroll") for (int r = 0; r < 16; ++r) { CA0[r] = __builtin_amdgcn_exp2f(CA0[r] - mnew); CA1[r] = __builtin_amdgcn_exp2f(CA1[r] - mnew); ls += CA0[r] + CA1[r]; } \
        lrun = lrun * alpha + ls; \
        _Pragma("unroll") for (int r = 0; r < 16; ++r) { o0[r] *= alpha; o1[r] *= alpha; } \
        bf16x8 pf[2][2]; \
        _Pragma("unroll") for (int s2 = 0; s2 < 2; ++s2) { u32x4 w0, w1; \
            w0.x = pk2(CA0[8 * s2 + 0], CA0[8 * s2 + 1]); w0.y = pk2(CA0[8 * s2 + 2], CA0[8 * s2 + 3]); w0.z = pk2(CA0[8 * s2 + 4], CA0[8 * s2 + 5]); w0.w = pk2(CA0[8 * s2 + 6], CA0[8 * s2 + 7]); \
            w1.x = pk2(CA1[8 * s2 + 0], CA1[8 * s2 + 1]); w1.y = pk2(CA1[8 * s2 + 2], CA1[8 * s2 + 3]); w1.z = pk2(CA1[8 * s2 + 4], CA1[8 * s2 + 5]); w1.w = pk2(CA1[8 * s2 + 6], CA1[8 * s2 + 7]); \
            pf[0][s2] = __builtin_bit_cast(bf16x8, w0); pf[1][s2] = __builtin_bit_cast(bf16x8, w1); } \
        const int vb = 16384 + (t & 1) * 8192; \
        _Pragma("unroll") for (int dblk = 0; dblk < 2; ++dblk) { const int d = 32 * dblk + r32; const int sw = (d >> 1) & 7; \
            _Pragma("unroll") for (int blk = 0; blk < 2; ++blk) \
                _Pragma("unroll") for (int s2 = 0; s2 < 2; ++s2) { const int ch = 4 * blk + 2 * s2; \
                    const u32x2 lo = *(const LAS u32x2*)(lds + vb + d * 128 + ((ch ^ sw) * 16) + hi * 8); \
                    const u32x2 hh = *(const LAS u32x2*)(lds + vb + d * 128 + (((ch + 1) ^ sw) * 16) + hi * 8); \
                    const u32x4 vv = {lo.x, lo.y, hh.x, hh.y}; \
                    if (dblk == 0) o0 = __builtin_amdgcn_mfma_f32_32x32x16_bf16(__builtin_bit_cast(bf16x8, vv), pf[blk][s2], o0, 0, 0, 0); \
                    else           o1 = __builtin_amdgcn_mfma_f32_32x32x16_bf16(__builtin_bit_cast(bf16x8, vv), pf[blk][s2], o1, 0, 0, 0); } } \
        if (t + 2 < SEQ / 64) *(LAS u32x4*)(lds + (t & 1) * 8192 + kdst) = kst; \
        if (t + 1 < SEQ / 64) *(LAS u32x4*)(lds + ((t + 1) & 1) * 8192 + vdst) = vst; \
        if (t + 3 < SEQ / 64) kst = *(const u32x4*)(ksrc + (size_t)(t + 3) * 64 * 128); \
        if (t + 2 < SEQ / 64) vst = *(const u32x4*)(vsrc + (t + 2) * 64); \
        __syncthreads(); } while (0)
    for (int u = u_first; u < 512; u += u_stride) {
        const int b = u >> 6, g = (u >> 5) & 1, qt = u & 31;
        const int head = 4 * g + (wave >> 1); const int qrow = b * SEQ + qt * 64 + 32 * (wave & 1) + r32;
        bf16x8 qf[4];
#pragma unroll
        for (int s = 0; s < 4; ++s) qf[s] = *(const bf16x8*)(QH + (size_t)qrow * 512 + head * 64 + 16 * s + 8 * hi);
        const bf16_t* ksrc = KH + (size_t)(b * SEQ + skey) * 128 + g * 64 + 8 * sc;
        const bf16_t* vsrc = VT + ((size_t)(b * 2 + g) * 64 + skey) * SEQ + 8 * sc;
        const int kdst = skey * 128 + ((sc ^ (skey & 7)) * 16), vdst = 16384 + skey * 128 + ((sc ^ ((skey >> 1) & 7)) * 16);
        u32x4 kst = *(const u32x4*)ksrc, vst = *(const u32x4*)vsrc;
        const u32x4 kst1 = *(const u32x4*)(ksrc + (size_t)64 * 128);
        __syncthreads();
        *(LAS u32x4*)(lds + kdst) = kst; *(LAS u32x4*)(lds + vdst) = vst; *(LAS u32x4*)(lds + 8192 + kdst) = kst1;
        kst = *(const u32x4*)(ksrc + (size_t)2 * 64 * 128); vst = *(const u32x4*)(vsrc + 64);
        __syncthreads();
        f32x16 o0 = {}, o1 = {}; float mrun = -1e30f, lrun = 0.f;
        f32x16 ca0, ca1, cb0, cb1;
        AT_QK(ca0, ca1, 0);
        __syncthreads();
        for (int t2 = 0; t2 < SEQ / 64; t2 += 2) { AT_ITER(t2, ca0, ca1, cb0, cb1); AT_ITER(t2 + 1, cb0, cb1, ca0, ca1); }
        const float ltot = lrun + __shfl_xor(lrun, 32); const float inv = 1.f / ltot;
        bf16_t* op = YC + (size_t)qrow * 1024 + 512 + head * 64 + 4 * hi;
#pragma unroll
        for (int q4 = 0; q4 < 4; ++q4) { u32x2 w0, w1;
            w0.x = pk2(o0[4 * q4 + 0] * inv, o0[4 * q4 + 1] * inv); w0.y = pk2(o0[4 * q4 + 2] * inv, o0[4 * q4 + 3] * inv);
            w1.x = pk2(o1[4 * q4 + 0] * inv, o1[4 * q4 + 1] * inv); w1.y = pk2(o1[4 * q4 + 2] * inv, o1[4 * q4 + 3] * inv);
            *(u32x2*)(op + 8 * q4) = w0; *(u32x2*)(op + 32 + 8 * q4) = w1; }
    }
#undef AT_QK
#undef AT_ITER
}

__device__ __forceinline__ void phase_attn(const Frame& F) { phase_attn_range(F, F.vcu, F.G); }
__device__ __forceinline__ void phase_cscan_attn_split(const Frame& F) {
    const int half_g = F.G >> 1, me = F.vcu >> 1;
    if ((F.vcu & 1) == 0) {
        for (int chain = me; chain < 128; chain += half_g) { const int dir = chain & 1, bh = chain >> 1, b = bh >> 3, h = bh & 7;
            for (int q_ = 0; q_ <= (int)((MK_REP_SUB) & 1u); ++q_) { if (dir) cscan_job<1>(F, b, h); else cscan_job<0>(F, b, h); } }
    } else {
        for (int q_ = 0; q_ <= (int)(((MK_REP_SUB) >> 1) & 1u); ++q_)
        for (int u4 = me; u4 * 4 < 512; u4 += half_g) for (int q = 0; q < 4; ++q) phase_attn_range(F, u4 * 4 + q, 1 << 30);
        __syncthreads();
        for (int q_ = 0; q_ <= (int)(((MK_REP_SUB) >> 4) & 1u); ++q_)
        { conv_experts_down(F, me * NWAVES + F.wave, half_g * NWAVES); conv_experts_gu(F, me * NWAVES + F.wave, half_g * NWAVES, EGU_EARLY, NEXP); }
    }
}
__device__ __forceinline__ void phase_rwkv_post(const Frame& F) {
    const int lane = F.lane, wave = F.wave, fr = lane & 15, fq = lane >> 4;
    const bf16_t *YF = wsp<bf16_t>(F.ws, A_YF), *YB = wsp<bf16_t>(F.ws, A_YB);
    const bf16_t *RS = wsp<bf16_t>(F.ws, A_RS), *VS = wsp<bf16_t>(F.ws, A_VS), *KSP = wsp<bf16_t>(F.ws, A_KS), *SGF = wsp<bf16_t>(F.ws, A_SGF);
    const bf16_t* AP = wsp<bf16_t>(F.ws, A_AP) + 128; const bf16_t* WG = wsp<bf16_t>(F.ws, WS_WLR) + (size_t)2048 * 256 + 128;
    bf16_t* YC = wsp<bf16_t>(F.ws, A_YCAT);
    constexpr int GRS = 1040;
    LAS unsigned char* GL = F.lds;
    const int c0 = 8 * lane;
    float gw_[8], gb_[8], rk_[8], ka_[8];
#pragma unroll
    for (int i = 0; i < 8; ++i) { gw_[i] = F.in[16][c0 + i]; gb_[i] = F.in[17][c0 + i]; rk_[i] = F.in[15][c0 + i]; ka_[i] = F.in[14][c0 + i]; }
    for (int tile = F.vcu; tile < M_TOK / 64; tile += F.G) { const int t0 = tile * 64;
        { f32x4 acc[4][4];
#pragma unroll
          for (int nt = 0; nt < 4; ++nt)
#pragma unroll
              for (int mt = 0; mt < 4; ++mt) acc[nt][mt] = (f32x4){0.f, 0.f, 0.f, 0.f};
#pragma unroll
          for (int ks = 0; ks < 4; ++ks) { bf16x8 a[4], b[4];
#pragma unroll
              for (int nt = 0; nt < 4; ++nt) a[nt] = *(const bf16x8*)(WG + (size_t)(64 * wave + 16 * nt + fr) * 256 + 32 * ks + 8 * fq);
#pragma unroll
              for (int mt = 0; mt < 4; ++mt) b[mt] = *(const bf16x8*)(AP + (size_t)(t0 + 16 * mt + fr) * 256 + 32 * ks + 8 * fq);
#pragma unroll
              for (int nt = 0; nt < 4; ++nt)
#pragma unroll
                  for (int mt = 0; mt < 4; ++mt) acc[nt][mt] = __builtin_amdgcn_mfma_f32_16x16x32_bf16(a[nt], b[mt], acc[nt][mt], 0, 0, 0); }
#pragma unroll
          for (int nt = 0; nt < 4; ++nt)
#pragma unroll
              for (int mt = 0; mt < 4; ++mt) { u32x2 w; w.x = pk2(acc[nt][mt][0], acc[nt][mt][1]); w.y = pk2(acc[nt][mt][2], acc[nt][mt][3]);
                  *(LAS u32x2*)(GL + (16 * mt + fr) * GRS + (64 * wave + 16 * nt + 4 * fq) * 2) = w; } }
        __syncthreads();
        for (int j = 0; j < 8; ++j) { const int tl = 8 * wave + j; const size_t o = (size_t)(t0 + tl) * 512 + c0;
            const u32x4 yfw = *(const u32x4*)(YF + o), ybw = *(const u32x4*)(YB + o);
            float y[8]; float sm = 0.f;
            y[0] = bflo(yfw.x) + bflo(ybw.x); y[1] = bfhi(yfw.x) + bfhi(ybw.x); y[2] = bflo(yfw.y) + bflo(ybw.y); y[3] = bfhi(yfw.y) + bfhi(ybw.y);
            y[4] = bflo(yfw.z) + bflo(ybw.z); y[5] = bfhi(yfw.z) + bfhi(ybw.z); y[6] = bflo(yfw.w) + bflo(ybw.w); y[7] = bfhi(yfw.w) + bfhi(ybw.w);
#pragma unroll
            for (int i = 0; i < 8; ++i) sm += y[i];
            sm += __shfl_xor(sm, 1); sm += __shfl_xor(sm, 2); sm += __shfl_xor(sm, 4);
            const float mean = sm * (1.f / 64.f); float sv = 0.f;
#pragma unroll
            for (int i = 0; i < 8; ++i) { y[i] -= mean; sv += y[i] * y[i]; }
            sv += __shfl_xor(sv, 1); sv += __shfl_xor(sv, 2); sv += __shfl_xor(sv, 4);
            const float rstd = 1.0f / sqrtf(sv * (1.f / 64.f) + 64e-5f);
            const u32x4 rw = *(const u32x4*)(RS + o), vw = *(const u32x4*)(VS + o), kw = *(const u32x4*)(KSP + o), sw = *(const u32x4*)(SGF + o), gw4 = *(const LAS u32x4*)(GL + tl * GRS + c0 * 2);
            float r8[8], v8[8], k8[8], g8[8], s8[8]; unpack8(rw, r8); unpack8(vw, v8); unpack8(kw, k8); unpack8(gw4, g8); unpack8(sw, s8);
#pragma unroll
            for (int i = 0; i < 8; ++i) k8[i] = bf2f(f2bf(k8[i] * (1.f + (s8[i] - 1.f) * ka_[i])));
            float bs = 0.f;
#pragma unroll
            for (int i = 0; i < 8; ++i) bs += r8[i] * k8[i] * rk_[i];
            bs += __shfl_xor(bs, 1); bs += __shfl_xor(bs, 2); bs += __shfl_xor(bs, 4);
            float ov[8];
#pragma unroll
            for (int i = 0; i < 8; ++i) ov[i] = ((y[i] * rstd) * gw_[i] + gb_[i] + bs * v8[i]) * g8[i];
            *(u32x4*)(YC + (size_t)(t0 + tl) * 1024 + c0) = pack8f(ov); }
        __syncthreads(); }
}

__device__ __forceinline__ void phase_gd(const Frame& F) {
    const int tid = F.tid, lane = F.lane, wave = F.wave, fr = lane & 15, fq = lane >> 4;
    LAS f32x4* PL = (LAS f32x4*)F.lds;
    const bf16_t* XB = wsp<bf16_t>(F.ws, WS_XB); const bf16_t* WG = wsp<bf16_t>(F.ws, WS_WIN1) + (size_t)3072 * 1024; const float* ssq = wsp<float>(F.ws, WS_SSQ2); bf16_t* P1 = wsp<bf16_t>(F.ws, A_P1);
    const int tpb = M_TOK / F.G;
    for (int t0 = F.vcu * tpb; t0 < (F.vcu + 1) * tpb; t0 += 64) {
        f32x4 acc[4];
#pragma unroll
        for (int t = 0; t < 4; ++t) acc[t] = (f32x4){0.f, 0.f, 0.f, 0.f};
#pragma unroll
        for (int s4 = 0; s4 < 4; ++s4) { const int k0 = 32 * (4 * wave + s4) + 8 * fq;
            const bf16x8 bfr = *(const bf16x8*)(WG + (size_t)fr * 1024 + k0);
#pragma unroll
            for (int t = 0; t < 4; ++t) { const bf16x8 afr = *(const bf16x8*)(XB + (size_t)(t0 + 16 * t + fr) * 1024 + k0);
                acc[t] = __builtin_amdgcn_mfma_f32_16x16x32_bf16(afr, bfr, acc[t], 0, 0, 0); } }
        __syncthreads();
#pragma unroll
        for (int t = 0; t < 4; ++t) PL[(wave * 4 + t) * 64 + lane] = acc[t];
        __syncthreads();
        if (tid < 256) { const int t = tid >> 6, l = tid & 63; f32x4 sum = PL[t * 64 + l];
#pragma unroll
            for (int w = 1; w < 8; ++w) sum += PL[(w * 4 + t) * 64 + l];
            const int lfr = l & 15, lfq = l >> 4;
#pragma unroll
            for (int r = 0; r < 4; ++r) { const int tok = t0 + 16 * t + 4 * lfq + r; P1[(size_t)tok * O_INP + 3072 + lfr] = f2bf(sum[r] * rstd_from_ssq(ssq, tok)); } }
    }
}

constexpr float GLA_QSCALE = 0.08838834764831845f;
__device__ __forceinline__ size_t gla_dir(size_t base, int dir) { return base + (size_t)dir * GLA_DIR_STRIDE; }
__device__ __forceinline__ float logsig16(float z) { return (fminf(z, 0.f) - __logf(1.f + __expf(-fabsf(z)))) * (1.f / 16.f); }
__device__ __forceinline__ void phase_gla_prep(const Frame& F) {
    const int tid = F.tid, lane = F.lane, wave = F.wave, fr = lane & 15, fq = lane >> 4;
    LAS float* GD = (LAS float*)F.lds;
    LAS float* PT = (LAS float*)(F.lds + 4096);
    LAS unsigned char* QTt = F.lds + 10240;
    LAS unsigned char* KTt = F.lds + 10240 + 17408;
    LAS unsigned char* RV = F.lds + 10240;
    LAS unsigned char* RQ = F.lds + 45056; LAS unsigned char* RK = F.lds + 45056 + 16384;
    LAS unsigned char* ATT = F.lds + 45056;
    LAS unsigned char* QHl = F.lds + 45056 + 9216;
    LAS unsigned char* VTt = F.lds + 77824;
    const bf16_t* P1 = wsp<bf16_t>(F.ws, A_P1);
    bf16_t* VT = wsp<bf16_t>(F.ws, A_VT1); float* DECS = wsp<float>(F.ws, WS_DECS); bf16_t* OF = wsp<bf16_t>(F.ws, A_OF);
    const int d = tid & 127, qr = tid >> 7;
    u32x4 pq[2], pk_[2], pv[4]; bf16_t pg[2];
#define GP_FETCH(u_) do { const int n_ = (u_) & 31, h_ = ((u_) >> 5) & 3, b_ = (u_) >> 7; const int T_ = b_ * SEQ + 64 * n_; \
        _Pragma("unroll") for (int i = 0; i < 2; ++i) { const int p = tid + 512 * i; pg[i] = P1[(size_t)(T_ + (p >> 4)) * O_INP + 3072 + (p & 15)]; \
            const int row = p >> 4, c = p & 15; const bf16_t* src = P1 + (size_t)(T_ + row) * O_INP + h_ * 128 + 8 * c; pq[i] = *(const u32x4*)src; pk_[i] = *(const u32x4*)(src + 512); } \
        _Pragma("unroll") for (int i = 0; i < 4; ++i) { const int p = tid + 512 * i, row = p >> 5, c = p & 31; pv[i] = *(const u32x4*)(P1 + (size_t)(T_ + row) * O_INP + 1024 + h_ * 256 + 8 * c); } } while (0)
    float upf[16], upb[16]; float bif = 0.f, bib = 0.f; int h_cur = -1;
    if (F.vcu < BATCH * GLA_H * 32) GP_FETCH(F.vcu);
    for (int unit = F.vcu; unit < BATCH * GLA_H * 32; unit += F.G) {
        const int n = unit & 31, h = (unit >> 5) & 3, b = unit >> 7; const int T0 = b * SEQ + 64 * n; const size_t tile = (size_t)(b * 4 + h) * 32 + n;
        __syncthreads();
#pragma unroll
        for (int i = 0; i < 2; ++i) { const int p = tid + 512 * i, row = p >> 4, c = p & 15; GD[p] = bf2f(pg[i]);
            *(LAS u32x4*)(RQ + row * 256 + c * 16) = pq[i]; *(LAS u32x4*)(RK + row * 256 + c * 16) = pk_[i]; }
#pragma unroll
        for (int i = 0; i < 4; ++i) { const int p = tid + 512 * i, row = p >> 5, c = p & 31; *(LAS u32x4*)(RV + row * 512 + c * 16) = pv[i]; }
        if (h != h_cur) { h_cur = h;
#pragma unroll
            for (int r = 0; r < 16; ++r) { upf[r] = F.in[27][r * 512 + h * 128 + d]; upb[r] = F.in[29][r * 512 + h * 128 + d]; }
            bif = F.in[28][h * 128 + d]; bib = F.in[30][h * 128 + d]; }
        if (unit + F.G < BATCH * GLA_H * 32) GP_FETCH(unit + F.G);
        __syncthreads();
        bf16_t qraw[16], kraw[16];
#pragma unroll
        for (int j = 0; j < 16; ++j) { qraw[j] = *(const LAS bf16_t*)(RQ + (16 * qr + j) * 256 + d * 2); kraw[j] = *(const LAS bf16_t*)(RK + (16 * qr + j) * 256 + d * 2); }
        { const int dv = tid & 255, th = tid >> 8; unsigned pk[16];
#pragma unroll
          for (int j = 0; j < 16; ++j) pk[j] = (unsigned)*(const LAS bf16_t*)(RV + (32 * th + 2 * j) * 512 + dv * 2) | ((unsigned)*(const LAS bf16_t*)(RV + (32 * th + 2 * j + 1) * 512 + dv * 2) << 16);
          bf16_t* gdst = VT + tile * 16384 + dv * 64 + 32 * th;
#pragma unroll
          for (int q = 0; q < 4; ++q) { const u32x4 w = {pk[4 * q], pk[4 * q + 1], pk[4 * q + 2], pk[4 * q + 3]}; *(u32x4*)(gdst + 8 * q) = w; *(LAS u32x4*)(VTt + dv * 144 + (32 * th + 8 * q) * 2) = w; } }
        float Bf[16], Bb[16];
#pragma unroll
        for (int j = 0; j < 16; ++j) { const LAS f32x4* gp = (const LAS f32x4*)(GD + (16 * qr + j) * 16); float zf = bif, zb = bib;
#pragma unroll
            for (int q = 0; q < 4; ++q) { const f32x4 g4 = gp[q];
#pragma unroll
                for (int e = 0; e < 4; ++e) { zf += g4[e] * upf[4 * q + e]; zb += g4[e] * upb[4 * q + e]; } }
            Bf[j] = logsig16(zf); Bb[j] = logsig16(zb); }
#pragma unroll
        for (int j = 1; j < 16; ++j) Bf[j] += Bf[j - 1];
#pragma unroll
        for (int j = 14; j >= 0; --j) Bb[j] += Bb[j + 1];
        PT[(0 * 4 + qr) * 128 + d] = Bf[15]; PT[(1 * 4 + qr) * 128 + d] = Bb[0];
        if (qr == 2) PT[1024 + d] = Bf[0];
        if (qr == 1) PT[1024 + 128 + d] = Bb[15];
        __syncthreads();
        float offf = 0.f, offb = 0.f, totf = 0.f, totb = 0.f, pre2f = 0.f, suf2b = 0.f;
#pragma unroll
        for (int q = 0; q < 4; ++q) { const float pf = PT[q * 128 + d], pb = PT[(4 + q) * 128 + d]; totf += pf; totb += pb; if (q < qr) offf += pf; if (q > qr) offb += pb; if (q < 2) pre2f += pf; if (q >= 2) suf2b += pb; }
        const float bmf = pre2f + PT[1024 + d], bmb = suf2b + PT[1024 + 128 + d];
#pragma unroll
        for (int j = 0; j < 16; ++j) { Bf[j] += offf; Bb[j] += offb; }
        f32x4 oacc[2][4];
#pragma unroll
        for (int x = 0; x < 2; ++x)
#pragma unroll
            for (int y = 0; y < 4; ++y) oacc[x][y] = (f32x4){0.f, 0.f, 0.f, 0.f};
#pragma unroll
        for (int dir = 0; dir < 2; ++dir) {
            const float bm = dir ? bmb : bmf, bl = dir ? totb : totf; const float ebm = __expf(bm), ebl = __expf(bl - bm);
            bf16_t* QHT = wsp<bf16_t>(F.ws, gla_dir(A_QHAT, dir)) + tile * 8192; bf16_t* K2T = wsp<bf16_t>(F.ws, gla_dir(A_K2T, dir)) + tile * 8192;
            unsigned k2pk[8];
#pragma unroll
            for (int j = 0; j < 16; ++j) { const float bv = dir ? Bb[j] : Bf[j]; const float e1 = __expf(bv - bm), r1 = __builtin_amdgcn_rcpf(e1);
                const float qs = bf2f(qraw[j]) * GLA_QSCALE, kk = bf2f(kraw[j]); const int tk = 16 * qr + j;
                const float qt = qs * e1, kt = kk * r1, qh = qt * ebm, k2 = kt * ebl;
                *(LAS bf16_t*)(QTt + tk * 272 + d * 2) = f2bf(qt); *(LAS bf16_t*)(KTt + tk * 272 + d * 2) = f2bf(kt); *(LAS bf16_t*)(QHl + tk * 272 + d * 2) = f2bf(qh);
                if (j & 1) k2pk[j >> 1] |= ((unsigned)f2bf(k2)) << 16; else k2pk[j >> 1] = (unsigned)f2bf(k2); }
            { bf16_t* kd = K2T + d * 64 + 16 * qr;
              *(u32x4*)kd = (u32x4){k2pk[0], k2pk[1], k2pk[2], k2pk[3]}; *(u32x4*)(kd + 8) = (u32x4){k2pk[4], k2pk[5], k2pk[6], k2pk[7]}; }
            if (qr == 0) DECS[((size_t)((b * 4 + h) * 2 + dir) * 32 + n) * 128 + d] = __expf(bl);
            __syncthreads();
#pragma unroll
            for (int i = 0; i < 2; ++i) { const int p = tid + 512 * i, row = p >> 4, c = p & 15; *(u32x4*)(QHT + row * 128 + c * 8) = *(const LAS u32x4*)(QHl + row * 272 + c * 16); }
            { const int ib = wave >> 1, jb0 = 2 * (wave & 1); f32x4 at[2] = {(f32x4){0.f, 0.f, 0.f, 0.f}, (f32x4){0.f, 0.f, 0.f, 0.f}};
#pragma unroll
              for (int s2 = 0; s2 < 4; ++s2) { const bf16x8 a = *(const LAS bf16x8*)(QTt + (16 * ib + fr) * 272 + (32 * s2 + 8 * fq) * 2);
#pragma unroll
                  for (int jj = 0; jj < 2; ++jj) { const bf16x8 bb = *(const LAS bf16x8*)(KTt + (16 * (jb0 + jj) + fr) * 272 + (32 * s2 + 8 * fq) * 2);
                      at[jj] = __builtin_amdgcn_mfma_f32_16x16x32_bf16(a, bb, at[jj], 0, 0, 0); } }
#pragma unroll
              for (int jj = 0; jj < 2; ++jj)
#pragma unroll
                  for (int r = 0; r < 4; ++r) { const int i = 16 * ib + 4 * fq + r, j = 16 * (jb0 + jj) + fr; const bool keep = dir ? (j > i) : (j <= i);
                      *(LAS bf16_t*)(ATT + i * 144 + j * 2) = f2bf(keep ? at[jj][r] : 0.f); } }
            __syncthreads();
#pragma unroll
            for (int s2 = 0; s2 < 2; ++s2) { bf16x8 bfr[4];
#pragma unroll
                for (int ib = 0; ib < 4; ++ib) bfr[ib] = *(const LAS bf16x8*)(ATT + (16 * ib + fr) * 144 + (32 * s2 + 8 * fq) * 2);
#pragma unroll
                for (int x = 0; x < 2; ++x) { const bf16x8 a = *(const LAS bf16x8*)(VTt + (16 * (2 * wave + x) + fr) * 144 + (32 * s2 + 8 * fq) * 2);
#pragma unroll
                    for (int ib = 0; ib < 4; ++ib) oacc[x][ib] = __builtin_amdgcn_mfma_f32_16x16x32_bf16(a, bfr[ib], oacc[x][ib], 0, 0, 0); } }
        }
#pragma unroll
        for (int x = 0; x < 2; ++x)
#pragma unroll
            for (int ib = 0; ib < 4; ++ib) { u32x2 w; w.x = pk2(oacc[x][ib][0], oacc[x][ib][1]); w.y = pk2(oacc[x][ib][2], oacc[x][ib][3]);
                *(u32x2*)(OF + (size_t)(T0 + 16 * ib + fr) * 1024 + h * 256 + 16 * (2 * wave + x) + 4 * fq) = w; }
    }
}
#undef GP_FETCH

template <int DIR> __device__ __forceinline__ void gla_seq_job(const Frame& F, int b, int h, int vs) {
    const int tid = F.tid, lane = F.lane, wave = F.wave, fr = lane & 15, fq = lane >> 4;
    LAS unsigned char* ST0 = F.lds; LAS unsigned char* ST1 = F.lds + 17408;
    LAS unsigned char* BUF = F.lds + 34816;
    constexpr int BQ = 0, BK2 = 17408, BVT = 17408 + 18432, BSZ = 45056;
    const bf16_t* QHT = wsp<bf16_t>(F.ws, gla_dir(A_QHAT, DIR)); const bf16_t* K2T = wsp<bf16_t>(F.ws, gla_dir(A_K2T, DIR));
    const bf16_t* VT = wsp<bf16_t>(F.ws, A_VT1); const float* DECS = wsp<float>(F.ws, WS_DECS); bf16_t* OF = wsp<bf16_t>(F.ws, A_OF); bf16_t* O = DIR ? wsp<bf16_t>(F.ws, A_OB) : OF;
    const int dvb = wave >> 1, ib0 = 2 * (wave & 1);
    const size_t tile0 = (size_t)(b * 4 + h) * 32;
    const int q0 = tid, q1 = tid + 512;
    const int dq0 = BQ + (q0 >> 4) * 272 + (q0 & 15) * 16, dq1 = BQ + (q1 >> 4) * 272 + (q1 & 15) * 16;
    const int dk0 = BK2 + (q0 >> 3) * 144 + (q0 & 7) * 16, dk1 = BK2 + (q1 >> 3) * 144 + (q1 & 7) * 16;
    const int dv0 = BVT + (q0 >> 3) * 144 + (q0 & 7) * 16;
    u32x4 sg[5]; f32x4 dec, decn; u32x2 oold[2], ooldn[2];
#define GL_LD(n_) do { const size_t t_ = tile0 + (n_); \
        sg[0] = *(const u32x4*)(QHT + t_ * 8192 + q0 * 8); sg[1] = *(const u32x4*)(QHT + t_ * 8192 + q1 * 8); \
        sg[2] = *(const u32x4*)(K2T + t_ * 8192 + q0 * 8); sg[3] = *(const u32x4*)(K2T + t_ * 8192 + q1 * 8); \
        sg[4] = *(const u32x4*)(VT + t_ * 16384 + vs * 4096 + q0 * 8); \
        decn = *(const f32x4*)(DECS + ((size_t)((b * 4 + h) * 2 + DIR) * 32 + (n_)) * 128 + 16 * wave + 4 * fq); \
        if (!DIR) { _Pragma("unroll") for (int ii = 0; ii < 2; ++ii) ooldn[ii] = *(const u32x2*)(OF + (size_t)(b * SEQ + 64 * (n_) + 16 * (ib0 + ii) + fr) * 1024 + h * 256 + 64 * vs + 16 * dvb + 4 * fq); } } while (0)
#define GL_ST(bp) do { *(LAS u32x4*)((bp) + dq0) = sg[0]; *(LAS u32x4*)((bp) + dq1) = sg[1]; *(LAS u32x4*)((bp) + dk0) = sg[2]; *(LAS u32x4*)((bp) + dk1) = sg[3]; *(LAS u32x4*)((bp) + dv0) = sg[4]; } while (0)
    __syncthreads();
    for (int i = tid; i < 17408 / 4; i += 512) ((LAS unsigned*)ST0)[i] = 0u;
    f32x4 st[4];
#pragma unroll
    for (int k = 0; k < 4; ++k) st[k] = (f32x4){0.f, 0.f, 0.f, 0.f};
    GL_LD(DIR ? 31 : 0); GL_ST(BUF); dec = decn; oold[0] = ooldn[0]; oold[1] = ooldn[1];
    __syncthreads();
    for (int cc = 0; cc < 32; ++cc) { const int n = DIR ? 31 - cc : cc, nn = DIR ? 30 - cc : cc + 1; const int T0 = b * SEQ + 64 * n;
        LAS unsigned char* STr = (cc & 1) ? ST1 : ST0; LAS unsigned char* STw = (cc & 1) ? ST0 : ST1;
        LAS unsigned char* bc = BUF + (cc & 1) * BSZ; LAS unsigned char* bn = BUF + ((cc + 1) & 1) * BSZ;
        if (cc + 1 < 32) GL_LD(nn);
#pragma unroll
        for (int x = 0; x < 4; ++x) st[x] = st[x] * dec;
        f32x4 oo[2] = {(f32x4){0.f, 0.f, 0.f, 0.f}, (f32x4){0.f, 0.f, 0.f, 0.f}};
#pragma unroll
        for (int s2 = 0; s2 < 4; ++s2) { const bf16x8 a = *(const LAS bf16x8*)(STr + (16 * dvb + fr) * 272 + (32 * s2 + 8 * fq) * 2);
#pragma unroll
            for (int ii = 0; ii < 2; ++ii) { const bf16x8 qf = *(const LAS bf16x8*)(bc + BQ + (16 * (ib0 + ii) + fr) * 272 + (32 * s2 + 8 * fq) * 2);
                oo[ii] = __builtin_amdgcn_mfma_f32_16x16x32_bf16(a, qf, oo[ii], 0, 0, 0); } }
#pragma unroll
        for (int s2 = 0; s2 < 2; ++s2) { const bf16x8 kf = *(const LAS bf16x8*)(bc + BK2 + (16 * wave + fr) * 144 + (32 * s2 + 8 * fq) * 2);
#pragma unroll
            for (int x = 0; x < 4; ++x) { const bf16x8 vf = *(const LAS bf16x8*)(bc + BVT + (16 * x + fr) * 144 + (32 * s2 + 8 * fq) * 2);
                st[x] = __builtin_amdgcn_mfma_f32_16x16x32_bf16(kf, vf, st[x], 0, 0, 0); } }
#pragma unroll
        for (int x = 0; x < 4; ++x) { u32x2 w; w.x = pk2(st[x][0], st[x][1]); w.y = pk2(st[x][2], st[x][3]); *(LAS u32x2*)(STw + (16 * x + fr) * 272 + (16 * wave + 4 * fq) * 2) = w; }
#pragma unroll
        for (int ii = 0; ii < 2; ++ii) { f32x4 v = oo[ii];
            if (!DIR) { v[0] += bflo(oold[ii].x); v[1] += bfhi(oold[ii].x); v[2] += bflo(oold[ii].y); v[3] += bfhi(oold[ii].y); }
            u32x2 w; w.x = pk2(v[0], v[1]); w.y = pk2(v[2], v[3]);
            *(u32x2*)(O + (size_t)(T0 + 16 * (ib0 + ii) + fr) * 1024 + h * 256 + 64 * vs + 16 * dvb + 4 * fq) = w; }
        if (cc + 1 < 32) { GL_ST(bn); dec = decn; oold[0] = ooldn[0]; oold[1] = ooldn[1]; }
        __syncthreads(); }
#undef GL_LD
#undef GL_ST
}
__device__ __forceinline__ void phase_gla_main(const Frame& F) {
    for (int job = F.vcu; job < 256; job += F.G) { const int vs = job & 3, dir = (job >> 2) & 1, h = (job >> 3) & 3, b = job >> 5;
        if (dir) gla_seq_job<1>(F, b, h, vs); else gla_seq_job<0>(F, b, h, vs); }
}

__device__ __forceinline__ void phase_gla_post(const Frame& F) {
    const int gw = F.vcu * NWAVES + F.wave, lane = F.lane; const int c0 = 16 * lane;
    const bf16_t *OF = wsp<bf16_t>(F.ws, A_OF), *OB = wsp<bf16_t>(F.ws, A_OB), *P1 = wsp<bf16_t>(F.ws, A_P1); bf16_t* GO = wsp<bf16_t>(F.ws, A_GOUT);
    float gn[16];
#pragma unroll
    for (int i = 0; i < 16; ++i) gn[i] = F.in[31][(c0 + i) & 255];
    for (int tok = gw; tok < M_TOK; tok += F.G * NWAVES) { const size_t o = (size_t)tok * 1024 + c0;
        float v[16]; float ss = 0.f;
#pragma unroll
        for (int hh = 0; hh < 2; ++hh) { const u32x4 a = *(const u32x4*)(OF + o + 8 * hh), bq = *(const u32x4*)(OB + o + 8 * hh);
            v[8 * hh + 0] = bflo(a.x) + bflo(bq.x); v[8 * hh + 1] = bfhi(a.x) + bfhi(bq.x); v[8 * hh + 2] = bflo(a.y) + bflo(bq.y); v[8 * hh + 3] = bfhi(a.y) + bfhi(bq.y);
            v[8 * hh + 4] = bflo(a.z) + bflo(bq.z); v[8 * hh + 5] = bfhi(a.z) + bfhi(bq.z); v[8 * hh + 6] = bflo(a.w) + bflo(bq.w); v[8 * hh + 7] = bfhi(a.w) + bfhi(bq.w); }
#pragma unroll
        for (int i = 0; i < 16; ++i) ss += v[i] * v[i];
        ss = dpp_row_sum(ss);
        const float rs = 1.0f / sqrtf(ss * (1.f / 256.f) + NORM_EPS);
        float og[16];
#pragma unroll
        for (int hh = 0; hh < 2; ++hh) { const u32x4 g = *(const u32x4*)(P1 + (size_t)tok * O_INP + 2048 + c0 + 8 * hh);
            og[8 * hh + 0] = bflo(g.x); og[8 * hh + 1] = bfhi(g.x); og[8 * hh + 2] = bflo(g.y); og[8 * hh + 3] = bfhi(g.y); og[8 * hh + 4] = bflo(g.z); og[8 * hh + 5] = bfhi(g.z); og[8 * hh + 6] = bflo(g.w); og[8 * hh + 7] = bfhi(g.w); }
        float r[16];
#pragma unroll
        for (int i = 0; i < 16; ++i) r[i] = v[i] * rs * gn[i] * siluf_(og[i]);
#pragma unroll
        for (int hh = 0; hh < 2; ++hh) { u32x4 w; w.x = pk2(r[8 * hh + 0], r[8 * hh + 1]); w.y = pk2(r[8 * hh + 2], r[8 * hh + 3]); w.z = pk2(r[8 * hh + 4], r[8 * hh + 5]); w.w = pk2(r[8 * hh + 6], r[8 * hh + 7]);
            *(u32x4*)(GO + o + 8 * hh) = w; } }
}

__device__ __forceinline__ void phase_route(const Frame& F) {
    const int tid = F.tid, lane = F.lane, wave = F.wave;
    LAS int* lcnt = (LAS int*)(F.lds + MOE_OFF);
    LAS float* RL = (LAS float*)F.lds;
    __syncthreads();
    if (tid < 16) lcnt[tid] = 0;
    const bf16_t* X = wsp<bf16_t>(F.ws, WS_XB); const float* g2 = F.in[33]; const float* RT = F.in[34];
    for (int i = tid; i < 2048; i += 512) { const int k = i >> 1; const f32x4 r = *(const f32x4*)(RT + (size_t)i * 4); *(LAS f32x4*)(RL + i * 4) = r * g2[k]; }
    __syncthreads();
    int* TE = wsp<int>(F.ws, WS_TOKE); float* TG = wsp<float>(F.ws, WS_TOKG); float* R3 = wsp<float>(F.ws, WS_RSTD3);
    const int tpb = M_TOK / F.G, tpw = tpb / NWAVES;
    for (int i0 = 0; i0 < tpw; i0 += 4) { const int tok0 = F.vcu * tpb + wave * tpw + i0;
        float acc[4][8], ss[4];
#pragma unroll
        for (int t = 0; t < 4; ++t) { ss[t] = 0.f;
#pragma unroll
            for (int e = 0; e < 8; ++e) acc[t][e] = 0.f; }
#pragma unroll
        for (int j = 0; j < 4; ++j) { const int k0 = 4 * lane + 256 * j; f32x4 xv[4];
#pragma unroll
            for (int t = 0; t < 4; ++t) { const u32x2 w = *(const u32x2*)(X + (size_t)(tok0 + t) * 1024 + k0); xv[t] = (f32x4){bflo(w.x), bfhi(w.x), bflo(w.y), bfhi(w.y)}; }
#pragma unroll
            for (int q = 0; q < 4; ++q) { const f32x4 r0 = *(const LAS f32x4*)(RL + (k0 + q) * 8), r1 = *(const LAS f32x4*)(RL + (k0 + q) * 8 + 4);
#pragma unroll
                for (int t = 0; t < 4; ++t) { const float xx = xv[t][q]; ss[t] += xx * xx;
                    acc[t][0] += xx * r0[0]; acc[t][1] += xx * r0[1]; acc[t][2] += xx * r0[2]; acc[t][3] += xx * r0[3]; acc[t][4] += xx * r1[0]; acc[t][5] += xx * r1[1]; acc[t][6] += xx * r1[2]; acc[t][7] += xx * r1[3]; } } }
#pragma unroll
        for (int t = 0; t < 4; ++t) { ss[t] = wave_sum(ss[t]);
#pragma unroll
            for (int e = 0; e < 8; ++e) acc[t][e] = wave_sum(acc[t][e]); }
        float lg[8]; float mss = 0.f;
#pragma unroll
        for (int t = 0; t < 4; ++t) { if (lane == t) { mss = ss[t];
#pragma unroll
                for (int e = 0; e < 8; ++e) lg[e] = acc[t][e]; } }
        if (lane < 4) { const int tok = tok0 + lane;
            const float rstd = 1.0f / sqrtf(mss * (1.f / 1024.f) + NORM_EPS);
            int i1 = 0; float l1 = lg[0] * rstd;
#pragma unroll
            for (int e = 1; e < 8; ++e) { const float l = lg[e] * rstd; if (l > l1) { l1 = l; i1 = e; } }
            int i2 = -1; float l2 = -3.0e38f;
#pragma unroll
            for (int e = 0; e < 8; ++e) { const float l = lg[e] * rstd; if (e != i1 && l > l2) { l2 = l; i2 = e; } }
            const float e2 = __expf(l2 - l1); const float ga = 1.f / (1.f + e2), gb = e2 / (1.f + e2);
            TE[tok * 2] = i1; TE[tok * 2 + 1] = i2; TG[tok * 2] = ga; TG[tok * 2 + 1] = gb; R3[tok] = rstd;
            atomicAdd((int*)&lcnt[i1], 1); atomicAdd((int*)&lcnt[8 + i2], 1); } }
    __syncthreads();
    if (tid < 16) wsp<int>(F.ws, WS_CNT)[F.vcu * 16 + tid] = lcnt[tid];
}
__device__ __forceinline__ void phase_place(const Frame& F) {
    const int tid = F.tid;
    LAS int* tab = (LAS int*)(F.lds + MOE_OFF);
    LAS int* C = (LAS int*)F.lds;
    LAS int* TEl = (LAS int*)(F.lds + 32768); LAS float* TGl = (LAS float*)(F.lds + 32768 + 1024);
    const int* CNT = wsp<int>(F.ws, WS_CNT); const int tpb = M_TOK / F.G;
    __syncthreads();
    for (int i = tid; i < F.G * 16; i += 512) C[i] = CNT[i];
    if (tid < 2 * tpb) { TEl[tid] = wsp<int>(F.ws, WS_TOKE)[F.vcu * tpb * 2 + tid]; TGl[tid] = wsp<float>(F.ws, WS_TOKG)[F.vcu * tpb * 2 + tid]; }
    __syncthreads();
    if (tid < 16) { int off = 0, tot = 0; for (int bb = 0; bb < F.G; ++bb) { const int c = C[bb * 16 + tid]; if (bb < F.vcu) off += c; tot += c; } tab[tid] = off; tab[16 + tid] = tot;
        if (F.vcu == 0) wsp<int>(F.ws, WS_TOT)[tid] = tot; }
    __syncthreads();
    if (tid < 16) { const int s = tid >> 3, e = tid & 7; int run = tab[tid]; for (int q = 0; q < e; ++q) run += tab[16 + q] + tab[24 + q];
        if (s) run += tab[16 + e];
        int* RTK = wsp<int>(F.ws, WS_ROWTOK); float* RGT = wsp<float>(F.ws, WS_ROWGATE);
        for (int i = 0; i < tpb; ++i) { if (TEl[i * 2 + s] == e) { RTK[run] = F.vcu * tpb + i; RGT[run] = TGl[i * 2 + s]; ++run; } } }
}
struct MoESched {
    pg8::GridOrder go; const LAS int* tab;
    const char* A; const char* Bt; size_t a_rowbytes, b_expert_bytes, b_tile_bytes; bool gather; int nt_;
    __device__ bool next(int i, pg8::Unit& u) const {
        int pm, pn; if (!go.tile(i, pm, pn)) return false;
        int e = 0;
#pragma unroll
        for (int q = 1; q < 8; ++q) if (pm >= tab[16 + q]) e = q;
        e = __builtin_amdgcn_readfirstlane(e);
        const int mt = pm - __builtin_amdgcn_readfirstlane(tab[16 + e]); const int row0 = __builtin_amdgcn_readfirstlane(tab[e]) + 256 * mt; int nr = __builtin_amdgcn_readfirstlane(tab[8 + e]) - 256 * mt; nr = nr > 256 ? 256 : nr;
        u.pm = pm; u.pn = pn; u.e = e; u.row0 = row0; u.nrows = nr; u.nt = nt_; u.flags = 0;
        u.a = gather ? A : A + (size_t)row0 * a_rowbytes; u.b = Bt + (size_t)e * b_expert_bytes + (size_t)pn * b_tile_bytes + (e >= EGU_EARLY ? WEGU_HI_SHIFT : (size_t)0); return true;
    }
};
struct MoEDownSched {
    const LAS int* tab; const char* A; const char* Bt; int nmt, c, round;
    __device__ void fill(pg8::Unit& u, int pm, int pn, int kp, int nt, int flags) const {
        int e = 0;
#pragma unroll
        for (int q = 1; q < 8; ++q) if (pm >= tab[16 + q]) e = q;
        e = __builtin_amdgcn_readfirstlane(e);
        const int mt = pm - __builtin_amdgcn_readfirstlane(tab[16 + e]); const int row0 = __builtin_amdgcn_readfirstlane(tab[e]) + 256 * mt; int nr = __builtin_amdgcn_readfirstlane(tab[8 + e]) - 256 * mt; nr = nr > 256 ? 256 : nr;
        u.pm = pm; u.pn = pn; u.e = e; u.row0 = row0; u.nrows = nr; u.nt = nt; u.flags = flags;
        u.a = A + (size_t)row0 * (D_FFE * 2) + (size_t)kp * 512 * 2; u.b = Bt + (size_t)e * ((size_t)1024 * D_FFE * 2) + (size_t)pn * ((size_t)256 * D_FFE * 2) + (size_t)kp * 512 * 2;
    }
    __device__ bool next(int i, pg8::Unit& u) const {
        if (i != 0) return false;
        if (round == 0) { const int pm = 8 * (c & 7) + ((c >> 3) & 7), pn = c >> 6; if (pm >= nmt) return false; fill(u, pm, pn, 0, D_FFE / 64, 0); return true; }
        { const int t = c / 7, kp = c % 7; const int pm = 64 + (t >> 2), pn = t & 3; if (pm >= nmt || t >= 36) return false; fill(u, pm, pn, kp, 8, 1 + c); return true; }
        return false;
    }
};
__device__ __forceinline__ int moe_table(const Frame& F, int mode) {
    LAS int* tab = (LAS int*)(F.lds + MOE_OFF);
    __syncthreads();
    if (F.tid == 0) { const int* TOT = wsp<int>(F.ws, WS_TOT); int rs = 0, ts = 0;
        for (int e = 0; e < 8; ++e) { const int c0 = TOT[e], c1 = TOT[8 + e]; const int st = rs + (mode == 1 ? c0 : 0), c = mode == 0 ? c0 : (mode == 1 ? c1 : c0 + c1);
            tab[e] = st; tab[8 + e] = c; tab[16 + e] = ts; rs += c0 + c1; ts += (c + 255) >> 8; }
        tab[24] = ts; }
    __syncthreads();
    return __builtin_amdgcn_readfirstlane(tab[24]);
}

__device__ __forceinline__ void moe_tail_reduce(const Frame& F, int s) {
    const int nmt = moe_table(F, s); const LAS int* tab = (const LAS int*)(F.lds + MOE_OFF);
    const int R = (nmt - 64) * 4; const int gw = F.vcu * NWAVES + F.wave, lane = F.lane;
    const float* part = wsp<float>(F.ws, s ? A_WEGU2 : A_WEGU); const int* RTK = wsp<int>(F.ws, WS_ROWTOK); const float* RGT = wsp<float>(F.ws, WS_ROWGATE);
    for (int idx = gw; idx < R * 256; idx += F.G * NWAVES) { const int t = idx >> 8, r = idx & 255; const int pm = 64 + (t >> 2), pn = t & 3;
        int e = 0;
#pragma unroll
        for (int q = 1; q < 8; ++q) if (pm >= tab[16 + q]) e = q;
        const int mt = pm - tab[16 + e]; const int row0 = tab[e] + 256 * mt; const int nr = tab[8 + e] - 256 * mt;
        if (r < nr) { const int tok = RTK[row0 + r] & 16383; const float gt = RGT[row0 + r];
            f32x4 a = {0.f, 0.f, 0.f, 0.f};
#pragma unroll
            for (int kp = 0; kp < 7; ++kp) a += *(const f32x4*)(part + ((size_t)(t * 7 + kp) * 256 + r) * 256 + 4 * lane);
            float* op = F.out + (size_t)tok * 1024 + 256 * pn + 4 * lane; f32x4 o;
            if (s == 0) { const u32x2 w = *(const u32x2*)(wsp<bf16_t>(F.ws, WS_XB) + (size_t)tok * 1024 + 256 * pn + 4 * lane); o = (f32x4){bflo(w.x), bfhi(w.x), bflo(w.y), bfhi(w.y)}; }
            else o = *(const f32x4*)op;
            o += a * gt; *(f32x4*)op = o; } }
}

constexpr int N_PHASES = 21;
__global__ void __launch_bounds__(NWAVES * 64, 2) mk_fwd(Args args) {
    extern __shared__ __attribute__((aligned(16))) unsigned char lds_raw[];
    Frame F; F.lds = (LAS unsigned char*)lds_raw; F.ws = args.ws; F.in = args.in; F.out = args.out;
    F.tid = threadIdx.x; F.lane = F.tid & 63; F.wave = __builtin_amdgcn_readfirstlane(F.tid >> 6);
    F.G = gridDim.x; { const int bx = blockIdx.x; F.vcu = (F.G % 8 == 0) ? (bx % 8) * (F.G / 8) + bx / 8 : bx; }
    volatile LAS unsigned* MISC = (volatile LAS unsigned*)(F.lds + MISC_OFF);
    if (F.tid < 64) MISC[F.tid] = 0u;
    __syncthreads();
    XcdBarrier bar; bar.bar = (unsigned*)(args.ws + WS_CTL) + CW_BAR; bar.x = 0; bar.st = nullptr;
    const int lo = args.ph_lo, hi = args.ph_hi;
    const bool multi = (hi - lo) > 1;
    if (multi) bar = xcd_barrier_post((unsigned*)(args.ws + WS_CTL) + CW_BAR, MISC + 8);
#ifdef PH_ONLY
#define IN(k) ((k) == PH_ONLY && lo <= (k) && (k) < hi)
#else
#define IN(k) (lo <= (k) && (k) < hi)
#endif
#define SEAM(k) do { if (IN(k) && IN((k) + 1)) xcd_barrier(bar); } while (0)
    unsigned char* ws = args.ws; const int cid = (int)blockIdx.x;
#define REFRESH() do { int t_ = threadIdx.x; asm volatile("" : "+v"(t_)); F.tid = t_; F.lane = t_ & 63; F.wave = __builtin_amdgcn_readfirstlane(t_ >> 6); unsigned long long w_ = (unsigned long long)args.ws; asm volatile("" : "+s"(w_)); F.ws = (unsigned char*)w_; ws = F.ws; } while (0)
    LAS unsigned char* ring = F.lds;

#ifndef MK_REP_MASK
#define MK_REP_MASK 0u
#endif
#define REPS(k) ((int)(((unsigned)(MK_REP_MASK) >> (k)) & 1u))
#define PHASE(k, ...) do { if (IN(k)) { for (int rep_ = 0; rep_ <= REPS(k); ++rep_) { if (rep_) xcd_barrier(bar); REFRESH(); __VA_ARGS__ } } SEAM(k); } while (0)
    PHASE(0, phase_prologue(F););
    PHASE(1, {
        pg8::DenseSched S; S.init(wsp<bf16_t>(ws, WS_XB), wsp<bf16_t>(ws, WS_WIN0), M_TOK, E_IN, 1024, F.G, cid);
        EpiScaleBf16 E{wsp<bf16_t>(ws, A_P0), E_IN, wsp<float>(ws, WS_SSQ0)};
        pg8::gemm_phase<EpiScaleBf16, pg8::DenseSched, false>(F.tid, ring, 1024, S, E, nullptr);
        if (F.G == 256 && cid >= 128 && rep_ == 0) { REFRESH(); conv_group(F, 1, (cid - 128) * NWAVES + F.wave, 128 * NWAVES); } });
    PHASE(2, phase_prep0(F););
    PHASE(3, {
        LowRankSched S; S.init(wsp<bf16_t>(ws, A_AP), wsp<bf16_t>(ws, WS_WLR), F.G, cid);
        EpiLowRank E{ws, F.in};
        pg8::gemm_phase<EpiLowRank, LowRankSched, false>(F.tid, ring, 256, S, E, nullptr); });
    PHASE(4, phase_cscan_attn_split(F););
    PHASE(5, phase_rwkv_post(F););
    PHASE(6, {
        pg8::DenseSched S; S.init(wsp<bf16_t>(ws, A_YCAT), wsp<bf16_t>(ws, WS_WOUT0), M_TOK, 1024, 1024, F.G, cid);
        EpiResidBf E{rep_ ? wsp<bf16_t>(ws, A_YF) : wsp<bf16_t>(ws, WS_XB), nullptr, rep_ ? wsp<float>(ws, WS_SSQ0) : wsp<float>(ws, WS_SSQ1)};
        pg8::gemm_phase<EpiResidBf, pg8::DenseSched, false>(F.tid, ring, 1024, S, E, nullptr); });
    PHASE(7, {
        pg8::DenseSched S; S.init(wsp<bf16_t>(ws, WS_XB), wsp<bf16_t>(ws, WS_WGU0), M_TOK, 2 * D_FF, 1024, F.G, cid);
        EpiSwiGLU E{wsp<bf16_t>(ws, A_HID0), D_FF, wsp<float>(ws, WS_SSQ1)};
        pg8::gemm_phase<EpiSwiGLU, pg8::DenseSched, false>(F.tid, ring, 1024, S, E, nullptr);
        if (F.G == 256 && cid >= 128 && rep_ == 0) { REFRESH(); conv_group(F, 2, (cid - 128) * NWAVES + F.wave, 128 * NWAVES); } });
    PHASE(8, {
        pg8::DenseSched S; S.init(wsp<bf16_t>(ws, A_HID0), wsp<bf16_t>(ws, WS_WD0), M_TOK, 1024, D_FF, F.G, cid);
        EpiResidBf E{rep_ ? wsp<bf16_t>(ws, A_YF) : wsp<bf16_t>(ws, WS_XB), nullptr, rep_ ? wsp<float>(ws, WS_SSQ0) : wsp<float>(ws, WS_SSQ2)};
        pg8::gemm_phase<EpiResidBf, pg8::DenseSched, false>(F.tid, ring, D_FF, S, E, nullptr); });
    PHASE(9, {
        pg8::DenseSched S; S.init(wsp<bf16_t>(ws, WS_XB), wsp<bf16_t>(ws, WS_WIN1), M_TOK, 3072, 1024, F.G, cid);
        EpiScaleBf16 E{wsp<bf16_t>(ws, A_P1), O_INP, wsp<float>(ws, WS_SSQ2)};
        pg8::gemm_phase<EpiScaleBf16, pg8::DenseSched, false>(F.tid, ring, 1024, S, E, nullptr);
        REFRESH(); phase_gd(F); });
    PHASE(10, phase_gla_prep(F););
    PHASE(11, phase_gla_main(F););
    PHASE(12, phase_gla_post(F););
    PHASE(13, {
        pg8::DenseSched S; S.init(wsp<bf16_t>(ws, A_GOUT), wsp<bf16_t>(ws, WS_WOUT1), M_TOK, 1024, 1024, F.G, cid);
        EpiResidBf E{rep_ ? wsp<bf16_t>(ws, A_VT1) : wsp<bf16_t>(ws, WS_XB), nullptr, nullptr};
        pg8::gemm_phase<EpiResidBf, pg8::DenseSched, false>(F.tid, ring, 1024, S, E, nullptr); });
    PHASE(14, for (int q_ = 0; q_ <= (int)(((MK_REP_SUB) >> 2) & 1u); ++q_) { phase_route(F); __syncthreads(); REFRESH(); }
              for (int q_ = 0; q_ <= (int)(((MK_REP_SUB) >> 3) & 1u); ++q_) { phase_conv_experts(F); __syncthreads(); REFRESH(); });
    PHASE(15, phase_place(F););
    PHASE(16, {
        const int nmt = moe_table(F, 2);
        MoESched S; S.go.init(nmt, 2 * D_FFE / 256, F.G, cid); S.tab = (const LAS int*)(F.lds + MOE_OFF);
        S.A = (const char*)wsp<bf16_t>(ws, WS_XB); S.Bt = (const char*)wsp<bf16_t>(ws, A_WEGU); S.a_rowbytes = 0; S.b_expert_bytes = (size_t)2 * D_FFE * 1024 * 2; S.b_tile_bytes = (size_t)256 * 1024 * 2; S.gather = true; S.nt_ = 16;
        const int* rtk = wsp<int>(ws, WS_ROWTOK);
        EpiSwiGLUMoE E{wsp<bf16_t>(ws, A_HID1), wsp<float>(ws, WS_RSTD3), rtk};
        pg8::gemm_phase<EpiSwiGLUMoE, MoESched, true>(F.tid, ring, 1024, S, E, rtk); });
#pragma unroll 1
    for (int s = 0; s < 2; ++s) {
        PHASE(17 + 2 * s, {
            const int nmt = moe_table(F, s);
            MoEDownSched S; S.tab = (const LAS int*)(F.lds + MOE_OFF); S.A = (const char*)wsp<bf16_t>(ws, A_HID1); S.Bt = (const char*)wsp<bf16_t>(ws, A_WED); S.nmt = nmt; S.c = cid; S.round = 0;
            EpiMoEDown E{F.out, wsp<int>(ws, WS_ROWTOK), wsp<float>(ws, WS_ROWGATE), s == 0 ? wsp<bf16_t>(ws, WS_XB) : nullptr};
            pg8::gemm_phase<EpiMoEDown, MoEDownSched, false>(F.tid, ring, D_FFE, S, E, nullptr);
            REFRESH(); S.round = 1; EpiPart EP{wsp<float>(ws, s ? A_WEGU2 : A_WEGU)};
            pg8::gemm_phase<EpiPart, MoEDownSched, false>(F.tid, ring, D_FFE, S, EP, nullptr); });
        PHASE(18 + 2 * s, moe_tail_reduce(F, s););
    }
#undef PHASE
#undef REPS
#undef IN
#undef SEAM
}

extern "C" void kernel_launch(void* const* d_in, const int* in_sizes, int n_in, void* d_out, int out_size, void* d_ws, size_t ws_size, hipStream_t stream) {
    static int grid = 0;
    if (grid == 0) {
        if (n_in != 38 || out_size != M_TOK * D_MODEL || ws_size < WS_END) { fprintf(stderr, "kernel_launch: unexpected shapes: n_in %d out %d ws %zu (need %zu)\n", n_in, out_size, ws_size, (size_t)WS_END); grid = -1; return; }
        int dev = 0, cus = 0;
        if (hipGetDevice(&dev) != hipSuccess || hipDeviceGetAttribute(&cus, hipDeviceAttributeMultiprocessorCount, dev) != hipSuccess) { grid = -1; return; }
        if (hipFuncSetAttribute((const void*)mk_fwd, hipFuncAttributeMaxDynamicSharedMemorySize, LDS_BYTES) != hipSuccess) { fprintf(stderr, "kernel_launch: hipFuncSetAttribute failed\n"); grid = -1; return; }
        (void)hipGetLastError();
        grid = cus;
        if (grid != 256) fprintf(stderr, "kernel_launch: note: %d CUs (built for 256)\n", grid);
    }
    if (grid < 0) return;
    (void)hipMemsetAsync((char*)d_ws + WS_CTL, 0, CTL_ZERO_BYTES, stream);
    Args a{};
    for (int i = 0; i < 38; ++i) a.in[i] = (const float*)d_in[i];
    a.out = (float*)d_out; a.ws = (unsigned char*)d_ws;
#if MK_N_LAUNCHES == 1
    a.ph_lo = 0; a.ph_hi = N_PHASES - 1 + 0;
    a.ph_hi = 21;
    hipLaunchKernelGGL(mk_fwd, dim3(grid), dim3(NWAVES * 64), LDS_BYTES, stream, a);
#else
#ifndef MK_LAST_PHASE
#define MK_LAST_PHASE 20
#endif
    for (int p = 0; p < MK_LAST_PHASE; ++p) { a.ph_lo = p; a.ph_hi = p + 1; hipLaunchKernelGGL(mk_fwd, dim3(grid), dim3(NWAVES * 64), LDS_BYTES, stream, a); }
#endif
}
```

```cpp
#include <hip/hip_runtime.h>
#include <cstdio>
#include <cstdint>

#ifndef MK_N_LAUNCHES
#define MK_N_LAUNCHES 1
#define MK_REP_MASK 0u
#define MK_REP_SUB 0u
#ifndef MK_REP_SUB
#define MK_REP_SUB 0u
#endif
#endif

#define GAS __attribute__((address_space(1)))
#define LAS __attribute__((address_space(3)))
typedef unsigned short bf16_t;
typedef short bf16x8 __attribute__((ext_vector_type(8)));
typedef short bf16x4 __attribute__((ext_vector_type(4)));
typedef float f32x4 __attribute__((ext_vector_type(4)));
typedef float f32x2 __attribute__((ext_vector_type(2)));
typedef float f32x16 __attribute__((ext_vector_type(16)));
typedef unsigned u32x4 __attribute__((ext_vector_type(4)));
typedef unsigned u32x2 __attribute__((ext_vector_type(2)));
typedef __bf16 bf16x2_t __attribute__((ext_vector_type(2)));

constexpr int D_MODEL = 1024, BATCH = 8, SEQ = 2048, M_TOK = BATCH * SEQ;
constexpr int HD = 64;
constexpr int RW_HEADS = 8, RW_DIM = 512, RW_IN = 1792;
constexpr int ATT_HEADS = 8, ATT_KV = 2;
constexpr int E_IN = 2560;
constexpr int GLA_H = 4, GLA_DK = 512, GLA_DV = 1024, GLA_DKH = 128, GLA_DVH = 256, GLA_R = 16;
constexpr int O_IN = 3088, O_INP = 3328;
constexpr int D_FF = 2816, NEXP = 8, D_FFE = 3584;
constexpr float NORM_EPS = 1e-6f;

constexpr size_t MiB = 1u << 20;
constexpr size_t WS_CTL = 0, CTL_ZERO_BYTES = 1 * MiB;
constexpr size_t WS_SSQ0 = 1 * MiB, WS_SSQ1 = 2 * MiB, WS_SSQ2 = 3 * MiB;
constexpr size_t WS_RSTD3 = 4 * MiB;
constexpr size_t WS_TOKE = WS_RSTD3 + 65536;
constexpr size_t WS_TOKG = WS_TOKE + 131072;
constexpr size_t WS_CNT = WS_TOKG + 131072;
constexpr size_t WS_TOT = WS_CNT + 16384;
constexpr size_t WS_ROWTOK = WS_TOT + 256;
constexpr int ROWS_PER_SLOT = M_TOK + 256;
constexpr size_t WS_ROWGATE = WS_ROWTOK + (size_t)2 * ROWS_PER_SLOT * 4;
constexpr size_t WS_DECS = 6 * MiB;
constexpr size_t WS_ROPE = 7 * MiB;
constexpr size_t WS_XB = 8 * MiB;
constexpr size_t WS_WIN0 = 40 * MiB, WS_WLR = 45 * MiB, WS_WOUT0 = 47 * MiB, WS_WGU0 = 49 * MiB, WS_WD0 = 60 * MiB, WS_WIN1 = 66 * MiB, WS_WOUT1 = 73 * MiB;
constexpr size_t AR = 75 * MiB;
constexpr size_t A_P0 = AR + 0, A_RS = AR + 80 * MiB, A_KS = AR + 96 * MiB, A_VS = AR + 112 * MiB, A_NKK = AR + 128 * MiB, A_AP = AR + 144 * MiB;
constexpr size_t A_QH = AR + 152 * MiB, A_KH = AR + 168 * MiB, A_VT0 = AR + 172 * MiB;
constexpr size_t A_LWF = AR + 176 * MiB, A_LWB = AR + 192 * MiB, A_SGF = AR + 208 * MiB, A_SGB = AR + 224 * MiB;
constexpr size_t A_GG = AR + 272 * MiB, A_YF = AR + 0 * MiB, A_YB = AR + 16 * MiB, A_YCAT = AR + 32 * MiB;
constexpr size_t A_HID0 = AR + 0;
constexpr size_t A_P1 = AR + 0;
constexpr size_t A_QHAT = AR + 104 * MiB, A_K2T = AR + 120 * MiB;
constexpr size_t GLA_DIR_STRIDE = 32 * MiB;
constexpr size_t A_VT1 = AR + 168 * MiB, A_OF = AR + 200 * MiB, A_OB = AR + 232 * MiB, A_GOUT = AR + 104 * MiB;
constexpr size_t A_WEGU = 40 * MiB, A_HID1 = 96 * MiB, A_WEGU2 = 339 * MiB, A_WED = 395 * MiB;
constexpr int EGU_EARLY = 4;
constexpr size_t WEGU_HI_SHIFT = A_WEGU2 - (A_WEGU + (size_t)EGU_EARLY * 14 * MiB);
constexpr int ROWS_ALL = 2 * M_TOK + 256;
constexpr size_t WS_END = 451 * MiB;
static_assert(A_WEGU + (size_t)EGU_EARLY * 14 * MiB <= A_HID1 && A_HID1 + (size_t)ROWS_ALL * D_FFE * 2 <= A_WEGU2 && A_WEGU2 >= AR + 264 * MiB && A_WEGU2 + (size_t)(NEXP - EGU_EARLY) * 14 * MiB <= A_WED && A_WED + (size_t)NEXP * 1024 * D_FFE * 2 <= WS_END && 2 * ROWS_PER_SLOT >= ROWS_ALL, "ws map");
static_assert(A_GOUT + 32 * MiB <= A_VT1 && A_YCAT + 32 * MiB <= A_RS, "ws map");

constexpr int CW_BAR = 4096;

constexpr int RING_BYTES = 131072;
constexpr int LDS_BYTES = 147456;
constexpr int MISC_OFF = LDS_BYTES - 512;
constexpr int MOE_OFF = LDS_BYTES - 256;

__device__ __forceinline__ unsigned pk2(float lo, float hi) { f32x2 v = {lo, hi}; bf16x2_t b = __builtin_convertvector(v, bf16x2_t); return __builtin_bit_cast(unsigned, b); }
__device__ __forceinline__ bf16_t f2bf(float f) { return (bf16_t)(pk2(f, 0.f) & 0xffffu); }
__device__ __forceinline__ float bf2f(bf16_t h) { return __uint_as_float(((unsigned)h) << 16); }
__device__ __forceinline__ float bflo(unsigned w) { return __uint_as_float(w << 16); }
__device__ __forceinline__ float bfhi(unsigned w) { return __uint_as_float(w & 0xffff0000u); }
__device__ __forceinline__ float wave_sum(float v) {
#pragma unroll
    for (int o = 1; o < 64; o <<= 1) v += __shfl_xor(v, o);
    return v;
}
__device__ __forceinline__ float sigmoidf_(float x) { return __builtin_amdgcn_rcpf(1.f + __expf(-x)); }
__device__ __forceinline__ float siluf_(float x) { return x * __builtin_amdgcn_rcpf(1.f + __expf(-x)); }
#define LDS_WAIT() asm volatile("s_waitcnt lgkmcnt(0)" ::: "memory")
#define VM_WAIT() asm volatile("s_waitcnt vmcnt(0)" ::: "memory")

#define XB_TMO      128
#define XB_XCNT(j)  (256  + 64 * (j))
#define XB_XSUB(j)  (1280 + 64 * (j))
#define XB_XGEN(j)  (2304 + 64 * (j))
#define XB_TOP      3328
#define XB_TOPGEN   3392
#define XCD_BAR_WORDS 3456
#define XB_SPIN_CAP (1u << 20)
__device__ __forceinline__ unsigned xb_ld(unsigned* p)              { return __hip_atomic_load(p, __ATOMIC_RELAXED, __HIP_MEMORY_SCOPE_AGENT); }
__device__ __forceinline__ unsigned xb_add(unsigned* p, unsigned v) { return __hip_atomic_fetch_add(p, v, __ATOMIC_RELAXED, __HIP_MEMORY_SCOPE_AGENT); }
__device__ __forceinline__ unsigned xb_xcc_id() { return (unsigned)__builtin_amdgcn_s_getreg((3 << 11) | 20) & 0xFu; }
#define XB_SPIN(cond, bar) do { unsigned _sp = 0; while (cond) { __builtin_amdgcn_s_sleep(1); \
    if ((++_sp & 255u) == 0u) { if (xb_ld(&(bar)[XB_TMO])) break; if (_sp > XB_SPIN_CAP) { atomicAdd(&(bar)[XB_TMO], 1u); break; } } } } while (0)
struct XcdBarrier { unsigned* bar; unsigned x; volatile LAS unsigned* st; };
__device__ __forceinline__ XcdBarrier xcd_barrier_post(unsigned* bar, volatile LAS unsigned* st) {
    XcdBarrier b; b.bar = bar; b.x = xb_xcc_id(); b.st = st;
    if (threadIdx.x == 0) (void)xb_add(&bar[XB_XCNT(b.x)], 1u);
    return b;
}
__device__ __forceinline__ void xcd_barrier_complete(unsigned* bar, unsigned x, unsigned& nloc, unsigned& nx) {
    const unsigned G = gridDim.x * gridDim.y * gridDim.z;
    unsigned sum, cnt, mine, sp = 0u;
    for (;;) {
        sum = 0u; cnt = 0u; mine = 0u;
#pragma unroll
        for (unsigned j = 0; j < 16; ++j) { const unsigned c = xb_ld(&bar[XB_XCNT(j)]); sum += c; cnt += (c > 0u) ? 1u : 0u; mine = (j == x) ? c : mine; }
        if (sum == G) break;
        __builtin_amdgcn_s_sleep(1);
        if ((++sp & 255u) == 0u) { if (xb_ld(&bar[XB_TMO])) break; if (sp > XB_SPIN_CAP) { atomicAdd(&bar[XB_TMO], 1u); break; } }
    }
    nloc = mine > 0u ? mine : 1u; nx = cnt > 0u ? cnt : 1u;
}
__device__ __forceinline__ void xcd_barrier(const XcdBarrier& b) {
    asm volatile("s_waitcnt vmcnt(0)" ::: "memory");
    __syncthreads();
    if (threadIdx.x == 0) {
        unsigned* bar = b.bar;
        __builtin_amdgcn_s_waitcnt(0);
        unsigned nloc = b.st[0], nx = b.st[1];
        if (nloc == 0u) { xcd_barrier_complete(bar, b.x, nloc, nx); b.st[0] = nloc; b.st[1] = nx; }
        const unsigned old = xb_add(&bar[XB_XSUB(b.x)], 1u);
        const unsigned gen = old / nloc;
        if (old + 1u == (gen + 1u) * nloc) {
            __builtin_amdgcn_fence(__ATOMIC_RELEASE, "agent");
            asm volatile("s_waitcnt vmcnt(0)" ::: "memory");
            const unsigned og = xb_add(&bar[XB_TOP], 1u);
            const unsigned tg = og / nx;
            if (og + 1u == (tg + 1u) * nx) xb_add(&bar[XB_TOPGEN], 1u);
            else XB_SPIN(xb_ld(&bar[XB_TOPGEN]) == tg, bar);
            __builtin_amdgcn_fence(__ATOMIC_ACQUIRE, "agent");
            xb_add(&bar[XB_XGEN(b.x)], 1u);
            asm volatile("s_waitcnt vmcnt(0)" ::: "memory");
        } else {
            XB_SPIN(xb_ld(&bar[XB_XGEN(b.x)]) == gen, bar);
            __builtin_amdgcn_fence(__ATOMIC_ACQUIRE, "agent");
            asm volatile("s_waitcnt vmcnt(0)" ::: "memory");
        }
    }
    __syncthreads();
}

namespace pg8 {
constexpr int BM = 256, BK = 64, HALF = 128, HTB = HALF * BK * 2, STAGE_BYTES = 8 * HTB, NXCD = 8, WGM = 4;
__host__ __device__ __forceinline__ int lds_byte(int r, int c) { const int st = (r >> 4) * 2 + (c >> 5), rr = r & 15, cc = c & 31, ob = rr * 64 + cc * 2; return st * 1024 + (ob ^ (((ob >> 9) & 1) << 5)); }
__host__ __device__ __forceinline__ void stage_rc(int b, int& R, int& C) { const int st = b / 1024, sb = b % 1024, swz = sb ^ (((sb >> 9) & 1) << 5); R = (st >> 1) * 16 + swz / 64; C = (st & 1) * 32 + (swz % 64) / 2; }
__host__ __device__ __forceinline__ int perm32(int rho) { const int n = rho >> 4, i = rho & 15; return 8 * (i >> 2) + 4 * n + (i & 3); }

struct Unit { const char* a; const char* b; int pm, pn; int row0, nrows, e; int nt, flags; int rot; };

struct GridOrder {
    int nM, nN, nwg, G, c;
    __device__ void init(int nM_, int nN_, int G_, int c_) { nM = nM_; nN = nN_; nwg = nM * nN; G = G_; c = c_; }
    __device__ bool tile(int i, int& pm, int& pn) const {
        const long L = (long)i * G + c; if (L >= nwg) return false;
        int wgid = (int)L; { const int q = nwg / NXCD, r = nwg % NXCD, xcd = wgid % NXCD, off = wgid / NXCD; wgid = (xcd < r ? xcd * (q + 1) : r * (q + 1) + (xcd - r) * q) + off; }
        const int nig = WGM * nN, gid = wgid / nig, fm = gid * WGM, gsz = (nM - fm) < WGM ? (nM - fm) : WGM;
        pm = fm + ((wgid % nig) % gsz); pn = (wgid % nig) / gsz; return true;
    }
};
struct DenseSched {
    GridOrder go; const char* A; const char* Bt; size_t tstep; int nt_;
    __device__ void init(const bf16_t* A_, const bf16_t* Bt_, int M, int N, int K, int G, int c) { go.init(M / BM, N / BM, G, c); A = (const char*)A_; Bt = (const char*)Bt_; tstep = (size_t)BM * K * 2; nt_ = K / BK; }
    __device__ bool next(int i, Unit& u) const { int pm, pn; if (!go.tile(i, pm, pn)) return false; u.pm = pm; u.pn = pn; u.a = A + (size_t)pm * tstep; u.b = Bt + (size_t)pn * tstep; u.row0 = pm * BM; u.nrows = BM; u.e = 0; u.nt = nt_; u.flags = 0; u.rot = 0; return true; }
};

template <class Epi, class Sched, bool GATHER>
__device__ __forceinline__ void gemm_phase(const int tid, LAS unsigned char* lds, const int K_, const Sched& S, const Epi& E, const int* gather_rows) {
    int K = K_; asm volatile("" : "+s"(K));
    const int wid = __builtin_amdgcn_readfirstlane(tid >> 6), lane = tid & 63, wr = wid >> 2, wc = wid & 3, fr = lane & 15, fq = lane >> 4;
    int sR[2], sC[2];
    unsigned voffB[2];
#pragma unroll
    for (int i = 0; i < 2; ++i) { int R, C; stage_rc(tid * 16 + i * 8192, R, C); sR[i] = R; sC[i] = C; const int Rb = Epi::PERM ? ((R & ~31) + perm32(R & 31)) : R; voffB[i] = (unsigned)(Rb * K + C) * 2u; }
    const size_t kstep = (size_t)(BK * 2);
    const size_t hstep = (size_t)HALF * K * 2;
    const unsigned ldsw = (unsigned)wid * 1024u;
    const int aoff = lds_byte(wr * 64 + fr, fq * 8), boff = lds_byte(wc * 32 + fr, fq * 8);
    unsigned cva[2][2], nva[2][2];
#define PG8_SETVA(va, u) do { _Pragma("unroll") for (int h_ = 0; h_ < 2; ++h_) _Pragma("unroll") for (int i_ = 0; i_ < 2; ++i_) { \
        if (GATHER) { int rr_ = (u).row0 + h_ * HALF + sR[i_]; const int rmax_ = (u).row0 + (u).nrows - 1; rr_ = rr_ > rmax_ ? rmax_ : rr_; int tk_ = gather_rows[rr_]; tk_ = tk_ < 0 ? 0 : (tk_ > 16383 ? 16383 : tk_); va[h_][i_] = (unsigned)(tk_ * K + sC[i_]) * 2u; } \
        else va[h_][i_] = (unsigned)((h_ * HALF + sR[i_]) * K + sC[i_]) * 2u; } } while (0)
#define PG8_SA(b, h) (((b) * 2 + (h)) * HTB)
#define PG8_SB(b, h) ((4 + (b) * 2 + (h)) * HTB)
#define PG8_STAGE2(bufoff, gbase, v0, v1) do { \
        __builtin_amdgcn_global_load_lds((const unsigned*)((const char*)(gbase) + (v0)), (LAS unsigned*)(lds + (bufoff) + ldsw), 16, 0, 0); \
        __builtin_amdgcn_global_load_lds((const unsigned*)((const char*)(gbase) + (v1)), (LAS unsigned*)(lds + (bufoff) + ldsw + 8192), 16, 0, 0); } while (0)
#define PG8_STAGEB(bufoff, gbase) PG8_STAGE2(bufoff, gbase, voffB[0], voffB[1])
#define PG8_STAGEA(bufoff, gbase, va, h) PG8_STAGE2(bufoff, gbase, va[h][0], va[h][1])
#define PG8_LDA(dst, b, h) do { _Pragma("unroll") for (int m = 0; m < 4; ++m) _Pragma("unroll") for (int k = 0; k < 2; ++k) dst[m][k] = *(const LAS bf16x8*)(lds + PG8_SA(b, h) + aoff + m * 2048 + k * 1024); } while (0)
#define PG8_LDB(dst, b, h) do { _Pragma("unroll") for (int n = 0; n < 2; ++n) _Pragma("unroll") for (int k = 0; k < 2; ++k) dst[n][k] = *(const LAS bf16x8*)(lds + PG8_SB(b, h) + boff + n * 2048 + k * 1024); } while (0)
#define PG8_MMA(ai, bj, At, Bt) do { __builtin_amdgcn_s_setprio(1); _Pragma("unroll") for (int m = 0; m < 4; ++m) _Pragma("unroll") for (int n = 0; n < 2; ++n) _Pragma("unroll") for (int k = 0; k < 2; ++k) \
        acc[ai][bj][m][n] = __builtin_amdgcn_mfma_f32_16x16x32_bf16(Bt[n][k], At[m][k], acc[ai][bj][m][n], 0, 0, 0); __builtin_amdgcn_s_setprio(0); } while (0)
#define PG8_WAIT_V(n) asm volatile("s_waitcnt vmcnt(" #n ")" ::: "memory")
#define PG8_WAIT_L(n) asm volatile("s_waitcnt lgkmcnt(" #n ")" ::: "memory")
#define PG8_BAR __builtin_amdgcn_s_barrier()
#define PG8_SCHED __builtin_amdgcn_sched_barrier(0)
    Unit cur, nxt; int ui = 0;
    if (!S.next(0, cur)) return;
    PG8_SETVA(cva, cur);
    f32x4 acc[2][2][4][2];
#pragma unroll
    for (int a = 0; a < 2; ++a)
#pragma unroll
        for (int b = 0; b < 2; ++b)
#pragma unroll
            for (int m = 0; m < 4; ++m)
#pragma unroll
                for (int n = 0; n < 2; ++n) acc[a][b][m][n] = (f32x4){0.f, 0.f, 0.f, 0.f};
    bf16x8 At[4][2], B0[2][2], B1[2][2];
    const char* cA = cur.a; const char* cB = cur.b;
    const char* pA = cA + (size_t)cur.rot * kstep; const char* pB = cB + (size_t)cur.rot * kstep;
    PG8_STAGEB(PG8_SB(0, 0), pB); PG8_STAGEB(PG8_SB(0, 1), pB + hstep); PG8_STAGEA(PG8_SA(0, 0), pA, cva, 0); PG8_STAGEA(PG8_SA(0, 1), pA, cva, 1);
    if (wr == 1) PG8_BAR;
    PG8_WAIT_V(2); PG8_BAR;
    PG8_STAGEB(PG8_SB(1, 0), pB + kstep); PG8_STAGEA(PG8_SA(1, 0), pA + kstep, cva, 0); PG8_STAGEB(PG8_SB(1, 1), pB + hstep + kstep);
    PG8_WAIT_V(6); PG8_BAR;
    for (;;) {
        const bool has_next = S.next(ui + 1, nxt);
        if (has_next) PG8_SETVA(nva, nxt);
        else {
#pragma unroll
            for (int h = 0; h < 2; ++h)
#pragma unroll
                for (int i = 0; i < 2; ++i) nva[h][i] = cva[h][i];
        }
        const char* nA = has_next ? nxt.a : cA; const char* nB = has_next ? nxt.b : cB;
        const char* nsA = has_next ? nA + (size_t)nxt.rot * kstep : pA; const char* nsB = has_next ? nB + (size_t)nxt.rot * kstep : pB;
        const int nt = cur.nt; const int wrap_t = nt - 2 - cur.rot;
        for (int t = 0; t < nt; t += 2) {
            const bool last = (t == nt - 2);
            const char* a1 = pA + kstep;
            const char* pA2 = (t == wrap_t) ? cA : pA + 2 * kstep; const char* pB2 = (t == wrap_t) ? cB : pB + 2 * kstep;
            const char* a2 = last ? nsA : pA2; const char* b2 = last ? nsB : pB2;
            const char* a3 = a2 + kstep; const char* b3 = b2 + kstep;
            pA = pA2; pB = pB2;
            unsigned va2[2][2];
#pragma unroll
            for (int h = 0; h < 2; ++h)
#pragma unroll
                for (int i = 0; i < 2; ++i) va2[h][i] = (GATHER && last) ? nva[h][i] : cva[h][i];
            PG8_LDB(B0, 0, 0); PG8_LDB(B1, 0, 1); PG8_SCHED; PG8_LDA(At, 0, 0); PG8_STAGEA(PG8_SA(1, 1), a1, cva, 1);
            PG8_WAIT_V(8); PG8_WAIT_L(0); PG8_BAR; PG8_MMA(0, 0, At, B0); PG8_MMA(0, 1, At, B1); PG8_BAR; PG8_SCHED;
            PG8_LDA(At, 0, 1); PG8_STAGEB(PG8_SB(0, 0), b2); PG8_STAGEB(PG8_SB(0, 1), b2 + hstep); PG8_STAGEA(PG8_SA(0, 0), a2, va2, 0);
            PG8_WAIT_V(8); PG8_WAIT_L(0); PG8_BAR; PG8_MMA(1, 0, At, B0); PG8_MMA(1, 1, At, B1); PG8_BAR; PG8_SCHED;
            PG8_LDB(B0, 1, 0); PG8_LDB(B1, 1, 1); PG8_SCHED; PG8_LDA(At, 1, 0); PG8_STAGEA(PG8_SA(0, 1), a2, va2, 1);
            PG8_WAIT_V(8); PG8_WAIT_L(0); PG8_BAR; PG8_MMA(0, 0, At, B0); PG8_MMA(0, 1, At, B1); PG8_BAR; PG8_SCHED;
            PG8_LDA(At, 1, 1); PG8_STAGEB(PG8_SB(1, 0), b3); PG8_STAGEB(PG8_SB(1, 1), b3 + hstep); PG8_STAGEA(PG8_SA(1, 0), a3, va2, 0);
            PG8_WAIT_V(8); PG8_WAIT_L(0); PG8_BAR; PG8_MMA(1, 0, At, B0); PG8_MMA(1, 1, At, B1); PG8_BAR; PG8_SCHED;
        }
        if (wr == 0) PG8_BAR;
        E(acc, cur, wr, wc, fr, fq);
#if ((MK_REP_SUB) >> 5) & 1
        if constexpr (Epi::PURE) { asm volatile("" ::: "memory"); E(acc, cur, wr, wc, fr, fq); }
#endif
        if (!has_next) break;
#pragma unroll
        for (int a = 0; a < 2; ++a)
#pragma unroll
            for (int b = 0; b < 2; ++b)
#pragma unroll
                for (int m = 0; m < 4; ++m)
#pragma unroll
                    for (int n = 0; n < 2; ++n) acc[a][b][m][n] = (f32x4){0.f, 0.f, 0.f, 0.f};
        cur = nxt; cA = nA; cB = nB; pA = nsA; pB = nsB; ++ui;
#pragma unroll
        for (int h = 0; h < 2; ++h)
#pragma unroll
            for (int i = 0; i < 2; ++i) cva[h][i] = nva[h][i];
        if (wr == 1) PG8_BAR;
    }
    PG8_WAIT_V(0);
    PG8_BAR;
#undef PG8_SETVA
#undef PG8_SA
#undef PG8_SB
#undef PG8_STAGE2
#undef PG8_STAGEA
#undef PG8_STAGEB
#undef PG8_LDA
#undef PG8_LDB
#undef PG8_MMA
#undef PG8_WAIT_V
#undef PG8_WAIT_L
#undef PG8_BAR
#undef PG8_SCHED
}
}

__device__ __forceinline__ float rstd_from_ssq(const float* ssq, int row) {
    const f32x4* p = (const f32x4*)(ssq + (size_t)row * 16);
    const f32x4 a = p[0], b = p[1], c = p[2], d = p[3];
    const float s = (((a.x + a.y) + (a.z + a.w)) + ((b.x + b.y) + (b.z + b.w))) + (((c.x + c.y) + (c.z + c.w)) + ((d.x + d.y) + (d.z + d.w)));
    return __builtin_amdgcn_rsqf(s * (1.f / 1024.f) + NORM_EPS);
}
__device__ __forceinline__ u32x4 pack8(const f32x4 v0, const f32x4 v1) { u32x4 w; w.x = pk2(v0[0], v0[1]); w.y = pk2(v0[2], v0[3]); w.z = pk2(v1[0], v1[1]); w.w = pk2(v1[2], v1[3]); return w; }
__device__ __forceinline__ void unpack8(const u32x4 w, float (&f)[8]) { f[0] = bflo(w.x); f[1] = bfhi(w.x); f[2] = bflo(w.y); f[3] = bfhi(w.y); f[4] = bflo(w.z); f[5] = bfhi(w.z); f[6] = bflo(w.w); f[7] = bfhi(w.w); }
__device__ __forceinline__ u32x4 pack8f(const float (&f)[8]) { u32x4 w; w.x = pk2(f[0], f[1]); w.y = pk2(f[2], f[3]); w.z = pk2(f[4], f[5]); w.w = pk2(f[6], f[7]); return w; }

__device__ __forceinline__ void swap16(f32x4& x, f32x4& y) {
#pragma unroll
    for (int i = 0; i < 4; ++i) { const auto r = __builtin_amdgcn_permlane16_swap(__float_as_uint(x[i]), __float_as_uint(y[i]), false, false); x[i] = __uint_as_float(r[0]); y[i] = __uint_as_float(r[1]); }
}
struct EpiScaleBf16 {
    static constexpr bool PERM = true; static constexpr bool PURE = true;
    bf16_t* O; int ldc; const float* ssq;
    __device__ __forceinline__ void operator()(const f32x4 (&acc)[2][2][4][2], const pg8::Unit& u, int wr, int wc, int fr, int fq) const {
        const int row0 = u.pm * 256 + wr * 64 + fr, col0 = u.pn * 256 + wc * 32 + 8 * fq;
#pragma unroll
        for (int ai = 0; ai < 2; ++ai)
#pragma unroll
            for (int m = 0; m < 4; ++m) { const int row = row0 + ai * 128 + m * 16; const float rs = rstd_from_ssq(ssq, row); bf16_t* rowp = O + (size_t)row * ldc + col0;
#pragma unroll
                for (int bj = 0; bj < 2; ++bj) *(u32x4*)(rowp + bj * 128) = pack8(acc[ai][bj][m][0] * rs, acc[ai][bj][m][1] * rs); }
    }
};
struct EpiResid {
    static constexpr bool PERM = true; static constexpr bool PURE = false;
    const float* base; float* out; bf16_t* xb; float* ssq;
    __device__ __forceinline__ void operator()(const f32x4 (&acc)[2][2][4][2], const pg8::Unit& u, int wr, int wc, int fr, int fq) const {
        const int row0 = u.pm * 256 + wr * 64 + fr, col0 = u.pn * 256 + wc * 32 + 8 * fq;
#pragma unroll
        for (int ai = 0; ai < 2; ++ai)
#pragma unroll
            for (int m = 0; m < 4; ++m) { const int row = row0 + ai * 128 + m * 16; const size_t off = (size_t)row * 1024 + col0; float ss = 0.f;
#pragma unroll
                for (int bj = 0; bj < 2; ++bj) { const f32x4 b0 = *(const f32x4*)(base + off + bj * 128), b1 = *(const f32x4*)(base + off + bj * 128 + 4);
                    const f32x4 o0 = b0 + acc[ai][bj][m][0], o1 = b1 + acc[ai][bj][m][1];
                    *(f32x4*)(out + off + bj * 128) = o0; *(f32x4*)(out + off + bj * 128 + 4) = o1;
                    ss += (o0[0] * o0[0] + o0[1] * o0[1]) + (o0[2] * o0[2] + o0[3] * o0[3]) + (o1[0] * o1[0] + o1[1] * o1[1]) + (o1[2] * o1[2] + o1[3] * o1[3]);
                    *(u32x4*)(xb + off + bj * 128) = pack8(o0, o1); }
                ss += __shfl_xor(ss, 16); ss += __shfl_xor(ss, 32);
                if (ssq && fq == 0) ssq[(size_t)row * 16 + u.pn * 4 + wc] = ss; }
    }
};
struct EpiResidBf {
    static constexpr bool PERM = true; static constexpr bool PURE = false;
    bf16_t* xb; float* out; float* ssq;
    __device__ __forceinline__ void operator()(const f32x4 (&acc)[2][2][4][2], const pg8::Unit& u, int wr, int wc, int fr, int fq) const {
        const int row0 = u.pm * 256 + wr * 64 + fr, col0 = u.pn * 256 + wc * 32 + 8 * fq;
#pragma unroll
        for (int ai = 0; ai < 2; ++ai)
#pragma unroll
            for (int m = 0; m < 4; ++m) { const int row = row0 + ai * 128 + m * 16; const size_t off = (size_t)row * 1024 + col0; float ss = 0.f;
#pragma unroll
                for (int bj = 0; bj < 2; ++bj) { const u32x4 bw = *(const u32x4*)(xb + off + bj * 128);
                    const f32x4 b0 = {bflo(bw.x), bfhi(bw.x), bflo(bw.y), bfhi(bw.y)}, b1 = {bflo(bw.z), bfhi(bw.z), bflo(bw.w), bfhi(bw.w)};
                    const f32x4 o0 = b0 + acc[ai][bj][m][0], o1 = b1 + acc[ai][bj][m][1];
                    if (out) { *(f32x4*)(out + off + bj * 128) = o0; *(f32x4*)(out + off + bj * 128 + 4) = o1; }
                    ss += (o0[0] * o0[0] + o0[1] * o0[1]) + (o0[2] * o0[2] + o0[3] * o0[3]) + (o1[0] * o1[0] + o1[1] * o1[1]) + (o1[2] * o1[2] + o1[3] * o1[3]);
                    *(u32x4*)(xb + off + bj * 128) = pack8(o0, o1); }
                ss += __shfl_xor(ss, 16); ss += __shfl_xor(ss, 32);
                if (ssq && fq == 0) ssq[(size_t)row * 16 + u.pn * 4 + wc] = ss; }
    }
};
struct EpiSwiGLU {
    static constexpr bool PERM = true; static constexpr bool PURE = true;
    bf16_t* H; int ldh; const float* ssq;
    __device__ __forceinline__ void operator()(const f32x4 (&acc)[2][2][4][2], const pg8::Unit& u, int wr, int wc, int fr, int fq) const {
        const int row0 = u.pm * 256 + wr * 64 + fr, hcol0 = u.pn * 128 + wc * 32 + 8 * fq;
#pragma unroll
        for (int ai = 0; ai < 2; ++ai)
#pragma unroll
            for (int m = 0; m < 4; ++m) { const int row = row0 + ai * 128 + m * 16; const float rs = rstd_from_ssq(ssq, row);
                f32x4 h[2];
#pragma unroll
                for (int n = 0; n < 2; ++n) { const f32x4 g = acc[ai][0][m][n] * rs, up = acc[ai][1][m][n] * rs;
#pragma unroll
                    for (int i = 0; i < 4; ++i) h[n][i] = siluf_(g[i]) * up[i]; }
                *(u32x4*)(H + (size_t)row * ldh + hcol0) = pack8(h[0], h[1]); }
    }
};
struct EpiSwiGLUMoE {
    static constexpr bool PERM = true; static constexpr bool PURE = true;
    bf16_t* H; const float* rstd3; const int* row_tok;
    __device__ __forceinline__ void operator()(const f32x4 (&acc)[2][2][4][2], const pg8::Unit& u, int wr, int wc, int fr, int fq) const {
        const int hcol0 = u.pn * 128 + wc * 32 + 8 * fq;
#pragma unroll
        for (int ai = 0; ai < 2; ++ai)
#pragma unroll
            for (int m = 0; m < 4; ++m) { const int rl = ai * 128 + wr * 64 + m * 16 + fr;
                if (rl < u.nrows) { const int grow = u.row0 + rl; const float rs = rstd3[row_tok[grow] & 16383];
                    f32x4 h[2];
#pragma unroll
                    for (int n = 0; n < 2; ++n) { const f32x4 g = acc[ai][0][m][n] * rs, up = acc[ai][1][m][n] * rs;
#pragma unroll
                        for (int i = 0; i < 4; ++i) h[n][i] = siluf_(g[i]) * up[i]; }
                    *(u32x4*)(H + (size_t)grow * D_FFE + hcol0) = pack8(h[0], h[1]); } }
    }
};
struct EpiMoEDown {
    static constexpr bool PERM = true; static constexpr bool PURE = false;
    float* out; const int* row_tok; const float* row_gate; bf16_t* xb; bool last;
    __device__ __forceinline__ void operator()(const f32x4 (&acc)[2][2][4][2], const pg8::Unit& u, int wr, int wc, int fr, int fq) const {
        if (last) {
            const int col0 = u.pn * 256 + wc * 32 + 8 * (fq & ~1) + 4 * (fq & 1);
#pragma unroll
            for (int ai = 0; ai < 2; ++ai)
#pragma unroll
                for (int m = 0; m < 4; ++m) { const int rl = ai * 128 + wr * 64 + m * 16 + fr;
                    if (rl < u.nrows) { const int grow = u.row0 + rl; const int tok = row_tok[grow] & 16383; const float gt = row_gate[grow]; const size_t o = (size_t)tok * 1024 + col0;
#pragma unroll
                        for (int bj = 0; bj < 2; ++bj) { const u32x2 w0 = *(const u32x2*)(xb + o + bj * 128), w1 = *(const u32x2*)(xb + o + bj * 128 + 8);
                            f32x4 p0 = acc[ai][bj][m][0] * gt, p1 = acc[ai][bj][m][1] * gt; swap16(p0, p1);
                            const f32x4 b0 = {bflo(w0.x), bfhi(w0.x), bflo(w0.y), bfhi(w0.y)}, b1 = {bflo(w1.x), bfhi(w1.x), bflo(w1.y), bfhi(w1.y)};
                            *(f32x4*)(out + o + bj * 128) = b0 + p0; *(f32x4*)(out + o + bj * 128 + 8) = b1 + p1; } } }
        } else {
            const int col0 = u.pn * 256 + wc * 32 + 8 * fq;
#pragma unroll
            for (int ai = 0; ai < 2; ++ai)
#pragma unroll
                for (int m = 0; m < 4; ++m) { const int rl = ai * 128 + wr * 64 + m * 16 + fr;
                    if (rl < u.nrows) { const int grow = u.row0 + rl; const int tok = row_tok[grow] & 16383; const float gt = row_gate[grow]; bf16_t* xp = xb + (size_t)tok * 1024 + col0;
#pragma unroll
                        for (int bj = 0; bj < 2; ++bj) { const u32x4 bw = *(const u32x4*)(xp + bj * 128);
                            const f32x4 b0 = {bflo(bw.x), bfhi(bw.x), bflo(bw.y), bfhi(bw.y)}, b1 = {bflo(bw.z), bfhi(bw.z), bflo(bw.w), bfhi(bw.w)};
                            *(u32x4*)(xp + bj * 128) = pack8(b0 + acc[ai][bj][m][0] * gt, b1 + acc[ai][bj][m][1] * gt); } } }
        }
    }
};
struct EpiPart {
    static constexpr bool PERM = true; static constexpr bool PURE = true;
    float* part;
    __device__ __forceinline__ void operator()(const f32x4 (&acc)[2][2][4][2], const pg8::Unit& u, int wr, int wc, int fr, int fq) const {
        float* pb = part + (size_t)(u.flags - 1) * 65536; const unsigned o0 = (unsigned)((wr * 64 + fr) * 256 + wc * 32 + 8 * (fq & ~1) + 4 * (fq & 1));
#pragma unroll
        for (int ai = 0; ai < 2; ++ai)
#pragma unroll
            for (int m = 0; m < 4; ++m)
#pragma unroll
                for (int bj = 0; bj < 2; ++bj) { float* pp = pb + o0 + (ai * 128 + m * 16) * 256 + bj * 128; f32x4 p0 = acc[ai][bj][m][0], p1 = acc[ai][bj][m][1]; swap16(p0, p1); *(f32x4*)pp = p0; *(f32x4*)(pp + 8) = p1; }
    }
};
struct LowRankSched {
    pg8::GridOrder go; const char* A; const char* Bt;
    __device__ void init(const bf16_t* A_, const bf16_t* Bt_, int G, int c) { go.init(M_TOK / 256, 8, G, c); A = (const char*)A_; Bt = (const char*)Bt_; }
    __device__ bool next(int i, pg8::Unit& u) const { int pm, pn; if (!go.tile(i, pm, pn)) return false; u.pm = pm; u.pn = pn; u.a = A + (size_t)pm * (256 * 256 * 2); u.b = Bt + (size_t)pn * (256 * 256 * 2);
        u.row0 = pm * 256; u.nrows = 256; u.e = 0; int two = 2; asm volatile("" : "+s"(two)); u.nt = two; u.flags = 0; u.rot = 0; return true; }
};
struct EpiLowRank {
    static constexpr bool PERM = true; static constexpr bool PURE = true;
    unsigned char* ws; const float* const* in;
    __device__ __forceinline__ void operator()(const f32x4 (&acc)[2][2][4][2], const pg8::Unit& u, int wr, int wc, int fr, int fq) const {
        const int kind = u.pn >> 1; const int row0 = u.pm * 256 + wr * 64 + fr; const int c0 = (u.pn & 1) * 256 + wc * 32 + 8 * fq;
        const float* zp = in[kind == 0 ? 4 : kind == 1 ? 6 : kind == 2 ? 8 : 10];
        bf16_t* o1 = (bf16_t*)(ws + (kind == 0 ? A_LWF : kind == 1 ? A_LWB : kind == 2 ? A_SGF : A_SGB));
        const float sc = kind < 2 ? -0.87506126f : 1.f;
#pragma unroll
        for (int bj = 0; bj < 2; ++bj) { const int c = c0 + bj * 128;
            const f32x4 z0 = *(const f32x4*)(zp + c), z1 = *(const f32x4*)(zp + c + 4);
#pragma unroll
            for (int ai = 0; ai < 2; ++ai)
#pragma unroll
                for (int m = 0; m < 4; ++m) { const int row = row0 + ai * 128 + m * 16; f32x4 v0 = acc[ai][bj][m][0] + z0, v1 = acc[ai][bj][m][1] + z1;
#pragma unroll
                    for (int i = 0; i < 4; ++i) { v0[i] = sc * sigmoidf_(v0[i]); v1[i] = sc * sigmoidf_(v1[i]); }
                    *(u32x4*)(o1 + (size_t)row * 512 + c) = pack8(v0, v1); } }
    }
};

constexpr int NWAVES = 8;
struct Args { const float* in[38]; float* out; unsigned char* ws; int ph_lo, ph_hi; };
struct Frame {
    LAS unsigned char* lds; unsigned char* ws; const float* const* in; float* out;
    int tid, lane, wave, vcu, G;
};
template <class T> __device__ __forceinline__ T* wsp(unsigned char* ws, size_t off) { return (T*)(ws + off); }

__device__ __forceinline__ void conv_item(const float* W, int ldw, int k0, int n0, int ncols, const float* gain, bf16_t* WT, int ldk, int dst_row0, LAS float* scr, int lane) {
#pragma unroll
    for (int i = 0; i < 8; ++i) { const int kk = (lane >> 3) + 8 * i, c4 = 4 * (lane & 7);
        f32x4 v = __builtin_nontemporal_load((const f32x4*)(W + (size_t)(k0 + kk) * ldw + n0 + c4));
        if (gain) v = v * gain[k0 + kk];
        scr[kk * 33 + c4 + 0] = v[0]; scr[kk * 33 + c4 + 1] = v[1]; scr[kk * 33 + c4 + 2] = v[2]; scr[kk * 33 + c4 + 3] = v[3]; }
    LDS_WAIT(); asm volatile("" ::: "memory");
    const int c = lane & 7;
#pragma unroll
    for (int j = 0; j < 4; ++j) { const int n = (lane >> 3) + 8 * j; const LAS float* s = scr + (8 * c) * 33 + n;
        u32x4 o; o.x = pk2(s[0 * 33], s[1 * 33]); o.y = pk2(s[2 * 33], s[3 * 33]); o.z = pk2(s[4 * 33], s[5 * 33]); o.w = pk2(s[6 * 33], s[7 * 33]);
        if (n < ncols) *(u32x4*)(WT + (size_t)(dst_row0 + n) * ldk + k0 + 8 * c) = o; }
    LDS_WAIT(); asm volatile("" ::: "memory");
}
__device__ __forceinline__ void conv_job_item(int r, const float* W, int ldw, int col0, int nblk, int ncols_last, const float* gain, bf16_t* WT, int ldk, int mode, int dst_off, LAS float* scr, int lane) {
    const int kb = r / nblk, nb = r % nblk; const int nrel = 32 * nb;
    int drow = dst_off + nrel; if (mode) drow = 256 * (nrel >> 7) + (nrel & 127) + (mode == 2 ? 128 : 0);
    conv_item(W, ldw, 64 * kb, col0 + nrel, (nb == nblk - 1) ? ncols_last : 32, gain, WT, ldk, drow, scr, lane);
}
struct ConvItem { const float* src; const float* gain; bf16_t* dst; int ldw, ldk, ncols; };
__device__ __forceinline__ ConvItem conv_desc(int r, const float* W, int ldw, int col0, int nblk, int ncols_last, const float* gain, bf16_t* WT, int ldk, int mode, int dst_off) {
    const int kb = r / nblk, nb = r % nblk; const int nrel = 32 * nb;
    int drow = dst_off + nrel; if (mode) drow = 256 * (nrel >> 7) + (nrel & 127) + (mode == 2 ? 128 : 0);
    ConvItem c; c.src = W + (size_t)(64 * kb) * ldw + col0 + nrel; c.gain = gain ? gain + 64 * kb : nullptr; c.dst = WT + (size_t)drow * ldk + 64 * kb; c.ldw = ldw; c.ldk = ldk; c.ncols = (nb == nblk - 1) ? ncols_last : 32; return c;
}
__device__ __forceinline__ void conv_ld(f32x4 (&v)[8], const ConvItem& c, int lane) {
#pragma unroll
    for (int i = 0; i < 8; ++i) { const int kk = (lane >> 3) + 8 * i, c4 = 4 * (lane & 7); v[i] = __builtin_nontemporal_load((const f32x4*)(c.src + (size_t)kk * c.ldw + c4)); }
}
typedef short v4i16_t __attribute__((ext_vector_type(4)));
__device__ __forceinline__ void conv_fin(const f32x4 (&v)[8], const ConvItem& c, LAS float* scr, int lane) {
#pragma unroll
    for (int i = 0; i < 8; ++i) { const int kk = (lane >> 3) + 8 * i, c4 = 4 * (lane & 7); f32x4 x = v[i]; if (c.gain) x = x * c.gain[kk];
        scr[kk * 33 + c4 + 0] = x[0]; scr[kk * 33 + c4 + 1] = x[1]; scr[kk * 33 + c4 + 2] = x[2]; scr[kk * 33 + c4 + 3] = x[3]; }
    LDS_WAIT(); asm volatile("" ::: "memory");
    const int cc = lane & 7;
#pragma unroll
    for (int j = 0; j < 4; ++j) { const int n = (lane >> 3) + 8 * j; const LAS float* sp = scr + (8 * cc) * 33 + n;
        u32x4 o; o.x = pk2(sp[0 * 33], sp[1 * 33]); o.y = pk2(sp[2 * 33], sp[3 * 33]); o.z = pk2(sp[4 * 33], sp[5 * 33]); o.w = pk2(sp[6 * 33], sp[7 * 33]);
        if (n < c.ncols) *(u32x4*)(c.dst + (size_t)n * c.ldk + 8 * cc) = o; }
    LDS_WAIT(); asm volatile("" ::: "memory");
}
template <class D> __device__ __forceinline__ void conv_run(const D& d, int w, int nw, int nitems, LAS float* scr, int lane) {
    f32x4 va[8], vb[8];
    int it = w; if (it >= nitems) return;
    ConvItem ca = d(it), cb = ca; conv_ld(va, ca, lane);
    for (;;) {
        const int it2 = it + nw; const bool h2 = it2 < nitems;
        if (h2) { cb = d(it2); conv_ld(vb, cb, lane); }
        conv_fin(va, ca, scr, lane);
        if (!h2) break;
        const int it3 = it2 + nw; const bool h3 = it3 < nitems;
        if (h3) { ca = d(it3); conv_ld(va, ca, lane); }
        conv_fin(vb, cb, scr, lane);
        if (!h3) break;
        it = it3;
    }
}
struct ConvG0 { const float* const* in; unsigned char* ws; __device__ __forceinline__ ConvItem operator()(int r) const { return conv_desc(r, in[2], 2560, 0, 80, 32, in[1], wsp<bf16_t>(ws, WS_WIN0), 1024, 0, 0); } };
struct ConvG1 { const float* const* in; unsigned char* ws; __device__ __forceinline__ ConvItem operator()(int it) const { constexpr int I1 = 16 * 32, I2 = 16 * 88; int r = it;
    if (r < I1) return conv_desc(r, in[20], 1024, 0, 32, 32, nullptr, wsp<bf16_t>(ws, WS_WOUT0), 1024, 0, 0); r -= I1;
    if (r < I2) return conv_desc(r, in[22], 2816, 0, 88, 32, in[21], wsp<bf16_t>(ws, WS_WGU0), 1024, 1, 0); r -= I2;
    if (r < I2) return conv_desc(r, in[23], 2816, 0, 88, 32, in[21], wsp<bf16_t>(ws, WS_WGU0), 1024, 2, 0); r -= I2;
    return conv_desc(r, in[24], 1024, 0, 32, 32, nullptr, wsp<bf16_t>(ws, WS_WD0), 2816, 0, 0); } };
struct ConvG2 { const float* const* in; unsigned char* ws; __device__ __forceinline__ ConvItem operator()(int it) const { constexpr int I5 = 16 * 64, I6 = 16 * 32, I7 = 16; int r = it;
    if (r < I5) return conv_desc(r, in[26], 3088, 0, 64, 32, in[25], wsp<bf16_t>(ws, WS_WIN1), 1024, 0, 0); r -= I5;
    if (r < I6) return conv_desc(r, in[26], 3088, 2064, 32, 32, in[25], wsp<bf16_t>(ws, WS_WIN1), 1024, 0, 2048); r -= I6;
    if (r < I7) return conv_desc(r, in[26], 3088, 2048, 1, 16, in[25], wsp<bf16_t>(ws, WS_WIN1), 1024, 0, 3072); r -= I7;
    return conv_desc(r, in[32], 1024, 0, 32, 32, nullptr, wsp<bf16_t>(ws, WS_WOUT1), 1024, 0, 0); } };
__device__ __forceinline__ void conv_group(const Frame& F, int group, int w, int nw) {
    LAS float* scr = (LAS float*)(F.lds + F.wave * 16384); const int lane = F.lane;
    if (group == 0) { ConvG0 d{F.in, F.ws}; conv_run(d, w, nw, 16 * 80, scr, lane); }
    else if (group == 1) { ConvG1 d{F.in, F.ws}; conv_run(d, w, nw, 16 * 32 + 2 * 16 * 88 + 44 * 32, scr, lane); }
    else { ConvG2 d{F.in, F.ws}; conv_run(d, w, nw, 16 * 64 + 16 * 32 + 16 + 16 * 32, scr, lane); }
}
__device__ __forceinline__ void phase_prologue(const Frame& F) {
    const int gw = F.vcu * NWAVES + F.wave, NGW = F.G * NWAVES, lane = F.lane;
    unsigned char* ws = F.ws;
    conv_group(F, 0, gw, NGW);
    if (F.G < 256) { conv_group(F, 1, gw, NGW); conv_group(F, 2, gw, NGW); }
    const int gt = F.vcu * 512 + F.tid, NGT = F.G * 512;
    { bf16_t* wlr = wsp<bf16_t>(ws, WS_WLR);
      for (int i = gt; i < 2560 * 256; i += NGT) { const int n = i >> 8, k = i & 255; float v = 0.f;
          if (n < 512)       { if (k < 64) v = F.in[5][k * 512 + n]; }
          else if (n < 1024) { if (k < 64) v = F.in[7][k * 512 + (n - 512)]; }
          else if (n < 1536) { if (k >= 64 && k < 128) v = F.in[9][(k - 64) * 512 + (n - 1024)]; }
          else if (n < 2048) { if (k >= 64 && k < 128) v = F.in[11][(k - 64) * 512 + (n - 1536)]; }
          else               { if (k >= 128) v = F.in[12][(k - 128) * 512 + (n - 2048)]; }
          wlr[i] = f2bf(v); } }
    { f32x2* rt = wsp<f32x2>(ws, WS_ROPE);
      for (int i = gt; i < SEQ * 32; i += NGT) { const int ts = i >> 5, pi = i & 31; const float freq = expf(-(float)(pi & 15) * (9.210340371976184f / 16.f));
          const float ang = ((pi >= 16) ? (float)(ts & 63) : (float)(ts >> 6)) * freq; float sn, cs; sincosf(ang, &sn, &cs); rt[i] = (f32x2){cs, sn}; } }
    { const float* x = F.in[0]; bf16_t* xb = wsp<bf16_t>(ws, WS_XB); float* ssq = wsp<float>(ws, WS_SSQ0);
      for (int m = gw; m < M_TOK; m += NGW) { const f32x4* xr = (const f32x4*)(x + (size_t)m * 1024) + lane; f32x4 v[4]; float s = 0.f;
#pragma unroll
          for (int j = 0; j < 4; ++j) { v[j] = xr[64 * j]; s += (v[j].x * v[j].x + v[j].y * v[j].y) + (v[j].z * v[j].z + v[j].w * v[j].w); }
          s = wave_sum(s);
          u32x2* o8 = (u32x2*)(xb + (size_t)m * 1024) + lane;
#pragma unroll
          for (int j = 0; j < 4; ++j) { u32x2 w; w.x = pk2(v[j].x, v[j].y); w.y = pk2(v[j].z, v[j].w); o8[64 * j] = w; }
          if (lane < 16) ssq[(size_t)m * 16 + lane] = (lane == 0) ? s : 0.f; } }
}
struct ConvEGU { const float* const* in; unsigned char* ws; int base; __device__ __forceinline__ ConvItem operator()(int it_) const { constexpr int IG = 16 * 112; const int it = it_ + base; const int e = it / (2 * IG), r = it % (2 * IG);
    bf16_t* wegu = wsp<bf16_t>(ws, A_WEGU + (e >= EGU_EARLY ? WEGU_HI_SHIFT : 0)) + (size_t)e * 2 * D_FFE * 1024;
    if (r < IG) return conv_desc(r, in[35] + (size_t)e * 1024 * D_FFE, D_FFE, 0, 112, 32, in[33], wegu, 1024, 1, 0);
    return conv_desc(r - IG, in[36] + (size_t)e * 1024 * D_FFE, D_FFE, 0, 112, 32, in[33], wegu, 1024, 2, 0); } };
struct ConvED { const float* const* in; unsigned char* ws; __device__ __forceinline__ ConvItem operator()(int it) const { constexpr int ID = 56 * 32; const int e = it / ID, r = it % ID;
    return conv_desc(r, in[37] + (size_t)e * D_FFE * 1024, 1024, 0, 32, 32, nullptr, wsp<bf16_t>(ws, A_WED) + (size_t)e * 1024 * D_FFE, D_FFE, 0, 0); } };
__device__ __forceinline__ void conv_experts_gu(const Frame& F, int w, int nw, int e_lo, int e_hi) { ConvEGU d{F.in, F.ws, e_lo * 2 * 16 * 112}; conv_run(d, w, nw, (e_hi - e_lo) * 2 * 16 * 112, (LAS float*)(F.lds + F.wave * 16384), F.lane); }
__device__ __forceinline__ void conv_experts_down(const Frame& F, int w, int nw) { ConvED d{F.in, F.ws}; conv_run(d, w, nw, NEXP * 56 * 32, (LAS float*)(F.lds + F.wave * 16384), F.lane); }
__device__ __forceinline__ void phase_conv_experts(const Frame& F) {
    const int gw = F.vcu * NWAVES + F.wave, NGW = F.G * NWAVES;
    conv_experts_gu(F, gw, NGW, 0, EGU_EARLY);
}

__device__ __forceinline__ float dpp8_sum(float v) {
    v += __builtin_bit_cast(float, __builtin_amdgcn_update_dpp(0, __builtin_bit_cast(int, v), 0xB1, 0xF, 0xF, false));
    v += __builtin_bit_cast(float, __builtin_amdgcn_update_dpp(0, __builtin_bit_cast(int, v), 0x4E, 0xF, 0xF, false));
    v += __builtin_bit_cast(float, __builtin_amdgcn_update_dpp(0, __builtin_bit_cast(int, v), 0x141, 0xF, 0xF, false));
    return v;
}
__device__ __forceinline__ void phase_prep0(const Frame& F) {
    const int gw = F.vcu * NWAVES + F.wave, lane = F.lane;
    const bf16_t* P = wsp<bf16_t>(F.ws, A_P0);
    bf16_t *RS = wsp<bf16_t>(F.ws, A_RS), *KS = wsp<bf16_t>(F.ws, A_KS), *VS = wsp<bf16_t>(F.ws, A_VS), *NKK = wsp<bf16_t>(F.ws, A_NKK), *AP = wsp<bf16_t>(F.ws, A_AP);
    bf16_t *QH = wsp<bf16_t>(F.ws, A_QH), *KH = wsp<bf16_t>(F.ws, A_KH), *VT = wsp<bf16_t>(F.ws, A_VT0);
    const f32x2* ROPE = wsp<f32x2>(F.ws, WS_ROPE);
    float mu[4][8], kkw[8], qn8[8], kn8[8];
#pragma unroll
    for (int j = 0; j < 4; ++j)
#pragma unroll
        for (int e = 0; e < 8; ++e) { const int col = 8 * (lane + 64 * j) + e; mu[j][e] = col < RW_IN ? F.in[3][col] : 0.f; }
#pragma unroll
    for (int e = 0; e < 8; ++e) { kkw[e] = F.in[13][8 * lane + e]; qn8[e] = F.in[18][8 * (lane & 7) + e]; kn8[e] = F.in[19][8 * (lane & 7) + e]; }
    for (int g8 = gw; g8 < M_TOK / 8; g8 += F.G * NWAVES) {
        u32x4 prev[4], cur[5], nxt[4], nn[4];
        { const int tok = g8 * 8; const int ts = tok & (SEQ - 1);
#pragma unroll
          for (int j = 0; j < 5; ++j) cur[j] = *(const u32x4*)(P + (size_t)tok * E_IN + 8 * (lane + 64 * j));
#pragma unroll
          for (int j = 0; j < 4; ++j) nxt[j] = *(const u32x4*)(P + (size_t)(tok + 1) * E_IN + 8 * (lane + 64 * j));
#pragma unroll
          for (int j = 0; j < 4; ++j) prev[j] = (ts > 0) ? *(const u32x4*)(P + (size_t)(tok - 1) * E_IN + 8 * (lane + 64 * j)) : (u32x4){0u, 0u, 0u, 0u}; }
        for (int tt = 0; tt < 8; ++tt) { const int tok = g8 * 8 + tt; const int ts = tok & (SEQ - 1); const int bb = tok >> 11;
            u32x4 ncur4 = (u32x4){0u, 0u, 0u, 0u};
#pragma unroll
            for (int j = 0; j < 4; ++j) nn[j] = (u32x4){0u, 0u, 0u, 0u};
            if (tt < 7 && ts + 2 < SEQ) {
#pragma unroll
                for (int j = 0; j < 4; ++j) nn[j] = *(const u32x4*)(P + (size_t)(tok + 2) * E_IN + 8 * (lane + 64 * j)); }
            if (tt < 7) ncur4 = *(const u32x4*)(P + (size_t)(tok + 1) * E_IN + 8 * (lane + 256));
            const f32x4 rp0 = *(const f32x4*)(ROPE + (size_t)ts * 32 + 4 * (lane & 7)), rp1 = *(const f32x4*)(ROPE + (size_t)ts * 32 + 4 * (lane & 7) + 2);
            const float cs4[4] = {rp0[0], rp0[2], rp1[0], rp1[2]}, sn4[4] = {rp0[1], rp0[3], rp1[1], rp1[3]};
            float s[4][8];
#pragma unroll
            for (int j = 0; j < 4; ++j) { float c[8], p[8], n[8]; unpack8(cur[j], c); unpack8(prev[j], p); unpack8(nxt[j], n);
#pragma unroll
                for (int e = 0; e < 8; ++e) s[j][e] = c[e] + (0.5f * (p[e] + n[e]) - c[e]) * mu[j][e]; }
            const size_t o512 = (size_t)tok * 512 + 8 * lane;
            *(u32x4*)(RS + o512) = pack8f(s[0]); *(u32x4*)(KS + o512) = pack8f(s[1]); *(u32x4*)(VS + o512) = pack8f(s[2]);
            { float kr[8]; float ss = 0.f;
#pragma unroll
              for (int e = 0; e < 8; ++e) { kr[e] = s[1][e] * kkw[e]; ss += kr[e] * kr[e]; }
              ss = dpp8_sum(ss); const float inv = -1.f / fmaxf(sqrtf(ss), 1e-12f);
#pragma unroll
              for (int e = 0; e < 8; ++e) kr[e] *= inv;
              *(u32x4*)(NKK + o512) = pack8f(kr); }
            float x3[8], x4[8]; unpack8(cur[3], x3); unpack8(cur[4], x4);
            { float ap[8];
#pragma unroll
              for (int e = 0; e < 8; ++e) ap[e] = lane < 8 ? tanhf(s[3][e]) : (lane < 16 ? s[3][e] : sigmoidf_(s[3][e]));
              if (lane < 32) *(u32x4*)(AP + (size_t)tok * 256 + 8 * lane) = pack8f(ap); }
#pragma unroll
            for (int which = 0; which < 2; ++which) { float (&x)[8] = which ? x4 : x3; float ss = 0.f;
#pragma unroll
                for (int e = 0; e < 8; ++e) ss += x[e] * x[e];
                ss = dpp8_sum(ss); const float rs = __builtin_amdgcn_rsqf(ss * (1.f / 64.f) + NORM_EPS);
                const bool isk = which && lane >= 32; float o[8];
#pragma unroll
                for (int p = 0; p < 4; ++p) { const float x0 = x[2 * p] * rs * (isk ? kn8[2 * p] : qn8[2 * p]), x1 = x[2 * p + 1] * rs * (isk ? kn8[2 * p + 1] : qn8[2 * p + 1]);
                    o[2 * p] = x0 * cs4[p] - x1 * sn4[p]; o[2 * p + 1] = x0 * sn4[p] + x1 * cs4[p]; }
                if (!isk) {
#pragma unroll
                    for (int e = 0; e < 8; ++e) o[e] *= 0.18033688011112042f; }
                if (which == 0) { if (lane >= 32) *(u32x4*)(QH + (size_t)tok * 512 + 8 * (lane - 32)) = pack8f(o); }
                else { if (lane < 32) *(u32x4*)(QH + (size_t)tok * 512 + 256 + 8 * lane) = pack8f(o);
                       else if (lane < 48) *(u32x4*)(KH + (size_t)tok * 128 + 8 * (lane - 32)) = pack8f(o); } }
            if (lane >= 48) { const int g = (lane - 48) >> 3, d0 = 8 * ((lane - 48) & 7); const unsigned w[4] = {cur[4].x, cur[4].y, cur[4].z, cur[4].w};
#pragma unroll
                for (int e = 0; e < 8; ++e) VT[((size_t)(bb * 2 + g) * 64 + d0 + e) * SEQ + ts] = (bf16_t)((e & 1) ? (w[e >> 1] >> 16) : (w[e >> 1] & 0xffffu)); }
#pragma unroll
            for (int j = 0; j < 4; ++j) prev[j] = cur[j];
#pragma unroll
            for (int j = 0; j < 4; ++j) { cur[j] = nxt[j]; nxt[j] = nn[j]; }
            cur[4] = ncur4;
        }
    }
}

__device__ __forceinline__ float dpp_row_sum(float v) {
    v += __builtin_bit_cast(float, __builtin_amdgcn_update_dpp(0, __builtin_bit_cast(int, v), 0xB1, 0xF, 0xF, false));
    v += __builtin_bit_cast(float, __builtin_amdgcn_update_dpp(0, __builtin_bit_cast(int, v), 0x4E, 0xF, 0xF, false));
    v += __builtin_bit_cast(float, __builtin_amdgcn_update_dpp(0, __builtin_bit_cast(int, v), 0x141, 0xF, 0xF, false));
    v += __builtin_bit_cast(float, __builtin_amdgcn_update_dpp(0, __builtin_bit_cast(int, v), 0x140, 0xF, 0xF, false));
    return v;
}
constexpr int SC_STEPS = 32, SC_STRIDE = 352, SC_BUF = SC_STEPS * SC_STRIDE;
__device__ __forceinline__ float dpp_row8_sum(float v) {
    v += __builtin_bit_cast(float, __builtin_amdgcn_update_dpp(0, __builtin_bit_cast(int, v), 0xB1, 0xF, 0xF, false));
    v += __builtin_bit_cast(float, __builtin_amdgcn_update_dpp(0, __builtin_bit_cast(int, v), 0x4E, 0xF, 0xF, false));
    v += __builtin_bit_cast(float, __builtin_amdgcn_update_dpp(0, __builtin_bit_cast(int, v), 0x141, 0xF, 0xF, false));
    return v;
}
struct ScOps { f32x2 w[4], kd[4], a[4], b[4], r[4]; float v; };
__device__ __forceinline__ void sc_ld(ScOps& o, const LAS float* bs, const LAS float* vp) {
#pragma unroll
    for (int i = 0; i < 2; ++i) {
        const f32x4 w4 = *(const LAS f32x4*)(bs + 4 * i), k4 = *(const LAS f32x4*)(bs + 64 + 4 * i), a4 = *(const LAS f32x4*)(bs + 128 + 4 * i), b4 = *(const LAS f32x4*)(bs + 192 + 4 * i), r4 = *(const LAS f32x4*)(bs + 256 + 4 * i);
        o.w[2 * i] = (f32x2){w4[0], w4[1]}; o.w[2 * i + 1] = (f32x2){w4[2], w4[3]}; o.kd[2 * i] = (f32x2){k4[0], k4[1]}; o.kd[2 * i + 1] = (f32x2){k4[2], k4[3]};
        o.a[2 * i] = (f32x2){a4[0], a4[1]}; o.a[2 * i + 1] = (f32x2){a4[2], a4[3]}; o.b[2 * i] = (f32x2){b4[0], b4[1]}; o.b[2 * i + 1] = (f32x2){b4[2], b4[3]};
        o.r[2 * i] = (f32x2){r4[0], r4[1]}; o.r[2 * i + 1] = (f32x2){r4[2], r4[3]}; }
    o.v = *vp;
}
template <int DIR> __device__ __forceinline__ float sc_step(f32x2 (&s)[4], const ScOps& o) {
    f32x2 u[4];
#pragma unroll
    for (int i = 0; i < 4; ++i) u[i] = o.kd[i] * o.v;
    f32x2 p = s[0] * o.a[0], q = s[1] * o.a[1];
    p = __builtin_elementwise_fma(s[2], o.a[2], p); q = __builtin_elementwise_fma(s[3], o.a[3], q); p = p + q;
    float sa = dpp_row8_sum(p[0] + p[1]);
    f32x2 yp, yq;
    if (DIR) { yp = s[0] * o.r[0]; yq = s[1] * o.r[1]; yp = __builtin_elementwise_fma(s[2], o.r[2], yp); yq = __builtin_elementwise_fma(s[3], o.r[3], yq); }
    const f32x2 sa2 = {sa, sa};
#pragma unroll
    for (int i = 0; i < 4; ++i) { const f32x2 t = __builtin_elementwise_fma(o.b[i], sa2, u[i]); s[i] = __builtin_elementwise_fma(s[i], o.w[i], t); }
    if (!DIR) { yp = s[0] * o.r[0]; yq = s[1] * o.r[1]; yp = __builtin_elementwise_fma(s[2], o.r[2], yp); yq = __builtin_elementwise_fma(s[3], o.r[3], yq); }
    yp = yp + yq;
    return dpp_row8_sum(yp[0] + yp[1]);
}
__device__ __forceinline__ void attn_tile_step(const LAS unsigned char* kb, const LAS unsigned char* vb, const bf16x8 (&q)[4], f32x16& o0, f32x16& o1, float& mrun, float& lrun, int r32, int hi) {
    f32x16 c0 = {}, c1 = {};
#pragma unroll
    for (int s4 = 0; s4 < 4; ++s4) { const int chk = 2 * s4 + hi;
        const bf16x8 k0 = *(const LAS bf16x8*)(kb + r32 * 128 + ((chk ^ (r32 & 7)) * 16));
        const bf16x8 k1 = *(const LAS bf16x8*)(kb + (32 + r32) * 128 + ((chk ^ (r32 & 7)) * 16));
        c0 = __builtin_amdgcn_mfma_f32_32x32x16_bf16(k0, q[s4], c0, 0, 0, 0);
        c1 = __builtin_amdgcn_mfma_f32_32x32x16_bf16(k1, q[s4], c1, 0, 0, 0); }
    float mx = c0[0];
#pragma unroll
    for (int r = 0; r < 16; ++r) { mx = fmaxf(mx, c0[r]); mx = fmaxf(mx, c1[r]); }
    mx = fmaxf(mx, __shfl_xor(mx, 32));
    const float mnew = fmaxf(mrun, mx); const float alpha = __builtin_amdgcn_exp2f(mrun - mnew); mrun = mnew;
    float ls = 0.f;
#pragma unroll
    for (int r = 0; r < 16; ++r) { c0[r] = __builtin_amdgcn_exp2f(c0[r] - mnew); c1[r] = __builtin_amdgcn_exp2f(c1[r] - mnew); ls += c0[r] + c1[r]; }
    lrun = lrun * alpha + ls;
#pragma unroll
    for (int r = 0; r < 16; ++r) { o0[r] *= alpha; o1[r] *= alpha; }
    u32x4 w00, w01, w10, w11;
    w00.x = pk2(c0[0], c0[1]); w00.y = pk2(c0[2], c0[3]); w00.z = pk2(c0[4], c0[5]); w00.w = pk2(c0[6], c0[7]);
    w01.x = pk2(c0[8], c0[9]); w01.y = pk2(c0[10], c0[11]); w01.z = pk2(c0[12], c0[13]); w01.w = pk2(c0[14], c0[15]);
    w10.x = pk2(c1[0], c1[1]); w10.y = pk2(c1[2], c1[3]); w10.z = pk2(c1[4], c1[5]); w10.w = pk2(c1[6], c1[7]);
    w11.x = pk2(c1[8], c1[9]); w11.y = pk2(c1[10], c1[11]); w11.z = pk2(c1[12], c1[13]); w11.w = pk2(c1[14], c1[15]);
    const bf16x8 p00 = __builtin_bit_cast(bf16x8, w00), p01 = __builtin_bit_cast(bf16x8, w01), p10 = __builtin_bit_cast(bf16x8, w10), p11 = __builtin_bit_cast(bf16x8, w11);
#define AT_VF(dd_, chk_) ({ const int sw_ = ((dd_) >> 1) & 7; const u32x2 lo_ = *(const LAS u32x2*)(vb + (dd_) * 128 + (((chk_) ^ sw_) * 16) + hi * 8); \
        const u32x2 hh_ = *(const LAS u32x2*)(vb + (dd_) * 128 + ((((chk_) + 1) ^ sw_) * 16) + hi * 8); const u32x4 vv_ = {lo_.x, lo_.y, hh_.x, hh_.y}; __builtin_bit_cast(bf16x8, vv_); })
    o0 = __builtin_amdgcn_mfma_f32_32x32x16_bf16(AT_VF(r32, 0), p00, o0, 0, 0, 0);
    o0 = __builtin_amdgcn_mfma_f32_32x32x16_bf16(AT_VF(r32, 2), p01, o0, 0, 0, 0);
    o0 = __builtin_amdgcn_mfma_f32_32x32x16_bf16(AT_VF(r32, 4), p10, o0, 0, 0, 0);
    o0 = __builtin_amdgcn_mfma_f32_32x32x16_bf16(AT_VF(r32, 6), p11, o0, 0, 0, 0);
    o1 = __builtin_amdgcn_mfma_f32_32x32x16_bf16(AT_VF(32 + r32, 0), p00, o1, 0, 0, 0);
    o1 = __builtin_amdgcn_mfma_f32_32x32x16_bf16(AT_VF(32 + r32, 2), p01, o1, 0, 0, 0);
    o1 = __builtin_amdgcn_mfma_f32_32x32x16_bf16(AT_VF(32 + r32, 4), p10, o1, 0, 0, 0);
    o1 = __builtin_amdgcn_mfma_f32_32x32x16_bf16(AT_VF(32 + r32, 6), p11, o1, 0, 0, 0);
#undef AT_VF
}
__device__ __forceinline__ void attn_store(bf16_t* op, const f32x16& o0, const f32x16& o1, float lrun) {
    const float ltot = lrun + __shfl_xor(lrun, 32); const float inv = 1.f / ltot;
#pragma unroll
    for (int q4 = 0; q4 < 4; ++q4) { u32x2 w0, w1;
        w0.x = pk2(o0[4 * q4 + 0] * inv, o0[4 * q4 + 1] * inv); w0.y = pk2(o0[4 * q4 + 2] * inv, o0[4 * q4 + 3] * inv);
        w1.x = pk2(o1[4 * q4 + 0] * inv, o1[4 * q4 + 1] * inv); w1.y = pk2(o1[4 * q4 + 2] * inv, o1[4 * q4 + 3] * inv);
        *(u32x2*)(op + 8 * q4) = w0; *(u32x2*)(op + 32 + 8 * q4) = w1; }
}
constexpr int CS_SLOT = 9216, CS_RS = 144;
__device__ __forceinline__ void cs_mm(f32x4 (&acc)[2], const LAS unsigned char* L, const LAS unsigned char* Rt, int mi, int ni0, int fr, int fq) {
#pragma unroll
    for (int s2 = 0; s2 < 2; ++s2) { const bf16x8 a = *(const LAS bf16x8*)(L + (16 * mi + fr) * CS_RS + (32 * s2 + 8 * fq) * 2);
#pragma unroll
        for (int jj = 0; jj < 2; ++jj) { const bf16x8 bb = *(const LAS bf16x8*)(Rt + (16 * (ni0 + jj) + fr) * CS_RS + (32 * s2 + 8 * fq) * 2);
            acc[jj] = __builtin_amdgcn_mfma_f32_16x16x32_bf16(a, bb, acc[jj], 0, 0, 0); } }
}
__device__ __forceinline__ void cs_st_t8(LAS unsigned char* dst, const f32x4 (&acc)[2], int mi, int ni0, int fr, int fq) {
#pragma unroll
    for (int jj = 0; jj < 2; ++jj) { u32x2 w; w.x = pk2(acc[jj][0], acc[jj][1]); w.y = pk2(acc[jj][2], acc[jj][3]);
        *(LAS u32x2*)(dst + (16 * (ni0 + jj) + fr) * CS_RS + (16 * mi + 4 * fq) * 2) = w; }
}
__device__ __forceinline__ void cs_st_sc(LAS unsigned char* dst, const f32x4 (&acc)[2], int mi, int ni0, int fr, int fq) {
#pragma unroll
    for (int jj = 0; jj < 2; ++jj)
#pragma unroll
        for (int r = 0; r < 4; ++r) *(LAS bf16_t*)(dst + (16 * mi + 4 * fq + r) * CS_RS + (16 * (ni0 + jj) + fr) * 2) = f2bf(acc[jj][r]);
}
__device__ __forceinline__ void cs_ld_t8(f32x4 (&acc)[2], const LAS unsigned char* src, int mi, int ni0, int fr, int fq) {
#pragma unroll
    for (int jj = 0; jj < 2; ++jj) { const u32x2 w = *(const LAS u32x2*)(src + (16 * (ni0 + jj) + fr) * CS_RS + (16 * mi + 4 * fq) * 2);
        acc[jj] = (f32x4){bflo(w.x), bfhi(w.x), bflo(w.y), bfhi(w.y)}; }
}
#define CS_ZERO(acc) do { acc[0] = (f32x4){0.f, 0.f, 0.f, 0.f}; acc[1] = acc[0]; } while (0)
template <int RS = CS_RS> __device__ __forceinline__ bf16x8 cs_afrag_tr(const LAS unsigned char* LT, int mi, int s2, int fr, int fq) {
    const LAS unsigned char* p = LT + (32 * s2 + 8 * fq + (fr >> 2)) * RS + (16 * mi + 4 * (fr & 3)) * 2;
    const v4i16_t lo = __builtin_amdgcn_ds_read_tr16_b64_v4i16((LAS v4i16_t*)p);
    const v4i16_t hi = __builtin_amdgcn_ds_read_tr16_b64_v4i16((LAS v4i16_t*)(p + 4 * RS));
    return (bf16x8){lo[0], lo[1], lo[2], lo[3], hi[0], hi[1], hi[2], hi[3]};
}
__device__ __forceinline__ void cs_mm_tr(f32x4 (&acc)[2], const LAS unsigned char* LT, const LAS unsigned char* Rt, int mi, int ni0, int fr, int fq) {
#pragma unroll
    for (int s2 = 0; s2 < 2; ++s2) { const bf16x8 a = cs_afrag_tr(LT, mi, s2, fr, fq);
#pragma unroll
        for (int jj = 0; jj < 2; ++jj) { const bf16x8 bb = *(const LAS bf16x8*)(Rt + (16 * (ni0 + jj) + fr) * CS_RS + (32 * s2 + 8 * fq) * 2);
            acc[jj] = __builtin_amdgcn_mfma_f32_16x16x32_bf16(a, bb, acc[jj], 0, 0, 0); } }
}
__device__ __forceinline__ void cs_mm_tr2(f32x4 (&aU)[2], f32x4 (&aS)[2], const LAS unsigned char* LUT, const LAS unsigned char* LST, const LAS unsigned char* Rt, bool doS, int mi, int ni0, int fr, int fq) {
#pragma unroll
    for (int s2 = 0; s2 < 2; ++s2) { const bf16x8 au = cs_afrag_tr(LUT, mi, s2, fr, fq); const bf16x8 as = cs_afrag_tr(LST, mi, s2, fr, fq);
#pragma unroll
        for (int jj = 0; jj < 2; ++jj) { const bf16x8 bb = *(const LAS bf16x8*)(Rt + (16 * (ni0 + jj) + fr) * CS_RS + (32 * s2 + 8 * fq) * 2);
            aU[jj] = __builtin_amdgcn_mfma_f32_16x16x32_bf16(au, bb, aU[jj], 0, 0, 0);
            if (doS) aS[jj] = __builtin_amdgcn_mfma_f32_16x16x32_bf16(as, bb, aS[jj], 0, 0, 0); } }
}
__device__ __forceinline__ void cs_mask(f32x4 (&acc)[2], int mi, int ni0, int fr, int fq, int mode) {
#pragma unroll
    for (int jj = 0; jj < 2; ++jj) { const int ni = ni0 + jj;
        const bool keep_all = (mode == 1) ? (ni < mi) : (ni > mi), diag = (ni == mi);
        if (diag) {
#pragma unroll
            for (int r = 0; r < 4; ++r) { const int ml = 4 * fq + r; const bool k = (mode == 0) ? (ml < fr) : (mode == 1) ? (fr < ml) : (ml <= fr); if (!k) acc[jj][r] = 0.f; }
        } else if (!keep_all) acc[jj] = (f32x4){0.f, 0.f, 0.f, 0.f}; }
}
template <int DIR> __device__ __forceinline__ void cscan_job(const Frame& F, int b, int h) {
    const int tid = F.tid, lane = F.lane, wave = F.wave, fr = lane & 15, fq = lane >> 4;
    LAS unsigned char* L0 = F.lds;
#define SL(i) (L0 + (i) * CS_SLOT)
    LAS float* Dl = (LAS float*)(SL(14) + 8704);
    const bf16_t* g0 = wsp<bf16_t>(F.ws, DIR ? A_LWB : A_LWF); const bf16_t* g1 = wsp<bf16_t>(F.ws, A_KS); const bf16_t* g2 = wsp<bf16_t>(F.ws, A_NKK);
    const bf16_t* g3 = wsp<bf16_t>(F.ws, DIR ? A_SGB : A_SGF); const bf16_t* g4 = wsp<bf16_t>(F.ws, A_RS); const bf16_t* g5 = wsp<bf16_t>(F.ws, A_VS);
    bf16_t* Y = wsp<bf16_t>(F.ws, DIR ? A_YB : A_YF);
    const int mi = wave >> 1, ni0 = 2 * (wave & 1);
    const int rt_ = tid >> 3, rc_ = tid & 7;
    const int ek = tid & 63, etq = tid >> 6;
    u32x4 raw[5], rawv, rawv_cur; bf16_t lwn[8];
    const float ka_k = F.in[14][h * 64 + ek];
#define CS_LOAD(n_) do { const int sq_ = 64 * (n_) + rt_; const size_t to_ = (size_t)(b * SEQ + (DIR ? (SEQ - 1 - sq_) : sq_)) * 512 + h * 64; \
        raw[1] = *(const u32x4*)(g1 + to_ + 8 * rc_); raw[2] = *(const u32x4*)(g2 + to_ + 8 * rc_); raw[3] = *(const u32x4*)(g3 + to_ + 8 * rc_); raw[4] = *(const u32x4*)(g4 + to_ + 8 * rc_); \
        rawv = *(const u32x4*)(g5 + to_ + 8 * rc_); \
        _Pragma("unroll") for (int j_ = 0; j_ < 8; ++j_) { const int sq2_ = 64 * (n_) + 8 * etq + j_; lwn[j_] = g0[(size_t)(b * SEQ + (DIR ? (SEQ - 1 - sq2_) : sq2_)) * 512 + h * 64 + ek]; } } while (0)
    __syncthreads();
    for (int i = tid; i < 8704 / 4; i += 512) ((LAS unsigned*)SL(14))[i] = 0u;
    CS_LOAD(0);
    float lwv[8], cw[8];
    LAS float* PART = (LAS float*)SL(12);
#define CS_STAGE0(nn_) do { \
        _Pragma("unroll") for (int j = 0; j < 8; ++j) lwv[j] = bf2f(lwn[j]); \
        cw[0] = lwv[0]; \
        _Pragma("unroll") for (int j = 1; j < 8; ++j) cw[j] = cw[j - 1] + lwv[j]; \
        PART[etq * 64 + ek] = cw[7]; \
        _Pragma("unroll") for (int q = 1; q < 5; ++q) *(LAS u32x4*)(SL(7 + q) + rt_ * CS_RS + rc_ * 16) = raw[q]; \
        rawv_cur = rawv; \
        if ((nn_) + 1 < 32) CS_LOAD((nn_) + 1); } while (0)
    CS_STAGE0(0);
    __syncthreads();
    for (int n = 0; n < 32; ++n) {
        { float off = 0.f, tot = 0.f;
#pragma unroll
          for (int q = 0; q < 8; ++q) { const float p = PART[q * 64 + ek]; tot += p; if (q < etq) off += p; }
          const float ec = __builtin_amdgcn_exp2f(tot);
          if (etq == 0) Dl[ek] = ec;
          unsigned pa[4], pbh[4], pkh[4];
#pragma unroll
          for (int j = 0; j < 8; ++j) { const int t = 8 * etq + j; const float c = cw[j] + off, cp = c - lwv[j];
              const float e1 = __builtin_amdgcn_exp2f(c), em = __builtin_amdgcn_exp2f(-c), ep = __builtin_amdgcn_exp2f(cp);
              const float kdv = bf2f(*(const LAS bf16_t*)(SL(8) + t * CS_RS + ek * 2)), av = bf2f(*(const LAS bf16_t*)(SL(9) + t * CS_RS + ek * 2));
              const float bv = bf2f(*(const LAS bf16_t*)(SL(10) + t * CS_RS + ek * 2)), rv = bf2f(*(const LAS bf16_t*)(SL(11) + t * CS_RS + ek * 2));
              const float sgv = bv; const float kd2 = kdv * (1.f + (sgv - 1.f) * ka_k), bb2 = -av * sgv;
              const float at = av * ep, bt = bb2 * em, kt = kd2 * em, rtv = rv * (DIR ? ep : e1), bh = bt * ec, kh = kt * ec;
              const unsigned w01 = pk2(at, bt), w23 = pk2(kt, rtv);
              *(LAS bf16_t*)(SL(0) + t * CS_RS + ek * 2) = (bf16_t)(w01 & 0xffffu); *(LAS bf16_t*)(SL(1) + t * CS_RS + ek * 2) = (bf16_t)(w01 >> 16);
              *(LAS bf16_t*)(SL(2) + t * CS_RS + ek * 2) = (bf16_t)(w23 & 0xffffu); *(LAS bf16_t*)(SL(3) + t * CS_RS + ek * 2) = (bf16_t)(w23 >> 16);
              const unsigned hbk = pk2(bh, kh); const unsigned ha = w01 & 0xffffu, hb = hbk & 0xffffu, hk = hbk >> 16;
              if (j & 1) { pa[j >> 1] |= ha << 16; pbh[j >> 1] |= hb << 16; pkh[j >> 1] |= hk << 16; } else { pa[j >> 1] = ha; pbh[j >> 1] = hb; pkh[j >> 1] = hk; } }
          *(LAS u32x4*)(SL(4) + ek * CS_RS + etq * 16) = (u32x4){pa[0], pa[1], pa[2], pa[3]};
          *(LAS u32x4*)(SL(5) + ek * CS_RS + etq * 16) = (u32x4){pbh[0], pbh[1], pbh[2], pbh[3]};
          *(LAS u32x4*)(SL(6) + ek * CS_RS + etq * 16) = (u32x4){pkh[0], pkh[1], pkh[2], pkh[3]}; }
        __syncthreads();
        { f32x4 acc[2];
          CS_ZERO(acc); cs_mm(acc, SL(1), SL(0), mi, ni0, fr, fq); cs_mask(acc, mi, ni0, fr, fq, 0);
          cs_st_t8(SL(8), acc, mi, ni0, fr, fq);
          if (mi == ni0 || mi == ni0 + 1) { const int jd = mi - ni0;
#pragma unroll
              for (int jj = 0; jj < 2; ++jj)
#pragma unroll
                  for (int r = 0; r < 4; ++r) if (jj == jd && (4 * fq + r) == fr) acc[jj][r] += 1.f; }
          cs_st_t8(SL(13), acc, mi, ni0, fr, fq);
          CS_ZERO(acc); cs_mm(acc, SL(0), SL(2), mi, ni0, fr, fq); cs_mask(acc, mi, ni0, fr, fq, 1); cs_st_t8(SL(9), acc, mi, ni0, fr, fq);
          CS_ZERO(acc); cs_mm(acc, SL(1), SL(3), mi, ni0, fr, fq); cs_mask(acc, mi, ni0, fr, fq, DIR ? 0 : 2); cs_st_t8(SL(10), acc, mi, ni0, fr, fq);
          CS_ZERO(acc); cs_mm(acc, SL(2), SL(3), mi, ni0, fr, fq); cs_mask(acc, mi, ni0, fr, fq, DIR ? 0 : 2); cs_st_t8(SL(11), acc, mi, ni0, fr, fq); }
        __syncthreads();
        { f32x4 aS[2], aU[2];
          CS_ZERO(aS); cs_mm_tr(aS, SL(8), SL(8), mi, ni0, fr, fq); cs_st_t8(SL(1), aS, mi, ni0, fr, fq);
          __syncthreads();
#pragma unroll
          for (int it = 0; it < 5; ++it) { const int xc = (it & 1) ? 8 : 1, xa = (it & 1) ? 1 : 8, tc = (it & 1) ? 12 : 13, ta = (it & 1) ? 13 : 12;
              cs_ld_t8(aU, SL(tc), mi, ni0, fr, fq); CS_ZERO(aS); cs_mm_tr2(aU, aS, SL(tc), SL(xc), SL(xc), it < 4, mi, ni0, fr, fq);
              cs_st_t8(SL(ta), aU, mi, ni0, fr, fq);
              if (it < 4) cs_st_t8(SL(xa), aS, mi, ni0, fr, fq);
              __syncthreads(); } }
        { f32x4 acc[2];
          CS_ZERO(acc); cs_mm(acc, SL(12), SL(4), mi, ni0, fr, fq); cs_st_t8(SL(0), acc, mi, ni0, fr, fq);
          CS_ZERO(acc); cs_mm(acc, SL(12), SL(9), mi, ni0, fr, fq); cs_st_t8(SL(1), acc, mi, ni0, fr, fq); }
        __syncthreads();
        { f32x4 acc[2];
          CS_ZERO(acc);
          if (mi == ni0 || mi == ni0 + 1) { const int jd = mi - ni0; const float dv = Dl[16 * mi + fr];
#pragma unroll
              for (int jj = 0; jj < 2; ++jj)
#pragma unroll
                  for (int r = 0; r < 4; ++r) if (jj == jd && (4 * fq + r) == fr) acc[jj][r] = dv; }
          cs_mm(acc, SL(0), SL(5), mi, ni0, fr, fq); cs_st_t8(SL(7), acc, mi, ni0, fr, fq);
          cs_ld_t8(acc, SL(3), mi, ni0, fr, fq); cs_mm(acc, SL(0), SL(10), mi, ni0, fr, fq); cs_st_t8(SL(3), acc, mi, ni0, fr, fq);
          cs_ld_t8(acc, SL(6), mi, ni0, fr, fq); cs_mm(acc, SL(1), SL(5), mi, ni0, fr, fq); cs_st_t8(SL(6), acc, mi, ni0, fr, fq);
          cs_ld_t8(acc, SL(11), mi, ni0, fr, fq); cs_mm(acc, SL(1), SL(10), mi, ni0, fr, fq); cs_st_t8(SL(13), acc, mi, ni0, fr, fq);
          const unsigned w4[4] = {rawv_cur.x, rawv_cur.y, rawv_cur.z, rawv_cur.w};
#pragma unroll
          for (int e = 0; e < 8; ++e) *(LAS bf16_t*)(SL(2) + (8 * rc_ + e) * CS_RS + rt_ * 2) = (bf16_t)((e & 1) ? (w4[e >> 1] >> 16) : (w4[e >> 1] & 0xffffu)); }
        __syncthreads();
        if (n + 1 < 32) CS_STAGE0(n + 1);
        { const LAS unsigned char* PH = (wave < 4 ? SL(7) : SL(3)) + (16 * (wave & 3) + fr) * CS_RS; const LAS unsigned char* PS = (wave < 4 ? SL(6) : SL(13)) + (16 * (wave & 3) + fr) * CS_RS;
          const LAS unsigned char* Sr = (n & 1) ? SL(15) : SL(14); LAS unsigned char* Sw = (n & 1) ? SL(14) : SL(15);
          f32x4 acc[4] = {(f32x4){0.f, 0.f, 0.f, 0.f}, (f32x4){0.f, 0.f, 0.f, 0.f}, (f32x4){0.f, 0.f, 0.f, 0.f}, (f32x4){0.f, 0.f, 0.f, 0.f}};
#pragma unroll
          for (int s2 = 0; s2 < 2; ++s2) { const bf16x8 bph = *(const LAS bf16x8*)(PH + (32 * s2 + 8 * fq) * 2), bps = *(const LAS bf16x8*)(PS + (32 * s2 + 8 * fq) * 2);
#pragma unroll
              for (int m2 = 0; m2 < 4; ++m2) { const bf16x8 as = cs_afrag_tr<136>(Sr, m2, s2, fr, fq), av = *(const LAS bf16x8*)(SL(2) + (16 * m2 + fr) * CS_RS + (32 * s2 + 8 * fq) * 2);
                  acc[m2] = __builtin_amdgcn_mfma_f32_16x16x32_bf16(as, bph, acc[m2], 0, 0, 0); acc[m2] = __builtin_amdgcn_mfma_f32_16x16x32_bf16(av, bps, acc[m2], 0, 0, 0); } }
          if (wave < 4) {
#pragma unroll
              for (int m2 = 0; m2 < 4; ++m2) { u32x2 w; w.x = pk2(acc[m2][0], acc[m2][1]); w.y = pk2(acc[m2][2], acc[m2][3]);
                  *(LAS u32x2*)(Sw + (16 * wave + fr) * 136 + (16 * m2 + 4 * fq) * 2) = w; }
          } else { const int sq = 64 * n + 16 * (wave - 4) + fr; const size_t tok = (size_t)(b * SEQ + (DIR ? (SEQ - 1 - sq) : sq));
#pragma unroll
              for (int m2 = 0; m2 < 4; ++m2) { u32x2 w; w.x = pk2(acc[m2][0], acc[m2][1]); w.y = pk2(acc[m2][2], acc[m2][3]); *(u32x2*)(Y + tok * 512 + h * 64 + 16 * m2 + 4 * fq) = w; } } }
        __syncthreads();
    }
#undef CS_LOAD
#undef CS_STAGE0
#undef SL
}

__device__ __forceinline__ void phase_attn_range(const Frame& F, int u_first, int u_stride) {
    const int tid = F.tid, lane = F.lane, wave = F.wave, r32 = lane & 31, hi = lane >> 5;
    LAS unsigned char* lds = F.lds;
    const bf16_t *QH = wsp<bf16_t>(F.ws, A_QH), *KH = wsp<bf16_t>(F.ws, A_KH), *VT = wsp<bf16_t>(F.ws, A_VT0); bf16_t* YC = wsp<bf16_t>(F.ws, A_YCAT);
    const int skey = tid >> 3, sc = tid & 7;
#define AT_QK(C0, C1, bo_) do { C0 = (f32x16){}; C1 = (f32x16){}; bf16x8 kf_[2][4]; \
        _Pragma("unroll") for (int s = 0; s < 4; ++s) { const int ch = 2 * s + hi; \
            kf_[0][s] = *(const LAS bf16x8*)(lds + (bo_) + r32 * 128 + ((ch ^ (r32 & 7)) * 16)); \
            kf_[1][s] = *(const LAS bf16x8*)(lds + (bo_) + (32 + r32) * 128 + ((ch ^ (r32 & 7)) * 16)); } \
        __builtin_amdgcn_sched_barrier(0); \
        _Pragma("unroll") for (int s = 0; s < 4; ++s) { \
            C0 = __builtin_amdgcn_mfma_f32_32x32x16_bf16(kf_[0][s], qf[s], C0, 0, 0, 0); \
            C1 = __builtin_amdgcn_mfma_f32_32x32x16_bf16(kf_[1][s], qf[s], C1, 0, 0, 0); } } while (0)
#define AT_ITER(t_, CA0, CA1, CB0, CB1) do { const int t = (t_); \
        if (t + 1 < SEQ / 64) AT_QK(CB0, CB1, ((t + 1) & 1) * 8192); \
        __builtin_amdgcn_sched_barrier(0); \
        float mx = CA0[0]; \
        _Pragma("unroll") for (int r = 0; r < 16; ++r) { mx = fmaxf(mx, CA0[r]); mx = fmaxf(mx, CA1[r]); } \
        mx = fmaxf(mx, __shfl_xor(mx, 32)); \
        const float mnew = fmaxf(mrun, mx); const float alpha = __builtin_amdgcn_exp2f(mrun - mnew); mrun = mnew; \
        float ls = 0.f; \
        _Pragma("unroll") for (int r = 0; r < 16; ++r) { CA0[r] = __builtin_amdgcn_exp2f(CA0[r] - mnew); CA1[r] = __builtin_amdgcn_exp2f(CA1[r] - mnew); ls += CA0[r] + CA1[r]; } \
        lrun = lrun * alpha + ls; \
        _Pragma("unroll") for (int r = 0; r < 16; ++r) { o0[r] *= alpha; o1[r] *= alpha; } \
        bf16x8 pf[2][2]; \
        _Pragma("unroll") for (int s2 = 0; s2 < 2; ++s2) { u32x4 w0, w1; \
            w0.x = pk2(CA0[8 * s2 + 0], CA0[8 * s2 + 1]); w0.y = pk2(CA0[8 * s2 + 2], CA0[8 * s2 + 3]); w0.z = pk2(CA0[8 * s2 + 4], CA0[8 * s2 + 5]); w0.w = pk2(CA0[8 * s2 + 6], CA0[8 * s2 + 7]); \
            w1.x = pk2(CA1[8 * s2 + 0], CA1[8 * s2 + 1]); w1.y = pk2(CA1[8 * s2 + 2], CA1[8 * s2 + 3]); w1.z = pk2(CA1[8 * s2 + 4], CA1[8 * s2 + 5]); w1.w = pk2(CA1[8 * s2 + 6], CA1[8 * s2 + 7]); \
            pf[0][s2] = __builtin_bit_cast(bf16x8, w0); pf[1][s2] = __builtin_bit_cast(bf16x8, w1); } \
        const int vb = 16384 + (t & 1) * 8192; \
        _Pragma("unroll") for (int dblk = 0; dblk < 2; ++dblk) { const int d = 32 * dblk + r32; const int sw = (d >> 1) & 7; \
            _Pragma("unroll") for (int blk = 0; blk < 2; ++blk) \
                _Pragma("unroll") for (int s2 = 0; s2 < 2; ++s2) { const int ch = 4 * blk + 2 * s2; \
                    const u32x2 lo = *(const LAS u32x2*)(lds + vb + d * 128 + ((ch ^ sw) * 16) + hi * 8); \
                    const u32x2 hh = *(const LAS u32x2*)(lds + vb + d * 128 + (((ch + 1) ^ sw) * 16) + hi * 8); \
                    const u32x4 vv = {lo.x, lo.y, hh.x, hh.y}; \
                    if (dblk == 0) o0 = __builtin_amdgcn_mfma_f32_32x32x16_bf16(__builtin_bit_cast(bf16x8, vv), pf[blk][s2], o0, 0, 0, 0); \
                    else           o1 = __builtin_amdgcn_mfma_f32_32x32x16_bf16(__builtin_bit_cast(bf16x8, vv), pf[blk][s2], o1, 0, 0, 0); } } \
        if (t + 2 < SEQ / 64) *(LAS u32x4*)(lds + (t & 1) * 8192 + kdst) = kst; \
        if (t + 1 < SEQ / 64) *(LAS u32x4*)(lds + ((t + 1) & 1) * 8192 + vdst) = vst; \
        if (t + 3 < SEQ / 64) kst = *(const u32x4*)(ksrc + (size_t)(t + 3) * 64 * 128); \
        if (t + 2 < SEQ / 64) vst = *(const u32x4*)(vsrc + (t + 2) * 64); \
        __syncthreads(); } while (0)
    for (int u = u_first; u < 512; u += u_stride) {
        const int b = u >> 6, g = (u >> 5) & 1, qt = u & 31;
        const int head = 4 * g + (wave >> 1); const int qrow = b * SEQ + qt * 64 + 32 * (wave & 1) + r32;
        bf16x8 qf[4];
#pragma unroll
        for (int s = 0; s < 4; ++s) qf[s] = *(const bf16x8*)(QH + (size_t)qrow * 512 + head * 64 + 16 * s + 8 * hi);
        const bf16_t* ksrc = KH + (size_t)(b * SEQ + skey) * 128 + g * 64 + 8 * sc;
        const bf16_t* vsrc = VT + ((size_t)(b * 2 + g) * 64 + skey) * SEQ + 8 * sc;
        const int kdst = skey * 128 + ((sc ^ (skey & 7)) * 16), vdst = 16384 + skey * 128 + ((sc ^ ((skey >> 1) & 7)) * 16);
        u32x4 kst = *(const u32x4*)ksrc, vst = *(const u32x4*)vsrc;
        const u32x4 kst1 = *(const u32x4*)(ksrc + (size_t)64 * 128);
        __syncthreads();
        *(LAS u32x4*)(lds + kdst) = kst; *(LAS u32x4*)(lds + vdst) = vst; *(LAS u32x4*)(lds + 8192 + kdst) = kst1;
        kst = *(const u32x4*)(ksrc + (size_t)2 * 64 * 128); vst = *(const u32x4*)(vsrc + 64);
        __syncthreads();
        f32x16 o0 = {}, o1 = {}; float mrun = -1e30f, lrun = 0.f;
        f32x16 ca0, ca1, cb0, cb1;
        AT_QK(ca0, ca1, 0);
        __syncthreads();
        for (int t2 = 0; t2 < SEQ / 64; t2 += 2) { AT_ITER(t2, ca0, ca1, cb0, cb1); AT_ITER(t2 + 1, cb0, cb1, ca0, ca1); }
        const float ltot = lrun + __shfl_xor(lrun, 32); const float inv = 1.f / ltot;
        bf16_t* op = YC + (size_t)qrow * 1024 + 512 + head * 64 + 4 * hi;
#pragma unroll
        for (int q4 = 0; q4 < 4; ++q4) { u32x2 w0, w1;
            w0.x = pk2(o0[4 * q4 + 0] * inv, o0[4 * q4 + 1] * inv); w0.y = pk2(o0[4 * q4 + 2] * inv, o0[4 * q4 + 3] * inv);
            w1.x = pk2(o1[4 * q4 + 0] * inv, o1[4 * q4 + 1] * inv); w1.y = pk2(o1[4 * q4 + 2] * inv, o1[4 * q4 + 3] * inv);
            *(u32x2*)(op + 8 * q4) = w0; *(u32x2*)(op + 32 + 8 * q4) = w1; }
    }
#undef AT_QK
#undef AT_ITER
}

__device__ __forceinline__ void phase_attn(const Frame& F) { phase_attn_range(F, F.vcu, F.G); }
__device__ __forceinline__ void phase_cscan_attn_split(const Frame& F) {
    const int half_g = F.G >> 1, me = F.vcu >> 1;
    if ((F.vcu & 1) == 0) {
        for (int chain = me; chain < 128; chain += half_g) { const int dir = chain & 1, bh = chain >> 1, b = bh >> 3, h = bh & 7;
            for (int q_ = 0; q_ <= (int)((MK_REP_SUB) & 1u); ++q_) { if (dir) cscan_job<1>(F, b, h); else cscan_job<0>(F, b, h); } }
    } else {
        for (int q_ = 0; q_ <= (int)(((MK_REP_SUB) >> 1) & 1u); ++q_)
        for (int u4 = me; u4 * 4 < 512; u4 += half_g) for (int q = 0; q < 4; ++q) phase_attn_range(F, u4 * 4 + q, 1 << 30);
        __syncthreads();
        for (int q_ = 0; q_ <= (int)(((MK_REP_SUB) >> 4) & 1u); ++q_)
        { conv_experts_down(F, me * NWAVES + F.wave, half_g * NWAVES); conv_experts_gu(F, me * NWAVES + F.wave, half_g * NWAVES, EGU_EARLY, NEXP); }
    }
}
__device__ __forceinline__ void phase_rwkv_post(const Frame& F) {
    const int lane = F.lane, wave = F.wave, fr = lane & 15, fq = lane >> 4;
    const bf16_t *YF = wsp<bf16_t>(F.ws, A_YF), *YB = wsp<bf16_t>(F.ws, A_YB);
    const bf16_t *RS = wsp<bf16_t>(F.ws, A_RS), *VS = wsp<bf16_t>(F.ws, A_VS), *KSP = wsp<bf16_t>(F.ws, A_KS), *SGF = wsp<bf16_t>(F.ws, A_SGF);
    const bf16_t* AP = wsp<bf16_t>(F.ws, A_AP) + 128; const bf16_t* WG = wsp<bf16_t>(F.ws, WS_WLR) + (size_t)2048 * 256 + 128;
    bf16_t* YC = wsp<bf16_t>(F.ws, A_YCAT);
    constexpr int GRS = 1040;
    LAS unsigned char* GL = F.lds;
    const int c0 = 8 * lane;
    float gw_[8], gb_[8], rk_[8], ka_[8];
#pragma unroll
    for (int i = 0; i < 8; ++i) { gw_[i] = F.in[16][c0 + i]; gb_[i] = F.in[17][c0 + i]; rk_[i] = F.in[15][c0 + i]; ka_[i] = F.in[14][c0 + i]; }
    for (int tile = F.vcu; tile < M_TOK / 64; tile += F.G) { const int t0 = tile * 64;
        { f32x4 acc[4][4];
#pragma unroll
          for (int nt = 0; nt < 4; ++nt)
#pragma unroll
              for (int mt = 0; mt < 4; ++mt) acc[nt][mt] = (f32x4){0.f, 0.f, 0.f, 0.f};
#pragma unroll
          for (int ks = 0; ks < 4; ++ks) { bf16x8 a[4], b[4];
#pragma unroll
              for (int nt = 0; nt < 4; ++nt) a[nt] = *(const bf16x8*)(WG + (size_t)(64 * wave + 16 * nt + fr) * 256 + 32 * ks + 8 * fq);
#pragma unroll
              for (int mt = 0; mt < 4; ++mt) b[mt] = *(const bf16x8*)(AP + (size_t)(t0 + 16 * mt + fr) * 256 + 32 * ks + 8 * fq);
#pragma unroll
              for (int nt = 0; nt < 4; ++nt)
#pragma unroll
                  for (int mt = 0; mt < 4; ++mt) acc[nt][mt] = __builtin_amdgcn_mfma_f32_16x16x32_bf16(a[nt], b[mt], acc[nt][mt], 0, 0, 0); }
#pragma unroll
          for (int nt = 0; nt < 4; ++nt)
#pragma unroll
              for (int mt = 0; mt < 4; ++mt) { u32x2 w; w.x = pk2(acc[nt][mt][0], acc[nt][mt][1]); w.y = pk2(acc[nt][mt][2], acc[nt][mt][3]);
                  *(LAS u32x2*)(GL + (16 * mt + fr) * GRS + (64 * wave + 16 * nt + 4 * fq) * 2) = w; } }
        __syncthreads();
        for (int j = 0; j < 8; ++j) { const int tl = 8 * wave + j; const size_t o = (size_t)(t0 + tl) * 512 + c0;
            const u32x4 yfw = *(const u32x4*)(YF + o), ybw = *(const u32x4*)(YB + o);
            float y[8]; float sm = 0.f;
            y[0] = bflo(yfw.x) + bflo(ybw.x); y[1] = bfhi(yfw.x) + bfhi(ybw.x); y[2] = bflo(yfw.y) + bflo(ybw.y); y[3] = bfhi(yfw.y) + bfhi(ybw.y);
            y[4] = bflo(yfw.z) + bflo(ybw.z); y[5] = bfhi(yfw.z) + bfhi(ybw.z); y[6] = bflo(yfw.w) + bflo(ybw.w); y[7] = bfhi(yfw.w) + bfhi(ybw.w);
#pragma unroll
            for (int i = 0; i < 8; ++i) sm += y[i];
            sm += __shfl_xor(sm, 1); sm += __shfl_xor(sm, 2); sm += __shfl_xor(sm, 4);
            const float mean = sm * (1.f / 64.f); float sv = 0.f;
#pragma unroll
            for (int i = 0; i < 8; ++i) { y[i] -= mean; sv += y[i] * y[i]; }
            sv += __shfl_xor(sv, 1); sv += __shfl_xor(sv, 2); sv += __shfl_xor(sv, 4);
            const float rstd = __builtin_amdgcn_rsqf(sv * (1.f / 64.f) + 64e-5f);
            const u32x4 rw = *(const u32x4*)(RS + o), vw = *(const u32x4*)(VS + o), kw = *(const u32x4*)(KSP + o), sw = *(const u32x4*)(SGF + o), gw4 = *(const LAS u32x4*)(GL + tl * GRS + c0 * 2);
            float r8[8], v8[8], k8[8], g8[8], s8[8]; unpack8(rw, r8); unpack8(vw, v8); unpack8(kw, k8); unpack8(gw4, g8); unpack8(sw, s8);
#pragma unroll
            for (int i = 0; i < 8; ++i) k8[i] = bf2f(f2bf(k8[i] * (1.f + (s8[i] - 1.f) * ka_[i])));
            float bs = 0.f;
#pragma unroll
            for (int i = 0; i < 8; ++i) bs += r8[i] * k8[i] * rk_[i];
            bs += __shfl_xor(bs, 1); bs += __shfl_xor(bs, 2); bs += __shfl_xor(bs, 4);
            float ov[8];
#pragma unroll
            for (int i = 0; i < 8; ++i) ov[i] = ((y[i] * rstd) * gw_[i] + gb_[i] + bs * v8[i]) * g8[i];
            *(u32x4*)(YC + (size_t)(t0 + tl) * 1024 + c0) = pack8f(ov); }
        __syncthreads(); }
}

__device__ __forceinline__ void phase_gd(const Frame& F) {
    const int tid = F.tid, lane = F.lane, wave = F.wave, fr = lane & 15, fq = lane >> 4;
    LAS f32x4* PL = (LAS f32x4*)F.lds;
    const bf16_t* XB = wsp<bf16_t>(F.ws, WS_XB); const bf16_t* WG = wsp<bf16_t>(F.ws, WS_WIN1) + (size_t)3072 * 1024; const float* ssq = wsp<float>(F.ws, WS_SSQ2); bf16_t* P1 = wsp<bf16_t>(F.ws, A_P1);
    const int tpb = M_TOK / F.G;
    for (int t0 = F.vcu * tpb; t0 < (F.vcu + 1) * tpb; t0 += 64) {
        f32x4 acc[4];
#pragma unroll
        for (int t = 0; t < 4; ++t) acc[t] = (f32x4){0.f, 0.f, 0.f, 0.f};
#pragma unroll
        for (int s4 = 0; s4 < 4; ++s4) { const int k0 = 32 * (4 * wave + s4) + 8 * fq;
            const bf16x8 bfr = *(const bf16x8*)(WG + (size_t)fr * 1024 + k0);
#pragma unroll
            for (int t = 0; t < 4; ++t) { const bf16x8 afr = *(const bf16x8*)(XB + (size_t)(t0 + 16 * t + fr) * 1024 + k0);
                acc[t] = __builtin_amdgcn_mfma_f32_16x16x32_bf16(afr, bfr, acc[t], 0, 0, 0); } }
        __syncthreads();
#pragma unroll
        for (int t = 0; t < 4; ++t) PL[(wave * 4 + t) * 64 + lane] = acc[t];
        __syncthreads();
        if (tid < 256) { const int t = tid >> 6, l = tid & 63; f32x4 sum = PL[t * 64 + l];
#pragma unroll
            for (int w = 1; w < 8; ++w) sum += PL[(w * 4 + t) * 64 + l];
            const int lfr = l & 15, lfq = l >> 4;
#pragma unroll
            for (int r = 0; r < 4; ++r) { const int tok = t0 + 16 * t + 4 * lfq + r; P1[(size_t)tok * O_INP + 3072 + lfr] = f2bf(sum[r] * rstd_from_ssq(ssq, tok)); } }
    }
}

constexpr float GLA_QSCALE = 0.08838834764831845f;
__device__ __forceinline__ size_t gla_dir(size_t base, int dir) { return base + (size_t)dir * GLA_DIR_STRIDE; }
__device__ __forceinline__ float logsig16(float z) { return (fminf(z, 0.f) - __logf(1.f + __expf(-fabsf(z)))) * (1.f / 16.f); }
__device__ __forceinline__ void phase_gla_prep(const Frame& F) {
    const int tid = F.tid, lane = F.lane, wave = F.wave, fr = lane & 15, fq = lane >> 4;
    LAS float* GD = (LAS float*)F.lds;
    LAS float* PT = (LAS float*)(F.lds + 4096);
    LAS unsigned char* QTt = F.lds + 10240;
    LAS unsigned char* KTt = F.lds + 10240 + 17408;
    LAS unsigned char* RV = F.lds + 10240;
    LAS unsigned char* RQ = F.lds + 45056; LAS unsigned char* RK = F.lds + 45056 + 16384;
    LAS unsigned char* ATT = F.lds + 45056;
    LAS unsigned char* QHl = F.lds + 45056 + 9216;
    LAS unsigned char* VTt = F.lds + 77824;
    const bf16_t* P1 = wsp<bf16_t>(F.ws, A_P1);
    bf16_t* VT = wsp<bf16_t>(F.ws, A_VT1); float* DECS = wsp<float>(F.ws, WS_DECS); bf16_t* OF = wsp<bf16_t>(F.ws, A_OF);
    const int d = tid & 127, qr = tid >> 7;
    u32x4 pq[2], pk_[2], pv[4]; bf16_t pg[2];
#define GP_FETCH(u_) do { const int n_ = (u_) & 31, h_ = ((u_) >> 5) & 3, b_ = (u_) >> 7; const int T_ = b_ * SEQ + 64 * n_; \
        _Pragma("unroll") for (int i = 0; i < 2; ++i) { const int p = tid + 512 * i; pg[i] = P1[(size_t)(T_ + (p >> 4)) * O_INP + 3072 + (p & 15)]; \
            const int row = p >> 4, c = p & 15; const bf16_t* src = P1 + (size_t)(T_ + row) * O_INP + h_ * 128 + 8 * c; pq[i] = *(const u32x4*)src; pk_[i] = *(const u32x4*)(src + 512); } \
        _Pragma("unroll") for (int i = 0; i < 4; ++i) { const int p = tid + 512 * i, row = p >> 5, c = p & 31; pv[i] = *(const u32x4*)(P1 + (size_t)(T_ + row) * O_INP + 1024 + h_ * 256 + 8 * c); } } while (0)
    float upf[16], upb[16]; float bif = 0.f, bib = 0.f; int h_cur = -1;
    if (F.vcu < BATCH * GLA_H * 32) GP_FETCH(F.vcu);
    for (int unit = F.vcu; unit < BATCH * GLA_H * 32; unit += F.G) {
        const int n = unit & 31, h = (unit >> 5) & 3, b = unit >> 7; const int T0 = b * SEQ + 64 * n; const size_t tile = (size_t)(b * 4 + h) * 32 + n;
        __syncthreads();
#pragma unroll
        for (int i = 0; i < 2; ++i) { const int p = tid + 512 * i, row = p >> 4, c = p & 15; GD[p] = bf2f(pg[i]);
            *(LAS u32x4*)(RQ + row * 256 + c * 16) = pq[i]; *(LAS u32x4*)(RK + row * 256 + c * 16) = pk_[i]; }
#pragma unroll
        for (int i = 0; i < 4; ++i) { const int p = tid + 512 * i, row = p >> 5, c = p & 31; *(LAS u32x4*)(RV + row * 512 + c * 16) = pv[i]; }
        if (h != h_cur) { h_cur = h;
#pragma unroll
            for (int r = 0; r < 16; ++r) { upf[r] = F.in[27][r * 512 + h * 128 + d]; upb[r] = F.in[29][r * 512 + h * 128 + d]; }
            bif = F.in[28][h * 128 + d]; bib = F.in[30][h * 128 + d]; }
        if (unit + F.G < BATCH * GLA_H * 32) GP_FETCH(unit + F.G);
        __syncthreads();
        bf16_t qraw[16], kraw[16];
#pragma unroll
        for (int j = 0; j < 16; ++j) { qraw[j] = *(const LAS bf16_t*)(RQ + (16 * qr + j) * 256 + d * 2); kraw[j] = *(const LAS bf16_t*)(RK + (16 * qr + j) * 256 + d * 2); }
        { const int dv = tid & 255, th = tid >> 8; unsigned pk[16];
#pragma unroll
          for (int j = 0; j < 16; ++j) pk[j] = (unsigned)*(const LAS bf16_t*)(RV + (32 * th + 2 * j) * 512 + dv * 2) | ((unsigned)*(const LAS bf16_t*)(RV + (32 * th + 2 * j + 1) * 512 + dv * 2) << 16);
          bf16_t* gdst = VT + tile * 16384 + dv * 64 + 32 * th;
#pragma unroll
          for (int q = 0; q < 4; ++q) { const u32x4 w = {pk[4 * q], pk[4 * q + 1], pk[4 * q + 2], pk[4 * q + 3]}; *(u32x4*)(gdst + 8 * q) = w; *(LAS u32x4*)(VTt + dv * 144 + (32 * th + 8 * q) * 2) = w; } }
        float Bf[16], Bb[16];
#pragma unroll
        for (int j = 0; j < 16; ++j) { const LAS f32x4* gp = (const LAS f32x4*)(GD + (16 * qr + j) * 16); float zf = bif, zb = bib;
#pragma unroll
            for (int q = 0; q < 4; ++q) { const f32x4 g4 = gp[q];
#pragma unroll
                for (int e = 0; e < 4; ++e) { zf += g4[e] * upf[4 * q + e]; zb += g4[e] * upb[4 * q + e]; } }
            Bf[j] = logsig16(zf); Bb[j] = logsig16(zb); }
#pragma unroll
        for (int j = 1; j < 16; ++j) Bf[j] += Bf[j - 1];
#pragma unroll
        for (int j = 14; j >= 0; --j) Bb[j] += Bb[j + 1];
        PT[(0 * 4 + qr) * 128 + d] = Bf[15]; PT[(1 * 4 + qr) * 128 + d] = Bb[0];
        if (qr == 2) PT[1024 + d] = Bf[0];
        if (qr == 1) PT[1024 + 128 + d] = Bb[15];
        __syncthreads();
        float offf = 0.f, offb = 0.f, totf = 0.f, totb = 0.f, pre2f = 0.f, suf2b = 0.f;
#pragma unroll
        for (int q = 0; q < 4; ++q) { const float pf = PT[q * 128 + d], pb = PT[(4 + q) * 128 + d]; totf += pf; totb += pb; if (q < qr) offf += pf; if (q > qr) offb += pb; if (q < 2) pre2f += pf; if (q >= 2) suf2b += pb; }
        const float bmf = pre2f + PT[1024 + d], bmb = suf2b + PT[1024 + 128 + d];
#pragma unroll
        for (int j = 0; j < 16; ++j) { Bf[j] += offf; Bb[j] += offb; }
        f32x4 oacc[2][4];
#pragma unroll
        for (int x = 0; x < 2; ++x)
#pragma unroll
            for (int y = 0; y < 4; ++y) oacc[x][y] = (f32x4){0.f, 0.f, 0.f, 0.f};
#pragma unroll
        for (int dir = 0; dir < 2; ++dir) {
            const float bm = dir ? bmb : bmf, bl = dir ? totb : totf; const float ebm = __expf(bm), ebl = __expf(bl - bm);
            bf16_t* QHT = wsp<bf16_t>(F.ws, gla_dir(A_QHAT, dir)) + tile * 8192; bf16_t* K2T = wsp<bf16_t>(F.ws, gla_dir(A_K2T, dir)) + tile * 8192;
            unsigned k2pk[8];
#pragma unroll
            for (int j = 0; j < 16; ++j) { const float bv = dir ? Bb[j] : Bf[j]; const float e1 = __expf(bv - bm), r1 = __builtin_amdgcn_rcpf(e1);
                const float qs = bf2f(qraw[j]) * GLA_QSCALE, kk = bf2f(kraw[j]); const int tk = 16 * qr + j;
                const float qt = qs * e1, kt = kk * r1, qh = qt * ebm, k2 = kt * ebl;
                *(LAS bf16_t*)(QTt + tk * 272 + d * 2) = f2bf(qt); *(LAS bf16_t*)(KTt + tk * 272 + d * 2) = f2bf(kt); *(LAS bf16_t*)(QHl + tk * 272 + d * 2) = f2bf(qh);
                if (j & 1) k2pk[j >> 1] |= ((unsigned)f2bf(k2)) << 16; else k2pk[j >> 1] = (unsigned)f2bf(k2); }
            { bf16_t* kd = K2T + d * 64 + 16 * qr;
              *(u32x4*)kd = (u32x4){k2pk[0], k2pk[1], k2pk[2], k2pk[3]}; *(u32x4*)(kd + 8) = (u32x4){k2pk[4], k2pk[5], k2pk[6], k2pk[7]}; }
            if (qr == 0) DECS[((size_t)((b * 4 + h) * 2 + dir) * 32 + n) * 128 + d] = __expf(bl);
            __syncthreads();
#pragma unroll
            for (int i = 0; i < 2; ++i) { const int p = tid + 512 * i, row = p >> 4, c = p & 15; *(u32x4*)(QHT + row * 128 + c * 8) = *(const LAS u32x4*)(QHl + row * 272 + c * 16); }
            { const int ib = wave >> 1, jb0 = 2 * (wave & 1); f32x4 at[2] = {(f32x4){0.f, 0.f, 0.f, 0.f}, (f32x4){0.f, 0.f, 0.f, 0.f}};
#pragma unroll
              for (int s2 = 0; s2 < 4; ++s2) { const bf16x8 a = *(const LAS bf16x8*)(QTt + (16 * ib + fr) * 272 + (32 * s2 + 8 * fq) * 2);
#pragma unroll
                  for (int jj = 0; jj < 2; ++jj) { const bf16x8 bb = *(const LAS bf16x8*)(KTt + (16 * (jb0 + jj) + fr) * 272 + (32 * s2 + 8 * fq) * 2);
                      at[jj] = __builtin_amdgcn_mfma_f32_16x16x32_bf16(a, bb, at[jj], 0, 0, 0); } }
#pragma unroll
              for (int jj = 0; jj < 2; ++jj)
#pragma unroll
                  for (int r = 0; r < 4; ++r) { const int i = 16 * ib + 4 * fq + r, j = 16 * (jb0 + jj) + fr; const bool keep = dir ? (j > i) : (j <= i);
                      *(LAS bf16_t*)(ATT + i * 144 + j * 2) = f2bf(keep ? at[jj][r] : 0.f); } }
            __syncthreads();
#pragma unroll
            for (int s2 = 0; s2 < 2; ++s2) { bf16x8 bfr[4];
#pragma unroll
                for (int ib = 0; ib < 4; ++ib) bfr[ib] = *(const LAS bf16x8*)(ATT + (16 * ib + fr) * 144 + (32 * s2 + 8 * fq) * 2);
#pragma unroll
                for (int x = 0; x < 2; ++x) { const bf16x8 a = *(const LAS bf16x8*)(VTt + (16 * (2 * wave + x) + fr) * 144 + (32 * s2 + 8 * fq) * 2);
#pragma unroll
                    for (int ib = 0; ib < 4; ++ib) oacc[x][ib] = __builtin_amdgcn_mfma_f32_16x16x32_bf16(a, bfr[ib], oacc[x][ib], 0, 0, 0); } }
        }
#pragma unroll
        for (int x = 0; x < 2; ++x)
#pragma unroll
            for (int ib = 0; ib < 4; ++ib) { u32x2 w; w.x = pk2(oacc[x][ib][0], oacc[x][ib][1]); w.y = pk2(oacc[x][ib][2], oacc[x][ib][3]);
                *(u32x2*)(OF + (size_t)(T0 + 16 * ib + fr) * 1024 + h * 256 + 16 * (2 * wave + x) + 4 * fq) = w; }
    }
}
#undef GP_FETCH

template <int DIR> __device__ __forceinline__ void gla_seq_job(const Frame& F, int b, int h, int vs) {
    const int tid = F.tid, lane = F.lane, wave = F.wave, fr = lane & 15, fq = lane >> 4;
    LAS unsigned char* ST0 = F.lds; LAS unsigned char* ST1 = F.lds + 17408;
    LAS unsigned char* BUF = F.lds + 34816;
    constexpr int BQ = 0, BK2 = 17408, BVT = 17408 + 18432, BSZ = 45056;
    const bf16_t* QHT = wsp<bf16_t>(F.ws, gla_dir(A_QHAT, DIR)); const bf16_t* K2T = wsp<bf16_t>(F.ws, gla_dir(A_K2T, DIR));
    const bf16_t* VT = wsp<bf16_t>(F.ws, A_VT1); const float* DECS = wsp<float>(F.ws, WS_DECS); bf16_t* OF = wsp<bf16_t>(F.ws, A_OF); bf16_t* O = DIR ? wsp<bf16_t>(F.ws, A_OB) : OF;
    const int dvb = wave >> 1, ib0 = 2 * (wave & 1);
    const size_t tile0 = (size_t)(b * 4 + h) * 32;
    const int q0 = tid, q1 = tid + 512;
    const int dq0 = BQ + (q0 >> 4) * 272 + (q0 & 15) * 16, dq1 = BQ + (q1 >> 4) * 272 + (q1 & 15) * 16;
    const int dk0 = BK2 + (q0 >> 3) * 144 + (q0 & 7) * 16, dk1 = BK2 + (q1 >> 3) * 144 + (q1 & 7) * 16;
    const int dv0 = BVT + (q0 >> 3) * 144 + (q0 & 7) * 16;
    u32x4 sg[5]; f32x4 dec, decn; u32x2 oold[2], ooldn[2];
#define GL_LD(n_) do { const size_t t_ = tile0 + (n_); \
        sg[0] = *(const u32x4*)(QHT + t_ * 8192 + q0 * 8); sg[1] = *(const u32x4*)(QHT + t_ * 8192 + q1 * 8); \
        sg[2] = *(const u32x4*)(K2T + t_ * 8192 + q0 * 8); sg[3] = *(const u32x4*)(K2T + t_ * 8192 + q1 * 8); \
        sg[4] = *(const u32x4*)(VT + t_ * 16384 + vs * 4096 + q0 * 8); \
        decn = *(const f32x4*)(DECS + ((size_t)((b * 4 + h) * 2 + DIR) * 32 + (n_)) * 128 + 16 * wave + 4 * fq); \
        if (!DIR) { _Pragma("unroll") for (int ii = 0; ii < 2; ++ii) ooldn[ii] = *(const u32x2*)(OF + (size_t)(b * SEQ + 64 * (n_) + 16 * (ib0 + ii) + fr) * 1024 + h * 256 + 64 * vs + 16 * dvb + 4 * fq); } } while (0)
#define GL_ST(bp) do { *(LAS u32x4*)((bp) + dq0) = sg[0]; *(LAS u32x4*)((bp) + dq1) = sg[1]; *(LAS u32x4*)((bp) + dk0) = sg[2]; *(LAS u32x4*)((bp) + dk1) = sg[3]; *(LAS u32x4*)((bp) + dv0) = sg[4]; } while (0)
    __syncthreads();
    for (int i = tid; i < 17408 / 4; i += 512) ((LAS unsigned*)ST0)[i] = 0u;
    f32x4 st[4];
#pragma unroll
    for (int k = 0; k < 4; ++k) st[k] = (f32x4){0.f, 0.f, 0.f, 0.f};
    GL_LD(DIR ? 31 : 0); GL_ST(BUF); dec = decn; oold[0] = ooldn[0]; oold[1] = ooldn[1];
    __syncthreads();
    for (int cc = 0; cc < 32; ++cc) { const int n = DIR ? 31 - cc : cc, nn = DIR ? 30 - cc : cc + 1; const int T0 = b * SEQ + 64 * n;
        LAS unsigned char* STr = (cc & 1) ? ST1 : ST0; LAS unsigned char* STw = (cc & 1) ? ST0 : ST1;
        LAS unsigned char* bc = BUF + (cc & 1) * BSZ; LAS unsigned char* bn = BUF + ((cc + 1) & 1) * BSZ;
        if (cc + 1 < 32) GL_LD(nn);
#pragma unroll
        for (int x = 0; x < 4; ++x) st[x] = st[x] * dec;
        f32x4 oo[2] = {(f32x4){0.f, 0.f, 0.f, 0.f}, (f32x4){0.f, 0.f, 0.f, 0.f}};
#pragma unroll
        for (int s2 = 0; s2 < 4; ++s2) { const bf16x8 a = *(const LAS bf16x8*)(STr + (16 * dvb + fr) * 272 + (32 * s2 + 8 * fq) * 2);
#pragma unroll
            for (int ii = 0; ii < 2; ++ii) { const bf16x8 qf = *(const LAS bf16x8*)(bc + BQ + (16 * (ib0 + ii) + fr) * 272 + (32 * s2 + 8 * fq) * 2);
                oo[ii] = __builtin_amdgcn_mfma_f32_16x16x32_bf16(a, qf, oo[ii], 0, 0, 0); } }
#pragma unroll
        for (int s2 = 0; s2 < 2; ++s2) { const bf16x8 kf = *(const LAS bf16x8*)(bc + BK2 + (16 * wave + fr) * 144 + (32 * s2 + 8 * fq) * 2);
#pragma unroll
            for (int x = 0; x < 4; ++x) { const bf16x8 vf = *(const LAS bf16x8*)(bc + BVT + (16 * x + fr) * 144 + (32 * s2 + 8 * fq) * 2);
                st[x] = __builtin_amdgcn_mfma_f32_16x16x32_bf16(kf, vf, st[x], 0, 0, 0); } }
#pragma unroll
        for (int x = 0; x < 4; ++x) { u32x2 w; w.x = pk2(st[x][0], st[x][1]); w.y = pk2(st[x][2], st[x][3]); *(LAS u32x2*)(STw + (16 * x + fr) * 272 + (16 * wave + 4 * fq) * 2) = w; }
#pragma unroll
        for (int ii = 0; ii < 2; ++ii) { f32x4 v = oo[ii];
            if (!DIR) { v[0] += bflo(oold[ii].x); v[1] += bfhi(oold[ii].x); v[2] += bflo(oold[ii].y); v[3] += bfhi(oold[ii].y); }
            u32x2 w; w.x = pk2(v[0], v[1]); w.y = pk2(v[2], v[3]);
            *(u32x2*)(O + (size_t)(T0 + 16 * (ib0 + ii) + fr) * 1024 + h * 256 + 64 * vs + 16 * dvb + 4 * fq) = w; }
        if (cc + 1 < 32) { GL_ST(bn); dec = decn; oold[0] = ooldn[0]; oold[1] = ooldn[1]; }
        __syncthreads(); }
#undef GL_LD
#undef GL_ST
}
__device__ __forceinline__ void phase_gla_main(const Frame& F) {
    for (int job = F.vcu; job < 256; job += F.G) { const int vs = job & 3, dir = (job >> 2) & 1, h = (job >> 3) & 3, b = job >> 5;
        if (dir) gla_seq_job<1>(F, b, h, vs); else gla_seq_job<0>(F, b, h, vs); }
}

__device__ __forceinline__ void phase_gla_post(const Frame& F) {
    const int gw = F.vcu * NWAVES + F.wave, lane = F.lane; const int c0 = 16 * lane;
    const bf16_t *OF = wsp<bf16_t>(F.ws, A_OF), *OB = wsp<bf16_t>(F.ws, A_OB), *P1 = wsp<bf16_t>(F.ws, A_P1); bf16_t* GO = wsp<bf16_t>(F.ws, A_GOUT);
    float gn[16];
#pragma unroll
    for (int i = 0; i < 16; ++i) gn[i] = F.in[31][(c0 + i) & 255];
    for (int tok = gw; tok < M_TOK; tok += F.G * NWAVES) { const size_t o = (size_t)tok * 1024 + c0;
        float v[16]; float ss = 0.f;
#pragma unroll
        for (int hh = 0; hh < 2; ++hh) { const u32x4 a = *(const u32x4*)(OF + o + 8 * hh), bq = *(const u32x4*)(OB + o + 8 * hh);
            v[8 * hh + 0] = bflo(a.x) + bflo(bq.x); v[8 * hh + 1] = bfhi(a.x) + bfhi(bq.x); v[8 * hh + 2] = bflo(a.y) + bflo(bq.y); v[8 * hh + 3] = bfhi(a.y) + bfhi(bq.y);
            v[8 * hh + 4] = bflo(a.z) + bflo(bq.z); v[8 * hh + 5] = bfhi(a.z) + bfhi(bq.z); v[8 * hh + 6] = bflo(a.w) + bflo(bq.w); v[8 * hh + 7] = bfhi(a.w) + bfhi(bq.w); }
#pragma unroll
        for (int i = 0; i < 16; ++i) ss += v[i] * v[i];
        ss = dpp_row_sum(ss);
        const float rs = __builtin_amdgcn_rsqf(ss * (1.f / 256.f) + NORM_EPS);
        float og[16];
#pragma unroll
        for (int hh = 0; hh < 2; ++hh) { const u32x4 g = *(const u32x4*)(P1 + (size_t)tok * O_INP + 2048 + c0 + 8 * hh);
            og[8 * hh + 0] = bflo(g.x); og[8 * hh + 1] = bfhi(g.x); og[8 * hh + 2] = bflo(g.y); og[8 * hh + 3] = bfhi(g.y); og[8 * hh + 4] = bflo(g.z); og[8 * hh + 5] = bfhi(g.z); og[8 * hh + 6] = bflo(g.w); og[8 * hh + 7] = bfhi(g.w); }
        float r[16];
#pragma unroll
        for (int i = 0; i < 16; ++i) r[i] = v[i] * rs * gn[i] * siluf_(og[i]);
#pragma unroll
        for (int hh = 0; hh < 2; ++hh) { u32x4 w; w.x = pk2(r[8 * hh + 0], r[8 * hh + 1]); w.y = pk2(r[8 * hh + 2], r[8 * hh + 3]); w.z = pk2(r[8 * hh + 4], r[8 * hh + 5]); w.w = pk2(r[8 * hh + 6], r[8 * hh + 7]);
            *(u32x4*)(GO + o + 8 * hh) = w; } }
}

__device__ __forceinline__ void phase_route(const Frame& F) {
    const int tid = F.tid, lane = F.lane, wave = F.wave;
    LAS int* lcnt = (LAS int*)(F.lds + MOE_OFF);
    LAS float* RL = (LAS float*)F.lds;
    __syncthreads();
    if (tid < 16) lcnt[tid] = 0;
    const bf16_t* X = wsp<bf16_t>(F.ws, WS_XB); const float* g2 = F.in[33]; const float* RT = F.in[34];
    for (int i = tid; i < 2048; i += 512) { const int k = i >> 1; const f32x4 r = *(const f32x4*)(RT + (size_t)i * 4); *(LAS f32x4*)(RL + i * 4) = r * g2[k]; }
    __syncthreads();
    int* TE = wsp<int>(F.ws, WS_TOKE); float* TG = wsp<float>(F.ws, WS_TOKG); float* R3 = wsp<float>(F.ws, WS_RSTD3);
    const int tpb = M_TOK / F.G, tpw = tpb / NWAVES;
    for (int i0 = 0; i0 < tpw; i0 += 4) { const int tok0 = F.vcu * tpb + wave * tpw + i0;
        float acc[4][8], ss[4];
#pragma unroll
        for (int t = 0; t < 4; ++t) { ss[t] = 0.f;
#pragma unroll
            for (int e = 0; e < 8; ++e) acc[t][e] = 0.f; }
#pragma unroll
        for (int j = 0; j < 4; ++j) { const int k0 = 4 * lane + 256 * j; f32x4 xv[4];
#pragma unroll
            for (int t = 0; t < 4; ++t) { const u32x2 w = *(const u32x2*)(X + (size_t)(tok0 + t) * 1024 + k0); xv[t] = (f32x4){bflo(w.x), bfhi(w.x), bflo(w.y), bfhi(w.y)}; }
#pragma unroll
            for (int q = 0; q < 4; ++q) { const f32x4 r0 = *(const LAS f32x4*)(RL + (k0 + q) * 8), r1 = *(const LAS f32x4*)(RL + (k0 + q) * 8 + 4);
#pragma unroll
                for (int t = 0; t < 4; ++t) { const float xx = xv[t][q]; ss[t] += xx * xx;
                    acc[t][0] += xx * r0[0]; acc[t][1] += xx * r0[1]; acc[t][2] += xx * r0[2]; acc[t][3] += xx * r0[3]; acc[t][4] += xx * r1[0]; acc[t][5] += xx * r1[1]; acc[t][6] += xx * r1[2]; acc[t][7] += xx * r1[3]; } } }
#pragma unroll
        for (int t = 0; t < 4; ++t) { ss[t] = wave_sum(ss[t]);
#pragma unroll
            for (int e = 0; e < 8; ++e) acc[t][e] = wave_sum(acc[t][e]); }
        float lg[8]; float mss = 0.f;
#pragma unroll
        for (int t = 0; t < 4; ++t) { if (lane == t) { mss = ss[t];
#pragma unroll
                for (int e = 0; e < 8; ++e) lg[e] = acc[t][e]; } }
        if (lane < 4) { const int tok = tok0 + lane;
            const float rstd = 1.0f / sqrtf(mss * (1.f / 1024.f) + NORM_EPS);
            int i1 = 0; float l1 = lg[0] * rstd;
#pragma unroll
            for (int e = 1; e < 8; ++e) { const float l = lg[e] * rstd; if (l > l1) { l1 = l; i1 = e; } }
            int i2 = -1; float l2 = -3.0e38f;
#pragma unroll
            for (int e = 0; e < 8; ++e) { const float l = lg[e] * rstd; if (e != i1 && l > l2) { l2 = l; i2 = e; } }
            const float e2 = __expf(l2 - l1); const float ga = 1.f / (1.f + e2), gb = e2 / (1.f + e2);
            TE[tok * 2] = i1; TE[tok * 2 + 1] = i2; TG[tok * 2] = ga; TG[tok * 2 + 1] = gb; R3[tok] = rstd;
            atomicAdd((int*)&lcnt[i1], 1); atomicAdd((int*)&lcnt[8 + i2], 1); } }
    __syncthreads();
    if (tid < 16) wsp<int>(F.ws, WS_CNT)[F.vcu * 16 + tid] = lcnt[tid];
}
__device__ __forceinline__ void phase_place(const Frame& F) {
    const int tid = F.tid;
    LAS int* tab = (LAS int*)(F.lds + MOE_OFF);
    LAS int* C = (LAS int*)F.lds;
    LAS int* TEl = (LAS int*)(F.lds + 32768); LAS float* TGl = (LAS float*)(F.lds + 32768 + 1024);
    const int* CNT = wsp<int>(F.ws, WS_CNT); const int tpb = M_TOK / F.G;
    __syncthreads();
    for (int i = tid; i < F.G * 16; i += 512) C[i] = CNT[i];
    if (tid < 2 * tpb) { TEl[tid] = wsp<int>(F.ws, WS_TOKE)[F.vcu * tpb * 2 + tid]; TGl[tid] = wsp<float>(F.ws, WS_TOKG)[F.vcu * tpb * 2 + tid]; }
    __syncthreads();
    if (tid < 16) { int off = 0, tot = 0; for (int bb = 0; bb < F.G; ++bb) { const int c = C[bb * 16 + tid]; if (bb < F.vcu) off += c; tot += c; } tab[tid] = off; tab[16 + tid] = tot;
        if (F.vcu == 0) wsp<int>(F.ws, WS_TOT)[tid] = tot; }
    __syncthreads();
    if (tid < 16) { const int s = tid >> 3, e = tid & 7; int run = tab[tid]; for (int q = 0; q < e; ++q) run += tab[16 + q] + tab[24 + q];
        if (s) run += tab[16 + e];
        int* RTK = wsp<int>(F.ws, WS_ROWTOK); float* RGT = wsp<float>(F.ws, WS_ROWGATE);
        for (int i = 0; i < tpb; ++i) { if (TEl[i * 2 + s] == e) { RTK[run] = F.vcu * tpb + i; RGT[run] = TGl[i * 2 + s]; ++run; } } }
}
struct MoESched {
    pg8::GridOrder go; const LAS int* tab;
    const char* A; const char* Bt; size_t a_rowbytes, b_expert_bytes, b_tile_bytes; bool gather; int nt_;
    __device__ bool next(int i, pg8::Unit& u) const {
        int pm, pn; if (!go.tile(i, pm, pn)) return false;
        int e = 0;
#pragma unroll
        for (int q = 1; q < 8; ++q) if (pm >= tab[16 + q]) e = q;
        e = __builtin_amdgcn_readfirstlane(e);
        const int mt = pm - __builtin_amdgcn_readfirstlane(tab[16 + e]); const int row0 = __builtin_amdgcn_readfirstlane(tab[e]) + 256 * mt; int nr = __builtin_amdgcn_readfirstlane(tab[8 + e]) - 256 * mt; nr = nr > 256 ? 256 : nr;
        u.pm = pm; u.pn = pn; u.e = e; u.row0 = row0; u.nrows = nr; u.nt = nt_; u.flags = 0; u.rot = 0;
        u.a = gather ? A : A + (size_t)row0 * a_rowbytes; u.b = Bt + (size_t)e * b_expert_bytes + (size_t)pn * b_tile_bytes + (e >= EGU_EARLY ? WEGU_HI_SHIFT : (size_t)0); return true;
    }
};
struct MoEDownSched {
    const LAS int* tab; const char* A; const char* Bt; int nmt, c, round;
    __device__ void fill(pg8::Unit& u, int pm, int pn, int kp, int nt, int flags) const {
        int e = 0;
#pragma unroll
        for (int q = 1; q < 8; ++q) if (pm >= tab[16 + q]) e = q;
        e = __builtin_amdgcn_readfirstlane(e);
        const int mt = pm - __builtin_amdgcn_readfirstlane(tab[16 + e]); const int row0 = __builtin_amdgcn_readfirstlane(tab[e]) + 256 * mt; int nr = __builtin_amdgcn_readfirstlane(tab[8 + e]) - 256 * mt; nr = nr > 256 ? 256 : nr;
        u.pm = pm; u.pn = pn; u.e = e; u.row0 = row0; u.nrows = nr; u.nt = nt; u.flags = flags; u.rot = 0;
        u.a = A + (size_t)row0 * (D_FFE * 2) + (size_t)kp * 512 * 2; u.b = Bt + (size_t)e * ((size_t)1024 * D_FFE * 2) + (size_t)pn * ((size_t)256 * D_FFE * 2) + (size_t)kp * 512 * 2;
    }
    __device__ bool next(int i, pg8::Unit& u) const {
        if (i != 0) return false;
        if (round == 0) { const int pm = 8 * (c & 7) + ((c >> 3) & 7), pn = c >> 6; if (pm >= nmt) return false; fill(u, pm, pn, 0, D_FFE / 64, 0); u.rot = ((c & 7) * 7) & ~1; return true; }
        { const int t = c / 7, kp = c % 7; const int pm = 64 + (t >> 2), pn = t & 3; if (pm >= nmt || t >= 36) return false; fill(u, pm, pn, kp, 8, 1 + c); return true; }
        return false;
    }
};
__device__ __forceinline__ int moe_table(const Frame& F, int mode) {
    LAS int* tab = (LAS int*)(F.lds + MOE_OFF);
    __syncthreads();
    if (F.tid == 0) { const int* TOT = wsp<int>(F.ws, WS_TOT); int rs = 0, ts = 0;
        for (int e = 0; e < 8; ++e) { const int c0 = TOT[e], c1 = TOT[8 + e]; const int st = rs + (mode == 1 ? c0 : 0), c = mode == 0 ? c0 : (mode == 1 ? c1 : c0 + c1);
            tab[e] = st; tab[8 + e] = c; tab[16 + e] = ts; rs += c0 + c1; ts += (c + 255) >> 8; }
        tab[24] = ts; }
    __syncthreads();
    return __builtin_amdgcn_readfirstlane(tab[24]);
}

__device__ __forceinline__ void moe_tail_reduce(const Frame& F, int s) {
    const int nmt = moe_table(F, s); const LAS int* tab = (const LAS int*)(F.lds + MOE_OFF);
    const int R = (nmt - 64) * 4; const int gw = F.vcu * NWAVES + F.wave, lane = F.lane;
    const float* part = wsp<float>(F.ws, s ? A_WEGU2 : A_WEGU); const int* RTK = wsp<int>(F.ws, WS_ROWTOK); const float* RGT = wsp<float>(F.ws, WS_ROWGATE);
    for (int idx = gw; idx < R * 256; idx += F.G * NWAVES) { const int t = idx >> 8, r = idx & 255; const int pm = 64 + (t >> 2), pn = t & 3;
        int e = 0;
#pragma unroll
        for (int q = 1; q < 8; ++q) if (pm >= tab[16 + q]) e = q;
        const int mt = pm - tab[16 + e]; const int row0 = tab[e] + 256 * mt; const int nr = tab[8 + e] - 256 * mt;
        if (r < nr) { const int tok = RTK[row0 + r] & 16383; const float gt = RGT[row0 + r];
            f32x4 a = {0.f, 0.f, 0.f, 0.f};
#pragma unroll
            for (int kp = 0; kp < 7; ++kp) a += *(const f32x4*)(part + ((size_t)(t * 7 + kp) * 256 + r) * 256 + 4 * lane);
            bf16_t* xp = wsp<bf16_t>(F.ws, WS_XB) + (size_t)tok * 1024 + 256 * pn + 4 * lane; const u32x2 w = *(const u32x2*)xp;
            f32x4 o = {bflo(w.x), bfhi(w.x), bflo(w.y), bfhi(w.y)}; o += a * gt;
            if (s == 0) { u32x2 r; r.x = pk2(o[0], o[1]); r.y = pk2(o[2], o[3]); *(u32x2*)xp = r; }
            else *(f32x4*)(F.out + (size_t)tok * 1024 + 256 * pn + 4 * lane) = o; } }
}

constexpr int N_PHASES = 21;
__global__ void __launch_bounds__(NWAVES * 64, 2) mk_fwd(Args args) {
    extern __shared__ __attribute__((aligned(16))) unsigned char lds_raw[];
    Frame F; F.lds = (LAS unsigned char*)lds_raw; F.ws = args.ws; F.in = args.in; F.out = args.out;
    F.tid = threadIdx.x; F.lane = F.tid & 63; F.wave = __builtin_amdgcn_readfirstlane(F.tid >> 6);
    F.G = gridDim.x; { const int bx = blockIdx.x; F.vcu = (F.G % 8 == 0) ? (bx % 8) * (F.G / 8) + bx / 8 : bx; }
    volatile LAS unsigned* MISC = (volatile LAS unsigned*)(F.lds + MISC_OFF);
    if (F.tid < 64) MISC[F.tid] = 0u;
    __syncthreads();
    XcdBarrier bar; bar.bar = (unsigned*)(args.ws + WS_CTL) + CW_BAR; bar.x = 0; bar.st = nullptr;
    const int lo = args.ph_lo, hi = args.ph_hi;
    const bool multi = (hi - lo) > 1;
    if (multi) bar = xcd_barrier_post((unsigned*)(args.ws + WS_CTL) + CW_BAR, MISC + 8);
#ifdef PH_ONLY
#define IN(k) ((k) == PH_ONLY && lo <= (k) && (k) < hi)
#else
#define IN(k) (lo <= (k) && (k) < hi)
#endif
#define SEAM(k) do { if (IN(k) && IN((k) + 1)) xcd_barrier(bar); } while (0)
    unsigned char* ws = args.ws; const int cid = (int)blockIdx.x;
#define REFRESH() do { int t_ = threadIdx.x; asm volatile("" : "+v"(t_)); F.tid = t_; F.lane = t_ & 63; F.wave = __builtin_amdgcn_readfirstlane(t_ >> 6); unsigned long long w_ = (unsigned long long)args.ws; asm volatile("" : "+s"(w_)); F.ws = (unsigned char*)w_; ws = F.ws; } while (0)
    LAS unsigned char* ring = F.lds;

#ifndef MK_REP_MASK
#define MK_REP_MASK 0u
#endif
#define REPS(k) ((int)(((unsigned)(MK_REP_MASK) >> (k)) & 1u))
#define PHASE(k, ...) do { if (IN(k)) { for (int rep_ = 0; rep_ <= REPS(k); ++rep_) { if (rep_) xcd_barrier(bar); REFRESH(); __VA_ARGS__ } } SEAM(k); } while (0)
    PHASE(0, phase_prologue(F););
    PHASE(1, {
        pg8::DenseSched S; S.init(wsp<bf16_t>(ws, WS_XB), wsp<bf16_t>(ws, WS_WIN0), M_TOK, E_IN, 1024, F.G, cid);
        EpiScaleBf16 E{wsp<bf16_t>(ws, A_P0), E_IN, wsp<float>(ws, WS_SSQ0)};
        pg8::gemm_phase<EpiScaleBf16, pg8::DenseSched, false>(F.tid, ring, 1024, S, E, nullptr);
        if (F.G == 256 && cid >= 128 && rep_ == 0) { REFRESH(); conv_group(F, 1, (cid - 128) * NWAVES + F.wave, 128 * NWAVES); } });
    PHASE(2, phase_prep0(F););
    PHASE(3, {
        LowRankSched S; S.init(wsp<bf16_t>(ws, A_AP), wsp<bf16_t>(ws, WS_WLR), F.G, cid);
        EpiLowRank E{ws, F.in};
        pg8::gemm_phase<EpiLowRank, LowRankSched, false>(F.tid, ring, 256, S, E, nullptr); });
    PHASE(4, phase_cscan_attn_split(F););
    PHASE(5, phase_rwkv_post(F););
    PHASE(6, {
        pg8::DenseSched S; S.init(wsp<bf16_t>(ws, A_YCAT), wsp<bf16_t>(ws, WS_WOUT0), M_TOK, 1024, 1024, F.G, cid);
        EpiResidBf E{rep_ ? wsp<bf16_t>(ws, A_YF) : wsp<bf16_t>(ws, WS_XB), nullptr, rep_ ? wsp<float>(ws, WS_SSQ0) : wsp<float>(ws, WS_SSQ1)};
        pg8::gemm_phase<EpiResidBf, pg8::DenseSched, false>(F.tid, ring, 1024, S, E, nullptr); });
    PHASE(7, {
        pg8::DenseSched S; S.init(wsp<bf16_t>(ws, WS_XB), wsp<bf16_t>(ws, WS_WGU0), M_TOK, 2 * D_FF, 1024, F.G, cid);
        EpiSwiGLU E{wsp<bf16_t>(ws, A_HID0), D_FF, wsp<float>(ws, WS_SSQ1)};
        pg8::gemm_phase<EpiSwiGLU, pg8::DenseSched, false>(F.tid, ring, 1024, S, E, nullptr);
        if (F.G == 256 && cid >= 128 && rep_ == 0) { REFRESH(); conv_group(F, 2, (cid - 128) * NWAVES + F.wave, 128 * NWAVES); } });
    PHASE(8, {
        pg8::DenseSched S; S.init(wsp<bf16_t>(ws, A_HID0), wsp<bf16_t>(ws, WS_WD0), M_TOK, 1024, D_FF, F.G, cid);
        EpiResidBf E{rep_ ? wsp<bf16_t>(ws, A_YF) : wsp<bf16_t>(ws, WS_XB), nullptr, rep_ ? wsp<float>(ws, WS_SSQ0) : wsp<float>(ws, WS_SSQ2)};
        pg8::gemm_phase<EpiResidBf, pg8::DenseSched, false>(F.tid, ring, D_FF, S, E, nullptr); });
    PHASE(9, {
        pg8::DenseSched S; S.init(wsp<bf16_t>(ws, WS_XB), wsp<bf16_t>(ws, WS_WIN1), M_TOK, 3072, 1024, F.G, cid);
        EpiScaleBf16 E{wsp<bf16_t>(ws, A_P1), O_INP, wsp<float>(ws, WS_SSQ2)};
        pg8::gemm_phase<EpiScaleBf16, pg8::DenseSched, false>(F.tid, ring, 1024, S, E, nullptr);
        REFRESH(); phase_gd(F); });
    PHASE(10, phase_gla_prep(F););
    PHASE(11, phase_gla_main(F););
    PHASE(12, phase_gla_post(F););
    PHASE(13, {
        pg8::DenseSched S; S.init(wsp<bf16_t>(ws, A_GOUT), wsp<bf16_t>(ws, WS_WOUT1), M_TOK, 1024, 1024, F.G, cid);
        EpiResidBf E{rep_ ? wsp<bf16_t>(ws, A_VT1) : wsp<bf16_t>(ws, WS_XB), nullptr, nullptr};
        pg8::gemm_phase<EpiResidBf, pg8::DenseSched, false>(F.tid, ring, 1024, S, E, nullptr); });
    PHASE(14, for (int q_ = 0; q_ <= (int)(((MK_REP_SUB) >> 2) & 1u); ++q_) { phase_route(F); __syncthreads(); REFRESH(); }
              for (int q_ = 0; q_ <= (int)(((MK_REP_SUB) >> 3) & 1u); ++q_) { phase_conv_experts(F); __syncthreads(); REFRESH(); });
    PHASE(15, phase_place(F););
    PHASE(16, {
        const int nmt = moe_table(F, 2);
        MoESched S; S.go.init(nmt, 2 * D_FFE / 256, F.G, cid); S.tab = (const LAS int*)(F.lds + MOE_OFF);
        S.A = (const char*)wsp<bf16_t>(ws, WS_XB); S.Bt = (const char*)wsp<bf16_t>(ws, A_WEGU); S.a_rowbytes = 0; S.b_expert_bytes = (size_t)2 * D_FFE * 1024 * 2; S.b_tile_bytes = (size_t)256 * 1024 * 2; S.gather = true; S.nt_ = 16;
        const int* rtk = wsp<int>(ws, WS_ROWTOK);
        EpiSwiGLUMoE E{wsp<bf16_t>(ws, A_HID1), wsp<float>(ws, WS_RSTD3), rtk};
        pg8::gemm_phase<EpiSwiGLUMoE, MoESched, true>(F.tid, ring, 1024, S, E, rtk); });
#pragma unroll 1
    for (int s = 0; s < 2; ++s) {
        PHASE(17 + 2 * s, {
            const int nmt = moe_table(F, s);
            MoEDownSched S; S.tab = (const LAS int*)(F.lds + MOE_OFF); S.A = (const char*)wsp<bf16_t>(ws, A_HID1); S.Bt = (const char*)wsp<bf16_t>(ws, A_WED); S.nmt = nmt; S.c = cid; S.round = 0;
            EpiMoEDown E{F.out, wsp<int>(ws, WS_ROWTOK), wsp<float>(ws, WS_ROWGATE), wsp<bf16_t>(ws, WS_XB), s == 1};
            pg8::gemm_phase<EpiMoEDown, MoEDownSched, false>(F.tid, ring, D_FFE, S, E, nullptr);
            REFRESH(); S.round = 1; EpiPart EP{wsp<float>(ws, s ? A_WEGU2 : A_WEGU)};
            pg8::gemm_phase<EpiPart, MoEDownSched, false>(F.tid, ring, D_FFE, S, EP, nullptr); });
        PHASE(18 + 2 * s, moe_tail_reduce(F, s););
    }
#undef PHASE
#undef REPS
#undef IN
#undef SEAM
}

extern "C" void kernel_launch(void* const* d_in, const int* in_sizes, int n_in, void* d_out, int out_size, void* d_ws, size_t ws_size, hipStream_t stream) {
    static int grid = 0;
    if (grid == 0) {
        if (n_in != 38 || out_size != M_TOK * D_MODEL || ws_size < WS_END) { fprintf(stderr, "kernel_launch: unexpected shapes: n_in %d out %d ws %zu (need %zu)\n", n_in, out_size, ws_size, (size_t)WS_END); grid = -1; return; }
        int dev = 0, cus = 0;
        if (hipGetDevice(&dev) != hipSuccess || hipDeviceGetAttribute(&cus, hipDeviceAttributeMultiprocessorCount, dev) != hipSuccess) { grid = -1; return; }
        if (hipFuncSetAttribute((const void*)mk_fwd, hipFuncAttributeMaxDynamicSharedMemorySize, LDS_BYTES) != hipSuccess) { fprintf(stderr, "kernel_launch: hipFuncSetAttribute failed\n"); grid = -1; return; }
        (void)hipGetLastError();
        grid = cus;
        if (grid != 256) fprintf(stderr, "kernel_launch: note: %d CUs (built for 256)\n", grid);
    }
    if (grid < 0) return;
    (void)hipMemsetAsync((char*)d_ws + WS_CTL, 0, CTL_ZERO_BYTES, stream);
    Args a{};
    for (int i = 0; i < 38; ++i) a.in[i] = (const float*)d_in[i];
    a.out = (float*)d_out; a.ws = (unsigned char*)d_ws;
#if MK_N_LAUNCHES == 1
    a.ph_lo = 0; a.ph_hi = N_PHASES - 1 + 0;
    a.ph_hi = 21;
    hipLaunchKernelGGL(mk_fwd, dim3(grid), dim3(NWAVES * 64), LDS_BYTES, stream, a);
#else
#ifndef MK_LAST_PHASE
#define MK_LAST_PHASE 20
#endif
    for (int p = 0; p < MK_LAST_PHASE; ++p) { a.ph_lo = p; a.ph_hi = p + 1; hipLaunchKernelGGL(mk_fwd, dim3(grid), dim3(NWAVES * 64), LDS_BYTES, stream, a); }
#endif
}
```

```cpp
#include <hip/hip_runtime.h>
#include <cstdio>
#include <cstdint>

#ifndef MK_N_LAUNCHES
#define MK_N_LAUNCHES 1
#define MK_REP_MASK 0u
#define MK_REP_SUB 0u
#ifndef MK_REP_SUB
#define MK_REP_SUB 0u
#endif
#endif

#define GAS __attribute__((address_space(1)))
#define LAS __attribute__((address_space(3)))
typedef unsigned short bf16_t;
typedef short bf16x8 __attribute__((ext_vector_type(8)));
typedef short bf16x4 __attribute__((ext_vector_type(4)));
typedef float f32x4 __attribute__((ext_vector_type(4)));
typedef float f32x2 __attribute__((ext_vector_type(2)));
typedef float f32x16 __attribute__((ext_vector_type(16)));
typedef unsigned u32x4 __attribute__((ext_vector_type(4)));
typedef unsigned u32x2 __attribute__((ext_vector_type(2)));
typedef __bf16 bf16x2_t __attribute__((ext_vector_type(2)));

constexpr int D_MODEL = 1024, BATCH = 8, SEQ = 2048, M_TOK = BATCH * SEQ;
constexpr int HD = 64;
constexpr int RW_HEADS = 8, RW_DIM = 512, RW_IN = 1792;
constexpr int ATT_HEADS = 8, ATT_KV = 2;
constexpr int E_IN = 2560;
constexpr int GLA_H = 4, GLA_DK = 512, GLA_DV = 1024, GLA_DKH = 128, GLA_DVH = 256, GLA_R = 16;
constexpr int O_IN = 3088, O_INP = 3328;
constexpr int D_FF = 2816, NEXP = 8, D_FFE = 3584;
constexpr float NORM_EPS = 1e-6f;

constexpr size_t MiB = 1u << 20;
constexpr size_t WS_CTL = 0, CTL_ZERO_BYTES = 64 * 1024;
constexpr size_t WS_SSQ0 = 1 * MiB, WS_SSQ1 = 2 * MiB, WS_SSQ2 = 3 * MiB;
constexpr size_t WS_RSTD3 = 4 * MiB;
constexpr size_t WS_TOKE = WS_RSTD3 + 65536;
constexpr size_t WS_TOKG = WS_TOKE + 131072;
constexpr size_t WS_CNT = WS_TOKG + 131072;
constexpr size_t WS_TOT = WS_CNT + 16384;
constexpr size_t WS_ROWTOK = WS_TOT + 256;
constexpr int ROWS_PER_SLOT = M_TOK + 256;
constexpr size_t WS_ROWGATE = WS_ROWTOK + (size_t)2 * ROWS_PER_SLOT * 4;
constexpr size_t WS_ROWC1 = WS_ROWGATE + (size_t)2 * ROWS_PER_SLOT * 4;
static_assert(WS_ROWC1 + (size_t)2 * ROWS_PER_SLOT * 4 <= 6 * MiB, "ws map");
constexpr size_t WS_DECS = 6 * MiB;
constexpr size_t WS_ROPE = 7 * MiB;
constexpr size_t WS_XB = 8 * MiB;
constexpr size_t WS_WIN0 = 40 * MiB, WS_WLR = 45 * MiB, WS_WOUT0 = 47 * MiB, WS_WGU0 = 49 * MiB, WS_WD0 = 60 * MiB, WS_WIN1 = 66 * MiB, WS_WOUT1 = 73 * MiB;
constexpr size_t AR = 75 * MiB;
constexpr size_t A_P0 = AR + 0, A_RS = AR + 80 * MiB, A_KS = AR + 96 * MiB, A_VS = AR + 112 * MiB, A_NKK = AR + 128 * MiB, A_AP = AR + 144 * MiB;
constexpr size_t A_QH = AR + 152 * MiB, A_KH = AR + 168 * MiB, A_VT0 = AR + 172 * MiB;
constexpr size_t A_LWF = AR + 176 * MiB, A_LWB = AR + 192 * MiB, A_SGF = AR + 208 * MiB, A_SGB = AR + 224 * MiB;
constexpr size_t A_GG = AR + 272 * MiB, A_YF = AR + 0 * MiB, A_YB = AR + 16 * MiB, A_YCAT = AR + 32 * MiB;
constexpr size_t A_HID0 = AR + 0;
constexpr size_t A_P1 = AR + 0;
constexpr size_t A_QHAT = AR + 104 * MiB, A_K2T = AR + 120 * MiB;
constexpr size_t GLA_DIR_STRIDE = 32 * MiB;
constexpr size_t A_VT1 = AR + 168 * MiB, A_OF = AR + 200 * MiB, A_OB = AR + 232 * MiB, A_GOUT = AR + 104 * MiB;
constexpr size_t A_WEGU = 40 * MiB, A_HID1 = 96 * MiB, A_WEGU2 = 339 * MiB, A_WED = 395 * MiB;
constexpr int EGU_EARLY = 4;
constexpr size_t WEGU_HI_SHIFT = A_WEGU2 - (A_WEGU + (size_t)EGU_EARLY * 14 * MiB);
constexpr int ROWS_ALL = 2 * M_TOK + 256;
constexpr size_t WS_END = 451 * MiB;
static_assert(A_WEGU + (size_t)EGU_EARLY * 14 * MiB <= A_HID1 && A_HID1 + (size_t)ROWS_ALL * D_FFE * 2 <= A_WEGU2 && A_WEGU2 >= AR + 264 * MiB && A_WEGU2 + (size_t)(NEXP - EGU_EARLY) * 14 * MiB <= A_WED && A_WED + (size_t)NEXP * 1024 * D_FFE * 2 <= WS_END && 2 * ROWS_PER_SLOT >= ROWS_ALL, "ws map");
static_assert(A_GOUT + 32 * MiB <= A_VT1 && A_YCAT + 32 * MiB <= A_RS, "ws map");

constexpr int CW_BAR = 4096;

constexpr int RING_BYTES = 131072;
constexpr int LDS_BYTES = 150016;
constexpr int MISC_OFF = LDS_BYTES - 512;
constexpr int MOE_OFF = LDS_BYTES - 256;

__device__ __forceinline__ unsigned pk2(float lo, float hi) { f32x2 v = {lo, hi}; bf16x2_t b = __builtin_convertvector(v, bf16x2_t); return __builtin_bit_cast(unsigned, b); }
__device__ __forceinline__ bf16_t f2bf(float f) { return (bf16_t)(pk2(f, 0.f) & 0xffffu); }
__device__ __forceinline__ float bf2f(bf16_t h) { return __uint_as_float(((unsigned)h) << 16); }
__device__ __forceinline__ float bflo(unsigned w) { return __uint_as_float(w << 16); }
__device__ __forceinline__ float bfhi(unsigned w) { return __uint_as_float(w & 0xffff0000u); }
__device__ __forceinline__ float xsum16(float v) { const auto r = __builtin_amdgcn_permlane16_swap(__float_as_uint(v), __float_as_uint(v), false, false); return __uint_as_float(r[0]) + __uint_as_float(r[1]); }
__device__ __forceinline__ float xsum32(float v) { const auto r = __builtin_amdgcn_permlane32_swap(__float_as_uint(v), __float_as_uint(v), false, false); return __uint_as_float(r[0]) + __uint_as_float(r[1]); }
__device__ __forceinline__ float xmax32(float v) { const auto r = __builtin_amdgcn_permlane32_swap(__float_as_uint(v), __float_as_uint(v), false, false); return fmaxf(__uint_as_float(r[0]), __uint_as_float(r[1])); }
__device__ __forceinline__ float wave_sum(float v) {
#pragma unroll
    for (int o = 1; o < 64; o <<= 1) v += __shfl_xor(v, o);
    return v;
}
__device__ __forceinline__ float sigmoidf_(float x) { return __builtin_amdgcn_rcpf(1.f + __expf(-x)); }
__device__ __forceinline__ float siluf_(float x) { return x * __builtin_amdgcn_rcpf(1.f + __expf(-x)); }
#define LDS_WAIT() asm volatile("s_waitcnt lgkmcnt(0)" ::: "memory")
#define VM_WAIT() asm volatile("s_waitcnt vmcnt(0)" ::: "memory")

#define XB_TMO      128
#define XB_XCNT(j)  (256  + 64 * (j))
#define XB_XSUB(j)  (1280 + 64 * (j))
#define XB_XGEN(j)  (2304 + 64 * (j))
#define XB_TOP      3328
#define XB_TOPGEN   3392
#define XCD_BAR_WORDS 3456
#define XB_SPIN_CAP (1u << 20)
__device__ __forceinline__ unsigned xb_ld(unsigned* p)              { return __hip_atomic_load(p, __ATOMIC_RELAXED, __HIP_MEMORY_SCOPE_AGENT); }
__device__ __forceinline__ unsigned xb_add(unsigned* p, unsigned v) { return __hip_atomic_fetch_add(p, v, __ATOMIC_RELAXED, __HIP_MEMORY_SCOPE_AGENT); }
__device__ __forceinline__ unsigned xb_xcc_id() { return (unsigned)__builtin_amdgcn_s_getreg((3 << 11) | 20) & 0xFu; }
#define XB_SPIN(cond, bar) do { unsigned _sp = 0; while (cond) { __builtin_amdgcn_s_sleep(1); \
    if ((++_sp & 255u) == 0u) { if (xb_ld(&(bar)[XB_TMO])) break; if (_sp > XB_SPIN_CAP) { atomicAdd(&(bar)[XB_TMO], 1u); break; } } } } while (0)
struct XcdBarrier { unsigned* bar; unsigned x; volatile LAS unsigned* st; };
__device__ __forceinline__ XcdBarrier xcd_barrier_post(unsigned* bar, volatile LAS unsigned* st) {
    XcdBarrier b; b.bar = bar; b.x = xb_xcc_id(); b.st = st;
    if (threadIdx.x == 0) (void)xb_add(&bar[XB_XCNT(b.x)], 1u);
    return b;
}
__device__ __forceinline__ void xcd_barrier_complete(unsigned* bar, unsigned x, unsigned& nloc, unsigned& nx) {
    const unsigned G = gridDim.x * gridDim.y * gridDim.z;
    unsigned sum, cnt, mine, sp = 0u;
    for (;;) {
        sum = 0u; cnt = 0u; mine = 0u;
#pragma unroll 1
        for (unsigned j = 0; j < 16; ++j) { const unsigned c = xb_ld(&bar[XB_XCNT(j)]); sum += c; cnt += (c > 0u) ? 1u : 0u; mine = (j == x) ? c : mine; }
        if (sum == G) break;
        __builtin_amdgcn_s_sleep(1);
        if ((++sp & 255u) == 0u) { if (xb_ld(&bar[XB_TMO])) break; if (sp > XB_SPIN_CAP) { atomicAdd(&bar[XB_TMO], 1u); break; } }
    }
    nloc = mine > 0u ? mine : 1u; nx = cnt > 0u ? cnt : 1u;
}
__device__ __forceinline__ void xcd_barrier(const XcdBarrier& b) {
    asm volatile("s_waitcnt vmcnt(0)" ::: "memory");
    __syncthreads();
    if (threadIdx.x == 0) {
        unsigned* bar = b.bar;
        __builtin_amdgcn_s_waitcnt(0);
        unsigned nloc = b.st[0], nx = b.st[1];
        if (nloc == 0u) { xcd_barrier_complete(bar, b.x, nloc, nx); b.st[0] = nloc; b.st[1] = nx; }
        const unsigned old = xb_add(&bar[XB_XSUB(b.x)], 1u);
        const unsigned gen = old / nloc;
        if (old + 1u == (gen + 1u) * nloc) {
            __builtin_amdgcn_fence(__ATOMIC_RELEASE, "agent");
            asm volatile("s_waitcnt vmcnt(0)" ::: "memory");
            const unsigned og = xb_add(&bar[XB_TOP], 1u);
            const unsigned tg = og / nx;
            if (og + 1u == (tg + 1u) * nx) xb_add(&bar[XB_TOPGEN], 1u);
            else XB_SPIN(xb_ld(&bar[XB_TOPGEN]) == tg, bar);
            __builtin_amdgcn_fence(__ATOMIC_ACQUIRE, "agent");
            xb_add(&bar[XB_XGEN(b.x)], 1u);
            asm volatile("s_waitcnt vmcnt(0)" ::: "memory");
        } else {
            XB_SPIN(xb_ld(&bar[XB_XGEN(b.x)]) == gen, bar);
            __builtin_amdgcn_fence(__ATOMIC_ACQUIRE, "agent");
            asm volatile("s_waitcnt vmcnt(0)" ::: "memory");
        }
    }
    __syncthreads();
}

namespace pg8 {
constexpr int BM = 256, BK = 64, HALF = 128, HTB = HALF * BK * 2, STAGE_BYTES = 8 * HTB, NXCD = 8, WGM = 4;
__host__ __device__ __forceinline__ int lds_byte(int r, int c) { const int st = (r >> 4) * 2 + (c >> 5), rr = r & 15, cc = c & 31, ob = rr * 64 + cc * 2; return st * 1024 + (ob ^ (((ob >> 9) & 1) << 5)); }
__host__ __device__ __forceinline__ void stage_rc(int b, int& R, int& C) { const int st = b / 1024, sb = b % 1024, swz = sb ^ (((sb >> 9) & 1) << 5); R = (st >> 1) * 16 + swz / 64; C = (st & 1) * 32 + (swz % 64) / 2; }
__host__ __device__ __forceinline__ int perm32(int rho) { const int n = rho >> 4, i = rho & 15; return 8 * (i >> 2) + 4 * n + (i & 3); }

struct Unit { const char* a; const char* b; int pm, pn; int row0, nrows, e; int nt, flags; int rot; };

struct GridOrder {
    int nM, nN, nwg, G, c;
    __device__ void init(int nM_, int nN_, int G_, int c_) { nM = nM_; nN = nN_; nwg = nM * nN; G = G_; c = c_; }
    __device__ bool tile(int i, int& pm, int& pn) const {
        const long L = (long)i * G + c; if (L >= nwg) return false;
        int wgid = (int)L; { const int q = nwg / NXCD, r = nwg % NXCD, xcd = wgid % NXCD, off = wgid / NXCD; wgid = (xcd < r ? xcd * (q + 1) : r * (q + 1) + (xcd - r) * q) + off; }
        const int nig = WGM * nN, gid = wgid / nig, fm = gid * WGM, gsz = (nM - fm) < WGM ? (nM - fm) : WGM;
        pm = fm + ((wgid % nig) % gsz); pn = (wgid % nig) / gsz; return true;
    }
};
struct DenseSched {
    GridOrder go; const char* A; const char* Bt; size_t tstep; int nt_;
    __device__ void init(const bf16_t* A_, const bf16_t* Bt_, int M, int N, int K, int G, int c) { go.init(M / BM, N / BM, G, c); A = (const char*)A_; Bt = (const char*)Bt_; tstep = (size_t)BM * K * 2; nt_ = K / BK; }
    __device__ bool next(int i, Unit& u) const { int pm, pn; if (!go.tile(i, pm, pn)) return false; u.pm = pm; u.pn = pn; u.a = A + (size_t)pm * tstep; u.b = Bt + (size_t)pn * tstep; u.row0 = pm * BM; u.nrows = BM; u.e = 0; u.nt = nt_; u.flags = 0; u.rot = 0; return true; }
};

template <class Epi, class Sched, bool GATHER>
__device__ __forceinline__ void gemm_phase(const int tid, LAS unsigned char* lds, const int K_, const Sched& S, const Epi& E, const int* gather_rows) {
    int K = K_; asm volatile("" : "+s"(K));
    const int wid = __builtin_amdgcn_readfirstlane(tid >> 6), lane = tid & 63, wr = wid >> 2, wc = wid & 3, fr = lane & 15, fq = lane >> 4;
    int sR[2], sC[2];
    unsigned voffB[2];
#pragma unroll
    for (int i = 0; i < 2; ++i) { int R, C; stage_rc(tid * 16 + i * 8192, R, C); sR[i] = R; sC[i] = C; const int Rb = Epi::PERM ? ((R & ~31) + perm32(R & 31)) : R; voffB[i] = (unsigned)(Rb * K + C) * 2u; }
    const size_t kstep = (size_t)(BK * 2);
    const size_t hstep = (size_t)HALF * K * 2;
    const unsigned ldsw = (unsigned)wid * 1024u;
    const int aoff = lds_byte(wr * 64 + fr, fq * 8), boff = lds_byte(wc * 32 + fr, fq * 8);
    unsigned cva[2][2], nva[2][2];
#define PG8_SETVA(va, u) do { _Pragma("unroll") for (int h_ = 0; h_ < 2; ++h_) _Pragma("unroll") for (int i_ = 0; i_ < 2; ++i_) { \
        if (GATHER) { int rr_ = (u).row0 + h_ * HALF + sR[i_]; const int rmax_ = (u).row0 + (u).nrows - 1; rr_ = rr_ > rmax_ ? rmax_ : rr_; int tk_ = gather_rows[rr_]; tk_ = tk_ < 0 ? 0 : (tk_ > 16383 ? 16383 : tk_); va[h_][i_] = (unsigned)(tk_ * K + sC[i_]) * 2u; } \
        else va[h_][i_] = (unsigned)((h_ * HALF + sR[i_]) * K + sC[i_]) * 2u; } } while (0)
#define PG8_SA(b, h) (((b) * 2 + (h)) * HTB)
#define PG8_SB(b, h) ((4 + (b) * 2 + (h)) * HTB)
#define PG8_STAGE2(bufoff, gbase, v0, v1) do { \
        __builtin_amdgcn_global_load_lds((const unsigned*)((const char*)(gbase) + (v0)), (LAS unsigned*)(lds + (bufoff) + ldsw), 16, 0, 0); \
        __builtin_amdgcn_global_load_lds((const unsigned*)((const char*)(gbase) + (v1)), (LAS unsigned*)(lds + (bufoff) + ldsw + 8192), 16, 0, 0); } while (0)
#define PG8_STAGEB(bufoff, gbase) PG8_STAGE2(bufoff, gbase, voffB[0], voffB[1])
#define PG8_STAGEA(bufoff, gbase, va, h) PG8_STAGE2(bufoff, gbase, va[h][0], va[h][1])
#define PG8_LDA(dst, b, h) do { _Pragma("unroll") for (int m = 0; m < 4; ++m) _Pragma("unroll") for (int k = 0; k < 2; ++k) dst[m][k] = *(const LAS bf16x8*)(lds + PG8_SA(b, h) + aoff + m * 2048 + k * 1024); } while (0)
#define PG8_LDB(dst, b, h) do { _Pragma("unroll") for (int n = 0; n < 2; ++n) _Pragma("unroll") for (int k = 0; k < 2; ++k) dst[n][k] = *(const LAS bf16x8*)(lds + PG8_SB(b, h) + boff + n * 2048 + k * 1024); } while (0)
#define PG8_MMA(ai, bj, At, Bt) do { __builtin_amdgcn_s_setprio(1); _Pragma("unroll") for (int m = 0; m < 4; ++m) _Pragma("unroll") for (int n = 0; n < 2; ++n) _Pragma("unroll") for (int k = 0; k < 2; ++k) \
        acc[ai][bj][m][n] = __builtin_amdgcn_mfma_f32_16x16x32_bf16(Bt[n][k], At[m][k], acc[ai][bj][m][n], 0, 0, 0); __builtin_amdgcn_s_setprio(0); } while (0)
#define PG8_WAIT_V(n) asm volatile("s_waitcnt vmcnt(" #n ")" ::: "memory")
#define PG8_WAIT_L(n) asm volatile("s_waitcnt lgkmcnt(" #n ")" ::: "memory")
#define PG8_BAR __builtin_amdgcn_s_barrier()
#define PG8_SCHED __builtin_amdgcn_sched_barrier(0)
    Unit cur, nxt; int ui = 0;
    if (!S.next(0, cur)) return;
    PG8_SETVA(cva, cur);
    f32x4 acc[2][2][4][2];
#pragma unroll
    for (int a = 0; a < 2; ++a)
#pragma unroll
        for (int b = 0; b < 2; ++b)
#pragma unroll
            for (int m = 0; m < 4; ++m)
#pragma unroll
                for (int n = 0; n < 2; ++n) acc[a][b][m][n] = (f32x4){0.f, 0.f, 0.f, 0.f};
    bf16x8 At[4][2], B0[2][2], B1[2][2];
    const char* cA = cur.a; const char* cB = cur.b;
    const char* pA = cA + (size_t)cur.rot * kstep; const char* pB = cB + (size_t)cur.rot * kstep;
    PG8_STAGEB(PG8_SB(0, 0), pB); PG8_STAGEB(PG8_SB(0, 1), pB + hstep); PG8_STAGEA(PG8_SA(0, 0), pA, cva, 0); PG8_STAGEA(PG8_SA(0, 1), pA, cva, 1);
    if (wr == 1) PG8_BAR;
    PG8_WAIT_V(2); PG8_BAR;
    PG8_STAGEB(PG8_SB(1, 0), pB + kstep); PG8_STAGEA(PG8_SA(1, 0), pA + kstep, cva, 0); PG8_STAGEB(PG8_SB(1, 1), pB + hstep + kstep);
    PG8_WAIT_V(6); PG8_BAR;
    for (;;) {
        const bool has_next = S.next(ui + 1, nxt);
        if (has_next) PG8_SETVA(nva, nxt);
        else {
#pragma unroll
            for (int h = 0; h < 2; ++h)
#pragma unroll
                for (int i = 0; i < 2; ++i) nva[h][i] = cva[h][i];
        }
        const char* nA = has_next ? nxt.a : cA; const char* nB = has_next ? nxt.b : cB;
        const char* nsA = has_next ? nA + (size_t)nxt.rot * kstep : pA; const char* nsB = has_next ? nB + (size_t)nxt.rot * kstep : pB;
        const int nt = cur.nt; const int wrap_t = nt - 2 - cur.rot;
        for (int t = 0; t < nt; t += 2) {
            const bool last = (t == nt - 2);
            const char* a1 = pA + kstep;
            const char* pA2 = (t == wrap_t) ? cA : pA + 2 * kstep; const char* pB2 = (t == wrap_t) ? cB : pB + 2 * kstep;
            const char* a2 = last ? nsA : pA2; const char* b2 = last ? nsB : pB2;
            const char* a3 = a2 + kstep; const char* b3 = b2 + kstep;
            pA = pA2; pB = pB2;
            unsigned va2[2][2];
#pragma unroll
            for (int h = 0; h < 2; ++h)
#pragma unroll
                for (int i = 0; i < 2; ++i) va2[h][i] = (GATHER && last) ? nva[h][i] : cva[h][i];
            PG8_LDB(B0, 0, 0); PG8_LDB(B1, 0, 1); PG8_SCHED; PG8_LDA(At, 0, 0); PG8_STAGEA(PG8_SA(1, 1), a1, cva, 1);
            PG8_WAIT_V(8); PG8_WAIT_L(0); PG8_BAR; PG8_MMA(0, 0, At, B0); PG8_MMA(0, 1, At, B1); PG8_BAR; PG8_SCHED;
            PG8_LDA(At, 0, 1); PG8_STAGEB(PG8_SB(0, 0), b2); PG8_STAGEB(PG8_SB(0, 1), b2 + hstep); PG8_STAGEA(PG8_SA(0, 0), a2, va2, 0);
            PG8_WAIT_V(8); PG8_WAIT_L(0); PG8_BAR; PG8_MMA(1, 0, At, B0); PG8_MMA(1, 1, At, B1); PG8_BAR; PG8_SCHED;
            PG8_LDB(B0, 1, 0); PG8_LDB(B1, 1, 1); PG8_SCHED; PG8_LDA(At, 1, 0); PG8_STAGEA(PG8_SA(0, 1), a2, va2, 1);
            PG8_WAIT_V(8); PG8_WAIT_L(0); PG8_BAR; PG8_MMA(0, 0, At, B0); PG8_MMA(0, 1, At, B1); PG8_BAR; PG8_SCHED;
            PG8_LDA(At, 1, 1); PG8_STAGEB(PG8_SB(1, 0), b3); PG8_STAGEB(PG8_SB(1, 1), b3 + hstep); PG8_STAGEA(PG8_SA(1, 0), a3, va2, 0);
            PG8_WAIT_V(8); PG8_WAIT_L(0); PG8_BAR; PG8_MMA(1, 0, At, B0); PG8_MMA(1, 1, At, B1); PG8_BAR; PG8_SCHED;
        }
        if (wr == 0) PG8_BAR;
        E(acc, cur, wr, wc, fr, fq);
#if ((MK_REP_SUB) >> 5) & 1
        if constexpr (Epi::PURE) { asm volatile("" ::: "memory"); E(acc, cur, wr, wc, fr, fq); }
#endif
        if (!has_next) break;
#pragma unroll
        for (int a = 0; a < 2; ++a)
#pragma unroll
            for (int b = 0; b < 2; ++b)
#pragma unroll
                for (int m = 0; m < 4; ++m)
#pragma unroll
                    for (int n = 0; n < 2; ++n) acc[a][b][m][n] = (f32x4){0.f, 0.f, 0.f, 0.f};
        cur = nxt; cA = nA; cB = nB; pA = nsA; pB = nsB; ++ui;
#pragma unroll
        for (int h = 0; h < 2; ++h)
#pragma unroll
            for (int i = 0; i < 2; ++i) cva[h][i] = nva[h][i];
        if (wr == 1) PG8_BAR;
    }
    PG8_WAIT_V(0);
    PG8_BAR;
#undef PG8_SETVA
#undef PG8_SA
#undef PG8_SB
#undef PG8_STAGE2
#undef PG8_STAGEA
#undef PG8_STAGEB
#undef PG8_LDA
#undef PG8_LDB
#undef PG8_MMA
#undef PG8_WAIT_V
#undef PG8_WAIT_L
#undef PG8_BAR
#undef PG8_SCHED
}
}

__device__ __forceinline__ float rstd_from_ssq4(const float* ssq, int row, int fq) {
    const f32x4 a = *(const f32x4*)(ssq + (size_t)row * 16 + 4 * fq);
    float s = (a.x + a.y) + (a.z + a.w);
    { const auto r = __builtin_amdgcn_permlane16_swap(__float_as_uint(s), __float_as_uint(s), false, false); s = __uint_as_float(r[0]) + __uint_as_float(r[1]); }
    { const auto r = __builtin_amdgcn_permlane32_swap(__float_as_uint(s), __float_as_uint(s), false, false); s = __uint_as_float(r[0]) + __uint_as_float(r[1]); }
    return __builtin_amdgcn_rsqf(s * (1.f / 1024.f) + NORM_EPS);
}
__device__ __forceinline__ float rstd_from_ssq(const float* ssq, int row) {
    const f32x4* p = (const f32x4*)(ssq + (size_t)row * 16);
    const f32x4 a = p[0], b = p[1], c = p[2], d = p[3];
    const float s = (((a.x + a.y) + (a.z + a.w)) + ((b.x + b.y) + (b.z + b.w))) + (((c.x + c.y) + (c.z + c.w)) + ((d.x + d.y) + (d.z + d.w)));
    return __builtin_amdgcn_rsqf(s * (1.f / 1024.f) + NORM_EPS);
}
__device__ __forceinline__ u32x4 pack8(const f32x4 v0, const f32x4 v1) { u32x4 w; w.x = pk2(v0[0], v0[1]); w.y = pk2(v0[2], v0[3]); w.z = pk2(v1[0], v1[1]); w.w = pk2(v1[2], v1[3]); return w; }
__device__ __forceinline__ void unpack8(const u32x4 w, float (&f)[8]) { f[0] = bflo(w.x); f[1] = bfhi(w.x); f[2] = bflo(w.y); f[3] = bfhi(w.y); f[4] = bflo(w.z); f[5] = bfhi(w.z); f[6] = bflo(w.w); f[7] = bfhi(w.w); }
__device__ __forceinline__ u32x4 pack8f(const float (&f)[8]) { u32x4 w; w.x = pk2(f[0], f[1]); w.y = pk2(f[2], f[3]); w.z = pk2(f[4], f[5]); w.w = pk2(f[6], f[7]); return w; }

__device__ __forceinline__ void swap16(f32x4& x, f32x4& y) {
#pragma unroll
    for (int i = 0; i < 4; ++i) { const auto r = __builtin_amdgcn_permlane16_swap(__float_as_uint(x[i]), __float_as_uint(y[i]), false, false); x[i] = __uint_as_float(r[0]); y[i] = __uint_as_float(r[1]); }
}
struct EpiScaleBf16 {
    static constexpr bool PERM = true; static constexpr bool PURE = true;
    bf16_t* O; int ldc; const float* ssq;
    __device__ __forceinline__ void operator()(const f32x4 (&acc)[2][2][4][2], const pg8::Unit& u, int wr, int wc, int fr, int fq) const {
        const int row0 = u.pm * 256 + wr * 64 + fr, col0 = u.pn * 256 + wc * 32 + 8 * fq;
#pragma unroll
        for (int ai = 0; ai < 2; ++ai)
#pragma unroll
            for (int m = 0; m < 4; ++m) { const int row = row0 + ai * 128 + m * 16; const float rs = rstd_from_ssq4(ssq, row, fq); bf16_t* rowp = O + (size_t)row * ldc + col0;
#pragma unroll
                for (int bj = 0; bj < 2; ++bj) *(u32x4*)(rowp + bj * 128) = pack8(acc[ai][bj][m][0] * rs, acc[ai][bj][m][1] * rs); }
    }
};
struct EpiResid {
    static constexpr bool PERM = true; static constexpr bool PURE = false;
    const float* base; float* out; bf16_t* xb; float* ssq;
    __device__ __forceinline__ void operator()(const f32x4 (&acc)[2][2][4][2], const pg8::Unit& u, int wr, int wc, int fr, int fq) const {
        const int row0 = u.pm * 256 + wr * 64 + fr, col0 = u.pn * 256 + wc * 32 + 8 * fq;
#pragma unroll
        for (int ai = 0; ai < 2; ++ai)
#pragma unroll
            for (int m = 0; m < 4; ++m) { const int row = row0 + ai * 128 + m * 16; const size_t off = (size_t)row * 1024 + col0; float ss = 0.f;
#pragma unroll
                for (int bj = 0; bj < 2; ++bj) { const f32x4 b0 = *(const f32x4*)(base + off + bj * 128), b1 = *(const f32x4*)(base + off + bj * 128 + 4);
                    const f32x4 o0 = b0 + acc[ai][bj][m][0], o1 = b1 + acc[ai][bj][m][1];
                    *(f32x4*)(out + off + bj * 128) = o0; *(f32x4*)(out + off + bj * 128 + 4) = o1;
                    ss += (o0[0] * o0[0] + o0[1] * o0[1]) + (o0[2] * o0[2] + o0[3] * o0[3]) + (o1[0] * o1[0] + o1[1] * o1[1]) + (o1[2] * o1[2] + o1[3] * o1[3]);
                    *(u32x4*)(xb + off + bj * 128) = pack8(o0, o1); }
                ss += __shfl_xor(ss, 16); ss += __shfl_xor(ss, 32);
                if (ssq && fq == 0) ssq[(size_t)row * 16 + u.pn * 4 + wc] = ss; }
    }
};
struct EpiResidBf {
    static constexpr bool PERM = true; static constexpr bool PURE = false;
    bf16_t* xb; float* out; float* ssq;
    __device__ __forceinline__ void operator()(const f32x4 (&acc)[2][2][4][2], const pg8::Unit& u, int wr, int wc, int fr, int fq) const {
        const int row0 = u.pm * 256 + wr * 64 + fr, col0 = u.pn * 256 + wc * 32 + 8 * fq;
#pragma unroll
        for (int ai = 0; ai < 2; ++ai) { u32x4 bw[4][2];
#pragma unroll
            for (int m = 0; m < 4; ++m)
#pragma unroll
                for (int bj = 0; bj < 2; ++bj) bw[m][bj] = *(const u32x4*)(xb + (size_t)(row0 + ai * 128 + m * 16) * 1024 + col0 + bj * 128);
#pragma unroll
            for (int m = 0; m < 4; ++m) { const int row = row0 + ai * 128 + m * 16; const size_t off = (size_t)row * 1024 + col0; float ss = 0.f;
#pragma unroll
                for (int bj = 0; bj < 2; ++bj) { const u32x4 w = bw[m][bj];
                    const f32x4 b0 = {bflo(w.x), bfhi(w.x), bflo(w.y), bfhi(w.y)}, b1 = {bflo(w.z), bfhi(w.z), bflo(w.w), bfhi(w.w)};
                    const f32x4 o0 = b0 + acc[ai][bj][m][0], o1 = b1 + acc[ai][bj][m][1];
                    if (out) { *(f32x4*)(out + off + bj * 128) = o0; *(f32x4*)(out + off + bj * 128 + 4) = o1; }
                    ss += (o0[0] * o0[0] + o0[1] * o0[1]) + (o0[2] * o0[2] + o0[3] * o0[3]) + (o1[0] * o1[0] + o1[1] * o1[1]) + (o1[2] * o1[2] + o1[3] * o1[3]);
                    *(u32x4*)(xb + off + bj * 128) = pack8(o0, o1); }
                ss += __shfl_xor(ss, 16); ss += __shfl_xor(ss, 32);
                if (ssq && fq == 0) ssq[(size_t)row * 16 + u.pn * 4 + wc] = ss; } }
    }
};
struct EpiSwiGLU {
    static constexpr bool PERM = true; static constexpr bool PURE = true;
    bf16_t* H; int ldh; const float* ssq;
    __device__ __forceinline__ void operator()(const f32x4 (&acc)[2][2][4][2], const pg8::Unit& u, int wr, int wc, int fr, int fq) const {
        const int row0 = u.pm * 256 + wr * 64 + fr, hcol0 = u.pn * 128 + wc * 32 + 8 * fq;
#pragma unroll
        for (int ai = 0; ai < 2; ++ai)
#pragma unroll
            for (int m = 0; m < 4; ++m) { const int row = row0 + ai * 128 + m * 16; const float rs = rstd_from_ssq4(ssq, row, fq);
                f32x4 h[2];
#pragma unroll
                for (int n = 0; n < 2; ++n) { const f32x4 t = acc[ai][0][m][n] * (rs * -1.4426950408889634f), p = acc[ai][0][m][n] * acc[ai][1][m][n] * (rs * rs);
#pragma unroll
                    for (int i = 0; i < 4; ++i) h[n][i] = __builtin_amdgcn_exp2f(t[i]);
                    h[n] = h[n] + 1.f;
#pragma unroll
                    for (int i = 0; i < 4; ++i) h[n][i] = __builtin_amdgcn_rcpf(h[n][i]);
                    h[n] = h[n] * p; }
                *(u32x4*)(H + (size_t)row * ldh + hcol0) = pack8(h[0], h[1]); }
    }
};
struct EpiSwiGLUMoE {
    static constexpr bool PERM = true; static constexpr bool PURE = true;
    bf16_t* H; const float* row_c1;
    __device__ __forceinline__ void operator()(const f32x4 (&acc)[2][2][4][2], const pg8::Unit& u, int wr, int wc, int fr, int fq) const {
        const int hcol0 = u.pn * 128 + wc * 32 + 8 * fq;
        float c1[2][4];
#pragma unroll
        for (int ai = 0; ai < 2; ++ai)
#pragma unroll
            for (int m = 0; m < 4; ++m) c1[ai][m] = row_c1[u.row0 + ai * 128 + wr * 64 + m * 16 + fr];
#pragma unroll
        for (int ai = 0; ai < 2; ++ai)
#pragma unroll
            for (int m = 0; m < 4; ++m) { const int rl = ai * 128 + wr * 64 + m * 16 + fr;
                f32x4 h[2];
#pragma unroll
                for (int n = 0; n < 2; ++n) { const f32x4 t = acc[ai][0][m][n] * c1[ai][m], p = acc[ai][0][m][n] * acc[ai][1][m][n];
#pragma unroll
                    for (int i = 0; i < 4; ++i) h[n][i] = __builtin_amdgcn_exp2f(t[i]);
                    h[n] = h[n] + 1.f;
#pragma unroll
                    for (int i = 0; i < 4; ++i) h[n][i] = __builtin_amdgcn_rcpf(h[n][i]);
                    h[n] = h[n] * p; }
                if (rl < u.nrows) *(u32x4*)(H + (size_t)(u.row0 + rl) * D_FFE + hcol0) = pack8(h[0], h[1]); }
    }
};
struct EpiMoEDown {
    static constexpr bool PERM = true; static constexpr bool PURE = false;
    float* out; const int* row_tok; const float* row_gate; bf16_t* xb; bool last;
    __device__ __forceinline__ void operator()(const f32x4 (&acc)[2][2][4][2], const pg8::Unit& u, int wr, int wc, int fr, int fq) const {
        int tk[2][4]; float gt8[2][4];
#pragma unroll
        for (int ai = 0; ai < 2; ++ai)
#pragma unroll
            for (int m = 0; m < 4; ++m) { const int grow = u.row0 + ai * 128 + wr * 64 + m * 16 + fr; tk[ai][m] = row_tok[grow] & 16383; gt8[ai][m] = row_gate[grow]; }
        if (last) {
            const int col0 = u.pn * 256 + wc * 32 + 8 * (fq & ~1) + 4 * (fq & 1);
#pragma unroll
            for (int ai = 0; ai < 2; ++ai) { u32x2 rw[4][2][2];
#pragma unroll
                for (int m = 0; m < 4; ++m)
#pragma unroll
                    for (int bj = 0; bj < 2; ++bj) { const size_t o = (size_t)tk[ai][m] * 1024 + col0 + bj * 128; rw[m][bj][0] = *(const u32x2*)(xb + o); rw[m][bj][1] = *(const u32x2*)(xb + o + 8); }
#pragma unroll
                for (int m = 0; m < 4; ++m) { const int rl = ai * 128 + wr * 64 + m * 16 + fr; const float gt = gt8[ai][m]; const size_t o = (size_t)tk[ai][m] * 1024 + col0;
#pragma unroll
                    for (int bj = 0; bj < 2; ++bj) { const u32x2 w0 = rw[m][bj][0], w1 = rw[m][bj][1];
                        f32x4 p0 = acc[ai][bj][m][0] * gt, p1 = acc[ai][bj][m][1] * gt; swap16(p0, p1);
                        const f32x4 b0 = {bflo(w0.x), bfhi(w0.x), bflo(w0.y), bfhi(w0.y)}, b1 = {bflo(w1.x), bfhi(w1.x), bflo(w1.y), bfhi(w1.y)};
                        if (rl < u.nrows) { *(f32x4*)(out + o + bj * 128) = b0 + p0; *(f32x4*)(out + o + bj * 128 + 8) = b1 + p1; } } } }
        } else {
            const int col0 = u.pn * 256 + wc * 32 + 8 * fq;
#pragma unroll
            for (int ai = 0; ai < 2; ++ai) { u32x4 rw[4][2];
#pragma unroll
                for (int m = 0; m < 4; ++m)
#pragma unroll
                    for (int bj = 0; bj < 2; ++bj) rw[m][bj] = *(const u32x4*)(xb + (size_t)tk[ai][m] * 1024 + col0 + bj * 128);
#pragma unroll
                for (int m = 0; m < 4; ++m) { const int rl = ai * 128 + wr * 64 + m * 16 + fr; const float gt = gt8[ai][m]; bf16_t* xp = xb + (size_t)tk[ai][m] * 1024 + col0;
#pragma unroll
                    for (int bj = 0; bj < 2; ++bj) { const u32x4 bw = rw[m][bj];
                        const f32x4 b0 = {bflo(bw.x), bfhi(bw.x), bflo(bw.y), bfhi(bw.y)}, b1 = {bflo(bw.z), bfhi(bw.z), bflo(bw.w), bfhi(bw.w)};
                        if (rl < u.nrows) *(u32x4*)(xp + bj * 128) = pack8(b0 + acc[ai][bj][m][0] * gt, b1 + acc[ai][bj][m][1] * gt); } } }
        }
    }
};
struct EpiPart {
    static constexpr bool PERM = true; static constexpr bool PURE = true;
    float* part;
    __device__ __forceinline__ void operator()(const f32x4 (&acc)[2][2][4][2], const pg8::Unit& u, int wr, int wc, int fr, int fq) const {
        float* pb = part + (size_t)(u.flags - 1) * 65536; const unsigned o0 = (unsigned)((wr * 64 + fr) * 256 + wc * 32 + 8 * (fq & ~1) + 4 * (fq & 1));
#pragma unroll
        for (int ai = 0; ai < 2; ++ai)
#pragma unroll
            for (int m = 0; m < 4; ++m)
#pragma unroll
                for (int bj = 0; bj < 2; ++bj) { float* pp = pb + o0 + (ai * 128 + m * 16) * 256 + bj * 128; f32x4 p0 = acc[ai][bj][m][0], p1 = acc[ai][bj][m][1]; swap16(p0, p1); *(f32x4*)pp = p0; *(f32x4*)(pp + 8) = p1; }
    }
};
struct LowRankSched {
    pg8::GridOrder go; const char* A; const char* Bt;
    __device__ void init(const bf16_t* A_, const bf16_t* Bt_, int G, int c) { go.init(M_TOK / 256, 8, G, c); A = (const char*)A_; Bt = (const char*)Bt_; }
    __device__ bool next(int i, pg8::Unit& u) const { int pm, pn; if (!go.tile(i, pm, pn)) return false; u.pm = pm; u.pn = pn; u.a = A + (size_t)pm * (256 * 256 * 2); u.b = Bt + (size_t)pn * (256 * 256 * 2);
        u.row0 = pm * 256; u.nrows = 256; u.e = 0; int two = 2; asm volatile("" : "+s"(two)); u.nt = two; u.flags = 0; u.rot = 0; return true; }
};
struct EpiLowRank {
    static constexpr bool PERM = true; static constexpr bool PURE = true;
    unsigned char* ws; const float* const* in;
    __device__ __forceinline__ void operator()(const f32x4 (&acc)[2][2][4][2], const pg8::Unit& u, int wr, int wc, int fr, int fq) const {
        const int kind = u.pn >> 1; const int row0 = u.pm * 256 + wr * 64 + fr; const int c0 = (u.pn & 1) * 256 + wc * 32 + 8 * fq;
        const float* zp = in[kind == 0 ? 4 : kind == 1 ? 6 : kind == 2 ? 8 : 10];
        bf16_t* o1 = (bf16_t*)(ws + (kind == 0 ? A_LWF : kind == 1 ? A_LWB : kind == 2 ? A_SGF : A_SGB));
        const float sc = kind < 2 ? -0.87506126f : 1.f;
#pragma unroll
        for (int bj = 0; bj < 2; ++bj) { const int c = c0 + bj * 128;
            const f32x4 z0 = *(const f32x4*)(zp + c) * -1.4426950408889634f, z1 = *(const f32x4*)(zp + c + 4) * -1.4426950408889634f;
#pragma unroll
            for (int ai = 0; ai < 2; ++ai)
#pragma unroll
                for (int m = 0; m < 4; ++m) { const int row = row0 + ai * 128 + m * 16; f32x4 v0 = acc[ai][bj][m][0] * -1.4426950408889634f + z0, v1 = acc[ai][bj][m][1] * -1.4426950408889634f + z1;
#pragma unroll
                    for (int i = 0; i < 4; ++i) { v0[i] = sc * __builtin_amdgcn_rcpf(1.f + __builtin_amdgcn_exp2f(v0[i])); v1[i] = sc * __builtin_amdgcn_rcpf(1.f + __builtin_amdgcn_exp2f(v1[i])); }
                    *(u32x4*)(o1 + (size_t)row * 512 + c) = pack8(v0, v1); } }
    }
};

constexpr int NWAVES = 8;
struct Args { const float* in[38]; float* out; unsigned char* ws; int ph_lo, ph_hi; };
struct Frame {
    LAS unsigned char* lds; unsigned char* ws; const float* const* in; float* out;
    int tid, lane, wave, vcu, G;
};
template <class T> __device__ __forceinline__ T* gptr(T* p) { return (T*)(GAS T*)p; }
template <class T> __device__ __forceinline__ T* wsp(unsigned char* ws, size_t off) { return (T*)(ws + off); }

__device__ __forceinline__ void conv_item(const float* W, int ldw, int k0, int n0, int ncols, const float* gain, bf16_t* WT, int ldk, int dst_row0, LAS float* scr, int lane) {
#pragma unroll
    for (int i = 0; i < 8; ++i) { const int kk = (lane >> 3) + 8 * i, c4 = 4 * (lane & 7);
        f32x4 v = __builtin_nontemporal_load((const f32x4*)(W + (size_t)(k0 + kk) * ldw + n0 + c4));
        if (gain) v = v * gain[k0 + kk];
        scr[kk * 33 + c4 + 0] = v[0]; scr[kk * 33 + c4 + 1] = v[1]; scr[kk * 33 + c4 + 2] = v[2]; scr[kk * 33 + c4 + 3] = v[3]; }
    LDS_WAIT(); asm volatile("" ::: "memory");
    const int c = lane & 7;
#pragma unroll
    for (int j = 0; j < 4; ++j) { const int n = (lane >> 3) + 8 * j; const LAS float* s = scr + (8 * c) * 33 + n;
        u32x4 o; o.x = pk2(s[0 * 33], s[1 * 33]); o.y = pk2(s[2 * 33], s[3 * 33]); o.z = pk2(s[4 * 33], s[5 * 33]); o.w = pk2(s[6 * 33], s[7 * 33]);
        if (n < ncols) *(u32x4*)(WT + (size_t)(dst_row0 + n) * ldk + k0 + 8 * c) = o; }
    LDS_WAIT(); asm volatile("" ::: "memory");
}
__device__ __forceinline__ void conv_job_item(int r, const float* W, int ldw, int col0, int nblk, int ncols_last, const float* gain, bf16_t* WT, int ldk, int mode, int dst_off, LAS float* scr, int lane) {
    const int kb = r / nblk, nb = r % nblk; const int nrel = 32 * nb;
    int drow = dst_off + nrel; if (mode) drow = 256 * (nrel >> 7) + (nrel & 127) + (mode == 2 ? 128 : 0);
    conv_item(W, ldw, 64 * kb, col0 + nrel, (nb == nblk - 1) ? ncols_last : 32, gain, WT, ldk, drow, scr, lane);
}
struct ConvItem { const float* src; const float* gain; bf16_t* dst; int ldw, ldk, ncols; };
__device__ __forceinline__ ConvItem conv_desc(int r, const float* W, int ldw, int col0, int nblk, int ncols_last, const float* gain, bf16_t* WT, int ldk, int mode, int dst_off) {
    const int kb = r / nblk, nb = r % nblk; const int nrel = 32 * nb;
    int drow = dst_off + nrel; if (mode) drow = 256 * (nrel >> 7) + (nrel & 127) + (mode == 2 ? 128 : 0);
    ConvItem c; c.src = W + (size_t)(64 * kb) * ldw + col0 + nrel; c.gain = gain ? gain + 64 * kb : nullptr; c.dst = WT + (size_t)drow * ldk + 64 * kb; c.ldw = ldw; c.ldk = ldk; c.ncols = (nb == nblk - 1) ? ncols_last : 32; return c;
}
__device__ __forceinline__ void conv_ld(f32x4 (&v)[8], const ConvItem& c, int lane) {
#pragma unroll
    for (int i = 0; i < 8; ++i) { const int kk = (lane >> 3) + 8 * i, c4 = 4 * (lane & 7); v[i] = __builtin_nontemporal_load((const GAS f32x4*)(c.src + (size_t)kk * c.ldw + c4)); }
}
typedef short v4i16_t __attribute__((ext_vector_type(4)));
typedef float f32x8_t __attribute__((ext_vector_type(8)));
__device__ __forceinline__ void conv_fin(const f32x4 (&v)[8], const ConvItem& c, LAS float* scr, int lane) {
#pragma unroll
    for (int i = 0; i < 8; ++i) { const int kk = (lane >> 3) + 8 * i, c4 = 4 * (lane & 7); f32x4 x = v[i]; if (c.gain) x = x * ((const GAS float*)c.gain)[kk];
        scr[kk * 33 + c4 + 0] = x[0]; scr[kk * 33 + c4 + 1] = x[1]; scr[kk * 33 + c4 + 2] = x[2]; scr[kk * 33 + c4 + 3] = x[3]; }
    LDS_WAIT(); asm volatile("" ::: "memory");
    const int cc = lane & 7;
#pragma unroll
    for (int j = 0; j < 4; ++j) { const int n = (lane >> 3) + 8 * j; const LAS float* sp = scr + (8 * cc) * 33 + n;
        u32x4 o; o.x = pk2(sp[0 * 33], sp[1 * 33]); o.y = pk2(sp[2 * 33], sp[3 * 33]); o.z = pk2(sp[4 * 33], sp[5 * 33]); o.w = pk2(sp[6 * 33], sp[7 * 33]);
        if (n < c.ncols) *(GAS u32x4*)(c.dst + (size_t)n * c.ldk + 8 * cc) = o; }
    LDS_WAIT(); asm volatile("" ::: "memory");
}
template <class D> __device__ __forceinline__ void conv_run(const D& d, int w, int nw, int nitems, LAS float* scr, int lane) {
    f32x4 va[8], vb[8];
    int it = w; if (it >= nitems) return;
    ConvItem ca = d(it), cb = ca; conv_ld(va, ca, lane);
    for (;;) {
        const int it2 = it + nw; const bool h2 = it2 < nitems;
        if (h2) { cb = d(it2); conv_ld(vb, cb, lane); }
        conv_fin(va, ca, scr, lane);
        if (!h2) break;
        const int it3 = it2 + nw; const bool h3 = it3 < nitems;
        if (h3) { ca = d(it3); conv_ld(va, ca, lane); }
        conv_fin(vb, cb, scr, lane);
        if (!h3) break;
        it = it3;
    }
}
struct ConvG0 { const float* const* in; unsigned char* ws; __device__ __forceinline__ ConvItem operator()(int r) const { return conv_desc(r, in[2], 2560, 0, 80, 32, in[1], wsp<bf16_t>(ws, WS_WIN0), 1024, 0, 0); } };
struct ConvG1 { const float* const* in; unsigned char* ws; __device__ __forceinline__ ConvItem operator()(int it) const { constexpr int I1 = 16 * 32, I2 = 16 * 88; int r = it;
    if (r < I1) return conv_desc(r, in[20], 1024, 0, 32, 32, nullptr, wsp<bf16_t>(ws, WS_WOUT0), 1024, 0, 0); r -= I1;
    if (r < I2) return conv_desc(r, in[22], 2816, 0, 88, 32, in[21], wsp<bf16_t>(ws, WS_WGU0), 1024, 1, 0); r -= I2;
    if (r < I2) return conv_desc(r, in[23], 2816, 0, 88, 32, in[21], wsp<bf16_t>(ws, WS_WGU0), 1024, 2, 0); r -= I2;
    return conv_desc(r, in[24], 1024, 0, 32, 32, nullptr, wsp<bf16_t>(ws, WS_WD0), 2816, 0, 0); } };
struct ConvG2 { const float* const* in; unsigned char* ws; __device__ __forceinline__ ConvItem operator()(int it) const { constexpr int I5 = 16 * 64, I6 = 16 * 32, I7 = 16; int r = it;
    if (r < I5) return conv_desc(r, in[26], 3088, 0, 64, 32, in[25], wsp<bf16_t>(ws, WS_WIN1), 1024, 0, 0); r -= I5;
    if (r < I6) return conv_desc(r, in[26], 3088, 2064, 32, 32, in[25], wsp<bf16_t>(ws, WS_WIN1), 1024, 0, 2048); r -= I6;
    if (r < I7) return conv_desc(r, in[26], 3088, 2048, 1, 16, in[25], wsp<bf16_t>(ws, WS_WIN1), 1024, 0, 3072); r -= I7;
    return conv_desc(r, in[32], 1024, 0, 32, 32, nullptr, wsp<bf16_t>(ws, WS_WOUT1), 1024, 0, 0); } };
__device__ __forceinline__ void conv_group(const Frame& F, int group, int w, int nw) {
    LAS float* scr = (LAS float*)(F.lds + F.wave * 16384); const int lane = F.lane;
    if (group == 0) { ConvG0 d{F.in, F.ws}; conv_run(d, w, nw, 16 * 80, scr, lane); }
    else if (group == 1) { ConvG1 d{F.in, F.ws}; conv_run(d, w, nw, 16 * 32 + 2 * 16 * 88 + 44 * 32, scr, lane); }
    else { ConvG2 d{F.in, F.ws}; conv_run(d, w, nw, 16 * 64 + 16 * 32 + 16 + 16 * 32, scr, lane); }
}
__device__ __forceinline__ void phase_prologue(const Frame& F) {
    const int gw = F.vcu * NWAVES + F.wave, NGW = F.G * NWAVES, lane = F.lane;
    unsigned char* ws = F.ws;
    conv_group(F, 0, gw, NGW);
    if (F.G < 256) { conv_group(F, 1, gw, NGW); conv_group(F, 2, gw, NGW); }
    const int gt = F.vcu * 512 + F.tid, NGT = F.G * 512;
    { bf16_t* wlr = wsp<bf16_t>(ws, WS_WLR);
      for (int i = gt; i < 2560 * 32; i += NGT) { const int n = i % 2560, k0 = 8 * (i / 2560);
          const float* src = nullptr; int kr = 0, nc = 0;
          if (n < 512)       { if (k0 < 64) { src = F.in[5]; kr = k0; nc = n; } }
          else if (n < 1024) { if (k0 < 64) { src = F.in[7]; kr = k0; nc = n - 512; } }
          else if (n < 1536) { if (k0 >= 64 && k0 < 128) { src = F.in[9]; kr = k0 - 64; nc = n - 1024; } }
          else if (n < 2048) { if (k0 >= 64 && k0 < 128) { src = F.in[11]; kr = k0 - 64; nc = n - 1536; } }
          else               { if (k0 >= 128) { src = F.in[12]; kr = k0 - 128; nc = n - 2048; } }
          float v[8];
#pragma unroll
          for (int j = 0; j < 8; ++j) v[j] = src ? src[(size_t)(kr + j) * 512 + nc] : 0.f;
          *(u32x4*)(wlr + (size_t)n * 256 + k0) = pack8f(v); } }
    { f32x2* rt = wsp<f32x2>(ws, WS_ROPE);
      for (int i = gt; i < SEQ * 32; i += NGT) { const int ts = i >> 5, pi = i & 31; const float freq = expf(-(float)(pi & 15) * (9.210340371976184f / 16.f));
          const float ang = ((pi >= 16) ? (float)(ts & 63) : (float)(ts >> 6)) * freq; float sn, cs; sincosf(ang, &sn, &cs); rt[i] = (f32x2){cs, sn}; } }
    { const float* x = F.in[0]; bf16_t* xb = wsp<bf16_t>(ws, WS_XB); float* ssq = wsp<float>(ws, WS_SSQ0);
      for (int m0 = gw; m0 < M_TOK; m0 += 4 * NGW) { f32x4 v[4][4];
#pragma unroll
          for (int q = 0; q < 4; ++q) { const int m = m0 + q * NGW; if (m < M_TOK) { const f32x4* xr = (const f32x4*)(x + (size_t)m * 1024) + lane;
#pragma unroll
              for (int j = 0; j < 4; ++j) v[q][j] = __builtin_nontemporal_load(xr + 64 * j); } }
#pragma unroll
          for (int q = 0; q < 4; ++q) { const int m = m0 + q * NGW; if (m < M_TOK) { float s = 0.f;
#pragma unroll
              for (int j = 0; j < 4; ++j) s += (v[q][j].x * v[q][j].x + v[q][j].y * v[q][j].y) + (v[q][j].z * v[q][j].z + v[q][j].w * v[q][j].w);
              s = wave_sum(s);
              u32x2* o8 = (u32x2*)(xb + (size_t)m * 1024) + lane;
#pragma unroll
              for (int j = 0; j < 4; ++j) { u32x2 w; w.x = pk2(v[q][j].x, v[q][j].y); w.y = pk2(v[q][j].z, v[q][j].w); o8[64 * j] = w; }
              if (lane < 16) ssq[(size_t)m * 16 + lane] = (lane == 0) ? s : 0.f; } } } }
}
struct ConvEGU { const float* const* in; unsigned char* ws; int base; __device__ __forceinline__ ConvItem operator()(int it_) const { constexpr int IG = 16 * 112; const int it = it_ + base; const int e = it / (2 * IG), r = it % (2 * IG);
    bf16_t* wegu = wsp<bf16_t>(ws, A_WEGU + (e >= EGU_EARLY ? WEGU_HI_SHIFT : 0)) + (size_t)e * 2 * D_FFE * 1024;
    if (r < IG) return conv_desc(r, in[35] + (size_t)e * 1024 * D_FFE, D_FFE, 0, 112, 32, in[33], wegu, 1024, 1, 0);
    return conv_desc(r - IG, in[36] + (size_t)e * 1024 * D_FFE, D_FFE, 0, 112, 32, in[33], wegu, 1024, 2, 0); } };
struct ConvED { const float* const* in; unsigned char* ws; int base; __device__ __forceinline__ ConvItem operator()(int it_) const { constexpr int ID = 56 * 32; const int it = it_ + base; const int e = it / ID, r = it % ID;
    return conv_desc(r, in[37] + (size_t)e * D_FFE * 1024, 1024, 0, 32, 32, nullptr, wsp<bf16_t>(ws, A_WED) + (size_t)e * 1024 * D_FFE, D_FFE, 0, 0); } };
__device__ __forceinline__ void conv_experts_gu(const Frame& F, int w, int nw, int e_lo, int e_hi) { ConvEGU d{F.in, F.ws, e_lo * 2 * 16 * 112}; conv_run(d, w, nw, (e_hi - e_lo) * 2 * 16 * 112, (LAS float*)(F.lds + F.wave * 16384), F.lane); }
constexpr int ED_TAIL = 8;
__device__ __forceinline__ void conv_experts_down(const Frame& F, int w, int nw, int e_lo, int e_hi) { ConvED d{F.in, F.ws, e_lo * 56 * 32}; conv_run(d, w, nw, (e_hi - e_lo) * 56 * 32, (LAS float*)(F.lds + F.wave * 16384), F.lane); }
__device__ __forceinline__ void phase_conv_experts(const Frame& F) {
    const int gw = F.vcu * NWAVES + F.wave, NGW = F.G * NWAVES;
    conv_experts_gu(F, gw, NGW, 0, EGU_EARLY);
}

__device__ __forceinline__ float dpp8_sum(float v) {
    v += __builtin_bit_cast(float, __builtin_amdgcn_update_dpp(0, __builtin_bit_cast(int, v), 0xB1, 0xF, 0xF, false));
    v += __builtin_bit_cast(float, __builtin_amdgcn_update_dpp(0, __builtin_bit_cast(int, v), 0x4E, 0xF, 0xF, false));
    v += __builtin_bit_cast(float, __builtin_amdgcn_update_dpp(0, __builtin_bit_cast(int, v), 0x141, 0xF, 0xF, false));
    return v;
}
__device__ __forceinline__ void phase_prep0(const Frame& F) {
    const int gw = F.vcu * NWAVES + F.wave, lane = F.lane;
    const bf16_t* P = wsp<bf16_t>(F.ws, A_P0);
    bf16_t *RS = wsp<bf16_t>(F.ws, A_RS), *KS = wsp<bf16_t>(F.ws, A_KS), *VS = wsp<bf16_t>(F.ws, A_VS), *NKK = wsp<bf16_t>(F.ws, A_NKK), *AP = wsp<bf16_t>(F.ws, A_AP);
    bf16_t *QH = wsp<bf16_t>(F.ws, A_QH), *KH = wsp<bf16_t>(F.ws, A_KH), *VT = wsp<bf16_t>(F.ws, A_VT0);
    const f32x2* ROPE = wsp<f32x2>(F.ws, WS_ROPE);
    float mu[4][8], kkw[8], qn8[8], kn8[8];
#pragma unroll
    for (int j = 0; j < 4; ++j)
#pragma unroll
        for (int e = 0; e < 8; ++e) { const int col = 8 * (lane + 64 * j) + e; mu[j][e] = col < RW_IN ? F.in[3][col] : 0.f; }
#pragma unroll
    for (int e = 0; e < 8; ++e) { kkw[e] = F.in[13][8 * lane + e]; qn8[e] = F.in[18][8 * (lane & 7) + e]; kn8[e] = F.in[19][8 * (lane & 7) + e]; }
    LAS unsigned char* vscr = F.lds + F.wave * 2048;
    for (int g8 = gw; g8 < M_TOK / 8; g8 += F.G * NWAVES) {
        u32x4 prev[4], cur[5], nxt[4], nn[4];
        { const int tok = g8 * 8; const int ts = tok & (SEQ - 1);
#pragma unroll
          for (int j = 0; j < 5; ++j) cur[j] = *(const u32x4*)(P + (size_t)tok * E_IN + 8 * (lane + 64 * j));
#pragma unroll
          for (int j = 0; j < 4; ++j) nxt[j] = *(const u32x4*)(P + (size_t)(tok + 1) * E_IN + 8 * (lane + 64 * j));
#pragma unroll
          for (int j = 0; j < 4; ++j) prev[j] = (ts > 0) ? *(const u32x4*)(P + (size_t)(tok - 1) * E_IN + 8 * (lane + 64 * j)) : (u32x4){0u, 0u, 0u, 0u}; }
        for (int tt = 0; tt < 8; ++tt) { const int tok = g8 * 8 + tt; const int ts = tok & (SEQ - 1); const int bb = tok >> 11;
            u32x4 ncur4 = (u32x4){0u, 0u, 0u, 0u};
#pragma unroll
            for (int j = 0; j < 4; ++j) nn[j] = (u32x4){0u, 0u, 0u, 0u};
            if (tt < 7 && ts + 2 < SEQ) {
#pragma unroll
                for (int j = 0; j < 4; ++j) nn[j] = *(const u32x4*)(P + (size_t)(tok + 2) * E_IN + 8 * (lane + 64 * j)); }
            if (tt < 7) ncur4 = *(const u32x4*)(P + (size_t)(tok + 1) * E_IN + 8 * (lane + 256));
            const f32x4 rp0 = *(const f32x4*)(ROPE + (size_t)ts * 32 + 4 * (lane & 7)), rp1 = *(const f32x4*)(ROPE + (size_t)ts * 32 + 4 * (lane & 7) + 2);
            const float cs4[4] = {rp0[0], rp0[2], rp1[0], rp1[2]}, sn4[4] = {rp0[1], rp0[3], rp1[1], rp1[3]};
            float s[4][8];
#pragma unroll
            for (int j = 0; j < 4; ++j) { float c[8], p[8], n[8]; unpack8(cur[j], c); unpack8(prev[j], p); unpack8(nxt[j], n);
#pragma unroll
                for (int e = 0; e < 8; ++e) s[j][e] = c[e] + (0.5f * (p[e] + n[e]) - c[e]) * mu[j][e]; }
            const size_t o512 = (size_t)tok * 512 + 8 * lane;
            *(u32x4*)(RS + o512) = pack8f(s[0]); *(u32x4*)(KS + o512) = pack8f(s[1]); *(u32x4*)(VS + o512) = pack8f(s[2]);
            { float kr[8]; float ss = 0.f;
#pragma unroll
              for (int e = 0; e < 8; ++e) { kr[e] = s[1][e] * kkw[e]; ss += kr[e] * kr[e]; }
              ss = dpp8_sum(ss); const float inv = -1.f / fmaxf(sqrtf(ss), 1e-12f);
#pragma unroll
              for (int e = 0; e < 8; ++e) kr[e] *= inv;
              *(u32x4*)(NKK + o512) = pack8f(kr); }
            float x3[8], x4[8]; unpack8(cur[3], x3); unpack8(cur[4], x4);
            { float ap[8];
#pragma unroll
              for (int e = 0; e < 8; ++e) { const float x = s[3][e]; const float sg = sigmoidf_(lane < 8 ? 2.f * x : x); ap[e] = lane < 8 ? 2.f * sg - 1.f : (lane < 16 ? x : sg); }
              if (lane < 32) *(u32x4*)(AP + (size_t)tok * 256 + 8 * lane) = pack8f(ap); }
#pragma unroll
            for (int which = 0; which < 2; ++which) { float (&x)[8] = which ? x4 : x3; float ss = 0.f;
#pragma unroll
                for (int e = 0; e < 8; ++e) ss += x[e] * x[e];
                ss = dpp8_sum(ss); const float rs = __builtin_amdgcn_rsqf(ss * (1.f / 64.f) + NORM_EPS);
                const bool isk = which && lane >= 32; float o[8];
#pragma unroll
                for (int p = 0; p < 4; ++p) { const float x0 = x[2 * p] * rs * (isk ? kn8[2 * p] : qn8[2 * p]), x1 = x[2 * p + 1] * rs * (isk ? kn8[2 * p + 1] : qn8[2 * p + 1]);
                    o[2 * p] = x0 * cs4[p] - x1 * sn4[p]; o[2 * p + 1] = x0 * sn4[p] + x1 * cs4[p]; }
                if (!isk) {
#pragma unroll
                    for (int e = 0; e < 8; ++e) o[e] *= 0.18033688011112042f; }
                if (which == 0) { if (lane >= 32) *(u32x4*)(QH + (size_t)tok * 512 + 8 * (lane - 32)) = pack8f(o); }
                else { if (lane < 32) *(u32x4*)(QH + (size_t)tok * 512 + 256 + 8 * lane) = pack8f(o);
                       else if (lane < 48) *(u32x4*)(KH + (size_t)tok * 128 + 8 * (lane - 32)) = pack8f(o); } }
            if (lane >= 48) *(LAS u32x4*)(vscr + tt * 256 + (lane - 48) * 16) = cur[4];
#pragma unroll
            for (int j = 0; j < 4; ++j) prev[j] = cur[j];
#pragma unroll
            for (int j = 0; j < 4; ++j) { cur[j] = nxt[j]; nxt[j] = nn[j]; }
            cur[4] = ncur4;
        }
        LDS_WAIT();
        { const int tok0 = g8 * 8, ts0 = tok0 & (SEQ - 1), bb0 = tok0 >> 11;
#pragma unroll
          for (int hh = 0; hh < 2; ++hh) { const int col = lane + 64 * hh; unsigned pk[4];
#pragma unroll
              for (int q = 0; q < 4; ++q) pk[q] = (unsigned)*(const LAS bf16_t*)(vscr + (2 * q) * 256 + col * 2) | ((unsigned)*(const LAS bf16_t*)(vscr + (2 * q + 1) * 256 + col * 2) << 16);
              *(u32x4*)(VT + ((size_t)(bb0 * 2 + (col >> 6)) * 64 + (col & 63)) * SEQ + ts0) = (u32x4){pk[0], pk[1], pk[2], pk[3]}; } }
        LDS_WAIT();
    }
}

__device__ __forceinline__ float dpp_row_sum(float v) {
    v += __builtin_bit_cast(float, __builtin_amdgcn_update_dpp(0, __builtin_bit_cast(int, v), 0xB1, 0xF, 0xF, false));
    v += __builtin_bit_cast(float, __builtin_amdgcn_update_dpp(0, __builtin_bit_cast(int, v), 0x4E, 0xF, 0xF, false));
    v += __builtin_bit_cast(float, __builtin_amdgcn_update_dpp(0, __builtin_bit_cast(int, v), 0x141, 0xF, 0xF, false));
    v += __builtin_bit_cast(float, __builtin_amdgcn_update_dpp(0, __builtin_bit_cast(int, v), 0x140, 0xF, 0xF, false));
    return v;
}
constexpr int SC_STEPS = 32, SC_STRIDE = 352, SC_BUF = SC_STEPS * SC_STRIDE;
__device__ __forceinline__ float dpp_row8_sum(float v) {
    v += __builtin_bit_cast(float, __builtin_amdgcn_update_dpp(0, __builtin_bit_cast(int, v), 0xB1, 0xF, 0xF, false));
    v += __builtin_bit_cast(float, __builtin_amdgcn_update_dpp(0, __builtin_bit_cast(int, v), 0x4E, 0xF, 0xF, false));
    v += __builtin_bit_cast(float, __builtin_amdgcn_update_dpp(0, __builtin_bit_cast(int, v), 0x141, 0xF, 0xF, false));
    return v;
}
struct ScOps { f32x2 w[4], kd[4], a[4], b[4], r[4]; float v; };
__device__ __forceinline__ void sc_ld(ScOps& o, const LAS float* bs, const LAS float* vp) {
#pragma unroll
    for (int i = 0; i < 2; ++i) {
        const f32x4 w4 = *(const LAS f32x4*)(bs + 4 * i), k4 = *(const LAS f32x4*)(bs + 64 + 4 * i), a4 = *(const LAS f32x4*)(bs + 128 + 4 * i), b4 = *(const LAS f32x4*)(bs + 192 + 4 * i), r4 = *(const LAS f32x4*)(bs + 256 + 4 * i);
        o.w[2 * i] = (f32x2){w4[0], w4[1]}; o.w[2 * i + 1] = (f32x2){w4[2], w4[3]}; o.kd[2 * i] = (f32x2){k4[0], k4[1]}; o.kd[2 * i + 1] = (f32x2){k4[2], k4[3]};
        o.a[2 * i] = (f32x2){a4[0], a4[1]}; o.a[2 * i + 1] = (f32x2){a4[2], a4[3]}; o.b[2 * i] = (f32x2){b4[0], b4[1]}; o.b[2 * i + 1] = (f32x2){b4[2], b4[3]};
        o.r[2 * i] = (f32x2){r4[0], r4[1]}; o.r[2 * i + 1] = (f32x2){r4[2], r4[3]}; }
    o.v = *vp;
}
template <int DIR> __device__ __forceinline__ float sc_step(f32x2 (&s)[4], const ScOps& o) {
    f32x2 u[4];
#pragma unroll
    for (int i = 0; i < 4; ++i) u[i] = o.kd[i] * o.v;
    f32x2 p = s[0] * o.a[0], q = s[1] * o.a[1];
    p = __builtin_elementwise_fma(s[2], o.a[2], p); q = __builtin_elementwise_fma(s[3], o.a[3], q); p = p + q;
    float sa = dpp_row8_sum(p[0] + p[1]);
    f32x2 yp, yq;
    if (DIR) { yp = s[0] * o.r[0]; yq = s[1] * o.r[1]; yp = __builtin_elementwise_fma(s[2], o.r[2], yp); yq = __builtin_elementwise_fma(s[3], o.r[3], yq); }
    const f32x2 sa2 = {sa, sa};
#pragma unroll
    for (int i = 0; i < 4; ++i) { const f32x2 t = __builtin_elementwise_fma(o.b[i], sa2, u[i]); s[i] = __builtin_elementwise_fma(s[i], o.w[i], t); }
    if (!DIR) { yp = s[0] * o.r[0]; yq = s[1] * o.r[1]; yp = __builtin_elementwise_fma(s[2], o.r[2], yp); yq = __builtin_elementwise_fma(s[3], o.r[3], yq); }
    yp = yp + yq;
    return dpp_row8_sum(yp[0] + yp[1]);
}
__device__ __forceinline__ void attn_tile_step(const LAS unsigned char* kb, const LAS unsigned char* vb, const bf16x8 (&q)[4], f32x16& o0, f32x16& o1, float& mrun, float& lrun, int r32, int hi) {
    f32x16 c0 = {}, c1 = {};
#pragma unroll
    for (int s4 = 0; s4 < 4; ++s4) { const int chk = 2 * s4 + hi;
        const bf16x8 k0 = *(const LAS bf16x8*)(kb + r32 * 128 + ((chk ^ (r32 & 7)) * 16));
        const bf16x8 k1 = *(const LAS bf16x8*)(kb + (32 + r32) * 128 + ((chk ^ (r32 & 7)) * 16));
        c0 = __builtin_amdgcn_mfma_f32_32x32x16_bf16(k0, q[s4], c0, 0, 0, 0);
        c1 = __builtin_amdgcn_mfma_f32_32x32x16_bf16(k1, q[s4], c1, 0, 0, 0); }
    float mx = c0[0];
#pragma unroll
    for (int r = 0; r < 16; ++r) { mx = fmaxf(mx, c0[r]); mx = fmaxf(mx, c1[r]); }
    mx = fmaxf(mx, __shfl_xor(mx, 32));
    const float mnew = fmaxf(mrun, mx); const float alpha = __builtin_amdgcn_exp2f(mrun - mnew); mrun = mnew;
    float ls = 0.f;
#pragma unroll
    for (int r = 0; r < 16; ++r) { c0[r] = __builtin_amdgcn_exp2f(c0[r] - mnew); c1[r] = __builtin_amdgcn_exp2f(c1[r] - mnew); ls += c0[r] + c1[r]; }
    lrun = lrun * alpha + ls;
#pragma unroll
    for (int r = 0; r < 16; ++r) { o0[r] *= alpha; o1[r] *= alpha; }
    u32x4 w00, w01, w10, w11;
    w00.x = pk2(c0[0], c0[1]); w00.y = pk2(c0[2], c0[3]); w00.z = pk2(c0[4], c0[5]); w00.w = pk2(c0[6], c0[7]);
    w01.x = pk2(c0[8], c0[9]); w01.y = pk2(c0[10], c0[11]); w01.z = pk2(c0[12], c0[13]); w01.w = pk2(c0[14], c0[15]);
    w10.x = pk2(c1[0], c1[1]); w10.y = pk2(c1[2], c1[3]); w10.z = pk2(c1[4], c1[5]); w10.w = pk2(c1[6], c1[7]);
    w11.x = pk2(c1[8], c1[9]); w11.y = pk2(c1[10], c1[11]); w11.z = pk2(c1[12], c1[13]); w11.w = pk2(c1[14], c1[15]);
    const bf16x8 p00 = __builtin_bit_cast(bf16x8, w00), p01 = __builtin_bit_cast(bf16x8, w01), p10 = __builtin_bit_cast(bf16x8, w10), p11 = __builtin_bit_cast(bf16x8, w11);
#define AT_VF(dd_, chk_) ({ const int sw_ = ((dd_) >> 1) & 7; const u32x2 lo_ = *(const LAS u32x2*)(vb + (dd_) * 128 + (((chk_) ^ sw_) * 16) + hi * 8); \
        const u32x2 hh_ = *(const LAS u32x2*)(vb + (dd_) * 128 + ((((chk_) + 1) ^ sw_) * 16) + hi * 8); const u32x4 vv_ = {lo_.x, lo_.y, hh_.x, hh_.y}; __builtin_bit_cast(bf16x8, vv_); })
    o0 = __builtin_amdgcn_mfma_f32_32x32x16_bf16(AT_VF(r32, 0), p00, o0, 0, 0, 0);
    o0 = __builtin_amdgcn_mfma_f32_32x32x16_bf16(AT_VF(r32, 2), p01, o0, 0, 0, 0);
    o0 = __builtin_amdgcn_mfma_f32_32x32x16_bf16(AT_VF(r32, 4), p10, o0, 0, 0, 0);
    o0 = __builtin_amdgcn_mfma_f32_32x32x16_bf16(AT_VF(r32, 6), p11, o0, 0, 0, 0);
    o1 = __builtin_amdgcn_mfma_f32_32x32x16_bf16(AT_VF(32 + r32, 0), p00, o1, 0, 0, 0);
    o1 = __builtin_amdgcn_mfma_f32_32x32x16_bf16(AT_VF(32 + r32, 2), p01, o1, 0, 0, 0);
    o1 = __builtin_amdgcn_mfma_f32_32x32x16_bf16(AT_VF(32 + r32, 4), p10, o1, 0, 0, 0);
    o1 = __builtin_amdgcn_mfma_f32_32x32x16_bf16(AT_VF(32 + r32, 6), p11, o1, 0, 0, 0);
#undef AT_VF
}
__device__ __forceinline__ void attn_store(bf16_t* op, const f32x16& o0, const f32x16& o1, float lrun) {
    const float ltot = lrun + __shfl_xor(lrun, 32); const float inv = 1.f / ltot;
#pragma unroll
    for (int q4 = 0; q4 < 4; ++q4) { u32x2 w0, w1;
        w0.x = pk2(o0[4 * q4 + 0] * inv, o0[4 * q4 + 1] * inv); w0.y = pk2(o0[4 * q4 + 2] * inv, o0[4 * q4 + 3] * inv);
        w1.x = pk2(o1[4 * q4 + 0] * inv, o1[4 * q4 + 1] * inv); w1.y = pk2(o1[4 * q4 + 2] * inv, o1[4 * q4 + 3] * inv);
        *(u32x2*)(op + 8 * q4) = w0; *(u32x2*)(op + 32 + 8 * q4) = w1; }
}
constexpr int CS_SLOT = 9216, CS_RS = 144;
__device__ __forceinline__ void cs_mm(f32x4 (&acc)[2], const LAS unsigned char* L, const LAS unsigned char* Rt, int mi, int ni0, int fr, int fq) {
#pragma unroll
    for (int s2 = 0; s2 < 2; ++s2) { const bf16x8 a = *(const LAS bf16x8*)(L + (16 * mi + fr) * CS_RS + (32 * s2 + 8 * fq) * 2);
#pragma unroll
        for (int jj = 0; jj < 2; ++jj) { const bf16x8 bb = *(const LAS bf16x8*)(Rt + (16 * (ni0 + jj) + fr) * CS_RS + (32 * s2 + 8 * fq) * 2);
            acc[jj] = __builtin_amdgcn_mfma_f32_16x16x32_bf16(a, bb, acc[jj], 0, 0, 0); } }
}
__device__ __forceinline__ void cs_st_t8(LAS unsigned char* dst, const f32x4 (&acc)[2], int mi, int ni0, int fr, int fq) {
#pragma unroll
    for (int jj = 0; jj < 2; ++jj) { u32x2 w; w.x = pk2(acc[jj][0], acc[jj][1]); w.y = pk2(acc[jj][2], acc[jj][3]);
        *(LAS u32x2*)(dst + (16 * (ni0 + jj) + fr) * CS_RS + (16 * mi + 4 * fq) * 2) = w; }
}
__device__ __forceinline__ void cs_st_sc(LAS unsigned char* dst, const f32x4 (&acc)[2], int mi, int ni0, int fr, int fq) {
#pragma unroll
    for (int jj = 0; jj < 2; ++jj)
#pragma unroll
        for (int r = 0; r < 4; ++r) *(LAS bf16_t*)(dst + (16 * mi + 4 * fq + r) * CS_RS + (16 * (ni0 + jj) + fr) * 2) = f2bf(acc[jj][r]);
}
__device__ __forceinline__ void cs_ld_t8(f32x4 (&acc)[2], const LAS unsigned char* src, int mi, int ni0, int fr, int fq) {
#pragma unroll
    for (int jj = 0; jj < 2; ++jj) { const u32x2 w = *(const LAS u32x2*)(src + (16 * (ni0 + jj) + fr) * CS_RS + (16 * mi + 4 * fq) * 2);
        acc[jj] = (f32x4){bflo(w.x), bfhi(w.x), bflo(w.y), bfhi(w.y)}; }
}
#define CS_ZERO(acc) do { acc[0] = (f32x4){0.f, 0.f, 0.f, 0.f}; acc[1] = acc[0]; } while (0)
template <int RS = CS_RS> __device__ __forceinline__ bf16x8 cs_afrag_tr(const LAS unsigned char* LT, int mi, int s2, int fr, int fq) {
    const LAS unsigned char* p = LT + (32 * s2 + 8 * fq + (fr >> 2)) * RS + (16 * mi + 4 * (fr & 3)) * 2;
    const v4i16_t lo = __builtin_amdgcn_ds_read_tr16_b64_v4i16((LAS v4i16_t*)p);
    const v4i16_t hi = __builtin_amdgcn_ds_read_tr16_b64_v4i16((LAS v4i16_t*)(p + 4 * RS));
    return (bf16x8){lo[0], lo[1], lo[2], lo[3], hi[0], hi[1], hi[2], hi[3]};
}
__device__ __forceinline__ void cs_mm_tr(f32x4 (&acc)[2], const LAS unsigned char* LT, const LAS unsigned char* Rt, int mi, int ni0, int fr, int fq) {
#pragma unroll
    for (int s2 = 0; s2 < 2; ++s2) { const bf16x8 a = cs_afrag_tr(LT, mi, s2, fr, fq);
#pragma unroll
        for (int jj = 0; jj < 2; ++jj) { const bf16x8 bb = *(const LAS bf16x8*)(Rt + (16 * (ni0 + jj) + fr) * CS_RS + (32 * s2 + 8 * fq) * 2);
            acc[jj] = __builtin_amdgcn_mfma_f32_16x16x32_bf16(a, bb, acc[jj], 0, 0, 0); } }
}
__device__ __forceinline__ void cs_mm_tr2(f32x4 (&aU)[2], f32x4 (&aS)[2], const LAS unsigned char* LUT, const LAS unsigned char* LST, const LAS unsigned char* Rt, bool doS, int mi, int ni0, int fr, int fq) {
#pragma unroll
    for (int s2 = 0; s2 < 2; ++s2) { const bf16x8 au = cs_afrag_tr(LUT, mi, s2, fr, fq); const bf16x8 as = cs_afrag_tr(LST, mi, s2, fr, fq);
#pragma unroll
        for (int jj = 0; jj < 2; ++jj) { const bf16x8 bb = *(const LAS bf16x8*)(Rt + (16 * (ni0 + jj) + fr) * CS_RS + (32 * s2 + 8 * fq) * 2);
            aU[jj] = __builtin_amdgcn_mfma_f32_16x16x32_bf16(au, bb, aU[jj], 0, 0, 0);
            if (doS) aS[jj] = __builtin_amdgcn_mfma_f32_16x16x32_bf16(as, bb, aS[jj], 0, 0, 0); } }
}
__device__ __forceinline__ void cs_mm_2r(f32x4 (&accA)[2], f32x4 (&accB)[2], const LAS unsigned char* L, const LAS unsigned char* RtA, const LAS unsigned char* RtB, int mi, int ni0, int fr, int fq) {
#pragma unroll
    for (int s2 = 0; s2 < 2; ++s2) { const bf16x8 a = *(const LAS bf16x8*)(L + (16 * mi + fr) * CS_RS + (32 * s2 + 8 * fq) * 2);
#pragma unroll
        for (int jj = 0; jj < 2; ++jj) { const bf16x8 ba = *(const LAS bf16x8*)(RtA + (16 * (ni0 + jj) + fr) * CS_RS + (32 * s2 + 8 * fq) * 2), bb = *(const LAS bf16x8*)(RtB + (16 * (ni0 + jj) + fr) * CS_RS + (32 * s2 + 8 * fq) * 2);
            accA[jj] = __builtin_amdgcn_mfma_f32_16x16x32_bf16(a, ba, accA[jj], 0, 0, 0); accB[jj] = __builtin_amdgcn_mfma_f32_16x16x32_bf16(a, bb, accB[jj], 0, 0, 0); } }
}
__device__ __forceinline__ void cs_ld_tile(f32x4& acc, const LAS unsigned char* src, int mi, int ni, int fr, int fq) {
    const u32x2 w = *(const LAS u32x2*)(src + (16 * ni + fr) * CS_RS + (16 * mi + 4 * fq) * 2); acc = (f32x4){bflo(w.x), bfhi(w.x), bflo(w.y), bfhi(w.y)};
}
__device__ __forceinline__ void cs_st_tile(LAS unsigned char* dst, const f32x4& acc, int mi, int ni, int fr, int fq) {
    u32x2 w; w.x = pk2(acc[0], acc[1]); w.y = pk2(acc[2], acc[3]); *(LAS u32x2*)(dst + (16 * ni + fr) * CS_RS + (16 * mi + 4 * fq) * 2) = w;
}
__device__ __forceinline__ void cs_zero_tile(LAS unsigned char* dst, int mi, int ni, int fr, int fq) { *(LAS u32x2*)(dst + (16 * ni + fr) * CS_RS + (16 * mi + 4 * fq) * 2) = (u32x2){0u, 0u}; }
__device__ __forceinline__ void cs_tile_step2(f32x4& aU, f32x4& aS, const LAS unsigned char* LUT, const LAS unsigned char* LST, const LAS unsigned char* Rt, bool doS, int mi, int ni, int s2, int fr, int fq) {
    const bf16x8 au = cs_afrag_tr(LUT, mi, s2, fr, fq);
    const bf16x8 bb = *(const LAS bf16x8*)(Rt + (16 * ni + fr) * CS_RS + (32 * s2 + 8 * fq) * 2);
    aU = __builtin_amdgcn_mfma_f32_16x16x32_bf16(au, bb, aU, 0, 0, 0);
    if (doS) { const bf16x8 as = cs_afrag_tr(LST, mi, s2, fr, fq); aS = __builtin_amdgcn_mfma_f32_16x16x32_bf16(as, bb, aS, 0, 0, 0); }
}
__device__ __forceinline__ void cs_mask(f32x4 (&acc)[2], int mi, int ni0, int fr, int fq, int mode) {
#pragma unroll
    for (int jj = 0; jj < 2; ++jj) { const int ni = ni0 + jj;
        const bool keep_all = (mode == 1) ? (ni < mi) : (ni > mi), diag = (ni == mi);
        if (diag) {
#pragma unroll
            for (int r = 0; r < 4; ++r) { const int ml = 4 * fq + r; const bool k = (mode == 0) ? (ml < fr) : (mode == 1) ? (fr < ml) : (ml <= fr); if (!k) acc[jj][r] = 0.f; }
        } else if (!keep_all) acc[jj] = (f32x4){0.f, 0.f, 0.f, 0.f}; }
}
template <int DIR> __device__ __forceinline__ void cscan_job(const Frame& F, int b, int h) {
    const int tid = F.tid, lane = F.lane, wave = F.wave, fr = lane & 15, fq = lane >> 4;
    LAS unsigned char* L0 = F.lds;
#define SL(i) (L0 + (i) * CS_SLOT)
    LAS float* Dl = (LAS float*)(SL(14) + 8704);
    const bf16_t* g0 = wsp<bf16_t>(F.ws, DIR ? A_LWB : A_LWF); const bf16_t* g1 = wsp<bf16_t>(F.ws, A_KS); const bf16_t* g2 = wsp<bf16_t>(F.ws, A_NKK);
    const bf16_t* g3 = wsp<bf16_t>(F.ws, DIR ? A_SGB : A_SGF); const bf16_t* g4 = wsp<bf16_t>(F.ws, A_RS); const bf16_t* g5 = wsp<bf16_t>(F.ws, A_VS);
    bf16_t* Y = wsp<bf16_t>(F.ws, DIR ? A_YB : A_YF);
    const int mi = wave >> 1, ni0 = 2 * (wave & 1);
    const int rt_ = tid >> 3, rc_ = tid & 7;
    const int ek = tid & 63, etq = tid >> 6;
    u32x4 rawv, rawv_cur; bf16_t lwn[8], kdn[8], ann[8], sgn[8], rnn[8];
    const float ka_k = F.in[14][h * 64 + ek];
#define CS_LOAD(n_) do { const int sq_ = 64 * (n_) + rt_; const size_t to_ = (size_t)(b * SEQ + (DIR ? (SEQ - 1 - sq_) : sq_)) * 512 + h * 64; \
        rawv = *(const u32x4*)(g5 + to_ + 8 * rc_); \
        _Pragma("unroll") for (int j_ = 0; j_ < 8; ++j_) { const int sq2_ = 64 * (n_) + 8 * etq + j_; const size_t o2_ = (size_t)(b * SEQ + (DIR ? (SEQ - 1 - sq2_) : sq2_)) * 512 + h * 64 + ek; \
            lwn[j_] = g0[o2_]; kdn[j_] = g1[o2_]; ann[j_] = g2[o2_]; sgn[j_] = g3[o2_]; rnn[j_] = g4[o2_]; } } while (0)
    __syncthreads();
    for (int i = tid; i < 8704 / 4; i += 512) ((LAS unsigned*)SL(14))[i] = 0u;
    CS_LOAD(0);
    float lwv[8], cw[8];
    LAS float* PART = (LAS float*)(L0 + 16 * CS_SLOT);
#define CS_STAGE0(nn_) do { \
        _Pragma("unroll") for (int j = 0; j < 8; ++j) lwv[j] = bf2f(lwn[j]); \
        cw[0] = lwv[0]; \
        _Pragma("unroll") for (int j = 1; j < 8; ++j) cw[j] = cw[j - 1] + lwv[j]; \
        PART[etq * 64 + ek] = cw[7]; \
        rawv_cur = rawv; } while (0)
    CS_STAGE0(0);
    __syncthreads();
    {
        { float off = 0.f, tot = 0.f;
#pragma unroll
          for (int q = 0; q < 8; ++q) { const float p = PART[q * 64 + ek]; tot += p; if (q < etq) off += p; }
          const float ec = __builtin_amdgcn_exp2f(tot);
          if (etq == 0) Dl[ek] = ec;
          unsigned pa[4], pbh[4], pkh[4];
          float e1p = __builtin_amdgcn_exp2f(off);
#pragma unroll
          for (int j = 0; j < 8; ++j) { const int t = 8 * etq + j; const float c = cw[j] + off;
              const float e1 = __builtin_amdgcn_exp2f(c), em = __builtin_amdgcn_exp2f(-c), ep = e1p; e1p = e1;
              const float kdv = bf2f(kdn[j]), av = bf2f(ann[j]), bv = bf2f(sgn[j]), rv = bf2f(rnn[j]);
              const float sgv = bv; const float kd2 = kdv * (1.f + (sgv - 1.f) * ka_k), bb2 = -av * sgv;
              const float at = av * ep, bt = bb2 * em, kt = kd2 * em, rtv = rv * (DIR ? ep : e1), bh = bt * ec, kh = kt * ec;
              const unsigned w01 = pk2(at, bt), w23 = pk2(kt, rtv);
              *(LAS bf16_t*)(SL(0) + t * CS_RS + ek * 2) = (bf16_t)(w01 & 0xffffu); *(LAS bf16_t*)(SL(1) + t * CS_RS + ek * 2) = (bf16_t)(w01 >> 16);
              *(LAS bf16_t*)(SL(2) + t * CS_RS + ek * 2) = (bf16_t)(w23 & 0xffffu); *(LAS bf16_t*)(SL(3) + t * CS_RS + ek * 2) = (bf16_t)(w23 >> 16);
              const unsigned hbk = pk2(bh, kh); const unsigned ha = w01 & 0xffffu, hb = hbk & 0xffffu, hk = hbk >> 16;
              if (j & 1) { pa[j >> 1] |= ha << 16; pbh[j >> 1] |= hb << 16; pkh[j >> 1] |= hk << 16; } else { pa[j >> 1] = ha; pbh[j >> 1] = hb; pkh[j >> 1] = hk; } }
          *(LAS u32x4*)(SL(4) + ek * CS_RS + etq * 16) = (u32x4){pa[0], pa[1], pa[2], pa[3]};
          *(LAS u32x4*)(SL(5) + ek * CS_RS + etq * 16) = (u32x4){pbh[0], pbh[1], pbh[2], pbh[3]};
          *(LAS u32x4*)(SL(6) + ek * CS_RS + etq * 16) = (u32x4){pkh[0], pkh[1], pkh[2], pkh[3]}; }
        CS_LOAD(1);
    }
    __syncthreads();
    for (int n = 0; n < 32; ++n) {
        { f32x4 acc[2], accp[2];
          CS_ZERO(acc); CS_ZERO(accp); cs_mm_2r(acc, accp, SL(1), SL(0), SL(3), mi, ni0, fr, fq); cs_mask(acc, mi, ni0, fr, fq, 0);
          cs_st_t8(SL(8), acc, mi, ni0, fr, fq);
          if (mi == ni0 || mi == ni0 + 1) { const int jd = mi - ni0;
#pragma unroll
              for (int jj = 0; jj < 2; ++jj)
#pragma unroll
                  for (int r = 0; r < 4; ++r) if (jj == jd && (4 * fq + r) == fr) acc[jj][r] += 1.f; }
          cs_st_t8(SL(13), acc, mi, ni0, fr, fq);
          cs_mask(accp, mi, ni0, fr, fq, DIR ? 0 : 2); cs_st_t8(SL(10), accp, mi, ni0, fr, fq); }
        __syncthreads();
        { const int w2_ = 2 * wave; const bool same = wave < 4;
          const int m0 = (0x2444 >> w2_) & 3, n0 = (0x34AF >> w2_) & 3, s0 = (0x40 >> wave) & 1;
          const int m1 = (0x3844 >> w2_) & 3, n1 = (0x39AF >> w2_) & 3, s1 = (0x6F >> wave) & 1;
          f32x4 aS[2], aU[2];
          if (wave < 7) { f32x4 x0 = {0.f, 0.f, 0.f, 0.f}, x1 = x0, d0 = x0;
              const bf16x8 a0 = cs_afrag_tr(SL(8), m0, s0, fr, fq), a1 = cs_afrag_tr(SL(8), m1, s1, fr, fq);
              const bf16x8 b0 = *(const LAS bf16x8*)(SL(8) + (16 * n0 + fr) * CS_RS + (32 * s0 + 8 * fq) * 2), b1 = *(const LAS bf16x8*)(SL(8) + (16 * n1 + fr) * CS_RS + (32 * s1 + 8 * fq) * 2);
              x0 = __builtin_amdgcn_mfma_f32_16x16x32_bf16(a0, b0, x0, 0, 0, 0); x1 = __builtin_amdgcn_mfma_f32_16x16x32_bf16(a1, b1, x1, 0, 0, 0);
              if (same) cs_st_tile(SL(1), x0 + x1, m0, n0, fr, fq); else { cs_st_tile(SL(1), x0, m0, n0, fr, fq); cs_st_tile(SL(1), x1, m1, n1, fr, fq); } (void)d0;
          } else { cs_zero_tile(SL(1), 1, 0, fr, fq); cs_zero_tile(SL(1), 2, 0, fr, fq); cs_zero_tile(SL(1), 2, 1, fr, fq); cs_zero_tile(SL(1), 3, 0, fr, fq); cs_zero_tile(SL(1), 3, 1, fr, fq); cs_zero_tile(SL(1), 3, 2, fr, fq); }
          CS_ZERO(aU); cs_mm(aU, SL(0), SL(2), mi, ni0, fr, fq); cs_mask(aU, mi, ni0, fr, fq, 1); cs_st_t8(SL(9), aU, mi, ni0, fr, fq);
          __syncthreads();
#pragma unroll
          for (int it = 0; it < 5; ++it) { const int xc = (it & 1) ? 8 : 1, xa = (it & 1) ? 1 : 8, tc = (it & 1) ? 12 : 13, ta = (it & 1) ? 13 : 12;
              if (wave < 7) { f32x4 u0, u1, x0 = {0.f, 0.f, 0.f, 0.f}, x1 = x0;
                  cs_ld_tile(u0, SL(tc), m0, n0, fr, fq); cs_ld_tile(u1, SL(tc), m1, n1, fr, fq); if (same) u1 = (f32x4){0.f, 0.f, 0.f, 0.f};
                  const bf16x8 au0 = cs_afrag_tr(SL(tc), m0, s0, fr, fq), au1 = cs_afrag_tr(SL(tc), m1, s1, fr, fq);
                  const bf16x8 b0 = *(const LAS bf16x8*)(SL(xc) + (16 * n0 + fr) * CS_RS + (32 * s0 + 8 * fq) * 2), b1 = *(const LAS bf16x8*)(SL(xc) + (16 * n1 + fr) * CS_RS + (32 * s1 + 8 * fq) * 2);
                  u0 = __builtin_amdgcn_mfma_f32_16x16x32_bf16(au0, b0, u0, 0, 0, 0); u1 = __builtin_amdgcn_mfma_f32_16x16x32_bf16(au1, b1, u1, 0, 0, 0);
                  if (it < 4) { const bf16x8 as0 = cs_afrag_tr(SL(xc), m0, s0, fr, fq), as1 = cs_afrag_tr(SL(xc), m1, s1, fr, fq);
                      x0 = __builtin_amdgcn_mfma_f32_16x16x32_bf16(as0, b0, x0, 0, 0, 0); x1 = __builtin_amdgcn_mfma_f32_16x16x32_bf16(as1, b1, x1, 0, 0, 0); }
                  if (same) { cs_st_tile(SL(ta), u0 + u1, m0, n0, fr, fq); if (it < 4) cs_st_tile(SL(xa), x0 + x1, m0, n0, fr, fq); }
                  else { cs_st_tile(SL(ta), u0, m0, n0, fr, fq); cs_st_tile(SL(ta), u1, m1, n1, fr, fq); if (it < 4) { cs_st_tile(SL(xa), x0, m0, n0, fr, fq); cs_st_tile(SL(xa), x1, m1, n1, fr, fq); } }
              } else if (it == 0) { cs_zero_tile(SL(12), 1, 0, fr, fq); cs_zero_tile(SL(12), 2, 0, fr, fq); cs_zero_tile(SL(12), 2, 1, fr, fq); cs_zero_tile(SL(12), 3, 0, fr, fq); cs_zero_tile(SL(12), 3, 1, fr, fq); cs_zero_tile(SL(12), 3, 2, fr, fq); }
              if (it == 4) { CS_ZERO(aS); cs_mm(aS, SL(2), SL(3), mi, ni0, fr, fq); cs_mask(aS, mi, ni0, fr, fq, DIR ? 0 : 2); cs_st_t8(SL(11), aS, mi, ni0, fr, fq); }
              __syncthreads(); } }
        { f32x4 acc[2], accg[2];
          CS_ZERO(acc); CS_ZERO(accg); cs_mm_2r(acc, accg, SL(12), SL(4), SL(9), mi, ni0, fr, fq); cs_st_t8(SL(0), acc, mi, ni0, fr, fq); cs_st_t8(SL(1), accg, mi, ni0, fr, fq); }
        __syncthreads();
        { f32x4 acc[2];
          CS_ZERO(acc);
          if (mi == ni0 || mi == ni0 + 1) { const int jd = mi - ni0; const float dv = Dl[16 * mi + fr];
#pragma unroll
              for (int jj = 0; jj < 2; ++jj)
#pragma unroll
                  for (int r = 0; r < 4; ++r) if (jj == jd && (4 * fq + r) == fr) acc[jj][r] = dv; }
          f32x4 acc1[2], acc2[2], acc3[2];
          cs_ld_t8(acc1, SL(3), mi, ni0, fr, fq); cs_ld_t8(acc2, SL(6), mi, ni0, fr, fq); cs_ld_t8(acc3, SL(11), mi, ni0, fr, fq);
          bf16x8 g1f[2], g2f[2], bhf[2][2], p1f[2][2];
#pragma unroll
          for (int s2 = 0; s2 < 2; ++s2) { g1f[s2] = *(const LAS bf16x8*)(SL(0) + (16 * mi + fr) * CS_RS + (32 * s2 + 8 * fq) * 2); g2f[s2] = *(const LAS bf16x8*)(SL(1) + (16 * mi + fr) * CS_RS + (32 * s2 + 8 * fq) * 2);
#pragma unroll
              for (int jj = 0; jj < 2; ++jj) { bhf[jj][s2] = *(const LAS bf16x8*)(SL(5) + (16 * (ni0 + jj) + fr) * CS_RS + (32 * s2 + 8 * fq) * 2); p1f[jj][s2] = *(const LAS bf16x8*)(SL(10) + (16 * (ni0 + jj) + fr) * CS_RS + (32 * s2 + 8 * fq) * 2); } }
#pragma unroll
          for (int s2 = 0; s2 < 2; ++s2)
#pragma unroll
              for (int jj = 0; jj < 2; ++jj) {
                  acc[jj] = __builtin_amdgcn_mfma_f32_16x16x32_bf16(g1f[s2], bhf[jj][s2], acc[jj], 0, 0, 0); acc1[jj] = __builtin_amdgcn_mfma_f32_16x16x32_bf16(g1f[s2], p1f[jj][s2], acc1[jj], 0, 0, 0);
                  acc2[jj] = __builtin_amdgcn_mfma_f32_16x16x32_bf16(g2f[s2], bhf[jj][s2], acc2[jj], 0, 0, 0); acc3[jj] = __builtin_amdgcn_mfma_f32_16x16x32_bf16(g2f[s2], p1f[jj][s2], acc3[jj], 0, 0, 0); }
          cs_st_t8(SL(7), acc, mi, ni0, fr, fq); cs_st_t8(SL(8), acc1, mi, ni0, fr, fq);
          cs_st_t8(SL(9), acc2, mi, ni0, fr, fq); cs_st_t8(SL(13), acc3, mi, ni0, fr, fq);
          const unsigned w4[4] = {rawv_cur.x, rawv_cur.y, rawv_cur.z, rawv_cur.w};
#pragma unroll
          for (int e = 0; e < 8; ++e) *(LAS bf16_t*)(SL(12) + (8 * rc_ + e) * CS_RS + rt_ * 2) = (bf16_t)((e & 1) ? (w4[e >> 1] >> 16) : (w4[e >> 1] & 0xffffu)); }
        if (n + 1 < 32) CS_STAGE0(n + 1);
        __syncthreads();
        {
          const int mp = wave & 1, np = wave >> 1; const int nl0 = 2 * (np & 1);
          const LAS unsigned char* PHb = (np < 2 ? SL(7) : SL(8)); const LAS unsigned char* PSb = (np < 2 ? SL(9) : SL(13));
          const LAS unsigned char* Sr = (n & 1) ? SL(15) : SL(14); LAS unsigned char* Sw = (n & 1) ? SL(14) : SL(15);
          f32x4 acc[2][2];
#pragma unroll
          for (int jm = 0; jm < 2; ++jm)
#pragma unroll
              for (int jn = 0; jn < 2; ++jn) acc[jm][jn] = (f32x4){0.f, 0.f, 0.f, 0.f};
#pragma unroll
          for (int s2 = 0; s2 < 2; ++s2) { bf16x8 as[2], av[2], bph[2], bps[2];
#pragma unroll
              for (int j = 0; j < 2; ++j) { as[j] = cs_afrag_tr<136>(Sr, 2 * mp + j, s2, fr, fq); av[j] = *(const LAS bf16x8*)(SL(12) + (16 * (2 * mp + j) + fr) * CS_RS + (32 * s2 + 8 * fq) * 2);
                  bph[j] = *(const LAS bf16x8*)(PHb + (16 * (nl0 + j) + fr) * CS_RS + (32 * s2 + 8 * fq) * 2); bps[j] = *(const LAS bf16x8*)(PSb + (16 * (nl0 + j) + fr) * CS_RS + (32 * s2 + 8 * fq) * 2); }
#pragma unroll
              for (int jm = 0; jm < 2; ++jm)
#pragma unroll
                  for (int jn = 0; jn < 2; ++jn) { acc[jm][jn] = __builtin_amdgcn_mfma_f32_16x16x32_bf16(as[jm], bph[jn], acc[jm][jn], 0, 0, 0); acc[jm][jn] = __builtin_amdgcn_mfma_f32_16x16x32_bf16(av[jm], bps[jn], acc[jm][jn], 0, 0, 0); } }
          if (np < 2) {
#pragma unroll
              for (int jm = 0; jm < 2; ++jm)
#pragma unroll
                  for (int jn = 0; jn < 2; ++jn) { u32x2 w; w.x = pk2(acc[jm][jn][0], acc[jm][jn][1]); w.y = pk2(acc[jm][jn][2], acc[jm][jn][3]);
                      *(LAS u32x2*)(Sw + (16 * (2 * np + jn) + fr) * 136 + (16 * (2 * mp + jm) + 4 * fq) * 2) = w; }
          } else {
#pragma unroll
              for (int jn = 0; jn < 2; ++jn) { const int sq = 64 * n + 16 * (2 * (np - 2) + jn) + fr; const size_t tok = (size_t)(b * SEQ + (DIR ? (SEQ - 1 - sq) : sq));
#pragma unroll
                  for (int jm = 0; jm < 2; ++jm) { u32x2 w; w.x = pk2(acc[jm][jn][0], acc[jm][jn][1]); w.y = pk2(acc[jm][jn][2], acc[jm][jn][3]); *(u32x2*)(Y + tok * 512 + h * 64 + 16 * (2 * mp + jm) + 4 * fq) = w; } } } }
        if (n + 1 < 32) {
        { float off = 0.f, tot = 0.f;
#pragma unroll
          for (int q = 0; q < 8; ++q) { const float p = PART[q * 64 + ek]; tot += p; if (q < etq) off += p; }
          const float ec = __builtin_amdgcn_exp2f(tot);
          if (etq == 0) Dl[ek] = ec;
          unsigned pa[4], pbh[4], pkh[4];
          float e1p = __builtin_amdgcn_exp2f(off);
#pragma unroll
          for (int j = 0; j < 8; ++j) { const int t = 8 * etq + j; const float c = cw[j] + off;
              const float e1 = __builtin_amdgcn_exp2f(c), em = __builtin_amdgcn_exp2f(-c), ep = e1p; e1p = e1;
              const float kdv = bf2f(kdn[j]), av = bf2f(ann[j]), bv = bf2f(sgn[j]), rv = bf2f(rnn[j]);
              const float sgv = bv; const float kd2 = kdv * (1.f + (sgv - 1.f) * ka_k), bb2 = -av * sgv;
              const float at = av * ep, bt = bb2 * em, kt = kd2 * em, rtv = rv * (DIR ? ep : e1), bh = bt * ec, kh = kt * ec;
              const unsigned w01 = pk2(at, bt), w23 = pk2(kt, rtv);
              *(LAS bf16_t*)(SL(0) + t * CS_RS + ek * 2) = (bf16_t)(w01 & 0xffffu); *(LAS bf16_t*)(SL(1) + t * CS_RS + ek * 2) = (bf16_t)(w01 >> 16);
              *(LAS bf16_t*)(SL(2) + t * CS_RS + ek * 2) = (bf16_t)(w23 & 0xffffu); *(LAS bf16_t*)(SL(3) + t * CS_RS + ek * 2) = (bf16_t)(w23 >> 16);
              const unsigned hbk = pk2(bh, kh); const unsigned ha = w01 & 0xffffu, hb = hbk & 0xffffu, hk = hbk >> 16;
              if (j & 1) { pa[j >> 1] |= ha << 16; pbh[j >> 1] |= hb << 16; pkh[j >> 1] |= hk << 16; } else { pa[j >> 1] = ha; pbh[j >> 1] = hb; pkh[j >> 1] = hk; } }
          *(LAS u32x4*)(SL(4) + ek * CS_RS + etq * 16) = (u32x4){pa[0], pa[1], pa[2], pa[3]};
          *(LAS u32x4*)(SL(5) + ek * CS_RS + etq * 16) = (u32x4){pbh[0], pbh[1], pbh[2], pbh[3]};
          *(LAS u32x4*)(SL(6) + ek * CS_RS + etq * 16) = (u32x4){pkh[0], pkh[1], pkh[2], pkh[3]}; }
            if (n + 2 < 32) CS_LOAD(n + 2);
        }
        __syncthreads();
    }
#undef CS_LOAD
#undef CS_STAGE0
#undef SL
}

__device__ __forceinline__ void phase_attn_range(const Frame& F, int u_first, int u_stride) {
    const int tid = F.tid, lane = F.lane, wave = F.wave, r32 = lane & 31, hi = lane >> 5;
    LAS unsigned char* lds = F.lds;
    const bf16_t *QH = wsp<bf16_t>(F.ws, A_QH), *KH = wsp<bf16_t>(F.ws, A_KH), *VT = wsp<bf16_t>(F.ws, A_VT0); bf16_t* YC = wsp<bf16_t>(F.ws, A_YCAT);
    const int skey = tid >> 3, sc = tid & 7;
#define AT_QK(C0, C1, bo_) do { C0 = (f32x16){}; C1 = (f32x16){}; bf16x8 kf_[2][4]; \
        _Pragma("unroll") for (int s = 0; s < 4; ++s) { const int ch = 2 * s + hi; \
            kf_[0][s] = *(const LAS bf16x8*)(lds + (bo_) + r32 * 128 + ((ch ^ (r32 & 7)) * 16)); \
            kf_[1][s] = *(const LAS bf16x8*)(lds + (bo_) + (32 + r32) * 128 + ((ch ^ (r32 & 7)) * 16)); } \
        __builtin_amdgcn_sched_barrier(0); \
        _Pragma("unroll") for (int s = 0; s < 4; ++s) { \
            C0 = __builtin_amdgcn_mfma_f32_32x32x16_bf16(kf_[0][s], qf[s], C0, 0, 0, 0); \
            C1 = __builtin_amdgcn_mfma_f32_32x32x16_bf16(kf_[1][s], qf[s], C1, 0, 0, 0); } } while (0)
#define AT_ITER(t_, CA0, CA1, CB0, CB1) do { const int t = (t_); \
        if (t + 1 < SEQ / 64) AT_QK(CB0, CB1, ((t + 1) & 1) * 8192); \
        __builtin_amdgcn_sched_barrier(0); \
        float mx = CA0[0]; \
        _Pragma("unroll") for (int r = 0; r < 16; ++r) { mx = fmaxf(mx, CA0[r]); mx = fmaxf(mx, CA1[r]); } \
        mx = xmax32(mx); \
          \
        if (__builtin_amdgcn_ballot_w64(mx - mrun > 4.0f) != 0ull) { const float mnew = fmaxf(mrun, mx); const float alpha = __builtin_amdgcn_exp2f(mrun - mnew); mrun = mnew; lrun *= alpha; \
            _Pragma("unroll") for (int r = 0; r < 16; ++r) { o0[r] *= alpha; o1[r] *= alpha; } } \
        { const float nm_ = -mrun; CA0 = CA0 + nm_; CA1 = CA1 + nm_; }            \
        _Pragma("unroll") for (int r = 0; r < 16; ++r) { CA0[r] = __builtin_amdgcn_exp2f(CA0[r]); CA1[r] = __builtin_amdgcn_exp2f(CA1[r]); } \
        { const f32x16 sv = CA0 + CA1; const f32x8_t s8 = sv.lo + sv.hi; const f32x4 s4 = s8.lo + s8.hi; const f32x2 s2 = s4.lo + s4.hi; lrun += s2.x + s2.y; } \
        bf16x8 pf[2][2]; \
        _Pragma("unroll") for (int s2 = 0; s2 < 2; ++s2) { u32x4 w0, w1; \
            w0.x = pk2(CA0[8 * s2 + 0], CA0[8 * s2 + 1]); w0.y = pk2(CA0[8 * s2 + 2], CA0[8 * s2 + 3]); w0.z = pk2(CA0[8 * s2 + 4], CA0[8 * s2 + 5]); w0.w = pk2(CA0[8 * s2 + 6], CA0[8 * s2 + 7]); \
            w1.x = pk2(CA1[8 * s2 + 0], CA1[8 * s2 + 1]); w1.y = pk2(CA1[8 * s2 + 2], CA1[8 * s2 + 3]); w1.z = pk2(CA1[8 * s2 + 4], CA1[8 * s2 + 5]); w1.w = pk2(CA1[8 * s2 + 6], CA1[8 * s2 + 7]); \
            pf[0][s2] = __builtin_bit_cast(bf16x8, w0); pf[1][s2] = __builtin_bit_cast(bf16x8, w1); } \
        const int vb = 16384 + (t & 1) * 8192; \
        _Pragma("unroll") for (int dblk = 0; dblk < 2; ++dblk) { const int d = 32 * dblk + r32; const int sw = (d >> 1) & 7; \
            _Pragma("unroll") for (int blk = 0; blk < 2; ++blk) \
                _Pragma("unroll") for (int s2 = 0; s2 < 2; ++s2) { const int ch = 4 * blk + 2 * s2; \
                    const u32x4 vv = *(const LAS u32x4*)(lds + vb + d * 128 + (((ch + hi) ^ sw) * 16));            \
                    if (dblk == 0) o0 = __builtin_amdgcn_mfma_f32_32x32x16_bf16(__builtin_bit_cast(bf16x8, vv), pf[blk][s2], o0, 0, 0, 0); \
                    else           o1 = __builtin_amdgcn_mfma_f32_32x32x16_bf16(__builtin_bit_cast(bf16x8, vv), pf[blk][s2], o1, 0, 0, 0); } } \
        if (t + 2 < SEQ / 64) *(LAS u32x4*)(lds + (t & 1) * 8192 + kdst) = kst; \
        if (t + 1 < SEQ / 64) { *(LAS u32x2*)(lds + ((t + 1) & 1) * 8192 + vdst) = (u32x2){vst.x, vst.y}; *(LAS u32x2*)(lds + ((t + 1) & 1) * 8192 + vdst2) = (u32x2){vst.z, vst.w}; } \
        if (t + 3 < SEQ / 64) kst = *(const u32x4*)(ksrc + (size_t)(t + 3) * 64 * 128); \
        if (t + 2 < SEQ / 64) vst = *(const u32x4*)(vsrc + (t + 2) * 64); \
        __syncthreads(); } while (0)
    for (int u = u_first; u < 512; u += u_stride) {
        const int b = u >> 6, g = (u >> 5) & 1, qt = u & 31;
        const int head = 4 * g + (wave >> 1); const int qrow = b * SEQ + qt * 64 + 32 * (wave & 1) + r32;
        bf16x8 qf[4];
#pragma unroll
        for (int s = 0; s < 4; ++s) qf[s] = *(const bf16x8*)(QH + (size_t)qrow * 512 + head * 64 + 16 * s + 8 * hi);
        const bf16_t* ksrc = KH + (size_t)(b * SEQ + skey) * 128 + g * 64 + 8 * sc;
        const bf16_t* vsrc = VT + ((size_t)(b * 2 + g) * 64 + skey) * SEQ + 8 * sc;
        const int kdst = skey * 128 + ((sc ^ (skey & 7)) * 16);
        const int vdst = 16384 + skey * 128 + (((sc & ~1) ^ ((skey >> 1) & 7)) * 16) + (sc & 1) * 8, vdst2 = 16384 + skey * 128 + (((sc | 1) ^ ((skey >> 1) & 7)) * 16) + (sc & 1) * 8;
        u32x4 kst = *(const u32x4*)ksrc, vst = *(const u32x4*)vsrc;
        const u32x4 kst1 = *(const u32x4*)(ksrc + (size_t)64 * 128);
        __syncthreads();
        *(LAS u32x4*)(lds + kdst) = kst; *(LAS u32x2*)(lds + vdst) = (u32x2){vst.x, vst.y}; *(LAS u32x2*)(lds + vdst2) = (u32x2){vst.z, vst.w}; *(LAS u32x4*)(lds + 8192 + kdst) = kst1;
        kst = *(const u32x4*)(ksrc + (size_t)2 * 64 * 128); vst = *(const u32x4*)(vsrc + 64);
        __syncthreads();
        f32x16 o0 = {}, o1 = {}; float mrun = -1e30f, lrun = 0.f;
        f32x16 ca0, ca1, cb0, cb1;
        AT_QK(ca0, ca1, 0);
        __syncthreads();
        for (int t2 = 0; t2 < SEQ / 64; t2 += 2) { AT_ITER(t2, ca0, ca1, cb0, cb1); AT_ITER(t2 + 1, cb0, cb1, ca0, ca1); }
        const float ltot = xsum32(lrun); const float inv = 1.f / ltot;
        bf16_t* op = YC + (size_t)qrow * 1024 + 512 + head * 64 + 4 * hi;
#pragma unroll
        for (int q4 = 0; q4 < 4; ++q4) { u32x2 w0, w1;
            w0.x = pk2(o0[4 * q4 + 0] * inv, o0[4 * q4 + 1] * inv); w0.y = pk2(o0[4 * q4 + 2] * inv, o0[4 * q4 + 3] * inv);
            w1.x = pk2(o1[4 * q4 + 0] * inv, o1[4 * q4 + 1] * inv); w1.y = pk2(o1[4 * q4 + 2] * inv, o1[4 * q4 + 3] * inv);
            *(u32x2*)(op + 8 * q4) = w0; *(u32x2*)(op + 32 + 8 * q4) = w1; }
    }
#undef AT_QK
#undef AT_ITER
}

__device__ __forceinline__ void phase_attn(const Frame& F) { phase_attn_range(F, F.vcu, F.G); }
__device__ __forceinline__ void phase_cscan_attn_split(const Frame& F) {
    const int half_g = F.G >> 1, me = F.vcu >> 1;
    if ((F.vcu & 1) == 0) {
        for (int chain = me; chain < 128; chain += half_g) { const int dir = chain & 1, bh = chain >> 1, b = bh >> 3, h = bh & 7;
            for (int q_ = 0; q_ <= (int)((MK_REP_SUB) & 1u); ++q_) { if (dir) cscan_job<1>(F, b, h); else cscan_job<0>(F, b, h); } }
    } else {
        for (int q_ = 0; q_ <= (int)(((MK_REP_SUB) >> 1) & 1u); ++q_)
        for (int u4 = me; u4 * 4 < 512; u4 += half_g) for (int q = 0; q < 4; ++q) phase_attn_range(F, u4 * 4 + q, 1 << 30);
        __syncthreads();
        for (int q_ = 0; q_ <= (int)(((MK_REP_SUB) >> 4) & 1u); ++q_)
        { conv_experts_down(F, me * NWAVES + F.wave, half_g * NWAVES, 0, F.G == 256 ? ED_TAIL : NEXP); conv_experts_gu(F, me * NWAVES + F.wave, half_g * NWAVES, EGU_EARLY, NEXP); }
    }
}
__device__ __forceinline__ void phase_rwkv_post(const Frame& F) {
    const int lane = F.lane, wave = F.wave, fr = lane & 15, fq = lane >> 4;
    const bf16_t *YF = wsp<bf16_t>(F.ws, A_YF), *YB = wsp<bf16_t>(F.ws, A_YB);
    const bf16_t *RS = wsp<bf16_t>(F.ws, A_RS), *VS = wsp<bf16_t>(F.ws, A_VS), *KSP = wsp<bf16_t>(F.ws, A_KS), *SGF = wsp<bf16_t>(F.ws, A_SGF);
    const bf16_t* AP = wsp<bf16_t>(F.ws, A_AP) + 128; const bf16_t* WG = wsp<bf16_t>(F.ws, WS_WLR) + (size_t)2048 * 256 + 128;
    bf16_t* YC = wsp<bf16_t>(F.ws, A_YCAT);
    constexpr int GRS = 1040;
    LAS unsigned char* GL = F.lds;
    const int c0 = 8 * lane;
    float gw_[8], gb_[8], rk_[8], ka_[8];
#pragma unroll
    for (int i = 0; i < 8; ++i) { gw_[i] = F.in[16][c0 + i]; gb_[i] = F.in[17][c0 + i]; rk_[i] = F.in[15][c0 + i]; ka_[i] = F.in[14][c0 + i]; }
    for (int tile = F.vcu; tile < M_TOK / 64; tile += F.G) { const int t0 = tile * 64;
        { f32x4 acc[4][4];
#pragma unroll
          for (int nt = 0; nt < 4; ++nt)
#pragma unroll
              for (int mt = 0; mt < 4; ++mt) acc[nt][mt] = (f32x4){0.f, 0.f, 0.f, 0.f};
#pragma unroll
          for (int ks = 0; ks < 4; ++ks) { bf16x8 a[4], b[4];
#pragma unroll
              for (int nt = 0; nt < 4; ++nt) a[nt] = *(const bf16x8*)(WG + (size_t)(64 * wave + 16 * nt + fr) * 256 + 32 * ks + 8 * fq);
#pragma unroll
              for (int mt = 0; mt < 4; ++mt) b[mt] = *(const bf16x8*)(AP + (size_t)(t0 + 16 * mt + fr) * 256 + 32 * ks + 8 * fq);
#pragma unroll
              for (int nt = 0; nt < 4; ++nt)
#pragma unroll
                  for (int mt = 0; mt < 4; ++mt) acc[nt][mt] = __builtin_amdgcn_mfma_f32_16x16x32_bf16(a[nt], b[mt], acc[nt][mt], 0, 0, 0); }
#pragma unroll
          for (int nt = 0; nt < 4; ++nt)
#pragma unroll
              for (int mt = 0; mt < 4; ++mt) { u32x2 w; w.x = pk2(acc[nt][mt][0], acc[nt][mt][1]); w.y = pk2(acc[nt][mt][2], acc[nt][mt][3]);
                  *(LAS u32x2*)(GL + (16 * mt + fr) * GRS + (64 * wave + 16 * nt + 4 * fq) * 2) = w; } }
        __syncthreads();
        for (int j = 0; j < 8; ++j) { const int tl = 8 * wave + j; const size_t o = (size_t)(t0 + tl) * 512 + c0;
            const u32x4 yfw = *(const u32x4*)(YF + o), ybw = *(const u32x4*)(YB + o);
            float y[8]; float sm = 0.f;
            y[0] = bflo(yfw.x) + bflo(ybw.x); y[1] = bfhi(yfw.x) + bfhi(ybw.x); y[2] = bflo(yfw.y) + bflo(ybw.y); y[3] = bfhi(yfw.y) + bfhi(ybw.y);
            y[4] = bflo(yfw.z) + bflo(ybw.z); y[5] = bfhi(yfw.z) + bfhi(ybw.z); y[6] = bflo(yfw.w) + bflo(ybw.w); y[7] = bfhi(yfw.w) + bfhi(ybw.w);
#pragma unroll
            for (int i = 0; i < 8; ++i) sm += y[i];
            sm += __shfl_xor(sm, 1); sm += __shfl_xor(sm, 2); sm += __shfl_xor(sm, 4);
            const float mean = sm * (1.f / 64.f); float sv = 0.f;
#pragma unroll
            for (int i = 0; i < 8; ++i) { y[i] -= mean; sv += y[i] * y[i]; }
            sv += __shfl_xor(sv, 1); sv += __shfl_xor(sv, 2); sv += __shfl_xor(sv, 4);
            const float rstd = __builtin_amdgcn_rsqf(sv * (1.f / 64.f) + 64e-5f);
            const u32x4 rw = *(const u32x4*)(RS + o), vw = *(const u32x4*)(VS + o), kw = *(const u32x4*)(KSP + o), sw = *(const u32x4*)(SGF + o), gw4 = *(const LAS u32x4*)(GL + tl * GRS + c0 * 2);
            float r8[8], v8[8], k8[8], g8[8], s8[8]; unpack8(rw, r8); unpack8(vw, v8); unpack8(kw, k8); unpack8(gw4, g8); unpack8(sw, s8);
#pragma unroll
            for (int i = 0; i < 8; ++i) k8[i] = bf2f(f2bf(k8[i] * (1.f + (s8[i] - 1.f) * ka_[i])));
            float bs = 0.f;
#pragma unroll
            for (int i = 0; i < 8; ++i) bs += r8[i] * k8[i] * rk_[i];
            bs += __shfl_xor(bs, 1); bs += __shfl_xor(bs, 2); bs += __shfl_xor(bs, 4);
            float ov[8];
#pragma unroll
            for (int i = 0; i < 8; ++i) ov[i] = ((y[i] * rstd) * gw_[i] + gb_[i] + bs * v8[i]) * g8[i];
            *(u32x4*)(YC + (size_t)(t0 + tl) * 1024 + c0) = pack8f(ov); }
        __syncthreads(); }
}

__device__ __forceinline__ void phase_gd(const Frame& F) {
    const int tid = F.tid, lane = F.lane, wave = F.wave, fr = lane & 15, fq = lane >> 4;
    LAS f32x4* PL = (LAS f32x4*)F.lds;
    const bf16_t* XB = wsp<bf16_t>(F.ws, WS_XB); const bf16_t* WG = wsp<bf16_t>(F.ws, WS_WIN1) + (size_t)3072 * 1024; const float* ssq = wsp<float>(F.ws, WS_SSQ2); bf16_t* P1 = wsp<bf16_t>(F.ws, A_P1);
    const int tpb = M_TOK / F.G;
    for (int t0 = F.vcu * tpb; t0 < (F.vcu + 1) * tpb; t0 += 64) {
        f32x4 acc[4];
#pragma unroll
        for (int t = 0; t < 4; ++t) acc[t] = (f32x4){0.f, 0.f, 0.f, 0.f};
#pragma unroll
        for (int s4 = 0; s4 < 4; ++s4) { const int k0 = 32 * (4 * wave + s4) + 8 * fq;
            const bf16x8 bfr = *(const bf16x8*)(WG + (size_t)fr * 1024 + k0);
#pragma unroll
            for (int t = 0; t < 4; ++t) { const bf16x8 afr = *(const bf16x8*)(XB + (size_t)(t0 + 16 * t + fr) * 1024 + k0);
                acc[t] = __builtin_amdgcn_mfma_f32_16x16x32_bf16(afr, bfr, acc[t], 0, 0, 0); } }
        __syncthreads();
#pragma unroll
        for (int t = 0; t < 4; ++t) PL[(wave * 4 + t) * 64 + lane] = acc[t];
        __syncthreads();
        if (tid < 256) { const int t = tid >> 6, l = tid & 63; f32x4 sum = PL[t * 64 + l];
#pragma unroll
            for (int w = 1; w < 8; ++w) sum += PL[(w * 4 + t) * 64 + l];
            const int lfr = l & 15, lfq = l >> 4;
#pragma unroll
            for (int r = 0; r < 4; ++r) { const int tok = t0 + 16 * t + 4 * lfq + r; P1[(size_t)tok * O_INP + 3072 + lfr] = f2bf(sum[r] * rstd_from_ssq(ssq, tok)); } }
    }
}

constexpr float GLA_QSCALE = 0.08838834764831845f;
__device__ __forceinline__ size_t gla_dir(size_t base, int dir) { return base + (size_t)dir * GLA_DIR_STRIDE; }
__device__ __forceinline__ float logsig16(float z) { return (fminf(z, 0.f) - __logf(1.f + __expf(-fabsf(z)))) * (1.f / 16.f); }
__device__ __forceinline__ void phase_gla_prep(const Frame& F) {
    const int tid = F.tid, lane = F.lane, wave = F.wave, fr = lane & 15, fq = lane >> 4;
    LAS float* GD = (LAS float*)F.lds;
    LAS float* PT = (LAS float*)(F.lds + 4096);
    LAS unsigned char* QTt = F.lds + 10240;
    LAS unsigned char* KTt = F.lds + 10240 + 17408;
    LAS unsigned char* RV = F.lds + 10240;
    LAS unsigned char* RQ = F.lds + 45056; LAS unsigned char* RK = F.lds + 45056 + 16384;
    LAS unsigned char* ATT = F.lds + 45056;
    LAS unsigned char* QHl = F.lds + 45056 + 9216;
    LAS unsigned char* VTt = F.lds + 77824;
    const bf16_t* P1 = wsp<bf16_t>(F.ws, A_P1);
    bf16_t* VT = wsp<bf16_t>(F.ws, A_VT1); float* DECS = wsp<float>(F.ws, WS_DECS); bf16_t* OF = wsp<bf16_t>(F.ws, A_OF);
    const int d = tid & 127, qr = tid >> 7;
    u32x4 pq[2], pk_[2], pv[4]; bf16_t pg[2];
#define GP_FETCH(u_) do { const int n_ = (u_) & 31, h_ = ((u_) >> 5) & 3, b_ = (u_) >> 7; const int T_ = b_ * SEQ + 64 * n_; \
        _Pragma("unroll") for (int i = 0; i < 2; ++i) { const int p = tid + 512 * i; pg[i] = P1[(size_t)(T_ + (p >> 4)) * O_INP + 3072 + (p & 15)]; \
            const int row = p >> 4, c = p & 15; const bf16_t* src = P1 + (size_t)(T_ + row) * O_INP + h_ * 128 + 8 * c; pq[i] = *(const u32x4*)src; pk_[i] = *(const u32x4*)(src + 512); } \
        _Pragma("unroll") for (int i = 0; i < 4; ++i) { const int p = tid + 512 * i, row = p >> 5, c = p & 31; pv[i] = *(const u32x4*)(P1 + (size_t)(T_ + row) * O_INP + 1024 + h_ * 256 + 8 * c); } } while (0)
    float upf[16], upb[16]; float bif = 0.f, bib = 0.f; int h_cur = -1;
    if (F.vcu < BATCH * GLA_H * 32) GP_FETCH(F.vcu);
    for (int unit = F.vcu; unit < BATCH * GLA_H * 32; unit += F.G) {
        const int n = unit & 31, h = (unit >> 5) & 3, b = unit >> 7; const int T0 = b * SEQ + 64 * n; const size_t tile = (size_t)(b * 4 + h) * 32 + n;
        __syncthreads();
#pragma unroll
        for (int i = 0; i < 2; ++i) { const int p = tid + 512 * i, row = p >> 4, c = p & 15; GD[p] = bf2f(pg[i]);
            *(LAS u32x4*)(RQ + row * 256 + c * 16) = pq[i]; *(LAS u32x4*)(RK + row * 256 + c * 16) = pk_[i]; }
#pragma unroll
        for (int i = 0; i < 4; ++i) { const int p = tid + 512 * i, row = p >> 5, c = p & 31; *(LAS u32x4*)(RV + row * 512 + c * 16) = pv[i]; }
        if (h != h_cur) { h_cur = h;
#pragma unroll
            for (int r = 0; r < 16; ++r) { upf[r] = F.in[27][r * 512 + h * 128 + d]; upb[r] = F.in[29][r * 512 + h * 128 + d]; }
            bif = F.in[28][h * 128 + d]; bib = F.in[30][h * 128 + d]; }
        if (unit + F.G < BATCH * GLA_H * 32) GP_FETCH(unit + F.G);
        __syncthreads();
        bf16_t qraw[16], kraw[16];
#pragma unroll
        for (int j = 0; j < 16; ++j) { qraw[j] = *(const LAS bf16_t*)(RQ + (16 * qr + j) * 256 + d * 2); kraw[j] = *(const LAS bf16_t*)(RK + (16 * qr + j) * 256 + d * 2); }
        { const int dv = tid & 255, th = tid >> 8; unsigned pk[16];
#pragma unroll
          for (int j = 0; j < 16; ++j) pk[j] = (unsigned)*(const LAS bf16_t*)(RV + (32 * th + 2 * j) * 512 + dv * 2) | ((unsigned)*(const LAS bf16_t*)(RV + (32 * th + 2 * j + 1) * 512 + dv * 2) << 16);
          bf16_t* gdst = VT + tile * 16384 + dv * 64 + 32 * th;
#pragma unroll
          for (int q = 0; q < 4; ++q) { const u32x4 w = {pk[4 * q], pk[4 * q + 1], pk[4 * q + 2], pk[4 * q + 3]}; *(u32x4*)(gdst + 8 * q) = w; *(LAS u32x4*)(VTt + dv * 144 + (32 * th + 8 * q) * 2) = w; } }
        float Bf[16], Bb[16];
#pragma unroll
        for (int j = 0; j < 16; ++j) { const LAS f32x4* gp = (const LAS f32x4*)(GD + (16 * qr + j) * 16); float zf = bif, zb = bib;
#pragma unroll
            for (int q = 0; q < 4; ++q) { const f32x4 g4 = gp[q];
#pragma unroll
                for (int e = 0; e < 4; ++e) { zf += g4[e] * upf[4 * q + e]; zb += g4[e] * upb[4 * q + e]; } }
            Bf[j] = logsig16(zf); Bb[j] = logsig16(zb); }
#pragma unroll
        for (int j = 1; j < 16; ++j) Bf[j] += Bf[j - 1];
#pragma unroll
        for (int j = 14; j >= 0; --j) Bb[j] += Bb[j + 1];
        PT[(0 * 4 + qr) * 128 + d] = Bf[15]; PT[(1 * 4 + qr) * 128 + d] = Bb[0];
        if (qr == 2) PT[1024 + d] = Bf[0];
        if (qr == 1) PT[1024 + 128 + d] = Bb[15];
        __syncthreads();
        float offf = 0.f, offb = 0.f, totf = 0.f, totb = 0.f, pre2f = 0.f, suf2b = 0.f;
#pragma unroll
        for (int q = 0; q < 4; ++q) { const float pf = PT[q * 128 + d], pb = PT[(4 + q) * 128 + d]; totf += pf; totb += pb; if (q < qr) offf += pf; if (q > qr) offb += pb; if (q < 2) pre2f += pf; if (q >= 2) suf2b += pb; }
        const float bmf = pre2f + PT[1024 + d], bmb = suf2b + PT[1024 + 128 + d];
#pragma unroll
        for (int j = 0; j < 16; ++j) { Bf[j] += offf; Bb[j] += offb; }
        f32x4 oacc[2][4];
#pragma unroll
        for (int x = 0; x < 2; ++x)
#pragma unroll
            for (int y = 0; y < 4; ++y) oacc[x][y] = (f32x4){0.f, 0.f, 0.f, 0.f};
#pragma unroll
        for (int dir = 0; dir < 2; ++dir) {
            const float bm = dir ? bmb : bmf, bl = dir ? totb : totf; const float ebm = __expf(bm), ebl = __expf(bl - bm);
            bf16_t* QHT = wsp<bf16_t>(F.ws, gla_dir(A_QHAT, dir)) + tile * 8192; bf16_t* K2T = wsp<bf16_t>(F.ws, gla_dir(A_K2T, dir)) + tile * 8192;
            unsigned k2pk[8];
#pragma unroll
            for (int j = 0; j < 16; ++j) { const float bv = dir ? Bb[j] : Bf[j]; const float e1 = __expf(bv - bm), r1 = __builtin_amdgcn_rcpf(e1);
                const float qs = bf2f(qraw[j]) * GLA_QSCALE, kk = bf2f(kraw[j]); const int tk = 16 * qr + j;
                const float qt = qs * e1, kt = kk * r1, qh = qt * ebm, k2 = kt * ebl;
                *(LAS bf16_t*)(QTt + tk * 272 + d * 2) = f2bf(qt); *(LAS bf16_t*)(KTt + tk * 272 + d * 2) = f2bf(kt); *(LAS bf16_t*)(QHl + tk * 272 + d * 2) = f2bf(qh);
                if (j & 1) k2pk[j >> 1] |= ((unsigned)f2bf(k2)) << 16; else k2pk[j >> 1] = (unsigned)f2bf(k2); }
            { bf16_t* kd = K2T + d * 64 + 16 * qr;
              *(u32x4*)kd = (u32x4){k2pk[0], k2pk[1], k2pk[2], k2pk[3]}; *(u32x4*)(kd + 8) = (u32x4){k2pk[4], k2pk[5], k2pk[6], k2pk[7]}; }
            if (qr == 0) DECS[((size_t)((b * 4 + h) * 2 + dir) * 32 + n) * 128 + d] = __expf(bl);
            __syncthreads();
#pragma unroll
            for (int i = 0; i < 2; ++i) { const int p = tid + 512 * i, row = p >> 4, c = p & 15; *(u32x4*)(QHT + row * 128 + c * 8) = *(const LAS u32x4*)(QHl + row * 272 + c * 16); }
            { const int ib = wave >> 1, jb0 = 2 * (wave & 1); f32x4 at[2] = {(f32x4){0.f, 0.f, 0.f, 0.f}, (f32x4){0.f, 0.f, 0.f, 0.f}};
#pragma unroll
              for (int s2 = 0; s2 < 4; ++s2) { const bf16x8 a = *(const LAS bf16x8*)(QTt + (16 * ib + fr) * 272 + (32 * s2 + 8 * fq) * 2);
#pragma unroll
                  for (int jj = 0; jj < 2; ++jj) { const bf16x8 bb = *(const LAS bf16x8*)(KTt + (16 * (jb0 + jj) + fr) * 272 + (32 * s2 + 8 * fq) * 2);
                      at[jj] = __builtin_amdgcn_mfma_f32_16x16x32_bf16(a, bb, at[jj], 0, 0, 0); } }
#pragma unroll
              for (int jj = 0; jj < 2; ++jj)
#pragma unroll
                  for (int r = 0; r < 4; ++r) { const int i = 16 * ib + 4 * fq + r, j = 16 * (jb0 + jj) + fr; const bool keep = dir ? (j > i) : (j <= i);
                      *(LAS bf16_t*)(ATT + i * 144 + j * 2) = f2bf(keep ? at[jj][r] : 0.f); } }
            __syncthreads();
#pragma unroll
            for (int s2 = 0; s2 < 2; ++s2) { bf16x8 bfr[4];
#pragma unroll
                for (int ib = 0; ib < 4; ++ib) bfr[ib] = *(const LAS bf16x8*)(ATT + (16 * ib + fr) * 144 + (32 * s2 + 8 * fq) * 2);
#pragma unroll
                for (int x = 0; x < 2; ++x) { const bf16x8 a = *(const LAS bf16x8*)(VTt + (16 * (2 * wave + x) + fr) * 144 + (32 * s2 + 8 * fq) * 2);
#pragma unroll
                    for (int ib = 0; ib < 4; ++ib) oacc[x][ib] = __builtin_amdgcn_mfma_f32_16x16x32_bf16(a, bfr[ib], oacc[x][ib], 0, 0, 0); } }
        }
#pragma unroll
        for (int x = 0; x < 2; ++x)
#pragma unroll
            for (int ib = 0; ib < 4; ++ib) { u32x2 w; w.x = pk2(oacc[x][ib][0], oacc[x][ib][1]); w.y = pk2(oacc[x][ib][2], oacc[x][ib][3]);
                *(u32x2*)(OF + (size_t)(T0 + 16 * ib + fr) * 1024 + h * 256 + 16 * (2 * wave + x) + 4 * fq) = w; }
    }
}
#undef GP_FETCH

template <int DIR> __device__ __forceinline__ void gla_seq_job(const Frame& F, int b, int h, int vs) {
    const int tid = F.tid, lane = F.lane, wave = F.wave, fr = lane & 15, fq = lane >> 4;
    LAS unsigned char* ST0 = F.lds; LAS unsigned char* ST1 = F.lds + 17408;
    LAS unsigned char* BUF = F.lds + 34816;
    constexpr int BQ = 0, BK2 = 17408, BVT = 17408 + 18432, BSZ = 45056;
    const bf16_t* QHT = wsp<bf16_t>(F.ws, gla_dir(A_QHAT, DIR)); const bf16_t* K2T = wsp<bf16_t>(F.ws, gla_dir(A_K2T, DIR));
    const bf16_t* VT = wsp<bf16_t>(F.ws, A_VT1); const float* DECS = wsp<float>(F.ws, WS_DECS); bf16_t* OF = wsp<bf16_t>(F.ws, A_OF); bf16_t* O = DIR ? wsp<bf16_t>(F.ws, A_OB) : OF;
    const int dvb = wave >> 1, ib0 = 2 * (wave & 1);
    const size_t tile0 = (size_t)(b * 4 + h) * 32;
    const int q0 = tid, q1 = tid + 512;
    const int dq0 = BQ + (q0 >> 4) * 272 + (q0 & 15) * 16, dq1 = BQ + (q1 >> 4) * 272 + (q1 & 15) * 16;
    const int dk0 = BK2 + (q0 >> 3) * 144 + (q0 & 7) * 16, dk1 = BK2 + (q1 >> 3) * 144 + (q1 & 7) * 16;
    const int dv0 = BVT + (q0 >> 3) * 144 + (q0 & 7) * 16;
    u32x4 sg[5]; f32x4 dec, decn; u32x2 oold[2], ooldn[2];
#define GL_LD(n_) do { const size_t t_ = tile0 + (n_); \
        sg[0] = *(const u32x4*)(QHT + t_ * 8192 + q0 * 8); sg[1] = *(const u32x4*)(QHT + t_ * 8192 + q1 * 8); \
        sg[2] = *(const u32x4*)(K2T + t_ * 8192 + q0 * 8); sg[3] = *(const u32x4*)(K2T + t_ * 8192 + q1 * 8); \
        sg[4] = *(const u32x4*)(VT + t_ * 16384 + vs * 4096 + q0 * 8); \
        decn = *(const f32x4*)(DECS + ((size_t)((b * 4 + h) * 2 + DIR) * 32 + (n_)) * 128 + 16 * wave + 4 * fq); \
        if (!DIR) { _Pragma("unroll") for (int ii = 0; ii < 2; ++ii) ooldn[ii] = *(const u32x2*)(OF + (size_t)(b * SEQ + 64 * (n_) + 16 * (ib0 + ii) + fr) * 1024 + h * 256 + 64 * vs + 16 * dvb + 4 * fq); } } while (0)
#define GL_ST(bp) do { *(LAS u32x4*)((bp) + dq0) = sg[0]; *(LAS u32x4*)((bp) + dq1) = sg[1]; *(LAS u32x4*)((bp) + dk0) = sg[2]; *(LAS u32x4*)((bp) + dk1) = sg[3]; *(LAS u32x4*)((bp) + dv0) = sg[4]; } while (0)
    __syncthreads();
    for (int i = tid; i < 17408 / 4; i += 512) ((LAS unsigned*)ST0)[i] = 0u;
    f32x4 st[4];
#pragma unroll
    for (int k = 0; k < 4; ++k) st[k] = (f32x4){0.f, 0.f, 0.f, 0.f};
    GL_LD(DIR ? 31 : 0); GL_ST(BUF); dec = decn; oold[0] = ooldn[0]; oold[1] = ooldn[1];
    __syncthreads();
    for (int cc = 0; cc < 32; ++cc) { const int n = DIR ? 31 - cc : cc, nn = DIR ? 30 - cc : cc + 1; const int T0 = b * SEQ + 64 * n;
        LAS unsigned char* STr = (cc & 1) ? ST1 : ST0; LAS unsigned char* STw = (cc & 1) ? ST0 : ST1;
        LAS unsigned char* bc = BUF + (cc & 1) * BSZ; LAS unsigned char* bn = BUF + ((cc + 1) & 1) * BSZ;
        if (cc + 1 < 32) GL_LD(nn);
#pragma unroll
        for (int x = 0; x < 4; ++x) st[x] = st[x] * dec;
        f32x4 oo[2] = {(f32x4){0.f, 0.f, 0.f, 0.f}, (f32x4){0.f, 0.f, 0.f, 0.f}};
#pragma unroll
        for (int s2 = 0; s2 < 4; ++s2) { const bf16x8 a = *(const LAS bf16x8*)(STr + (16 * dvb + fr) * 272 + (32 * s2 + 8 * fq) * 2);
#pragma unroll
            for (int ii = 0; ii < 2; ++ii) { const bf16x8 qf = *(const LAS bf16x8*)(bc + BQ + (16 * (ib0 + ii) + fr) * 272 + (32 * s2 + 8 * fq) * 2);
                oo[ii] = __builtin_amdgcn_mfma_f32_16x16x32_bf16(a, qf, oo[ii], 0, 0, 0); } }
#pragma unroll
        for (int s2 = 0; s2 < 2; ++s2) { const bf16x8 kf = *(const LAS bf16x8*)(bc + BK2 + (16 * wave + fr) * 144 + (32 * s2 + 8 * fq) * 2);
#pragma unroll
            for (int x = 0; x < 4; ++x) { const bf16x8 vf = *(const LAS bf16x8*)(bc + BVT + (16 * x + fr) * 144 + (32 * s2 + 8 * fq) * 2);
                st[x] = __builtin_amdgcn_mfma_f32_16x16x32_bf16(kf, vf, st[x], 0, 0, 0); } }
#pragma unroll
        for (int x = 0; x < 4; ++x) { u32x2 w; w.x = pk2(st[x][0], st[x][1]); w.y = pk2(st[x][2], st[x][3]); *(LAS u32x2*)(STw + (16 * x + fr) * 272 + (16 * wave + 4 * fq) * 2) = w; }
#pragma unroll
        for (int ii = 0; ii < 2; ++ii) { f32x4 v = oo[ii];
            if (!DIR) { v[0] += bflo(oold[ii].x); v[1] += bfhi(oold[ii].x); v[2] += bflo(oold[ii].y); v[3] += bfhi(oold[ii].y); }
            u32x2 w; w.x = pk2(v[0], v[1]); w.y = pk2(v[2], v[3]);
            *(u32x2*)(O + (size_t)(T0 + 16 * (ib0 + ii) + fr) * 1024 + h * 256 + 64 * vs + 16 * dvb + 4 * fq) = w; }
        if (cc + 1 < 32) { GL_ST(bn); dec = decn; oold[0] = ooldn[0]; oold[1] = ooldn[1]; }
        __syncthreads(); }
#undef GL_LD
#undef GL_ST
}
__device__ __forceinline__ void phase_gla_main(const Frame& F) {
    for (int job = F.vcu; job < 256; job += F.G) { const int vs = job & 3, dir = (job >> 2) & 1, h = (job >> 3) & 3, b = job >> 5;
        if (dir) gla_seq_job<1>(F, b, h, vs); else gla_seq_job<0>(F, b, h, vs); }
}

__device__ __forceinline__ void phase_gla_post(const Frame& F) {
    const int gw = F.vcu * NWAVES + F.wave, lane = F.lane; const int c0 = 16 * lane;
    const bf16_t *OF = wsp<bf16_t>(F.ws, A_OF), *OB = wsp<bf16_t>(F.ws, A_OB), *P1 = wsp<bf16_t>(F.ws, A_P1); bf16_t* GO = wsp<bf16_t>(F.ws, A_GOUT);
    float gn[16];
#pragma unroll
    for (int i = 0; i < 16; ++i) gn[i] = F.in[31][(c0 + i) & 255];
    for (int tok = gw; tok < M_TOK; tok += F.G * NWAVES) { const size_t o = (size_t)tok * 1024 + c0;
        float v[16]; float ss = 0.f;
#pragma unroll
        for (int hh = 0; hh < 2; ++hh) { const u32x4 a = *(const u32x4*)(OF + o + 8 * hh), bq = *(const u32x4*)(OB + o + 8 * hh);
            v[8 * hh + 0] = bflo(a.x) + bflo(bq.x); v[8 * hh + 1] = bfhi(a.x) + bfhi(bq.x); v[8 * hh + 2] = bflo(a.y) + bflo(bq.y); v[8 * hh + 3] = bfhi(a.y) + bfhi(bq.y);
            v[8 * hh + 4] = bflo(a.z) + bflo(bq.z); v[8 * hh + 5] = bfhi(a.z) + bfhi(bq.z); v[8 * hh + 6] = bflo(a.w) + bflo(bq.w); v[8 * hh + 7] = bfhi(a.w) + bfhi(bq.w); }
#pragma unroll
        for (int i = 0; i < 16; ++i) ss += v[i] * v[i];
        ss = dpp_row_sum(ss);
        const float rs = __builtin_amdgcn_rsqf(ss * (1.f / 256.f) + NORM_EPS);
        float og[16];
#pragma unroll
        for (int hh = 0; hh < 2; ++hh) { const u32x4 g = *(const u32x4*)(P1 + (size_t)tok * O_INP + 2048 + c0 + 8 * hh);
            og[8 * hh + 0] = bflo(g.x); og[8 * hh + 1] = bfhi(g.x); og[8 * hh + 2] = bflo(g.y); og[8 * hh + 3] = bfhi(g.y); og[8 * hh + 4] = bflo(g.z); og[8 * hh + 5] = bfhi(g.z); og[8 * hh + 6] = bflo(g.w); og[8 * hh + 7] = bfhi(g.w); }
        float r[16];
#pragma unroll
        for (int i = 0; i < 16; ++i) r[i] = v[i] * rs * gn[i] * siluf_(og[i]);
#pragma unroll
        for (int hh = 0; hh < 2; ++hh) { u32x4 w; w.x = pk2(r[8 * hh + 0], r[8 * hh + 1]); w.y = pk2(r[8 * hh + 2], r[8 * hh + 3]); w.z = pk2(r[8 * hh + 4], r[8 * hh + 5]); w.w = pk2(r[8 * hh + 6], r[8 * hh + 7]);
            *(u32x4*)(GO + o + 8 * hh) = w; } }
}

template <bool SPLIT> __device__ __forceinline__ void phase_route(const Frame& F) {
    const int tid = F.tid, lane = F.lane, wave = F.wave;
    LAS int* lcnt = (LAS int*)(F.lds + MOE_OFF);
    LAS float* RL = (LAS float*)F.lds;
    __syncthreads();
    if (tid < 16) lcnt[tid] = 0;
    const bf16_t* X = wsp<bf16_t>(F.ws, WS_XB); const float* g2 = F.in[33]; const float* RT = F.in[34];
    for (int i = tid; i < 2048; i += 512) { const int k = i >> 1; const f32x4 r = *(const f32x4*)(RT + (size_t)i * 4); *(LAS f32x4*)(RL + i * 4) = r * g2[k]; }
    __syncthreads();
    int* TE = wsp<int>(F.ws, WS_TOKE); float* TG = wsp<float>(F.ws, WS_TOKG); float* R3 = wsp<float>(F.ws, WS_RSTD3);
    const int tpb = M_TOK / F.G, tpw = SPLIT ? tpb / 2 : tpb / NWAVES;
    if (SPLIT && wave >= 2) conv_experts_gu(F, F.vcu * (NWAVES - 2) + (wave - 2), F.G * (NWAVES - 2), 0, EGU_EARLY);
    else
    for (int i0 = 0; i0 < tpw; i0 += 4) { const int tok0 = F.vcu * tpb + wave * tpw + i0;
        float acc[4][8], ss[4];
#pragma unroll
        for (int t = 0; t < 4; ++t) { ss[t] = 0.f;
#pragma unroll
            for (int e = 0; e < 8; ++e) acc[t][e] = 0.f; }
#pragma unroll
        for (int j = 0; j < 4; ++j) { const int k0 = 4 * lane + 256 * j; f32x4 xv[4];
#pragma unroll
            for (int t = 0; t < 4; ++t) { const u32x2 w = *(const u32x2*)(X + (size_t)(tok0 + t) * 1024 + k0); xv[t] = (f32x4){bflo(w.x), bfhi(w.x), bflo(w.y), bfhi(w.y)}; }
#pragma unroll
            for (int q = 0; q < 4; ++q) { const f32x4 r0 = *(const LAS f32x4*)(RL + (k0 + q) * 8), r1 = *(const LAS f32x4*)(RL + (k0 + q) * 8 + 4);
#pragma unroll
                for (int t = 0; t < 4; ++t) { const float xx = xv[t][q]; ss[t] += xx * xx;
                    acc[t][0] += xx * r0[0]; acc[t][1] += xx * r0[1]; acc[t][2] += xx * r0[2]; acc[t][3] += xx * r0[3]; acc[t][4] += xx * r1[0]; acc[t][5] += xx * r1[1]; acc[t][6] += xx * r1[2]; acc[t][7] += xx * r1[3]; } } }
#pragma unroll
        for (int t = 0; t < 4; ++t) { ss[t] = wave_sum(ss[t]);
#pragma unroll
            for (int e = 0; e < 8; ++e) acc[t][e] = wave_sum(acc[t][e]); }
        float lg[8]; float mss = 0.f;
#pragma unroll
        for (int t = 0; t < 4; ++t) { if (lane == t) { mss = ss[t];
#pragma unroll
                for (int e = 0; e < 8; ++e) lg[e] = acc[t][e]; } }
        if (lane < 4) { const int tok = tok0 + lane;
            const float rstd = 1.0f / sqrtf(mss * (1.f / 1024.f) + NORM_EPS);
            int i1 = 0; float l1 = lg[0] * rstd;
#pragma unroll
            for (int e = 1; e < 8; ++e) { const float l = lg[e] * rstd; if (l > l1) { l1 = l; i1 = e; } }
            int i2 = -1; float l2 = -3.0e38f;
#pragma unroll
            for (int e = 0; e < 8; ++e) { const float l = lg[e] * rstd; if (e != i1 && l > l2) { l2 = l; i2 = e; } }
            const float e2 = __expf(l2 - l1); const float ga = 1.f / (1.f + e2), gb = e2 / (1.f + e2);
            TE[tok * 2] = i1; TE[tok * 2 + 1] = i2; TG[tok * 2] = ga; TG[tok * 2 + 1] = gb; R3[tok] = rstd;
            atomicAdd((int*)&lcnt[i1], 1); atomicAdd((int*)&lcnt[8 + i2], 1); } }
    __syncthreads();
    if (tid < 16) wsp<int>(F.ws, WS_CNT)[F.vcu * 16 + tid] = lcnt[tid];
}
__device__ __forceinline__ void phase_place(const Frame& F) {
    const int tid = F.tid;
    LAS int* tab = (LAS int*)(F.lds + MOE_OFF);
    LAS int* C = (LAS int*)F.lds;
    LAS int* TEl = (LAS int*)(F.lds + 32768); LAS float* TGl = (LAS float*)(F.lds + 32768 + 1024);
    const int* CNT = wsp<int>(F.ws, WS_CNT); const int tpb = M_TOK / F.G;
    __syncthreads();
    for (int i = tid; i < F.G * 16; i += 512) C[i] = CNT[i];
    if (tid < 2 * tpb) { TEl[tid] = wsp<int>(F.ws, WS_TOKE)[F.vcu * tpb * 2 + tid]; const float r3 = wsp<float>(F.ws, WS_RSTD3)[F.vcu * tpb + (tid >> 1)];
        TGl[tid] = wsp<float>(F.ws, WS_TOKG)[F.vcu * tpb * 2 + tid] * (r3 * r3); TGl[2 * tpb + tid] = r3 * -1.4426950408889634f; }
    __syncthreads();
    if (tid < 16) { int off = 0, tot = 0; for (int bb = 0; bb < F.G; ++bb) { const int c = C[bb * 16 + tid]; if (bb < F.vcu) off += c; tot += c; } tab[tid] = off; tab[16 + tid] = tot;
        if (F.vcu == 0) wsp<int>(F.ws, WS_TOT)[tid] = tot; }
    __syncthreads();
    if (tid < 16) { const int s = tid >> 3, e = tid & 7; int run = tab[tid]; for (int q = 0; q < e; ++q) run += tab[16 + q] + tab[24 + q];
        if (s) run += tab[16 + e];
        int* RTK = wsp<int>(F.ws, WS_ROWTOK); float* RGT = wsp<float>(F.ws, WS_ROWGATE); float* RC1 = wsp<float>(F.ws, WS_ROWC1);
        for (int i = 0; i < tpb; ++i) { if (TEl[i * 2 + s] == e) { RTK[run] = F.vcu * tpb + i; RGT[run] = TGl[i * 2 + s]; RC1[run] = TGl[2 * tpb + i * 2 + s]; ++run; } } }
}
struct MoESched {
    pg8::GridOrder go; const LAS int* tab;
    const char* A; const char* Bt; size_t a_rowbytes, b_expert_bytes, b_tile_bytes; bool gather; int nt_;
    __device__ bool next(int i, pg8::Unit& u) const {
        int pm, pn; if (!go.tile(i, pm, pn)) return false;
        int e = 0;
#pragma unroll
        for (int q = 1; q < 8; ++q) if (pm >= tab[16 + q]) e = q;
        e = __builtin_amdgcn_readfirstlane(e);
        const int mt = pm - __builtin_amdgcn_readfirstlane(tab[16 + e]); const int row0 = __builtin_amdgcn_readfirstlane(tab[e]) + 256 * mt; int nr = __builtin_amdgcn_readfirstlane(tab[8 + e]) - 256 * mt; nr = nr > 256 ? 256 : nr;
        u.pm = pm; u.pn = pn; u.e = e; u.row0 = row0; u.nrows = nr; u.nt = nt_; u.flags = 0; u.rot = 0;
        u.a = gather ? A : A + (size_t)row0 * a_rowbytes; u.b = Bt + (size_t)e * b_expert_bytes + (size_t)pn * b_tile_bytes + (e >= EGU_EARLY ? WEGU_HI_SHIFT : (size_t)0); return true;
    }
};
struct MoEDownSched {
    const LAS int* tab; const char* A; const char* Bt; int nmt, c, round;
    __device__ void fill(pg8::Unit& u, int pm, int pn, int kp, int nt, int flags) const {
        int e = 0;
#pragma unroll
        for (int q = 1; q < 8; ++q) if (pm >= tab[16 + q]) e = q;
        e = __builtin_amdgcn_readfirstlane(e);
        const int mt = pm - __builtin_amdgcn_readfirstlane(tab[16 + e]); const int row0 = __builtin_amdgcn_readfirstlane(tab[e]) + 256 * mt; int nr = __builtin_amdgcn_readfirstlane(tab[8 + e]) - 256 * mt; nr = nr > 256 ? 256 : nr;
        u.pm = pm; u.pn = pn; u.e = e; u.row0 = row0; u.nrows = nr; u.nt = nt; u.flags = flags; u.rot = 0;
        u.a = A + (size_t)row0 * (D_FFE * 2) + (size_t)kp * 512 * 2; u.b = Bt + (size_t)e * ((size_t)1024 * D_FFE * 2) + (size_t)pn * ((size_t)256 * D_FFE * 2) + (size_t)kp * 512 * 2;
    }
    __device__ bool next(int i, pg8::Unit& u) const {
        if (i != 0) return false;
        if (round == 0) { const int pm = 8 * (c & 7) + ((c >> 3) & 7), pn = c >> 6; if (pm >= nmt) return false; fill(u, pm, pn, 0, D_FFE / 64, 0); u.rot = ((c & 7) * 7) & ~1; return true; }
        { const int t = c / 7, kp = c % 7; const int pm = 64 + (t >> 2), pn = t & 3; if (pm >= nmt || t >= 36) return false; fill(u, pm, pn, kp, 8, 1 + c); return true; }
        return false;
    }
};
__device__ __forceinline__ int moe_table(const Frame& F, int mode) {
    LAS int* tab = (LAS int*)(F.lds + MOE_OFF);
    __syncthreads();
    if (F.tid == 0) { const int* TOT = wsp<int>(F.ws, WS_TOT); int rs = 0, ts = 0;
        for (int e = 0; e < 8; ++e) { const int c0 = TOT[e], c1 = TOT[8 + e]; const int st = rs + (mode == 1 ? c0 : 0), c = mode == 0 ? c0 : (mode == 1 ? c1 : c0 + c1);
            tab[e] = st; tab[8 + e] = c; tab[16 + e] = ts; rs += c0 + c1; ts += (c + 255) >> 8; }
        tab[24] = ts; }
    __syncthreads();
    return __builtin_amdgcn_readfirstlane(tab[24]);
}

__device__ __forceinline__ void moe_tail_reduce(const Frame& F, int s) {
    const int nmt = moe_table(F, s); const LAS int* tab = (const LAS int*)(F.lds + MOE_OFF);
    const int gw = F.vcu * NWAVES + F.wave, lane = F.lane;
    const float* part = wsp<float>(F.ws, s ? A_WEGU2 : A_WEGU); const int* RTK = wsp<int>(F.ws, WS_ROWTOK); const float* RGT = wsp<float>(F.ws, WS_ROWGATE);
    int nrk[8], row0k[8]; int V = 0;
#pragma unroll
    for (int k = 0; k < 8; ++k) { const int pm = 64 + k; nrk[k] = 0; row0k[k] = 0;
        if (pm < nmt) { int e = 0;
#pragma unroll
            for (int q = 1; q < 8; ++q) if (pm >= tab[16 + q]) e = q;
            const int mt = pm - tab[16 + e]; row0k[k] = tab[e] + 256 * mt; int nr = tab[8 + e] - 256 * mt; nrk[k] = nr > 256 ? 256 : (nr < 0 ? 0 : nr); }
        nrk[k] = __builtin_amdgcn_readfirstlane(nrk[k]); row0k[k] = __builtin_amdgcn_readfirstlane(row0k[k]); V += nrk[k]; }
    for (int j = gw; j < 4 * V; j += F.G * NWAVES) { const int pn = j & 3; int r = j >> 2, k = 0, row0 = 0; bool done = false;
#pragma unroll
        for (int q = 0; q < 8; ++q) { if (!done) { if (r < nrk[q]) { done = true; k = q; row0 = row0k[q]; } else r -= nrk[q]; } }
        const int t = 4 * k + pn;
        { const int tok = RTK[row0 + r] & 16383; const float gt = RGT[row0 + r];
            f32x4 a = {0.f, 0.f, 0.f, 0.f};
#pragma unroll
            for (int kp = 0; kp < 7; ++kp) a += *(const f32x4*)(part + ((size_t)(t * 7 + kp) * 256 + r) * 256 + 4 * lane);
            bf16_t* xp = wsp<bf16_t>(F.ws, WS_XB) + (size_t)tok * 1024 + 256 * pn + 4 * lane; const u32x2 w = *(const u32x2*)xp;
            f32x4 o = {bflo(w.x), bfhi(w.x), bflo(w.y), bfhi(w.y)}; o += a * gt;
            if (s == 0) { u32x2 rr; rr.x = pk2(o[0], o[1]); rr.y = pk2(o[2], o[3]); *(u32x2*)xp = rr; }
            else *(f32x4*)(F.out + (size_t)tok * 1024 + 256 * pn + 4 * lane) = o; } }
}

constexpr int N_PHASES = 21;
__global__ void __launch_bounds__(NWAVES * 64, 2) mk_fwd(Args args) {
    extern __shared__ __attribute__((aligned(16))) unsigned char lds_raw[];
    Frame F; F.lds = (LAS unsigned char*)lds_raw; F.ws = (unsigned char*)(GAS unsigned char*)args.ws; F.in = args.in; F.out = (float*)(GAS float*)args.out;
    F.tid = threadIdx.x; F.lane = F.tid & 63; F.wave = __builtin_amdgcn_readfirstlane(F.tid >> 6);
    F.G = gridDim.x; { const int bx = blockIdx.x; F.vcu = (F.G % 8 == 0) ? (bx % 8) * (F.G / 8) + bx / 8 : bx; }
    volatile LAS unsigned* MISC = (volatile LAS unsigned*)(F.lds + MISC_OFF);
    if (F.tid < 64) MISC[F.tid] = 0u;
    __syncthreads();
    XcdBarrier bar; bar.bar = (unsigned*)(args.ws + WS_CTL) + CW_BAR; bar.x = 0; bar.st = nullptr;
    const int lo = args.ph_lo, hi = args.ph_hi;
    const bool multi = (hi - lo) > 1;
    if (multi) bar = xcd_barrier_post((unsigned*)(args.ws + WS_CTL) + CW_BAR, MISC + 8);
#ifdef PH_ONLY
#define IN(k) ((k) == PH_ONLY && lo <= (k) && (k) < hi)
#else
#define IN(k) (lo <= (k) && (k) < hi)
#endif
#define SEAM(k) do { if (IN(k) && IN((k) + 1)) xcd_barrier(bar); } while (0)
    unsigned char* ws = args.ws; const int cid = (int)blockIdx.x;
#define REFRESH() do { int t_ = threadIdx.x; asm volatile("" : "+v"(t_)); F.tid = t_; F.lane = t_ & 63; F.wave = __builtin_amdgcn_readfirstlane(t_ >> 6); GAS unsigned char* w_ = (GAS unsigned char*)args.ws; asm volatile("" : "+s"(w_)); F.ws = (unsigned char*)w_; ws = F.ws; } while (0)
    LAS unsigned char* ring = F.lds;

#ifndef MK_REP_MASK
#define MK_REP_MASK 0u
#endif
#define REPS(k) ((int)(((unsigned)(MK_REP_MASK) >> (k)) & 1u))
#define PHASE(k, ...) do { if (IN(k)) { for (int rep_ = 0; rep_ <= REPS(k); ++rep_) { if (rep_) xcd_barrier(bar); REFRESH(); __VA_ARGS__ } } SEAM(k); } while (0)
    PHASE(0, phase_prologue(F););
    PHASE(1, {
        pg8::DenseSched S; S.init(wsp<bf16_t>(ws, WS_XB), wsp<bf16_t>(ws, WS_WIN0), M_TOK, E_IN, 1024, F.G, cid);
        EpiScaleBf16 E{wsp<bf16_t>(ws, A_P0), E_IN, wsp<float>(ws, WS_SSQ0)};
        pg8::gemm_phase<EpiScaleBf16, pg8::DenseSched, false>(F.tid, ring, 1024, S, E, nullptr);
        if (F.G == 256 && cid >= 128 && rep_ == 0) { REFRESH(); conv_group(F, 1, (cid - 128) * NWAVES + F.wave, 128 * NWAVES); } });
    PHASE(2, phase_prep0(F););
    PHASE(3, {
        LowRankSched S; S.init(wsp<bf16_t>(ws, A_AP), wsp<bf16_t>(ws, WS_WLR), F.G, cid);
        EpiLowRank E{ws, F.in};
        pg8::gemm_phase<EpiLowRank, LowRankSched, false>(F.tid, ring, 256, S, E, nullptr); });
    PHASE(4, phase_cscan_attn_split(F););
    PHASE(5, phase_rwkv_post(F););
    PHASE(6, {
        pg8::DenseSched S; S.init(wsp<bf16_t>(ws, A_YCAT), wsp<bf16_t>(ws, WS_WOUT0), M_TOK, 1024, 1024, F.G, cid);
        EpiResidBf E{rep_ ? wsp<bf16_t>(ws, A_YF) : wsp<bf16_t>(ws, WS_XB), nullptr, rep_ ? wsp<float>(ws, WS_SSQ0) : wsp<float>(ws, WS_SSQ1)};
        pg8::gemm_phase<EpiResidBf, pg8::DenseSched, false>(F.tid, ring, 1024, S, E, nullptr); });
    PHASE(7, {
        pg8::DenseSched S; S.init(wsp<bf16_t>(ws, WS_XB), wsp<bf16_t>(ws, WS_WGU0), M_TOK, 2 * D_FF, 1024, F.G, cid);
        EpiSwiGLU E{wsp<bf16_t>(ws, A_HID0), D_FF, wsp<float>(ws, WS_SSQ1)};
        pg8::gemm_phase<EpiSwiGLU, pg8::DenseSched, false>(F.tid, ring, 1024, S, E, nullptr);
        if (F.G == 256 && cid >= 128 && rep_ == 0) { REFRESH(); conv_group(F, 2, (cid - 128) * NWAVES + F.wave, 128 * NWAVES); conv_experts_down(F, (cid - 128) * NWAVES + F.wave, 128 * NWAVES, ED_TAIL, NEXP); } });
    PHASE(8, {
        pg8::DenseSched S; S.init(wsp<bf16_t>(ws, A_HID0), wsp<bf16_t>(ws, WS_WD0), M_TOK, 1024, D_FF, F.G, cid);
        EpiResidBf E{rep_ ? wsp<bf16_t>(ws, A_YF) : wsp<bf16_t>(ws, WS_XB), nullptr, rep_ ? wsp<float>(ws, WS_SSQ0) : wsp<float>(ws, WS_SSQ2)};
        pg8::gemm_phase<EpiResidBf, pg8::DenseSched, false>(F.tid, ring, D_FF, S, E, nullptr); });
    PHASE(9, {
        pg8::DenseSched S; S.init(wsp<bf16_t>(ws, WS_XB), wsp<bf16_t>(ws, WS_WIN1), M_TOK, 3072, 1024, F.G, cid);
        EpiScaleBf16 E{wsp<bf16_t>(ws, A_P1), O_INP, wsp<float>(ws, WS_SSQ2)};
        pg8::gemm_phase<EpiScaleBf16, pg8::DenseSched, false>(F.tid, ring, 1024, S, E, nullptr);
        REFRESH(); phase_gd(F); });
    PHASE(10, phase_gla_prep(F););
    PHASE(11, phase_gla_main(F););
    PHASE(12, phase_gla_post(F););
    PHASE(13, {
        pg8::DenseSched S; S.init(wsp<bf16_t>(ws, A_GOUT), wsp<bf16_t>(ws, WS_WOUT1), M_TOK, 1024, 1024, F.G, cid);
        EpiResidBf E{rep_ ? wsp<bf16_t>(ws, A_VT1) : wsp<bf16_t>(ws, WS_XB), nullptr, nullptr};
        pg8::gemm_phase<EpiResidBf, pg8::DenseSched, false>(F.tid, ring, 1024, S, E, nullptr); });
    PHASE(14, { if (F.G == 256) phase_route<true>(F); else { phase_route<false>(F); __syncthreads(); REFRESH(); phase_conv_experts(F); } });
    PHASE(15, phase_place(F););
    PHASE(16, {
        const int nmt = moe_table(F, 2);
        MoESched S; S.go.init(nmt, 2 * D_FFE / 256, F.G, cid); S.tab = (const LAS int*)(F.lds + MOE_OFF);
        S.A = (const char*)wsp<bf16_t>(ws, WS_XB); S.Bt = (const char*)wsp<bf16_t>(ws, A_WEGU); S.a_rowbytes = 0; S.b_expert_bytes = (size_t)2 * D_FFE * 1024 * 2; S.b_tile_bytes = (size_t)256 * 1024 * 2; S.gather = true; S.nt_ = 16;
        const int* rtk = wsp<int>(ws, WS_ROWTOK);
        EpiSwiGLUMoE E{wsp<bf16_t>(ws, A_HID1), wsp<float>(ws, WS_ROWC1)};
        pg8::gemm_phase<EpiSwiGLUMoE, MoESched, true>(F.tid, ring, 1024, S, E, rtk); });
#pragma unroll 1
    for (int s = 0; s < 2; ++s) {
        PHASE(17 + 2 * s, {
            const int nmt = moe_table(F, s);
            MoEDownSched S; S.tab = (const LAS int*)(F.lds + MOE_OFF); S.A = (const char*)wsp<bf16_t>(ws, A_HID1); S.Bt = (const char*)wsp<bf16_t>(ws, A_WED); S.nmt = nmt; S.c = cid; S.round = 0;
            EpiMoEDown E{F.out, wsp<int>(ws, WS_ROWTOK), wsp<float>(ws, WS_ROWGATE), wsp<bf16_t>(ws, WS_XB), s == 1};
            pg8::gemm_phase<EpiMoEDown, MoEDownSched, false>(F.tid, ring, D_FFE, S, E, nullptr);
            REFRESH(); S.round = 1; EpiPart EP{wsp<float>(ws, s ? A_WEGU2 : A_WEGU)};
            pg8::gemm_phase<EpiPart, MoEDownSched, false>(F.tid, ring, D_FFE, S, EP, nullptr); });
        PHASE(18 + 2 * s, moe_tail_reduce(F, s););
    }
#undef PHASE
#undef REPS
#undef IN
#undef SEAM
}

extern "C" void kernel_launch(void* const* d_in, const int* in_sizes, int n_in, void* d_out, int out_size, void* d_ws, size_t ws_size, hipStream_t stream) {
    static int grid = 0;
    if (grid == 0) {
        if (n_in != 38 || out_size != M_TOK * D_MODEL || ws_size < WS_END) { fprintf(stderr, "kernel_launch: unexpected shapes: n_in %d out %d ws %zu (need %zu)\n", n_in, out_size, ws_size, (size_t)WS_END); grid = -1; return; }
        int dev = 0, cus = 0;
        if (hipGetDevice(&dev) != hipSuccess || hipDeviceGetAttribute(&cus, hipDeviceAttributeMultiprocessorCount, dev) != hipSuccess) { grid = -1; return; }
        if (hipFuncSetAttribute((const void*)mk_fwd, hipFuncAttributeMaxDynamicSharedMemorySize, LDS_BYTES) != hipSuccess) { fprintf(stderr, "kernel_launch: hipFuncSetAttribute failed\n"); grid = -1; return; }
        (void)hipGetLastError();
        grid = cus;
        if (grid != 256) fprintf(stderr, "kernel_launch: note: %d CUs (built for 256)\n", grid);
    }
    if (grid < 0) return;
    (void)hipMemsetAsync((char*)d_ws + WS_CTL, 0, CTL_ZERO_BYTES, stream);
    Args a{};
    for (int i = 0; i < 38; ++i) a.in[i] = (const float*)d_in[i];
    a.out = (float*)d_out; a.ws = (unsigned char*)d_ws;
#if MK_N_LAUNCHES == 1
    a.ph_lo = 0; a.ph_hi = N_PHASES - 1 + 0;
    a.ph_hi = 21;
    hipLaunchKernelGGL(mk_fwd, dim3(grid), dim3(NWAVES * 64), LDS_BYTES, stream, a);
#else
#ifndef MK_LAST_PHASE
#define MK_LAST_PHASE 20
#endif
    for (int p = 0; p < MK_LAST_PHASE; ++p) { a.ph_lo = p; a.ph_hi = p + 1; hipLaunchKernelGGL(mk_fwd, dim3(grid), dim3(NWAVES * 64), LDS_BYTES, stream, a); }
#endif
}
```
